# Optimizing an MI355X kernel written in HIP

```python
import math
import jax
import jax.numpy as jnp
from jax import lax
import numpy as np

D_MODEL = 1024
BATCH = 2
SEQ = 8192
DEPTH = 4

GRID_W = 64
CTX_LEN = 256
D_MIX = D_MODEL
W_GROUP = D_MIX // 4
EPS = 1e-6
CONV_W = 3
ROPE_BASE = 10000.0

ML_HEADS = 4
ML_DH = W_GROUP // ML_HEADS
ML_CHUNK = 64

MLA_HEADS = 4
MLA_NOPE = 64
MLA_ROPE = 32
MLA_V = W_GROUP // MLA_HEADS
MLA_Q_LORA = 256
MLA_KV_LORA = 128
ATTN_BLOCK = 128

SSD_HEADDIM = 64
SSD_HEADS = W_GROUP // SSD_HEADDIM
SSD_GROUPS = 2
SSD_STATE = 128
SSD_CHUNK = 64

S5_GROUP = 16
S5_NGROUPS = W_GROUP // S5_GROUP
S5_STATE = 64

D_FF = 2816

ML_COLS = 4 * W_GROUP + 4 * ML_HEADS
MLA_COLS = MLA_Q_LORA + MLA_KV_LORA + MLA_ROPE
SSD_COLS = 2 * W_GROUP + 2 * SSD_GROUPS * SSD_STATE + 2 * SSD_HEADS
S5_COLS = W_GROUP
P_IN = ML_COLS + MLA_COLS + SSD_COLS + S5_COLS
SPLIT_IN = (ML_COLS, ML_COLS + MLA_COLS, ML_COLS + MLA_COLS + SSD_COLS)

kernel_name = 'hybrid_parallel_groups_dit_trunk'


def rmsnorm(x, g):
    x32 = x.astype(jnp.float32)
    y = x32 * lax.rsqrt(jnp.mean(x32 * x32, axis=-1, keepdims=True) + EPS)
    return (y * g.astype(jnp.float32)).astype(x.dtype)


def modulate(h, shift, scale):
    return h * (1 + scale) + shift


def dwconv(x, w, b=None):
    pad = (CONV_W - 1) // 2
    y = lax.conv_general_dilated(x, w[:, None, :].astype(x.dtype), window_strides=(1,),
                                 padding=((pad, pad),), dimension_numbers=('NWC', 'WIO', 'NWC'),
                                 feature_group_count=x.shape[-1])
    return y if b is None else y + b


def axial_rope_tables(n_tokens, dim):
    rows = n_tokens // GRID_W
    row = jnp.broadcast_to(jnp.arange(rows)[:, None], (rows, GRID_W)).reshape(-1).astype(jnp.float32)
    col = jnp.broadcast_to(jnp.arange(GRID_W)[None, :], (rows, GRID_W)).reshape(-1).astype(jnp.float32)
    n_freq = dim // 4
    inv = ROPE_BASE ** (-jnp.arange(n_freq, dtype=jnp.float32) / n_freq)
    ang = jnp.concatenate([row[:, None] * inv, col[:, None] * inv], axis=-1)
    return jnp.cos(ang), jnp.sin(ang)


def apply_rope(x, cos, sin):
    x1, x2 = jnp.split(x.astype(jnp.float32), 2, axis=-1)
    cs, sn = cos[:, None, :], sin[:, None, :]
    return jnp.concatenate([x1 * cs - x2 * sn, x1 * sn + x2 * cs], axis=-1).astype(x.dtype)


def mlstm_chunked(q, k, v, ig, lf, state):
    bsz, nh, T, dh = q.shape
    nc = T // ML_CHUNK

    def to_chunks(a):
        return jnp.moveaxis(a.reshape(a.shape[:2] + (nc, ML_CHUNK) + a.shape[3:]), 2, 0)

    mask = jnp.tril(jnp.ones((ML_CHUNK, ML_CHUNK), dtype=bool))

    def step(carry, blk):
        C, n, m = carry
        qb, kb, vb, ib, fb = blk
        b = jnp.cumsum(fb, axis=-1)
        dmat = jnp.where(mask, b[..., :, None] - b[..., None, :] + ib[..., None, :], -jnp.inf)
        inter = b + m[..., None]
        m_t = jnp.maximum(inter, jnp.max(dmat, axis=-1))
        w_inter = jnp.exp(inter - m_t)
        s = jnp.einsum('bhtd,bhsd->bhts', qb, kb) * jnp.exp(dmat - m_t[..., None])
        num = jnp.einsum('bhts,bhse->bhte', s, vb) + w_inter[..., None] * jnp.einsum('bhtd,bhde->bhte', qb, C)
        den = jnp.sum(s, axis=-1) + w_inter * jnp.einsum('bhtd,bhd->bht', qb, n)
        h = num / jnp.maximum(jnp.abs(den), jnp.exp(-m_t))[..., None]
        b_last = b[..., -1]
        w_log = b_last[..., None] - b + ib
        m_new = jnp.maximum(b_last + m, jnp.max(w_log, axis=-1))
        decay = jnp.exp(b_last + m - m_new)
        w_s = jnp.exp(w_log - m_new[..., None])
        C = decay[..., None, None] * C + jnp.einsum('bhs,bhsd,bhse->bhde', w_s, kb, vb)
        n = decay[..., None] * n + jnp.einsum('bhs,bhsd->bhd', w_s, kb)
        return (C, n, m_new), h

    state, h = lax.scan(step, state, tuple(to_chunks(a) for a in (q, k, v, ig, lf)))
    return jnp.moveaxis(h, 0, 2).reshape(bsz, nh, T, dh), state


def mlstm_mixer(pc, pl, gate_bias, norm_g):
    def prep(p):
        q, k, v, o, g = jnp.split(p, [W_GROUP, 2 * W_GROUP, 3 * W_GROUP, 4 * W_GROUP], axis=-1)
        bsz, T = p.shape[:2]

        def heads(a):
            return jnp.moveaxis(a.astype(jnp.float32).reshape(bsz, T, ML_HEADS, ML_DH), 2, 1)

        g = jnp.moveaxis(g.astype(jnp.float32).reshape(bsz, T, 4, ML_HEADS) + gate_bias, 1, 3)
        return heads(q), heads(k) * ML_DH ** -0.5, heads(v), o, g

    qc, kc, vc, oc, gc = prep(pc)
    ql, kl, vl, ol, gl = prep(pl)
    bsz = pl.shape[0]
    zero = (jnp.zeros((bsz, ML_HEADS, ML_DH, ML_DH), jnp.float32),
            jnp.zeros((bsz, ML_HEADS, ML_DH), jnp.float32),
            jnp.zeros((bsz, ML_HEADS), jnp.float32))
    flip = lambda a: jnp.flip(a, axis=2)
    hc_sum, hl_sum = 0.0, 0.0
    for d in range(2):
        ctx_args = (qc, kc, vc, gc[:, 2 * d], jax.nn.log_sigmoid(gc[:, 2 * d + 1]))
        lat_args = (ql, kl, vl, gl[:, 2 * d], jax.nn.log_sigmoid(gl[:, 2 * d + 1]))
        if d == 1:
            ctx_args = tuple(flip(a) for a in ctx_args)
            lat_args = tuple(flip(a) for a in lat_args)
        hc, st = mlstm_chunked(*ctx_args, zero)
        hl, _ = mlstm_chunked(*lat_args, st)
        if d == 1:
            hc, hl = flip(hc), flip(hl)
        hc_sum = hc_sum + hc
        hl_sum = hl_sum + hl

    def out(h, o):
        bsz_, _, T, _ = h.shape
        h = rmsnorm(jnp.moveaxis(h, 1, 2), norm_g.reshape(ML_HEADS, ML_DH)).reshape(bsz_, T, W_GROUP)
        return (h * jax.nn.sigmoid(o.astype(jnp.float32))).astype(o.dtype)

    return out(hc_sum, oc), out(hl_sum, ol)


def mla_mixer(pc, pl, q_norm, kv_norm, w_uq, w_ukv, cos, sin):
    scale = (MLA_NOPE + MLA_ROPE) ** -0.5

    def project(p, rotate):
        cq, ckv, kr = jnp.split(p, [MLA_Q_LORA, MLA_Q_LORA + MLA_KV_LORA], axis=-1)
        bsz, T = p.shape[:2]
        q = (rmsnorm(cq, q_norm) @ w_uq).reshape(bsz, T, MLA_HEADS, MLA_NOPE + MLA_ROPE)
        kv = (rmsnorm(ckv, kv_norm) @ w_ukv).reshape(bsz, T, MLA_HEADS, MLA_NOPE + MLA_V)
        q_nope, q_rope = jnp.split(q, [MLA_NOPE], axis=-1)
        k_nope, v = jnp.split(kv, [MLA_NOPE], axis=-1)
        kr = kr[:, :, None, :]
        if rotate:
            q_rope = apply_rope(q_rope, cos, sin)
            kr = apply_rope(kr, cos, sin)
        q = jnp.concatenate([q_nope, q_rope], axis=-1)
        k = jnp.concatenate([k_nope, jnp.broadcast_to(kr, k_nope.shape[:-1] + (MLA_ROPE,))], axis=-1)
        return q, k, v

    def attend(q, k, v):
        s = jnp.einsum('bqhd,bkhd->bhqk', q, k).astype(jnp.float32) * scale
        p = jax.nn.softmax(s, axis=-1).astype(v.dtype)
        return jnp.einsum('bhqk,bkhd->bqhd', p, v)

    qc, kc, vc = project(pc, False)
    ql, kl, vl = project(pl, True)
    bsz, Tc = pc.shape[:2]
    T = pl.shape[1]
    yc = attend(qc, kc, vc).reshape(bsz, Tc, W_GROUP)
    k_all = jnp.concatenate([kl, kc], axis=1)
    v_all = jnp.concatenate([vl, vc], axis=1)
    nb = T // ATTN_BLOCK
    qb = jnp.moveaxis(ql.reshape(bsz, nb, ATTN_BLOCK, MLA_HEADS, MLA_NOPE + MLA_ROPE), 1, 0)
    yl = lax.map(lambda qq: attend(qq, k_all, v_all), qb)
    yl = jnp.moveaxis(yl, 0, 1).reshape(bsz, T, W_GROUP)
    return yc, yl


def ssd_chunked(q, k, v, la, S):
    bsz, nh, T, _ = q.shape
    nc = T // SSD_CHUNK

    def to_chunks(a):
        return jnp.moveaxis(a.reshape(a.shape[:2] + (nc, SSD_CHUNK) + a.shape[3:]), 2, 0)

    mask = jnp.tril(jnp.ones((SSD_CHUNK, SSD_CHUNK), dtype=bool))

    def step(S, blk):
        qb, kb, vb, lb = blk
        cs = jnp.cumsum(lb, axis=-1)
        decay = jnp.exp(jnp.where(mask, cs[..., :, None] - cs[..., None, :], -jnp.inf))
        y = jnp.einsum('bhts,bhsp->bhtp', jnp.einsum('bhtn,bhsn->bhts', qb, kb) * decay, vb) \
            + jnp.exp(cs)[..., None] * jnp.einsum('bhtn,bhnp->bhtp', qb, S)
        w_s = jnp.exp(cs[..., -1:] - cs)
        S = jnp.exp(cs[..., -1])[..., None, None] * S + jnp.einsum('bhs,bhsn,bhsp->bhnp', w_s, kb, vb)
        return S, y

    S, y = lax.scan(step, S, tuple(to_chunks(a) for a in (q, k, v, la)))
    return jnp.moveaxis(y, 0, 2).reshape(bsz, nh, T, v.shape[-1]), S


def ssd_mixer(pc, pl, conv_w, conv_b, a_log, dt_bias, d_skip, norm_g):
    gn = SSD_GROUPS * SSD_STATE
    rep = SSD_HEADS // SSD_GROUPS

    def prep(p):
        z, xbc, dt = jnp.split(p, [W_GROUP, 2 * W_GROUP + 2 * gn], axis=-1)
        xbc = jax.nn.silu(dwconv(xbc, conv_w, conv_b)).astype(jnp.float32)
        xs, bm, cm = jnp.split(xbc, [W_GROUP, W_GROUP + gn], axis=-1)
        bsz, T = p.shape[:2]
        xs = jnp.moveaxis(xs.reshape(bsz, T, SSD_HEADS, SSD_HEADDIM), 2, 1)
        bm = jnp.repeat(jnp.moveaxis(bm.reshape(bsz, T, SSD_GROUPS, SSD_STATE), 2, 1), rep, axis=1)
        cm = jnp.repeat(jnp.moveaxis(cm.reshape(bsz, T, SSD_GROUPS, SSD_STATE), 2, 1), rep, axis=1)
        dt = jax.nn.softplus(dt.astype(jnp.float32).reshape(bsz, T, 2, SSD_HEADS) + dt_bias)
        return z, xs, bm, cm, jnp.moveaxis(dt, 1, 3)

    zc, xc, bc, cc, dtc = prep(pc)
    zl, xl, bl, cl, dtl = prep(pl)
    bsz = pl.shape[0]
    zero = jnp.zeros((bsz, SSD_HEADS, SSD_STATE, SSD_HEADDIM), jnp.float32)
    flip = lambda a: jnp.flip(a, axis=2)
    yc = d_skip[:, None, None] * xc
    yl = d_skip[:, None, None] * xl
    for d in range(2):
        A = -jnp.exp(a_log[d])[:, None]
        ctx_args = (cc, bc * dtc[:, d, ..., None], xc, dtc[:, d] * A)
        lat_args = (cl, bl * dtl[:, d, ..., None], xl, dtl[:, d] * A)
        if d == 1:
            ctx_args = tuple(flip(a) for a in ctx_args)
            lat_args = tuple(flip(a) for a in lat_args)
        hc, S = ssd_chunked(*ctx_args, zero)
        hl, _ = ssd_chunked(*lat_args, S)
        if d == 1:
            hc, hl = flip(hc), flip(hl)
        yc = yc + hc
        yl = yl + hl

    def out(y, z):
        bsz_, _, T, _ = y.shape
        y = jnp.moveaxis(y, 1, 2).reshape(bsz_, T, W_GROUP)
        return rmsnorm(y * jax.nn.silu(z.astype(jnp.float32)), norm_g).astype(z.dtype)

    return out(yc, zc), out(yl, zl)


def diag_scan(ab_re, ab_im, bu_re, bu_im, x0_re, x0_im):
    bu_re = bu_re.at[:, 0].add(ab_re * x0_re - ab_im * x0_im)
    bu_im = bu_im.at[:, 0].add(ab_re * x0_im + ab_im * x0_re)
    a_re = jnp.broadcast_to(ab_re, bu_re.shape)
    a_im = jnp.broadcast_to(ab_im, bu_im.shape)

    def op(e1, e2):
        a1r, a1i, b1r, b1i = e1
        a2r, a2i, b2r, b2i = e2
        return (a2r * a1r - a2i * a1i, a2r * a1i + a2i * a1r,
                a2r * b1r - a2i * b1i + b2r, a2r * b1i + a2i * b1r + b2i)

    _, _, xr, xi = lax.associative_scan(op, (a_re, a_im, bu_re, bu_im), axis=1)
    return xr, xi


def s5_mixer(uc, ul, a_re, a_im, log_dt, b_re, b_im, c_re, c_im, d_skip, w_glu):
    def groups(u):
        return u.astype(jnp.float32).reshape(u.shape[0], u.shape[1], S5_NGROUPS, S5_GROUP)

    def readout(s_re, s_im):
        return jnp.einsum('gjn,btgn->btgj', c_re, s_re) - jnp.einsum('gjn,btgn->btgj', c_im, s_im)

    ugc, ugl = groups(uc), groups(ul)
    zero = jnp.zeros((uc.shape[0], S5_NGROUPS, S5_STATE), jnp.float32)
    dg = d_skip.reshape(S5_NGROUPS, S5_GROUP)
    yc = dg * ugc
    yl = dg * ugl
    for d in range(2):
        lam_re = jnp.minimum(a_re[d], -1e-4)
        lam_im = a_im[d]
        dt = jnp.exp(log_dt[d])[:, None]
        mag = jnp.exp(lam_re * dt)
        ab_re, ab_im = mag * jnp.cos(lam_im * dt), mag * jnp.sin(lam_im * dt)
        den = lam_re * lam_re + lam_im * lam_im
        f_re = ((ab_re - 1) * lam_re + ab_im * lam_im) / den
        f_im = (ab_im * lam_re - (ab_re - 1) * lam_im) / den
        bb_re = f_re[..., None] * b_re - f_im[..., None] * b_im
        bb_im = f_re[..., None] * b_im + f_im[..., None] * b_re

        def drive(ug):
            return (jnp.einsum('gnj,btgj->btgn', bb_re, ug), jnp.einsum('gnj,btgj->btgn', bb_im, ug))

        uc_d, ul_d = (ugc, ugl) if d == 0 else (jnp.flip(ugc, 1), jnp.flip(ugl, 1))
        sc_re, sc_im = diag_scan(ab_re, ab_im, *drive(uc_d), zero, zero)
        sl_re, sl_im = diag_scan(ab_re, ab_im, *drive(ul_d), sc_re[:, -1], sc_im[:, -1])
        rc, rl = readout(sc_re, sc_im), readout(sl_re, sl_im)
        if d == 1:
            rc, rl = jnp.flip(rc, 1), jnp.flip(rl, 1)
        yc = yc + rc
        yl = yl + rl

    def glu(y, like):
        y = jax.nn.gelu(y.reshape(y.shape[0], y.shape[1], W_GROUP))
        return (y * jax.nn.sigmoid(y @ w_glu.astype(jnp.float32))).astype(like.dtype)

    return glu(yc, uc), glu(yl, ul)


def conv_ffn(h, w_up, conv_w, w_down):
    u, g = jnp.split(h @ w_up, 2, axis=-1)
    return (jax.nn.silu(dwconv(g, conv_w)) * u) @ w_down


def setup_inputs(seed: int = 0) -> dict:
    key = jax.random.key(seed)
    ks = iter(jax.random.split(key, 48))
    f32 = jnp.float32
    L, D = DEPTH, D_MODEL

    def nrm(shape, scale):
        return scale * jax.random.normal(next(ks), shape, f32)

    def gain(shape):
        return 1.0 + 0.02 * jax.random.normal(next(ks), shape, f32)

    def unif(shape, lo, hi):
        return jax.random.uniform(next(ks), shape, f32, lo, hi)

    ssd_conv_ch = W_GROUP + 2 * SSD_GROUPS * SSD_STATE
    fgate = jnp.linspace(3.0, 6.0, ML_HEADS, dtype=f32)
    igate = jnp.zeros((ML_HEADS,), f32)
    ml_gate_bias = jnp.stack([igate, fgate, igate, fgate])[None] + nrm((L, 4, ML_HEADS), 0.1)
    dt0 = jnp.exp(unif((L, 2, SSD_HEADS), math.log(1e-3), math.log(1e-1)))
    return {
        'x': nrm((BATCH, SEQ, D), 1.0),
        'c': nrm((BATCH, D), 1.0),
        'ctx': nrm((BATCH, CTX_LEN, D), 1.0),
        'c_ctx': nrm((D,), 1.0),
        'w_mod': nrm((L, D, 6 * D), 0.5 * D ** -0.5),
        'b_mod': nrm((L, 6 * D), 0.01),
        'norm1': gain((L, D)),
        'norm2': gain((L, D)),
        'w_in': nrm((L, D, P_IN), D ** -0.5),
        'ml_gate_bias': ml_gate_bias,
        'ml_norm': gain((L, W_GROUP)),
        'mla_q_norm': gain((L, MLA_Q_LORA)),
        'mla_kv_norm': gain((L, MLA_KV_LORA)),
        'mla_w_uq': nrm((L, MLA_Q_LORA, MLA_HEADS * (MLA_NOPE + MLA_ROPE)), MLA_Q_LORA ** -0.5),
        'mla_w_ukv': nrm((L, MLA_KV_LORA, MLA_HEADS * (MLA_NOPE + MLA_V)), MLA_KV_LORA ** -0.5),
        'ssd_conv_w': nrm((L, CONV_W, ssd_conv_ch), CONV_W ** -0.5),
        'ssd_conv_b': nrm((L, ssd_conv_ch), 0.01),
        'ssd_a_log': jnp.log(unif((L, 2, SSD_HEADS), 1.0, 16.0)),
        'ssd_dt_bias': dt0 + jnp.log(-jnp.expm1(-dt0)),
        'ssd_d': gain((L, SSD_HEADS)),
        'ssd_norm': gain((L, W_GROUP)),
        's5_a_re': -0.5 + nrm((L, 2, S5_NGROUPS, S5_STATE), 0.01),
        's5_a_im': jnp.broadcast_to(math.pi * jnp.arange(S5_STATE, dtype=f32), (L, 2, S5_NGROUPS, S5_STATE)),
        's5_log_dt': unif((L, 2, S5_NGROUPS), math.log(1e-3), math.log(1e-1)),
        's5_b_re': nrm((L, S5_NGROUPS, S5_STATE, S5_GROUP), (2 * S5_GROUP) ** -0.5),
        's5_b_im': nrm((L, S5_NGROUPS, S5_STATE, S5_GROUP), (2 * S5_GROUP) ** -0.5),
        's5_c_re': nrm((L, S5_NGROUPS, S5_GROUP, S5_STATE), S5_STATE ** -0.5),
        's5_c_im': nrm((L, S5_NGROUPS, S5_GROUP, S5_STATE), S5_STATE ** -0.5),
        's5_d': gain((L, W_GROUP)),
        's5_w_glu': nrm((L, W_GROUP, W_GROUP), W_GROUP ** -0.5),
        'w_out': nrm((L, D_MIX, D), D_MIX ** -0.5),
        'ffn_w_up': nrm((L, D, 2 * D_FF), D ** -0.5),
        'ffn_conv_w': nrm((L, CONV_W, D_FF), CONV_W ** -0.5),
        'ffn_w_down': nrm((L, D_FF, D), D_FF ** -0.5),
        'final_norm': gain((D,)),
    }


def reference(x, c, ctx, c_ctx, w_mod, b_mod, norm1, norm2, w_in, ml_gate_bias, ml_norm,
              mla_q_norm, mla_kv_norm, mla_w_uq, mla_w_ukv, ssd_conv_w, ssd_conv_b, ssd_a_log,
              ssd_dt_bias, ssd_d, ssd_norm, s5_a_re, s5_a_im, s5_log_dt, s5_b_re, s5_b_im,
              s5_c_re, s5_c_im, s5_d, s5_w_glu, w_out, ffn_w_up, ffn_conv_w, ffn_w_down, final_norm):
    cos, sin = axial_rope_tables(x.shape[1], MLA_ROPE)
    s_lat = jax.nn.silu(c)
    s_ctx = jax.nn.silu(c_ctx)
    for l in range(DEPTH):
        ml = jnp.split(s_lat @ w_mod[l] + b_mod[l], 6, axis=-1)
        mc = jnp.split(s_ctx @ w_mod[l] + b_mod[l], 6, axis=-1)
        hl = modulate(rmsnorm(x, norm1[l]), ml[0][:, None], ml[1][:, None])
        hc = modulate(rmsnorm(ctx, norm1[l]), mc[0], mc[1])
        pl = jnp.split(hl @ w_in[l], SPLIT_IN, axis=-1)
        pc = jnp.split(hc @ w_in[l], SPLIT_IN, axis=-1)
        ya_c, ya_l = mlstm_mixer(pc[0], pl[0], ml_gate_bias[l], ml_norm[l])
        yb_c, yb_l = mla_mixer(pc[1], pl[1], mla_q_norm[l], mla_kv_norm[l], mla_w_uq[l], mla_w_ukv[l], cos, sin)
        yc_c, yc_l = ssd_mixer(pc[2], pl[2], ssd_conv_w[l], ssd_conv_b[l], ssd_a_log[l], ssd_dt_bias[l],
                               ssd_d[l], ssd_norm[l])
        yd_c, yd_l = s5_mixer(pc[3], pl[3], s5_a_re[l], s5_a_im[l], s5_log_dt[l], s5_b_re[l], s5_b_im[l],
                              s5_c_re[l], s5_c_im[l], s5_d[l], s5_w_glu[l])
        y_lat = jnp.concatenate([ya_l, yb_l, yc_l, yd_l], axis=-1) @ w_out[l]
        x = x + ml[2][:, None] * y_lat
        h2 = modulate(rmsnorm(x, norm2[l]), ml[3][:, None], ml[4][:, None])
        x = x + ml[5][:, None] * conv_ffn(h2, ffn_w_up[l], ffn_conv_w[l], ffn_w_down[l])
        if l < DEPTH - 1:
            y_ctx = jnp.concatenate([ya_c, yb_c, yc_c, yd_c], axis=-1) @ w_out[l]
            ctx = ctx + mc[2] * y_ctx
            hc2 = modulate(rmsnorm(ctx, norm2[l]), mc[3], mc[4])
            ctx = ctx + mc[5] * conv_ffn(hc2, ffn_w_up[l], ffn_conv_w[l], ffn_w_down[l])
    return rmsnorm(x, final_norm)
```

```cpp
#include <hip/hip_runtime.h>
#include <hip/hip_cooperative_groups.h>
#include <cstdio>
#include <cstdint>
namespace cg = cooperative_groups;

#ifndef PROBE_MASK
#define PROBE_MASK 63
#endif
#ifndef MULTI_LAUNCH
#define MULTI_LAUNCH 0
#endif

typedef unsigned short bf16_t;
typedef short bf16x8 __attribute__((ext_vector_type(8)));
typedef float f32x4 __attribute__((ext_vector_type(4)));
typedef unsigned u32x4 __attribute__((ext_vector_type(4)));
typedef unsigned u32x2 __attribute__((ext_vector_type(2)));
#define DI __device__ __forceinline__
#define MFMA16(a, b, c) __builtin_amdgcn_mfma_f32_16x16x32_bf16((a), (b), (c), 0, 0, 0)

constexpr int NB = 2, T = 8192, TC = 256, NL = 4;
constexpr int NLAT = NB * T, NROW = NLAT + NB * TC;
constexpr int TALL = T + TC;
constexpr int PINP = 2816;
constexpr int C_MLQ = 0, C_MLK = 256, C_MLV = 512, C_MLO = 768, C_CQ = 1040, C_CKV = 1296, C_KR = 1424,
              C_Z = 1456, C_XBC = 1712, C_S5 = 2488;
constexpr int NCH = 132;
constexpr int DFF = 2816;

constexpr size_t SZ_WIN = (size_t)NL * 2816 * 1024 * 2, SZ_WUQ = (size_t)NL * 384 * 256 * 2, SZ_WUKV = (size_t)NL * 512 * 128 * 2,
                 SZ_WGLU = (size_t)NL * 256 * 256 * 2, SZ_WOUT = (size_t)NL * 1024 * 1024 * 2, SZ_WUP = (size_t)NL * 5632 * 1024 * 2,
                 SZ_WDN = (size_t)NL * 1024 * 2816 * 2, SZ_MOD = (size_t)NL * 3 * 6144 * 4, SZ_CTX = (size_t)512 * 1024 * 4,
                 SZ_HY = (size_t)NROW * 1024 * 2, SZ_GML = (size_t)NROW * 16 * 4, SZ_DTR = (size_t)NROW * 8 * 4, SZ_SSQ = (size_t)NROW * 4 * 4,
                 SZ_QRAW = (size_t)NROW * 384 * 2, SZ_KH = (size_t)NB * 4 * TALL * 64 * 2 + (size_t)NB * TALL * 32 * 2, SZ_VT = (size_t)NB * 4 * 64 * TALL * 2,
                 SZ_S5S = (size_t)NB * 16 * 2 * NCH * 128 * 4, SZ_MLM = (size_t)16 * NCH * 32 * 4, SZ_SSA = (size_t)16 * NCH * 32 * 4,
                 SZ_P = (size_t)NROW * PINP * 2, SZ_MLS = (size_t)16 * NCH * 4160 * 4, SZ_SSDS = (size_t)16 * NCH * 8192 * 4;
constexpr size_t OFF_WIN = 0, OFF_WUQ = OFF_WIN + SZ_WIN, OFF_WUKV = OFF_WUQ + SZ_WUQ, OFF_WGLU = OFF_WUKV + SZ_WUKV,
                 OFF_WOUT = OFF_WGLU + SZ_WGLU, OFF_WUP = OFF_WOUT + SZ_WOUT, OFF_WDN = OFF_WUP + SZ_WUP, OFF_MOD = OFF_WDN + SZ_WDN,
                 OFF_CTX = OFF_MOD + SZ_MOD, OFF_HY = OFF_CTX + SZ_CTX, OFF_GML = OFF_HY + SZ_HY, OFF_DTR = OFF_GML + SZ_GML,
                 OFF_SSQ = OFF_DTR + SZ_DTR, OFF_QRAW = OFF_SSQ + SZ_SSQ, OFF_KH = OFF_QRAW + SZ_QRAW, OFF_VT = OFF_KH + SZ_KH,
                 OFF_S5S = OFF_VT + SZ_VT, OFF_MLM = OFF_S5S + SZ_S5S, OFF_SSA = OFF_MLM + SZ_MLM,
                 OFF_R = ((OFF_SSA + SZ_SSA + 255) / 256) * 256, OFF_P = OFF_R, OFF_MLS = OFF_P + SZ_P, OFF_SSDS = OFF_MLS + SZ_MLS,
                 WS_NEED = OFF_SSDS + SZ_SSDS;
static_assert((size_t)NROW * 5632 * 2 <= SZ_P + SZ_MLS + SZ_SSDS, "UG overlay");

constexpr size_t OFF_KR = OFF_KH + (size_t)NB * 4 * TALL * 64 * 2;
struct Params {
  const float *x, *c, *ctx, *c_ctx, *w_mod, *b_mod, *norm1, *norm2, *w_in, *ml_gate_bias, *ml_norm, *mla_q_norm, *mla_kv_norm,
      *mla_w_uq, *mla_w_ukv, *ssd_conv_w, *ssd_conv_b, *ssd_a_log, *ssd_dt_bias, *ssd_d, *ssd_norm, *s5_a_re, *s5_a_im, *s5_log_dt,
      *s5_b_re, *s5_b_im, *s5_c_re, *s5_c_im, *s5_d, *s5_w_glu, *w_out, *ffn_w_up, *ffn_conv_w, *ffn_w_down, *final_norm;
  float* xb;
  char* ws;
  int ph_lo, ph_hi;
};

DI bf16_t f2bf(float x) { unsigned u = __float_as_uint(x); u += 0x7fffu + ((u >> 16) & 1u); return (bf16_t)(u >> 16); }
DI float bf2f(bf16_t v) { return __uint_as_float(((unsigned)v) << 16); }
DI unsigned pack2(float lo, float hi) { return (unsigned)f2bf(lo) | ((unsigned)f2bf(hi) << 16); }
DI float bflo(unsigned w) { return __uint_as_float(w << 16); }
DI float bfhi(unsigned w) { return __uint_as_float(w & 0xffff0000u); }
DI float silu_f(float x) { return x / (1.f + __expf(-x)); }
DI float sigm_f(float x) { return 1.f / (1.f + __expf(-x)); }
DI float softplus_f(float x) { return fmaxf(x, 0.f) + log1pf(__expf(-fabsf(x))); }
DI float logsigm_f(float x) { return fminf(x, 0.f) - log1pf(__expf(-fabsf(x))); }
DI float gelu_tanh_f(float x) { float u = 0.7978845608f * (x + 0.044715f * x * x * x); return x * sigm_f(2.f * u); }
DI float wave_sum(float v) { for (int o = 32; o; o >>= 1) v += __shfl_xor(v, o); return v; }
DI float wave_max(float v) { for (int o = 32; o; o >>= 1) v = fmaxf(v, __shfl_xor(v, o)); return v; }
DI float wave_incl_scan(float v, int lane) { for (int o = 1; o < 64; o <<= 1) { float t = __shfl_up(v, o); if (lane >= o) v += t; } return v; }
DI float red16_max(float v) { v = fmaxf(v, __shfl_xor(v, 1)); v = fmaxf(v, __shfl_xor(v, 2)); v = fmaxf(v, __shfl_xor(v, 4)); v = fmaxf(v, __shfl_xor(v, 8)); return v; }
DI float red16_sum(float v) { v += __shfl_xor(v, 1); v += __shfl_xor(v, 2); v += __shfl_xor(v, 4); v += __shfl_xor(v, 8); return v; }
DI bf16x8 ld_frag(const bf16_t* p) { return *(const bf16x8*)p; }
DI bf16x8 mk_frag(unsigned a, unsigned b, unsigned c, unsigned d) { u32x4 u = {a, b, c, d}; return __builtin_bit_cast(bf16x8, u); }
DI bf16x8 frag_from_f32(const float* p, float sgn) {
  float4 a = *(const float4*)p, b = *(const float4*)(p + 4);
  return mk_frag(pack2(a.x * sgn, a.y * sgn), pack2(a.z * sgn, a.w * sgn), pack2(b.x * sgn, b.y * sgn), pack2(b.z * sgn, b.w * sgn));
}
DI int ltid() { int t = threadIdx.x; asm volatile("" : "+v"(t)); return t; }
DI int row_of(int b, int part, int t) { return part ? NLAT + b * TC + t : b * T + t; }

DI void tr_tile(const float* __restrict__ src, int K, int N, bf16_t* __restrict__ dst, const float* gain, int glo, int ghi, int tk, int tn, float* tile) {
  const int tid = ltid(), c = tid & 63, rq = tid >> 6;
  for (int rr = 0; rr < 16; ++rr) {
    const int r = rr * 4 + rq, k = tk * 64 + r, n = tn * 64 + c;
    float v = (n < N) ? src[(size_t)k * N + n] : 0.f;
    if (gain && k >= glo && k < ghi) v *= gain[k - glo];
    tile[r * 65 + c] = v;
  }
  __syncthreads();
  for (int cc = 0; cc < 16; ++cc) { const int n = cc * 4 + rq; dst[(size_t)(tn * 64 + n) * K + tk * 64 + c] = f2bf(tile[c * 65 + n]); }
  __syncthreads();
}

constexpr int TR_PER_LAYER = 3128, P0_TR = NL * TR_PER_LAYER, P0_MOD = NL * 96, P0_CPX = NLAT * 1024 / 4096, P0_CPC = 512 * 1024 / 4096;
constexpr int P0_ZERO = (int)((WS_NEED - OFF_HY + 65535) / 65536);
constexpr int P0_ITEMS = P0_TR + P0_MOD + P0_CPX + P0_CPC + P0_ZERO;

DI void p0_item(const Params& p, int item, char* smem) {
  const int tid = ltid();
  if (item < P0_TR) {
    const int l = item / TR_PER_LAYER; int t = item % TR_PER_LAYER; float* tile = (float*)smem;
    if (t < 704) { tr_tile(p.w_in + (size_t)l * 1024 * 2744, 1024, 2744, (bf16_t*)(p.ws + OFF_WIN) + (size_t)l * 2816 * 1024, nullptr, 0, 0, t / 44, t % 44, tile); return; }
    t -= 704;
    if (t < 24) { tr_tile(p.mla_w_uq + (size_t)l * 256 * 384, 256, 384, (bf16_t*)(p.ws + OFF_WUQ) + (size_t)l * 384 * 256, p.mla_q_norm + l * 256, 0, 256, t / 6, t % 6, tile); return; }
    t -= 24;
    if (t < 16) { tr_tile(p.mla_w_ukv + (size_t)l * 128 * 512, 128, 512, (bf16_t*)(p.ws + OFF_WUKV) + (size_t)l * 512 * 128, p.mla_kv_norm + l * 128, 0, 128, t / 8, t % 8, tile); return; }
    t -= 16;
    if (t < 16) { tr_tile(p.s5_w_glu + (size_t)l * 256 * 256, 256, 256, (bf16_t*)(p.ws + OFF_WGLU) + (size_t)l * 256 * 256, nullptr, 0, 0, t / 4, t % 4, tile); return; }
    t -= 16;
    if (t < 256) { tr_tile(p.w_out + (size_t)l * 1024 * 1024, 1024, 1024, (bf16_t*)(p.ws + OFF_WOUT) + (size_t)l * 1024 * 1024, p.ssd_norm + l * 256, 512, 768, t / 16, t % 16, tile); return; }
    t -= 256;
    if (t < 1408) { tr_tile(p.ffn_w_up + (size_t)l * 1024 * 5632, 1024, 5632, (bf16_t*)(p.ws + OFF_WUP) + (size_t)l * 5632 * 1024, nullptr, 0, 0, t / 88, t % 88, tile); return; }
    t -= 1408;
    tr_tile(p.ffn_w_down + (size_t)l * 2816 * 1024, 2816, 1024, (bf16_t*)(p.ws + OFF_WDN) + (size_t)l * 1024 * 2816, nullptr, 0, 0, t / 16, t % 16, tile);
    return;
  }
  item -= P0_TR;
  if (item < P0_MOD) {
    const int l = item / 96, cb = item % 96, cl = tid & 63, kq = tid >> 6;
    float* sv = (float*)smem;
    float* red = sv + 3072;
    for (int i = tid; i < 1024; i += 256) { sv[i] = silu_f(p.c[i]); sv[1024 + i] = silu_f(p.c[1024 + i]); sv[2048 + i] = silu_f(p.c_ctx[i]); }
    __syncthreads();
    const int col = cb * 64 + cl; const float* W = p.w_mod + (size_t)l * 1024 * 6144 + col;
    float a0 = 0.f, a1 = 0.f, a2 = 0.f;
#pragma unroll 8
    for (int k = kq * 256; k < kq * 256 + 256; ++k) { const float w = W[(size_t)k * 6144]; a0 += sv[k] * w; a1 += sv[1024 + k] * w; a2 += sv[2048 + k] * w; }
    red[(kq * 3 + 0) * 64 + cl] = a0; red[(kq * 3 + 1) * 64 + cl] = a1; red[(kq * 3 + 2) * 64 + cl] = a2;
    __syncthreads();
    if (tid < 192) {
      const int s = tid >> 6; const float bm = p.b_mod[l * 6144 + col];
      const float v = red[(0 * 3 + s) * 64 + cl] + red[(1 * 3 + s) * 64 + cl] + red[(2 * 3 + s) * 64 + cl] + red[(3 * 3 + s) * 64 + cl] + bm;
      ((float*)(p.ws + OFF_MOD))[(size_t)(l * 3 + s) * 6144 + col] = v;
    }
    __syncthreads();
    return;
  }
  item -= P0_MOD;
  if (item >= P0_CPX + P0_CPC) {
    item -= P0_CPX + P0_CPC;
    char* z = p.ws + OFF_HY + (size_t)item * 65536;
    const size_t lim = WS_NEED - OFF_HY - (size_t)item * 65536;
    for (int i = 0; i < 16; ++i) { const size_t o = (size_t)(i * 256 + tid) * 16; if (o < lim) *(u32x4*)(z + o) = (u32x4){0u, 0u, 0u, 0u}; }
    return;
  }
  const float* src; float* dst;
  if (item < P0_CPX) { src = p.x + (size_t)item * 4096; dst = p.xb + (size_t)item * 4096; }
  else { item -= P0_CPX; src = p.ctx + (size_t)item * 4096; dst = (float*)(p.ws + OFF_CTX) + (size_t)item * 4096; }
  for (int i = 0; i < 4; ++i) { const int o = (i * 256 + tid) * 4; *(float4*)(dst + o) = *(const float4*)(src + o); }
}

DI void norm_item(const Params& p, int l, int which, int item) {
  const int lane = ltid() & 63, w = __builtin_amdgcn_readfirstlane(ltid() >> 6), row = item * 4 + w;
  const float* x = row < NLAT ? p.xb + (size_t)row * 1024 : (const float*)(p.ws + OFF_CTX) + (size_t)(row - NLAT) * 1024;
  float4 v[4]; float ss = 0.f;
#pragma unroll
  for (int i = 0; i < 4; ++i) { v[i] = *(const float4*)(x + (i * 64 + lane) * 4); ss += v[i].x * v[i].x + v[i].y * v[i].y + v[i].z * v[i].z + v[i].w * v[i].w; }
  ss = wave_sum(ss);
  const float rstd = rsqrtf(ss * (1.f / 1024.f) + 1e-6f);
  const int s = row < NLAT ? row / T : 2;
  const float* g = (which ? p.norm2 : p.norm1) + l * 1024;
  const float* md = (const float*)(p.ws + OFF_MOD) + (size_t)(l * 3 + s) * 6144 + (which ? 3072 : 0);
  bf16_t* H = (bf16_t*)(p.ws + OFF_HY) + (size_t)row * 1024;
#pragma unroll
  for (int i = 0; i < 4; ++i) {
    const int k = (i * 64 + lane) * 4;
    const float4 g4 = *(const float4*)(g + k), sh = *(const float4*)(md + k), sc = *(const float4*)(md + 1024 + k);
    u32x2 o; o.x = pack2(v[i].x * rstd * g4.x * (1.f + sc.x) + sh.x, v[i].y * rstd * g4.y * (1.f + sc.y) + sh.y);
    o.y = pack2(v[i].z * rstd * g4.z * (1.f + sc.z) + sh.z, v[i].w * rstd * g4.w * (1.f + sc.w) + sh.w);
    *(u32x2*)(H + k) = o;
  }
}

template <int AMODE, class Epi>
DI void gemm_tile(const bf16_t* __restrict__ A, int lda, const bf16_t* __restrict__ Bt, int ldb, int K, int m0, int n0, char* smem, const float* ssq, Epi epi) {
  bf16_t* As = (bf16_t*)smem; bf16_t* Bs = As + 128 * 72;
  const int tid = ltid(), lane = tid & 63, w = __builtin_amdgcn_readfirstlane(tid >> 6), wm = w >> 1, wn = w & 1, l15 = lane & 15, g4 = lane >> 4;
  u32x4 ar[4], br[4]; float rs[4];
  const int r0 = tid >> 3, cc = tid & 7;
  const bf16_t* ap = A + (size_t)(m0 + r0) * lda + cc * 8;
  const bf16_t* bp = Bt + (size_t)(n0 + r0) * ldb + cc * 8;
  const size_t astep = (size_t)32 * lda, bstep = (size_t)32 * ldb;
  if (AMODE == 1) {
#pragma unroll
    for (int i = 0; i < 4; ++i) { const float* q = ssq + (m0 + r0 + 32 * i); rs[i] = rsqrtf((q[0] + q[NROW] + q[2 * NROW] + q[3 * NROW]) * (1.f / 256.f) + 1e-6f); }
  }
  f32x4 acc[4][4];
#pragma unroll
  for (int i = 0; i < 4; ++i)
#pragma unroll
    for (int j = 0; j < 4; ++j) acc[i][j] = (f32x4){0.f, 0.f, 0.f, 0.f};
#pragma unroll
  for (int i = 0; i < 4; ++i) { ar[i] = *(const u32x4*)(ap + i * astep); br[i] = *(const u32x4*)(bp + i * bstep); }
  const int nk = K >> 6;
  for (int kt = 0; kt < nk; ++kt) {
    if (AMODE == 1 && kt >= 8 && kt < 12) {
#pragma unroll
      for (int i = 0; i < 4; ++i) {
        const float s = rs[i]; u32x4 q = ar[i];
        q.x = pack2(bflo(q.x) * s, bfhi(q.x) * s); q.y = pack2(bflo(q.y) * s, bfhi(q.y) * s);
        q.z = pack2(bflo(q.z) * s, bfhi(q.z) * s); q.w = pack2(bflo(q.w) * s, bfhi(q.w) * s); ar[i] = q;
      }
    }
#pragma unroll
    for (int i = 0; i < 4; ++i) { *(u32x4*)(As + (r0 + 32 * i) * 72 + cc * 8) = ar[i]; *(u32x4*)(Bs + (r0 + 32 * i) * 72 + cc * 8) = br[i]; }
    __syncthreads();
    if (kt + 1 < nk) {
#pragma unroll
      for (int i = 0; i < 4; ++i) { ar[i] = *(const u32x4*)(ap + i * astep + (kt + 1) * 64); br[i] = *(const u32x4*)(bp + i * bstep + (kt + 1) * 64); }
    }
#pragma unroll
    for (int ks = 0; ks < 2; ++ks) {
      bf16x8 af[4], bfr[4];
#pragma unroll
      for (int i = 0; i < 4; ++i) { af[i] = ld_frag(As + (64 * wm + 16 * i + l15) * 72 + ks * 32 + g4 * 8); bfr[i] = ld_frag(Bs + (64 * wn + 16 * i + l15) * 72 + ks * 32 + g4 * 8); }
#pragma unroll
      for (int i = 0; i < 4; ++i)
#pragma unroll
        for (int j = 0; j < 4; ++j) acc[i][j] = MFMA16(bfr[j], af[i], acc[i][j]);
    }
    __syncthreads();
  }
#pragma unroll
  for (int i = 0; i < 4; ++i)
#pragma unroll
    for (int j = 0; j < 4; ++j) epi(m0 + 64 * wm + 16 * i + l15, n0 + 64 * wn + 16 * j + 4 * g4, acc[i][j]);
}

DI void store_bf4(bf16_t* dst, f32x4 v) { u32x2 o; o.x = pack2(v[0], v[1]); o.y = pack2(v[2], v[3]); *(u32x2*)dst = o; }

DI void gemm_in_item(const Params& p, int l, int item, char* smem) {
  const int mt = item / 22, nt = item % 22;
  bf16_t* P = (bf16_t*)(p.ws + OFF_P); float* GML = (float*)(p.ws + OFF_GML); float* DTR = (float*)(p.ws + OFF_DTR);
  gemm_tile<0>((const bf16_t*)(p.ws + OFF_HY), 1024, (const bf16_t*)(p.ws + OFF_WIN) + (size_t)l * 2816 * 1024, 1024, 1024, mt * 128, nt * 128, smem, nullptr,
               [&](int row, int col, f32x4 v) {
                 store_bf4(P + (size_t)row * PINP + col, v);
                 if (col >= 1024 && col < 1040) *(f32x4*)(GML + (size_t)row * 16 + (col - 1024)) = v;
                 if (col >= 2480 && col < 2488) *(f32x4*)(DTR + (size_t)row * 8 + (col - 2480)) = v;
               });
}

DI void tile_rstd(const bf16_t* P, int m0, int col0, int ncols, float* rst) {
  const int tid = ltid(), r = tid >> 1, hf = tid & 1, n = ncols >> 1;
  const bf16_t* src = P + (size_t)(m0 + r) * PINP + col0 + hf * n;
  float ss = 0.f;
  for (int c = 0; c < n; c += 8) { const u32x4 q = *(const u32x4*)(src + c);
    ss += bflo(q.x) * bflo(q.x) + bfhi(q.x) * bfhi(q.x) + bflo(q.y) * bflo(q.y) + bfhi(q.y) * bfhi(q.y) + bflo(q.z) * bflo(q.z) + bfhi(q.z) * bfhi(q.z) + bflo(q.w) * bflo(q.w) + bfhi(q.w) * bfhi(q.w); }
  ss += __shfl_xor(ss, 1);
  if (hf == 0) rst[r] = rsqrtf(ss / (float)ncols + 1e-6f);
  __syncthreads();
}
DI void qproj_item(const Params& p, int l, int item, char* smem) {
  const int mt = item / 3, nt = item % 3; const bf16_t* P = (const bf16_t*)(p.ws + OFF_P);
  float* rst = (float*)(smem + 36864);
  tile_rstd(P, mt * 128, C_CQ, 256, rst);
  bf16_t* Q = (bf16_t*)(p.ws + OFF_QRAW);
  gemm_tile<0>(P + C_CQ, PINP, (const bf16_t*)(p.ws + OFF_WUQ) + (size_t)l * 384 * 256, 256, 256, mt * 128, nt * 128, smem, nullptr,
               [&](int row, int col, f32x4 v) { const float r = rst[row - mt * 128]; store_bf4(Q + (size_t)row * 384 + col, v * r); });
  __syncthreads();
}
DI void kvproj_item(const Params& p, int l, int item, char* smem) {
  const int mt = item / 4, nt = item % 4; const bf16_t* P = (const bf16_t*)(p.ws + OFF_P);
  float* rst = (float*)(smem + 36864);
  tile_rstd(P, mt * 128, C_CKV, 128, rst);
  bf16_t* KH = (bf16_t*)(p.ws + OFF_KH); bf16_t* VT = (bf16_t*)(p.ws + OFF_VT);
  gemm_tile<0>(P + C_CKV, PINP, (const bf16_t*)(p.ws + OFF_WUKV) + (size_t)l * 512 * 128, 128, 128, mt * 128, nt * 128, smem, nullptr,
               [&](int row, int col, f32x4 v) {
                 const float r = rst[row - mt * 128]; v = v * r;
                 const int hh = col >> 7, dd = col & 127;
                 int b, tpos; if (row < NLAT) { b = row / T; tpos = row % T; } else { b = (row - NLAT) / TC; tpos = T + (row - NLAT) % TC; }
                 if (dd < 64) store_bf4(KH + ((size_t)(b * 4 + hh) * TALL + tpos) * 64 + dd, v);
                 else {
                   bf16_t* vp = VT + ((size_t)(b * 4 + hh) * 64 + (dd - 64)) * TALL + tpos;
                   vp[0] = f2bf(v[0]); vp[TALL] = f2bf(v[1]); vp[2 * TALL] = f2bf(v[2]); vp[3 * TALL] = f2bf(v[3]);
                 }
               });
  __syncthreads();
}
DI void rope_cs(int t, int i, float& cs, float& sn) {
  const int pos = (i < 8) ? (t >> 6) : (t & 63); const int f = i & 7;
  const float inv = exp2f(-(float)f * (13.287712379549449f / 8.f));
  const float ang = (float)pos * inv;
  cs = cosf(ang); sn = sinf(ang);
}
DI void ropek_item(const Params& p, int item) {
  const int row = item * 256 + ltid();
  const bf16_t* src = (const bf16_t*)(p.ws + OFF_P) + (size_t)row * PINP + C_KR;
  u32x4 q[4];
#pragma unroll
  for (int i = 0; i < 4; ++i) q[i] = *(const u32x4*)(src + i * 8);
  float v[32];
#pragma unroll
  for (int i = 0; i < 4; ++i) { v[i * 8 + 0] = bflo(q[i].x); v[i * 8 + 1] = bfhi(q[i].x); v[i * 8 + 2] = bflo(q[i].y); v[i * 8 + 3] = bfhi(q[i].y);
    v[i * 8 + 4] = bflo(q[i].z); v[i * 8 + 5] = bfhi(q[i].z); v[i * 8 + 6] = bflo(q[i].w); v[i * 8 + 7] = bfhi(q[i].w); }
  int b, tpos;
  if (row < NLAT) {
    b = row / T; tpos = row % T;
#pragma unroll
    for (int i = 0; i < 16; ++i) { float cs, sn; rope_cs(tpos, i, cs, sn); const float x1 = v[i], x2 = v[i + 16]; v[i] = x1 * cs - x2 * sn; v[i + 16] = x1 * sn + x2 * cs; }
  } else { b = (row - NLAT) / TC; tpos = T + (row - NLAT) % TC; }
  u32x4 o[4];
#pragma unroll
  for (int i = 0; i < 4; ++i) { o[i].x = pack2(v[i * 8], v[i * 8 + 1]); o[i].y = pack2(v[i * 8 + 2], v[i * 8 + 3]); o[i].z = pack2(v[i * 8 + 4], v[i * 8 + 5]); o[i].w = pack2(v[i * 8 + 6], v[i * 8 + 7]); }
  bf16_t* dst = (bf16_t*)(p.ws + OFF_KR) + ((size_t)b * TALL + tpos) * 32;
#pragma unroll
  for (int i = 0; i < 4; ++i) *(u32x4*)(dst + i * 8) = o[i];
}

DI void attn_item(const Params& p, int item, char* smem) {
  const int tid = ltid(), lane = tid & 63, w = __builtin_amdgcn_readfirstlane(tid >> 6), l15 = lane & 15, g4 = lane >> 4;
  int b, h, qt, latent;
  if (item < 512) { latent = 1; qt = item & 63; h = (item >> 6) & 3; b = item >> 8; }
  else { latent = 0; const int i2 = item - 512; qt = i2 & 1; h = (i2 >> 1) & 3; b = i2 >> 3; }
  const int qrow0 = latent ? b * T + qt * 128 : NLAT + b * TC + qt * 128;
  bf16_t* Qs = (bf16_t*)smem;
  bf16_t* Ks = (bf16_t*)smem;
  bf16_t* Vs = Ks + 64 * 104;
  const bf16_t* Qraw = (const bf16_t*)(p.ws + OFF_QRAW);
  const float qscale = 0.10206207261596577f * 1.4426950408889634f;
  for (int id = tid; id < 1280; id += 256) {
    const int r = id / 10, cc = id % 10;
    const bf16_t* src = Qraw + (size_t)(qrow0 + r) * 384 + h * 96 + cc * 8;
    const u32x4 q = *(const u32x4*)src;
    float a[8] = {bflo(q.x), bfhi(q.x), bflo(q.y), bfhi(q.y), bflo(q.z), bfhi(q.z), bflo(q.w), bfhi(q.w)};
    if (cc < 8) {
      u32x4 o; o.x = pack2(a[0] * qscale, a[1] * qscale); o.y = pack2(a[2] * qscale, a[3] * qscale); o.z = pack2(a[4] * qscale, a[5] * qscale); o.w = pack2(a[6] * qscale, a[7] * qscale);
      *(u32x4*)(Qs + r * 104 + cc * 8) = o;
    } else {
      const u32x4 q2 = *(const u32x4*)(src + 16);
      float c2[8] = {bflo(q2.x), bfhi(q2.x), bflo(q2.y), bfhi(q2.y), bflo(q2.z), bfhi(q2.z), bflo(q2.w), bfhi(q2.w)};
      float o1[8], o2[8];
#pragma unroll
      for (int j = 0; j < 8; ++j) {
        float cs = 1.f, sn = 0.f;
        if (latent) rope_cs(qt * 128 + r, (cc - 8) * 8 + j, cs, sn);
        o1[j] = (a[j] * cs - c2[j] * sn) * qscale; o2[j] = (a[j] * sn + c2[j] * cs) * qscale;
      }
      u32x4 o; o.x = pack2(o1[0], o1[1]); o.y = pack2(o1[2], o1[3]); o.z = pack2(o1[4], o1[5]); o.w = pack2(o1[6], o1[7]);
      *(u32x4*)(Qs + r * 104 + cc * 8) = o;
      o.x = pack2(o2[0], o2[1]); o.y = pack2(o2[2], o2[3]); o.z = pack2(o2[4], o2[5]); o.w = pack2(o2[6], o2[7]);
      *(u32x4*)(Qs + r * 104 + cc * 8 + 16) = o;
    }
  }
  __syncthreads();
  bf16x8 qf[2][3];
#pragma unroll
  for (int qs = 0; qs < 2; ++qs)
#pragma unroll
    for (int ks = 0; ks < 3; ++ks) qf[qs][ks] = ld_frag(Qs + (32 * w + 16 * qs + l15) * 104 + ks * 32 + g4 * 8);
  __syncthreads();
  const int kt0 = latent ? 0 : 128, kt1 = 132;
  const bf16_t* Kg = (const bf16_t*)(p.ws + OFF_KH) + (size_t)(b * 4 + h) * TALL * 64;
  const bf16_t* Rg = (const bf16_t*)(p.ws + OFF_KR) + (size_t)b * TALL * 32;
  const bf16_t* Vg = (const bf16_t*)(p.ws + OFF_VT) + (size_t)(b * 4 + h) * 64 * TALL;
  u32x4 kr[3], vr[2];
  const int ve0 = tid >> 3, vc = tid & 7;
  {
    kr[0] = *(const u32x4*)(Kg + (size_t)kt0 * 4096 + tid * 8); kr[1] = *(const u32x4*)(Kg + (size_t)kt0 * 4096 + (tid + 256) * 8);
    kr[2] = *(const u32x4*)(Rg + (size_t)kt0 * 2048 + tid * 8);
#pragma unroll
    for (int i = 0; i < 2; ++i) vr[i] = *(const u32x4*)(Vg + (size_t)(ve0 + 32 * i) * TALL + kt0 * 64 + vc * 8);
  }
  float mrun[2] = {-1e30f, -1e30f}, lsum[2] = {0.f, 0.f};
  f32x4 O[4][2];
#pragma unroll
  for (int es = 0; es < 4; ++es)
#pragma unroll
    for (int qs = 0; qs < 2; ++qs) O[es][qs] = (f32x4){0.f, 0.f, 0.f, 0.f};
  for (int kt = kt0; kt < kt1; ++kt) {
    __syncthreads();
#pragma unroll
    for (int i = 0; i < 2; ++i) { const int id = tid + 256 * i; *(u32x4*)(Ks + (id >> 3) * 104 + (id & 7) * 8) = kr[i]; }
    *(u32x4*)(Ks + (tid >> 2) * 104 + 64 + (tid & 3) * 8) = kr[2];
#pragma unroll
    for (int i = 0; i < 2; ++i) *(u32x4*)(Vs + (ve0 + 32 * i) * 72 + vc * 8) = vr[i];
    __syncthreads();
    if (kt + 1 < kt1) {
      kr[0] = *(const u32x4*)(Kg + (size_t)(kt + 1) * 4096 + tid * 8); kr[1] = *(const u32x4*)(Kg + (size_t)(kt + 1) * 4096 + (tid + 256) * 8);
      kr[2] = *(const u32x4*)(Rg + (size_t)(kt + 1) * 2048 + tid * 8);
#pragma unroll
      for (int i = 0; i < 2; ++i) vr[i] = *(const u32x4*)(Vg + (size_t)(ve0 + 32 * i) * TALL + (kt + 1) * 64 + vc * 8);
    }
    f32x4 sa[4][2];
#pragma unroll
    for (int kb = 0; kb < 4; ++kb)
#pragma unroll
      for (int qs = 0; qs < 2; ++qs) sa[kb][qs] = (f32x4){0.f, 0.f, 0.f, 0.f};
#pragma unroll
    for (int ks = 0; ks < 3; ++ks)
#pragma unroll
      for (int kb = 0; kb < 4; ++kb) {
        const bf16x8 a = ld_frag(Ks + (16 * kb + l15) * 104 + ks * 32 + g4 * 8);
#pragma unroll
        for (int qs = 0; qs < 2; ++qs) sa[kb][qs] = MFMA16(a, qf[qs][ks], sa[kb][qs]);
      }
    bf16x8 pf[2][2];
#pragma unroll
    for (int qs = 0; qs < 2; ++qs) {
      float mx = -1e30f;
#pragma unroll
      for (int kb = 0; kb < 4; ++kb)
#pragma unroll
        for (int j = 0; j < 4; ++j) mx = fmaxf(mx, sa[kb][qs][j]);
      mx = fmaxf(mx, __shfl_xor(mx, 16)); mx = fmaxf(mx, __shfl_xor(mx, 32));
      const float mnew = fmaxf(mrun[qs], mx), alpha = exp2f(mrun[qs] - mnew);
      mrun[qs] = mnew;
      float ps = 0.f;
#pragma unroll
      for (int kb = 0; kb < 4; ++kb)
#pragma unroll
        for (int j = 0; j < 4; ++j) { const float e = exp2f(sa[kb][qs][j] - mnew); sa[kb][qs][j] = e; ps += e; }
      lsum[qs] = lsum[qs] * alpha + ps;
#pragma unroll
      for (int es = 0; es < 4; ++es) O[es][qs] = O[es][qs] * alpha;
#pragma unroll
      for (int k2 = 0; k2 < 2; ++k2)
        pf[qs][k2] = mk_frag(pack2(sa[2 * k2][qs][0], sa[2 * k2][qs][1]), pack2(sa[2 * k2][qs][2], sa[2 * k2][qs][3]),
                             pack2(sa[2 * k2 + 1][qs][0], sa[2 * k2 + 1][qs][1]), pack2(sa[2 * k2 + 1][qs][2], sa[2 * k2 + 1][qs][3]));
    }
#pragma unroll
    for (int k2 = 0; k2 < 2; ++k2)
#pragma unroll
      for (int es = 0; es < 4; ++es) {
        const bf16_t* vp = Vs + (16 * es + l15) * 72 + 32 * k2 + 4 * g4;
        const u32x2 lo = *(const u32x2*)vp, hi = *(const u32x2*)(vp + 16);
        const bf16x8 a = mk_frag(lo.x, lo.y, hi.x, hi.y);
#pragma unroll
        for (int qs = 0; qs < 2; ++qs) O[es][qs] = MFMA16(a, pf[qs][k2], O[es][qs]);
      }
  }
  bf16_t* Y = (bf16_t*)(p.ws + OFF_HY);
#pragma unroll
  for (int qs = 0; qs < 2; ++qs) {
    float l = lsum[qs]; l += __shfl_xor(l, 16); l += __shfl_xor(l, 32);
    const float inv = 1.f / l;
    const int row = qrow0 + 32 * w + 16 * qs + l15;
#pragma unroll
    for (int es = 0; es < 4; ++es) store_bf4(Y + (size_t)row * 1024 + 256 + h * 64 + 16 * es + 4 * g4, O[es][qs] * inv);
  }
  __syncthreads();
}

DI void chunk_geom(int tcg, int b, int& part, int& tc, int& row0) { part = tcg >= 128; tc = part ? tcg - 128 : tcg; row0 = row_of(b, part, tc * 64); }
DI int chain_slot(int dir, int part, int tc) { return dir ? (part ? 3 - tc : 131 - tc) : (part ? tc : 4 + tc); }

DI void mlstm_p1(const Params& p, int l, int item, char* smem) {
  const int tid = ltid(), lane = tid & 63, w = __builtin_amdgcn_readfirstlane(tid >> 6), l15 = lane & 15, g4 = lane >> 4;
  const int tcg = item % NCH; int r = item / NCH; const int dir = r & 1; r >>= 1; const int h = r & 3, b = r >> 2;
  int part, tc, row0; chunk_geom(tcg, b, part, tc, row0);
  const int c = chain_slot(dir, part, tc), chain = (b * 4 + h) * 2 + dir;
  bf16_t* A = (bf16_t*)smem;
  bf16_t* Bk = A + 80 * 72;
  float* fs = (float*)(Bk + 64 * 72);
  const bf16_t* P = (const bf16_t*)(p.ws + OFF_P); const float* GML = (const float*)(p.ws + OFF_GML);
  float* MLM = (float*)(p.ws + OFF_MLM) + (size_t)(chain * NCH + c) * 32;
  if (tid < 64) {
    const int gi = 2 * dir;
    const float ig = GML[(size_t)(row0 + tid) * 16 + gi * 4 + h] + p.ml_gate_bias[l * 16 + gi * 4 + h];
    const float fg = GML[(size_t)(row0 + tid) * 16 + (gi + 1) * 4 + h] + p.ml_gate_bias[l * 16 + (gi + 1) * 4 + h];
    const float lf = logsigm_f(fg);
    const float pre = wave_incl_scan(lf, lane), tot = __shfl(pre, 63);
    const float bc = dir ? tot - pre + lf : pre;
    const float wlog = tot - bc + ig, mloc = wave_max(wlog), wv = __expf(wlog - mloc);
    fs[tid] = wv; A[64 * 72 + tid] = f2bf(wv);
    if (tid == 0) { MLM[0] = mloc; MLM[1] = tot; }
  }
  for (int i = tid; i < 15 * 72; i += 256) A[65 * 72 + i] = 0;
  __syncthreads();
  {
    const int s = tid >> 2, d0 = (tid & 3) * 16; const float wv = fs[s];
    const bf16_t* kp = P + (size_t)(row0 + s) * PINP + C_MLK + h * 64 + d0;
    const bf16_t* vp = P + (size_t)(row0 + s) * PINP + C_MLV + h * 64 + d0;
#pragma unroll
    for (int hf = 0; hf < 2; ++hf) {
      const u32x4 kq = *(const u32x4*)(kp + hf * 8), vq = *(const u32x4*)(vp + hf * 8);
      const float kk[8] = {bflo(kq.x), bfhi(kq.x), bflo(kq.y), bfhi(kq.y), bflo(kq.z), bfhi(kq.z), bflo(kq.w), bfhi(kq.w)};
      const float vv[8] = {bflo(vq.x), bfhi(vq.x), bflo(vq.y), bfhi(vq.y), bflo(vq.z), bfhi(vq.z), bflo(vq.w), bfhi(vq.w)};
#pragma unroll
      for (int j = 0; j < 8; ++j) { Bk[(d0 + hf * 8 + j) * 72 + s] = f2bf(kk[j] * 0.125f); A[(d0 + hf * 8 + j) * 72 + s] = f2bf(vv[j] * wv); }
    }
  }
  __syncthreads();
  float* MLS = (float*)(p.ws + OFF_MLS) + (size_t)(chain * NCH + c) * 4160;
  for (int t = w; t < 20; t += 4) {
    const int ms = t >> 2, ns = t & 3;
    f32x4 acc = {0.f, 0.f, 0.f, 0.f};
#pragma unroll
    for (int ks = 0; ks < 2; ++ks) acc = MFMA16(ld_frag(A + (16 * ms + l15) * 72 + ks * 32 + g4 * 8), ld_frag(Bk + (16 * ns + l15) * 72 + ks * 32 + g4 * 8), acc);
#pragma unroll
    for (int j = 0; j < 4; ++j) { const int e = 16 * ms + 4 * g4 + j; if (e <= 64) MLS[e * 64 + 16 * ns + l15] = acc[j]; }
  }
  __syncthreads();
}
DI void mlstm_p2(const Params& p, int item) {
  const int gi = item * 256 + ltid(), chain = gi / 4160, e = gi % 4160;
  float* MLS = (float*)(p.ws + OFF_MLS) + (size_t)chain * NCH * 4160 + e;
  float* MLM = (float*)(p.ws + OFF_MLM) + (size_t)chain * NCH * 32;
  float C = 0.f, m = 0.f;
  for (int c0 = 0; c0 < NCH; c0 += 12) {
    float d[12], ml[12], bl[12];
#pragma unroll
    for (int i = 0; i < 12; ++i) { d[i] = MLS[(size_t)(c0 + i) * 4160]; ml[i] = MLM[(c0 + i) * 32]; bl[i] = MLM[(c0 + i) * 32 + 1]; }
#pragma unroll
    for (int i = 0; i < 12; ++i) {
      MLS[(size_t)(c0 + i) * 4160] = C; if (e == 0) MLM[(c0 + i) * 32 + 16] = m;
      const float mn = fmaxf(bl[i] + m, ml[i]);
      C = __expf(bl[i] + m - mn) * C + __expf(ml[i] - mn) * d[i]; m = mn;
    }
  }
}
DI void mlstm_p3(const Params& p, int l, int item, char* smem) {
  const int tid = ltid(), lane = tid & 63, w = __builtin_amdgcn_readfirstlane(tid >> 6), l15 = lane & 15, g4 = lane >> 4;
  const int h = item & 3; const int r = item >> 2; const int tcg = r % NCH, b = r / NCH;
  int part, tc, row0; chunk_geom(tcg, b, part, tc, row0);
  bf16_t* Qs = (bf16_t*)smem;
  bf16_t* Ks = Qs + 64 * 72;
  bf16_t* Vt = Ks + 64 * 72;
  bf16_t* Sb = Vt + 64 * 72;
  float* fb = (float*)(Sb + 64 * 72);
  float* fi = fb + 64;
  const bf16_t* P = (const bf16_t*)(p.ws + OFF_P); const float* GML = (const float*)(p.ws + OFF_GML);
  {
    const int s = tid >> 2, d0 = (tid & 3) * 16;
    const bf16_t* base = P + (size_t)(row0 + s) * PINP + h * 64 + d0;
#pragma unroll
    for (int hf = 0; hf < 2; ++hf) {
      *(u32x4*)(Qs + s * 72 + d0 + hf * 8) = *(const u32x4*)(base + C_MLQ + hf * 8);
      const u32x4 kq = *(const u32x4*)(base + C_MLK + hf * 8), vq = *(const u32x4*)(base + C_MLV + hf * 8);
      u32x4 ko; ko.x = pack2(bflo(kq.x) * 0.125f, bfhi(kq.x) * 0.125f); ko.y = pack2(bflo(kq.y) * 0.125f, bfhi(kq.y) * 0.125f);
      ko.z = pack2(bflo(kq.z) * 0.125f, bfhi(kq.z) * 0.125f); ko.w = pack2(bflo(kq.w) * 0.125f, bfhi(kq.w) * 0.125f);
      *(u32x4*)(Ks + s * 72 + d0 + hf * 8) = ko;
      const unsigned vw[4] = {vq.x, vq.y, vq.z, vq.w};
#pragma unroll
      for (int j = 0; j < 4; ++j) { Vt[(d0 + hf * 8 + 2 * j) * 72 + s] = (bf16_t)(vw[j] & 0xffffu); Vt[(d0 + hf * 8 + 2 * j + 1) * 72 + s] = (bf16_t)(vw[j] >> 16); }
    }
  }
  f32x4 hs[4];
#pragma unroll
  for (int ns = 0; ns < 4; ++ns) hs[ns] = (f32x4){0.f, 0.f, 0.f, 0.f};
#pragma unroll 1
  for (int dir = 0; dir < 2; ++dir) {
    const int c = chain_slot(dir, part, tc), chain = (b * 4 + h) * 2 + dir;
    const float m_in = ((const float*)(p.ws + OFF_MLM))[(size_t)(chain * NCH + c) * 32 + 16];
    const float* Cst = (const float*)(p.ws + OFF_MLS) + (size_t)(chain * NCH + c) * 4160;
    __syncthreads();
    if (tid < 64) {
      const int gi = 2 * dir;
      const float ig = GML[(size_t)(row0 + tid) * 16 + gi * 4 + h] + p.ml_gate_bias[l * 16 + gi * 4 + h];
      const float fg = GML[(size_t)(row0 + tid) * 16 + (gi + 1) * 4 + h] + p.ml_gate_bias[l * 16 + (gi + 1) * 4 + h];
      const float lf = logsigm_f(fg);
      const float pre = wave_incl_scan(lf, lane), tot = __shfl(pre, 63);
      fb[tid] = dir ? tot - pre + lf : pre; fi[tid] = ig;
    }
    __syncthreads();
    f32x4 sc[4];
#pragma unroll
    for (int ns = 0; ns < 4; ++ns) {
      f32x4 a = {0.f, 0.f, 0.f, 0.f};
#pragma unroll
      for (int ks = 0; ks < 2; ++ks) a = MFMA16(ld_frag(Qs + (16 * w + l15) * 72 + ks * 32 + g4 * 8), ld_frag(Ks + (16 * ns + l15) * 72 + ks * 32 + g4 * 8), a);
      sc[ns] = a;
    }
    float bi[4], mt[4], rsum[4];
#pragma unroll
    for (int j = 0; j < 4; ++j) {
      const int i = 16 * w + 4 * g4 + j; bi[j] = fb[i];
      float mx = -1e30f;
#pragma unroll
      for (int ns = 0; ns < 4; ++ns) { const int s = 16 * ns + l15; const bool ok = dir ? (s >= i) : (s <= i); const float dm = bi[j] - fb[s] + fi[s]; if (ok) mx = fmaxf(mx, dm); }
      mx = red16_max(mx);
      mt[j] = fmaxf(bi[j] + m_in, mx);
      float rs = 0.f;
#pragma unroll
      for (int ns = 0; ns < 4; ++ns) {
        const int s = 16 * ns + l15; const bool ok = dir ? (s >= i) : (s <= i);
        const float v = ok ? sc[ns][j] * __expf(bi[j] - fb[s] + fi[s] - mt[j]) : 0.f;
        rs += v; Sb[i * 72 + s] = f2bf(v);
      }
      rsum[j] = red16_sum(rs);
    }
    __syncthreads();
    f32x4 qc[5];
#pragma unroll
    for (int ns = 0; ns < 5; ++ns) {
      f32x4 a = {0.f, 0.f, 0.f, 0.f};
      const int e = 16 * ns + l15;
#pragma unroll
      for (int ks = 0; ks < 2; ++ks) {
        bf16x8 bfm;
        if (e <= 64) bfm = frag_from_f32(Cst + e * 64 + ks * 32 + g4 * 8, 1.f); else bfm = mk_frag(0u, 0u, 0u, 0u);
        a = MFMA16(ld_frag(Qs + (16 * w + l15) * 72 + ks * 32 + g4 * 8), bfm, a);
      }
      qc[ns] = a;
    }
    f32x4 nm[4];
#pragma unroll
    for (int ns = 0; ns < 4; ++ns) {
      f32x4 a = {0.f, 0.f, 0.f, 0.f};
#pragma unroll
      for (int ks = 0; ks < 2; ++ks) a = MFMA16(ld_frag(Sb + (16 * w + l15) * 72 + ks * 32 + g4 * 8), ld_frag(Vt + (16 * ns + l15) * 72 + ks * 32 + g4 * 8), a);
      nm[ns] = a;
    }
#pragma unroll
    for (int j = 0; j < 4; ++j) {
      const float wi = __expf(bi[j] + m_in - mt[j]);
      const float qn = __shfl(qc[4][j], lane & 48);
      const float den = rsum[j] + wi * qn;
      const float dd = 1.f / fmaxf(fabsf(den), __expf(-mt[j]));
#pragma unroll
      for (int ns = 0; ns < 4; ++ns) hs[ns][j] += (nm[ns][j] + wi * qc[ns][j]) * dd;
    }
  }
  bf16_t* Y = (bf16_t*)(p.ws + OFF_HY);
#pragma unroll
  for (int j = 0; j < 4; ++j) {
    float ss = 0.f;
#pragma unroll
    for (int ns = 0; ns < 4; ++ns) ss += hs[ns][j] * hs[ns][j];
    ss = red16_sum(ss);
    const float rstd = rsqrtf(ss * (1.f / 64.f) + 1e-6f);
    const int row = row0 + 16 * w + 4 * g4 + j;
#pragma unroll
    for (int ns = 0; ns < 4; ++ns) {
      const int ch = h * 64 + 16 * ns + l15;
      const float o = bf2f(P[(size_t)row * PINP + C_MLO + ch]);
      Y[(size_t)row * 1024 + ch] = f2bf(hs[ns][j] * rstd * p.ml_norm[l * 256 + ch] * sigm_f(o));
    }
  }
  __syncthreads();
}

DI void conv_silu8(const Params& p, int l, const bf16_t* P, int row, bool hp, bool hn, int ch, float* out) {
  const bf16_t* src = P + (size_t)row * PINP + C_XBC + ch;
  const u32x4 z = {0u, 0u, 0u, 0u};
  const u32x4 c0 = *(const u32x4*)src, pm = hp ? *(const u32x4*)(src - PINP) : z, nx = hn ? *(const u32x4*)(src + PINP) : z;
  const float* cw = p.ssd_conv_w + (size_t)l * 3 * 768 + ch; const float* cb = p.ssd_conv_b + l * 768 + ch;
  const float a[8] = {bflo(pm.x), bfhi(pm.x), bflo(pm.y), bfhi(pm.y), bflo(pm.z), bfhi(pm.z), bflo(pm.w), bfhi(pm.w)};
  const float m[8] = {bflo(c0.x), bfhi(c0.x), bflo(c0.y), bfhi(c0.y), bflo(c0.z), bfhi(c0.z), bflo(c0.w), bfhi(c0.w)};
  const float n[8] = {bflo(nx.x), bfhi(nx.x), bflo(nx.y), bfhi(nx.y), bflo(nx.z), bfhi(nx.z), bflo(nx.w), bfhi(nx.w)};
#pragma unroll
  for (int j = 0; j < 8; ++j) out[j] = silu_f(cb[j] + cw[j] * a[j] + cw[768 + j] * m[j] + cw[1536 + j] * n[j]);
}
DI void ssd_gates(const Params& p, int l, int dir, int h, int row0, int tid, int lane, float& dt, float& cs, float& tot) {
  const float* DTR = (const float*)(p.ws + OFF_DTR);
  dt = softplus_f(DTR[(size_t)(row0 + tid) * 8 + dir * 4 + h] + p.ssd_dt_bias[l * 8 + dir * 4 + h]);
  const float la = -dt * __expf(p.ssd_a_log[l * 8 + dir * 4 + h]);
  const float pre = wave_incl_scan(la, lane); tot = __shfl(pre, 63);
  cs = dir ? tot - pre + la : pre;
}
DI void ssd_p1(const Params& p, int l, int item, char* smem) {
  const int tid = ltid(), lane = tid & 63, w = __builtin_amdgcn_readfirstlane(tid >> 6), l15 = lane & 15, g4 = lane >> 4;
  const int tcg = item % NCH; int r = item / NCH; const int dir = r & 1; r >>= 1; const int h = r & 3, b = r >> 2;
  int part, tc, row0; chunk_geom(tcg, b, part, tc, row0);
  const int c = chain_slot(dir, part, tc), chain = (b * 4 + h) * 2 + dir, lastc = part ? 3 : 127;
  bf16_t* Xt = (bf16_t*)smem;
  bf16_t* Bt = Xt + 64 * 72;
  float* fs = (float*)(Bt + 128 * 72);
  const bf16_t* P = (const bf16_t*)(p.ws + OFF_P);
  if (tid < 64) {
    float dt, cs, tot; ssd_gates(p, l, dir, h, row0, tid, lane, dt, cs, tot);
    fs[tid] = __expf(tot - cs) * dt;
    if (tid == 0) ((float*)(p.ws + OFF_SSA))[(chain * NCH + c) * 32] = tot;
  }
  __syncthreads();
  const int grp = h >> 1;
  for (int id = tid; id < 64 * 24; id += 256) {
    const int s = id / 24, cc = id % 24;
    const bool hp = !(tc == 0 && s == 0), hn = !(tc == lastc && s == 63);
    float v[8];
    if (cc < 8) { conv_silu8(p, l, P, row0 + s, hp, hn, h * 64 + cc * 8, v); const float wv = fs[s];
#pragma unroll
      for (int j = 0; j < 8; ++j) Xt[(cc * 8 + j) * 72 + s] = f2bf(v[j] * wv); }
    else { const int n0 = (cc - 8) * 8; conv_silu8(p, l, P, row0 + s, hp, hn, 256 + grp * 128 + n0, v);
#pragma unroll
      for (int j = 0; j < 8; ++j) Bt[(n0 + j) * 72 + s] = f2bf(v[j]); }
  }
  __syncthreads();
  float* SS = (float*)(p.ws + OFF_SSDS) + (size_t)(chain * NCH + c) * 8192;
#pragma unroll
  for (int ns = 0; ns < 8; ++ns) {
    f32x4 acc = {0.f, 0.f, 0.f, 0.f};
#pragma unroll
    for (int ks = 0; ks < 2; ++ks) acc = MFMA16(ld_frag(Xt + (16 * w + l15) * 72 + ks * 32 + g4 * 8), ld_frag(Bt + (16 * ns + l15) * 72 + ks * 32 + g4 * 8), acc);
#pragma unroll
    for (int j = 0; j < 4; ++j) SS[(16 * w + 4 * g4 + j) * 128 + 16 * ns + l15] = acc[j];
  }
  __syncthreads();
}
DI void ssd_p2(const Params& p, int item) {
  const int gi = item * 256 + ltid(), chain = gi >> 13, e = gi & 8191;
  float* SS = (float*)(p.ws + OFF_SSDS) + (size_t)chain * NCH * 8192 + e;
  const float* SA = (const float*)(p.ws + OFF_SSA) + (size_t)chain * NCH * 32;
  float S = 0.f;
  for (int c0 = 0; c0 < NCH; c0 += 12) {
    float d[12], a[12];
#pragma unroll
    for (int i = 0; i < 12; ++i) { d[i] = SS[(size_t)(c0 + i) * 8192]; a[i] = SA[(c0 + i) * 32]; }
#pragma unroll
    for (int i = 0; i < 12; ++i) { SS[(size_t)(c0 + i) * 8192] = S; S = __expf(a[i]) * S + d[i]; }
  }
}
DI void ssd_p3(const Params& p, int l, int item, char* smem) {
  const int tid = ltid(), lane = tid & 63, w = __builtin_amdgcn_readfirstlane(tid >> 6), l15 = lane & 15, g4 = lane >> 4;
  const int h = item & 3; const int r = item >> 2; const int tcg = r % NCH, b = r / NCH;
  int part, tc, row0; chunk_geom(tcg, b, part, tc, row0);
  const int lastc = part ? 3 : 127, grp = h >> 1;
  bf16_t* Cm = (bf16_t*)smem;
  bf16_t* Bm = Cm + 64 * 136;
  bf16_t* Xt = Bm + 64 * 136;
  bf16_t* Sb = Xt + 64 * 72;
  float* fcs = (float*)(Sb + 64 * 72);
  float* fdt = fcs + 64;
  const bf16_t* P = (const bf16_t*)(p.ws + OFF_P);
  for (int id = tid; id < 64 * 40; id += 256) {
    const int s = id / 40, cc = id % 40;
    const bool hp = !(tc == 0 && s == 0), hn = !(tc == lastc && s == 63);
    float v[8];
    if (cc < 8) { conv_silu8(p, l, P, row0 + s, hp, hn, h * 64 + cc * 8, v);
#pragma unroll
      for (int j = 0; j < 8; ++j) Xt[(cc * 8 + j) * 72 + s] = f2bf(v[j]); }
    else {
      const int q = cc - 8, isC = q >= 16, n0 = (q & 15) * 8;
      conv_silu8(p, l, P, row0 + s, hp, hn, 256 + isC * 256 + grp * 128 + n0, v);
      u32x4 o; o.x = pack2(v[0], v[1]); o.y = pack2(v[2], v[3]); o.z = pack2(v[4], v[5]); o.w = pack2(v[6], v[7]);
      *(u32x4*)((isC ? Cm : Bm) + s * 136 + n0) = o;
    }
  }
  f32x4 ys[4];
#pragma unroll
  for (int ns = 0; ns < 4; ++ns) ys[ns] = (f32x4){0.f, 0.f, 0.f, 0.f};
#pragma unroll 1
  for (int dir = 0; dir < 2; ++dir) {
    const int c = chain_slot(dir, part, tc), chain = (b * 4 + h) * 2 + dir;
    const float* St = (const float*)(p.ws + OFF_SSDS) + (size_t)(chain * NCH + c) * 8192;
    __syncthreads();
    if (tid < 64) { float dt, cs, tot; ssd_gates(p, l, dir, h, row0, tid, lane, dt, cs, tot); fcs[tid] = cs; fdt[tid] = dt; }
    __syncthreads();
    float ci[4];
#pragma unroll
    for (int j = 0; j < 4; ++j) ci[j] = fcs[16 * w + 4 * g4 + j];
#pragma unroll
    for (int ns = 0; ns < 4; ++ns) {
      f32x4 a = {0.f, 0.f, 0.f, 0.f};
#pragma unroll
      for (int ks = 0; ks < 4; ++ks) a = MFMA16(ld_frag(Cm + (16 * w + l15) * 136 + ks * 32 + g4 * 8), ld_frag(Bm + (16 * ns + l15) * 136 + ks * 32 + g4 * 8), a);
      const int s = 16 * ns + l15; const float css = fcs[s], dts = fdt[s];
#pragma unroll
      for (int j = 0; j < 4; ++j) {
        const int i = 16 * w + 4 * g4 + j; const bool ok = dir ? (s >= i) : (s <= i);
        Sb[i * 72 + s] = f2bf(ok ? a[j] * __expf(ci[j] - css) * dts : 0.f);
      }
    }
    __syncthreads();
#pragma unroll
    for (int ns = 0; ns < 4; ++ns) {
      f32x4 a = {0.f, 0.f, 0.f, 0.f}, bq = {0.f, 0.f, 0.f, 0.f};
#pragma unroll
      for (int ks = 0; ks < 2; ++ks) a = MFMA16(ld_frag(Sb + (16 * w + l15) * 72 + ks * 32 + g4 * 8), ld_frag(Xt + (16 * ns + l15) * 72 + ks * 32 + g4 * 8), a);
#pragma unroll
      for (int ks = 0; ks < 4; ++ks) bq = MFMA16(ld_frag(Cm + (16 * w + l15) * 136 + ks * 32 + g4 * 8), frag_from_f32(St + (16 * ns + l15) * 128 + ks * 32 + g4 * 8, 1.f), bq);
#pragma unroll
      for (int j = 0; j < 4; ++j) ys[ns][j] += a[j] + __expf(ci[j]) * bq[j];
    }
  }
  bf16_t* Y = (bf16_t*)(p.ws + OFF_HY); float* SSQ = (float*)(p.ws + OFF_SSQ);
  const float dsk = p.ssd_d[l * 4 + h];
#pragma unroll
  for (int j = 0; j < 4; ++j) {
    const int i = 16 * w + 4 * g4 + j, row = row0 + i; float ss = 0.f;
#pragma unroll
    for (int ns = 0; ns < 4; ++ns) {
      const int pp = 16 * ns + l15;
      const float xv = bf2f(Xt[pp * 72 + i]);
      const float z = bf2f(P[(size_t)row * PINP + C_Z + h * 64 + pp]);
      const float g = (ys[ns][j] + dsk * xv) * silu_f(z);
      ss += g * g; Y[(size_t)row * 1024 + 512 + h * 64 + pp] = f2bf(g);
    }
    ss = red16_sum(ss);
    if (l15 == 0) SSQ[(size_t)h * NROW + row] = ss;
  }
  __syncthreads();
}

struct S5Par { float are, aim, bre[16], bim[16]; };
DI void s5_params(const Params& p, int l, int dir, int g, int n, S5Par& q, float& dtv, float& lre, float& lim) {
  const int ai = ((l * 2 + dir) * 16 + g) * 64 + n;
  lre = fminf(p.s5_a_re[ai], -1e-4f); lim = p.s5_a_im[ai];
  dtv = __expf(p.s5_log_dt[(l * 2 + dir) * 16 + g]);
  const float mag = __expf(lre * dtv), ang = lim * dtv;
  q.are = mag * cosf(ang); q.aim = mag * sinf(ang);
  const float den = lre * lre + lim * lim;
  const float fre = ((q.are - 1.f) * lre + q.aim * lim) / den, fim = (q.aim * lre - (q.are - 1.f) * lim) / den;
  const float* br = p.s5_b_re + ((size_t)(l * 16 + g) * 64 + n) * 16; const float* bi = p.s5_b_im + ((size_t)(l * 16 + g) * 64 + n) * 16;
#pragma unroll
  for (int j = 0; j < 16; ++j) { q.bre[j] = fre * br[j] - fim * bi[j]; q.bim[j] = fre * bi[j] + fim * br[j]; }
}
DI void s5_step(const S5Par& q, const bf16_t* us, int s, float& xr, float& xi) {
  const u32x4 a0 = *(const u32x4*)(us + s * 16), a1 = *(const u32x4*)(us + s * 16 + 8);
  const unsigned uw[8] = {a0.x, a0.y, a0.z, a0.w, a1.x, a1.y, a1.z, a1.w};
  float br = 0.f, bi = 0.f;
#pragma unroll
  for (int j = 0; j < 8; ++j) { const float a = bflo(uw[j]), c = bfhi(uw[j]); br += q.bre[2 * j] * a + q.bre[2 * j + 1] * c; bi += q.bim[2 * j] * a + q.bim[2 * j + 1] * c; }
  const float nr = q.are * xr - q.aim * xi + br, ni = q.are * xi + q.aim * xr + bi;
  xr = nr; xi = ni;
}
DI void s5_p1(const Params& p, int l, int item, char* smem) {
  const int lane = ltid() & 63, wi = item * 4 + __builtin_amdgcn_readfirstlane(ltid() >> 6);
  const int tcg = wi % NCH; int r = wi / NCH; const int dir = r & 1; r >>= 1; const int g = r & 15, b = r >> 4;
  int part, tc, row0; chunk_geom(tcg, b, part, tc, row0);
  const int c = chain_slot(dir, part, tc);
  S5Par q; float dtv, lre, lim; s5_params(p, l, dir, g, lane, q, dtv, lre, lim);
  const bf16_t* up = (const bf16_t*)(p.ws + OFF_P) + (size_t)(row0 + lane) * PINP + C_S5 + g * 16;
  bf16_t* us = (bf16_t*)smem + __builtin_amdgcn_readfirstlane(ltid() >> 6) * 1024;
  *(u32x4*)(us + lane * 16) = *(const u32x4*)up; *(u32x4*)(us + lane * 16 + 8) = *(const u32x4*)(up + 8);
  float xr = 0.f, xi = 0.f;
  for (int st = 0; st < 64; ++st) { const int s = dir ? 63 - st : st; s5_step(q, us, s, xr, xi); }
  float* S = (float*)(p.ws + OFF_S5S) + ((size_t)((b * 16 + g) * 2 + dir) * NCH + c) * 128;
  S[lane] = xr; S[64 + lane] = xi;
}
DI void s5_p2(const Params& p, int l, int item) {
  const int gi = item * 256 + ltid(), n = gi & 63, dir = (gi >> 6) & 1, g = (gi >> 7) & 15, b = gi >> 11;
  const int ai = ((l * 2 + dir) * 16 + g) * 64 + n;
  const float lre = fminf(p.s5_a_re[ai], -1e-4f), lim = p.s5_a_im[ai], dtv = __expf(p.s5_log_dt[(l * 2 + dir) * 16 + g]);
  const float mag = __expf(64.f * lre * dtv), ang = 64.f * (lim * dtv);
  const float ar = mag * cosf(ang), aim = mag * sinf(ang);
  float* S = (float*)(p.ws + OFF_S5S) + (size_t)((b * 16 + g) * 2 + dir) * NCH * 128 + n;
  float xr = 0.f, xi = 0.f;
  for (int c0 = 0; c0 < NCH; c0 += 12) {
    float dr[12], di[12];
#pragma unroll
    for (int i = 0; i < 12; ++i) { dr[i] = S[(c0 + i) * 128]; di[i] = S[(c0 + i) * 128 + 64]; }
#pragma unroll
    for (int i = 0; i < 12; ++i) { S[(c0 + i) * 128] = xr; S[(c0 + i) * 128 + 64] = xi; const float nr = ar * xr - aim * xi + dr[i], ni = ar * xi + aim * xr + di[i]; xr = nr; xi = ni; }
  }
}
DI void s5_p3(const Params& p, int l, int item, char* smem) {
  const int tid = ltid(), lane = tid & 63, w = __builtin_amdgcn_readfirstlane(tid >> 6), l15 = lane & 15, g4 = lane >> 4;
  const int tcg = item % NCH, b = item / NCH;
  int part, tc, row0; chunk_geom(tcg, b, part, tc, row0);
  bf16_t* xs = (bf16_t*)smem + w * (16 * 136);
  bf16_t* yg = (bf16_t*)smem + 4 * 16 * 136;
  const bf16_t* P = (const bf16_t*)(p.ws + OFF_P);
#pragma unroll 1
  for (int gi = 0; gi < 4; ++gi) {
    const int g = w + 4 * gi;
    const bf16_t* up = P + (size_t)(row0 + lane) * PINP + C_S5 + g * 16;
    bf16_t* us = (bf16_t*)smem + 25600 + w * 1024;
    *(u32x4*)(us + lane * 16) = *(const u32x4*)up; *(u32x4*)(us + lane * 16 + 8) = *(const u32x4*)(up + 8);
    f32x4 yt[4];
#pragma unroll
    for (int ib = 0; ib < 4; ++ib) yt[ib] = (f32x4){0.f, 0.f, 0.f, 0.f};
#pragma unroll
    for (int dir = 0; dir < 2; ++dir) {
      S5Par q; float dtv, lre, lim; s5_params(p, l, dir, g, lane, q, dtv, lre, lim);
      const int c = chain_slot(dir, part, tc);
      const float* S = (const float*)(p.ws + OFF_S5S) + ((size_t)((b * 16 + g) * 2 + dir) * NCH + c) * 128;
      float xr = S[lane], xi = S[64 + lane];
      bf16x8 cf[4];
#pragma unroll
      for (int ks = 0; ks < 4; ++ks) {
        const int k = ks * 32 + g4 * 8;
        const float* src = (k < 64 ? p.s5_c_re : p.s5_c_im) + ((size_t)(l * 16 + g) * 16 + l15) * 64 + (k & 63);
        cf[ks] = frag_from_f32(src, k < 64 ? 1.f : -1.f);
      }
#pragma unroll
      for (int blk = 0; blk < 4; ++blk) {
        __syncthreads();
#pragma unroll 4
        for (int st = 0; st < 16; ++st) {
          const int step = blk * 16 + st, s = dir ? 63 - step : step;
          s5_step(q, us, s, xr, xi);
          xs[(s & 15) * 136 + lane] = f2bf(xr); xs[(s & 15) * 136 + 64 + lane] = f2bf(xi);
        }
        __syncthreads();
        f32x4 a = {0.f, 0.f, 0.f, 0.f};
#pragma unroll
        for (int ks = 0; ks < 4; ++ks) a = MFMA16(ld_frag(xs + l15 * 136 + ks * 32 + g4 * 8), cf[ks], a);
        const int ib = dir ? 3 - blk : blk;
        yt[ib] += a;
      }
    }
#pragma unroll
    for (int ib = 0; ib < 4; ++ib)
#pragma unroll
      for (int j = 0; j < 4; ++j) {
        const int tok = 16 * ib + 4 * g4 + j, ch = g * 16 + l15;
        const float u = bf2f(P[(size_t)(row0 + tok) * PINP + C_S5 + ch]);
        yg[tok * 264 + ch] = f2bf(gelu_tanh_f(yt[ib][j] + p.s5_d[l * 256 + ch] * u));
      }
  }
  __syncthreads();
  const bf16_t* Wg = (const bf16_t*)(p.ws + OFF_WGLU) + (size_t)l * 256 * 256;
  bf16_t* Y = (bf16_t*)(p.ws + OFF_HY);
#pragma unroll 1
  for (int ns = 0; ns < 4; ++ns) {
    f32x4 acc[4];
#pragma unroll
    for (int ms = 0; ms < 4; ++ms) acc[ms] = (f32x4){0.f, 0.f, 0.f, 0.f};
#pragma unroll
    for (int ks = 0; ks < 8; ++ks) {
      const bf16x8 wf = ld_frag(Wg + (size_t)(64 * w + 16 * ns + l15) * 256 + ks * 32 + g4 * 8);
#pragma unroll
      for (int ms = 0; ms < 4; ++ms) acc[ms] = MFMA16(wf, ld_frag(yg + (16 * ms + l15) * 264 + ks * 32 + g4 * 8), acc[ms]);
    }
#pragma unroll
    for (int ms = 0; ms < 4; ++ms) {
      const int tok = 16 * ms + l15, n0 = 64 * w + 16 * ns + 4 * g4;
      const u32x2 yv = *(const u32x2*)(yg + tok * 264 + n0);
      f32x4 o; o[0] = bflo(yv.x) * sigm_f(acc[ms][0]); o[1] = bfhi(yv.x) * sigm_f(acc[ms][1]); o[2] = bflo(yv.y) * sigm_f(acc[ms][2]); o[3] = bfhi(yv.y) * sigm_f(acc[ms][3]);
      store_bf4(Y + (size_t)(row0 + tok) * 1024 + 768 + n0, o);
    }
  }
  __syncthreads();
}

DI void outproj_item(const Params& p, int l, int item, char* smem) {
  const int mt = item >> 3, nt = item & 7;
  const float* MOD = (const float*)(p.ws + OFF_MOD);
  gemm_tile<1>((const bf16_t*)(p.ws + OFF_HY), 1024, (const bf16_t*)(p.ws + OFF_WOUT) + (size_t)l * 1024 * 1024, 1024, 1024, mt * 128, nt * 128, smem, (const float*)(p.ws + OFF_SSQ),
               [&](int row, int col, f32x4 v) {
                 const int s = row < NLAT ? row / T : 2;
                 const f32x4 gt = *(const f32x4*)(MOD + (size_t)(l * 3 + s) * 6144 + 2048 + col);
                 float* xp = row < NLAT ? p.xb + (size_t)row * 1024 + col : (float*)(p.ws + OFF_CTX) + (size_t)(row - NLAT) * 1024 + col;
                 *(f32x4*)xp = *(f32x4*)xp + gt * v;
               });
}
DI void ffnup_item(const Params& p, int l, int item, char* smem) {
  const int mt = item / 44, nt = item % 44;
  bf16_t* UG = (bf16_t*)(p.ws + OFF_R);
  gemm_tile<0>((const bf16_t*)(p.ws + OFF_HY), 1024, (const bf16_t*)(p.ws + OFF_WUP) + (size_t)l * 5632 * 1024, 1024, 1024, mt * 128, nt * 128, smem, nullptr,
               [&](int row, int col, f32x4 v) { store_bf4(UG + (size_t)row * 5632 + col, v); });
}
DI void act_item(const Params& p, int l, int item) {
  bf16_t* UG = (bf16_t*)(p.ws + OFF_R);
  const float* cw = p.ffn_conv_w + (size_t)l * 3 * DFF;
  for (int i = 0; i < 11; ++i) {
    const int id = ltid() + 256 * i, r = id / 352, cc = id % 352, row = item * 8 + r, k = cc * 8;
    int t, tl; if (row < NLAT) { t = row % T; tl = T; } else { t = (row - NLAT) % TC; tl = TC; }
    bf16_t* up = UG + (size_t)row * 5632 + k; const bf16_t* gp = up + DFF;
    const u32x4 z = {0u, 0u, 0u, 0u};
    const u32x4 u = *(const u32x4*)up, g0 = *(const u32x4*)gp, gm = t > 0 ? *(const u32x4*)(gp - 5632) : z, gn = t < tl - 1 ? *(const u32x4*)(gp + 5632) : z;
    const float uf[8] = {bflo(u.x), bfhi(u.x), bflo(u.y), bfhi(u.y), bflo(u.z), bfhi(u.z), bflo(u.w), bfhi(u.w)};
    const float a[8] = {bflo(gm.x), bfhi(gm.x), bflo(gm.y), bfhi(gm.y), bflo(gm.z), bfhi(gm.z), bflo(gm.w), bfhi(gm.w)};
    const float m[8] = {bflo(g0.x), bfhi(g0.x), bflo(g0.y), bfhi(g0.y), bflo(g0.z), bfhi(g0.z), bflo(g0.w), bfhi(g0.w)};
    const float n[8] = {bflo(gn.x), bfhi(gn.x), bflo(gn.y), bfhi(gn.y), bflo(gn.z), bfhi(gn.z), bflo(gn.w), bfhi(gn.w)};
    float o[8];
#pragma unroll
    for (int j = 0; j < 8; ++j) o[j] = silu_f(cw[k + j] * a[j] + cw[DFF + k + j] * m[j] + cw[2 * DFF + k + j] * n[j]) * uf[j];
    u32x4 ov; ov.x = pack2(o[0], o[1]); ov.y = pack2(o[2], o[3]); ov.z = pack2(o[4], o[5]); ov.w = pack2(o[6], o[7]);
    *(u32x4*)up = ov;
  }
}
DI void ffndown_item(const Params& p, int l, int item, char* smem) {
  const int mt = item >> 3, nt = item & 7;
  const float* MOD = (const float*)(p.ws + OFF_MOD);
  gemm_tile<0>((const bf16_t*)(p.ws + OFF_R), 5632, (const bf16_t*)(p.ws + OFF_WDN) + (size_t)l * 1024 * 2816, 2816, 2816, mt * 128, nt * 128, smem, nullptr,
               [&](int row, int col, f32x4 v) {
                 const int s = row < NLAT ? row / T : 2;
                 const f32x4 gt = *(const f32x4*)(MOD + (size_t)(l * 3 + s) * 6144 + 5120 + col);
                 float* xp = row < NLAT ? p.xb + (size_t)row * 1024 + col : (float*)(p.ws + OFF_CTX) + (size_t)(row - NLAT) * 1024 + col;
                 *(f32x4*)xp = *(f32x4*)xp + gt * v;
               });
}
DI void final_item(const Params& p, int item) {
  const int lane = ltid() & 63, w = __builtin_amdgcn_readfirstlane(ltid() >> 6), row = item * 4 + w;
  float* x = p.xb + (size_t)row * 1024;
  float4 v[4]; float ss = 0.f;
#pragma unroll
  for (int i = 0; i < 4; ++i) { v[i] = *(const float4*)(x + (i * 64 + lane) * 4); ss += v[i].x * v[i].x + v[i].y * v[i].y + v[i].z * v[i].z + v[i].w * v[i].w; }
  ss = wave_sum(ss);
  const float rstd = rsqrtf(ss * (1.f / 1024.f) + 1e-6f);
#pragma unroll
  for (int i = 0; i < 4; ++i) {
    const int k = (i * 64 + lane) * 4; const float4 g = *(const float4*)(p.final_norm + k);
    float4 o; o.x = v[i].x * rstd * g.x; o.y = v[i].y * rstd * g.y; o.z = v[i].z * rstd * g.z; o.w = v[i].w * rstd * g.w;
    *(float4*)(x + k) = o;
  }
}

constexpr int PPL = 12;
constexpr int N_PHASES = 2 + NL * PPL;
#define FOR_ITEMS(n) for (int it = blockIdx.x; it < (n); it += gridDim.x)

DI void run_phase(const Params& p, int ph, char* smem) {
  if (ph == 0) { FOR_ITEMS(P0_ITEMS) p0_item(p, it, smem); return; }
  if (ph == N_PHASES - 1) { FOR_ITEMS(NLAT / 4) final_item(p, it); return; }
  const int l = (ph - 1) / PPL, k = (ph - 1) % PPL;
  const int mtiles = (l == NL - 1) ? 128 : 132;
  switch (k) {
    case 0: FOR_ITEMS(NROW / 4) norm_item(p, l, 0, it); break;
    case 1: FOR_ITEMS(132 * 22) gemm_in_item(p, l, it, smem); break;
    case 2: FOR_ITEMS(2112) s5_p1(p, l, it, smem); break;
    case 3: {
      constexpr int n0 = 2112, n1 = n0 + 2112, n2 = n1 + 528, n3 = n2 + 396, n5 = n3 + 66;
      FOR_ITEMS(n5) {
        if (it < n0) ssd_p1(p, l, it, smem);
        else if (it < n1) mlstm_p1(p, l, it - n0, smem);
        else if (it < n2) kvproj_item(p, l, it - n1, smem);
        else if (it < n3) qproj_item(p, l, it - n2, smem);
        else ropek_item(p, it - n3);
      }
    } break;
    case 4: {
      constexpr int n0 = 512, n1 = n0 + 260, n2 = n1 + 16;
      FOR_ITEMS(n2) { if (it < n0) ssd_p2(p, it); else if (it < n1) mlstm_p2(p, it - n0); else s5_p2(p, l, it - n1); }
    } break;
    case 5: FOR_ITEMS(264) s5_p3(p, l, it, smem); break;
    case 6: {
      constexpr int n0 = 528, n2 = n0 + 1056, n3 = n2 + 1056;
      FOR_ITEMS(n3) {
        if (it < n0) attn_item(p, it, smem);
        else if (it < n2) ssd_p3(p, l, it - n0, smem);
        else mlstm_p3(p, l, it - n2, smem);
      }
    } break;
    case 7: FOR_ITEMS(mtiles * 8) outproj_item(p, l, it, smem); break;
    case 8: FOR_ITEMS(mtiles * 32) norm_item(p, l, 1, it); break;
    case 9: FOR_ITEMS(mtiles * 44) ffnup_item(p, l, it, smem); break;
    case 10: FOR_ITEMS(mtiles * 16) act_item(p, l, it); break;
    case 11: FOR_ITEMS(mtiles * 8) ffndown_item(p, l, it, smem); break;
  }
}

#ifndef HASH_LO
#define HASH_LO OFF_MOD
#define HASH_HI WS_NEED
#endif
#ifndef PROBE_N
#define PROBE_N 0
#endif
DI void hash_dump(const Params& p) {
  const size_t NOUT = (size_t)NLAT * 1024, nw = (HASH_HI - HASH_LO) / 4;
  const unsigned* wsw = (const unsigned*)(p.ws + HASH_LO);
  for (size_t i = (size_t)blockIdx.x * 256 + threadIdx.x; i < NOUT; i += (size_t)gridDim.x * 256) {
    unsigned h = 12345u;
    for (size_t j = i; j < nw; j += NOUT) h = h * 1664525u + wsw[j];
    p.xb[i] = (float)(h & 0xFFFFFFu);
  }
}
constexpr int SMEM_BYTES = 59392;
__global__ void __launch_bounds__(256, 2) trunk_fwd(Params p) {
  __shared__ __attribute__((aligned(16))) char smem[SMEM_BYTES];
  cg::grid_group grid = cg::this_grid();
  for (int i = threadIdx.x; i < SMEM_BYTES / 16; i += 256) ((u32x4*)smem)[i] = (u32x4){0u, 0u, 0u, 0u};
  __syncthreads();
  for (int ph = p.ph_lo; ph < p.ph_hi; ++ph) {
    run_phase(p, ph, smem);
    if (ph + 1 < p.ph_hi) grid.sync();
  }
}

__global__ void __launch_bounds__(256) hash_kernel(Params p) { hash_dump(p); }

extern "C" void kernel_launch(void* const* d_in, const int* in_sizes, int n_in, void* d_out, int out_size, void* d_ws, size_t ws_size, hipStream_t stream) {
  static int grid_blocks = 0;
  if (!grid_blocks) {
    int dev = 0, cus = 0, per_cu = 0;
    hipGetDevice(&dev);
    hipDeviceGetAttribute(&cus, hipDeviceAttributeMultiprocessorCount, dev);
    hipOccupancyMaxActiveBlocksPerMultiprocessor(&per_cu, trunk_fwd, 256, 0);
    if (per_cu > 2) per_cu = 2;
    grid_blocks = cus * per_cu;
  }
  if (ws_size < WS_NEED) { fprintf(stderr, "workspace too small: %zu < %zu\n", ws_size, (size_t)WS_NEED); return; }
  Params p{};
  const float** fp = (const float**)&p;
  for (int i = 0; i < 35; ++i) fp[i] = (const float*)d_in[i];
  p.xb = (float*)d_out; p.ws = (char*)d_ws;
#if MULTI_LAUNCH
#if PROBE_N
  for (int ph = 0; ph < PROBE_N; ++ph) { p.ph_lo = ph; p.ph_hi = ph + 1; hipLaunchKernelGGL(trunk_fwd, dim3(grid_blocks), dim3(256), 0, stream, p); }
  hipLaunchKernelGGL(hash_kernel, dim3(grid_blocks), dim3(256), 0, stream, p);
#else
  for (int ph = 0; ph < N_PHASES; ++ph) { p.ph_lo = ph; p.ph_hi = ph + 1; hipLaunchKernelGGL(trunk_fwd, dim3(grid_blocks), dim3(256), 0, stream, p); }
#endif
#else
  p.ph_lo = 0; p.ph_hi = N_PHASES;
  void* args[] = {&p};
  hipError_t e = hipLaunchCooperativeKernel((void*)trunk_fwd, dim3(grid_blocks), dim3(256), args, 0, stream);
  if (e != hipSuccess) fprintf(stderr, "cooperative launch failed: %s (grid %d)\n", hipGetErrorString(e), grid_blocks);
#endif
}
```

```cpp
#include <hip/hip_runtime.h>
#include <hip/hip_cooperative_groups.h>
#include <cstdio>
#include <cstdint>
namespace cg = cooperative_groups;

#ifndef PROBE_MASK
#define PROBE_MASK 63
#endif
#ifndef ZERO_FILL
#define ZERO_FILL 0
#endif
#ifndef MULTI_LAUNCH
#define MULTI_LAUNCH 0
#endif

typedef unsigned short bf16_t;
typedef short bf16x8 __attribute__((ext_vector_type(8)));
typedef float f32x4 __attribute__((ext_vector_type(4)));
typedef unsigned u32x4 __attribute__((ext_vector_type(4)));
typedef unsigned u32x2 __attribute__((ext_vector_type(2)));
#define DI __device__ __forceinline__
#define MFMA16(a, b, c) __builtin_amdgcn_mfma_f32_16x16x32_bf16((a), (b), (c), 0, 0, 0)

constexpr int NB = 2, T = 8192, TC = 256, NL = 4;
constexpr int NLAT = NB * T, NROW = NLAT + NB * TC;
constexpr int TALL = T + TC;
constexpr int PINP = 2816;
constexpr int C_MLQ = 0, C_MLK = 256, C_MLV = 512, C_MLO = 768, C_CQ = 1040, C_CKV = 1296, C_KR = 1424,
              C_Z = 1456, C_XBC = 1712, C_S5 = 2488;
constexpr int NCH = 132;
constexpr int DFF = 2816;

constexpr size_t SZ_WIN = (size_t)NL * 2816 * 1024 * 2, SZ_WUQ = (size_t)NL * 384 * 256 * 2, SZ_WUKV = (size_t)NL * 512 * 128 * 2,
                 SZ_WGLU = (size_t)NL * 256 * 256 * 2, SZ_WOUT = (size_t)NL * 1024 * 1024 * 2, SZ_WUP = (size_t)NL * 5632 * 1024 * 2,
                 SZ_WDN = (size_t)NL * 1024 * 2816 * 2, SZ_MOD = (size_t)NL * 3 * 6144 * 4, SZ_CTX = (size_t)512 * 1024 * 4,
                 SZ_HY = (size_t)NROW * 1024 * 2, SZ_GML = (size_t)NROW * 16 * 4, SZ_DTR = (size_t)NROW * 8 * 4, SZ_SSQ = (size_t)NROW * 4 * 4,
                 SZ_QRAW = (size_t)NROW * 384 * 2, SZ_KH = (size_t)NB * 4 * TALL * 64 * 2 + (size_t)NB * TALL * 32 * 2, SZ_VT = (size_t)NB * 4 * 64 * TALL * 2,
                 SZ_S5S = (size_t)NB * 16 * 2 * NCH * 128 * 4, SZ_MLM = (size_t)16 * NCH * 32 * 4, SZ_SSA = (size_t)16 * NCH * 32 * 4,
                 SZ_P = (size_t)NROW * PINP * 2, SZ_MLS = (size_t)16 * NCH * 4160 * 4, SZ_SSDS = (size_t)16 * NCH * 8192 * 4;
constexpr size_t OFF_WIN = 0, OFF_WUQ = OFF_WIN + SZ_WIN, OFF_WUKV = OFF_WUQ + SZ_WUQ, OFF_WGLU = OFF_WUKV + SZ_WUKV,
                 OFF_WOUT = OFF_WGLU + SZ_WGLU, OFF_WUP = OFF_WOUT + SZ_WOUT, OFF_WDN = OFF_WUP + SZ_WUP, OFF_MOD = OFF_WDN + SZ_WDN,
                 OFF_CTX = OFF_MOD + SZ_MOD, OFF_HY = OFF_CTX + SZ_CTX, OFF_GML = OFF_HY + SZ_HY, OFF_DTR = OFF_GML + SZ_GML,
                 OFF_SSQ = OFF_DTR + SZ_DTR, OFF_QRAW = OFF_SSQ + SZ_SSQ, OFF_KH = OFF_QRAW + SZ_QRAW, OFF_VT = OFF_KH + SZ_KH,
                 OFF_S5S = OFF_VT + SZ_VT, OFF_MLM = OFF_S5S + SZ_S5S, OFF_SSA = OFF_MLM + SZ_MLM,
                 OFF_R = ((OFF_SSA + SZ_SSA + 255) / 256) * 256, OFF_P = OFF_R, OFF_MLS = OFF_P + SZ_P, OFF_SSDS = OFF_MLS + SZ_MLS,
                 WS_NEED = OFF_SSDS + SZ_SSDS;
static_assert((size_t)NROW * 5632 * 2 <= SZ_P + SZ_MLS + SZ_SSDS, "UG overlay");

constexpr size_t OFF_KR = OFF_KH + (size_t)NB * 4 * TALL * 64 * 2;
struct Params {
  const float *x, *c, *ctx, *c_ctx, *w_mod, *b_mod, *norm1, *norm2, *w_in, *ml_gate_bias, *ml_norm, *mla_q_norm, *mla_kv_norm,
      *mla_w_uq, *mla_w_ukv, *ssd_conv_w, *ssd_conv_b, *ssd_a_log, *ssd_dt_bias, *ssd_d, *ssd_norm, *s5_a_re, *s5_a_im, *s5_log_dt,
      *s5_b_re, *s5_b_im, *s5_c_re, *s5_c_im, *s5_d, *s5_w_glu, *w_out, *ffn_w_up, *ffn_conv_w, *ffn_w_down, *final_norm;
  float* xb;
  char* ws;
  int ph_lo, ph_hi;
};

DI bf16_t f2bf(float x) { unsigned u = __float_as_uint(x); u += 0x7fffu + ((u >> 16) & 1u); return (bf16_t)(u >> 16); }
DI float bf2f(bf16_t v) { return __uint_as_float(((unsigned)v) << 16); }
DI unsigned pack2(float lo, float hi) { return (unsigned)f2bf(lo) | ((unsigned)f2bf(hi) << 16); }
DI float bflo(unsigned w) { return __uint_as_float(w << 16); }
DI float bfhi(unsigned w) { return __uint_as_float(w & 0xffff0000u); }
DI float silu_f(float x) { return x / (1.f + __expf(-x)); }
DI float sigm_f(float x) { return 1.f / (1.f + __expf(-x)); }
DI float softplus_f(float x) { return fmaxf(x, 0.f) + log1pf(__expf(-fabsf(x))); }
DI float logsigm_f(float x) { return fminf(x, 0.f) - log1pf(__expf(-fabsf(x))); }
DI float gelu_tanh_f(float x) { float u = 0.7978845608f * (x + 0.044715f * x * x * x); return x * sigm_f(2.f * u); }
DI float wave_sum(float v) { for (int o = 32; o; o >>= 1) v += __shfl_xor(v, o); return v; }
DI float wave_max(float v) { for (int o = 32; o; o >>= 1) v = fmaxf(v, __shfl_xor(v, o)); return v; }
DI float wave_incl_scan(float v, int lane) { for (int o = 1; o < 64; o <<= 1) { float t = __shfl_up(v, o); if (lane >= o) v += t; } return v; }
DI float red16_max(float v) { v = fmaxf(v, __shfl_xor(v, 1)); v = fmaxf(v, __shfl_xor(v, 2)); v = fmaxf(v, __shfl_xor(v, 4)); v = fmaxf(v, __shfl_xor(v, 8)); return v; }
DI float red16_sum(float v) { v += __shfl_xor(v, 1); v += __shfl_xor(v, 2); v += __shfl_xor(v, 4); v += __shfl_xor(v, 8); return v; }
DI bf16x8 ld_frag(const bf16_t* p) { return *(const bf16x8*)p; }
DI bf16x8 mk_frag(unsigned a, unsigned b, unsigned c, unsigned d) { u32x4 u = {a, b, c, d}; return __builtin_bit_cast(bf16x8, u); }
DI bf16x8 frag_from_f32(const float* p, float sgn) {
  float4 a = *(const float4*)p, b = *(const float4*)(p + 4);
  return mk_frag(pack2(a.x * sgn, a.y * sgn), pack2(a.z * sgn, a.w * sgn), pack2(b.x * sgn, b.y * sgn), pack2(b.z * sgn, b.w * sgn));
}
DI int ltid() { int t = threadIdx.x; asm volatile("" : "+v"(t)); return t; }
DI int row_of(int b, int part, int t) { return part ? NLAT + b * TC + t : b * T + t; }

DI void tr_tile(const float* __restrict__ src, int K, int N, bf16_t* __restrict__ dst, const float* gain, int glo, int ghi, int tk, int tn, float* tile) {
  const int tid = ltid(), c = tid & 63, rq = tid >> 6;
  for (int rr = 0; rr < 16; ++rr) {
    const int r = rr * 4 + rq, k = tk * 64 + r, n = tn * 64 + c;
    float v = (n < N) ? src[(size_t)k * N + n] : 0.f;
    if (gain && k >= glo && k < ghi) v *= gain[k - glo];
    tile[r * 65 + c] = v;
  }
  __syncthreads();
  for (int cc = 0; cc < 16; ++cc) { const int n = cc * 4 + rq; dst[(size_t)(tn * 64 + n) * K + tk * 64 + c] = f2bf(tile[c * 65 + n]); }
  __syncthreads();
}

constexpr int TR_PER_LAYER = 3128, P0_TR = NL * TR_PER_LAYER, P0_MOD = NL * 96, P0_CPX = NLAT * 1024 / 4096, P0_CPC = 512 * 1024 / 4096;
constexpr int P0_ZERO = (int)((WS_NEED - OFF_HY + 65535) / 65536);
constexpr int P0_ITEMS = P0_TR + P0_MOD + P0_CPX + P0_CPC + (ZERO_FILL ? P0_ZERO : 0);

DI void p0_item(const Params& p, int item, char* smem) {
  const int tid = ltid();
  if (item < P0_TR) {
    const int l = item / TR_PER_LAYER; int t = item % TR_PER_LAYER; float* tile = (float*)smem;
    if (t < 704) { tr_tile(p.w_in + (size_t)l * 1024 * 2744, 1024, 2744, (bf16_t*)(p.ws + OFF_WIN) + (size_t)l * 2816 * 1024, nullptr, 0, 0, t / 44, t % 44, tile); return; }
    t -= 704;
    if (t < 24) { tr_tile(p.mla_w_uq + (size_t)l * 256 * 384, 256, 384, (bf16_t*)(p.ws + OFF_WUQ) + (size_t)l * 384 * 256, p.mla_q_norm + l * 256, 0, 256, t / 6, t % 6, tile); return; }
    t -= 24;
    if (t < 16) { tr_tile(p.mla_w_ukv + (size_t)l * 128 * 512, 128, 512, (bf16_t*)(p.ws + OFF_WUKV) + (size_t)l * 512 * 128, p.mla_kv_norm + l * 128, 0, 128, t / 8, t % 8, tile); return; }
    t -= 16;
    if (t < 16) { tr_tile(p.s5_w_glu + (size_t)l * 256 * 256, 256, 256, (bf16_t*)(p.ws + OFF_WGLU) + (size_t)l * 256 * 256, nullptr, 0, 0, t / 4, t % 4, tile); return; }
    t -= 16;
    if (t < 256) { tr_tile(p.w_out + (size_t)l * 1024 * 1024, 1024, 1024, (bf16_t*)(p.ws + OFF_WOUT) + (size_t)l * 1024 * 1024, p.ssd_norm + l * 256, 512, 768, t / 16, t % 16, tile); return; }
    t -= 256;
    if (t < 1408) { tr_tile(p.ffn_w_up + (size_t)l * 1024 * 5632, 1024, 5632, (bf16_t*)(p.ws + OFF_WUP) + (size_t)l * 5632 * 1024, nullptr, 0, 0, t / 88, t % 88, tile); return; }
    t -= 1408;
    tr_tile(p.ffn_w_down + (size_t)l * 2816 * 1024, 2816, 1024, (bf16_t*)(p.ws + OFF_WDN) + (size_t)l * 1024 * 2816, nullptr, 0, 0, t / 16, t % 16, tile);
    return;
  }
  item -= P0_TR;
  if (item < P0_MOD) {
    const int l = item / 96, cb = item % 96, cl = tid & 63, kq = tid >> 6;
    float* sv = (float*)smem;
    float* red = sv + 3072;
    for (int i = tid; i < 1024; i += 256) { sv[i] = silu_f(p.c[i]); sv[1024 + i] = silu_f(p.c[1024 + i]); sv[2048 + i] = silu_f(p.c_ctx[i]); }
    __syncthreads();
    const int col = cb * 64 + cl; const float* W = p.w_mod + (size_t)l * 1024 * 6144 + col;
    float a0 = 0.f, a1 = 0.f, a2 = 0.f;
#pragma unroll 8
    for (int k = kq * 256; k < kq * 256 + 256; ++k) { const float w = W[(size_t)k * 6144]; a0 += sv[k] * w; a1 += sv[1024 + k] * w; a2 += sv[2048 + k] * w; }
    red[(kq * 3 + 0) * 64 + cl] = a0; red[(kq * 3 + 1) * 64 + cl] = a1; red[(kq * 3 + 2) * 64 + cl] = a2;
    __syncthreads();
    if (tid < 192) {
      const int s = tid >> 6; const float bm = p.b_mod[l * 6144 + col];
      const float v = red[(0 * 3 + s) * 64 + cl] + red[(1 * 3 + s) * 64 + cl] + red[(2 * 3 + s) * 64 + cl] + red[(3 * 3 + s) * 64 + cl] + bm;
      ((float*)(p.ws + OFF_MOD))[(size_t)(l * 3 + s) * 6144 + col] = v;
    }
    __syncthreads();
    return;
  }
  item -= P0_MOD;
  if (item >= P0_CPX + P0_CPC) {
    item -= P0_CPX + P0_CPC;
    char* z = p.ws + OFF_HY + (size_t)item * 65536;
    const size_t lim = WS_NEED - OFF_HY - (size_t)item * 65536;
    for (int i = 0; i < 16; ++i) { const size_t o = (size_t)(i * 256 + tid) * 16; if (o < lim) *(u32x4*)(z + o) = (u32x4){0u, 0u, 0u, 0u}; }
    return;
  }
  const float* src; float* dst;
  if (item < P0_CPX) { src = p.x + (size_t)item * 4096; dst = p.xb + (size_t)item * 4096; }
  else { item -= P0_CPX; src = p.ctx + (size_t)item * 4096; dst = (float*)(p.ws + OFF_CTX) + (size_t)item * 4096; }
  for (int i = 0; i < 4; ++i) { const int o = (i * 256 + tid) * 4; *(float4*)(dst + o) = *(const float4*)(src + o); }
}

DI void norm_item(const Params& p, int l, int which, int item) {
  const int lane = ltid() & 63, w = __builtin_amdgcn_readfirstlane(ltid() >> 6), row = item * 4 + w;
  const float* x = row < NLAT ? p.xb + (size_t)row * 1024 : (const float*)(p.ws + OFF_CTX) + (size_t)(row - NLAT) * 1024;
  float4 v[4]; float ss = 0.f;
#pragma unroll
  for (int i = 0; i < 4; ++i) { v[i] = *(const float4*)(x + (i * 64 + lane) * 4); ss += v[i].x * v[i].x + v[i].y * v[i].y + v[i].z * v[i].z + v[i].w * v[i].w; }
  ss = wave_sum(ss);
  const float rstd = rsqrtf(ss * (1.f / 1024.f) + 1e-6f);
  const int s = row < NLAT ? row / T : 2;
  const float* g = (which ? p.norm2 : p.norm1) + l * 1024;
  const float* md = (const float*)(p.ws + OFF_MOD) + (size_t)(l * 3 + s) * 6144 + (which ? 3072 : 0);
  bf16_t* H = (bf16_t*)(p.ws + OFF_HY) + (size_t)row * 1024;
#pragma unroll
  for (int i = 0; i < 4; ++i) {
    const int k = (i * 64 + lane) * 4;
    const float4 g4 = *(const float4*)(g + k), sh = *(const float4*)(md + k), sc = *(const float4*)(md + 1024 + k);
    u32x2 o; o.x = pack2(v[i].x * rstd * g4.x * (1.f + sc.x) + sh.x, v[i].y * rstd * g4.y * (1.f + sc.y) + sh.y);
    o.y = pack2(v[i].z * rstd * g4.z * (1.f + sc.z) + sh.z, v[i].w * rstd * g4.w * (1.f + sc.w) + sh.w);
    *(u32x2*)(H + k) = o;
  }
}

template <int AMODE, class Epi>
DI void gemm_tile(const bf16_t* __restrict__ A, int lda, const bf16_t* __restrict__ Bt, int ldb, int K, int m0, int n0, char* smem, const float* ssq, Epi epi) {
  bf16_t* As = (bf16_t*)smem; bf16_t* Bs = As + 128 * 72;
  const int tid = ltid(), lane = tid & 63, w = __builtin_amdgcn_readfirstlane(tid >> 6), wm = w >> 1, wn = w & 1, l15 = lane & 15, g4 = lane >> 4;
  u32x4 ar[4], br[4]; float rs[4];
  const int r0 = tid >> 3, cc = tid & 7;
  const bf16_t* ap = A + (size_t)(m0 + r0) * lda + cc * 8;
  const bf16_t* bp = Bt + (size_t)(n0 + r0) * ldb + cc * 8;
  const size_t astep = (size_t)32 * lda, bstep = (size_t)32 * ldb;
  if (AMODE == 1) {
#pragma unroll
    for (int i = 0; i < 4; ++i) { const float* q = ssq + (m0 + r0 + 32 * i); rs[i] = rsqrtf((q[0] + q[NROW] + q[2 * NROW] + q[3 * NROW]) * (1.f / 256.f) + 1e-6f); }
  }
  f32x4 acc[4][4];
#pragma unroll
  for (int i = 0; i < 4; ++i)
#pragma unroll
    for (int j = 0; j < 4; ++j) acc[i][j] = (f32x4){0.f, 0.f, 0.f, 0.f};
#pragma unroll
  for (int i = 0; i < 4; ++i) { ar[i] = *(const u32x4*)(ap + i * astep); br[i] = *(const u32x4*)(bp + i * bstep); }
  const int nk = K >> 6;
  for (int kt = 0; kt < nk; ++kt) {
    if (AMODE == 1 && kt >= 8 && kt < 12) {
#pragma unroll
      for (int i = 0; i < 4; ++i) {
        const float s = rs[i]; u32x4 q = ar[i];
        q.x = pack2(bflo(q.x) * s, bfhi(q.x) * s); q.y = pack2(bflo(q.y) * s, bfhi(q.y) * s);
        q.z = pack2(bflo(q.z) * s, bfhi(q.z) * s); q.w = pack2(bflo(q.w) * s, bfhi(q.w) * s); ar[i] = q;
      }
    }
#pragma unroll
    for (int i = 0; i < 4; ++i) { *(u32x4*)(As + (r0 + 32 * i) * 72 + cc * 8) = ar[i]; *(u32x4*)(Bs + (r0 + 32 * i) * 72 + cc * 8) = br[i]; }
    __syncthreads();
    if (kt + 1 < nk) {
#pragma unroll
      for (int i = 0; i < 4; ++i) { ar[i] = *(const u32x4*)(ap + i * astep + (kt + 1) * 64); br[i] = *(const u32x4*)(bp + i * bstep + (kt + 1) * 64); }
    }
#pragma unroll
    for (int ks = 0; ks < 2; ++ks) {
      bf16x8 af[4], bfr[4];
#pragma unroll
      for (int i = 0; i < 4; ++i) { af[i] = ld_frag(As + (64 * wm + 16 * i + l15) * 72 + ks * 32 + g4 * 8); bfr[i] = ld_frag(Bs + (64 * wn + 16 * i + l15) * 72 + ks * 32 + g4 * 8); }
#pragma unroll
      for (int i = 0; i < 4; ++i)
#pragma unroll
        for (int j = 0; j < 4; ++j) acc[i][j] = MFMA16(bfr[j], af[i], acc[i][j]);
    }
    __syncthreads();
  }
#pragma unroll
  for (int i = 0; i < 4; ++i)
#pragma unroll
    for (int j = 0; j < 4; ++j) epi(m0 + 64 * wm + 16 * i + l15, n0 + 64 * wn + 16 * j + 4 * g4, acc[i][j]);
}

DI void store_bf4(bf16_t* dst, f32x4 v) { u32x2 o; o.x = pack2(v[0], v[1]); o.y = pack2(v[2], v[3]); *(u32x2*)dst = o; }

DI void gemm_in_item(const Params& p, int l, int item, char* smem) {
  const int mt = item / 22, nt = item % 22;
  bf16_t* P = (bf16_t*)(p.ws + OFF_P); float* GML = (float*)(p.ws + OFF_GML); float* DTR = (float*)(p.ws + OFF_DTR);
  gemm_tile<0>((const bf16_t*)(p.ws + OFF_HY), 1024, (const bf16_t*)(p.ws + OFF_WIN) + (size_t)l * 2816 * 1024, 1024, 1024, mt * 128, nt * 128, smem, nullptr,
               [&](int row, int col, f32x4 v) {
                 store_bf4(P + (size_t)row * PINP + col, v);
                 if (col >= 1024 && col < 1040) *(f32x4*)(GML + (size_t)row * 16 + (col - 1024)) = v;
                 if (col >= 2480 && col < 2488) *(f32x4*)(DTR + (size_t)row * 8 + (col - 2480)) = v;
               });
}

DI void tile_rstd(const bf16_t* P, int m0, int col0, int ncols, float* rst) {
  const int tid = ltid(), r = tid >> 1, hf = tid & 1, n = ncols >> 1;
  const bf16_t* src = P + (size_t)(m0 + r) * PINP + col0 + hf * n;
  float ss = 0.f;
  for (int c = 0; c < n; c += 8) { const u32x4 q = *(const u32x4*)(src + c);
    ss += bflo(q.x) * bflo(q.x) + bfhi(q.x) * bfhi(q.x) + bflo(q.y) * bflo(q.y) + bfhi(q.y) * bfhi(q.y) + bflo(q.z) * bflo(q.z) + bfhi(q.z) * bfhi(q.z) + bflo(q.w) * bflo(q.w) + bfhi(q.w) * bfhi(q.w); }
  ss += __shfl_xor(ss, 1);
  if (hf == 0) rst[r] = rsqrtf(ss / (float)ncols + 1e-6f);
  __syncthreads();
}
DI void qproj_item(const Params& p, int l, int item, char* smem) {
  const int mt = item / 3, nt = item % 3; const bf16_t* P = (const bf16_t*)(p.ws + OFF_P);
  float* rst = (float*)(smem + 36864);
  tile_rstd(P, mt * 128, C_CQ, 256, rst);
  bf16_t* Q = (bf16_t*)(p.ws + OFF_QRAW);
  gemm_tile<0>(P + C_CQ, PINP, (const bf16_t*)(p.ws + OFF_WUQ) + (size_t)l * 384 * 256, 256, 256, mt * 128, nt * 128, smem, nullptr,
               [&](int row, int col, f32x4 v) { const float r = rst[row - mt * 128]; store_bf4(Q + (size_t)row * 384 + col, v * r); });
  __syncthreads();
}
DI void kvproj_item(const Params& p, int l, int item, char* smem) {
  const int mt = item / 4, nt = item % 4; const bf16_t* P = (const bf16_t*)(p.ws + OFF_P);
  float* rst = (float*)(smem + 36864);
  tile_rstd(P, mt * 128, C_CKV, 128, rst);
  bf16_t* KH = (bf16_t*)(p.ws + OFF_KH); bf16_t* VT = (bf16_t*)(p.ws + OFF_VT);
  gemm_tile<0>(P + C_CKV, PINP, (const bf16_t*)(p.ws + OFF_WUKV) + (size_t)l * 512 * 128, 128, 128, mt * 128, nt * 128, smem, nullptr,
               [&](int row, int col, f32x4 v) {
                 const float r = rst[row - mt * 128]; v = v * r;
                 const int hh = col >> 7, dd = col & 127;
                 int b, tpos; if (row < NLAT) { b = row / T; tpos = row % T; } else { b = (row - NLAT) / TC; tpos = T + (row - NLAT) % TC; }
                 if (dd < 64) store_bf4(KH + ((size_t)(b * 4 + hh) * TALL + tpos) * 64 + dd, v);
                 else {
                   bf16_t* vp = VT + ((size_t)(b * 4 + hh) * 64 + (dd - 64)) * TALL + tpos;
                   vp[0] = f2bf(v[0]); vp[TALL] = f2bf(v[1]); vp[2 * TALL] = f2bf(v[2]); vp[3 * TALL] = f2bf(v[3]);
                 }
               });
  __syncthreads();
}
DI void rope_cs(int t, int i, float& cs, float& sn) {
  const int pos = (i < 8) ? (t >> 6) : (t & 63); const int f = i & 7;
  const float inv = exp2f(-(float)f * (13.287712379549449f / 8.f));
  const float ang = (float)pos * inv;
  cs = cosf(ang); sn = sinf(ang);
}
DI void ropek_item(const Params& p, int item) {
  const int row = item * 256 + ltid();
  const bf16_t* src = (const bf16_t*)(p.ws + OFF_P) + (size_t)row * PINP + C_KR;
  u32x4 q[4];
#pragma unroll
  for (int i = 0; i < 4; ++i) q[i] = *(const u32x4*)(src + i * 8);
  float v[32];
#pragma unroll
  for (int i = 0; i < 4; ++i) { v[i * 8 + 0] = bflo(q[i].x); v[i * 8 + 1] = bfhi(q[i].x); v[i * 8 + 2] = bflo(q[i].y); v[i * 8 + 3] = bfhi(q[i].y);
    v[i * 8 + 4] = bflo(q[i].z); v[i * 8 + 5] = bfhi(q[i].z); v[i * 8 + 6] = bflo(q[i].w); v[i * 8 + 7] = bfhi(q[i].w); }
  int b, tpos;
  if (row < NLAT) {
    b = row / T; tpos = row % T;
#pragma unroll
    for (int i = 0; i < 16; ++i) { float cs, sn; rope_cs(tpos, i, cs, sn); const float x1 = v[i], x2 = v[i + 16]; v[i] = x1 * cs - x2 * sn; v[i + 16] = x1 * sn + x2 * cs; }
  } else { b = (row - NLAT) / TC; tpos = T + (row - NLAT) % TC; }
  u32x4 o[4];
#pragma unroll
  for (int i = 0; i < 4; ++i) { o[i].x = pack2(v[i * 8], v[i * 8 + 1]); o[i].y = pack2(v[i * 8 + 2], v[i * 8 + 3]); o[i].z = pack2(v[i * 8 + 4], v[i * 8 + 5]); o[i].w = pack2(v[i * 8 + 6], v[i * 8 + 7]); }
  bf16_t* dst = (bf16_t*)(p.ws + OFF_KR) + ((size_t)b * TALL + tpos) * 32;
#pragma unroll
  for (int i = 0; i < 4; ++i) *(u32x4*)(dst + i * 8) = o[i];
}

DI void attn_item(const Params& p, int item, char* smem) {
  const int tid = ltid(), lane = tid & 63, w = __builtin_amdgcn_readfirstlane(tid >> 6), l15 = lane & 15, g4 = lane >> 4;
  int b, h, qt, latent;
  if (item < 512) { latent = 1; qt = item & 63; h = (item >> 6) & 3; b = item >> 8; }
  else { latent = 0; const int i2 = item - 512; qt = i2 & 1; h = (i2 >> 1) & 3; b = i2 >> 3; }
  const int qrow0 = latent ? b * T + qt * 128 : NLAT + b * TC + qt * 128;
  bf16_t* Qs = (bf16_t*)smem;
  bf16_t* Ks = (bf16_t*)smem;
  bf16_t* Vs = Ks + 64 * 104;
  const bf16_t* Qraw = (const bf16_t*)(p.ws + OFF_QRAW);
  const float qscale = 0.10206207261596577f * 1.4426950408889634f;
  for (int id = tid; id < 1280; id += 256) {
    const int r = id / 10, cc = id % 10;
    const bf16_t* src = Qraw + (size_t)(qrow0 + r) * 384 + h * 96 + cc * 8;
    const u32x4 q = *(const u32x4*)src;
    float a[8] = {bflo(q.x), bfhi(q.x), bflo(q.y), bfhi(q.y), bflo(q.z), bfhi(q.z), bflo(q.w), bfhi(q.w)};
    if (cc < 8) {
      u32x4 o; o.x = pack2(a[0] * qscale, a[1] * qscale); o.y = pack2(a[2] * qscale, a[3] * qscale); o.z = pack2(a[4] * qscale, a[5] * qscale); o.w = pack2(a[6] * qscale, a[7] * qscale);
      *(u32x4*)(Qs + r * 104 + cc * 8) = o;
    } else {
      const u32x4 q2 = *(const u32x4*)(src + 16);
      float c2[8] = {bflo(q2.x), bfhi(q2.x), bflo(q2.y), bfhi(q2.y), bflo(q2.z), bfhi(q2.z), bflo(q2.w), bfhi(q2.w)};
      float o1[8], o2[8];
#pragma unroll
      for (int j = 0; j < 8; ++j) {
        float cs = 1.f, sn = 0.f;
        if (latent) rope_cs(qt * 128 + r, (cc - 8) * 8 + j, cs, sn);
        o1[j] = (a[j] * cs - c2[j] * sn) * qscale; o2[j] = (a[j] * sn + c2[j] * cs) * qscale;
      }
      u32x4 o; o.x = pack2(o1[0], o1[1]); o.y = pack2(o1[2], o1[3]); o.z = pack2(o1[4], o1[5]); o.w = pack2(o1[6], o1[7]);
      *(u32x4*)(Qs + r * 104 + cc * 8) = o;
      o.x = pack2(o2[0], o2[1]); o.y = pack2(o2[2], o2[3]); o.z = pack2(o2[4], o2[5]); o.w = pack2(o2[6], o2[7]);
      *(u32x4*)(Qs + r * 104 + cc * 8 + 16) = o;
    }
  }
  __syncthreads();
  bf16x8 qf[2][3];
#pragma unroll
  for (int qs = 0; qs < 2; ++qs)
#pragma unroll
    for (int ks = 0; ks < 3; ++ks) qf[qs][ks] = ld_frag(Qs + (32 * w + 16 * qs + l15) * 104 + ks * 32 + g4 * 8);
  __syncthreads();
  const int kt0 = latent ? 0 : 128, kt1 = 132;
  const bf16_t* Kg = (const bf16_t*)(p.ws + OFF_KH) + (size_t)(b * 4 + h) * TALL * 64;
  const bf16_t* Rg = (const bf16_t*)(p.ws + OFF_KR) + (size_t)b * TALL * 32;
  const bf16_t* Vg = (const bf16_t*)(p.ws + OFF_VT) + (size_t)(b * 4 + h) * 64 * TALL;
  u32x4 kr[3], vr[2];
  const int ve0 = tid >> 3, vc = tid & 7;
  {
    kr[0] = *(const u32x4*)(Kg + (size_t)kt0 * 4096 + tid * 8); kr[1] = *(const u32x4*)(Kg + (size_t)kt0 * 4096 + (tid + 256) * 8);
    kr[2] = *(const u32x4*)(Rg + (size_t)kt0 * 2048 + tid * 8);
#pragma unroll
    for (int i = 0; i < 2; ++i) vr[i] = *(const u32x4*)(Vg + (size_t)(ve0 + 32 * i) * TALL + kt0 * 64 + vc * 8);
  }
  float mrun[2] = {-1e30f, -1e30f}, lsum[2] = {0.f, 0.f};
  f32x4 O[4][2];
#pragma unroll
  for (int es = 0; es < 4; ++es)
#pragma unroll
    for (int qs = 0; qs < 2; ++qs) O[es][qs] = (f32x4){0.f, 0.f, 0.f, 0.f};
  for (int kt = kt0; kt < kt1; ++kt) {
    __syncthreads();
#pragma unroll
    for (int i = 0; i < 2; ++i) { const int id = tid + 256 * i; *(u32x4*)(Ks + (id >> 3) * 104 + (id & 7) * 8) = kr[i]; }
    *(u32x4*)(Ks + (tid >> 2) * 104 + 64 + (tid & 3) * 8) = kr[2];
#pragma unroll
    for (int i = 0; i < 2; ++i) *(u32x4*)(Vs + (ve0 + 32 * i) * 72 + vc * 8) = vr[i];
    __syncthreads();
    if (kt + 1 < kt1) {
      kr[0] = *(const u32x4*)(Kg + (size_t)(kt + 1) * 4096 + tid * 8); kr[1] = *(const u32x4*)(Kg + (size_t)(kt + 1) * 4096 + (tid + 256) * 8);
      kr[2] = *(const u32x4*)(Rg + (size_t)(kt + 1) * 2048 + tid * 8);
#pragma unroll
      for (int i = 0; i < 2; ++i) vr[i] = *(const u32x4*)(Vg + (size_t)(ve0 + 32 * i) * TALL + (kt + 1) * 64 + vc * 8);
    }
    f32x4 sa[4][2];
#pragma unroll
    for (int kb = 0; kb < 4; ++kb)
#pragma unroll
      for (int qs = 0; qs < 2; ++qs) sa[kb][qs] = (f32x4){0.f, 0.f, 0.f, 0.f};
#pragma unroll
    for (int ks = 0; ks < 3; ++ks)
#pragma unroll
      for (int kb = 0; kb < 4; ++kb) {
        const bf16x8 a = ld_frag(Ks + (16 * kb + l15) * 104 + ks * 32 + g4 * 8);
#pragma unroll
        for (int qs = 0; qs < 2; ++qs) sa[kb][qs] = MFMA16(a, qf[qs][ks], sa[kb][qs]);
      }
    bf16x8 pf[2][2];
#pragma unroll
    for (int qs = 0; qs < 2; ++qs) {
      float mx = -1e30f;
#pragma unroll
      for (int kb = 0; kb < 4; ++kb)
#pragma unroll
        for (int j = 0; j < 4; ++j) mx = fmaxf(mx, sa[kb][qs][j]);
      mx = fmaxf(mx, __shfl_xor(mx, 16)); mx = fmaxf(mx, __shfl_xor(mx, 32));
      const float mnew = fmaxf(mrun[qs], mx), alpha = exp2f(mrun[qs] - mnew);
      mrun[qs] = mnew;
      float ps = 0.f;
#pragma unroll
      for (int kb = 0; kb < 4; ++kb)
#pragma unroll
        for (int j = 0; j < 4; ++j) { const float e = exp2f(sa[kb][qs][j] - mnew); sa[kb][qs][j] = e; ps += e; }
      lsum[qs] = lsum[qs] * alpha + ps;
#pragma unroll
      for (int es = 0; es < 4; ++es) O[es][qs] = O[es][qs] * alpha;
#pragma unroll
      for (int k2 = 0; k2 < 2; ++k2)
        pf[qs][k2] = mk_frag(pack2(sa[2 * k2][qs][0], sa[2 * k2][qs][1]), pack2(sa[2 * k2][qs][2], sa[2 * k2][qs][3]),
                             pack2(sa[2 * k2 + 1][qs][0], sa[2 * k2 + 1][qs][1]), pack2(sa[2 * k2 + 1][qs][2], sa[2 * k2 + 1][qs][3]));
    }
#pragma unroll
    for (int k2 = 0; k2 < 2; ++k2)
#pragma unroll
      for (int es = 0; es < 4; ++es) {
        const bf16_t* vp = Vs + (16 * es + l15) * 72 + 32 * k2 + 4 * g4;
        const u32x2 lo = *(const u32x2*)vp, hi = *(const u32x2*)(vp + 16);
        const bf16x8 a = mk_frag(lo.x, lo.y, hi.x, hi.y);
#pragma unroll
        for (int qs = 0; qs < 2; ++qs) O[es][qs] = MFMA16(a, pf[qs][k2], O[es][qs]);
      }
  }
  bf16_t* Y = (bf16_t*)(p.ws + OFF_HY);
#pragma unroll
  for (int qs = 0; qs < 2; ++qs) {
    float l = lsum[qs]; l += __shfl_xor(l, 16); l += __shfl_xor(l, 32);
    const float inv = 1.f / l;
    const int row = qrow0 + 32 * w + 16 * qs + l15;
#pragma unroll
    for (int es = 0; es < 4; ++es) store_bf4(Y + (size_t)row * 1024 + 256 + h * 64 + 16 * es + 4 * g4, O[es][qs] * inv);
  }
  __syncthreads();
}

DI void chunk_geom(int tcg, int b, int& part, int& tc, int& row0) { part = tcg >= 128; tc = part ? tcg - 128 : tcg; row0 = row_of(b, part, tc * 64); }
DI int chain_slot(int dir, int part, int tc) { return dir ? (part ? 3 - tc : 131 - tc) : (part ? tc : 4 + tc); }

DI void mlstm_p1(const Params& p, int l, int item, char* smem) {
  const int tid = ltid(), lane = tid & 63, w = __builtin_amdgcn_readfirstlane(tid >> 6), l15 = lane & 15, g4 = lane >> 4;
  const int tcg = item % NCH; int r = item / NCH; const int dir = r & 1; r >>= 1; const int h = r & 3, b = r >> 2;
  int part, tc, row0; chunk_geom(tcg, b, part, tc, row0);
  const int c = chain_slot(dir, part, tc), chain = (b * 4 + h) * 2 + dir;
  bf16_t* A = (bf16_t*)smem;
  bf16_t* Bk = A + 80 * 72;
  float* fs = (float*)(Bk + 64 * 72);
  const bf16_t* P = (const bf16_t*)(p.ws + OFF_P); const float* GML = (const float*)(p.ws + OFF_GML);
  float* MLM = (float*)(p.ws + OFF_MLM) + (size_t)(chain * NCH + c) * 32;
  if (tid < 64) {
    const int gi = 2 * dir;
    const float ig = GML[(size_t)(row0 + tid) * 16 + gi * 4 + h] + p.ml_gate_bias[l * 16 + gi * 4 + h];
    const float fg = GML[(size_t)(row0 + tid) * 16 + (gi + 1) * 4 + h] + p.ml_gate_bias[l * 16 + (gi + 1) * 4 + h];
    const float lf = logsigm_f(fg);
    const float pre = wave_incl_scan(lf, lane), tot = __shfl(pre, 63);
    const float bc = dir ? tot - pre + lf : pre;
    const float wlog = tot - bc + ig, mloc = wave_max(wlog), wv = __expf(wlog - mloc);
    fs[tid] = wv; A[64 * 72 + tid] = f2bf(wv);
    if (tid == 0) { MLM[0] = mloc; MLM[1] = tot; }
  }
  for (int i = tid; i < 15 * 72; i += 256) A[65 * 72 + i] = 0;
  __syncthreads();
  {
    const int s = tid >> 2, d0 = (tid & 3) * 16; const float wv = fs[s];
    const bf16_t* kp = P + (size_t)(row0 + s) * PINP + C_MLK + h * 64 + d0;
    const bf16_t* vp = P + (size_t)(row0 + s) * PINP + C_MLV + h * 64 + d0;
#pragma unroll
    for (int hf = 0; hf < 2; ++hf) {
      const u32x4 kq = *(const u32x4*)(kp + hf * 8), vq = *(const u32x4*)(vp + hf * 8);
      const float kk[8] = {bflo(kq.x), bfhi(kq.x), bflo(kq.y), bfhi(kq.y), bflo(kq.z), bfhi(kq.z), bflo(kq.w), bfhi(kq.w)};
      const float vv[8] = {bflo(vq.x), bfhi(vq.x), bflo(vq.y), bfhi(vq.y), bflo(vq.z), bfhi(vq.z), bflo(vq.w), bfhi(vq.w)};
#pragma unroll
      for (int j = 0; j < 8; ++j) { Bk[(d0 + hf * 8 + j) * 72 + s] = f2bf(kk[j] * 0.125f); A[(d0 + hf * 8 + j) * 72 + s] = f2bf(vv[j] * wv); }
    }
  }
  __syncthreads();
  float* MLS = (float*)(p.ws + OFF_MLS) + (size_t)(chain * NCH + c) * 4160;
  for (int t = w; t < 20; t += 4) {
    const int ms = t >> 2, ns = t & 3;
    f32x4 acc = {0.f, 0.f, 0.f, 0.f};
#pragma unroll
    for (int ks = 0; ks < 2; ++ks) acc = MFMA16(ld_frag(A + (16 * ms + l15) * 72 + ks * 32 + g4 * 8), ld_frag(Bk + (16 * ns + l15) * 72 + ks * 32 + g4 * 8), acc);
#pragma unroll
    for (int j = 0; j < 4; ++j) { const int e = 16 * ms + 4 * g4 + j; if (e <= 64) MLS[e * 64 + 16 * ns + l15] = acc[j]; }
  }
  __syncthreads();
}
DI void mlstm_p2(const Params& p, int item) {
  const int gi = item * 256 + ltid(), chain = gi / 4160, e = gi % 4160;
  float* MLS = (float*)(p.ws + OFF_MLS) + (size_t)chain * NCH * 4160 + e;
  float* MLM = (float*)(p.ws + OFF_MLM) + (size_t)chain * NCH * 32;
  float C = 0.f, m = 0.f;
  for (int c0 = 0; c0 < NCH; c0 += 12) {
    float d[12], ml[12], bl[12];
#pragma unroll
    for (int i = 0; i < 12; ++i) { d[i] = MLS[(size_t)(c0 + i) * 4160]; ml[i] = MLM[(c0 + i) * 32]; bl[i] = MLM[(c0 + i) * 32 + 1]; }
#pragma unroll
    for (int i = 0; i < 12; ++i) {
      MLS[(size_t)(c0 + i) * 4160] = C; if (e == 0) MLM[(c0 + i) * 32 + 16] = m;
      const float mn = fmaxf(bl[i] + m, ml[i]);
      C = __expf(bl[i] + m - mn) * C + __expf(ml[i] - mn) * d[i]; m = mn;
    }
  }
}
DI void mlstm_p3(const Params& p, int l, int item, char* smem) {
  const int tid = ltid(), lane = tid & 63, w = __builtin_amdgcn_readfirstlane(tid >> 6), l15 = lane & 15, g4 = lane >> 4;
  const int h = item & 3; const int r = item >> 2; const int tcg = r % NCH, b = r / NCH;
  int part, tc, row0; chunk_geom(tcg, b, part, tc, row0);
  bf16_t* Qs = (bf16_t*)smem;
  bf16_t* Ks = Qs + 64 * 72;
  bf16_t* Vt = Ks + 64 * 72;
  bf16_t* Sb = Vt + 64 * 72;
  float* fb = (float*)(Sb + 64 * 72);
  float* fi = fb + 64;
  const bf16_t* P = (const bf16_t*)(p.ws + OFF_P); const float* GML = (const float*)(p.ws + OFF_GML);
  {
    const int s = tid >> 2, d0 = (tid & 3) * 16;
    const bf16_t* base = P + (size_t)(row0 + s) * PINP + h * 64 + d0;
#pragma unroll
    for (int hf = 0; hf < 2; ++hf) {
      *(u32x4*)(Qs + s * 72 + d0 + hf * 8) = *(const u32x4*)(base + C_MLQ + hf * 8);
      const u32x4 kq = *(const u32x4*)(base + C_MLK + hf * 8), vq = *(const u32x4*)(base + C_MLV + hf * 8);
      u32x4 ko; ko.x = pack2(bflo(kq.x) * 0.125f, bfhi(kq.x) * 0.125f); ko.y = pack2(bflo(kq.y) * 0.125f, bfhi(kq.y) * 0.125f);
      ko.z = pack2(bflo(kq.z) * 0.125f, bfhi(kq.z) * 0.125f); ko.w = pack2(bflo(kq.w) * 0.125f, bfhi(kq.w) * 0.125f);
      *(u32x4*)(Ks + s * 72 + d0 + hf * 8) = ko;
      const unsigned vw[4] = {vq.x, vq.y, vq.z, vq.w};
#pragma unroll
      for (int j = 0; j < 4; ++j) { Vt[(d0 + hf * 8 + 2 * j) * 72 + s] = (bf16_t)(vw[j] & 0xffffu); Vt[(d0 + hf * 8 + 2 * j + 1) * 72 + s] = (bf16_t)(vw[j] >> 16); }
    }
  }
  f32x4 hs[4];
#pragma unroll
  for (int ns = 0; ns < 4; ++ns) hs[ns] = (f32x4){0.f, 0.f, 0.f, 0.f};
#pragma unroll 1
  for (int dir = 0; dir < 2; ++dir) {
    const int c = chain_slot(dir, part, tc), chain = (b * 4 + h) * 2 + dir;
    const float m_in = ((const float*)(p.ws + OFF_MLM))[(size_t)(chain * NCH + c) * 32 + 16];
    const float* Cst = (const float*)(p.ws + OFF_MLS) + (size_t)(chain * NCH + c) * 4160;
    __syncthreads();
    if (tid < 64) {
      const int gi = 2 * dir;
      const float ig = GML[(size_t)(row0 + tid) * 16 + gi * 4 + h] + p.ml_gate_bias[l * 16 + gi * 4 + h];
      const float fg = GML[(size_t)(row0 + tid) * 16 + (gi + 1) * 4 + h] + p.ml_gate_bias[l * 16 + (gi + 1) * 4 + h];
      const float lf = logsigm_f(fg);
      const float pre = wave_incl_scan(lf, lane), tot = __shfl(pre, 63);
      fb[tid] = dir ? tot - pre + lf : pre; fi[tid] = ig;
    }
    __syncthreads();
    f32x4 sc[4];
#pragma unroll
    for (int ns = 0; ns < 4; ++ns) {
      f32x4 a = {0.f, 0.f, 0.f, 0.f};
#pragma unroll
      for (int ks = 0; ks < 2; ++ks) a = MFMA16(ld_frag(Qs + (16 * w + l15) * 72 + ks * 32 + g4 * 8), ld_frag(Ks + (16 * ns + l15) * 72 + ks * 32 + g4 * 8), a);
      sc[ns] = a;
    }
    float bi[4], mt[4], rsum[4];
#pragma unroll
    for (int j = 0; j < 4; ++j) {
      const int i = 16 * w + 4 * g4 + j; bi[j] = fb[i];
      float mx = -1e30f;
#pragma unroll
      for (int ns = 0; ns < 4; ++ns) { const int s = 16 * ns + l15; const bool ok = dir ? (s >= i) : (s <= i); const float dm = bi[j] - fb[s] + fi[s]; if (ok) mx = fmaxf(mx, dm); }
      mx = red16_max(mx);
      mt[j] = fmaxf(bi[j] + m_in, mx);
      float rs = 0.f;
#pragma unroll
      for (int ns = 0; ns < 4; ++ns) {
        const int s = 16 * ns + l15; const bool ok = dir ? (s >= i) : (s <= i);
        const float v = ok ? sc[ns][j] * __expf(bi[j] - fb[s] + fi[s] - mt[j]) : 0.f;
        rs += v; Sb[i * 72 + s] = f2bf(v);
      }
      rsum[j] = red16_sum(rs);
    }
    __syncthreads();
    f32x4 qc[5];
#pragma unroll
    for (int ns = 0; ns < 5; ++ns) {
      f32x4 a = {0.f, 0.f, 0.f, 0.f};
      const int e = 16 * ns + l15;
#pragma unroll
      for (int ks = 0; ks < 2; ++ks) {
        bf16x8 bfm;
        if (e <= 64) bfm = frag_from_f32(Cst + e * 64 + ks * 32 + g4 * 8, 1.f); else bfm = mk_frag(0u, 0u, 0u, 0u);
        a = MFMA16(ld_frag(Qs + (16 * w + l15) * 72 + ks * 32 + g4 * 8), bfm, a);
      }
      qc[ns] = a;
    }
    f32x4 nm[4];
#pragma unroll
    for (int ns = 0; ns < 4; ++ns) {
      f32x4 a = {0.f, 0.f, 0.f, 0.f};
#pragma unroll
      for (int ks = 0; ks < 2; ++ks) a = MFMA16(ld_frag(Sb + (16 * w + l15) * 72 + ks * 32 + g4 * 8), ld_frag(Vt + (16 * ns + l15) * 72 + ks * 32 + g4 * 8), a);
      nm[ns] = a;
    }
#pragma unroll
    for (int j = 0; j < 4; ++j) {
      const float wi = __expf(bi[j] + m_in - mt[j]);
      const float qn = __shfl(qc[4][j], lane & 48);
      const float den = rsum[j] + wi * qn;
      const float dd = 1.f / fmaxf(fabsf(den), __expf(-mt[j]));
#pragma unroll
      for (int ns = 0; ns < 4; ++ns) hs[ns][j] += (nm[ns][j] + wi * qc[ns][j]) * dd;
    }
  }
  bf16_t* Y = (bf16_t*)(p.ws + OFF_HY);
#pragma unroll
  for (int j = 0; j < 4; ++j) {
    float ss = 0.f;
#pragma unroll
    for (int ns = 0; ns < 4; ++ns) ss += hs[ns][j] * hs[ns][j];
    ss = red16_sum(ss);
    const float rstd = rsqrtf(ss * (1.f / 64.f) + 1e-6f);
    const int row = row0 + 16 * w + 4 * g4 + j;
#pragma unroll
    for (int ns = 0; ns < 4; ++ns) {
      const int ch = h * 64 + 16 * ns + l15;
      const float o = bf2f(P[(size_t)row * PINP + C_MLO + ch]);
      Y[(size_t)row * 1024 + ch] = f2bf(hs[ns][j] * rstd * p.ml_norm[l * 256 + ch] * sigm_f(o));
    }
  }
  __syncthreads();
}

DI void conv_silu8(const Params& p, int l, const bf16_t* P, int row, bool hp, bool hn, int ch, float* out) {
  const bf16_t* src = P + (size_t)row * PINP + C_XBC + ch;
  const u32x4 z = {0u, 0u, 0u, 0u};
  const u32x4 c0 = *(const u32x4*)src, pm = hp ? *(const u32x4*)(src - PINP) : z, nx = hn ? *(const u32x4*)(src + PINP) : z;
  const float* cw = p.ssd_conv_w + (size_t)l * 3 * 768 + ch; const float* cb = p.ssd_conv_b + l * 768 + ch;
  const float a[8] = {bflo(pm.x), bfhi(pm.x), bflo(pm.y), bfhi(pm.y), bflo(pm.z), bfhi(pm.z), bflo(pm.w), bfhi(pm.w)};
  const float m[8] = {bflo(c0.x), bfhi(c0.x), bflo(c0.y), bfhi(c0.y), bflo(c0.z), bfhi(c0.z), bflo(c0.w), bfhi(c0.w)};
  const float n[8] = {bflo(nx.x), bfhi(nx.x), bflo(nx.y), bfhi(nx.y), bflo(nx.z), bfhi(nx.z), bflo(nx.w), bfhi(nx.w)};
#pragma unroll
  for (int j = 0; j < 8; ++j) out[j] = silu_f(cb[j] + cw[j] * a[j] + cw[768 + j] * m[j] + cw[1536 + j] * n[j]);
}
DI void ssd_gates(const Params& p, int l, int dir, int h, int row0, int tid, int lane, float& dt, float& cs, float& tot) {
  const float* DTR = (const float*)(p.ws + OFF_DTR);
  dt = softplus_f(DTR[(size_t)(row0 + tid) * 8 + dir * 4 + h] + p.ssd_dt_bias[l * 8 + dir * 4 + h]);
  const float la = -dt * __expf(p.ssd_a_log[l * 8 + dir * 4 + h]);
  const float pre = wave_incl_scan(la, lane); tot = __shfl(pre, 63);
  cs = dir ? tot - pre + la : pre;
}
DI void ssd_p1(const Params& p, int l, int item, char* smem) {
  const int tid = ltid(), lane = tid & 63, w = __builtin_amdgcn_readfirstlane(tid >> 6), l15 = lane & 15, g4 = lane >> 4;
  const int tcg = item % NCH; int r = item / NCH; const int dir = r & 1; r >>= 1; const int h = r & 3, b = r >> 2;
  int part, tc, row0; chunk_geom(tcg, b, part, tc, row0);
  const int c = chain_slot(dir, part, tc), chain = (b * 4 + h) * 2 + dir, lastc = part ? 3 : 127;
  bf16_t* Xt = (bf16_t*)smem;
  bf16_t* Bt = Xt + 64 * 72;
  float* fs = (float*)(Bt + 128 * 72);
  const bf16_t* P = (const bf16_t*)(p.ws + OFF_P);
  if (tid < 64) {
    float dt, cs, tot; ssd_gates(p, l, dir, h, row0, tid, lane, dt, cs, tot);
    fs[tid] = __expf(tot - cs) * dt;
    if (tid == 0) ((float*)(p.ws + OFF_SSA))[(chain * NCH + c) * 32] = tot;
  }
  __syncthreads();
  const int grp = h >> 1;
  for (int id = tid; id < 64 * 24; id += 256) {
    const int s = id / 24, cc = id % 24;
    const bool hp = !(tc == 0 && s == 0), hn = !(tc == lastc && s == 63);
    float v[8];
    if (cc < 8) { conv_silu8(p, l, P, row0 + s, hp, hn, h * 64 + cc * 8, v); const float wv = fs[s];
#pragma unroll
      for (int j = 0; j < 8; ++j) Xt[(cc * 8 + j) * 72 + s] = f2bf(v[j] * wv); }
    else { const int n0 = (cc - 8) * 8; conv_silu8(p, l, P, row0 + s, hp, hn, 256 + grp * 128 + n0, v);
#pragma unroll
      for (int j = 0; j < 8; ++j) Bt[(n0 + j) * 72 + s] = f2bf(v[j]); }
  }
  __syncthreads();
  float* SS = (float*)(p.ws + OFF_SSDS) + (size_t)(chain * NCH + c) * 8192;
#pragma unroll
  for (int ns = 0; ns < 8; ++ns) {
    f32x4 acc = {0.f, 0.f, 0.f, 0.f};
#pragma unroll
    for (int ks = 0; ks < 2; ++ks) acc = MFMA16(ld_frag(Xt + (16 * w + l15) * 72 + ks * 32 + g4 * 8), ld_frag(Bt + (16 * ns + l15) * 72 + ks * 32 + g4 * 8), acc);
#pragma unroll
    for (int j = 0; j < 4; ++j) SS[(16 * w + 4 * g4 + j) * 128 + 16 * ns + l15] = acc[j];
  }
  __syncthreads();
}
DI void ssd_p2(const Params& p, int item) {
  const int gi = item * 256 + ltid(), chain = gi >> 13, e = gi & 8191;
  float* SS = (float*)(p.ws + OFF_SSDS) + (size_t)chain * NCH * 8192 + e;
  const float* SA = (const float*)(p.ws + OFF_SSA) + (size_t)chain * NCH * 32;
  float S = 0.f;
  for (int c0 = 0; c0 < NCH; c0 += 12) {
    float d[12], a[12];
#pragma unroll
    for (int i = 0; i < 12; ++i) { d[i] = SS[(size_t)(c0 + i) * 8192]; a[i] = SA[(c0 + i) * 32]; }
#pragma unroll
    for (int i = 0; i < 12; ++i) { SS[(size_t)(c0 + i) * 8192] = S; S = __expf(a[i]) * S + d[i]; }
  }
}
DI void ssd_p3(const Params& p, int l, int item, char* smem) {
  const int tid = ltid(), lane = tid & 63, w = __builtin_amdgcn_readfirstlane(tid >> 6), l15 = lane & 15, g4 = lane >> 4;
  const int h = item & 3; const int r = item >> 2; const int tcg = r % NCH, b = r / NCH;
  int part, tc, row0; chunk_geom(tcg, b, part, tc, row0);
  const int lastc = part ? 3 : 127, grp = h >> 1;
  bf16_t* Cm = (bf16_t*)smem;
  bf16_t* Bm = Cm + 64 * 136;
  bf16_t* Xt = Bm + 64 * 136;
  bf16_t* Sb = Xt + 64 * 72;
  float* fcs = (float*)(Sb + 64 * 72);
  float* fdt = fcs + 64;
  const bf16_t* P = (const bf16_t*)(p.ws + OFF_P);
  for (int id = tid; id < 64 * 40; id += 256) {
    const int s = id / 40, cc = id % 40;
    const bool hp = !(tc == 0 && s == 0), hn = !(tc == lastc && s == 63);
    float v[8];
    if (cc < 8) { conv_silu8(p, l, P, row0 + s, hp, hn, h * 64 + cc * 8, v);
#pragma unroll
      for (int j = 0; j < 8; ++j) Xt[(cc * 8 + j) * 72 + s] = f2bf(v[j]); }
    else {
      const int q = cc - 8, isC = q >= 16, n0 = (q & 15) * 8;
      conv_silu8(p, l, P, row0 + s, hp, hn, 256 + isC * 256 + grp * 128 + n0, v);
      u32x4 o; o.x = pack2(v[0], v[1]); o.y = pack2(v[2], v[3]); o.z = pack2(v[4], v[5]); o.w = pack2(v[6], v[7]);
      *(u32x4*)((isC ? Cm : Bm) + s * 136 + n0) = o;
    }
  }
  f32x4 ys[4];
#pragma unroll
  for (int ns = 0; ns < 4; ++ns) ys[ns] = (f32x4){0.f, 0.f, 0.f, 0.f};
#pragma unroll 1
  for (int dir = 0; dir < 2; ++dir) {
    const int c = chain_slot(dir, part, tc), chain = (b * 4 + h) * 2 + dir;
    const float* St = (const float*)(p.ws + OFF_SSDS) + (size_t)(chain * NCH + c) * 8192;
    __syncthreads();
    if (tid < 64) { float dt, cs, tot; ssd_gates(p, l, dir, h, row0, tid, lane, dt, cs, tot); fcs[tid] = cs; fdt[tid] = dt; }
    __syncthreads();
    float ci[4];
#pragma unroll
    for (int j = 0; j < 4; ++j) ci[j] = fcs[16 * w + 4 * g4 + j];
#pragma unroll
    for (int ns = 0; ns < 4; ++ns) {
      f32x4 a = {0.f, 0.f, 0.f, 0.f};
#pragma unroll
      for (int ks = 0; ks < 4; ++ks) a = MFMA16(ld_frag(Cm + (16 * w + l15) * 136 + ks * 32 + g4 * 8), ld_frag(Bm + (16 * ns + l15) * 136 + ks * 32 + g4 * 8), a);
      const int s = 16 * ns + l15; const float css = fcs[s], dts = fdt[s];
#pragma unroll
      for (int j = 0; j < 4; ++j) {
        const int i = 16 * w + 4 * g4 + j; const bool ok = dir ? (s >= i) : (s <= i);
        Sb[i * 72 + s] = f2bf(ok ? a[j] * __expf(ci[j] - css) * dts : 0.f);
      }
    }
    __syncthreads();
#pragma unroll
    for (int ns = 0; ns < 4; ++ns) {
      f32x4 a = {0.f, 0.f, 0.f, 0.f}, bq = {0.f, 0.f, 0.f, 0.f};
#pragma unroll
      for (int ks = 0; ks < 2; ++ks) a = MFMA16(ld_frag(Sb + (16 * w + l15) * 72 + ks * 32 + g4 * 8), ld_frag(Xt + (16 * ns + l15) * 72 + ks * 32 + g4 * 8), a);
#pragma unroll
      for (int ks = 0; ks < 4; ++ks) bq = MFMA16(ld_frag(Cm + (16 * w + l15) * 136 + ks * 32 + g4 * 8), frag_from_f32(St + (16 * ns + l15) * 128 + ks * 32 + g4 * 8, 1.f), bq);
#pragma unroll
      for (int j = 0; j < 4; ++j) ys[ns][j] += a[j] + __expf(ci[j]) * bq[j];
    }
  }
  bf16_t* Y = (bf16_t*)(p.ws + OFF_HY); float* SSQ = (float*)(p.ws + OFF_SSQ);
  const float dsk = p.ssd_d[l * 4 + h];
#pragma unroll
  for (int j = 0; j < 4; ++j) {
    const int i = 16 * w + 4 * g4 + j, row = row0 + i; float ss = 0.f;
#pragma unroll
    for (int ns = 0; ns < 4; ++ns) {
      const int pp = 16 * ns + l15;
      const float xv = bf2f(Xt[pp * 72 + i]);
      const float z = bf2f(P[(size_t)row * PINP + C_Z + h * 64 + pp]);
      const float g = (ys[ns][j] + dsk * xv) * silu_f(z);
      ss += g * g; Y[(size_t)row * 1024 + 512 + h * 64 + pp] = f2bf(g);
    }
    ss = red16_sum(ss);
    if (l15 == 0) SSQ[(size_t)h * NROW + row] = ss;
  }
  __syncthreads();
}

struct S5Par { float are, aim, bre[16], bim[16]; };
DI void s5_params(const Params& p, int l, int dir, int g, int n, S5Par& q, float& dtv, float& lre, float& lim) {
  const int ai = ((l * 2 + dir) * 16 + g) * 64 + n;
  lre = fminf(p.s5_a_re[ai], -1e-4f); lim = p.s5_a_im[ai];
  dtv = __expf(p.s5_log_dt[(l * 2 + dir) * 16 + g]);
  const float mag = __expf(lre * dtv), ang = lim * dtv;
  q.are = mag * cosf(ang); q.aim = mag * sinf(ang);
  const float den = lre * lre + lim * lim;
  const float fre = ((q.are - 1.f) * lre + q.aim * lim) / den, fim = (q.aim * lre - (q.are - 1.f) * lim) / den;
  const float* br = p.s5_b_re + ((size_t)(l * 16 + g) * 64 + n) * 16; const float* bi = p.s5_b_im + ((size_t)(l * 16 + g) * 64 + n) * 16;
#pragma unroll
  for (int j = 0; j < 16; ++j) { q.bre[j] = fre * br[j] - fim * bi[j]; q.bim[j] = fre * bi[j] + fim * br[j]; }
}
DI void s5_step(const S5Par& q, const bf16_t* us, int s, float& xr, float& xi) {
  const u32x4 a0 = *(const u32x4*)(us + s * 16), a1 = *(const u32x4*)(us + s * 16 + 8);
  const unsigned uw[8] = {a0.x, a0.y, a0.z, a0.w, a1.x, a1.y, a1.z, a1.w};
  float br = 0.f, bi = 0.f;
#pragma unroll
  for (int j = 0; j < 8; ++j) { const float a = bflo(uw[j]), c = bfhi(uw[j]); br += q.bre[2 * j] * a + q.bre[2 * j + 1] * c; bi += q.bim[2 * j] * a + q.bim[2 * j + 1] * c; }
  const float nr = q.are * xr - q.aim * xi + br, ni = q.are * xi + q.aim * xr + bi;
  xr = nr; xi = ni;
}
DI void s5_p1(const Params& p, int l, int item, char* smem) {
  const int lane = ltid() & 63, wi = item * 4 + __builtin_amdgcn_readfirstlane(ltid() >> 6);
  const int tcg = wi % NCH; int r = wi / NCH; const int dir = r & 1; r >>= 1; const int g = r & 15, b = r >> 4;
  int part, tc, row0; chunk_geom(tcg, b, part, tc, row0);
  const int c = chain_slot(dir, part, tc);
  S5Par q; float dtv, lre, lim; s5_params(p, l, dir, g, lane, q, dtv, lre, lim);
  const bf16_t* up = (const bf16_t*)(p.ws + OFF_P) + (size_t)(row0 + lane) * PINP + C_S5 + g * 16;
  bf16_t* us = (bf16_t*)smem + __builtin_amdgcn_readfirstlane(ltid() >> 6) * 1024;
  *(u32x4*)(us + lane * 16) = *(const u32x4*)up; *(u32x4*)(us + lane * 16 + 8) = *(const u32x4*)(up + 8);
  float xr = 0.f, xi = 0.f;
  for (int st = 0; st < 64; ++st) { const int s = dir ? 63 - st : st; s5_step(q, us, s, xr, xi); }
  float* S = (float*)(p.ws + OFF_S5S) + ((size_t)((b * 16 + g) * 2 + dir) * NCH + c) * 128;
  S[lane] = xr; S[64 + lane] = xi;
}
DI void s5_p2(const Params& p, int l, int item) {
  const int gi = item * 256 + ltid(), n = gi & 63, dir = (gi >> 6) & 1, g = (gi >> 7) & 15, b = gi >> 11;
  const int ai = ((l * 2 + dir) * 16 + g) * 64 + n;
  const float lre = fminf(p.s5_a_re[ai], -1e-4f), lim = p.s5_a_im[ai], dtv = __expf(p.s5_log_dt[(l * 2 + dir) * 16 + g]);
  const float mag = __expf(64.f * lre * dtv), ang = 64.f * (lim * dtv);
  const float ar = mag * cosf(ang), aim = mag * sinf(ang);
  float* S = (float*)(p.ws + OFF_S5S) + (size_t)((b * 16 + g) * 2 + dir) * NCH * 128 + n;
  float xr = 0.f, xi = 0.f;
  for (int c0 = 0; c0 < NCH; c0 += 12) {
    float dr[12], di[12];
#pragma unroll
    for (int i = 0; i < 12; ++i) { dr[i] = S[(c0 + i) * 128]; di[i] = S[(c0 + i) * 128 + 64]; }
#pragma unroll
    for (int i = 0; i < 12; ++i) { S[(c0 + i) * 128] = xr; S[(c0 + i) * 128 + 64] = xi; const float nr = ar * xr - aim * xi + dr[i], ni = ar * xi + aim * xr + di[i]; xr = nr; xi = ni; }
  }
}
DI void s5_p3(const Params& p, int l, int item, char* smem) {
  const int tid = ltid(), lane = tid & 63, w = __builtin_amdgcn_readfirstlane(tid >> 6), l15 = lane & 15, g4 = lane >> 4;
  const int tcg = item % NCH, b = item / NCH;
  int part, tc, row0; chunk_geom(tcg, b, part, tc, row0);
  bf16_t* xs = (bf16_t*)smem + w * (16 * 136);
  bf16_t* yg = (bf16_t*)smem + 4 * 16 * 136;
  const bf16_t* P = (const bf16_t*)(p.ws + OFF_P);
#pragma unroll 1
  for (int gi = 0; gi < 4; ++gi) {
    const int g = w + 4 * gi;
    const bf16_t* up = P + (size_t)(row0 + lane) * PINP + C_S5 + g * 16;
    bf16_t* us = (bf16_t*)smem + 25600 + w * 1024;
    *(u32x4*)(us + lane * 16) = *(const u32x4*)up; *(u32x4*)(us + lane * 16 + 8) = *(const u32x4*)(up + 8);
    f32x4 yt[4];
#pragma unroll
    for (int ib = 0; ib < 4; ++ib) yt[ib] = (f32x4){0.f, 0.f, 0.f, 0.f};
#pragma unroll
    for (int dir = 0; dir < 2; ++dir) {
      S5Par q; float dtv, lre, lim; s5_params(p, l, dir, g, lane, q, dtv, lre, lim);
      const int c = chain_slot(dir, part, tc);
      const float* S = (const float*)(p.ws + OFF_S5S) + ((size_t)((b * 16 + g) * 2 + dir) * NCH + c) * 128;
      float xr = S[lane], xi = S[64 + lane];
      bf16x8 cf[4];
#pragma unroll
      for (int ks = 0; ks < 4; ++ks) {
        const int k = ks * 32 + g4 * 8;
        const float* src = (k < 64 ? p.s5_c_re : p.s5_c_im) + ((size_t)(l * 16 + g) * 16 + l15) * 64 + (k & 63);
        cf[ks] = frag_from_f32(src, k < 64 ? 1.f : -1.f);
      }
#pragma unroll
      for (int blk = 0; blk < 4; ++blk) {
        __syncthreads();
#pragma unroll 4
        for (int st = 0; st < 16; ++st) {
          const int step = blk * 16 + st, s = dir ? 63 - step : step;
          s5_step(q, us, s, xr, xi);
          xs[(s & 15) * 136 + lane] = f2bf(xr); xs[(s & 15) * 136 + 64 + lane] = f2bf(xi);
        }
        __syncthreads();
        f32x4 a = {0.f, 0.f, 0.f, 0.f};
#pragma unroll
        for (int ks = 0; ks < 4; ++ks) a = MFMA16(ld_frag(xs + l15 * 136 + ks * 32 + g4 * 8), cf[ks], a);
        const int ib = dir ? 3 - blk : blk;
        yt[ib] += a;
      }
    }
#pragma unroll
    for (int ib = 0; ib < 4; ++ib)
#pragma unroll
      for (int j = 0; j < 4; ++j) {
        const int tok = 16 * ib + 4 * g4 + j, ch = g * 16 + l15;
        const float u = bf2f(P[(size_t)(row0 + tok) * PINP + C_S5 + ch]);
        yg[tok * 264 + ch] = f2bf(gelu_tanh_f(yt[ib][j] + p.s5_d[l * 256 + ch] * u));
      }
  }
  __syncthreads();
  const bf16_t* Wg = (const bf16_t*)(p.ws + OFF_WGLU) + (size_t)l * 256 * 256;
  bf16_t* Y = (bf16_t*)(p.ws + OFF_HY);
#pragma unroll 1
  for (int ns = 0; ns < 4; ++ns) {
    f32x4 acc[4];
#pragma unroll
    for (int ms = 0; ms < 4; ++ms) acc[ms] = (f32x4){0.f, 0.f, 0.f, 0.f};
#pragma unroll
    for (int ks = 0; ks < 8; ++ks) {
      const bf16x8 wf = ld_frag(Wg + (size_t)(64 * w + 16 * ns + l15) * 256 + ks * 32 + g4 * 8);
#pragma unroll
      for (int ms = 0; ms < 4; ++ms) acc[ms] = MFMA16(wf, ld_frag(yg + (16 * ms + l15) * 264 + ks * 32 + g4 * 8), acc[ms]);
    }
#pragma unroll
    for (int ms = 0; ms < 4; ++ms) {
      const int tok = 16 * ms + l15, n0 = 64 * w + 16 * ns + 4 * g4;
      const u32x2 yv = *(const u32x2*)(yg + tok * 264 + n0);
      f32x4 o; o[0] = bflo(yv.x) * sigm_f(acc[ms][0]); o[1] = bfhi(yv.x) * sigm_f(acc[ms][1]); o[2] = bflo(yv.y) * sigm_f(acc[ms][2]); o[3] = bfhi(yv.y) * sigm_f(acc[ms][3]);
      store_bf4(Y + (size_t)(row0 + tok) * 1024 + 768 + n0, o);
    }
  }
  __syncthreads();
}

DI void outproj_item(const Params& p, int l, int item, char* smem) {
  const int mt = item >> 3, nt = item & 7;
  const float* MOD = (const float*)(p.ws + OFF_MOD);
  gemm_tile<1>((const bf16_t*)(p.ws + OFF_HY), 1024, (const bf16_t*)(p.ws + OFF_WOUT) + (size_t)l * 1024 * 1024, 1024, 1024, mt * 128, nt * 128, smem, (const float*)(p.ws + OFF_SSQ),
               [&](int row, int col, f32x4 v) {
                 const int s = row < NLAT ? row / T : 2;
                 const f32x4 gt = *(const f32x4*)(MOD + (size_t)(l * 3 + s) * 6144 + 2048 + col);
                 float* xp = row < NLAT ? p.xb + (size_t)row * 1024 + col : (float*)(p.ws + OFF_CTX) + (size_t)(row - NLAT) * 1024 + col;
                 *(f32x4*)xp = *(f32x4*)xp + gt * v;
               });
}
DI void ffnup_item(const Params& p, int l, int item, char* smem) {
  const int mt = item / 44, nt = item % 44;
  bf16_t* UG = (bf16_t*)(p.ws + OFF_R);
  gemm_tile<0>((const bf16_t*)(p.ws + OFF_HY), 1024, (const bf16_t*)(p.ws + OFF_WUP) + (size_t)l * 5632 * 1024, 1024, 1024, mt * 128, nt * 128, smem, nullptr,
               [&](int row, int col, f32x4 v) { store_bf4(UG + (size_t)row * 5632 + col, v); });
}
DI void act_item(const Params& p, int l, int item) {
  bf16_t* UG = (bf16_t*)(p.ws + OFF_R);
  const float* cw = p.ffn_conv_w + (size_t)l * 3 * DFF;
  for (int i = 0; i < 11; ++i) {
    const int id = ltid() + 256 * i, r = id / 352, cc = id % 352, row = item * 8 + r, k = cc * 8;
    int t, tl; if (row < NLAT) { t = row % T; tl = T; } else { t = (row - NLAT) % TC; tl = TC; }
    bf16_t* up = UG + (size_t)row * 5632 + k; const bf16_t* gp = up + DFF;
    const u32x4 z = {0u, 0u, 0u, 0u};
    const u32x4 u = *(const u32x4*)up, g0 = *(const u32x4*)gp, gm = t > 0 ? *(const u32x4*)(gp - 5632) : z, gn = t < tl - 1 ? *(const u32x4*)(gp + 5632) : z;
    const float uf[8] = {bflo(u.x), bfhi(u.x), bflo(u.y), bfhi(u.y), bflo(u.z), bfhi(u.z), bflo(u.w), bfhi(u.w)};
    const float a[8] = {bflo(gm.x), bfhi(gm.x), bflo(gm.y), bfhi(gm.y), bflo(gm.z), bfhi(gm.z), bflo(gm.w), bfhi(gm.w)};
    const float m[8] = {bflo(g0.x), bfhi(g0.x), bflo(g0.y), bfhi(g0.y), bflo(g0.z), bfhi(g0.z), bflo(g0.w), bfhi(g0.w)};
    const float n[8] = {bflo(gn.x), bfhi(gn.x), bflo(gn.y), bfhi(gn.y), bflo(gn.z), bfhi(gn.z), bflo(gn.w), bfhi(gn.w)};
    float o[8];
#pragma unroll
    for (int j = 0; j < 8; ++j) o[j] = silu_f(cw[k + j] * a[j] + cw[DFF + k + j] * m[j] + cw[2 * DFF + k + j] * n[j]) * uf[j];
    u32x4 ov; ov.x = pack2(o[0], o[1]); ov.y = pack2(o[2], o[3]); ov.z = pack2(o[4], o[5]); ov.w = pack2(o[6], o[7]);
    *(u32x4*)up = ov;
  }
}
DI void ffndown_item(const Params& p, int l, int item, char* smem) {
  const int mt = item >> 3, nt = item & 7;
  const float* MOD = (const float*)(p.ws + OFF_MOD);
  gemm_tile<0>((const bf16_t*)(p.ws + OFF_R), 5632, (const bf16_t*)(p.ws + OFF_WDN) + (size_t)l * 1024 * 2816, 2816, 2816, mt * 128, nt * 128, smem, nullptr,
               [&](int row, int col, f32x4 v) {
                 const int s = row < NLAT ? row / T : 2;
                 const f32x4 gt = *(const f32x4*)(MOD + (size_t)(l * 3 + s) * 6144 + 5120 + col);
                 float* xp = row < NLAT ? p.xb + (size_t)row * 1024 + col : (float*)(p.ws + OFF_CTX) + (size_t)(row - NLAT) * 1024 + col;
                 *(f32x4*)xp = *(f32x4*)xp + gt * v;
               });
}
DI void final_item(const Params& p, int item) {
  const int lane = ltid() & 63, w = __builtin_amdgcn_readfirstlane(ltid() >> 6), row = item * 4 + w;
  float* x = p.xb + (size_t)row * 1024;
  float4 v[4]; float ss = 0.f;
#pragma unroll
  for (int i = 0; i < 4; ++i) { v[i] = *(const float4*)(x + (i * 64 + lane) * 4); ss += v[i].x * v[i].x + v[i].y * v[i].y + v[i].z * v[i].z + v[i].w * v[i].w; }
  ss = wave_sum(ss);
  const float rstd = rsqrtf(ss * (1.f / 1024.f) + 1e-6f);
#pragma unroll
  for (int i = 0; i < 4; ++i) {
    const int k = (i * 64 + lane) * 4; const float4 g = *(const float4*)(p.final_norm + k);
    float4 o; o.x = v[i].x * rstd * g.x; o.y = v[i].y * rstd * g.y; o.z = v[i].z * rstd * g.z; o.w = v[i].w * rstd * g.w;
    *(float4*)(x + k) = o;
  }
}

constexpr int PPL = 12;
constexpr int N_PHASES = 2 + NL * PPL;
#define FOR_ITEMS(n) for (int it = blockIdx.x; it < (n); it += gridDim.x)

DI void run_phase(const Params& p, int ph, char* smem) {
  if (ph == 0) { FOR_ITEMS(P0_ITEMS) p0_item(p, it, smem); return; }
  if (ph == N_PHASES - 1) { FOR_ITEMS(NLAT / 4) final_item(p, it); return; }
  const int l = (ph - 1) / PPL, k = (ph - 1) % PPL;
  const int mtiles = (l == NL - 1) ? 128 : 132;
  switch (k) {
    case 0: FOR_ITEMS(NROW / 4) norm_item(p, l, 0, it); break;
    case 1: FOR_ITEMS(132 * 22) gemm_in_item(p, l, it, smem); break;
    case 2: FOR_ITEMS(2112) s5_p1(p, l, it, smem); break;
    case 3: {
      constexpr int n0 = 2112, n1 = n0 + 2112, n2 = n1 + 528, n3 = n2 + 396, n5 = n3 + 66;
      FOR_ITEMS(n5) {
        if (it < n0) ssd_p1(p, l, it, smem);
        else if (it < n1) mlstm_p1(p, l, it - n0, smem);
        else if (it < n2) kvproj_item(p, l, it - n1, smem);
        else if (it < n3) qproj_item(p, l, it - n2, smem);
        else ropek_item(p, it - n3);
      }
    } break;
    case 4: {
      constexpr int n0 = 512, n1 = n0 + 260, n2 = n1 + 16;
      FOR_ITEMS(n2) { if (it < n0) ssd_p2(p, it); else if (it < n1) mlstm_p2(p, it - n0); else s5_p2(p, l, it - n1); }
    } break;
    case 5: FOR_ITEMS(264) s5_p3(p, l, it, smem); break;
    case 6: {
      constexpr int n0 = 528, n2 = n0 + 1056, n3 = n2 + 1056;
      FOR_ITEMS(n3) {
        if (it < n0) attn_item(p, it, smem);
        else if (it < n2) ssd_p3(p, l, it - n0, smem);
        else mlstm_p3(p, l, it - n2, smem);
      }
    } break;
    case 7: FOR_ITEMS(mtiles * 8) outproj_item(p, l, it, smem); break;
    case 8: FOR_ITEMS(mtiles * 32) norm_item(p, l, 1, it); break;
    case 9: FOR_ITEMS(mtiles * 44) ffnup_item(p, l, it, smem); break;
    case 10: FOR_ITEMS(mtiles * 16) act_item(p, l, it); break;
    case 11: FOR_ITEMS(mtiles * 8) ffndown_item(p, l, it, smem); break;
  }
}

#ifndef HASH_LO
#define HASH_LO OFF_MOD
#define HASH_HI WS_NEED
#endif
#ifndef PROBE_N
#define PROBE_N 0
#endif
DI void hash_dump(const Params& p) {
  const size_t NOUT = (size_t)NLAT * 1024, nw = (HASH_HI - HASH_LO) / 4;
  const unsigned* wsw = (const unsigned*)(p.ws + HASH_LO);
  for (size_t i = (size_t)blockIdx.x * 256 + threadIdx.x; i < NOUT; i += (size_t)gridDim.x * 256) {
    unsigned h = 12345u;
    for (size_t j = i; j < nw; j += NOUT) h = h * 1664525u + wsw[j];
    p.xb[i] = (float)(h & 0xFFFFFFu);
  }
}

#define XB_TMO      128
#define XB_XCNT(j)  (256  + 64 * (j))
#define XB_XSUB(j)  (1280 + 64 * (j))
#define XB_XGEN(j)  (2304 + 64 * (j))
#define XB_TOP      3328
#define XB_TOPGEN   3392
#define XCD_BAR_WORDS 3456
#define XB_SPIN_CAP (1u << 22)
#define LAS __attribute__((address_space(3)))
DI unsigned xb_ld(unsigned* p) { return __hip_atomic_load(p, __ATOMIC_RELAXED, __HIP_MEMORY_SCOPE_AGENT); }
DI unsigned xb_add(unsigned* p, unsigned v) { return __hip_atomic_fetch_add(p, v, __ATOMIC_RELAXED, __HIP_MEMORY_SCOPE_AGENT); }
DI unsigned xb_xcc_id() { return (unsigned)__builtin_amdgcn_s_getreg((3 << 11) | 20) & 0xFu; }
#define XB_SPIN(cond, bar) do { unsigned _sp = 0; while (cond) { __builtin_amdgcn_s_sleep(1); \
    if ((++_sp & 255u) == 0u) { if (xb_ld(&(bar)[XB_TMO])) break; if (_sp > XB_SPIN_CAP) { atomicAdd(&(bar)[XB_TMO], 1u); break; } } } } while (0)
struct XcdBarrier { unsigned* bar; unsigned x; volatile LAS unsigned* st; };
DI XcdBarrier xcd_barrier_post(unsigned* bar, volatile LAS unsigned* st) {
  XcdBarrier b; b.bar = bar; b.x = xb_xcc_id(); b.st = st;
  if (threadIdx.x == 0) (void)xb_add(&bar[XB_XCNT(b.x)], 1u);
  return b;
}
DI void xcd_barrier_complete(unsigned* bar, unsigned x, unsigned& nloc, unsigned& nx) {
  const unsigned G = gridDim.x;
  unsigned sum, cnt, mine, sp = 0u;
  for (;;) {
    sum = 0u; cnt = 0u; mine = 0u;
#pragma unroll
    for (unsigned j = 0; j < 16; ++j) { const unsigned c = xb_ld(&bar[XB_XCNT(j)]); sum += c; cnt += (c > 0u) ? 1u : 0u; mine = (j == x) ? c : mine; }
    if (sum == G) break;
    __builtin_amdgcn_s_sleep(1);
    if ((++sp & 255u) == 0u) { if (xb_ld(&bar[XB_TMO])) break; if (sp > XB_SPIN_CAP) { atomicAdd(&bar[XB_TMO], 1u); break; } }
  }
  nloc = mine > 0u ? mine : 1u; nx = cnt > 0u ? cnt : 1u;
}
DI void xcd_barrier(const XcdBarrier& b) {
  asm volatile("s_waitcnt vmcnt(0)" ::: "memory");
  __syncthreads();
  if (threadIdx.x == 0) {
    unsigned* bar = b.bar;
    __builtin_amdgcn_s_waitcnt(0);
    unsigned nloc = b.st[0], nx = b.st[1];
    if (nloc == 0u) { xcd_barrier_complete(bar, b.x, nloc, nx); b.st[0] = nloc; b.st[1] = nx; }
    const unsigned old = xb_add(&bar[XB_XSUB(b.x)], 1u);
    const unsigned gen = old / nloc;
    if (old + 1u == (gen + 1u) * nloc) {
      __builtin_amdgcn_fence(__ATOMIC_RELEASE, "agent");
      asm volatile("s_waitcnt vmcnt(0)" ::: "memory");
      const unsigned og = xb_add(&bar[XB_TOP], 1u);
      const unsigned tg = og / nx;
      if (og + 1u == (tg + 1u) * nx) xb_add(&bar[XB_TOPGEN], 1u);
      else XB_SPIN(xb_ld(&bar[XB_TOPGEN]) == tg, bar);
      __builtin_amdgcn_fence(__ATOMIC_ACQUIRE, "agent");
      xb_add(&bar[XB_XGEN(b.x)], 1u);
      asm volatile("s_waitcnt vmcnt(0)" ::: "memory");
    } else {
      XB_SPIN(xb_ld(&bar[XB_XGEN(b.x)]) == gen, bar);
      __builtin_amdgcn_fence(__ATOMIC_ACQUIRE, "agent");
      asm volatile("s_waitcnt vmcnt(0)" ::: "memory");
    }
  }
  __syncthreads();
}
constexpr size_t OFF_BAR = ((WS_NEED + 255) / 256) * 256;
constexpr int SMEM_BYTES = 59392;
__global__ void __launch_bounds__(256, 2) trunk_fwd(Params p) {
  __shared__ __attribute__((aligned(16))) char smem[SMEM_BYTES];
  __shared__ uint4 xb_words;
  cg::grid_group grid = cg::this_grid();
  if (threadIdx.x == 0) xb_words = make_uint4(0u, 0u, 0u, 0u);
  __syncthreads();
  XcdBarrier xb = xcd_barrier_post((unsigned*)(p.ws + OFF_BAR), (volatile LAS unsigned*)&xb_words);
  for (int ph = p.ph_lo; ph < p.ph_hi; ++ph) {
    run_phase(p, ph, smem);
    if (ph + 1 < p.ph_hi) { if (ph == p.ph_lo) grid.sync(); else xcd_barrier(xb); }
  }
}

__global__ void __launch_bounds__(256) hash_kernel(Params p) { hash_dump(p); }

extern "C" void kernel_launch(void* const* d_in, const int* in_sizes, int n_in, void* d_out, int out_size, void* d_ws, size_t ws_size, hipStream_t stream) {
  static int grid_blocks = 0;
  if (!grid_blocks) {
    int dev = 0, cus = 0, per_cu = 0;
    hipGetDevice(&dev);
    hipDeviceGetAttribute(&cus, hipDeviceAttributeMultiprocessorCount, dev);
    hipOccupancyMaxActiveBlocksPerMultiprocessor(&per_cu, trunk_fwd, 256, 0);
    if (per_cu > 2) per_cu = 2;
    grid_blocks = cus * per_cu;
  }
  if (ws_size < OFF_BAR + XCD_BAR_WORDS * 4) { fprintf(stderr, "workspace too small: %zu < %zu\n", ws_size, (size_t)WS_NEED); return; }
  Params p{};
  const float** fp = (const float**)&p;
  for (int i = 0; i < 35; ++i) fp[i] = (const float*)d_in[i];
  p.xb = (float*)d_out; p.ws = (char*)d_ws;
#if MULTI_LAUNCH
#if PROBE_N
  for (int ph = 0; ph < PROBE_N; ++ph) { p.ph_lo = ph; p.ph_hi = ph + 1; hipLaunchKernelGGL(trunk_fwd, dim3(grid_blocks), dim3(256), 0, stream, p); }
  hipLaunchKernelGGL(hash_kernel, dim3(grid_blocks), dim3(256), 0, stream, p);
#else
  for (int ph = 0; ph < N_PHASES; ++ph) { p.ph_lo = ph; p.ph_hi = ph + 1; hipLaunchKernelGGL(trunk_fwd, dim3(grid_blocks), dim3(256), 0, stream, p); }
#endif
#else
  p.ph_lo = 0; p.ph_hi = N_PHASES;
  hipMemsetAsync((char*)d_ws + OFF_BAR, 0, XCD_BAR_WORDS * 4, stream);
  void* args[] = {&p};
  hipError_t e = hipLaunchCooperativeKernel((void*)trunk_fwd, dim3(grid_blocks), dim3(256), args, 0, stream);
  if (e != hipSuccess) fprintf(stderr, "cooperative launch failed: %s (grid %d)\n", hipGetErrorString(e), grid_blocks);
#endif
}
```

```cpp
#include <hip/hip_runtime.h>
#include <hip/hip_cooperative_groups.h>
#include <cstdio>
#include <cstdint>
namespace cg = cooperative_groups;

#ifndef PROBE_MASK
#define PROBE_MASK 63
#endif
#ifndef ZERO_FILL
#define ZERO_FILL 0
#endif
#ifndef MULTI_LAUNCH
#define MULTI_LAUNCH 0
#endif

typedef unsigned short bf16_t;
typedef short bf16x8 __attribute__((ext_vector_type(8)));
typedef float f32x4 __attribute__((ext_vector_type(4)));
typedef unsigned u32x4 __attribute__((ext_vector_type(4)));
typedef unsigned u32x2 __attribute__((ext_vector_type(2)));
#define DI __device__ __forceinline__
#define MFMA16(a, b, c) __builtin_amdgcn_mfma_f32_16x16x32_bf16((a), (b), (c), 0, 0, 0)

constexpr int NB = 2, T = 8192, TC = 256, NL = 4;
constexpr int NLAT = NB * T, NROW = NLAT + NB * TC;
constexpr int TALL = T + TC;
constexpr int PINP = 2816;
constexpr int C_MLQ = 0, C_MLK = 256, C_MLV = 512, C_MLO = 768, C_CQ = 1040, C_CKV = 1296, C_KR = 1424,
              C_Z = 1456, C_XBC = 1712, C_S5 = 2488;
constexpr int NCH = 132;
constexpr int DFF = 2816;

constexpr size_t SZ_WIN = (size_t)NL * 2816 * 1024 * 2, SZ_WUQ = (size_t)NL * 384 * 256 * 2, SZ_WUKV = (size_t)NL * 512 * 128 * 2,
                 SZ_WGLU = (size_t)NL * 256 * 256 * 2, SZ_WOUT = (size_t)NL * 1024 * 1024 * 2, SZ_WUP = (size_t)NL * 5632 * 1024 * 2,
                 SZ_WDN = (size_t)NL * 1024 * 2816 * 2, SZ_MOD = (size_t)NL * 3 * 6144 * 4, SZ_CTX = (size_t)512 * 1024 * 4,
                 SZ_HY = (size_t)NROW * 1024 * 2, SZ_GML = (size_t)NROW * 16 * 4, SZ_DTR = (size_t)NROW * 8 * 4, SZ_SSQ = (size_t)NROW * 4 * 4,
                 SZ_QRAW = (size_t)NROW * 384 * 2, SZ_KH = (size_t)NB * 4 * TALL * 64 * 2 + (size_t)NB * TALL * 32 * 2, SZ_VT = (size_t)NB * 4 * 64 * TALL * 2,
                 SZ_S5S = (size_t)NB * 16 * 2 * NCH * 128 * 4, SZ_MLM = (size_t)16 * NCH * 32 * 4, SZ_SSA = (size_t)16 * NCH * 32 * 4,
                 SZ_P = (size_t)NROW * PINP * 2, SZ_MLS = (size_t)16 * NCH * 4160 * 4, SZ_SSDS = (size_t)16 * NCH * 8192 * 4;
constexpr size_t OFF_WIN = 0, OFF_WUQ = OFF_WIN + SZ_WIN, OFF_WUKV = OFF_WUQ + SZ_WUQ, OFF_WGLU = OFF_WUKV + SZ_WUKV,
                 OFF_WOUT = OFF_WGLU + SZ_WGLU, OFF_WUP = OFF_WOUT + SZ_WOUT, OFF_WDN = OFF_WUP + SZ_WUP, OFF_MOD = OFF_WDN + SZ_WDN,
                 OFF_CTX = OFF_MOD + SZ_MOD, OFF_HY = OFF_CTX + SZ_CTX, OFF_GML = OFF_HY + SZ_HY, OFF_DTR = OFF_GML + SZ_GML,
                 OFF_SSQ = OFF_DTR + SZ_DTR, OFF_QRAW = OFF_SSQ + SZ_SSQ, OFF_KH = OFF_QRAW + SZ_QRAW, OFF_VT = OFF_KH + SZ_KH,
                 OFF_S5S = OFF_VT + SZ_VT, OFF_MLM = OFF_S5S + SZ_S5S, OFF_SSA = OFF_MLM + SZ_MLM,
                 OFF_R = ((OFF_SSA + SZ_SSA + 255) / 256) * 256, OFF_P = OFF_R, OFF_MLS = OFF_P + SZ_P, OFF_SSDS = OFF_MLS + SZ_MLS,
                 WS_NEED = OFF_SSDS + SZ_SSDS;
static_assert((size_t)NROW * 5632 * 2 <= SZ_P + SZ_MLS + SZ_SSDS, "UG overlay");

constexpr size_t OFF_KR = OFF_KH + (size_t)NB * 4 * TALL * 64 * 2;
struct Params {
  const float *x, *c, *ctx, *c_ctx, *w_mod, *b_mod, *norm1, *norm2, *w_in, *ml_gate_bias, *ml_norm, *mla_q_norm, *mla_kv_norm,
      *mla_w_uq, *mla_w_ukv, *ssd_conv_w, *ssd_conv_b, *ssd_a_log, *ssd_dt_bias, *ssd_d, *ssd_norm, *s5_a_re, *s5_a_im, *s5_log_dt,
      *s5_b_re, *s5_b_im, *s5_c_re, *s5_c_im, *s5_d, *s5_w_glu, *w_out, *ffn_w_up, *ffn_conv_w, *ffn_w_down, *final_norm;
  float* xb;
  char* ws;
  int ph_lo, ph_hi;
};

DI bf16_t f2bf(float x) { unsigned u = __float_as_uint(x); u += 0x7fffu + ((u >> 16) & 1u); return (bf16_t)(u >> 16); }
DI float bf2f(bf16_t v) { return __uint_as_float(((unsigned)v) << 16); }
DI unsigned pack2(float lo, float hi) { return (unsigned)f2bf(lo) | ((unsigned)f2bf(hi) << 16); }
DI float bflo(unsigned w) { return __uint_as_float(w << 16); }
DI float bfhi(unsigned w) { return __uint_as_float(w & 0xffff0000u); }
DI float silu_f(float x) { return x / (1.f + __expf(-x)); }
DI float sigm_f(float x) { return 1.f / (1.f + __expf(-x)); }
DI float softplus_f(float x) { return fmaxf(x, 0.f) + log1pf(__expf(-fabsf(x))); }
DI float logsigm_f(float x) { return fminf(x, 0.f) - log1pf(__expf(-fabsf(x))); }
DI float gelu_tanh_f(float x) { float u = 0.7978845608f * (x + 0.044715f * x * x * x); return x * sigm_f(2.f * u); }
DI float wave_sum(float v) { for (int o = 32; o; o >>= 1) v += __shfl_xor(v, o); return v; }
DI float wave_max(float v) { for (int o = 32; o; o >>= 1) v = fmaxf(v, __shfl_xor(v, o)); return v; }
DI float wave_incl_scan(float v, int lane) { for (int o = 1; o < 64; o <<= 1) { float t = __shfl_up(v, o); if (lane >= o) v += t; } return v; }
DI float red16_max(float v) { v = fmaxf(v, __shfl_xor(v, 1)); v = fmaxf(v, __shfl_xor(v, 2)); v = fmaxf(v, __shfl_xor(v, 4)); v = fmaxf(v, __shfl_xor(v, 8)); return v; }
DI float red16_sum(float v) { v += __shfl_xor(v, 1); v += __shfl_xor(v, 2); v += __shfl_xor(v, 4); v += __shfl_xor(v, 8); return v; }
DI bf16x8 ld_frag(const bf16_t* p) { return *(const bf16x8*)p; }
DI bf16x8 mk_frag(unsigned a, unsigned b, unsigned c, unsigned d) { u32x4 u = {a, b, c, d}; return __builtin_bit_cast(bf16x8, u); }
DI bf16x8 frag_from_f32(const float* p, float sgn) {
  float4 a = *(const float4*)p, b = *(const float4*)(p + 4);
  return mk_frag(pack2(a.x * sgn, a.y * sgn), pack2(a.z * sgn, a.w * sgn), pack2(b.x * sgn, b.y * sgn), pack2(b.z * sgn, b.w * sgn));
}
DI int ltid() { int t = threadIdx.x; asm volatile("" : "+v"(t)); return t; }
DI int row_of(int b, int part, int t) { return part ? NLAT + b * TC + t : b * T + t; }

DI void tr_tile(const float* __restrict__ src, int K, int N, bf16_t* __restrict__ dst, const float* gain, int glo, int ghi, int tk, int tn, float* tile) {
  const int tid = ltid(), c = tid & 63, rq = tid >> 6;
  for (int rr = 0; rr < 16; ++rr) {
    const int r = rr * 4 + rq, k = tk * 64 + r, n = tn * 64 + c;
    float v = (n < N) ? src[(size_t)k * N + n] : 0.f;
    if (gain && k >= glo && k < ghi) v *= gain[k - glo];
    tile[r * 65 + c] = v;
  }
  __syncthreads();
  for (int cc = 0; cc < 16; ++cc) { const int n = cc * 4 + rq; dst[(size_t)(tn * 64 + n) * K + tk * 64 + c] = f2bf(tile[c * 65 + n]); }
  __syncthreads();
}

constexpr int TR_PER_LAYER = 3128, P0_TR = NL * TR_PER_LAYER, P0_MOD = NL * 96, P0_CPX = NLAT * 1024 / 4096, P0_CPC = 512 * 1024 / 4096;
constexpr int P0_ZERO = (int)((WS_NEED - OFF_HY + 65535) / 65536);
constexpr int P0_ITEMS = P0_TR + P0_MOD + P0_CPX + P0_CPC + (ZERO_FILL ? P0_ZERO : 0);

DI void p0_item(const Params& p, int item, char* smem) {
  const int tid = ltid();
  if (item < P0_TR) {
    const int l = item / TR_PER_LAYER; int t = item % TR_PER_LAYER; float* tile = (float*)smem;
    if (t < 704) { tr_tile(p.w_in + (size_t)l * 1024 * 2744, 1024, 2744, (bf16_t*)(p.ws + OFF_WIN) + (size_t)l * 2816 * 1024, nullptr, 0, 0, t / 44, t % 44, tile); return; }
    t -= 704;
    if (t < 24) { tr_tile(p.mla_w_uq + (size_t)l * 256 * 384, 256, 384, (bf16_t*)(p.ws + OFF_WUQ) + (size_t)l * 384 * 256, p.mla_q_norm + l * 256, 0, 256, t / 6, t % 6, tile); return; }
    t -= 24;
    if (t < 16) { tr_tile(p.mla_w_ukv + (size_t)l * 128 * 512, 128, 512, (bf16_t*)(p.ws + OFF_WUKV) + (size_t)l * 512 * 128, p.mla_kv_norm + l * 128, 0, 128, t / 8, t % 8, tile); return; }
    t -= 16;
    if (t < 16) { tr_tile(p.s5_w_glu + (size_t)l * 256 * 256, 256, 256, (bf16_t*)(p.ws + OFF_WGLU) + (size_t)l * 256 * 256, nullptr, 0, 0, t / 4, t % 4, tile); return; }
    t -= 16;
    if (t < 256) { tr_tile(p.w_out + (size_t)l * 1024 * 1024, 1024, 1024, (bf16_t*)(p.ws + OFF_WOUT) + (size_t)l * 1024 * 1024, p.ssd_norm + l * 256, 512, 768, t / 16, t % 16, tile); return; }
    t -= 256;
    if (t < 1408) { tr_tile(p.ffn_w_up + (size_t)l * 1024 * 5632, 1024, 5632, (bf16_t*)(p.ws + OFF_WUP) + (size_t)l * 5632 * 1024, nullptr, 0, 0, t / 88, t % 88, tile); return; }
    t -= 1408;
    tr_tile(p.ffn_w_down + (size_t)l * 2816 * 1024, 2816, 1024, (bf16_t*)(p.ws + OFF_WDN) + (size_t)l * 1024 * 2816, nullptr, 0, 0, t / 16, t % 16, tile);
    return;
  }
  item -= P0_TR;
  if (item < P0_MOD) {
    const int l = item / 96, cb = item % 96, cl = tid & 63, kq = tid >> 6;
    float* sv = (float*)smem;
    float* red = sv + 3072;
    for (int i = tid; i < 1024; i += 256) { sv[i] = silu_f(p.c[i]); sv[1024 + i] = silu_f(p.c[1024 + i]); sv[2048 + i] = silu_f(p.c_ctx[i]); }
    __syncthreads();
    const int col = cb * 64 + cl; const float* W = p.w_mod + (size_t)l * 1024 * 6144 + col;
    float a0 = 0.f, a1 = 0.f, a2 = 0.f;
#pragma unroll 8
    for (int k = kq * 256; k < kq * 256 + 256; ++k) { const float w = W[(size_t)k * 6144]; a0 += sv[k] * w; a1 += sv[1024 + k] * w; a2 += sv[2048 + k] * w; }
    red[(kq * 3 + 0) * 64 + cl] = a0; red[(kq * 3 + 1) * 64 + cl] = a1; red[(kq * 3 + 2) * 64 + cl] = a2;
    __syncthreads();
    if (tid < 192) {
      const int s = tid >> 6; const float bm = p.b_mod[l * 6144 + col];
      const float v = red[(0 * 3 + s) * 64 + cl] + red[(1 * 3 + s) * 64 + cl] + red[(2 * 3 + s) * 64 + cl] + red[(3 * 3 + s) * 64 + cl] + bm;
      ((float*)(p.ws + OFF_MOD))[(size_t)(l * 3 + s) * 6144 + col] = v;
    }
    __syncthreads();
    return;
  }
  item -= P0_MOD;
  if (item >= P0_CPX + P0_CPC) {
    item -= P0_CPX + P0_CPC;
    char* z = p.ws + OFF_HY + (size_t)item * 65536;
    const size_t lim = WS_NEED - OFF_HY - (size_t)item * 65536;
    for (int i = 0; i < 16; ++i) { const size_t o = (size_t)(i * 256 + tid) * 16; if (o < lim) *(u32x4*)(z + o) = (u32x4){0u, 0u, 0u, 0u}; }
    return;
  }
  const float* src; float* dst;
  if (item < P0_CPX) { src = p.x + (size_t)item * 4096; dst = p.xb + (size_t)item * 4096; }
  else { item -= P0_CPX; src = p.ctx + (size_t)item * 4096; dst = (float*)(p.ws + OFF_CTX) + (size_t)item * 4096; }
  for (int i = 0; i < 4; ++i) { const int o = (i * 256 + tid) * 4; *(float4*)(dst + o) = *(const float4*)(src + o); }
}

DI void norm_item(const Params& p, int l, int which, int item) {
  const int lane = ltid() & 63, w = __builtin_amdgcn_readfirstlane(ltid() >> 6), row = item * 4 + w;
  const float* x = row < NLAT ? p.xb + (size_t)row * 1024 : (const float*)(p.ws + OFF_CTX) + (size_t)(row - NLAT) * 1024;
  float4 v[4]; float ss = 0.f;
#pragma unroll
  for (int i = 0; i < 4; ++i) { v[i] = *(const float4*)(x + (i * 64 + lane) * 4); ss += v[i].x * v[i].x + v[i].y * v[i].y + v[i].z * v[i].z + v[i].w * v[i].w; }
  ss = wave_sum(ss);
  const float rstd = rsqrtf(ss * (1.f / 1024.f) + 1e-6f);
  const int s = row < NLAT ? row / T : 2;
  const float* g = (which ? p.norm2 : p.norm1) + l * 1024;
  const float* md = (const float*)(p.ws + OFF_MOD) + (size_t)(l * 3 + s) * 6144 + (which ? 3072 : 0);
  bf16_t* H = (bf16_t*)(p.ws + OFF_HY) + (size_t)row * 1024;
#pragma unroll
  for (int i = 0; i < 4; ++i) {
    const int k = (i * 64 + lane) * 4;
    const float4 g4 = *(const float4*)(g + k), sh = *(const float4*)(md + k), sc = *(const float4*)(md + 1024 + k);
    u32x2 o; o.x = pack2(v[i].x * rstd * g4.x * (1.f + sc.x) + sh.x, v[i].y * rstd * g4.y * (1.f + sc.y) + sh.y);
    o.y = pack2(v[i].z * rstd * g4.z * (1.f + sc.z) + sh.z, v[i].w * rstd * g4.w * (1.f + sc.w) + sh.w);
    *(u32x2*)(H + k) = o;
  }
}

template <int AMODE, class Epi>
DI void gemm_tile(const bf16_t* __restrict__ A, int lda, const bf16_t* __restrict__ Bt, int ldb, int K, int m0, int n0, char* smem, const float* ssq, Epi epi) {
  bf16_t* As = (bf16_t*)smem; bf16_t* Bs = As + 128 * 72;
  const int tid = ltid(), lane = tid & 63, w = __builtin_amdgcn_readfirstlane(tid >> 6), wm = w >> 1, wn = w & 1, l15 = lane & 15, g4 = lane >> 4;
  u32x4 ar[4], br[4]; float rs[4];
  const int r0 = tid >> 3, cc = tid & 7;
  const bf16_t* ap = A + (size_t)(m0 + r0) * lda + cc * 8;
  const bf16_t* bp = Bt + (size_t)(n0 + r0) * ldb + cc * 8;
  const size_t astep = (size_t)32 * lda, bstep = (size_t)32 * ldb;
  if (AMODE == 1) {
#pragma unroll
    for (int i = 0; i < 4; ++i) { const float* q = ssq + (m0 + r0 + 32 * i); rs[i] = rsqrtf((q[0] + q[NROW] + q[2 * NROW] + q[3 * NROW]) * (1.f / 256.f) + 1e-6f); }
  }
  f32x4 acc[4][4];
#pragma unroll
  for (int i = 0; i < 4; ++i)
#pragma unroll
    for (int j = 0; j < 4; ++j) acc[i][j] = (f32x4){0.f, 0.f, 0.f, 0.f};
#pragma unroll
  for (int i = 0; i < 4; ++i) { ar[i] = *(const u32x4*)(ap + i * astep); br[i] = *(const u32x4*)(bp + i * bstep); }
  const int nk = K >> 6;
  for (int kt = 0; kt < nk; ++kt) {
    if (AMODE == 1 && kt >= 8 && kt < 12) {
#pragma unroll
      for (int i = 0; i < 4; ++i) {
        const float s = rs[i]; u32x4 q = ar[i];
        q.x = pack2(bflo(q.x) * s, bfhi(q.x) * s); q.y = pack2(bflo(q.y) * s, bfhi(q.y) * s);
        q.z = pack2(bflo(q.z) * s, bfhi(q.z) * s); q.w = pack2(bflo(q.w) * s, bfhi(q.w) * s); ar[i] = q;
      }
    }
#pragma unroll
    for (int i = 0; i < 4; ++i) { *(u32x4*)(As + (r0 + 32 * i) * 72 + cc * 8) = ar[i]; *(u32x4*)(Bs + (r0 + 32 * i) * 72 + cc * 8) = br[i]; }
    __syncthreads();
    if (kt + 1 < nk) {
#pragma unroll
      for (int i = 0; i < 4; ++i) { ar[i] = *(const u32x4*)(ap + i * astep + (kt + 1) * 64); br[i] = *(const u32x4*)(bp + i * bstep + (kt + 1) * 64); }
    }
    __builtin_amdgcn_sched_barrier(0);
#pragma unroll
    for (int ks = 0; ks < 2; ++ks) {
      bf16x8 af[4], bfr[4];
#pragma unroll
      for (int i = 0; i < 4; ++i) { af[i] = ld_frag(As + (64 * wm + 16 * i + l15) * 72 + ks * 32 + g4 * 8); bfr[i] = ld_frag(Bs + (64 * wn + 16 * i + l15) * 72 + ks * 32 + g4 * 8); }
#pragma unroll
      for (int i = 0; i < 4; ++i)
#pragma unroll
        for (int j = 0; j < 4; ++j) acc[i][j] = MFMA16(bfr[j], af[i], acc[i][j]);
    }
    __syncthreads();
  }
#pragma unroll
  for (int i = 0; i < 4; ++i)
#pragma unroll
    for (int j = 0; j < 4; ++j) epi(m0 + 64 * wm + 16 * i + l15, n0 + 64 * wn + 16 * j + 4 * g4, acc[i][j]);
}

DI void store_bf4(bf16_t* dst, f32x4 v) { u32x2 o; o.x = pack2(v[0], v[1]); o.y = pack2(v[2], v[3]); *(u32x2*)dst = o; }

DI void gemm_in_item(const Params& p, int l, int item, char* smem) {
  const int mt = item / 22, nt = item % 22;
  bf16_t* P = (bf16_t*)(p.ws + OFF_P); float* GML = (float*)(p.ws + OFF_GML); float* DTR = (float*)(p.ws + OFF_DTR);
  gemm_tile<0>((const bf16_t*)(p.ws + OFF_HY), 1024, (const bf16_t*)(p.ws + OFF_WIN) + (size_t)l * 2816 * 1024, 1024, 1024, mt * 128, nt * 128, smem, nullptr,
               [&](int row, int col, f32x4 v) {
                 store_bf4(P + (size_t)row * PINP + col, v);
                 if (col >= 1024 && col < 1040) *(f32x4*)(GML + (size_t)row * 16 + (col - 1024)) = v;
                 if (col >= 2480 && col < 2488) *(f32x4*)(DTR + (size_t)row * 8 + (col - 2480)) = v;
               });
}

DI void tile_rstd(const bf16_t* P, int m0, int col0, int ncols, float* rst) {
  const int tid = ltid(), r = tid >> 1, hf = tid & 1, n = ncols >> 1;
  const bf16_t* src = P + (size_t)(m0 + r) * PINP + col0 + hf * n;
  float ss = 0.f;
  for (int c = 0; c < n; c += 8) { const u32x4 q = *(const u32x4*)(src + c);
    ss += bflo(q.x) * bflo(q.x) + bfhi(q.x) * bfhi(q.x) + bflo(q.y) * bflo(q.y) + bfhi(q.y) * bfhi(q.y) + bflo(q.z) * bflo(q.z) + bfhi(q.z) * bfhi(q.z) + bflo(q.w) * bflo(q.w) + bfhi(q.w) * bfhi(q.w); }
  ss += __shfl_xor(ss, 1);
  if (hf == 0) rst[r] = rsqrtf(ss / (float)ncols + 1e-6f);
  __syncthreads();
}
DI void qproj_item(const Params& p, int l, int item, char* smem) {
  const int mt = item / 3, nt = item % 3; const bf16_t* P = (const bf16_t*)(p.ws + OFF_P);
  float* rst = (float*)(smem + 36864);
  tile_rstd(P, mt * 128, C_CQ, 256, rst);
  bf16_t* Q = (bf16_t*)(p.ws + OFF_QRAW);
  gemm_tile<0>(P + C_CQ, PINP, (const bf16_t*)(p.ws + OFF_WUQ) + (size_t)l * 384 * 256, 256, 256, mt * 128, nt * 128, smem, nullptr,
               [&](int row, int col, f32x4 v) { const float r = rst[row - mt * 128]; store_bf4(Q + (size_t)row * 384 + col, v * r); });
  __syncthreads();
}
DI void kvproj_item(const Params& p, int l, int item, char* smem) {
  const int mt = item / 4, nt = item % 4; const bf16_t* P = (const bf16_t*)(p.ws + OFF_P);
  float* rst = (float*)(smem + 36864);
  tile_rstd(P, mt * 128, C_CKV, 128, rst);
  bf16_t* KH = (bf16_t*)(p.ws + OFF_KH); bf16_t* VT = (bf16_t*)(p.ws + OFF_VT);
  gemm_tile<0>(P + C_CKV, PINP, (const bf16_t*)(p.ws + OFF_WUKV) + (size_t)l * 512 * 128, 128, 128, mt * 128, nt * 128, smem, nullptr,
               [&](int row, int col, f32x4 v) {
                 const float r = rst[row - mt * 128]; v = v * r;
                 const int hh = col >> 7, dd = col & 127;
                 int b, tpos; if (row < NLAT) { b = row / T; tpos = row % T; } else { b = (row - NLAT) / TC; tpos = T + (row - NLAT) % TC; }
                 if (dd < 64) store_bf4(KH + ((size_t)(b * 4 + hh) * TALL + tpos) * 64 + dd, v);
                 else {
                   bf16_t* vp = VT + ((size_t)(b * 4 + hh) * 64 + (dd - 64)) * TALL + tpos;
                   vp[0] = f2bf(v[0]); vp[TALL] = f2bf(v[1]); vp[2 * TALL] = f2bf(v[2]); vp[3 * TALL] = f2bf(v[3]);
                 }
               });
  __syncthreads();
}
DI void rope_cs(int t, int i, float& cs, float& sn) {
  const int pos = (i < 8) ? (t >> 6) : (t & 63); const int f = i & 7;
  const float inv = exp2f(-(float)f * (13.287712379549449f / 8.f));
  const float ang = (float)pos * inv;
  cs = cosf(ang); sn = sinf(ang);
}
DI void ropek_item(const Params& p, int item) {
  const int row = item * 256 + ltid();
  const bf16_t* src = (const bf16_t*)(p.ws + OFF_P) + (size_t)row * PINP + C_KR;
  u32x4 q[4];
#pragma unroll
  for (int i = 0; i < 4; ++i) q[i] = *(const u32x4*)(src + i * 8);
  float v[32];
#pragma unroll
  for (int i = 0; i < 4; ++i) { v[i * 8 + 0] = bflo(q[i].x); v[i * 8 + 1] = bfhi(q[i].x); v[i * 8 + 2] = bflo(q[i].y); v[i * 8 + 3] = bfhi(q[i].y);
    v[i * 8 + 4] = bflo(q[i].z); v[i * 8 + 5] = bfhi(q[i].z); v[i * 8 + 6] = bflo(q[i].w); v[i * 8 + 7] = bfhi(q[i].w); }
  int b, tpos;
  if (row < NLAT) {
    b = row / T; tpos = row % T;
#pragma unroll
    for (int i = 0; i < 16; ++i) { float cs, sn; rope_cs(tpos, i, cs, sn); const float x1 = v[i], x2 = v[i + 16]; v[i] = x1 * cs - x2 * sn; v[i + 16] = x1 * sn + x2 * cs; }
  } else { b = (row - NLAT) / TC; tpos = T + (row - NLAT) % TC; }
  u32x4 o[4];
#pragma unroll
  for (int i = 0; i < 4; ++i) { o[i].x = pack2(v[i * 8], v[i * 8 + 1]); o[i].y = pack2(v[i * 8 + 2], v[i * 8 + 3]); o[i].z = pack2(v[i * 8 + 4], v[i * 8 + 5]); o[i].w = pack2(v[i * 8 + 6], v[i * 8 + 7]); }
  bf16_t* dst = (bf16_t*)(p.ws + OFF_KR) + ((size_t)b * TALL + tpos) * 32;
#pragma unroll
  for (int i = 0; i < 4; ++i) *(u32x4*)(dst + i * 8) = o[i];
}

DI void attn_item(const Params& p, int item, char* smem) {
  const int tid = ltid(), lane = tid & 63, w = __builtin_amdgcn_readfirstlane(tid >> 6), l15 = lane & 15, g4 = lane >> 4;
  int b, h, qt, latent;
  if (item < 512) { latent = 1; qt = item & 63; h = (item >> 6) & 3; b = item >> 8; }
  else { latent = 0; const int i2 = item - 512; qt = i2 & 1; h = (i2 >> 1) & 3; b = i2 >> 3; }
  const int qrow0 = latent ? b * T + qt * 128 : NLAT + b * TC + qt * 128;
  bf16_t* Qs = (bf16_t*)smem;
  bf16_t* Ks = (bf16_t*)smem;
  bf16_t* Vs = Ks + 64 * 104;
  const bf16_t* Qraw = (const bf16_t*)(p.ws + OFF_QRAW);
  const float qscale = 0.10206207261596577f * 1.4426950408889634f;
  for (int id = tid; id < 1280; id += 256) {
    const int r = id / 10, cc = id % 10;
    const bf16_t* src = Qraw + (size_t)(qrow0 + r) * 384 + h * 96 + cc * 8;
    const u32x4 q = *(const u32x4*)src;
    float a[8] = {bflo(q.x), bfhi(q.x), bflo(q.y), bfhi(q.y), bflo(q.z), bfhi(q.z), bflo(q.w), bfhi(q.w)};
    if (cc < 8) {
      u32x4 o; o.x = pack2(a[0] * qscale, a[1] * qscale); o.y = pack2(a[2] * qscale, a[3] * qscale); o.z = pack2(a[4] * qscale, a[5] * qscale); o.w = pack2(a[6] * qscale, a[7] * qscale);
      *(u32x4*)(Qs + r * 104 + cc * 8) = o;
    } else {
      const u32x4 q2 = *(const u32x4*)(src + 16);
      float c2[8] = {bflo(q2.x), bfhi(q2.x), bflo(q2.y), bfhi(q2.y), bflo(q2.z), bfhi(q2.z), bflo(q2.w), bfhi(q2.w)};
      float o1[8], o2[8];
#pragma unroll
      for (int j = 0; j < 8; ++j) {
        float cs = 1.f, sn = 0.f;
        if (latent) rope_cs(qt * 128 + r, (cc - 8) * 8 + j, cs, sn);
        o1[j] = (a[j] * cs - c2[j] * sn) * qscale; o2[j] = (a[j] * sn + c2[j] * cs) * qscale;
      }
      u32x4 o; o.x = pack2(o1[0], o1[1]); o.y = pack2(o1[2], o1[3]); o.z = pack2(o1[4], o1[5]); o.w = pack2(o1[6], o1[7]);
      *(u32x4*)(Qs + r * 104 + cc * 8) = o;
      o.x = pack2(o2[0], o2[1]); o.y = pack2(o2[2], o2[3]); o.z = pack2(o2[4], o2[5]); o.w = pack2(o2[6], o2[7]);
      *(u32x4*)(Qs + r * 104 + cc * 8 + 16) = o;
    }
  }
  __syncthreads();
  bf16x8 qf[2][3];
#pragma unroll
  for (int qs = 0; qs < 2; ++qs)
#pragma unroll
    for (int ks = 0; ks < 3; ++ks) qf[qs][ks] = ld_frag(Qs + (32 * w + 16 * qs + l15) * 104 + ks * 32 + g4 * 8);
  __syncthreads();
  const int kt0 = latent ? 0 : 128, kt1 = 132;
  const bf16_t* Kg = (const bf16_t*)(p.ws + OFF_KH) + (size_t)(b * 4 + h) * TALL * 64;
  const bf16_t* Rg = (const bf16_t*)(p.ws + OFF_KR) + (size_t)b * TALL * 32;
  const bf16_t* Vg = (const bf16_t*)(p.ws + OFF_VT) + (size_t)(b * 4 + h) * 64 * TALL;
  u32x4 kr[3], vr[2];
  const int ve0 = tid >> 3, vc = tid & 7;
  {
    kr[0] = *(const u32x4*)(Kg + (size_t)kt0 * 4096 + tid * 8); kr[1] = *(const u32x4*)(Kg + (size_t)kt0 * 4096 + (tid + 256) * 8);
    kr[2] = *(const u32x4*)(Rg + (size_t)kt0 * 2048 + tid * 8);
#pragma unroll
    for (int i = 0; i < 2; ++i) vr[i] = *(const u32x4*)(Vg + (size_t)(ve0 + 32 * i) * TALL + kt0 * 64 + vc * 8);
  }
  float mrun[2] = {-1e30f, -1e30f}, lsum[2] = {0.f, 0.f};
  f32x4 O[4][2];
#pragma unroll
  for (int es = 0; es < 4; ++es)
#pragma unroll
    for (int qs = 0; qs < 2; ++qs) O[es][qs] = (f32x4){0.f, 0.f, 0.f, 0.f};
  for (int kt = kt0; kt < kt1; ++kt) {
    __syncthreads();
#pragma unroll
    for (int i = 0; i < 2; ++i) { const int id = tid + 256 * i; *(u32x4*)(Ks + (id >> 3) * 104 + (id & 7) * 8) = kr[i]; }
    *(u32x4*)(Ks + (tid >> 2) * 104 + 64 + (tid & 3) * 8) = kr[2];
#pragma unroll
    for (int i = 0; i < 2; ++i) *(u32x4*)(Vs + (ve0 + 32 * i) * 72 + vc * 8) = vr[i];
    __syncthreads();
    if (kt + 1 < kt1) {
      kr[0] = *(const u32x4*)(Kg + (size_t)(kt + 1) * 4096 + tid * 8); kr[1] = *(const u32x4*)(Kg + (size_t)(kt + 1) * 4096 + (tid + 256) * 8);
      kr[2] = *(const u32x4*)(Rg + (size_t)(kt + 1) * 2048 + tid * 8);
#pragma unroll
      for (int i = 0; i < 2; ++i) vr[i] = *(const u32x4*)(Vg + (size_t)(ve0 + 32 * i) * TALL + (kt + 1) * 64 + vc * 8);
    }
    __builtin_amdgcn_sched_barrier(0);
    f32x4 sa[4][2];
#pragma unroll
    for (int kb = 0; kb < 4; ++kb)
#pragma unroll
      for (int qs = 0; qs < 2; ++qs) sa[kb][qs] = (f32x4){0.f, 0.f, 0.f, 0.f};
#pragma unroll
    for (int ks = 0; ks < 3; ++ks)
#pragma unroll
      for (int kb = 0; kb < 4; ++kb) {
        const bf16x8 a = ld_frag(Ks + (16 * kb + l15) * 104 + ks * 32 + g4 * 8);
#pragma unroll
        for (int qs = 0; qs < 2; ++qs) sa[kb][qs] = MFMA16(a, qf[qs][ks], sa[kb][qs]);
      }
    bf16x8 pf[2][2];
#pragma unroll
    for (int qs = 0; qs < 2; ++qs) {
      float mx = -1e30f;
#pragma unroll
      for (int kb = 0; kb < 4; ++kb)
#pragma unroll
        for (int j = 0; j < 4; ++j) mx = fmaxf(mx, sa[kb][qs][j]);
      mx = fmaxf(mx, __shfl_xor(mx, 16)); mx = fmaxf(mx, __shfl_xor(mx, 32));
      const float mnew = fmaxf(mrun[qs], mx), alpha = exp2f(mrun[qs] - mnew);
      mrun[qs] = mnew;
      float ps = 0.f;
#pragma unroll
      for (int kb = 0; kb < 4; ++kb)
#pragma unroll
        for (int j = 0; j < 4; ++j) { const float e = exp2f(sa[kb][qs][j] - mnew); sa[kb][qs][j] = e; ps += e; }
      lsum[qs] = lsum[qs] * alpha + ps;
#pragma unroll
      for (int es = 0; es < 4; ++es) O[es][qs] = O[es][qs] * alpha;
#pragma unroll
      for (int k2 = 0; k2 < 2; ++k2)
        pf[qs][k2] = mk_frag(pack2(sa[2 * k2][qs][0], sa[2 * k2][qs][1]), pack2(sa[2 * k2][qs][2], sa[2 * k2][qs][3]),
                             pack2(sa[2 * k2 + 1][qs][0], sa[2 * k2 + 1][qs][1]), pack2(sa[2 * k2 + 1][qs][2], sa[2 * k2 + 1][qs][3]));
    }
#pragma unroll
    for (int k2 = 0; k2 < 2; ++k2)
#pragma unroll
      for (int es = 0; es < 4; ++es) {
        const bf16_t* vp = Vs + (16 * es + l15) * 72 + 32 * k2 + 4 * g4;
        const u32x2 lo = *(const u32x2*)vp, hi = *(const u32x2*)(vp + 16);
        const bf16x8 a = mk_frag(lo.x, lo.y, hi.x, hi.y);
#pragma unroll
        for (int qs = 0; qs < 2; ++qs) O[es][qs] = MFMA16(a, pf[qs][k2], O[es][qs]);
      }
  }
  bf16_t* Y = (bf16_t*)(p.ws + OFF_HY);
#pragma unroll
  for (int qs = 0; qs < 2; ++qs) {
    float l = lsum[qs]; l += __shfl_xor(l, 16); l += __shfl_xor(l, 32);
    const float inv = 1.f / l;
    const int row = qrow0 + 32 * w + 16 * qs + l15;
#pragma unroll
    for (int es = 0; es < 4; ++es) store_bf4(Y + (size_t)row * 1024 + 256 + h * 64 + 16 * es + 4 * g4, O[es][qs] * inv);
  }
  __syncthreads();
}

DI void chunk_geom(int tcg, int b, int& part, int& tc, int& row0) { part = tcg >= 128; tc = part ? tcg - 128 : tcg; row0 = row_of(b, part, tc * 64); }
DI int chain_slot(int dir, int part, int tc) { return dir ? (part ? 3 - tc : 131 - tc) : (part ? tc : 4 + tc); }

DI void mlstm_p1(const Params& p, int l, int item, char* smem) {
  const int tid = ltid(), lane = tid & 63, w = __builtin_amdgcn_readfirstlane(tid >> 6), l15 = lane & 15, g4 = lane >> 4;
  const int tcg = item % NCH; int r = item / NCH; const int dir = r & 1; r >>= 1; const int h = r & 3, b = r >> 2;
  int part, tc, row0; chunk_geom(tcg, b, part, tc, row0);
  const int c = chain_slot(dir, part, tc), chain = (b * 4 + h) * 2 + dir;
  bf16_t* A = (bf16_t*)smem;
  bf16_t* Bk = A + 80 * 72;
  float* fs = (float*)(Bk + 64 * 72);
  const bf16_t* P = (const bf16_t*)(p.ws + OFF_P); const float* GML = (const float*)(p.ws + OFF_GML);
  float* MLM = (float*)(p.ws + OFF_MLM) + (size_t)(chain * NCH + c) * 32;
  if (tid < 64) {
    const int gi = 2 * dir;
    const float ig = GML[(size_t)(row0 + tid) * 16 + gi * 4 + h] + p.ml_gate_bias[l * 16 + gi * 4 + h];
    const float fg = GML[(size_t)(row0 + tid) * 16 + (gi + 1) * 4 + h] + p.ml_gate_bias[l * 16 + (gi + 1) * 4 + h];
    const float lf = logsigm_f(fg);
    const float pre = wave_incl_scan(lf, lane), tot = __shfl(pre, 63);
    const float bc = dir ? tot - pre + lf : pre;
    const float wlog = tot - bc + ig, mloc = wave_max(wlog), wv = __expf(wlog - mloc);
    fs[tid] = wv; A[64 * 72 + tid] = f2bf(wv);
    if (tid == 0) { MLM[0] = mloc; MLM[1] = tot; }
  }
  for (int i = tid; i < 15 * 72; i += 256) A[65 * 72 + i] = 0;
  __syncthreads();
  {
    const int s = tid >> 2, d0 = (tid & 3) * 16; const float wv = fs[s];
    const bf16_t* kp = P + (size_t)(row0 + s) * PINP + C_MLK + h * 64 + d0;
    const bf16_t* vp = P + (size_t)(row0 + s) * PINP + C_MLV + h * 64 + d0;
#pragma unroll
    for (int hf = 0; hf < 2; ++hf) {
      const u32x4 kq = *(const u32x4*)(kp + hf * 8), vq = *(const u32x4*)(vp + hf * 8);
      const float kk[8] = {bflo(kq.x), bfhi(kq.x), bflo(kq.y), bfhi(kq.y), bflo(kq.z), bfhi(kq.z), bflo(kq.w), bfhi(kq.w)};
      const float vv[8] = {bflo(vq.x), bfhi(vq.x), bflo(vq.y), bfhi(vq.y), bflo(vq.z), bfhi(vq.z), bflo(vq.w), bfhi(vq.w)};
#pragma unroll
      for (int j = 0; j < 8; ++j) { Bk[(d0 + hf * 8 + j) * 72 + s] = f2bf(kk[j] * 0.125f); A[(d0 + hf * 8 + j) * 72 + s] = f2bf(vv[j] * wv); }
    }
  }
  __syncthreads();
  float* MLS = (float*)(p.ws + OFF_MLS) + (size_t)(chain * NCH + c) * 4160;
  for (int t = w; t < 20; t += 4) {
    const int ms = t >> 2, ns = t & 3;
    f32x4 acc = {0.f, 0.f, 0.f, 0.f};
#pragma unroll
    for (int ks = 0; ks < 2; ++ks) acc = MFMA16(ld_frag(A + (16 * ms + l15) * 72 + ks * 32 + g4 * 8), ld_frag(Bk + (16 * ns + l15) * 72 + ks * 32 + g4 * 8), acc);
#pragma unroll
    for (int j = 0; j < 4; ++j) { const int e = 16 * ms + 4 * g4 + j; if (e <= 64) MLS[e * 64 + 16 * ns + l15] = acc[j]; }
  }
  __syncthreads();
}
DI void mlstm_p2(const Params& p, int item) {
  const int gi = item * 256 + ltid(), chain = gi / 4160, e = gi % 4160;
  float* MLS = (float*)(p.ws + OFF_MLS) + (size_t)chain * NCH * 4160 + e;
  float* MLM = (float*)(p.ws + OFF_MLM) + (size_t)chain * NCH * 32;
  float C = 0.f, m = 0.f;
  for (int c0 = 0; c0 < NCH; c0 += 12) {
    float d[12], ml[12], bl[12];
#pragma unroll
    for (int i = 0; i < 12; ++i) { d[i] = MLS[(size_t)(c0 + i) * 4160]; ml[i] = MLM[(c0 + i) * 32]; bl[i] = MLM[(c0 + i) * 32 + 1]; }
#pragma unroll
    for (int i = 0; i < 12; ++i) {
      MLS[(size_t)(c0 + i) * 4160] = C; if (e == 0) MLM[(c0 + i) * 32 + 16] = m;
      const float mn = fmaxf(bl[i] + m, ml[i]);
      C = __expf(bl[i] + m - mn) * C + __expf(ml[i] - mn) * d[i]; m = mn;
    }
  }
}
DI void mlstm_p3(const Params& p, int l, int item, char* smem) {
  const int tid = ltid(), lane = tid & 63, w = __builtin_amdgcn_readfirstlane(tid >> 6), l15 = lane & 15, g4 = lane >> 4;
  const int h = item & 3; const int r = item >> 2; const int tcg = r % NCH, b = r / NCH;
  int part, tc, row0; chunk_geom(tcg, b, part, tc, row0);
  bf16_t* Qs = (bf16_t*)smem;
  bf16_t* Ks = Qs + 64 * 72;
  bf16_t* Vt = Ks + 64 * 72;
  bf16_t* Sb = Vt + 64 * 72;
  float* fb = (float*)(Sb + 64 * 72);
  float* fi = fb + 64;
  const bf16_t* P = (const bf16_t*)(p.ws + OFF_P); const float* GML = (const float*)(p.ws + OFF_GML);
  {
    const int s = tid >> 2, d0 = (tid & 3) * 16;
    const bf16_t* base = P + (size_t)(row0 + s) * PINP + h * 64 + d0;
#pragma unroll
    for (int hf = 0; hf < 2; ++hf) {
      *(u32x4*)(Qs + s * 72 + d0 + hf * 8) = *(const u32x4*)(base + C_MLQ + hf * 8);
      const u32x4 kq = *(const u32x4*)(base + C_MLK + hf * 8), vq = *(const u32x4*)(base + C_MLV + hf * 8);
      u32x4 ko; ko.x = pack2(bflo(kq.x) * 0.125f, bfhi(kq.x) * 0.125f); ko.y = pack2(bflo(kq.y) * 0.125f, bfhi(kq.y) * 0.125f);
      ko.z = pack2(bflo(kq.z) * 0.125f, bfhi(kq.z) * 0.125f); ko.w = pack2(bflo(kq.w) * 0.125f, bfhi(kq.w) * 0.125f);
      *(u32x4*)(Ks + s * 72 + d0 + hf * 8) = ko;
      const unsigned vw[4] = {vq.x, vq.y, vq.z, vq.w};
#pragma unroll
      for (int j = 0; j < 4; ++j) { Vt[(d0 + hf * 8 + 2 * j) * 72 + s] = (bf16_t)(vw[j] & 0xffffu); Vt[(d0 + hf * 8 + 2 * j + 1) * 72 + s] = (bf16_t)(vw[j] >> 16); }
    }
  }
  f32x4 hs[4];
#pragma unroll
  for (int ns = 0; ns < 4; ++ns) hs[ns] = (f32x4){0.f, 0.f, 0.f, 0.f};
#pragma unroll 1
  for (int dir = 0; dir < 2; ++dir) {
    const int c = chain_slot(dir, part, tc), chain = (b * 4 + h) * 2 + dir;
    const float m_in = ((const float*)(p.ws + OFF_MLM))[(size_t)(chain * NCH + c) * 32 + 16];
    const float* Cst = (const float*)(p.ws + OFF_MLS) + (size_t)(chain * NCH + c) * 4160;
    __syncthreads();
    if (tid < 64) {
      const int gi = 2 * dir;
      const float ig = GML[(size_t)(row0 + tid) * 16 + gi * 4 + h] + p.ml_gate_bias[l * 16 + gi * 4 + h];
      const float fg = GML[(size_t)(row0 + tid) * 16 + (gi + 1) * 4 + h] + p.ml_gate_bias[l * 16 + (gi + 1) * 4 + h];
      const float lf = logsigm_f(fg);
      const float pre = wave_incl_scan(lf, lane), tot = __shfl(pre, 63);
      fb[tid] = dir ? tot - pre + lf : pre; fi[tid] = ig;
    }
    __syncthreads();
    f32x4 sc[4];
#pragma unroll
    for (int ns = 0; ns < 4; ++ns) {
      f32x4 a = {0.f, 0.f, 0.f, 0.f};
#pragma unroll
      for (int ks = 0; ks < 2; ++ks) a = MFMA16(ld_frag(Qs + (16 * w + l15) * 72 + ks * 32 + g4 * 8), ld_frag(Ks + (16 * ns + l15) * 72 + ks * 32 + g4 * 8), a);
      sc[ns] = a;
    }
    float bi[4], mt[4], rsum[4];
#pragma unroll
    for (int j = 0; j < 4; ++j) {
      const int i = 16 * w + 4 * g4 + j; bi[j] = fb[i];
      float mx = -1e30f;
#pragma unroll
      for (int ns = 0; ns < 4; ++ns) { const int s = 16 * ns + l15; const bool ok = dir ? (s >= i) : (s <= i); const float dm = bi[j] - fb[s] + fi[s]; if (ok) mx = fmaxf(mx, dm); }
      mx = red16_max(mx);
      mt[j] = fmaxf(bi[j] + m_in, mx);
      float rs = 0.f;
#pragma unroll
      for (int ns = 0; ns < 4; ++ns) {
        const int s = 16 * ns + l15; const bool ok = dir ? (s >= i) : (s <= i);
        const float v = ok ? sc[ns][j] * __expf(bi[j] - fb[s] + fi[s] - mt[j]) : 0.f;
        rs += v; Sb[i * 72 + s] = f2bf(v);
      }
      rsum[j] = red16_sum(rs);
    }
    __syncthreads();
    f32x4 qc[5];
#pragma unroll
    for (int ns = 0; ns < 5; ++ns) {
      f32x4 a = {0.f, 0.f, 0.f, 0.f};
      const int e = 16 * ns + l15;
#pragma unroll
      for (int ks = 0; ks < 2; ++ks) {
        bf16x8 bfm;
        if (e <= 64) bfm = frag_from_f32(Cst + e * 64 + ks * 32 + g4 * 8, 1.f); else bfm = mk_frag(0u, 0u, 0u, 0u);
        a = MFMA16(ld_frag(Qs + (16 * w + l15) * 72 + ks * 32 + g4 * 8), bfm, a);
      }
      qc[ns] = a;
    }
    f32x4 nm[4];
#pragma unroll
    for (int ns = 0; ns < 4; ++ns) {
      f32x4 a = {0.f, 0.f, 0.f, 0.f};
#pragma unroll
      for (int ks = 0; ks < 2; ++ks) a = MFMA16(ld_frag(Sb + (16 * w + l15) * 72 + ks * 32 + g4 * 8), ld_frag(Vt + (16 * ns + l15) * 72 + ks * 32 + g4 * 8), a);
      nm[ns] = a;
    }
#pragma unroll
    for (int j = 0; j < 4; ++j) {
      const float wi = __expf(bi[j] + m_in - mt[j]);
      const float qn = __shfl(qc[4][j], lane & 48);
      const float den = rsum[j] + wi * qn;
      const float dd = 1.f / fmaxf(fabsf(den), __expf(-mt[j]));
#pragma unroll
      for (int ns = 0; ns < 4; ++ns) hs[ns][j] += (nm[ns][j] + wi * qc[ns][j]) * dd;
    }
  }
  bf16_t* Y = (bf16_t*)(p.ws + OFF_HY);
#pragma unroll
  for (int j = 0; j < 4; ++j) {
    float ss = 0.f;
#pragma unroll
    for (int ns = 0; ns < 4; ++ns) ss += hs[ns][j] * hs[ns][j];
    ss = red16_sum(ss);
    const float rstd = rsqrtf(ss * (1.f / 64.f) + 1e-6f);
    const int row = row0 + 16 * w + 4 * g4 + j;
#pragma unroll
    for (int ns = 0; ns < 4; ++ns) {
      const int ch = h * 64 + 16 * ns + l15;
      const float o = bf2f(P[(size_t)row * PINP + C_MLO + ch]);
      Y[(size_t)row * 1024 + ch] = f2bf(hs[ns][j] * rstd * p.ml_norm[l * 256 + ch] * sigm_f(o));
    }
  }
  __syncthreads();
}

DI void conv_silu8(const Params& p, int l, const bf16_t* P, int row, bool hp, bool hn, int ch, float* out) {
  const bf16_t* src = P + (size_t)row * PINP + C_XBC + ch;
  const u32x4 z = {0u, 0u, 0u, 0u};
  const u32x4 c0 = *(const u32x4*)src, pm = hp ? *(const u32x4*)(src - PINP) : z, nx = hn ? *(const u32x4*)(src + PINP) : z;
  const float* cw = p.ssd_conv_w + (size_t)l * 3 * 768 + ch; const float* cb = p.ssd_conv_b + l * 768 + ch;
  const float a[8] = {bflo(pm.x), bfhi(pm.x), bflo(pm.y), bfhi(pm.y), bflo(pm.z), bfhi(pm.z), bflo(pm.w), bfhi(pm.w)};
  const float m[8] = {bflo(c0.x), bfhi(c0.x), bflo(c0.y), bfhi(c0.y), bflo(c0.z), bfhi(c0.z), bflo(c0.w), bfhi(c0.w)};
  const float n[8] = {bflo(nx.x), bfhi(nx.x), bflo(nx.y), bfhi(nx.y), bflo(nx.z), bfhi(nx.z), bflo(nx.w), bfhi(nx.w)};
#pragma unroll
  for (int j = 0; j < 8; ++j) out[j] = silu_f(cb[j] + cw[j] * a[j] + cw[768 + j] * m[j] + cw[1536 + j] * n[j]);
}
DI void ssd_gates(const Params& p, int l, int dir, int h, int row0, int tid, int lane, float& dt, float& cs, float& tot) {
  const float* DTR = (const float*)(p.ws + OFF_DTR);
  dt = softplus_f(DTR[(size_t)(row0 + tid) * 8 + dir * 4 + h] + p.ssd_dt_bias[l * 8 + dir * 4 + h]);
  const float la = -dt * __expf(p.ssd_a_log[l * 8 + dir * 4 + h]);
  const float pre = wave_incl_scan(la, lane); tot = __shfl(pre, 63);
  cs = dir ? tot - pre + la : pre;
}
DI void ssd_p1(const Params& p, int l, int item, char* smem) {
  const int tid = ltid(), lane = tid & 63, w = __builtin_amdgcn_readfirstlane(tid >> 6), l15 = lane & 15, g4 = lane >> 4;
  const int tcg = item % NCH; int r = item / NCH; const int dir = r & 1; r >>= 1; const int h = r & 3, b = r >> 2;
  int part, tc, row0; chunk_geom(tcg, b, part, tc, row0);
  const int c = chain_slot(dir, part, tc), chain = (b * 4 + h) * 2 + dir, lastc = part ? 3 : 127;
  bf16_t* Xt = (bf16_t*)smem;
  bf16_t* Bt = Xt + 64 * 72;
  float* fs = (float*)(Bt + 128 * 72);
  const bf16_t* P = (const bf16_t*)(p.ws + OFF_P);
  if (tid < 64) {
    float dt, cs, tot; ssd_gates(p, l, dir, h, row0, tid, lane, dt, cs, tot);
    fs[tid] = __expf(tot - cs) * dt;
    if (tid == 0) ((float*)(p.ws + OFF_SSA))[(chain * NCH + c) * 32] = tot;
  }
  __syncthreads();
  const int grp = h >> 1;
  for (int id = tid; id < 64 * 24; id += 256) {
    const int s = id / 24, cc = id % 24;
    const bool hp = !(tc == 0 && s == 0), hn = !(tc == lastc && s == 63);
    float v[8];
    if (cc < 8) { conv_silu8(p, l, P, row0 + s, hp, hn, h * 64 + cc * 8, v); const float wv = fs[s];
#pragma unroll
      for (int j = 0; j < 8; ++j) Xt[(cc * 8 + j) * 72 + s] = f2bf(v[j] * wv); }
    else { const int n0 = (cc - 8) * 8; conv_silu8(p, l, P, row0 + s, hp, hn, 256 + grp * 128 + n0, v);
#pragma unroll
      for (int j = 0; j < 8; ++j) Bt[(n0 + j) * 72 + s] = f2bf(v[j]); }
  }
  __syncthreads();
  float* SS = (float*)(p.ws + OFF_SSDS) + (size_t)(chain * NCH + c) * 8192;
#pragma unroll
  for (int ns = 0; ns < 8; ++ns) {
    f32x4 acc = {0.f, 0.f, 0.f, 0.f};
#pragma unroll
    for (int ks = 0; ks < 2; ++ks) acc = MFMA16(ld_frag(Xt + (16 * w + l15) * 72 + ks * 32 + g4 * 8), ld_frag(Bt + (16 * ns + l15) * 72 + ks * 32 + g4 * 8), acc);
#pragma unroll
    for (int j = 0; j < 4; ++j) SS[(16 * w + 4 * g4 + j) * 128 + 16 * ns + l15] = acc[j];
  }
  __syncthreads();
}
DI void ssd_p2(const Params& p, int item) {
  const int gi = item * 256 + ltid(), chain = gi >> 13, e = gi & 8191;
  float* SS = (float*)(p.ws + OFF_SSDS) + (size_t)chain * NCH * 8192 + e;
  const float* SA = (const float*)(p.ws + OFF_SSA) + (size_t)chain * NCH * 32;
  float S = 0.f;
  for (int c0 = 0; c0 < NCH; c0 += 12) {
    float d[12], a[12];
#pragma unroll
    for (int i = 0; i < 12; ++i) { d[i] = SS[(size_t)(c0 + i) * 8192]; a[i] = SA[(c0 + i) * 32]; }
#pragma unroll
    for (int i = 0; i < 12; ++i) { SS[(size_t)(c0 + i) * 8192] = S; S = __expf(a[i]) * S + d[i]; }
  }
}
DI void ssd_p3(const Params& p, int l, int item, char* smem) {
  const int tid = ltid(), lane = tid & 63, w = __builtin_amdgcn_readfirstlane(tid >> 6), l15 = lane & 15, g4 = lane >> 4;
  const int h = item & 3; const int r = item >> 2; const int tcg = r % NCH, b = r / NCH;
  int part, tc, row0; chunk_geom(tcg, b, part, tc, row0);
  const int lastc = part ? 3 : 127, grp = h >> 1;
  bf16_t* Cm = (bf16_t*)smem;
  bf16_t* Bm = Cm + 64 * 136;
  bf16_t* Xt = Bm + 64 * 136;
  bf16_t* Sb = Xt + 64 * 72;
  float* fcs = (float*)(Sb + 64 * 72);
  float* fdt = fcs + 64;
  const bf16_t* P = (const bf16_t*)(p.ws + OFF_P);
  for (int id = tid; id < 64 * 40; id += 256) {
    const int s = id / 40, cc = id % 40;
    const bool hp = !(tc == 0 && s == 0), hn = !(tc == lastc && s == 63);
    float v[8];
    if (cc < 8) { conv_silu8(p, l, P, row0 + s, hp, hn, h * 64 + cc * 8, v);
#pragma unroll
      for (int j = 0; j < 8; ++j) Xt[(cc * 8 + j) * 72 + s] = f2bf(v[j]); }
    else {
      const int q = cc - 8, isC = q >= 16, n0 = (q & 15) * 8;
      conv_silu8(p, l, P, row0 + s, hp, hn, 256 + isC * 256 + grp * 128 + n0, v);
      u32x4 o; o.x = pack2(v[0], v[1]); o.y = pack2(v[2], v[3]); o.z = pack2(v[4], v[5]); o.w = pack2(v[6], v[7]);
      *(u32x4*)((isC ? Cm : Bm) + s * 136 + n0) = o;
    }
  }
  f32x4 ys[4];
#pragma unroll
  for (int ns = 0; ns < 4; ++ns) ys[ns] = (f32x4){0.f, 0.f, 0.f, 0.f};
#pragma unroll 1
  for (int dir = 0; dir < 2; ++dir) {
    const int c = chain_slot(dir, part, tc), chain = (b * 4 + h) * 2 + dir;
    const float* St = (const float*)(p.ws + OFF_SSDS) + (size_t)(chain * NCH + c) * 8192;
    __syncthreads();
    if (tid < 64) { float dt, cs, tot; ssd_gates(p, l, dir, h, row0, tid, lane, dt, cs, tot); fcs[tid] = cs; fdt[tid] = dt; }
    __syncthreads();
    float ci[4];
#pragma unroll
    for (int j = 0; j < 4; ++j) ci[j] = fcs[16 * w + 4 * g4 + j];
#pragma unroll
    for (int ns = 0; ns < 4; ++ns) {
      f32x4 a = {0.f, 0.f, 0.f, 0.f};
#pragma unroll
      for (int ks = 0; ks < 4; ++ks) a = MFMA16(ld_frag(Cm + (16 * w + l15) * 136 + ks * 32 + g4 * 8), ld_frag(Bm + (16 * ns + l15) * 136 + ks * 32 + g4 * 8), a);
      const int s = 16 * ns + l15; const float css = fcs[s], dts = fdt[s];
#pragma unroll
      for (int j = 0; j < 4; ++j) {
        const int i = 16 * w + 4 * g4 + j; const bool ok = dir ? (s >= i) : (s <= i);
        Sb[i * 72 + s] = f2bf(ok ? a[j] * __expf(ci[j] - css) * dts : 0.f);
      }
    }
    __syncthreads();
#pragma unroll
    for (int ns = 0; ns < 4; ++ns) {
      f32x4 a = {0.f, 0.f, 0.f, 0.f}, bq = {0.f, 0.f, 0.f, 0.f};
#pragma unroll
      for (int ks = 0; ks < 2; ++ks) a = MFMA16(ld_frag(Sb + (16 * w + l15) * 72 + ks * 32 + g4 * 8), ld_frag(Xt + (16 * ns + l15) * 72 + ks * 32 + g4 * 8), a);
#pragma unroll
      for (int ks = 0; ks < 4; ++ks) bq = MFMA16(ld_frag(Cm + (16 * w + l15) * 136 + ks * 32 + g4 * 8), frag_from_f32(St + (16 * ns + l15) * 128 + ks * 32 + g4 * 8, 1.f), bq);
#pragma unroll
      for (int j = 0; j < 4; ++j) ys[ns][j] += a[j] + __expf(ci[j]) * bq[j];
    }
  }
  bf16_t* Y = (bf16_t*)(p.ws + OFF_HY); float* SSQ = (float*)(p.ws + OFF_SSQ);
  const float dsk = p.ssd_d[l * 4 + h];
#pragma unroll
  for (int j = 0; j < 4; ++j) {
    const int i = 16 * w + 4 * g4 + j, row = row0 + i; float ss = 0.f;
#pragma unroll
    for (int ns = 0; ns < 4; ++ns) {
      const int pp = 16 * ns + l15;
      const float xv = bf2f(Xt[pp * 72 + i]);
      const float z = bf2f(P[(size_t)row * PINP + C_Z + h * 64 + pp]);
      const float g = (ys[ns][j] + dsk * xv) * silu_f(z);
      ss += g * g; Y[(size_t)row * 1024 + 512 + h * 64 + pp] = f2bf(g);
    }
    ss = red16_sum(ss);
    if (l15 == 0) SSQ[(size_t)h * NROW + row] = ss;
  }
  __syncthreads();
}

struct S5Par { float are, aim, bre[16], bim[16]; };
DI void s5_params(const Params& p, int l, int dir, int g, int n, S5Par& q, float& dtv, float& lre, float& lim) {
  const int ai = ((l * 2 + dir) * 16 + g) * 64 + n;
  lre = fminf(p.s5_a_re[ai], -1e-4f); lim = p.s5_a_im[ai];
  dtv = __expf(p.s5_log_dt[(l * 2 + dir) * 16 + g]);
  const float mag = __expf(lre * dtv), ang = lim * dtv;
  q.are = mag * cosf(ang); q.aim = mag * sinf(ang);
  const float den = lre * lre + lim * lim;
  const float fre = ((q.are - 1.f) * lre + q.aim * lim) / den, fim = (q.aim * lre - (q.are - 1.f) * lim) / den;
  const float* br = p.s5_b_re + ((size_t)(l * 16 + g) * 64 + n) * 16; const float* bi = p.s5_b_im + ((size_t)(l * 16 + g) * 64 + n) * 16;
#pragma unroll
  for (int j = 0; j < 16; ++j) { q.bre[j] = fre * br[j] - fim * bi[j]; q.bim[j] = fre * bi[j] + fim * br[j]; }
}
DI void s5_step(const S5Par& q, const bf16_t* us, int s, float& xr, float& xi) {
  const u32x4 a0 = *(const u32x4*)(us + s * 16), a1 = *(const u32x4*)(us + s * 16 + 8);
  const unsigned uw[8] = {a0.x, a0.y, a0.z, a0.w, a1.x, a1.y, a1.z, a1.w};
  float br = 0.f, bi = 0.f;
#pragma unroll
  for (int j = 0; j < 8; ++j) { const float a = bflo(uw[j]), c = bfhi(uw[j]); br += q.bre[2 * j] * a + q.bre[2 * j + 1] * c; bi += q.bim[2 * j] * a + q.bim[2 * j + 1] * c; }
  const float nr = q.are * xr - q.aim * xi + br, ni = q.are * xi + q.aim * xr + bi;
  xr = nr; xi = ni;
}
DI void s5_p1(const Params& p, int l, int item, char* smem) {
  const int lane = ltid() & 63, wi = item * 4 + __builtin_amdgcn_readfirstlane(ltid() >> 6);
  const int tcg = wi % NCH; int r = wi / NCH; const int dir = r & 1; r >>= 1; const int g = r & 15, b = r >> 4;
  int part, tc, row0; chunk_geom(tcg, b, part, tc, row0);
  const int c = chain_slot(dir, part, tc);
  S5Par q; float dtv, lre, lim; s5_params(p, l, dir, g, lane, q, dtv, lre, lim);
  const bf16_t* up = (const bf16_t*)(p.ws + OFF_P) + (size_t)(row0 + lane) * PINP + C_S5 + g * 16;
  bf16_t* us = (bf16_t*)smem + __builtin_amdgcn_readfirstlane(ltid() >> 6) * 1024;
  *(u32x4*)(us + lane * 16) = *(const u32x4*)up; *(u32x4*)(us + lane * 16 + 8) = *(const u32x4*)(up + 8);
  float xr = 0.f, xi = 0.f;
  for (int st = 0; st < 64; ++st) { const int s = dir ? 63 - st : st; s5_step(q, us, s, xr, xi); }
  float* S = (float*)(p.ws + OFF_S5S) + ((size_t)((b * 16 + g) * 2 + dir) * NCH + c) * 128;
  S[lane] = xr; S[64 + lane] = xi;
}
DI void s5_p2(const Params& p, int l, int item) {
  const int gi = item * 256 + ltid(), n = gi & 63, dir = (gi >> 6) & 1, g = (gi >> 7) & 15, b = gi >> 11;
  const int ai = ((l * 2 + dir) * 16 + g) * 64 + n;
  const float lre = fminf(p.s5_a_re[ai], -1e-4f), lim = p.s5_a_im[ai], dtv = __expf(p.s5_log_dt[(l * 2 + dir) * 16 + g]);
  const float mag = __expf(64.f * lre * dtv), ang = 64.f * (lim * dtv);
  const float ar = mag * cosf(ang), aim = mag * sinf(ang);
  float* S = (float*)(p.ws + OFF_S5S) + (size_t)((b * 16 + g) * 2 + dir) * NCH * 128 + n;
  float xr = 0.f, xi = 0.f;
  for (int c0 = 0; c0 < NCH; c0 += 12) {
    float dr[12], di[12];
#pragma unroll
    for (int i = 0; i < 12; ++i) { dr[i] = S[(c0 + i) * 128]; di[i] = S[(c0 + i) * 128 + 64]; }
#pragma unroll
    for (int i = 0; i < 12; ++i) { S[(c0 + i) * 128] = xr; S[(c0 + i) * 128 + 64] = xi; const float nr = ar * xr - aim * xi + dr[i], ni = ar * xi + aim * xr + di[i]; xr = nr; xi = ni; }
  }
}
DI void s5_p3(const Params& p, int l, int item, char* smem) {
  const int tid = ltid(), lane = tid & 63, w = __builtin_amdgcn_readfirstlane(tid >> 6), l15 = lane & 15, g4 = lane >> 4;
  const int tcg = item % NCH, b = item / NCH;
  int part, tc, row0; chunk_geom(tcg, b, part, tc, row0);
  bf16_t* xs = (bf16_t*)smem + w * (16 * 136);
  bf16_t* yg = (bf16_t*)smem + 4 * 16 * 136;
  const bf16_t* P = (const bf16_t*)(p.ws + OFF_P);
#pragma unroll 1
  for (int gi = 0; gi < 4; ++gi) {
    const int g = w + 4 * gi;
    const bf16_t* up = P + (size_t)(row0 + lane) * PINP + C_S5 + g * 16;
    bf16_t* us = (bf16_t*)smem + 25600 + w * 1024;
    *(u32x4*)(us + lane * 16) = *(const u32x4*)up; *(u32x4*)(us + lane * 16 + 8) = *(const u32x4*)(up + 8);
    f32x4 yt[4];
#pragma unroll
    for (int ib = 0; ib < 4; ++ib) yt[ib] = (f32x4){0.f, 0.f, 0.f, 0.f};
#pragma unroll
    for (int dir = 0; dir < 2; ++dir) {
      S5Par q; float dtv, lre, lim; s5_params(p, l, dir, g, lane, q, dtv, lre, lim);
      const int c = chain_slot(dir, part, tc);
      const float* S = (const float*)(p.ws + OFF_S5S) + ((size_t)((b * 16 + g) * 2 + dir) * NCH + c) * 128;
      float xr = S[lane], xi = S[64 + lane];
      bf16x8 cf[4];
#pragma unroll
      for (int ks = 0; ks < 4; ++ks) {
        const int k = ks * 32 + g4 * 8;
        const float* src = (k < 64 ? p.s5_c_re : p.s5_c_im) + ((size_t)(l * 16 + g) * 16 + l15) * 64 + (k & 63);
        cf[ks] = frag_from_f32(src, k < 64 ? 1.f : -1.f);
      }
#pragma unroll
      for (int blk = 0; blk < 4; ++blk) {
        __syncthreads();
#pragma unroll 4
        for (int st = 0; st < 16; ++st) {
          const int step = blk * 16 + st, s = dir ? 63 - step : step;
          s5_step(q, us, s, xr, xi);
          xs[(s & 15) * 136 + lane] = f2bf(xr); xs[(s & 15) * 136 + 64 + lane] = f2bf(xi);
        }
        __syncthreads();
        f32x4 a = {0.f, 0.f, 0.f, 0.f};
#pragma unroll
        for (int ks = 0; ks < 4; ++ks) a = MFMA16(ld_frag(xs + l15 * 136 + ks * 32 + g4 * 8), cf[ks], a);
        const int ib = dir ? 3 - blk : blk;
        yt[ib] += a;
      }
    }
#pragma unroll
    for (int ib = 0; ib < 4; ++ib)
#pragma unroll
      for (int j = 0; j < 4; ++j) {
        const int tok = 16 * ib + 4 * g4 + j, ch = g * 16 + l15;
        const float u = bf2f(P[(size_t)(row0 + tok) * PINP + C_S5 + ch]);
        yg[tok * 264 + ch] = f2bf(gelu_tanh_f(yt[ib][j] + p.s5_d[l * 256 + ch] * u));
      }
  }
  __syncthreads();
  const bf16_t* Wg = (const bf16_t*)(p.ws + OFF_WGLU) + (size_t)l * 256 * 256;
  bf16_t* Y = (bf16_t*)(p.ws + OFF_HY);
#pragma unroll 1
  for (int ns = 0; ns < 4; ++ns) {
    f32x4 acc[4];
#pragma unroll
    for (int ms = 0; ms < 4; ++ms) acc[ms] = (f32x4){0.f, 0.f, 0.f, 0.f};
#pragma unroll
    for (int ks = 0; ks < 8; ++ks) {
      const bf16x8 wf = ld_frag(Wg + (size_t)(64 * w + 16 * ns + l15) * 256 + ks * 32 + g4 * 8);
#pragma unroll
      for (int ms = 0; ms < 4; ++ms) acc[ms] = MFMA16(wf, ld_frag(yg + (16 * ms + l15) * 264 + ks * 32 + g4 * 8), acc[ms]);
    }
#pragma unroll
    for (int ms = 0; ms < 4; ++ms) {
      const int tok = 16 * ms + l15, n0 = 64 * w + 16 * ns + 4 * g4;
      const u32x2 yv = *(const u32x2*)(yg + tok * 264 + n0);
      f32x4 o; o[0] = bflo(yv.x) * sigm_f(acc[ms][0]); o[1] = bfhi(yv.x) * sigm_f(acc[ms][1]); o[2] = bflo(yv.y) * sigm_f(acc[ms][2]); o[3] = bfhi(yv.y) * sigm_f(acc[ms][3]);
      store_bf4(Y + (size_t)(row0 + tok) * 1024 + 768 + n0, o);
    }
  }
  __syncthreads();
}

DI void outproj_item(const Params& p, int l, int item, char* smem) {
  const int mt = item >> 3, nt = item & 7;
  const float* MOD = (const float*)(p.ws + OFF_MOD);
  gemm_tile<1>((const bf16_t*)(p.ws + OFF_HY), 1024, (const bf16_t*)(p.ws + OFF_WOUT) + (size_t)l * 1024 * 1024, 1024, 1024, mt * 128, nt * 128, smem, (const float*)(p.ws + OFF_SSQ),
               [&](int row, int col, f32x4 v) {
                 const int s = row < NLAT ? row / T : 2;
                 const f32x4 gt = *(const f32x4*)(MOD + (size_t)(l * 3 + s) * 6144 + 2048 + col);
                 float* xp = row < NLAT ? p.xb + (size_t)row * 1024 + col : (float*)(p.ws + OFF_CTX) + (size_t)(row - NLAT) * 1024 + col;
                 *(f32x4*)xp = *(f32x4*)xp + gt * v;
               });
}
DI void ffnup_item(const Params& p, int l, int item, char* smem) {
  const int mt = item / 44, nt = item % 44;
  bf16_t* UG = (bf16_t*)(p.ws + OFF_R);
  gemm_tile<0>((const bf16_t*)(p.ws + OFF_HY), 1024, (const bf16_t*)(p.ws + OFF_WUP) + (size_t)l * 5632 * 1024, 1024, 1024, mt * 128, nt * 128, smem, nullptr,
               [&](int row, int col, f32x4 v) { store_bf4(UG + (size_t)row * 5632 + col, v); });
}
DI void act_item(const Params& p, int l, int item) {
  bf16_t* UG = (bf16_t*)(p.ws + OFF_R);
  const float* cw = p.ffn_conv_w + (size_t)l * 3 * DFF;
  for (int i = 0; i < 11; ++i) {
    const int id = ltid() + 256 * i, r = id / 352, cc = id % 352, row = item * 8 + r, k = cc * 8;
    int t, tl; if (row < NLAT) { t = row % T; tl = T; } else { t = (row - NLAT) % TC; tl = TC; }
    bf16_t* up = UG + (size_t)row * 5632 + k; const bf16_t* gp = up + DFF;
    const u32x4 z = {0u, 0u, 0u, 0u};
    const u32x4 u = *(const u32x4*)up, g0 = *(const u32x4*)gp, gm = t > 0 ? *(const u32x4*)(gp - 5632) : z, gn = t < tl - 1 ? *(const u32x4*)(gp + 5632) : z;
    const float uf[8] = {bflo(u.x), bfhi(u.x), bflo(u.y), bfhi(u.y), bflo(u.z), bfhi(u.z), bflo(u.w), bfhi(u.w)};
    const float a[8] = {bflo(gm.x), bfhi(gm.x), bflo(gm.y), bfhi(gm.y), bflo(gm.z), bfhi(gm.z), bflo(gm.w), bfhi(gm.w)};
    const float m[8] = {bflo(g0.x), bfhi(g0.x), bflo(g0.y), bfhi(g0.y), bflo(g0.z), bfhi(g0.z), bflo(g0.w), bfhi(g0.w)};
    const float n[8] = {bflo(gn.x), bfhi(gn.x), bflo(gn.y), bfhi(gn.y), bflo(gn.z), bfhi(gn.z), bflo(gn.w), bfhi(gn.w)};
    float o[8];
#pragma unroll
    for (int j = 0; j < 8; ++j) o[j] = silu_f(cw[k + j] * a[j] + cw[DFF + k + j] * m[j] + cw[2 * DFF + k + j] * n[j]) * uf[j];
    u32x4 ov; ov.x = pack2(o[0], o[1]); ov.y = pack2(o[2], o[3]); ov.z = pack2(o[4], o[5]); ov.w = pack2(o[6], o[7]);
    *(u32x4*)up = ov;
  }
}
DI void ffndown_item(const Params& p, int l, int item, char* smem) {
  const int mt = item >> 3, nt = item & 7;
  const float* MOD = (const float*)(p.ws + OFF_MOD);
  gemm_tile<0>((const bf16_t*)(p.ws + OFF_R), 5632, (const bf16_t*)(p.ws + OFF_WDN) + (size_t)l * 1024 * 2816, 2816, 2816, mt * 128, nt * 128, smem, nullptr,
               [&](int row, int col, f32x4 v) {
                 const int s = row < NLAT ? row / T : 2;
                 const f32x4 gt = *(const f32x4*)(MOD + (size_t)(l * 3 + s) * 6144 + 5120 + col);
                 float* xp = row < NLAT ? p.xb + (size_t)row * 1024 + col : (float*)(p.ws + OFF_CTX) + (size_t)(row - NLAT) * 1024 + col;
                 *(f32x4*)xp = *(f32x4*)xp + gt * v;
               });
}
DI void final_item(const Params& p, int item) {
  const int lane = ltid() & 63, w = __builtin_amdgcn_readfirstlane(ltid() >> 6), row = item * 4 + w;
  float* x = p.xb + (size_t)row * 1024;
  float4 v[4]; float ss = 0.f;
#pragma unroll
  for (int i = 0; i < 4; ++i) { v[i] = *(const float4*)(x + (i * 64 + lane) * 4); ss += v[i].x * v[i].x + v[i].y * v[i].y + v[i].z * v[i].z + v[i].w * v[i].w; }
  ss = wave_sum(ss);
  const float rstd = rsqrtf(ss * (1.f / 1024.f) + 1e-6f);
#pragma unroll
  for (int i = 0; i < 4; ++i) {
    const int k = (i * 64 + lane) * 4; const float4 g = *(const float4*)(p.final_norm + k);
    float4 o; o.x = v[i].x * rstd * g.x; o.y = v[i].y * rstd * g.y; o.z = v[i].z * rstd * g.z; o.w = v[i].w * rstd * g.w;
    *(float4*)(x + k) = o;
  }
}

constexpr int PPL = 12;
constexpr int N_PHASES = 2 + NL * PPL;
#define FOR_ITEMS(n) for (int it = blockIdx.x; it < (n); it += gridDim.x)

DI void run_phase(const Params& p, int ph, char* smem) {
  if (ph == 0) { FOR_ITEMS(P0_ITEMS) p0_item(p, it, smem); return; }
  if (ph == N_PHASES - 1) { FOR_ITEMS(NLAT / 4) final_item(p, it); return; }
  const int l = (ph - 1) / PPL, k = (ph - 1) % PPL;
  const int mtiles = (l == NL - 1) ? 128 : 132;
  switch (k) {
    case 0: FOR_ITEMS(NROW / 4) norm_item(p, l, 0, it); break;
    case 1: FOR_ITEMS(132 * 22) gemm_in_item(p, l, it, smem); break;
    case 2: FOR_ITEMS(2112) s5_p1(p, l, it, smem); break;
    case 3: {
      constexpr int n0 = 2112, n1 = n0 + 2112, n2 = n1 + 528, n3 = n2 + 396, n5 = n3 + 66;
      FOR_ITEMS(n5) {
        if (it < n0) ssd_p1(p, l, it, smem);
        else if (it < n1) mlstm_p1(p, l, it - n0, smem);
        else if (it < n2) kvproj_item(p, l, it - n1, smem);
        else if (it < n3) qproj_item(p, l, it - n2, smem);
        else ropek_item(p, it - n3);
      }
    } break;
    case 4: {
      constexpr int n0 = 512, n1 = n0 + 260, n2 = n1 + 16;
      FOR_ITEMS(n2) { if (it < n0) ssd_p2(p, it); else if (it < n1) mlstm_p2(p, it - n0); else s5_p2(p, l, it - n1); }
    } break;
    case 5: FOR_ITEMS(264) s5_p3(p, l, it, smem); break;
    case 6: {
      constexpr int n0 = 528, n2 = n0 + 1056, n3 = n2 + 1056;
      FOR_ITEMS(n3) {
        if (it < n0) attn_item(p, it, smem);
        else if (it < n2) ssd_p3(p, l, it - n0, smem);
        else mlstm_p3(p, l, it - n2, smem);
      }
    } break;
    case 7: FOR_ITEMS(mtiles * 8) outproj_item(p, l, it, smem); break;
    case 8: FOR_ITEMS(mtiles * 32) norm_item(p, l, 1, it); break;
    case 9: FOR_ITEMS(mtiles * 44) ffnup_item(p, l, it, smem); break;
    case 10: FOR_ITEMS(mtiles * 16) act_item(p, l, it); break;
    case 11: FOR_ITEMS(mtiles * 8) ffndown_item(p, l, it, smem); break;
  }
}

#ifndef HASH_LO
#define HASH_LO OFF_MOD
#define HASH_HI WS_NEED
#endif
#ifndef PROBE_N
#define PROBE_N 0
#endif
DI void hash_dump(const Params& p) {
  const size_t NOUT = (size_t)NLAT * 1024, nw = (HASH_HI - HASH_LO) / 4;
  const unsigned* wsw = (const unsigned*)(p.ws + HASH_LO);
  for (size_t i = (size_t)blockIdx.x * 256 + threadIdx.x; i < NOUT; i += (size_t)gridDim.x * 256) {
    unsigned h = 12345u;
    for (size_t j = i; j < nw; j += NOUT) h = h * 1664525u + wsw[j];
    p.xb[i] = (float)(h & 0xFFFFFFu);
  }
}

#define XB_TMO      128
#define XB_XCNT(j)  (256  + 64 * (j))
#define XB_XSUB(j)  (1280 + 64 * (j))
#define XB_XGEN(j)  (2304 + 64 * (j))
#define XB_TOP      3328
#define XB_TOPGEN   3392
#define XCD_BAR_WORDS 3456
#define XB_SPIN_CAP (1u << 22)
#define LAS __attribute__((address_space(3)))
DI unsigned xb_ld(unsigned* p) { return __hip_atomic_load(p, __ATOMIC_RELAXED, __HIP_MEMORY_SCOPE_AGENT); }
DI unsigned xb_add(unsigned* p, unsigned v) { return __hip_atomic_fetch_add(p, v, __ATOMIC_RELAXED, __HIP_MEMORY_SCOPE_AGENT); }
DI unsigned xb_xcc_id() { return (unsigned)__builtin_amdgcn_s_getreg((3 << 11) | 20) & 0xFu; }
#define XB_SPIN(cond, bar) do { unsigned _sp = 0; while (cond) { __builtin_amdgcn_s_sleep(1); \
    if ((++_sp & 255u) == 0u) { if (xb_ld(&(bar)[XB_TMO])) break; if (_sp > XB_SPIN_CAP) { atomicAdd(&(bar)[XB_TMO], 1u); break; } } } } while (0)
struct XcdBarrier { unsigned* bar; unsigned x; volatile LAS unsigned* st; };
DI XcdBarrier xcd_barrier_post(unsigned* bar, volatile LAS unsigned* st) {
  XcdBarrier b; b.bar = bar; b.x = xb_xcc_id(); b.st = st;
  if (threadIdx.x == 0) (void)xb_add(&bar[XB_XCNT(b.x)], 1u);
  return b;
}
DI void xcd_barrier_complete(unsigned* bar, unsigned x, unsigned& nloc, unsigned& nx) {
  const unsigned G = gridDim.x;
  unsigned sum, cnt, mine, sp = 0u;
  for (;;) {
    sum = 0u; cnt = 0u; mine = 0u;
#pragma unroll
    for (unsigned j = 0; j < 16; ++j) { const unsigned c = xb_ld(&bar[XB_XCNT(j)]); sum += c; cnt += (c > 0u) ? 1u : 0u; mine = (j == x) ? c : mine; }
    if (sum == G) break;
    __builtin_amdgcn_s_sleep(1);
    if ((++sp & 255u) == 0u) { if (xb_ld(&bar[XB_TMO])) break; if (sp > XB_SPIN_CAP) { atomicAdd(&bar[XB_TMO], 1u); break; } }
  }
  nloc = mine > 0u ? mine : 1u; nx = cnt > 0u ? cnt : 1u;
}
DI void xcd_barrier(const XcdBarrier& b) {
  asm volatile("s_waitcnt vmcnt(0)" ::: "memory");
  __syncthreads();
  if (threadIdx.x == 0) {
    unsigned* bar = b.bar;
    __builtin_amdgcn_s_waitcnt(0);
    unsigned nloc = b.st[0], nx = b.st[1];
    if (nloc == 0u) { xcd_barrier_complete(bar, b.x, nloc, nx); b.st[0] = nloc; b.st[1] = nx; }
    const unsigned old = xb_add(&bar[XB_XSUB(b.x)], 1u);
    const unsigned gen = old / nloc;
    if (old + 1u == (gen + 1u) * nloc) {
      __builtin_amdgcn_fence(__ATOMIC_RELEASE, "agent");
      asm volatile("s_waitcnt vmcnt(0)" ::: "memory");
      const unsigned og = xb_add(&bar[XB_TOP], 1u);
      const unsigned tg = og / nx;
      if (og + 1u == (tg + 1u) * nx) xb_add(&bar[XB_TOPGEN], 1u);
      else XB_SPIN(xb_ld(&bar[XB_TOPGEN]) == tg, bar);
      __builtin_amdgcn_fence(__ATOMIC_ACQUIRE, "agent");
      xb_add(&bar[XB_XGEN(b.x)], 1u);
      asm volatile("s_waitcnt vmcnt(0)" ::: "memory");
    } else {
      XB_SPIN(xb_ld(&bar[XB_XGEN(b.x)]) == gen, bar);
      __builtin_amdgcn_fence(__ATOMIC_ACQUIRE, "agent");
      asm volatile("s_waitcnt vmcnt(0)" ::: "memory");
    }
  }
  __syncthreads();
}
constexpr size_t OFF_BAR = ((WS_NEED + 255) / 256) * 256;
constexpr int SMEM_BYTES = 59392;
__global__ void __launch_bounds__(256, 2) trunk_fwd(Params p) {
  __shared__ __attribute__((aligned(16))) char smem[SMEM_BYTES];
  __shared__ uint4 xb_words;
  cg::grid_group grid = cg::this_grid();
  if (threadIdx.x == 0) xb_words = make_uint4(0u, 0u, 0u, 0u);
  __syncthreads();
  XcdBarrier xb = xcd_barrier_post((unsigned*)(p.ws + OFF_BAR), (volatile LAS unsigned*)&xb_words);
  for (int ph = p.ph_lo; ph < p.ph_hi; ++ph) {
    run_phase(p, ph, smem);
    if (ph + 1 < p.ph_hi) { if (ph == p.ph_lo) grid.sync(); else xcd_barrier(xb); }
  }
}

__global__ void __launch_bounds__(256) hash_kernel(Params p) { hash_dump(p); }

extern "C" void kernel_launch(void* const* d_in, const int* in_sizes, int n_in, void* d_out, int out_size, void* d_ws, size_t ws_size, hipStream_t stream) {
  static int grid_blocks = 0;
  if (!grid_blocks) {
    int dev = 0, cus = 0, per_cu = 0;
    hipGetDevice(&dev);
    hipDeviceGetAttribute(&cus, hipDeviceAttributeMultiprocessorCount, dev);
    hipOccupancyMaxActiveBlocksPerMultiprocessor(&per_cu, trunk_fwd, 256, 0);
    if (per_cu > 2) per_cu = 2;
    grid_blocks = cus * per_cu;
  }
  if (ws_size < OFF_BAR + XCD_BAR_WORDS * 4) { fprintf(stderr, "workspace too small: %zu < %zu\n", ws_size, (size_t)WS_NEED); return; }
  Params p{};
  const float** fp = (const float**)&p;
  for (int i = 0; i < 35; ++i) fp[i] = (const float*)d_in[i];
  p.xb = (float*)d_out; p.ws = (char*)d_ws;
#if MULTI_LAUNCH
#if PROBE_N
  for (int ph = 0; ph < PROBE_N; ++ph) { p.ph_lo = ph; p.ph_hi = ph + 1; hipLaunchKernelGGL(trunk_fwd, dim3(grid_blocks), dim3(256), 0, stream, p); }
  hipLaunchKernelGGL(hash_kernel, dim3(grid_blocks), dim3(256), 0, stream, p);
#else
  for (int ph = 0; ph < N_PHASES; ++ph) { p.ph_lo = ph; p.ph_hi = ph + 1; hipLaunchKernelGGL(trunk_fwd, dim3(grid_blocks), dim3(256), 0, stream, p); }
#endif
#else
  p.ph_lo = 0; p.ph_hi = N_PHASES;
  hipMemsetAsync((char*)d_ws + OFF_BAR, 0, XCD_BAR_WORDS * 4, stream);
  void* args[] = {&p};
  hipError_t e = hipLaunchCooperativeKernel((void*)trunk_fwd, dim3(grid_blocks), dim3(256), args, 0, stream);
  if (e != hipSuccess) fprintf(stderr, "cooperative launch failed: %s (grid %d)\n", hipGetErrorString(e), grid_blocks);
#endif
}
```

```cpp
#include <hip/hip_runtime.h>
#include <hip/hip_cooperative_groups.h>
#include <cstdio>
#include <cstdint>
namespace cg = cooperative_groups;

#ifndef PROBE_MASK
#define PROBE_MASK 63
#endif
#ifndef ZERO_FILL
#define ZERO_FILL 0
#endif
#ifndef MULTI_LAUNCH
#define MULTI_LAUNCH 0
#endif

typedef unsigned short bf16_t;
typedef short bf16x8 __attribute__((ext_vector_type(8)));
typedef float f32x4 __attribute__((ext_vector_type(4)));
typedef unsigned u32x4 __attribute__((ext_vector_type(4)));
typedef unsigned u32x2 __attribute__((ext_vector_type(2)));
#define DI __device__ __forceinline__
#define MFMA16(a, b, c) __builtin_amdgcn_mfma_f32_16x16x32_bf16((a), (b), (c), 0, 0, 0)

constexpr int NB = 2, T = 8192, TC = 256, NL = 4;
constexpr int NLAT = NB * T, NROW = NLAT + NB * TC;
constexpr int TALL = T + TC;
constexpr int PINP = 2816;
constexpr int C_MLQ = 0, C_MLK = 256, C_MLV = 512, C_MLO = 768, C_CQ = 1040, C_CKV = 1296, C_KR = 1424,
              C_Z = 1456, C_XBC = 1712, C_S5 = 2488;
constexpr int NCH = 132;
constexpr int DFF = 2816;

constexpr size_t SZ_WIN = (size_t)NL * 2816 * 1024 * 2, SZ_WUQ = (size_t)NL * 384 * 256 * 2, SZ_WUKV = (size_t)NL * 512 * 128 * 2,
                 SZ_WGLU = (size_t)NL * 256 * 256 * 2, SZ_WOUT = (size_t)NL * 1024 * 1024 * 2, SZ_WUP = (size_t)NL * 5632 * 1024 * 2,
                 SZ_WDN = (size_t)NL * 1024 * 2816 * 2, SZ_MOD = (size_t)NL * 3 * 6144 * 4, SZ_CTX = (size_t)512 * 1024 * 4,
                 SZ_HY = (size_t)NROW * 1024 * 2, SZ_GML = (size_t)NROW * 16 * 4, SZ_DTR = (size_t)NROW * 8 * 4, SZ_SSQ = (size_t)NROW * 4 * 4,
                 SZ_QRAW = (size_t)NROW * 384 * 2, SZ_KH = (size_t)NB * 4 * TALL * 64 * 2 + (size_t)NB * TALL * 32 * 2, SZ_VT = (size_t)NB * 4 * 64 * TALL * 2,
                 SZ_S5S = (size_t)NB * 16 * 2 * NCH * 128 * 4, SZ_MLM = (size_t)16 * NCH * 32 * 4, SZ_SSA = (size_t)16 * NCH * 32 * 4,
                 SZ_P = (size_t)NROW * PINP * 2, SZ_MLS = (size_t)16 * NCH * 4160 * 4, SZ_SSDS = (size_t)16 * NCH * 8192 * 4;
constexpr size_t OFF_WIN = 0, OFF_WUQ = OFF_WIN + SZ_WIN, OFF_WUKV = OFF_WUQ + SZ_WUQ, OFF_WGLU = OFF_WUKV + SZ_WUKV,
                 OFF_WOUT = OFF_WGLU + SZ_WGLU, OFF_WUP = OFF_WOUT + SZ_WOUT, OFF_WDN = OFF_WUP + SZ_WUP, OFF_MOD = OFF_WDN + SZ_WDN,
                 OFF_CTX = OFF_MOD + SZ_MOD, OFF_HY = OFF_CTX + SZ_CTX, OFF_GML = OFF_HY + SZ_HY, OFF_DTR = OFF_GML + SZ_GML,
                 OFF_SSQ = OFF_DTR + SZ_DTR, OFF_QRAW = OFF_SSQ + SZ_SSQ, OFF_KH = OFF_QRAW + SZ_QRAW, OFF_VT = OFF_KH + SZ_KH,
                 OFF_S5S = OFF_VT + SZ_VT, OFF_MLM = OFF_S5S + SZ_S5S, OFF_SSA = OFF_MLM + SZ_MLM,
                 OFF_R = ((OFF_SSA + SZ_SSA + 255) / 256) * 256, OFF_P = OFF_R, OFF_MLS = OFF_P + SZ_P, OFF_SSDS = OFF_MLS + SZ_MLS,
                 WS_NEED = OFF_SSDS + SZ_SSDS;
static_assert((size_t)NROW * 5632 * 2 <= SZ_P + SZ_MLS + SZ_SSDS, "UG overlay");

constexpr size_t OFF_KR = OFF_KH + (size_t)NB * 4 * TALL * 64 * 2;
struct Params {
  const float *x, *c, *ctx, *c_ctx, *w_mod, *b_mod, *norm1, *norm2, *w_in, *ml_gate_bias, *ml_norm, *mla_q_norm, *mla_kv_norm,
      *mla_w_uq, *mla_w_ukv, *ssd_conv_w, *ssd_conv_b, *ssd_a_log, *ssd_dt_bias, *ssd_d, *ssd_norm, *s5_a_re, *s5_a_im, *s5_log_dt,
      *s5_b_re, *s5_b_im, *s5_c_re, *s5_c_im, *s5_d, *s5_w_glu, *w_out, *ffn_w_up, *ffn_conv_w, *ffn_w_down, *final_norm;
  float* xb;
  char* ws;
  int ph_lo, ph_hi;
};

typedef __bf16 hbf16x2 __attribute__((ext_vector_type(2)));
typedef float f32x2 __attribute__((ext_vector_type(2)));
DI bf16_t f2bf(float x) { return __builtin_bit_cast(bf16_t, (__bf16)x); }
DI float bf2f(bf16_t v) { return __uint_as_float(((unsigned)v) << 16); }
DI unsigned pack2(float lo, float hi) { f32x2 v = {lo, hi}; return __builtin_bit_cast(unsigned, __builtin_convertvector(v, hbf16x2)); }
DI float bflo(unsigned w) { return __uint_as_float(w << 16); }
DI float bfhi(unsigned w) { return __uint_as_float(w & 0xffff0000u); }
DI float silu_f(float x) { return x / (1.f + __expf(-x)); }
DI float sigm_f(float x) { return 1.f / (1.f + __expf(-x)); }
DI float softplus_f(float x) { return fmaxf(x, 0.f) + log1pf(__expf(-fabsf(x))); }
DI float logsigm_f(float x) { return fminf(x, 0.f) - log1pf(__expf(-fabsf(x))); }
DI float gelu_tanh_f(float x) { float u = 0.7978845608f * (x + 0.044715f * x * x * x); return x * sigm_f(2.f * u); }
DI float wave_sum(float v) { for (int o = 32; o; o >>= 1) v += __shfl_xor(v, o); return v; }
DI float wave_max(float v) { for (int o = 32; o; o >>= 1) v = fmaxf(v, __shfl_xor(v, o)); return v; }
DI float wave_incl_scan(float v, int lane) { for (int o = 1; o < 64; o <<= 1) { float t = __shfl_up(v, o); if (lane >= o) v += t; } return v; }
DI float red16_max(float v) { v = fmaxf(v, __shfl_xor(v, 1)); v = fmaxf(v, __shfl_xor(v, 2)); v = fmaxf(v, __shfl_xor(v, 4)); v = fmaxf(v, __shfl_xor(v, 8)); return v; }
DI float red16_sum(float v) { v += __shfl_xor(v, 1); v += __shfl_xor(v, 2); v += __shfl_xor(v, 4); v += __shfl_xor(v, 8); return v; }
DI bf16x8 ld_frag(const bf16_t* p) { return *(const bf16x8*)p; }
DI bf16x8 mk_frag(unsigned a, unsigned b, unsigned c, unsigned d) { u32x4 u = {a, b, c, d}; return __builtin_bit_cast(bf16x8, u); }
DI bf16x8 frag_from_f32(const float* p, float sgn) {
  float4 a = *(const float4*)p, b = *(const float4*)(p + 4);
  return mk_frag(pack2(a.x * sgn, a.y * sgn), pack2(a.z * sgn, a.w * sgn), pack2(b.x * sgn, b.y * sgn), pack2(b.z * sgn, b.w * sgn));
}
DI int ltid() { int t = threadIdx.x; asm volatile("" : "+v"(t)); return t; }
DI int row_of(int b, int part, int t) { return part ? NLAT + b * TC + t : b * T + t; }

DI void tr_tile(const float* __restrict__ src, int K, int N, bf16_t* __restrict__ dst, const float* gain, int glo, int ghi, int tk, int tn, float* tile) {
  const int tid = ltid(), c = tid & 63, rq = tid >> 6;
  for (int rr = 0; rr < 16; ++rr) {
    const int r = rr * 4 + rq, k = tk * 64 + r, n = tn * 64 + c;
    float v = (n < N) ? src[(size_t)k * N + n] : 0.f;
    if (gain && k >= glo && k < ghi) v *= gain[k - glo];
    tile[r * 65 + c] = v;
  }
  __syncthreads();
  for (int cc = 0; cc < 16; ++cc) { const int n = cc * 4 + rq; dst[(size_t)(tn * 64 + n) * K + tk * 64 + c] = f2bf(tile[c * 65 + n]); }
  __syncthreads();
}

constexpr int TR_PER_LAYER = 3128, P0_TR = NL * TR_PER_LAYER, P0_MOD = NL * 96, P0_CPX = NLAT * 1024 / 4096, P0_CPC = 512 * 1024 / 4096;
constexpr int P0_ZERO = (int)((WS_NEED - OFF_HY + 65535) / 65536);
constexpr int P0_ITEMS = P0_TR + P0_MOD + P0_CPX + P0_CPC + (ZERO_FILL ? P0_ZERO : 0);

DI void p0_item(const Params& p, int item, char* smem) {
  const int tid = ltid();
  if (item < P0_TR) {
    const int l = item / TR_PER_LAYER; int t = item % TR_PER_LAYER; float* tile = (float*)smem;
    if (t < 704) { tr_tile(p.w_in + (size_t)l * 1024 * 2744, 1024, 2744, (bf16_t*)(p.ws + OFF_WIN) + (size_t)l * 2816 * 1024, nullptr, 0, 0, t / 44, t % 44, tile); return; }
    t -= 704;
    if (t < 24) { tr_tile(p.mla_w_uq + (size_t)l * 256 * 384, 256, 384, (bf16_t*)(p.ws + OFF_WUQ) + (size_t)l * 384 * 256, p.mla_q_norm + l * 256, 0, 256, t / 6, t % 6, tile); return; }
    t -= 24;
    if (t < 16) { tr_tile(p.mla_w_ukv + (size_t)l * 128 * 512, 128, 512, (bf16_t*)(p.ws + OFF_WUKV) + (size_t)l * 512 * 128, p.mla_kv_norm + l * 128, 0, 128, t / 8, t % 8, tile); return; }
    t -= 16;
    if (t < 16) { tr_tile(p.s5_w_glu + (size_t)l * 256 * 256, 256, 256, (bf16_t*)(p.ws + OFF_WGLU) + (size_t)l * 256 * 256, nullptr, 0, 0, t / 4, t % 4, tile); return; }
    t -= 16;
    if (t < 256) { tr_tile(p.w_out + (size_t)l * 1024 * 1024, 1024, 1024, (bf16_t*)(p.ws + OFF_WOUT) + (size_t)l * 1024 * 1024, p.ssd_norm + l * 256, 512, 768, t / 16, t % 16, tile); return; }
    t -= 256;
    if (t < 1408) { tr_tile(p.ffn_w_up + (size_t)l * 1024 * 5632, 1024, 5632, (bf16_t*)(p.ws + OFF_WUP) + (size_t)l * 5632 * 1024, nullptr, 0, 0, t / 88, t % 88, tile); return; }
    t -= 1408;
    tr_tile(p.ffn_w_down + (size_t)l * 2816 * 1024, 2816, 1024, (bf16_t*)(p.ws + OFF_WDN) + (size_t)l * 1024 * 2816, nullptr, 0, 0, t / 16, t % 16, tile);
    return;
  }
  item -= P0_TR;
  if (item < P0_MOD) {
    const int l = item / 96, cb = item % 96, cl = tid & 63, kq = tid >> 6;
    float* sv = (float*)smem;
    float* red = sv + 3072;
    for (int i = tid; i < 1024; i += 256) { sv[i] = silu_f(p.c[i]); sv[1024 + i] = silu_f(p.c[1024 + i]); sv[2048 + i] = silu_f(p.c_ctx[i]); }
    __syncthreads();
    const int col = cb * 64 + cl; const float* W = p.w_mod + (size_t)l * 1024 * 6144 + col;
    float a0 = 0.f, a1 = 0.f, a2 = 0.f;
#pragma unroll 8
    for (int k = kq * 256; k < kq * 256 + 256; ++k) { const float w = W[(size_t)k * 6144]; a0 += sv[k] * w; a1 += sv[1024 + k] * w; a2 += sv[2048 + k] * w; }
    red[(kq * 3 + 0) * 64 + cl] = a0; red[(kq * 3 + 1) * 64 + cl] = a1; red[(kq * 3 + 2) * 64 + cl] = a2;
    __syncthreads();
    if (tid < 192) {
      const int s = tid >> 6; const float bm = p.b_mod[l * 6144 + col];
      const float v = red[(0 * 3 + s) * 64 + cl] + red[(1 * 3 + s) * 64 + cl] + red[(2 * 3 + s) * 64 + cl] + red[(3 * 3 + s) * 64 + cl] + bm;
      ((float*)(p.ws + OFF_MOD))[(size_t)(l * 3 + s) * 6144 + col] = v;
    }
    __syncthreads();
    return;
  }
  item -= P0_MOD;
  if (item >= P0_CPX + P0_CPC) {
    item -= P0_CPX + P0_CPC;
    char* z = p.ws + OFF_HY + (size_t)item * 65536;
    const size_t lim = WS_NEED - OFF_HY - (size_t)item * 65536;
    for (int i = 0; i < 16; ++i) { const size_t o = (size_t)(i * 256 + tid) * 16; if (o < lim) *(u32x4*)(z + o) = (u32x4){0u, 0u, 0u, 0u}; }
    return;
  }
  const float* src; float* dst;
  if (item < P0_CPX) { src = p.x + (size_t)item * 4096; dst = p.xb + (size_t)item * 4096; }
  else { item -= P0_CPX; src = p.ctx + (size_t)item * 4096; dst = (float*)(p.ws + OFF_CTX) + (size_t)item * 4096; }
  for (int i = 0; i < 4; ++i) { const int o = (i * 256 + tid) * 4; *(float4*)(dst + o) = *(const float4*)(src + o); }
}

DI void norm_item(const Params& p, int l, int which, int item) {
  const int lane = ltid() & 63, w = __builtin_amdgcn_readfirstlane(ltid() >> 6), row = item * 4 + w;
  const float* x = row < NLAT ? p.xb + (size_t)row * 1024 : (const float*)(p.ws + OFF_CTX) + (size_t)(row - NLAT) * 1024;
  float4 v[4]; float ss = 0.f;
#pragma unroll
  for (int i = 0; i < 4; ++i) { v[i] = *(const float4*)(x + (i * 64 + lane) * 4); ss += v[i].x * v[i].x + v[i].y * v[i].y + v[i].z * v[i].z + v[i].w * v[i].w; }
  ss = wave_sum(ss);
  const float rstd = rsqrtf(ss * (1.f / 1024.f) + 1e-6f);
  const int s = row < NLAT ? row / T : 2;
  const float* g = (which ? p.norm2 : p.norm1) + l * 1024;
  const float* md = (const float*)(p.ws + OFF_MOD) + (size_t)(l * 3 + s) * 6144 + (which ? 3072 : 0);
  bf16_t* H = (bf16_t*)(p.ws + OFF_HY) + (size_t)row * 1024;
#pragma unroll
  for (int i = 0; i < 4; ++i) {
    const int k = (i * 64 + lane) * 4;
    const float4 g4 = *(const float4*)(g + k), sh = *(const float4*)(md + k), sc = *(const float4*)(md + 1024 + k);
    u32x2 o; o.x = pack2(v[i].x * rstd * g4.x * (1.f + sc.x) + sh.x, v[i].y * rstd * g4.y * (1.f + sc.y) + sh.y);
    o.y = pack2(v[i].z * rstd * g4.z * (1.f + sc.z) + sh.z, v[i].w * rstd * g4.w * (1.f + sc.w) + sh.w);
    *(u32x2*)(H + k) = o;
  }
}

template <int AMODE, class Epi>
DI void gemm_tile(const bf16_t* __restrict__ A, int lda, const bf16_t* __restrict__ Bt, int ldb, int K, int m0, int n0, char* smem, const float* ssq, Epi epi) {
  bf16_t* As = (bf16_t*)smem; bf16_t* Bs = As + 128 * 72;
  const int tid = ltid(), lane = tid & 63, w = __builtin_amdgcn_readfirstlane(tid >> 6), wm = w >> 1, wn = w & 1, l15 = lane & 15, g4 = lane >> 4;
  u32x4 ar[4], br[4]; float rs[4];
  const int r0 = tid >> 3, cc = tid & 7;
  const bf16_t* ap = A + (size_t)(m0 + r0) * lda + cc * 8;
  const bf16_t* bp = Bt + (size_t)(n0 + r0) * ldb + cc * 8;
  const size_t astep = (size_t)32 * lda, bstep = (size_t)32 * ldb;
  if (AMODE == 1) {
#pragma unroll
    for (int i = 0; i < 4; ++i) { const float* q = ssq + (m0 + r0 + 32 * i); rs[i] = rsqrtf((q[0] + q[NROW] + q[2 * NROW] + q[3 * NROW]) * (1.f / 256.f) + 1e-6f); }
  }
  f32x4 acc[4][4];
#pragma unroll
  for (int i = 0; i < 4; ++i)
#pragma unroll
    for (int j = 0; j < 4; ++j) acc[i][j] = (f32x4){0.f, 0.f, 0.f, 0.f};
#pragma unroll
  for (int i = 0; i < 4; ++i) { ar[i] = *(const u32x4*)(ap + i * astep); br[i] = *(const u32x4*)(bp + i * bstep); }
  const int nk = K >> 6;
  for (int kt = 0; kt < nk; ++kt) {
    if (AMODE == 1 && kt >= 8 && kt < 12) {
#pragma unroll
      for (int i = 0; i < 4; ++i) {
        const float s = rs[i]; u32x4 q = ar[i];
        q.x = pack2(bflo(q.x) * s, bfhi(q.x) * s); q.y = pack2(bflo(q.y) * s, bfhi(q.y) * s);
        q.z = pack2(bflo(q.z) * s, bfhi(q.z) * s); q.w = pack2(bflo(q.w) * s, bfhi(q.w) * s); ar[i] = q;
      }
    }
#pragma unroll
    for (int i = 0; i < 4; ++i) { *(u32x4*)(As + (r0 + 32 * i) * 72 + cc * 8) = ar[i]; *(u32x4*)(Bs + (r0 + 32 * i) * 72 + cc * 8) = br[i]; }
    __syncthreads();
    if (kt + 1 < nk) {
#pragma unroll
      for (int i = 0; i < 4; ++i) { ar[i] = *(const u32x4*)(ap + i * astep + (kt + 1) * 64); br[i] = *(const u32x4*)(bp + i * bstep + (kt + 1) * 64); }
    }
    __builtin_amdgcn_sched_barrier(0);
#pragma unroll
    for (int ks = 0; ks < 2; ++ks) {
      bf16x8 af[4], bfr[4];
#pragma unroll
      for (int i = 0; i < 4; ++i) { af[i] = ld_frag(As + (64 * wm + 16 * i + l15) * 72 + ks * 32 + g4 * 8); bfr[i] = ld_frag(Bs + (64 * wn + 16 * i + l15) * 72 + ks * 32 + g4 * 8); }
#pragma unroll
      for (int i = 0; i < 4; ++i)
#pragma unroll
        for (int j = 0; j < 4; ++j) acc[i][j] = MFMA16(bfr[j], af[i], acc[i][j]);
    }
    __syncthreads();
  }
#pragma unroll
  for (int i = 0; i < 4; ++i)
#pragma unroll
    for (int j = 0; j < 4; ++j) epi(m0 + 64 * wm + 16 * i + l15, n0 + 64 * wn + 16 * j + 4 * g4, acc[i][j]);
}

DI void store_bf4(bf16_t* dst, f32x4 v) { u32x2 o; o.x = pack2(v[0], v[1]); o.y = pack2(v[2], v[3]); *(u32x2*)dst = o; }

DI void gemm_in_item(const Params& p, int l, int item, char* smem) {
  const int mt = item / 22, nt = item % 22;
  bf16_t* P = (bf16_t*)(p.ws + OFF_P); float* GML = (float*)(p.ws + OFF_GML); float* DTR = (float*)(p.ws + OFF_DTR);
  gemm_tile<0>((const bf16_t*)(p.ws + OFF_HY), 1024, (const bf16_t*)(p.ws + OFF_WIN) + (size_t)l * 2816 * 1024, 1024, 1024, mt * 128, nt * 128, smem, nullptr,
               [&](int row, int col, f32x4 v) {
                 store_bf4(P + (size_t)row * PINP + col, v);
                 if (col >= 1024 && col < 1040) *(f32x4*)(GML + (size_t)row * 16 + (col - 1024)) = v;
                 if (col >= 2480 && col < 2488) *(f32x4*)(DTR + (size_t)row * 8 + (col - 2480)) = v;
               });
}

DI void tile_rstd(const bf16_t* P, int m0, int col0, int ncols, float* rst) {
  const int tid = ltid(), r = tid >> 1, hf = tid & 1, n = ncols >> 1;
  const bf16_t* src = P + (size_t)(m0 + r) * PINP + col0 + hf * n;
  float ss = 0.f;
  for (int c = 0; c < n; c += 8) { const u32x4 q = *(const u32x4*)(src + c);
    ss += bflo(q.x) * bflo(q.x) + bfhi(q.x) * bfhi(q.x) + bflo(q.y) * bflo(q.y) + bfhi(q.y) * bfhi(q.y) + bflo(q.z) * bflo(q.z) + bfhi(q.z) * bfhi(q.z) + bflo(q.w) * bflo(q.w) + bfhi(q.w) * bfhi(q.w); }
  ss += __shfl_xor(ss, 1);
  if (hf == 0) rst[r] = rsqrtf(ss / (float)ncols + 1e-6f);
  __syncthreads();
}
DI void qproj_item(const Params& p, int l, int item, char* smem) {
  const int mt = item / 3, nt = item % 3; const bf16_t* P = (const bf16_t*)(p.ws + OFF_P);
  float* rst = (float*)(smem + 36864);
  tile_rstd(P, mt * 128, C_CQ, 256, rst);
  bf16_t* Q = (bf16_t*)(p.ws + OFF_QRAW);
  gemm_tile<0>(P + C_CQ, PINP, (const bf16_t*)(p.ws + OFF_WUQ) + (size_t)l * 384 * 256, 256, 256, mt * 128, nt * 128, smem, nullptr,
               [&](int row, int col, f32x4 v) { const float r = rst[row - mt * 128]; store_bf4(Q + (size_t)row * 384 + col, v * r); });
  __syncthreads();
}
DI void kvproj_item(const Params& p, int l, int item, char* smem) {
  const int mt = item / 4, nt = item % 4; const bf16_t* P = (const bf16_t*)(p.ws + OFF_P);
  float* rst = (float*)(smem + 36864);
  tile_rstd(P, mt * 128, C_CKV, 128, rst);
  bf16_t* KH = (bf16_t*)(p.ws + OFF_KH); bf16_t* VT = (bf16_t*)(p.ws + OFF_VT);
  gemm_tile<0>(P + C_CKV, PINP, (const bf16_t*)(p.ws + OFF_WUKV) + (size_t)l * 512 * 128, 128, 128, mt * 128, nt * 128, smem, nullptr,
               [&](int row, int col, f32x4 v) {
                 const float r = rst[row - mt * 128]; v = v * r;
                 const int hh = col >> 7, dd = col & 127;
                 int b, tpos; if (row < NLAT) { b = row / T; tpos = row % T; } else { b = (row - NLAT) / TC; tpos = T + (row - NLAT) % TC; }
                 if (dd < 64) store_bf4(KH + ((size_t)(b * 4 + hh) * TALL + tpos) * 64 + dd, v);
                 else {
                   bf16_t* vp = VT + ((size_t)(b * 4 + hh) * 64 + (dd - 64)) * TALL + tpos;
                   vp[0] = f2bf(v[0]); vp[TALL] = f2bf(v[1]); vp[2 * TALL] = f2bf(v[2]); vp[3 * TALL] = f2bf(v[3]);
                 }
               });
  __syncthreads();
}
DI void rope_cs(int t, int i, float& cs, float& sn) {
  const int pos = (i < 8) ? (t >> 6) : (t & 63); const int f = i & 7;
  const float inv = exp2f(-(float)f * (13.287712379549449f / 8.f));
  const float ang = (float)pos * inv;
  cs = cosf(ang); sn = sinf(ang);
}
DI void ropek_item(const Params& p, int item) {
  const int row = item * 256 + ltid();
  const bf16_t* src = (const bf16_t*)(p.ws + OFF_P) + (size_t)row * PINP + C_KR;
  u32x4 q[4];
#pragma unroll
  for (int i = 0; i < 4; ++i) q[i] = *(const u32x4*)(src + i * 8);
  float v[32];
#pragma unroll
  for (int i = 0; i < 4; ++i) { v[i * 8 + 0] = bflo(q[i].x); v[i * 8 + 1] = bfhi(q[i].x); v[i * 8 + 2] = bflo(q[i].y); v[i * 8 + 3] = bfhi(q[i].y);
    v[i * 8 + 4] = bflo(q[i].z); v[i * 8 + 5] = bfhi(q[i].z); v[i * 8 + 6] = bflo(q[i].w); v[i * 8 + 7] = bfhi(q[i].w); }
  int b, tpos;
  if (row < NLAT) {
    b = row / T; tpos = row % T;
#pragma unroll
    for (int i = 0; i < 16; ++i) { float cs, sn; rope_cs(tpos, i, cs, sn); const float x1 = v[i], x2 = v[i + 16]; v[i] = x1 * cs - x2 * sn; v[i + 16] = x1 * sn + x2 * cs; }
  } else { b = (row - NLAT) / TC; tpos = T + (row - NLAT) % TC; }
  u32x4 o[4];
#pragma unroll
  for (int i = 0; i < 4; ++i) { o[i].x = pack2(v[i * 8], v[i * 8 + 1]); o[i].y = pack2(v[i * 8 + 2], v[i * 8 + 3]); o[i].z = pack2(v[i * 8 + 4], v[i * 8 + 5]); o[i].w = pack2(v[i * 8 + 6], v[i * 8 + 7]); }
  bf16_t* dst = (bf16_t*)(p.ws + OFF_KR) + ((size_t)b * TALL + tpos) * 32;
#pragma unroll
  for (int i = 0; i < 4; ++i) *(u32x4*)(dst + i * 8) = o[i];
}

DI void attn_item(const Params& p, int item, char* smem) {
  const int tid = ltid(), lane = tid & 63, w = __builtin_amdgcn_readfirstlane(tid >> 6), l15 = lane & 15, g4 = lane >> 4;
  int b, h, qt, latent;
  if (item < 512) { latent = 1; qt = item & 63; h = (item >> 6) & 3; b = item >> 8; }
  else { latent = 0; const int i2 = item - 512; qt = i2 & 1; h = (i2 >> 1) & 3; b = i2 >> 3; }
  const int qrow0 = latent ? b * T + qt * 128 : NLAT + b * TC + qt * 128;
  bf16_t* Qs = (bf16_t*)smem;
  bf16_t* Ks = (bf16_t*)smem;
  bf16_t* Vs = Ks + 64 * 104;
  const bf16_t* Qraw = (const bf16_t*)(p.ws + OFF_QRAW);
  const float qscale = 0.10206207261596577f * 1.4426950408889634f;
  for (int id = tid; id < 1280; id += 256) {
    const int r = id / 10, cc = id % 10;
    const bf16_t* src = Qraw + (size_t)(qrow0 + r) * 384 + h * 96 + cc * 8;
    const u32x4 q = *(const u32x4*)src;
    float a[8] = {bflo(q.x), bfhi(q.x), bflo(q.y), bfhi(q.y), bflo(q.z), bfhi(q.z), bflo(q.w), bfhi(q.w)};
    if (cc < 8) {
      u32x4 o; o.x = pack2(a[0] * qscale, a[1] * qscale); o.y = pack2(a[2] * qscale, a[3] * qscale); o.z = pack2(a[4] * qscale, a[5] * qscale); o.w = pack2(a[6] * qscale, a[7] * qscale);
      *(u32x4*)(Qs + r * 104 + cc * 8) = o;
    } else {
      const u32x4 q2 = *(const u32x4*)(src + 16);
      float c2[8] = {bflo(q2.x), bfhi(q2.x), bflo(q2.y), bfhi(q2.y), bflo(q2.z), bfhi(q2.z), bflo(q2.w), bfhi(q2.w)};
      float o1[8], o2[8];
#pragma unroll
      for (int j = 0; j < 8; ++j) {
        float cs = 1.f, sn = 0.f;
        if (latent) rope_cs(qt * 128 + r, (cc - 8) * 8 + j, cs, sn);
        o1[j] = (a[j] * cs - c2[j] * sn) * qscale; o2[j] = (a[j] * sn + c2[j] * cs) * qscale;
      }
      u32x4 o; o.x = pack2(o1[0], o1[1]); o.y = pack2(o1[2], o1[3]); o.z = pack2(o1[4], o1[5]); o.w = pack2(o1[6], o1[7]);
      *(u32x4*)(Qs + r * 104 + cc * 8) = o;
      o.x = pack2(o2[0], o2[1]); o.y = pack2(o2[2], o2[3]); o.z = pack2(o2[4], o2[5]); o.w = pack2(o2[6], o2[7]);
      *(u32x4*)(Qs + r * 104 + cc * 8 + 16) = o;
    }
  }
  __syncthreads();
  bf16x8 qf[2][3];
#pragma unroll
  for (int qs = 0; qs < 2; ++qs)
#pragma unroll
    for (int ks = 0; ks < 3; ++ks) qf[qs][ks] = ld_frag(Qs + (32 * w + 16 * qs + l15) * 104 + ks * 32 + g4 * 8);
  __syncthreads();
  const int kt0 = latent ? 0 : 128, kt1 = 132;
  const bf16_t* Kg = (const bf16_t*)(p.ws + OFF_KH) + (size_t)(b * 4 + h) * TALL * 64;
  const bf16_t* Rg = (const bf16_t*)(p.ws + OFF_KR) + (size_t)b * TALL * 32;
  const bf16_t* Vg = (const bf16_t*)(p.ws + OFF_VT) + (size_t)(b * 4 + h) * 64 * TALL;
  u32x4 kr[3], vr[2];
  const int ve0 = tid >> 3, vc = tid & 7;
  {
    kr[0] = *(const u32x4*)(Kg + (size_t)kt0 * 4096 + tid * 8); kr[1] = *(const u32x4*)(Kg + (size_t)kt0 * 4096 + (tid + 256) * 8);
    kr[2] = *(const u32x4*)(Rg + (size_t)kt0 * 2048 + tid * 8);
#pragma unroll
    for (int i = 0; i < 2; ++i) vr[i] = *(const u32x4*)(Vg + (size_t)(ve0 + 32 * i) * TALL + kt0 * 64 + vc * 8);
  }
  float mrun[2] = {-1e30f, -1e30f}, lsum[2] = {0.f, 0.f};
  f32x4 O[4][2];
#pragma unroll
  for (int es = 0; es < 4; ++es)
#pragma unroll
    for (int qs = 0; qs < 2; ++qs) O[es][qs] = (f32x4){0.f, 0.f, 0.f, 0.f};
  constexpr int KVB = 64 * 104 + 64 * 72;
  {
#pragma unroll
    for (int i = 0; i < 2; ++i) { const int id = tid + 256 * i; *(u32x4*)(Ks + (id >> 3) * 104 + (id & 7) * 8) = kr[i]; }
    *(u32x4*)(Ks + (tid >> 2) * 104 + 64 + (tid & 3) * 8) = kr[2];
#pragma unroll
    for (int i = 0; i < 2; ++i) *(u32x4*)(Vs + (ve0 + 32 * i) * 72 + vc * 8) = vr[i];
    if (kt0 + 1 < kt1) {
      kr[0] = *(const u32x4*)(Kg + (size_t)(kt0 + 1) * 4096 + tid * 8); kr[1] = *(const u32x4*)(Kg + (size_t)(kt0 + 1) * 4096 + (tid + 256) * 8);
      kr[2] = *(const u32x4*)(Rg + (size_t)(kt0 + 1) * 2048 + tid * 8);
#pragma unroll
      for (int i = 0; i < 2; ++i) vr[i] = *(const u32x4*)(Vg + (size_t)(ve0 + 32 * i) * TALL + (kt0 + 1) * 64 + vc * 8);
    }
    __syncthreads();
  }
  for (int kt = kt0; kt < kt1; ++kt) {
    const int cur = (kt - kt0) & 1;
    const bf16_t* Kc = Ks + cur * KVB; const bf16_t* Vc = Vs + cur * KVB;
    bf16_t* Kn = Ks + (cur ^ 1) * KVB; bf16_t* Vn = Vs + (cur ^ 1) * KVB;
    if (kt + 1 < kt1) {
#pragma unroll
      for (int i = 0; i < 2; ++i) { const int id = tid + 256 * i; *(u32x4*)(Kn + (id >> 3) * 104 + (id & 7) * 8) = kr[i]; }
      *(u32x4*)(Kn + (tid >> 2) * 104 + 64 + (tid & 3) * 8) = kr[2];
#pragma unroll
      for (int i = 0; i < 2; ++i) *(u32x4*)(Vn + (ve0 + 32 * i) * 72 + vc * 8) = vr[i];
    }
    if (kt + 2 < kt1) {
      kr[0] = *(const u32x4*)(Kg + (size_t)(kt + 2) * 4096 + tid * 8); kr[1] = *(const u32x4*)(Kg + (size_t)(kt + 2) * 4096 + (tid + 256) * 8);
      kr[2] = *(const u32x4*)(Rg + (size_t)(kt + 2) * 2048 + tid * 8);
#pragma unroll
      for (int i = 0; i < 2; ++i) vr[i] = *(const u32x4*)(Vg + (size_t)(ve0 + 32 * i) * TALL + (kt + 2) * 64 + vc * 8);
    }
    __builtin_amdgcn_sched_barrier(0);
    f32x4 sa[4][2];
#pragma unroll
    for (int kb = 0; kb < 4; ++kb)
#pragma unroll
      for (int qs = 0; qs < 2; ++qs) sa[kb][qs] = (f32x4){0.f, 0.f, 0.f, 0.f};
#pragma unroll
    for (int ks = 0; ks < 3; ++ks)
#pragma unroll
      for (int kb = 0; kb < 4; ++kb) {
        const bf16x8 a = ld_frag(Kc + (16 * kb + l15) * 104 + ks * 32 + g4 * 8);
#pragma unroll
        for (int qs = 0; qs < 2; ++qs) sa[kb][qs] = MFMA16(a, qf[qs][ks], sa[kb][qs]);
      }
    bf16x8 pf[2][2];
#pragma unroll
    for (int qs = 0; qs < 2; ++qs) {
      float mx = -1e30f;
#pragma unroll
      for (int kb = 0; kb < 4; ++kb)
#pragma unroll
        for (int j = 0; j < 4; ++j) mx = fmaxf(mx, sa[kb][qs][j]);
      mx = fmaxf(mx, __shfl_xor(mx, 16)); mx = fmaxf(mx, __shfl_xor(mx, 32));
      const float mnew = fmaxf(mrun[qs], mx), alpha = __builtin_amdgcn_exp2f(mrun[qs] - mnew);
      mrun[qs] = mnew;
      float ps = 0.f;
#pragma unroll
      for (int kb = 0; kb < 4; ++kb)
#pragma unroll
        for (int j = 0; j < 4; ++j) { const float e = __builtin_amdgcn_exp2f(sa[kb][qs][j] - mnew); sa[kb][qs][j] = e; ps += e; }
      lsum[qs] = lsum[qs] * alpha + ps;
#pragma unroll
      for (int es = 0; es < 4; ++es) O[es][qs] = O[es][qs] * alpha;
#pragma unroll
      for (int k2 = 0; k2 < 2; ++k2)
        pf[qs][k2] = mk_frag(pack2(sa[2 * k2][qs][0], sa[2 * k2][qs][1]), pack2(sa[2 * k2][qs][2], sa[2 * k2][qs][3]),
                             pack2(sa[2 * k2 + 1][qs][0], sa[2 * k2 + 1][qs][1]), pack2(sa[2 * k2 + 1][qs][2], sa[2 * k2 + 1][qs][3]));
    }
#pragma unroll
    for (int k2 = 0; k2 < 2; ++k2)
#pragma unroll
      for (int es = 0; es < 4; ++es) {
        const bf16_t* vp = Vc + (16 * es + l15) * 72 + 32 * k2 + 4 * g4;
        const u32x2 lo = *(const u32x2*)vp, hi = *(const u32x2*)(vp + 16);
        const bf16x8 a = mk_frag(lo.x, lo.y, hi.x, hi.y);
#pragma unroll
        for (int qs = 0; qs < 2; ++qs) O[es][qs] = MFMA16(a, pf[qs][k2], O[es][qs]);
      }
    __syncthreads();
  }
  bf16_t* Y = (bf16_t*)(p.ws + OFF_HY);
#pragma unroll
  for (int qs = 0; qs < 2; ++qs) {
    float l = lsum[qs]; l += __shfl_xor(l, 16); l += __shfl_xor(l, 32);
    const float inv = 1.f / l;
    const int row = qrow0 + 32 * w + 16 * qs + l15;
#pragma unroll
    for (int es = 0; es < 4; ++es) store_bf4(Y + (size_t)row * 1024 + 256 + h * 64 + 16 * es + 4 * g4, O[es][qs] * inv);
  }
  __syncthreads();
}

DI void chunk_geom(int tcg, int b, int& part, int& tc, int& row0) { part = tcg >= 128; tc = part ? tcg - 128 : tcg; row0 = row_of(b, part, tc * 64); }
DI int chain_slot(int dir, int part, int tc) { return dir ? (part ? 3 - tc : 131 - tc) : (part ? tc : 4 + tc); }

DI void mlstm_p1(const Params& p, int l, int item, char* smem) {
  const int tid = ltid(), lane = tid & 63, w = __builtin_amdgcn_readfirstlane(tid >> 6), l15 = lane & 15, g4 = lane >> 4;
  const int tcg = item % NCH; int r = item / NCH; const int dir = r & 1; r >>= 1; const int h = r & 3, b = r >> 2;
  int part, tc, row0; chunk_geom(tcg, b, part, tc, row0);
  const int c = chain_slot(dir, part, tc), chain = (b * 4 + h) * 2 + dir;
  bf16_t* A = (bf16_t*)smem;
  bf16_t* Bk = A + 80 * 72;
  float* fs = (float*)(Bk + 64 * 72);
  const bf16_t* P = (const bf16_t*)(p.ws + OFF_P); const float* GML = (const float*)(p.ws + OFF_GML);
  float* MLM = (float*)(p.ws + OFF_MLM) + (size_t)(chain * NCH + c) * 32;
  if (tid < 64) {
    const int gi = 2 * dir;
    const float ig = GML[(size_t)(row0 + tid) * 16 + gi * 4 + h] + p.ml_gate_bias[l * 16 + gi * 4 + h];
    const float fg = GML[(size_t)(row0 + tid) * 16 + (gi + 1) * 4 + h] + p.ml_gate_bias[l * 16 + (gi + 1) * 4 + h];
    const float lf = logsigm_f(fg);
    const float pre = wave_incl_scan(lf, lane), tot = __shfl(pre, 63);
    const float bc = dir ? tot - pre + lf : pre;
    const float wlog = tot - bc + ig, mloc = wave_max(wlog), wv = __expf(wlog - mloc);
    fs[tid] = wv; A[64 * 72 + tid] = f2bf(wv);
    if (tid == 0) { MLM[0] = mloc; MLM[1] = tot; }
  }
  for (int i = tid; i < 15 * 72; i += 256) A[65 * 72 + i] = 0;
  __syncthreads();
  {
    const int s = tid >> 2, d0 = (tid & 3) * 16; const float wv = fs[s];
    const bf16_t* kp = P + (size_t)(row0 + s) * PINP + C_MLK + h * 64 + d0;
    const bf16_t* vp = P + (size_t)(row0 + s) * PINP + C_MLV + h * 64 + d0;
#pragma unroll
    for (int hf = 0; hf < 2; ++hf) {
      const u32x4 kq = *(const u32x4*)(kp + hf * 8), vq = *(const u32x4*)(vp + hf * 8);
      const float kk[8] = {bflo(kq.x), bfhi(kq.x), bflo(kq.y), bfhi(kq.y), bflo(kq.z), bfhi(kq.z), bflo(kq.w), bfhi(kq.w)};
      const float vv[8] = {bflo(vq.x), bfhi(vq.x), bflo(vq.y), bfhi(vq.y), bflo(vq.z), bfhi(vq.z), bflo(vq.w), bfhi(vq.w)};
#pragma unroll
      for (int j = 0; j < 8; ++j) { Bk[(d0 + hf * 8 + j) * 72 + s] = f2bf(kk[j] * 0.125f); A[(d0 + hf * 8 + j) * 72 + s] = f2bf(vv[j] * wv); }
    }
  }
  __syncthreads();
  float* MLS = (float*)(p.ws + OFF_MLS) + (size_t)(chain * NCH + c) * 4160;
  for (int t = w; t < 20; t += 4) {
    const int ms = t >> 2, ns = t & 3;
    f32x4 acc = {0.f, 0.f, 0.f, 0.f};
#pragma unroll
    for (int ks = 0; ks < 2; ++ks) acc = MFMA16(ld_frag(A + (16 * ms + l15) * 72 + ks * 32 + g4 * 8), ld_frag(Bk + (16 * ns + l15) * 72 + ks * 32 + g4 * 8), acc);
#pragma unroll
    for (int j = 0; j < 4; ++j) { const int e = 16 * ms + 4 * g4 + j; if (e <= 64) MLS[e * 64 + 16 * ns + l15] = acc[j]; }
  }
  __syncthreads();
}
DI void mlstm_p2(const Params& p, int item) {
  const int gi = item * 256 + ltid(), chain = gi / 4160, e = gi % 4160;
  float* MLS = (float*)(p.ws + OFF_MLS) + (size_t)chain * NCH * 4160 + e;
  float* MLM = (float*)(p.ws + OFF_MLM) + (size_t)chain * NCH * 32;
  float C = 0.f, m = 0.f;
  for (int c0 = 0; c0 < NCH; c0 += 12) {
    float d[12], ml[12], bl[12];
#pragma unroll
    for (int i = 0; i < 12; ++i) { d[i] = MLS[(size_t)(c0 + i) * 4160]; ml[i] = MLM[(c0 + i) * 32]; bl[i] = MLM[(c0 + i) * 32 + 1]; }
#pragma unroll
    for (int i = 0; i < 12; ++i) {
      MLS[(size_t)(c0 + i) * 4160] = C; if (e == 0) MLM[(c0 + i) * 32 + 16] = m;
      const float mn = fmaxf(bl[i] + m, ml[i]);
      C = __expf(bl[i] + m - mn) * C + __expf(ml[i] - mn) * d[i]; m = mn;
    }
  }
}
DI void mlstm_p3(const Params& p, int l, int item, char* smem) {
  const int tid = ltid(), lane = tid & 63, w = __builtin_amdgcn_readfirstlane(tid >> 6), l15 = lane & 15, g4 = lane >> 4;
  const int h = item & 3; const int r = item >> 2; const int tcg = r % NCH, b = r / NCH;
  int part, tc, row0; chunk_geom(tcg, b, part, tc, row0);
  bf16_t* Qs = (bf16_t*)smem;
  bf16_t* Ks = Qs + 64 * 72;
  bf16_t* Vt = Ks + 64 * 72;
  bf16_t* Sb = Vt + 64 * 72;
  float* fb = (float*)(Sb + 64 * 72);
  float* fi = fb + 64;
  const bf16_t* P = (const bf16_t*)(p.ws + OFF_P); const float* GML = (const float*)(p.ws + OFF_GML);
  {
    const int s = tid >> 2, d0 = (tid & 3) * 16;
    const bf16_t* base = P + (size_t)(row0 + s) * PINP + h * 64 + d0;
#pragma unroll
    for (int hf = 0; hf < 2; ++hf) {
      *(u32x4*)(Qs + s * 72 + d0 + hf * 8) = *(const u32x4*)(base + C_MLQ + hf * 8);
      const u32x4 kq = *(const u32x4*)(base + C_MLK + hf * 8), vq = *(const u32x4*)(base + C_MLV + hf * 8);
      u32x4 ko; ko.x = pack2(bflo(kq.x) * 0.125f, bfhi(kq.x) * 0.125f); ko.y = pack2(bflo(kq.y) * 0.125f, bfhi(kq.y) * 0.125f);
      ko.z = pack2(bflo(kq.z) * 0.125f, bfhi(kq.z) * 0.125f); ko.w = pack2(bflo(kq.w) * 0.125f, bfhi(kq.w) * 0.125f);
      *(u32x4*)(Ks + s * 72 + d0 + hf * 8) = ko;
      const unsigned vw[4] = {vq.x, vq.y, vq.z, vq.w};
#pragma unroll
      for (int j = 0; j < 4; ++j) { Vt[(d0 + hf * 8 + 2 * j) * 72 + s] = (bf16_t)(vw[j] & 0xffffu); Vt[(d0 + hf * 8 + 2 * j + 1) * 72 + s] = (bf16_t)(vw[j] >> 16); }
    }
  }
  f32x4 hs[4];
#pragma unroll
  for (int ns = 0; ns < 4; ++ns) hs[ns] = (f32x4){0.f, 0.f, 0.f, 0.f};
#pragma unroll 1
  for (int dir = 0; dir < 2; ++dir) {
    const int c = chain_slot(dir, part, tc), chain = (b * 4 + h) * 2 + dir;
    const float m_in = ((const float*)(p.ws + OFF_MLM))[(size_t)(chain * NCH + c) * 32 + 16];
    const float* Cst = (const float*)(p.ws + OFF_MLS) + (size_t)(chain * NCH + c) * 4160;
    __syncthreads();
    if (tid < 64) {
      const int gi = 2 * dir;
      const float ig = GML[(size_t)(row0 + tid) * 16 + gi * 4 + h] + p.ml_gate_bias[l * 16 + gi * 4 + h];
      const float fg = GML[(size_t)(row0 + tid) * 16 + (gi + 1) * 4 + h] + p.ml_gate_bias[l * 16 + (gi + 1) * 4 + h];
      const float lf = logsigm_f(fg);
      const float pre = wave_incl_scan(lf, lane), tot = __shfl(pre, 63);
      fb[tid] = dir ? tot - pre + lf : pre; fi[tid] = ig;
    }
    __syncthreads();
    f32x4 sc[4];
#pragma unroll
    for (int ns = 0; ns < 4; ++ns) {
      f32x4 a = {0.f, 0.f, 0.f, 0.f};
#pragma unroll
      for (int ks = 0; ks < 2; ++ks) a = MFMA16(ld_frag(Qs + (16 * w + l15) * 72 + ks * 32 + g4 * 8), ld_frag(Ks + (16 * ns + l15) * 72 + ks * 32 + g4 * 8), a);
      sc[ns] = a;
    }
    float bi[4], mt[4], rsum[4];
#pragma unroll
    for (int j = 0; j < 4; ++j) {
      const int i = 16 * w + 4 * g4 + j; bi[j] = fb[i];
      float mx = -1e30f;
#pragma unroll
      for (int ns = 0; ns < 4; ++ns) { const int s = 16 * ns + l15; const bool ok = dir ? (s >= i) : (s <= i); const float dm = bi[j] - fb[s] + fi[s]; if (ok) mx = fmaxf(mx, dm); }
      mx = red16_max(mx);
      mt[j] = fmaxf(bi[j] + m_in, mx);
      float rs = 0.f;
#pragma unroll
      for (int ns = 0; ns < 4; ++ns) {
        const int s = 16 * ns + l15; const bool ok = dir ? (s >= i) : (s <= i);
        const float v = ok ? sc[ns][j] * __expf(bi[j] - fb[s] + fi[s] - mt[j]) : 0.f;
        rs += v; Sb[i * 72 + s] = f2bf(v);
      }
      rsum[j] = red16_sum(rs);
    }
    __syncthreads();
    f32x4 qc[5];
#pragma unroll
    for (int ns = 0; ns < 5; ++ns) {
      f32x4 a = {0.f, 0.f, 0.f, 0.f};
      const int e = 16 * ns + l15;
#pragma unroll
      for (int ks = 0; ks < 2; ++ks) {
        bf16x8 bfm;
        if (e <= 64) bfm = frag_from_f32(Cst + e * 64 + ks * 32 + g4 * 8, 1.f); else bfm = mk_frag(0u, 0u, 0u, 0u);
        a = MFMA16(ld_frag(Qs + (16 * w + l15) * 72 + ks * 32 + g4 * 8), bfm, a);
      }
      qc[ns] = a;
    }
    f32x4 nm[4];
#pragma unroll
    for (int ns = 0; ns < 4; ++ns) {
      f32x4 a = {0.f, 0.f, 0.f, 0.f};
#pragma unroll
      for (int ks = 0; ks < 2; ++ks) a = MFMA16(ld_frag(Sb + (16 * w + l15) * 72 + ks * 32 + g4 * 8), ld_frag(Vt + (16 * ns + l15) * 72 + ks * 32 + g4 * 8), a);
      nm[ns] = a;
    }
#pragma unroll
    for (int j = 0; j < 4; ++j) {
      const float wi = __expf(bi[j] + m_in - mt[j]);
      const float qn = __shfl(qc[4][j], lane & 48);
      const float den = rsum[j] + wi * qn;
      const float dd = 1.f / fmaxf(fabsf(den), __expf(-mt[j]));
#pragma unroll
      for (int ns = 0; ns < 4; ++ns) hs[ns][j] += (nm[ns][j] + wi * qc[ns][j]) * dd;
    }
  }
  bf16_t* Y = (bf16_t*)(p.ws + OFF_HY);
#pragma unroll
  for (int j = 0; j < 4; ++j) {
    float ss = 0.f;
#pragma unroll
    for (int ns = 0; ns < 4; ++ns) ss += hs[ns][j] * hs[ns][j];
    ss = red16_sum(ss);
    const float rstd = rsqrtf(ss * (1.f / 64.f) + 1e-6f);
    const int row = row0 + 16 * w + 4 * g4 + j;
#pragma unroll
    for (int ns = 0; ns < 4; ++ns) {
      const int ch = h * 64 + 16 * ns + l15;
      const float o = bf2f(P[(size_t)row * PINP + C_MLO + ch]);
      Y[(size_t)row * 1024 + ch] = f2bf(hs[ns][j] * rstd * p.ml_norm[l * 256 + ch] * sigm_f(o));
    }
  }
  __syncthreads();
}

DI void conv_silu8(const Params& p, int l, const bf16_t* P, int row, bool hp, bool hn, int ch, float* out) {
  const bf16_t* src = P + (size_t)row * PINP + C_XBC + ch;
  const u32x4 z = {0u, 0u, 0u, 0u};
  const u32x4 c0 = *(const u32x4*)src, pm = hp ? *(const u32x4*)(src - PINP) : z, nx = hn ? *(const u32x4*)(src + PINP) : z;
  const float* cw = p.ssd_conv_w + (size_t)l * 3 * 768 + ch; const float* cb = p.ssd_conv_b + l * 768 + ch;
  const float a[8] = {bflo(pm.x), bfhi(pm.x), bflo(pm.y), bfhi(pm.y), bflo(pm.z), bfhi(pm.z), bflo(pm.w), bfhi(pm.w)};
  const float m[8] = {bflo(c0.x), bfhi(c0.x), bflo(c0.y), bfhi(c0.y), bflo(c0.z), bfhi(c0.z), bflo(c0.w), bfhi(c0.w)};
  const float n[8] = {bflo(nx.x), bfhi(nx.x), bflo(nx.y), bfhi(nx.y), bflo(nx.z), bfhi(nx.z), bflo(nx.w), bfhi(nx.w)};
#pragma unroll
  for (int j = 0; j < 8; ++j) out[j] = silu_f(cb[j] + cw[j] * a[j] + cw[768 + j] * m[j] + cw[1536 + j] * n[j]);
}
DI void ssd_gates(const Params& p, int l, int dir, int h, int row0, int tid, int lane, float& dt, float& cs, float& tot) {
  const float* DTR = (const float*)(p.ws + OFF_DTR);
  dt = softplus_f(DTR[(size_t)(row0 + tid) * 8 + dir * 4 + h] + p.ssd_dt_bias[l * 8 + dir * 4 + h]);
  const float la = -dt * __expf(p.ssd_a_log[l * 8 + dir * 4 + h]);
  const float pre = wave_incl_scan(la, lane); tot = __shfl(pre, 63);
  cs = dir ? tot - pre + la : pre;
}
DI void ssd_p1(const Params& p, int l, int item, char* smem) {
  const int tid = ltid(), lane = tid & 63, w = __builtin_amdgcn_readfirstlane(tid >> 6), l15 = lane & 15, g4 = lane >> 4;
  const int tcg = item % NCH; int r = item / NCH; const int dir = r & 1; r >>= 1; const int h = r & 3, b = r >> 2;
  int part, tc, row0; chunk_geom(tcg, b, part, tc, row0);
  const int c = chain_slot(dir, part, tc), chain = (b * 4 + h) * 2 + dir, lastc = part ? 3 : 127;
  bf16_t* Xt = (bf16_t*)smem;
  bf16_t* Bt = Xt + 64 * 72;
  float* fs = (float*)(Bt + 128 * 72);
  const bf16_t* P = (const bf16_t*)(p.ws + OFF_P);
  if (tid < 64) {
    float dt, cs, tot; ssd_gates(p, l, dir, h, row0, tid, lane, dt, cs, tot);
    fs[tid] = __expf(tot - cs) * dt;
    if (tid == 0) ((float*)(p.ws + OFF_SSA))[(chain * NCH + c) * 32] = tot;
  }
  __syncthreads();
  const int grp = h >> 1;
  for (int id = tid; id < 64 * 24; id += 256) {
    const int s = id / 24, cc = id % 24;
    const bool hp = !(tc == 0 && s == 0), hn = !(tc == lastc && s == 63);
    float v[8];
    if (cc < 8) { conv_silu8(p, l, P, row0 + s, hp, hn, h * 64 + cc * 8, v); const float wv = fs[s];
#pragma unroll
      for (int j = 0; j < 8; ++j) Xt[(cc * 8 + j) * 72 + s] = f2bf(v[j] * wv); }
    else { const int n0 = (cc - 8) * 8; conv_silu8(p, l, P, row0 + s, hp, hn, 256 + grp * 128 + n0, v);
#pragma unroll
      for (int j = 0; j < 8; ++j) Bt[(n0 + j) * 72 + s] = f2bf(v[j]); }
  }
  __syncthreads();
  float* SS = (float*)(p.ws + OFF_SSDS) + (size_t)(chain * NCH + c) * 8192;
#pragma unroll
  for (int ns = 0; ns < 8; ++ns) {
    f32x4 acc = {0.f, 0.f, 0.f, 0.f};
#pragma unroll
    for (int ks = 0; ks < 2; ++ks) acc = MFMA16(ld_frag(Xt + (16 * w + l15) * 72 + ks * 32 + g4 * 8), ld_frag(Bt + (16 * ns + l15) * 72 + ks * 32 + g4 * 8), acc);
#pragma unroll
    for (int j = 0; j < 4; ++j) SS[(16 * w + 4 * g4 + j) * 128 + 16 * ns + l15] = acc[j];
  }
  __syncthreads();
}
DI void ssd_p2(const Params& p, int item) {
  const int gi = item * 256 + ltid(), chain = gi >> 13, e = gi & 8191;
  float* SS = (float*)(p.ws + OFF_SSDS) + (size_t)chain * NCH * 8192 + e;
  const float* SA = (const float*)(p.ws + OFF_SSA) + (size_t)chain * NCH * 32;
  float S = 0.f;
  for (int c0 = 0; c0 < NCH; c0 += 12) {
    float d[12], a[12];
#pragma unroll
    for (int i = 0; i < 12; ++i) { d[i] = SS[(size_t)(c0 + i) * 8192]; a[i] = SA[(c0 + i) * 32]; }
#pragma unroll
    for (int i = 0; i < 12; ++i) { SS[(size_t)(c0 + i) * 8192] = S; S = __expf(a[i]) * S + d[i]; }
  }
}
DI void ssd_p3(const Params& p, int l, int item, char* smem) {
  const int tid = ltid(), lane = tid & 63, w = __builtin_amdgcn_readfirstlane(tid >> 6), l15 = lane & 15, g4 = lane >> 4;
  const int h = item & 3; const int r = item >> 2; const int tcg = r % NCH, b = r / NCH;
  int part, tc, row0; chunk_geom(tcg, b, part, tc, row0);
  const int lastc = part ? 3 : 127, grp = h >> 1;
  bf16_t* Cm = (bf16_t*)smem;
  bf16_t* Bm = Cm + 64 * 136;
  bf16_t* Xt = Bm + 64 * 136;
  bf16_t* Sb = Xt + 64 * 72;
  float* fcs = (float*)(Sb + 64 * 72);
  float* fdt = fcs + 64;
  const bf16_t* P = (const bf16_t*)(p.ws + OFF_P);
  for (int id = tid; id < 64 * 40; id += 256) {
    const int s = id / 40, cc = id % 40;
    const bool hp = !(tc == 0 && s == 0), hn = !(tc == lastc && s == 63);
    float v[8];
    if (cc < 8) { conv_silu8(p, l, P, row0 + s, hp, hn, h * 64 + cc * 8, v);
#pragma unroll
      for (int j = 0; j < 8; ++j) Xt[(cc * 8 + j) * 72 + s] = f2bf(v[j]); }
    else {
      const int q = cc - 8, isC = q >= 16, n0 = (q & 15) * 8;
      conv_silu8(p, l, P, row0 + s, hp, hn, 256 + isC * 256 + grp * 128 + n0, v);
      u32x4 o; o.x = pack2(v[0], v[1]); o.y = pack2(v[2], v[3]); o.z = pack2(v[4], v[5]); o.w = pack2(v[6], v[7]);
      *(u32x4*)((isC ? Cm : Bm) + s * 136 + n0) = o;
    }
  }
  f32x4 ys[4];
#pragma unroll
  for (int ns = 0; ns < 4; ++ns) ys[ns] = (f32x4){0.f, 0.f, 0.f, 0.f};
#pragma unroll 1
  for (int dir = 0; dir < 2; ++dir) {
    const int c = chain_slot(dir, part, tc), chain = (b * 4 + h) * 2 + dir;
    const float* St = (const float*)(p.ws + OFF_SSDS) + (size_t)(chain * NCH + c) * 8192;
    __syncthreads();
    if (tid < 64) { float dt, cs, tot; ssd_gates(p, l, dir, h, row0, tid, lane, dt, cs, tot); fcs[tid] = cs; fdt[tid] = dt; }
    __syncthreads();
    float ci[4];
#pragma unroll
    for (int j = 0; j < 4; ++j) ci[j] = fcs[16 * w + 4 * g4 + j];
#pragma unroll
    for (int ns = 0; ns < 4; ++ns) {
      f32x4 a = {0.f, 0.f, 0.f, 0.f};
#pragma unroll
      for (int ks = 0; ks < 4; ++ks) a = MFMA16(ld_frag(Cm + (16 * w + l15) * 136 + ks * 32 + g4 * 8), ld_frag(Bm + (16 * ns + l15) * 136 + ks * 32 + g4 * 8), a);
      const int s = 16 * ns + l15; const float css = fcs[s], dts = fdt[s];
#pragma unroll
      for (int j = 0; j < 4; ++j) {
        const int i = 16 * w + 4 * g4 + j; const bool ok = dir ? (s >= i) : (s <= i);
        Sb[i * 72 + s] = f2bf(ok ? a[j] * __expf(ci[j] - css) * dts : 0.f);
      }
    }
    __syncthreads();
#pragma unroll
    for (int ns = 0; ns < 4; ++ns) {
      f32x4 a = {0.f, 0.f, 0.f, 0.f}, bq = {0.f, 0.f, 0.f, 0.f};
#pragma unroll
      for (int ks = 0; ks < 2; ++ks) a = MFMA16(ld_frag(Sb + (16 * w + l15) * 72 + ks * 32 + g4 * 8), ld_frag(Xt + (16 * ns + l15) * 72 + ks * 32 + g4 * 8), a);
#pragma unroll
      for (int ks = 0; ks < 4; ++ks) bq = MFMA16(ld_frag(Cm + (16 * w + l15) * 136 + ks * 32 + g4 * 8), frag_from_f32(St + (16 * ns + l15) * 128 + ks * 32 + g4 * 8, 1.f), bq);
#pragma unroll
      for (int j = 0; j < 4; ++j) ys[ns][j] += a[j] + __expf(ci[j]) * bq[j];
    }
  }
  bf16_t* Y = (bf16_t*)(p.ws + OFF_HY); float* SSQ = (float*)(p.ws + OFF_SSQ);
  const float dsk = p.ssd_d[l * 4 + h];
#pragma unroll
  for (int j = 0; j < 4; ++j) {
    const int i = 16 * w + 4 * g4 + j, row = row0 + i; float ss = 0.f;
#pragma unroll
    for (int ns = 0; ns < 4; ++ns) {
      const int pp = 16 * ns + l15;
      const float xv = bf2f(Xt[pp * 72 + i]);
      const float z = bf2f(P[(size_t)row * PINP + C_Z + h * 64 + pp]);
      const float g = (ys[ns][j] + dsk * xv) * silu_f(z);
      ss += g * g; Y[(size_t)row * 1024 + 512 + h * 64 + pp] = f2bf(g);
    }
    ss = red16_sum(ss);
    if (l15 == 0) SSQ[(size_t)h * NROW + row] = ss;
  }
  __syncthreads();
}

struct S5Par { float are, aim, bre[16], bim[16]; };
DI void s5_params(const Params& p, int l, int dir, int g, int n, S5Par& q, float& dtv, float& lre, float& lim) {
  const int ai = ((l * 2 + dir) * 16 + g) * 64 + n;
  lre = fminf(p.s5_a_re[ai], -1e-4f); lim = p.s5_a_im[ai];
  dtv = __expf(p.s5_log_dt[(l * 2 + dir) * 16 + g]);
  const float mag = __expf(lre * dtv), ang = lim * dtv;
  q.are = mag * cosf(ang); q.aim = mag * sinf(ang);
  const float den = lre * lre + lim * lim;
  const float fre = ((q.are - 1.f) * lre + q.aim * lim) / den, fim = (q.aim * lre - (q.are - 1.f) * lim) / den;
  const float* br = p.s5_b_re + ((size_t)(l * 16 + g) * 64 + n) * 16; const float* bi = p.s5_b_im + ((size_t)(l * 16 + g) * 64 + n) * 16;
#pragma unroll
  for (int j = 0; j < 16; ++j) { q.bre[j] = fre * br[j] - fim * bi[j]; q.bim[j] = fre * bi[j] + fim * br[j]; }
}
DI void s5_step(const S5Par& q, const bf16_t* us, int s, float& xr, float& xi) {
  const u32x4 a0 = *(const u32x4*)(us + s * 16), a1 = *(const u32x4*)(us + s * 16 + 8);
  const unsigned uw[8] = {a0.x, a0.y, a0.z, a0.w, a1.x, a1.y, a1.z, a1.w};
  float br = 0.f, bi = 0.f;
#pragma unroll
  for (int j = 0; j < 8; ++j) { const float a = bflo(uw[j]), c = bfhi(uw[j]); br += q.bre[2 * j] * a + q.bre[2 * j + 1] * c; bi += q.bim[2 * j] * a + q.bim[2 * j + 1] * c; }
  const float nr = q.are * xr - q.aim * xi + br, ni = q.are * xi + q.aim * xr + bi;
  xr = nr; xi = ni;
}
DI void s5_p1(const Params& p, int l, int item, char* smem) {
  const int lane = ltid() & 63, wi = item * 4 + __builtin_amdgcn_readfirstlane(ltid() >> 6);
  const int tcg = wi % NCH; int r = wi / NCH; const int dir = r & 1; r >>= 1; const int g = r & 15, b = r >> 4;
  int part, tc, row0; chunk_geom(tcg, b, part, tc, row0);
  const int c = chain_slot(dir, part, tc);
  S5Par q; float dtv, lre, lim; s5_params(p, l, dir, g, lane, q, dtv, lre, lim);
  const bf16_t* up = (const bf16_t*)(p.ws + OFF_P) + (size_t)(row0 + lane) * PINP + C_S5 + g * 16;
  bf16_t* us = (bf16_t*)smem + __builtin_amdgcn_readfirstlane(ltid() >> 6) * 1024;
  *(u32x4*)(us + lane * 16) = *(const u32x4*)up; *(u32x4*)(us + lane * 16 + 8) = *(const u32x4*)(up + 8);
  float xr = 0.f, xi = 0.f;
  for (int st = 0; st < 64; ++st) { const int s = dir ? 63 - st : st; s5_step(q, us, s, xr, xi); }
  float* S = (float*)(p.ws + OFF_S5S) + ((size_t)((b * 16 + g) * 2 + dir) * NCH + c) * 128;
  S[lane] = xr; S[64 + lane] = xi;
}
DI void s5_p2(const Params& p, int l, int item) {
  const int gi = item * 256 + ltid(), n = gi & 63, dir = (gi >> 6) & 1, g = (gi >> 7) & 15, b = gi >> 11;
  const int ai = ((l * 2 + dir) * 16 + g) * 64 + n;
  const float lre = fminf(p.s5_a_re[ai], -1e-4f), lim = p.s5_a_im[ai], dtv = __expf(p.s5_log_dt[(l * 2 + dir) * 16 + g]);
  const float mag = __expf(64.f * lre * dtv), ang = 64.f * (lim * dtv);
  const float ar = mag * cosf(ang), aim = mag * sinf(ang);
  float* S = (float*)(p.ws + OFF_S5S) + (size_t)((b * 16 + g) * 2 + dir) * NCH * 128 + n;
  float xr = 0.f, xi = 0.f;
  for (int c0 = 0; c0 < NCH; c0 += 12) {
    float dr[12], di[12];
#pragma unroll
    for (int i = 0; i < 12; ++i) { dr[i] = S[(c0 + i) * 128]; di[i] = S[(c0 + i) * 128 + 64]; }
#pragma unroll
    for (int i = 0; i < 12; ++i) { S[(c0 + i) * 128] = xr; S[(c0 + i) * 128 + 64] = xi; const float nr = ar * xr - aim * xi + dr[i], ni = ar * xi + aim * xr + di[i]; xr = nr; xi = ni; }
  }
}
DI void s5_p3(const Params& p, int l, int item, char* smem) {
  const int tid = ltid(), lane = tid & 63, w = __builtin_amdgcn_readfirstlane(tid >> 6), l15 = lane & 15, g4 = lane >> 4;
  const int tcg = item % NCH, b = item / NCH;
  int part, tc, row0; chunk_geom(tcg, b, part, tc, row0);
  bf16_t* xs = (bf16_t*)smem + w * (16 * 136);
  bf16_t* yg = (bf16_t*)smem + 4 * 16 * 136;
  const bf16_t* P = (const bf16_t*)(p.ws + OFF_P);
#pragma unroll 1
  for (int gi = 0; gi < 4; ++gi) {
    const int g = w + 4 * gi;
    const bf16_t* up = P + (size_t)(row0 + lane) * PINP + C_S5 + g * 16;
    bf16_t* us = (bf16_t*)smem + 25600 + w * 1024;
    *(u32x4*)(us + lane * 16) = *(const u32x4*)up; *(u32x4*)(us + lane * 16 + 8) = *(const u32x4*)(up + 8);
    f32x4 yt[4];
#pragma unroll
    for (int ib = 0; ib < 4; ++ib) yt[ib] = (f32x4){0.f, 0.f, 0.f, 0.f};
#pragma unroll
    for (int dir = 0; dir < 2; ++dir) {
      S5Par q; float dtv, lre, lim; s5_params(p, l, dir, g, lane, q, dtv, lre, lim);
      const int c = chain_slot(dir, part, tc);
      const float* S = (const float*)(p.ws + OFF_S5S) + ((size_t)((b * 16 + g) * 2 + dir) * NCH + c) * 128;
      float xr = S[lane], xi = S[64 + lane];
      bf16x8 cf[4];
#pragma unroll
      for (int ks = 0; ks < 4; ++ks) {
        const int k = ks * 32 + g4 * 8;
        const float* src = (k < 64 ? p.s5_c_re : p.s5_c_im) + ((size_t)(l * 16 + g) * 16 + l15) * 64 + (k & 63);
        cf[ks] = frag_from_f32(src, k < 64 ? 1.f : -1.f);
      }
#pragma unroll
      for (int blk = 0; blk < 4; ++blk) {
        asm volatile("s_waitcnt lgkmcnt(0)" ::: "memory");
#pragma unroll 4
        for (int st = 0; st < 16; ++st) {
          const int step = blk * 16 + st, s = dir ? 63 - step : step;
          s5_step(q, us, s, xr, xi);
          xs[(s & 15) * 136 + lane] = f2bf(xr); xs[(s & 15) * 136 + 64 + lane] = f2bf(xi);
        }
        asm volatile("s_waitcnt lgkmcnt(0)" ::: "memory");
        f32x4 a = {0.f, 0.f, 0.f, 0.f};
#pragma unroll
        for (int ks = 0; ks < 4; ++ks) a = MFMA16(ld_frag(xs + l15 * 136 + ks * 32 + g4 * 8), cf[ks], a);
        const int ib = dir ? 3 - blk : blk;
        yt[ib] += a;
      }
    }
#pragma unroll
    for (int ib = 0; ib < 4; ++ib)
#pragma unroll
      for (int j = 0; j < 4; ++j) {
        const int tok = 16 * ib + 4 * g4 + j, ch = g * 16 + l15;
        const float u = bf2f(P[(size_t)(row0 + tok) * PINP + C_S5 + ch]);
        yg[tok * 264 + ch] = f2bf(gelu_tanh_f(yt[ib][j] + p.s5_d[l * 256 + ch] * u));
      }
  }
  __syncthreads();
  const bf16_t* Wg = (const bf16_t*)(p.ws + OFF_WGLU) + (size_t)l * 256 * 256;
  bf16_t* Y = (bf16_t*)(p.ws + OFF_HY);
#pragma unroll 1
  for (int ns = 0; ns < 4; ++ns) {
    f32x4 acc[4];
#pragma unroll
    for (int ms = 0; ms < 4; ++ms) acc[ms] = (f32x4){0.f, 0.f, 0.f, 0.f};
#pragma unroll
    for (int ks = 0; ks < 8; ++ks) {
      const bf16x8 wf = ld_frag(Wg + (size_t)(64 * w + 16 * ns + l15) * 256 + ks * 32 + g4 * 8);
#pragma unroll
      for (int ms = 0; ms < 4; ++ms) acc[ms] = MFMA16(wf, ld_frag(yg + (16 * ms + l15) * 264 + ks * 32 + g4 * 8), acc[ms]);
    }
#pragma unroll
    for (int ms = 0; ms < 4; ++ms) {
      const int tok = 16 * ms + l15, n0 = 64 * w + 16 * ns + 4 * g4;
      const u32x2 yv = *(const u32x2*)(yg + tok * 264 + n0);
      f32x4 o; o[0] = bflo(yv.x) * sigm_f(acc[ms][0]); o[1] = bfhi(yv.x) * sigm_f(acc[ms][1]); o[2] = bflo(yv.y) * sigm_f(acc[ms][2]); o[3] = bfhi(yv.y) * sigm_f(acc[ms][3]);
      store_bf4(Y + (size_t)(row0 + tok) * 1024 + 768 + n0, o);
    }
  }
  __syncthreads();
}

DI void outproj_item(const Params& p, int l, int item, char* smem) {
  const int mt = item >> 3, nt = item & 7;
  const float* MOD = (const float*)(p.ws + OFF_MOD);
  gemm_tile<1>((const bf16_t*)(p.ws + OFF_HY), 1024, (const bf16_t*)(p.ws + OFF_WOUT) + (size_t)l * 1024 * 1024, 1024, 1024, mt * 128, nt * 128, smem, (const float*)(p.ws + OFF_SSQ),
               [&](int row, int col, f32x4 v) {
                 const int s = row < NLAT ? row / T : 2;
                 const f32x4 gt = *(const f32x4*)(MOD + (size_t)(l * 3 + s) * 6144 + 2048 + col);
                 float* xp = row < NLAT ? p.xb + (size_t)row * 1024 + col : (float*)(p.ws + OFF_CTX) + (size_t)(row - NLAT) * 1024 + col;
                 *(f32x4*)xp = *(f32x4*)xp + gt * v;
               });
}
DI void ffnup_item(const Params& p, int l, int item, char* smem) {
  const int mt = item / 44, nt = item % 44;
  bf16_t* UG = (bf16_t*)(p.ws + OFF_R);
  gemm_tile<0>((const bf16_t*)(p.ws + OFF_HY), 1024, (const bf16_t*)(p.ws + OFF_WUP) + (size_t)l * 5632 * 1024, 1024, 1024, mt * 128, nt * 128, smem, nullptr,
               [&](int row, int col, f32x4 v) { store_bf4(UG + (size_t)row * 5632 + col, v); });
}
DI void act_item(const Params& p, int l, int item) {
  bf16_t* UG = (bf16_t*)(p.ws + OFF_R);
  const float* cw = p.ffn_conv_w + (size_t)l * 3 * DFF;
  for (int i = 0; i < 11; ++i) {
    const int id = ltid() + 256 * i, r = id / 352, cc = id % 352, row = item * 8 + r, k = cc * 8;
    int t, tl; if (row < NLAT) { t = row % T; tl = T; } else { t = (row - NLAT) % TC; tl = TC; }
    bf16_t* up = UG + (size_t)row * 5632 + k; const bf16_t* gp = up + DFF;
    const u32x4 z = {0u, 0u, 0u, 0u};
    const u32x4 u = *(const u32x4*)up, g0 = *(const u32x4*)gp, gm = t > 0 ? *(const u32x4*)(gp - 5632) : z, gn = t < tl - 1 ? *(const u32x4*)(gp + 5632) : z;
    const float uf[8] = {bflo(u.x), bfhi(u.x), bflo(u.y), bfhi(u.y), bflo(u.z), bfhi(u.z), bflo(u.w), bfhi(u.w)};
    const float a[8] = {bflo(gm.x), bfhi(gm.x), bflo(gm.y), bfhi(gm.y), bflo(gm.z), bfhi(gm.z), bflo(gm.w), bfhi(gm.w)};
    const float m[8] = {bflo(g0.x), bfhi(g0.x), bflo(g0.y), bfhi(g0.y), bflo(g0.z), bfhi(g0.z), bflo(g0.w), bfhi(g0.w)};
    const float n[8] = {bflo(gn.x), bfhi(gn.x), bflo(gn.y), bfhi(gn.y), bflo(gn.z), bfhi(gn.z), bflo(gn.w), bfhi(gn.w)};
    float o[8];
#pragma unroll
    for (int j = 0; j < 8; ++j) o[j] = silu_f(cw[k + j] * a[j] + cw[DFF + k + j] * m[j] + cw[2 * DFF + k + j] * n[j]) * uf[j];
    u32x4 ov; ov.x = pack2(o[0], o[1]); ov.y = pack2(o[2], o[3]); ov.z = pack2(o[4], o[5]); ov.w = pack2(o[6], o[7]);
    *(u32x4*)up = ov;
  }
}
DI void ffndown_item(const Params& p, int l, int item, char* smem) {
  const int mt = item >> 3, nt = item & 7;
  const float* MOD = (const float*)(p.ws + OFF_MOD);
  gemm_tile<0>((const bf16_t*)(p.ws + OFF_R), 5632, (const bf16_t*)(p.ws + OFF_WDN) + (size_t)l * 1024 * 2816, 2816, 2816, mt * 128, nt * 128, smem, nullptr,
               [&](int row, int col, f32x4 v) {
                 const int s = row < NLAT ? row / T : 2;
                 const f32x4 gt = *(const f32x4*)(MOD + (size_t)(l * 3 + s) * 6144 + 5120 + col);
                 float* xp = row < NLAT ? p.xb + (size_t)row * 1024 + col : (float*)(p.ws + OFF_CTX) + (size_t)(row - NLAT) * 1024 + col;
                 *(f32x4*)xp = *(f32x4*)xp + gt * v;
               });
}
DI void final_item(const Params& p, int item) {
  const int lane = ltid() & 63, w = __builtin_amdgcn_readfirstlane(ltid() >> 6), row = item * 4 + w;
  float* x = p.xb + (size_t)row * 1024;
  float4 v[4]; float ss = 0.f;
#pragma unroll
  for (int i = 0; i < 4; ++i) { v[i] = *(const float4*)(x + (i * 64 + lane) * 4); ss += v[i].x * v[i].x + v[i].y * v[i].y + v[i].z * v[i].z + v[i].w * v[i].w; }
  ss = wave_sum(ss);
  const float rstd = rsqrtf(ss * (1.f / 1024.f) + 1e-6f);
#pragma unroll
  for (int i = 0; i < 4; ++i) {
    const int k = (i * 64 + lane) * 4; const float4 g = *(const float4*)(p.final_norm + k);
    float4 o; o.x = v[i].x * rstd * g.x; o.y = v[i].y * rstd * g.y; o.z = v[i].z * rstd * g.z; o.w = v[i].w * rstd * g.w;
    *(float4*)(x + k) = o;
  }
}

constexpr int PPL = 12;
constexpr int N_PHASES = 2 + NL * PPL;
#define FOR_ITEMS(n) for (int it = blockIdx.x; it < (n); it += gridDim.x)

DI void run_phase(const Params& p, int ph, char* smem) {
  if (ph == 0) { FOR_ITEMS(P0_ITEMS) p0_item(p, it, smem); return; }
  if (ph == N_PHASES - 1) { FOR_ITEMS(NLAT / 4) final_item(p, it); return; }
  const int l = (ph - 1) / PPL, k = (ph - 1) % PPL;
  const int mtiles = (l == NL - 1) ? 128 : 132;
  switch (k) {
    case 0: FOR_ITEMS(NROW / 4) norm_item(p, l, 0, it); break;
    case 1: FOR_ITEMS(132 * 22) gemm_in_item(p, l, it, smem); break;
    case 2: FOR_ITEMS(2112) s5_p1(p, l, it, smem); break;
    case 3: {
      constexpr int n0 = 2112, n1 = n0 + 2112, n2 = n1 + 528, n3 = n2 + 396, n5 = n3 + 66;
      FOR_ITEMS(n5) {
        if (it < n0) ssd_p1(p, l, it, smem);
        else if (it < n1) mlstm_p1(p, l, it - n0, smem);
        else if (it < n2) kvproj_item(p, l, it - n1, smem);
        else if (it < n3) qproj_item(p, l, it - n2, smem);
        else ropek_item(p, it - n3);
      }
    } break;
    case 4: {
      constexpr int n0 = 512, n1 = n0 + 260, n2 = n1 + 16;
      FOR_ITEMS(n2) { if (it < n0) ssd_p2(p, it); else if (it < n1) mlstm_p2(p, it - n0); else s5_p2(p, l, it - n1); }
    } break;
    case 5: FOR_ITEMS(264) s5_p3(p, l, it, smem); break;
    case 6: {
      constexpr int n0 = 528, n2 = n0 + 1056, n3 = n2 + 1056;
      const bool late = blockIdx.x >= (gridDim.x >> 1);
      if (!late) { FOR_ITEMS(n0) attn_item(p, it, smem); }
      FOR_ITEMS(n3) {
        if (it < n0) continue;
        if (it < n2) ssd_p3(p, l, it - n0, smem);
        else mlstm_p3(p, l, it - n2, smem);
      }
      if (late) { FOR_ITEMS(n0) attn_item(p, it, smem); }
    } break;
    case 7: FOR_ITEMS(mtiles * 8) outproj_item(p, l, it, smem); break;
    case 8: FOR_ITEMS(mtiles * 32) norm_item(p, l, 1, it); break;
    case 9: FOR_ITEMS(mtiles * 44) ffnup_item(p, l, it, smem); break;
    case 10: FOR_ITEMS(mtiles * 16) act_item(p, l, it); break;
    case 11: FOR_ITEMS(mtiles * 8) ffndown_item(p, l, it, smem); break;
  }
}

#ifndef HASH_LO
#define HASH_LO OFF_MOD
#define HASH_HI WS_NEED
#endif
#ifndef PROBE_N
#define PROBE_N 0
#endif
DI void hash_dump(const Params& p) {
  const size_t NOUT = (size_t)NLAT * 1024, nw = (HASH_HI - HASH_LO) / 4;
  const unsigned* wsw = (const unsigned*)(p.ws + HASH_LO);
  for (size_t i = (size_t)blockIdx.x * 256 + threadIdx.x; i < NOUT; i += (size_t)gridDim.x * 256) {
    unsigned h = 12345u;
    for (size_t j = i; j < nw; j += NOUT) h = h * 1664525u + wsw[j];
    p.xb[i] = (float)(h & 0xFFFFFFu);
  }
}

#define XB_TMO      128
#define XB_XCNT(j)  (256  + 64 * (j))
#define XB_XSUB(j)  (1280 + 64 * (j))
#define XB_XGEN(j)  (2304 + 64 * (j))
#define XB_TOP      3328
#define XB_TOPGEN   3392
#define XCD_BAR_WORDS 3456
#define XB_SPIN_CAP (1u << 22)
#define LAS __attribute__((address_space(3)))
DI unsigned xb_ld(unsigned* p) { return __hip_atomic_load(p, __ATOMIC_RELAXED, __HIP_MEMORY_SCOPE_AGENT); }
DI unsigned xb_add(unsigned* p, unsigned v) { return __hip_atomic_fetch_add(p, v, __ATOMIC_RELAXED, __HIP_MEMORY_SCOPE_AGENT); }
DI unsigned xb_xcc_id() { return (unsigned)__builtin_amdgcn_s_getreg((3 << 11) | 20) & 0xFu; }
#define XB_SPIN(cond, bar) do { unsigned _sp = 0; while (cond) { __builtin_amdgcn_s_sleep(1); \
    if ((++_sp & 255u) == 0u) { if (xb_ld(&(bar)[XB_TMO])) break; if (_sp > XB_SPIN_CAP) { atomicAdd(&(bar)[XB_TMO], 1u); break; } } } } while (0)
struct XcdBarrier { unsigned* bar; unsigned x; volatile LAS unsigned* st; };
DI XcdBarrier xcd_barrier_post(unsigned* bar, volatile LAS unsigned* st) {
  XcdBarrier b; b.bar = bar; b.x = xb_xcc_id(); b.st = st;
  if (threadIdx.x == 0) (void)xb_add(&bar[XB_XCNT(b.x)], 1u);
  return b;
}
DI void xcd_barrier_complete(unsigned* bar, unsigned x, unsigned& nloc, unsigned& nx) {
  const unsigned G = gridDim.x;
  unsigned sum, cnt, mine, sp = 0u;
  for (;;) {
    sum = 0u; cnt = 0u; mine = 0u;
#pragma unroll
    for (unsigned j = 0; j < 16; ++j) { const unsigned c = xb_ld(&bar[XB_XCNT(j)]); sum += c; cnt += (c > 0u) ? 1u : 0u; mine = (j == x) ? c : mine; }
    if (sum == G) break;
    __builtin_amdgcn_s_sleep(1);
    if ((++sp & 255u) == 0u) { if (xb_ld(&bar[XB_TMO])) break; if (sp > XB_SPIN_CAP) { atomicAdd(&bar[XB_TMO], 1u); break; } }
  }
  nloc = mine > 0u ? mine : 1u; nx = cnt > 0u ? cnt : 1u;
}
DI void xcd_barrier(const XcdBarrier& b) {
  asm volatile("s_waitcnt vmcnt(0)" ::: "memory");
  __syncthreads();
  if (threadIdx.x == 0) {
    unsigned* bar = b.bar;
    __builtin_amdgcn_s_waitcnt(0);
    unsigned nloc = b.st[0], nx = b.st[1];
    if (nloc == 0u) { xcd_barrier_complete(bar, b.x, nloc, nx); b.st[0] = nloc; b.st[1] = nx; }
    const unsigned old = xb_add(&bar[XB_XSUB(b.x)], 1u);
    const unsigned gen = old / nloc;
    if (old + 1u == (gen + 1u) * nloc) {
      __builtin_amdgcn_fence(__ATOMIC_RELEASE, "agent");
      asm volatile("s_waitcnt vmcnt(0)" ::: "memory");
      const unsigned og = xb_add(&bar[XB_TOP], 1u);
      const unsigned tg = og / nx;
      if (og + 1u == (tg + 1u) * nx) xb_add(&bar[XB_TOPGEN], 1u);
      else XB_SPIN(xb_ld(&bar[XB_TOPGEN]) == tg, bar);
      __builtin_amdgcn_fence(__ATOMIC_ACQUIRE, "agent");
      xb_add(&bar[XB_XGEN(b.x)], 1u);
      asm volatile("s_waitcnt vmcnt(0)" ::: "memory");
    } else {
      XB_SPIN(xb_ld(&bar[XB_XGEN(b.x)]) == gen, bar);
      __builtin_amdgcn_fence(__ATOMIC_ACQUIRE, "agent");
      asm volatile("s_waitcnt vmcnt(0)" ::: "memory");
    }
  }
  __syncthreads();
}
constexpr size_t OFF_BAR = ((WS_NEED + 255) / 256) * 256;
constexpr int SMEM_BYTES = 59392;
__global__ void __launch_bounds__(256, 2) trunk_fwd(Params p) {
  __shared__ __attribute__((aligned(16))) char smem[SMEM_BYTES];
  __shared__ uint4 xb_words;
  cg::grid_group grid = cg::this_grid();
  if (threadIdx.x == 0) xb_words = make_uint4(0u, 0u, 0u, 0u);
  __syncthreads();
  XcdBarrier xb = xcd_barrier_post((unsigned*)(p.ws + OFF_BAR), (volatile LAS unsigned*)&xb_words);
  for (int ph = p.ph_lo; ph < p.ph_hi; ++ph) {
    run_phase(p, ph, smem);
    if (ph + 1 < p.ph_hi) { if (ph == p.ph_lo) grid.sync(); else xcd_barrier(xb); }
  }
}

__global__ void __launch_bounds__(256) hash_kernel(Params p) { hash_dump(p); }

extern "C" void kernel_launch(void* const* d_in, const int* in_sizes, int n_in, void* d_out, int out_size, void* d_ws, size_t ws_size, hipStream_t stream) {
  static int grid_blocks = 0;
  if (!grid_blocks) {
    int dev = 0, cus = 0, per_cu = 0;
    hipGetDevice(&dev);
    hipDeviceGetAttribute(&cus, hipDeviceAttributeMultiprocessorCount, dev);
    hipOccupancyMaxActiveBlocksPerMultiprocessor(&per_cu, trunk_fwd, 256, 0);
    if (per_cu > 2) per_cu = 2;
    grid_blocks = cus * per_cu;
  }
  if (ws_size < OFF_BAR + XCD_BAR_WORDS * 4) { fprintf(stderr, "workspace too small: %zu < %zu\n", ws_size, (size_t)WS_NEED); return; }
  Params p{};
  const float** fp = (const float**)&p;
  for (int i = 0; i < 35; ++i) fp[i] = (const float*)d_in[i];
  p.xb = (float*)d_out; p.ws = (char*)d_ws;
#if MULTI_LAUNCH
#if PROBE_N
  for (int ph = 0; ph < PROBE_N; ++ph) { p.ph_lo = ph; p.ph_hi = ph + 1; hipLaunchKernelGGL(trunk_fwd, dim3(grid_blocks), dim3(256), 0, stream, p); }
  hipLaunchKernelGGL(hash_kernel, dim3(grid_blocks), dim3(256), 0, stream, p);
#else
  for (int ph = 0; ph < N_PHASES; ++ph) { p.ph_lo = ph; p.ph_hi = ph + 1; hipLaunchKernelGGL(trunk_fwd, dim3(grid_blocks), dim3(256), 0, stream, p); }
#endif
#else
  p.ph_lo = 0; p.ph_hi = N_PHASES;
  hipMemsetAsync((char*)d_ws + OFF_BAR, 0, XCD_BAR_WORDS * 4, stream);
  void* args[] = {&p};
  hipError_t e = hipLaunchCooperativeKernel((void*)trunk_fwd, dim3(grid_blocks), dim3(256), args, 0, stream);
  if (e != hipSuccess) fprintf(stderr, "cooperative launch failed: %s (grid %d)\n", hipGetErrorString(e), grid_blocks);
#endif
}
```

```cpp
#include <hip/hip_runtime.h>
#include <hip/hip_cooperative_groups.h>
#include <cstdio>
#include <cstdint>
namespace cg = cooperative_groups;

#ifndef PROBE_MASK
#define PROBE_MASK 63
#endif
#ifndef ZERO_FILL
#define ZERO_FILL 0
#endif
#ifndef MULTI_LAUNCH
#define MULTI_LAUNCH 0
#endif

typedef unsigned short bf16_t;
typedef short bf16x8 __attribute__((ext_vector_type(8)));
typedef float f32x4 __attribute__((ext_vector_type(4)));
typedef unsigned u32x4 __attribute__((ext_vector_type(4)));
typedef unsigned u32x2 __attribute__((ext_vector_type(2)));
#define DI __device__ __forceinline__
#define MFMA16(a, b, c) __builtin_amdgcn_mfma_f32_16x16x32_bf16((a), (b), (c), 0, 0, 0)

constexpr int NB = 2, T = 8192, TC = 256, NL = 4;
constexpr int NLAT = NB * T, NROW = NLAT + NB * TC;
constexpr int TALL = T + TC;
constexpr int PINP = 2816;
constexpr int C_MLQ = 0, C_MLK = 256, C_MLV = 512, C_MLO = 768, C_CQ = 1040, C_CKV = 1296, C_KR = 1424,
              C_Z = 1456, C_XBC = 1712, C_S5 = 2488;
constexpr int NCH = 132;
constexpr int DFF = 2816;

constexpr size_t SZ_WIN = (size_t)NL * 2816 * 1024 * 2, SZ_WUQ = (size_t)NL * 384 * 256 * 2, SZ_WUKV = (size_t)NL * 512 * 128 * 2,
                 SZ_WGLU = (size_t)NL * 256 * 256 * 2, SZ_WOUT = (size_t)NL * 1024 * 1024 * 2, SZ_WUP = (size_t)NL * 5632 * 1024 * 2,
                 SZ_WDN = (size_t)NL * 1024 * 2816 * 2, SZ_MOD = (size_t)NL * 3 * 6144 * 4, SZ_CTX = (size_t)512 * 1024 * 4,
                 SZ_HY = (size_t)NROW * 1024 * 2, SZ_GML = (size_t)NROW * 16 * 4, SZ_DTR = (size_t)NROW * 8 * 4, SZ_SSQ = (size_t)NROW * 4 * 4,
                 SZ_QRAW = (size_t)NROW * 384 * 2, SZ_KH = (size_t)NB * 4 * TALL * 64 * 2 + (size_t)NB * TALL * 32 * 2, SZ_VT = (size_t)NB * 4 * 64 * TALL * 2,
                 SZ_S5S = (size_t)NB * 16 * 2 * NCH * 128 * 4, SZ_MLM = (size_t)16 * NCH * 32 * 4, SZ_SSA = (size_t)16 * NCH * 32 * 4,
                 SZ_P = (size_t)NROW * PINP * 2, SZ_MLS = (size_t)16 * NCH * 4160 * 4, SZ_SSDS = (size_t)16 * NCH * 8192 * 4;
constexpr size_t OFF_WIN = 0, OFF_WUQ = OFF_WIN + SZ_WIN, OFF_WUKV = OFF_WUQ + SZ_WUQ, OFF_WGLU = OFF_WUKV + SZ_WUKV,
                 OFF_WOUT = OFF_WGLU + SZ_WGLU, OFF_WUP = OFF_WOUT + SZ_WOUT, OFF_WDN = OFF_WUP + SZ_WUP, OFF_MOD = OFF_WDN + SZ_WDN,
                 OFF_CTX = OFF_MOD + SZ_MOD, OFF_HY = OFF_CTX + SZ_CTX, OFF_GML = OFF_HY + SZ_HY, OFF_DTR = OFF_GML + SZ_GML,
                 OFF_SSQ = OFF_DTR + SZ_DTR, OFF_QRAW = OFF_SSQ + SZ_SSQ, OFF_KH = OFF_QRAW + SZ_QRAW, OFF_VT = OFF_KH + SZ_KH,
                 OFF_S5S = OFF_VT + SZ_VT, OFF_MLM = OFF_S5S + SZ_S5S, OFF_SSA = OFF_MLM + SZ_MLM,
                 OFF_R = ((OFF_SSA + SZ_SSA + 255) / 256) * 256, OFF_P = OFF_R, OFF_MLS = OFF_P + SZ_P, OFF_SSDS = OFF_MLS + SZ_MLS,
                 WS_NEED = OFF_SSDS + SZ_SSDS;
static_assert((size_t)NROW * 5632 * 2 <= SZ_P + SZ_MLS + SZ_SSDS, "UG overlay");

constexpr size_t OFF_KR = OFF_KH + (size_t)NB * 4 * TALL * 64 * 2;
struct Params {
  const float *x, *c, *ctx, *c_ctx, *w_mod, *b_mod, *norm1, *norm2, *w_in, *ml_gate_bias, *ml_norm, *mla_q_norm, *mla_kv_norm,
      *mla_w_uq, *mla_w_ukv, *ssd_conv_w, *ssd_conv_b, *ssd_a_log, *ssd_dt_bias, *ssd_d, *ssd_norm, *s5_a_re, *s5_a_im, *s5_log_dt,
      *s5_b_re, *s5_b_im, *s5_c_re, *s5_c_im, *s5_d, *s5_w_glu, *w_out, *ffn_w_up, *ffn_conv_w, *ffn_w_down, *final_norm;
  float* xb;
  char* ws;
  int ph_lo, ph_hi;
};

typedef __bf16 hbf16x2 __attribute__((ext_vector_type(2)));
typedef float f32x2 __attribute__((ext_vector_type(2)));
DI bf16_t f2bf(float x) { return __builtin_bit_cast(bf16_t, (__bf16)x); }
DI float bf2f(bf16_t v) { return __uint_as_float(((unsigned)v) << 16); }
DI unsigned pack2(float lo, float hi) { f32x2 v = {lo, hi}; return __builtin_bit_cast(unsigned, __builtin_convertvector(v, hbf16x2)); }
DI float bflo(unsigned w) { return __uint_as_float(w << 16); }
DI float bfhi(unsigned w) { return __uint_as_float(w & 0xffff0000u); }
DI float silu_f(float x) { return x / (1.f + __expf(-x)); }
DI float sigm_f(float x) { return 1.f / (1.f + __expf(-x)); }
DI float softplus_f(float x) { return fmaxf(x, 0.f) + log1pf(__expf(-fabsf(x))); }
DI float logsigm_f(float x) { return fminf(x, 0.f) - log1pf(__expf(-fabsf(x))); }
DI float gelu_tanh_f(float x) { float u = 0.7978845608f * (x + 0.044715f * x * x * x); return x * sigm_f(2.f * u); }
DI float wave_sum(float v) { for (int o = 32; o; o >>= 1) v += __shfl_xor(v, o); return v; }
DI float wave_max(float v) { for (int o = 32; o; o >>= 1) v = fmaxf(v, __shfl_xor(v, o)); return v; }
DI float wave_incl_scan(float v, int lane) { for (int o = 1; o < 64; o <<= 1) { float t = __shfl_up(v, o); if (lane >= o) v += t; } return v; }
DI float red16_max(float v) { v = fmaxf(v, __shfl_xor(v, 1)); v = fmaxf(v, __shfl_xor(v, 2)); v = fmaxf(v, __shfl_xor(v, 4)); v = fmaxf(v, __shfl_xor(v, 8)); return v; }
DI float red16_sum(float v) { v += __shfl_xor(v, 1); v += __shfl_xor(v, 2); v += __shfl_xor(v, 4); v += __shfl_xor(v, 8); return v; }
DI bf16x8 ld_frag(const bf16_t* p) { return *(const bf16x8*)p; }
DI bf16x8 mk_frag(unsigned a, unsigned b, unsigned c, unsigned d) { u32x4 u = {a, b, c, d}; return __builtin_bit_cast(bf16x8, u); }
DI bf16x8 frag_from_f32(const float* p, float sgn) {
  float4 a = *(const float4*)p, b = *(const float4*)(p + 4);
  return mk_frag(pack2(a.x * sgn, a.y * sgn), pack2(a.z * sgn, a.w * sgn), pack2(b.x * sgn, b.y * sgn), pack2(b.z * sgn, b.w * sgn));
}
DI int ltid() { int t = threadIdx.x; asm volatile("" : "+v"(t)); return t; }
DI int row_of(int b, int part, int t) { return part ? NLAT + b * TC + t : b * T + t; }

DI void tr_tile(const float* __restrict__ src, int K, int N, bf16_t* __restrict__ dst, const float* gain, int glo, int ghi, int tk, int tn, float* tile) {
  const int tid = ltid(), c4 = tid & 15, rq = tid >> 4;
  const bool vec = (N & 3) == 0;
#pragma unroll
  for (int rr = 0; rr < 4; ++rr) {
    const int r = rr * 16 + rq, k = tk * 64 + r, n = tn * 64 + c4 * 4;
    float4 v;
    if (vec && n + 3 < N) v = *(const float4*)(src + (size_t)k * N + n);
    else { v.x = n < N ? src[(size_t)k * N + n] : 0.f; v.y = n + 1 < N ? src[(size_t)k * N + n + 1] : 0.f; v.z = n + 2 < N ? src[(size_t)k * N + n + 2] : 0.f; v.w = n + 3 < N ? src[(size_t)k * N + n + 3] : 0.f; }
    if (gain && k >= glo && k < ghi) { const float g = gain[k - glo]; v.x *= g; v.y *= g; v.z *= g; v.w *= g; }
    *(float4*)(tile + r * 68 + c4 * 4) = v;
  }
  __syncthreads();
#pragma unroll
  for (int q = 0; q < 2; ++q) {
    const int id = tid + 256 * q, n = id >> 3, k0 = (id & 7) * 8;
    u32x4 o;
    o.x = pack2(tile[(k0 + 0) * 68 + n], tile[(k0 + 1) * 68 + n]); o.y = pack2(tile[(k0 + 2) * 68 + n], tile[(k0 + 3) * 68 + n]);
    o.z = pack2(tile[(k0 + 4) * 68 + n], tile[(k0 + 5) * 68 + n]); o.w = pack2(tile[(k0 + 6) * 68 + n], tile[(k0 + 7) * 68 + n]);
    *(u32x4*)(dst + (size_t)(tn * 64 + n) * K + tk * 64 + k0) = o;
  }
  __syncthreads();
}

constexpr int TR_PER_LAYER = 3128, P0_TR = NL * TR_PER_LAYER, P0_MOD = NL * 96, P0_CPX = NLAT * 1024 / 4096, P0_CPC = 512 * 1024 / 4096;
constexpr int P0_ZERO = (int)((WS_NEED - OFF_HY + 65535) / 65536);
constexpr int P0_ITEMS = P0_TR + P0_MOD + P0_CPX + P0_CPC + (ZERO_FILL ? P0_ZERO : 0);

DI void p0_item(const Params& p, int item, char* smem) {
  const int tid = ltid();
  if (item < P0_MOD) {
    const int l = item / 96, cb = item % 96, cl = tid & 63, kq = tid >> 6;
    float* sv = (float*)smem;
    float* red = sv + 3072;
    for (int i = tid; i < 1024; i += 256) { sv[i] = silu_f(p.c[i]); sv[1024 + i] = silu_f(p.c[1024 + i]); sv[2048 + i] = silu_f(p.c_ctx[i]); }
    __syncthreads();
    const int col = cb * 64 + cl; const float* W = p.w_mod + (size_t)l * 1024 * 6144 + col;
    float a0 = 0.f, a1 = 0.f, a2 = 0.f;
#pragma unroll 16
    for (int k = kq * 256; k < kq * 256 + 256; ++k) { const float w = W[(size_t)k * 6144]; a0 += sv[k] * w; a1 += sv[1024 + k] * w; a2 += sv[2048 + k] * w; }
    red[(kq * 3 + 0) * 64 + cl] = a0; red[(kq * 3 + 1) * 64 + cl] = a1; red[(kq * 3 + 2) * 64 + cl] = a2;
    __syncthreads();
    if (tid < 192) {
      const int s = tid >> 6; const float bm = p.b_mod[l * 6144 + col];
      const float v = red[(0 * 3 + s) * 64 + cl] + red[(1 * 3 + s) * 64 + cl] + red[(2 * 3 + s) * 64 + cl] + red[(3 * 3 + s) * 64 + cl] + bm;
      ((float*)(p.ws + OFF_MOD))[(size_t)(l * 3 + s) * 6144 + col] = v;
    }
    __syncthreads();
    return;
  }
  item -= P0_MOD;
  if (item < P0_TR) {
    const int l = item / TR_PER_LAYER; int t = item % TR_PER_LAYER; float* tile = (float*)smem;
    if (t < 704) { tr_tile(p.w_in + (size_t)l * 1024 * 2744, 1024, 2744, (bf16_t*)(p.ws + OFF_WIN) + (size_t)l * 2816 * 1024, nullptr, 0, 0, t / 44, t % 44, tile); return; }
    t -= 704;
    if (t < 24) { tr_tile(p.mla_w_uq + (size_t)l * 256 * 384, 256, 384, (bf16_t*)(p.ws + OFF_WUQ) + (size_t)l * 384 * 256, p.mla_q_norm + l * 256, 0, 256, t / 6, t % 6, tile); return; }
    t -= 24;
    if (t < 16) { tr_tile(p.mla_w_ukv + (size_t)l * 128 * 512, 128, 512, (bf16_t*)(p.ws + OFF_WUKV) + (size_t)l * 512 * 128, p.mla_kv_norm + l * 128, 0, 128, t / 8, t % 8, tile); return; }
    t -= 16;
    if (t < 16) { tr_tile(p.s5_w_glu + (size_t)l * 256 * 256, 256, 256, (bf16_t*)(p.ws + OFF_WGLU) + (size_t)l * 256 * 256, nullptr, 0, 0, t / 4, t % 4, tile); return; }
    t -= 16;
    if (t < 256) { tr_tile(p.w_out + (size_t)l * 1024 * 1024, 1024, 1024, (bf16_t*)(p.ws + OFF_WOUT) + (size_t)l * 1024 * 1024, p.ssd_norm + l * 256, 512, 768, t / 16, t % 16, tile); return; }
    t -= 256;
    if (t < 1408) { tr_tile(p.ffn_w_up + (size_t)l * 1024 * 5632, 1024, 5632, (bf16_t*)(p.ws + OFF_WUP) + (size_t)l * 5632 * 1024, nullptr, 0, 0, t / 88, t % 88, tile); return; }
    t -= 1408;
    tr_tile(p.ffn_w_down + (size_t)l * 2816 * 1024, 2816, 1024, (bf16_t*)(p.ws + OFF_WDN) + (size_t)l * 1024 * 2816, nullptr, 0, 0, t / 16, t % 16, tile);
    return;
  }
  item -= P0_TR;
  if (item >= P0_CPX + P0_CPC) {
    item -= P0_CPX + P0_CPC;
    char* z = p.ws + OFF_HY + (size_t)item * 65536;
    const size_t lim = WS_NEED - OFF_HY - (size_t)item * 65536;
    for (int i = 0; i < 16; ++i) { const size_t o = (size_t)(i * 256 + tid) * 16; if (o < lim) *(u32x4*)(z + o) = (u32x4){0u, 0u, 0u, 0u}; }
    return;
  }
  const float* src; float* dst;
  if (item < P0_CPX) { src = p.x + (size_t)item * 4096; dst = p.xb + (size_t)item * 4096; }
  else { item -= P0_CPX; src = p.ctx + (size_t)item * 4096; dst = (float*)(p.ws + OFF_CTX) + (size_t)item * 4096; }
  for (int i = 0; i < 4; ++i) { const int o = (i * 256 + tid) * 4; *(float4*)(dst + o) = *(const float4*)(src + o); }
}

DI void norm_item(const Params& p, int l, int which, int item) {
  const int lane = ltid() & 63, w = __builtin_amdgcn_readfirstlane(ltid() >> 6), row = item * 4 + w;
  const float* x = row < NLAT ? p.xb + (size_t)row * 1024 : (const float*)(p.ws + OFF_CTX) + (size_t)(row - NLAT) * 1024;
  float4 v[4]; float ss = 0.f;
#pragma unroll
  for (int i = 0; i < 4; ++i) { v[i] = *(const float4*)(x + (i * 64 + lane) * 4); ss += v[i].x * v[i].x + v[i].y * v[i].y + v[i].z * v[i].z + v[i].w * v[i].w; }
  ss = wave_sum(ss);
  const float rstd = rsqrtf(ss * (1.f / 1024.f) + 1e-6f);
  const int s = row < NLAT ? row / T : 2;
  const float* g = (which ? p.norm2 : p.norm1) + l * 1024;
  const float* md = (const float*)(p.ws + OFF_MOD) + (size_t)(l * 3 + s) * 6144 + (which ? 3072 : 0);
  bf16_t* H = (bf16_t*)(p.ws + OFF_HY) + (size_t)row * 1024;
#pragma unroll
  for (int i = 0; i < 4; ++i) {
    const int k = (i * 64 + lane) * 4;
    const float4 g4 = *(const float4*)(g + k), sh = *(const float4*)(md + k), sc = *(const float4*)(md + 1024 + k);
    u32x2 o; o.x = pack2(v[i].x * rstd * g4.x * (1.f + sc.x) + sh.x, v[i].y * rstd * g4.y * (1.f + sc.y) + sh.y);
    o.y = pack2(v[i].z * rstd * g4.z * (1.f + sc.z) + sh.z, v[i].w * rstd * g4.w * (1.f + sc.w) + sh.w);
    *(u32x2*)(H + k) = o;
  }
}

DI u32x4 scale_bf8(u32x4 q, float s) {
  q.x = pack2(bflo(q.x) * s, bfhi(q.x) * s); q.y = pack2(bflo(q.y) * s, bfhi(q.y) * s);
  q.z = pack2(bflo(q.z) * s, bfhi(q.z) * s); q.w = pack2(bflo(q.w) * s, bfhi(q.w) * s); return q;
}
#define GEMM_STEP(AR, BR, KT)                                                                                         \
  {                                                                                                                   \
    if (AMODE == 1 && (KT) >= 8 && (KT) < 12) {                                                                       \
      _Pragma("unroll") for (int i = 0; i < 4; ++i) AR[i] = scale_bf8(AR[i], rs[i]);                                  \
    }                                                                                                                 \
    _Pragma("unroll") for (int i = 0; i < 4; ++i) { *(u32x4*)(As + (r0 + 32 * i) * 72 + cc * 8) = AR[i]; *(u32x4*)(Bs + (r0 + 32 * i) * 72 + cc * 8) = BR[i]; } \
    __syncthreads();                                                                                                  \
    if ((KT) + 2 < nk) {                                                                                              \
      _Pragma("unroll") for (int i = 0; i < 4; ++i) { AR[i] = *(const u32x4*)(ap + i * astep + ((KT) + 2) * 64); BR[i] = *(const u32x4*)(bp + i * bstep + ((KT) + 2) * 64); } \
    }                                                                                                                 \
    __builtin_amdgcn_sched_barrier(0);                                                                                \
    _Pragma("unroll") for (int ks = 0; ks < 2; ++ks) {                                                                \
      bf16x8 af[4], bfr[4];                                                                                           \
      _Pragma("unroll") for (int i = 0; i < 4; ++i) { af[i] = ld_frag(As + (64 * wm + 16 * i + l15) * 72 + ks * 32 + g4 * 8); bfr[i] = ld_frag(Bs + (64 * wn + 16 * i + l15) * 72 + ks * 32 + g4 * 8); } \
      _Pragma("unroll") for (int i = 0; i < 4; ++i)                                                                   \
        _Pragma("unroll") for (int j = 0; j < 4; ++j) acc[i][j] = MFMA16(bfr[j], af[i], acc[i][j]);                   \
    }                                                                                                                 \
    __syncthreads();                                                                                                  \
  }
template <int AMODE, int STAGE, class Epi>
DI void gemm_tile(const bf16_t* __restrict__ A, int lda, const bf16_t* __restrict__ Bt, int ldb, int K, int m0, int n0, char* smem, const float* ssq, Epi epi) {
  bf16_t* As = (bf16_t*)smem; bf16_t* Bs = As + 128 * 72;
  const int tid = ltid(), lane = tid & 63, w = __builtin_amdgcn_readfirstlane(tid >> 6), wm = w >> 1, wn = w & 1, l15 = lane & 15, g4 = lane >> 4;
  u32x4 ar0[4], br0[4], ar1[4], br1[4]; float rs[4];
  const int r0 = tid >> 3, cc = tid & 7;
  const bf16_t* ap = A + (size_t)(m0 + r0) * lda + cc * 8;
  const bf16_t* bp = Bt + (size_t)(n0 + r0) * ldb + cc * 8;
  const size_t astep = (size_t)32 * lda, bstep = (size_t)32 * ldb;
  if (AMODE == 1) {
#pragma unroll
    for (int i = 0; i < 4; ++i) { const float* q = ssq + (m0 + r0 + 32 * i); rs[i] = rsqrtf((q[0] + q[NROW] + q[2 * NROW] + q[3 * NROW]) * (1.f / 256.f) + 1e-6f); }
  }
  f32x4 acc[4][4];
#pragma unroll
  for (int i = 0; i < 4; ++i)
#pragma unroll
    for (int j = 0; j < 4; ++j) acc[i][j] = (f32x4){0.f, 0.f, 0.f, 0.f};
  const int nk = K >> 6;
#pragma unroll
  for (int i = 0; i < 4; ++i) { ar0[i] = *(const u32x4*)(ap + i * astep); br0[i] = *(const u32x4*)(bp + i * bstep); }
#pragma unroll
  for (int i = 0; i < 4; ++i) { ar1[i] = *(const u32x4*)(ap + i * astep + 64); br1[i] = *(const u32x4*)(bp + i * bstep + 64); }
  for (int kt = 0; kt < nk; kt += 2) {
    GEMM_STEP(ar0, br0, kt)
    GEMM_STEP(ar1, br1, kt + 1)
  }
  if (STAGE == 2) {
    float* Tf = (float*)smem;
#pragma unroll
    for (int h = 0; h < 2; ++h) {
      if (wm == h) {
#pragma unroll
        for (int i = 0; i < 4; ++i)
#pragma unroll
          for (int j = 0; j < 4; ++j) *(f32x4*)(Tf + (16 * i + l15) * 132 + 64 * wn + 16 * j + 4 * g4) = acc[i][j];
      }
      __syncthreads();
#pragma unroll
      for (int q = 0; q < 8; ++q) { const int id = tid + 256 * q, r = id >> 5, c = id & 31; epi(m0 + 64 * h + r, n0 + c * 4, *(const f32x4*)(Tf + r * 132 + c * 4)); }
      __syncthreads();
    }
    return;
  }
#pragma unroll
  for (int i = 0; i < 4; ++i)
#pragma unroll
    for (int j = 0; j < 4; ++j) epi(m0 + 64 * wm + 16 * i + l15, n0 + 64 * wn + 16 * j + 4 * g4, acc[i][j]);
}

DI void store_bf4(bf16_t* dst, f32x4 v) { u32x2 o; o.x = pack2(v[0], v[1]); o.y = pack2(v[2], v[3]); *(u32x2*)dst = o; }

DI void gemm_in_item(const Params& p, int l, int item, char* smem) {
  const int mt = item / 22, nt = item % 22;
  bf16_t* P = (bf16_t*)(p.ws + OFF_P); float* GML = (float*)(p.ws + OFF_GML); float* DTR = (float*)(p.ws + OFF_DTR);
  bf16_t* Ts = (bf16_t*)smem;
  const int m0 = mt * 128, n0 = nt * 128;
  gemm_tile<0, 0>((const bf16_t*)(p.ws + OFF_HY), 1024, (const bf16_t*)(p.ws + OFF_WIN) + (size_t)l * 2816 * 1024, 1024, 1024, mt * 128, nt * 128, smem, nullptr,
               [&](int row, int col, f32x4 v) {
                 store_bf4(Ts + (row - m0) * 136 + (col - n0), v);
                 if (col >= 1024 && col < 1040) *(f32x4*)(GML + (size_t)row * 16 + (col - 1024)) = v;
                 if (col >= 2480 && col < 2488) *(f32x4*)(DTR + (size_t)row * 8 + (col - 2480)) = v;
               });
  __syncthreads();
  { const int tid = ltid();
#pragma unroll
    for (int i = 0; i < 8; ++i) { const int id = tid + 256 * i, r = id >> 4, c = id & 15; *(u32x4*)(P + (size_t)(m0 + r) * PINP + n0 + c * 8) = *(const u32x4*)(Ts + r * 136 + c * 8); } }
  __syncthreads();
}

DI void tile_rstd(const bf16_t* P, int m0, int col0, int ncols, float* rst) {
  const int tid = ltid(), r = tid >> 1, hf = tid & 1, n = ncols >> 1;
  const bf16_t* src = P + (size_t)(m0 + r) * PINP + col0 + hf * n;
  float ss = 0.f;
  for (int c = 0; c < n; c += 8) { const u32x4 q = *(const u32x4*)(src + c);
    ss += bflo(q.x) * bflo(q.x) + bfhi(q.x) * bfhi(q.x) + bflo(q.y) * bflo(q.y) + bfhi(q.y) * bfhi(q.y) + bflo(q.z) * bflo(q.z) + bfhi(q.z) * bfhi(q.z) + bflo(q.w) * bflo(q.w) + bfhi(q.w) * bfhi(q.w); }
  ss += __shfl_xor(ss, 1);
  if (hf == 0) rst[r] = rsqrtf(ss / (float)ncols + 1e-6f);
  __syncthreads();
}
DI void qproj_item(const Params& p, int l, int item, char* smem) {
  const int mt = item / 3, nt = item % 3; const bf16_t* P = (const bf16_t*)(p.ws + OFF_P);
  float* rst = (float*)(smem + 36864);
  tile_rstd(P, mt * 128, C_CQ, 256, rst);
  bf16_t* Q = (bf16_t*)(p.ws + OFF_QRAW);
  gemm_tile<0, 0>(P + C_CQ, PINP, (const bf16_t*)(p.ws + OFF_WUQ) + (size_t)l * 384 * 256, 256, 256, mt * 128, nt * 128, smem, nullptr,
               [&](int row, int col, f32x4 v) { const float r = rst[row - mt * 128]; store_bf4(Q + (size_t)row * 384 + col, v * r); });
  __syncthreads();
}
DI void kvproj_item(const Params& p, int l, int item, char* smem) {
  const int mt = item / 4, nt = item % 4; const bf16_t* P = (const bf16_t*)(p.ws + OFF_P);
  float* rst = (float*)(smem + 36864);
  tile_rstd(P, mt * 128, C_CKV, 128, rst);
  bf16_t* KH = (bf16_t*)(p.ws + OFF_KH); bf16_t* VT = (bf16_t*)(p.ws + OFF_VT);
  gemm_tile<0, 0>(P + C_CKV, PINP, (const bf16_t*)(p.ws + OFF_WUKV) + (size_t)l * 512 * 128, 128, 128, mt * 128, nt * 128, smem, nullptr,
               [&](int row, int col, f32x4 v) {
                 const float r = rst[row - mt * 128]; v = v * r;
                 const int hh = col >> 7, dd = col & 127;
                 int b, tpos; if (row < NLAT) { b = row / T; tpos = row % T; } else { b = (row - NLAT) / TC; tpos = T + (row - NLAT) % TC; }
                 if (dd < 64) store_bf4(KH + ((size_t)(b * 4 + hh) * TALL + tpos) * 64 + dd, v);
                 else {
                   bf16_t* vp = VT + ((size_t)(b * 4 + hh) * 64 + (dd - 64)) * TALL + tpos;
                   vp[0] = f2bf(v[0]); vp[TALL] = f2bf(v[1]); vp[2 * TALL] = f2bf(v[2]); vp[3 * TALL] = f2bf(v[3]);
                 }
               });
  __syncthreads();
}
DI void rope_cs(int t, int i, float& cs, float& sn) {
  const int pos = (i < 8) ? (t >> 6) : (t & 63); const int f = i & 7;
  const float inv = exp2f(-(float)f * (13.287712379549449f / 8.f));
  const float ang = (float)pos * inv;
  cs = cosf(ang); sn = sinf(ang);
}
DI void ropek_item(const Params& p, int item) {
  const int row = item * 256 + ltid();
  const bf16_t* src = (const bf16_t*)(p.ws + OFF_P) + (size_t)row * PINP + C_KR;
  u32x4 q[4];
#pragma unroll
  for (int i = 0; i < 4; ++i) q[i] = *(const u32x4*)(src + i * 8);
  float v[32];
#pragma unroll
  for (int i = 0; i < 4; ++i) { v[i * 8 + 0] = bflo(q[i].x); v[i * 8 + 1] = bfhi(q[i].x); v[i * 8 + 2] = bflo(q[i].y); v[i * 8 + 3] = bfhi(q[i].y);
    v[i * 8 + 4] = bflo(q[i].z); v[i * 8 + 5] = bfhi(q[i].z); v[i * 8 + 6] = bflo(q[i].w); v[i * 8 + 7] = bfhi(q[i].w); }
  int b, tpos;
  if (row < NLAT) {
    b = row / T; tpos = row % T;
#pragma unroll
    for (int i = 0; i < 16; ++i) { float cs, sn; rope_cs(tpos, i, cs, sn); const float x1 = v[i], x2 = v[i + 16]; v[i] = x1 * cs - x2 * sn; v[i + 16] = x1 * sn + x2 * cs; }
  } else { b = (row - NLAT) / TC; tpos = T + (row - NLAT) % TC; }
  u32x4 o[4];
#pragma unroll
  for (int i = 0; i < 4; ++i) { o[i].x = pack2(v[i * 8], v[i * 8 + 1]); o[i].y = pack2(v[i * 8 + 2], v[i * 8 + 3]); o[i].z = pack2(v[i * 8 + 4], v[i * 8 + 5]); o[i].w = pack2(v[i * 8 + 6], v[i * 8 + 7]); }
  bf16_t* dst = (bf16_t*)(p.ws + OFF_KR) + ((size_t)b * TALL + tpos) * 32;
#pragma unroll
  for (int i = 0; i < 4; ++i) *(u32x4*)(dst + i * 8) = o[i];
}

DI void attn_item(const Params& p, int item, char* smem) {
  const int tid = ltid(), lane = tid & 63, w = __builtin_amdgcn_readfirstlane(tid >> 6), l15 = lane & 15, g4 = lane >> 4;
  int b, h, qt, latent;
  if (item < 512) { latent = 1; qt = item & 63; h = (item >> 6) & 3; b = item >> 8; }
  else { latent = 0; const int i2 = item - 512; qt = i2 & 1; h = (i2 >> 1) & 3; b = i2 >> 3; }
  const int qrow0 = latent ? b * T + qt * 128 : NLAT + b * TC + qt * 128;
  bf16_t* Qs = (bf16_t*)smem;
  bf16_t* Ks = (bf16_t*)smem;
  bf16_t* Vs = Ks + 64 * 104;
  const bf16_t* Qraw = (const bf16_t*)(p.ws + OFF_QRAW);
  const float qscale = 0.10206207261596577f * 1.4426950408889634f;
  for (int id = tid; id < 1280; id += 256) {
    const int r = id / 10, cc = id % 10;
    const bf16_t* src = Qraw + (size_t)(qrow0 + r) * 384 + h * 96 + cc * 8;
    const u32x4 q = *(const u32x4*)src;
    float a[8] = {bflo(q.x), bfhi(q.x), bflo(q.y), bfhi(q.y), bflo(q.z), bfhi(q.z), bflo(q.w), bfhi(q.w)};
    if (cc < 8) {
      u32x4 o; o.x = pack2(a[0] * qscale, a[1] * qscale); o.y = pack2(a[2] * qscale, a[3] * qscale); o.z = pack2(a[4] * qscale, a[5] * qscale); o.w = pack2(a[6] * qscale, a[7] * qscale);
      *(u32x4*)(Qs + r * 104 + cc * 8) = o;
    } else {
      const u32x4 q2 = *(const u32x4*)(src + 16);
      float c2[8] = {bflo(q2.x), bfhi(q2.x), bflo(q2.y), bfhi(q2.y), bflo(q2.z), bfhi(q2.z), bflo(q2.w), bfhi(q2.w)};
      float o1[8], o2[8];
#pragma unroll
      for (int j = 0; j < 8; ++j) {
        float cs = 1.f, sn = 0.f;
        if (latent) rope_cs(qt * 128 + r, (cc - 8) * 8 + j, cs, sn);
        o1[j] = (a[j] * cs - c2[j] * sn) * qscale; o2[j] = (a[j] * sn + c2[j] * cs) * qscale;
      }
      u32x4 o; o.x = pack2(o1[0], o1[1]); o.y = pack2(o1[2], o1[3]); o.z = pack2(o1[4], o1[5]); o.w = pack2(o1[6], o1[7]);
      *(u32x4*)(Qs + r * 104 + cc * 8) = o;
      o.x = pack2(o2[0], o2[1]); o.y = pack2(o2[2], o2[3]); o.z = pack2(o2[4], o2[5]); o.w = pack2(o2[6], o2[7]);
      *(u32x4*)(Qs + r * 104 + cc * 8 + 16) = o;
    }
  }
  __syncthreads();
  bf16x8 qf[2][3];
#pragma unroll
  for (int qs = 0; qs < 2; ++qs)
#pragma unroll
    for (int ks = 0; ks < 3; ++ks) qf[qs][ks] = ld_frag(Qs + (32 * w + 16 * qs + l15) * 104 + ks * 32 + g4 * 8);
  __syncthreads();
  const int kt0 = latent ? 0 : 128, kt1 = 132;
  const bf16_t* Kg = (const bf16_t*)(p.ws + OFF_KH) + (size_t)(b * 4 + h) * TALL * 64;
  const bf16_t* Rg = (const bf16_t*)(p.ws + OFF_KR) + (size_t)b * TALL * 32;
  const bf16_t* Vg = (const bf16_t*)(p.ws + OFF_VT) + (size_t)(b * 4 + h) * 64 * TALL;
  u32x4 kr[3], vr[2];
  const int ve0 = tid >> 3, vc = tid & 7;
  {
    kr[0] = *(const u32x4*)(Kg + (size_t)kt0 * 4096 + tid * 8); kr[1] = *(const u32x4*)(Kg + (size_t)kt0 * 4096 + (tid + 256) * 8);
    kr[2] = *(const u32x4*)(Rg + (size_t)kt0 * 2048 + tid * 8);
#pragma unroll
    for (int i = 0; i < 2; ++i) vr[i] = *(const u32x4*)(Vg + (size_t)(ve0 + 32 * i) * TALL + kt0 * 64 + vc * 8);
  }
  float mrun[2] = {-1e30f, -1e30f}, lsum[2] = {0.f, 0.f};
  f32x4 O[4][2];
#pragma unroll
  for (int es = 0; es < 4; ++es)
#pragma unroll
    for (int qs = 0; qs < 2; ++qs) O[es][qs] = (f32x4){0.f, 0.f, 0.f, 0.f};
  constexpr int KVB = 64 * 104 + 64 * 72;
  {
#pragma unroll
    for (int i = 0; i < 2; ++i) { const int id = tid + 256 * i; *(u32x4*)(Ks + (id >> 3) * 104 + (id & 7) * 8) = kr[i]; }
    *(u32x4*)(Ks + (tid >> 2) * 104 + 64 + (tid & 3) * 8) = kr[2];
#pragma unroll
    for (int i = 0; i < 2; ++i) *(u32x4*)(Vs + (ve0 + 32 * i) * 72 + vc * 8) = vr[i];
    if (kt0 + 1 < kt1) {
      kr[0] = *(const u32x4*)(Kg + (size_t)(kt0 + 1) * 4096 + tid * 8); kr[1] = *(const u32x4*)(Kg + (size_t)(kt0 + 1) * 4096 + (tid + 256) * 8);
      kr[2] = *(const u32x4*)(Rg + (size_t)(kt0 + 1) * 2048 + tid * 8);
#pragma unroll
      for (int i = 0; i < 2; ++i) vr[i] = *(const u32x4*)(Vg + (size_t)(ve0 + 32 * i) * TALL + (kt0 + 1) * 64 + vc * 8);
    }
    __syncthreads();
  }
  for (int kt = kt0; kt < kt1; ++kt) {
    const int cur = (kt - kt0) & 1;
    const bf16_t* Kc = Ks + cur * KVB; const bf16_t* Vc = Vs + cur * KVB;
    bf16_t* Kn = Ks + (cur ^ 1) * KVB; bf16_t* Vn = Vs + (cur ^ 1) * KVB;
    if (kt + 1 < kt1) {
#pragma unroll
      for (int i = 0; i < 2; ++i) { const int id = tid + 256 * i; *(u32x4*)(Kn + (id >> 3) * 104 + (id & 7) * 8) = kr[i]; }
      *(u32x4*)(Kn + (tid >> 2) * 104 + 64 + (tid & 3) * 8) = kr[2];
#pragma unroll
      for (int i = 0; i < 2; ++i) *(u32x4*)(Vn + (ve0 + 32 * i) * 72 + vc * 8) = vr[i];
    }
    if (kt + 2 < kt1) {
      kr[0] = *(const u32x4*)(Kg + (size_t)(kt + 2) * 4096 + tid * 8); kr[1] = *(const u32x4*)(Kg + (size_t)(kt + 2) * 4096 + (tid + 256) * 8);
      kr[2] = *(const u32x4*)(Rg + (size_t)(kt + 2) * 2048 + tid * 8);
#pragma unroll
      for (int i = 0; i < 2; ++i) vr[i] = *(const u32x4*)(Vg + (size_t)(ve0 + 32 * i) * TALL + (kt + 2) * 64 + vc * 8);
    }
    __builtin_amdgcn_sched_barrier(0);
    f32x4 sa[4][2];
#pragma unroll
    for (int kb = 0; kb < 4; ++kb)
#pragma unroll
      for (int qs = 0; qs < 2; ++qs) sa[kb][qs] = (f32x4){0.f, 0.f, 0.f, 0.f};
#pragma unroll
    for (int ks = 0; ks < 3; ++ks)
#pragma unroll
      for (int kb = 0; kb < 4; ++kb) {
        const bf16x8 a = ld_frag(Kc + (16 * kb + l15) * 104 + ks * 32 + g4 * 8);
#pragma unroll
        for (int qs = 0; qs < 2; ++qs) sa[kb][qs] = MFMA16(a, qf[qs][ks], sa[kb][qs]);
      }
    bf16x8 pf[2][2];
#pragma unroll
    for (int qs = 0; qs < 2; ++qs) {
      float mx = -1e30f;
#pragma unroll
      for (int kb = 0; kb < 4; ++kb)
#pragma unroll
        for (int j = 0; j < 4; ++j) mx = fmaxf(mx, sa[kb][qs][j]);
      mx = fmaxf(mx, __shfl_xor(mx, 16)); mx = fmaxf(mx, __shfl_xor(mx, 32));
      const float mnew = fmaxf(mrun[qs], mx), alpha = __builtin_amdgcn_exp2f(mrun[qs] - mnew);
      mrun[qs] = mnew;
      float ps = 0.f;
#pragma unroll
      for (int kb = 0; kb < 4; ++kb)
#pragma unroll
        for (int j = 0; j < 4; ++j) { const float e = __builtin_amdgcn_exp2f(sa[kb][qs][j] - mnew); sa[kb][qs][j] = e; ps += e; }
      lsum[qs] = lsum[qs] * alpha + ps;
#pragma unroll
      for (int es = 0; es < 4; ++es) O[es][qs] = O[es][qs] * alpha;
#pragma unroll
      for (int k2 = 0; k2 < 2; ++k2)
        pf[qs][k2] = mk_frag(pack2(sa[2 * k2][qs][0], sa[2 * k2][qs][1]), pack2(sa[2 * k2][qs][2], sa[2 * k2][qs][3]),
                             pack2(sa[2 * k2 + 1][qs][0], sa[2 * k2 + 1][qs][1]), pack2(sa[2 * k2 + 1][qs][2], sa[2 * k2 + 1][qs][3]));
    }
#pragma unroll
    for (int k2 = 0; k2 < 2; ++k2)
#pragma unroll
      for (int es = 0; es < 4; ++es) {
        const bf16_t* vp = Vc + (16 * es + l15) * 72 + 32 * k2 + 4 * g4;
        const u32x2 lo = *(const u32x2*)vp, hi = *(const u32x2*)(vp + 16);
        const bf16x8 a = mk_frag(lo.x, lo.y, hi.x, hi.y);
#pragma unroll
        for (int qs = 0; qs < 2; ++qs) O[es][qs] = MFMA16(a, pf[qs][k2], O[es][qs]);
      }
    __syncthreads();
  }
  bf16_t* Y = (bf16_t*)(p.ws + OFF_HY);
#pragma unroll
  for (int qs = 0; qs < 2; ++qs) {
    float l = lsum[qs]; l += __shfl_xor(l, 16); l += __shfl_xor(l, 32);
    const float inv = 1.f / l;
    const int row = qrow0 + 32 * w + 16 * qs + l15;
#pragma unroll
    for (int es = 0; es < 4; ++es) store_bf4(Y + (size_t)row * 1024 + 256 + h * 64 + 16 * es + 4 * g4, O[es][qs] * inv);
  }
  __syncthreads();
}

DI void chunk_geom(int tcg, int b, int& part, int& tc, int& row0) { part = tcg >= 128; tc = part ? tcg - 128 : tcg; row0 = row_of(b, part, tc * 64); }
DI int chain_slot(int dir, int part, int tc) { return dir ? (part ? 3 - tc : 131 - tc) : (part ? tc : 4 + tc); }

DI void mlstm_p1(const Params& p, int l, int item, char* smem) {
  const int tid = ltid(), lane = tid & 63, w = __builtin_amdgcn_readfirstlane(tid >> 6), l15 = lane & 15, g4 = lane >> 4;
  const int tcg = item % NCH; int r = item / NCH; const int dir = r & 1; r >>= 1; const int h = r & 3, b = r >> 2;
  int part, tc, row0; chunk_geom(tcg, b, part, tc, row0);
  const int c = chain_slot(dir, part, tc), chain = (b * 4 + h) * 2 + dir;
  bf16_t* A = (bf16_t*)smem;
  bf16_t* Bk = A + 80 * 72;
  float* fs = (float*)(Bk + 64 * 72);
  const bf16_t* P = (const bf16_t*)(p.ws + OFF_P); const float* GML = (const float*)(p.ws + OFF_GML);
  float* MLM = (float*)(p.ws + OFF_MLM) + (size_t)(chain * NCH + c) * 32;
  if (tid < 64) {
    const int gi = 2 * dir;
    const float ig = GML[(size_t)(row0 + tid) * 16 + gi * 4 + h] + p.ml_gate_bias[l * 16 + gi * 4 + h];
    const float fg = GML[(size_t)(row0 + tid) * 16 + (gi + 1) * 4 + h] + p.ml_gate_bias[l * 16 + (gi + 1) * 4 + h];
    const float lf = logsigm_f(fg);
    const float pre = wave_incl_scan(lf, lane), tot = __shfl(pre, 63);
    const float bc = dir ? tot - pre + lf : pre;
    const float wlog = tot - bc + ig, mloc = wave_max(wlog), wv = __expf(wlog - mloc);
    fs[tid] = wv; A[64 * 72 + tid] = f2bf(wv);
    if (tid == 0) { MLM[0] = mloc; MLM[1] = tot; }
  }
  for (int i = tid; i < 15 * 72; i += 256) A[65 * 72 + i] = 0;
  __syncthreads();
  {
    const int s = tid >> 2, d0 = (tid & 3) * 16; const float wv = fs[s];
    const bf16_t* kp = P + (size_t)(row0 + s) * PINP + C_MLK + h * 64 + d0;
    const bf16_t* vp = P + (size_t)(row0 + s) * PINP + C_MLV + h * 64 + d0;
#pragma unroll
    for (int hf = 0; hf < 2; ++hf) {
      const u32x4 kq = *(const u32x4*)(kp + hf * 8), vq = *(const u32x4*)(vp + hf * 8);
      const float kk[8] = {bflo(kq.x), bfhi(kq.x), bflo(kq.y), bfhi(kq.y), bflo(kq.z), bfhi(kq.z), bflo(kq.w), bfhi(kq.w)};
      const float vv[8] = {bflo(vq.x), bfhi(vq.x), bflo(vq.y), bfhi(vq.y), bflo(vq.z), bfhi(vq.z), bflo(vq.w), bfhi(vq.w)};
#pragma unroll
      for (int j = 0; j < 8; ++j) { Bk[(d0 + hf * 8 + j) * 72 + s] = f2bf(kk[j] * 0.125f); A[(d0 + hf * 8 + j) * 72 + s] = f2bf(vv[j] * wv); }
    }
  }
  __syncthreads();
  float* MLS = (float*)(p.ws + OFF_MLS) + (size_t)(chain * NCH + c) * 4160;
  for (int t = w; t < 20; t += 4) {
    const int ms = t >> 2, ns = t & 3;
    f32x4 acc = {0.f, 0.f, 0.f, 0.f};
#pragma unroll
    for (int ks = 0; ks < 2; ++ks) acc = MFMA16(ld_frag(A + (16 * ms + l15) * 72 + ks * 32 + g4 * 8), ld_frag(Bk + (16 * ns + l15) * 72 + ks * 32 + g4 * 8), acc);
#pragma unroll
    for (int j = 0; j < 4; ++j) { const int e = 16 * ms + 4 * g4 + j; if (e <= 64) MLS[e * 64 + 16 * ns + l15] = acc[j]; }
  }
  __syncthreads();
}
DI void mlstm_p2(const Params& p, int item) {
  const int gi = item * 256 + ltid(), chain = gi / 4160, e = gi % 4160;
  float* MLS = (float*)(p.ws + OFF_MLS) + (size_t)chain * NCH * 4160 + e;
  float* MLM = (float*)(p.ws + OFF_MLM) + (size_t)chain * NCH * 32;
  float C = 0.f, m = 0.f;
  for (int c0 = 0; c0 < NCH; c0 += 12) {
    float d[12], ml[12], bl[12];
#pragma unroll
    for (int i = 0; i < 12; ++i) { d[i] = MLS[(size_t)(c0 + i) * 4160]; ml[i] = MLM[(c0 + i) * 32]; bl[i] = MLM[(c0 + i) * 32 + 1]; }
#pragma unroll
    for (int i = 0; i < 12; ++i) {
      MLS[(size_t)(c0 + i) * 4160] = C; if (e == 0) MLM[(c0 + i) * 32 + 16] = m;
      const float mn = fmaxf(bl[i] + m, ml[i]);
      C = __expf(bl[i] + m - mn) * C + __expf(ml[i] - mn) * d[i]; m = mn;
    }
  }
}
DI void mlstm_p3(const Params& p, int l, int item, char* smem) {
  const int tid = ltid(), lane = tid & 63, w = __builtin_amdgcn_readfirstlane(tid >> 6), l15 = lane & 15, g4 = lane >> 4;
  const int h = item & 3; const int r = item >> 2; const int tcg = r % NCH, b = r / NCH;
  int part, tc, row0; chunk_geom(tcg, b, part, tc, row0);
  bf16_t* Qs = (bf16_t*)smem;
  bf16_t* Ks = Qs + 64 * 72;
  bf16_t* Vt = Ks + 64 * 72;
  bf16_t* Sb = Vt + 64 * 72;
  float* fb = (float*)(Sb + 64 * 72);
  float* fi = fb + 64;
  const bf16_t* P = (const bf16_t*)(p.ws + OFF_P); const float* GML = (const float*)(p.ws + OFF_GML);
  {
    const int s = tid >> 2, d0 = (tid & 3) * 16;
    const bf16_t* base = P + (size_t)(row0 + s) * PINP + h * 64 + d0;
#pragma unroll
    for (int hf = 0; hf < 2; ++hf) {
      *(u32x4*)(Qs + s * 72 + d0 + hf * 8) = *(const u32x4*)(base + C_MLQ + hf * 8);
      const u32x4 kq = *(const u32x4*)(base + C_MLK + hf * 8), vq = *(const u32x4*)(base + C_MLV + hf * 8);
      u32x4 ko; ko.x = pack2(bflo(kq.x) * 0.125f, bfhi(kq.x) * 0.125f); ko.y = pack2(bflo(kq.y) * 0.125f, bfhi(kq.y) * 0.125f);
      ko.z = pack2(bflo(kq.z) * 0.125f, bfhi(kq.z) * 0.125f); ko.w = pack2(bflo(kq.w) * 0.125f, bfhi(kq.w) * 0.125f);
      *(u32x4*)(Ks + s * 72 + d0 + hf * 8) = ko;
      const unsigned vw[4] = {vq.x, vq.y, vq.z, vq.w};
#pragma unroll
      for (int j = 0; j < 4; ++j) { Vt[(d0 + hf * 8 + 2 * j) * 72 + s] = (bf16_t)(vw[j] & 0xffffu); Vt[(d0 + hf * 8 + 2 * j + 1) * 72 + s] = (bf16_t)(vw[j] >> 16); }
    }
  }
  f32x4 hs[4];
#pragma unroll
  for (int ns = 0; ns < 4; ++ns) hs[ns] = (f32x4){0.f, 0.f, 0.f, 0.f};
#pragma unroll 1
  for (int dir = 0; dir < 2; ++dir) {
    const int c = chain_slot(dir, part, tc), chain = (b * 4 + h) * 2 + dir;
    const float m_in = ((const float*)(p.ws + OFF_MLM))[(size_t)(chain * NCH + c) * 32 + 16];
    const float* Cst = (const float*)(p.ws + OFF_MLS) + (size_t)(chain * NCH + c) * 4160;
    __syncthreads();
    if (tid < 64) {
      const int gi = 2 * dir;
      const float ig = GML[(size_t)(row0 + tid) * 16 + gi * 4 + h] + p.ml_gate_bias[l * 16 + gi * 4 + h];
      const float fg = GML[(size_t)(row0 + tid) * 16 + (gi + 1) * 4 + h] + p.ml_gate_bias[l * 16 + (gi + 1) * 4 + h];
      const float lf = logsigm_f(fg);
      const float pre = wave_incl_scan(lf, lane), tot = __shfl(pre, 63);
      fb[tid] = dir ? tot - pre + lf : pre; fi[tid] = ig;
    }
    __syncthreads();
    f32x4 sc[4];
#pragma unroll
    for (int ns = 0; ns < 4; ++ns) {
      f32x4 a = {0.f, 0.f, 0.f, 0.f};
#pragma unroll
      for (int ks = 0; ks < 2; ++ks) a = MFMA16(ld_frag(Qs + (16 * w + l15) * 72 + ks * 32 + g4 * 8), ld_frag(Ks + (16 * ns + l15) * 72 + ks * 32 + g4 * 8), a);
      sc[ns] = a;
    }
    float bi[4], mt[4], rsum[4];
#pragma unroll
    for (int j = 0; j < 4; ++j) {
      const int i = 16 * w + 4 * g4 + j; bi[j] = fb[i];
      float mx = -1e30f;
#pragma unroll
      for (int ns = 0; ns < 4; ++ns) { const int s = 16 * ns + l15; const bool ok = dir ? (s >= i) : (s <= i); const float dm = bi[j] - fb[s] + fi[s]; if (ok) mx = fmaxf(mx, dm); }
      mx = red16_max(mx);
      mt[j] = fmaxf(bi[j] + m_in, mx);
      float rs = 0.f;
#pragma unroll
      for (int ns = 0; ns < 4; ++ns) {
        const int s = 16 * ns + l15; const bool ok = dir ? (s >= i) : (s <= i);
        const float v = ok ? sc[ns][j] * __expf(bi[j] - fb[s] + fi[s] - mt[j]) : 0.f;
        rs += v; Sb[i * 72 + s] = f2bf(v);
      }
      rsum[j] = red16_sum(rs);
    }
    __syncthreads();
    f32x4 qc[5];
#pragma unroll
    for (int ns = 0; ns < 5; ++ns) {
      f32x4 a = {0.f, 0.f, 0.f, 0.f};
      const int e = 16 * ns + l15;
#pragma unroll
      for (int ks = 0; ks < 2; ++ks) {
        bf16x8 bfm;
        if (e <= 64) bfm = frag_from_f32(Cst + e * 64 + ks * 32 + g4 * 8, 1.f); else bfm = mk_frag(0u, 0u, 0u, 0u);
        a = MFMA16(ld_frag(Qs + (16 * w + l15) * 72 + ks * 32 + g4 * 8), bfm, a);
      }
      qc[ns] = a;
    }
    f32x4 nm[4];
#pragma unroll
    for (int ns = 0; ns < 4; ++ns) {
      f32x4 a = {0.f, 0.f, 0.f, 0.f};
#pragma unroll
      for (int ks = 0; ks < 2; ++ks) a = MFMA16(ld_frag(Sb + (16 * w + l15) * 72 + ks * 32 + g4 * 8), ld_frag(Vt + (16 * ns + l15) * 72 + ks * 32 + g4 * 8), a);
      nm[ns] = a;
    }
#pragma unroll
    for (int j = 0; j < 4; ++j) {
      const float wi = __expf(bi[j] + m_in - mt[j]);
      const float qn = __shfl(qc[4][j], lane & 48);
      const float den = rsum[j] + wi * qn;
      const float dd = 1.f / fmaxf(fabsf(den), __expf(-mt[j]));
#pragma unroll
      for (int ns = 0; ns < 4; ++ns) hs[ns][j] += (nm[ns][j] + wi * qc[ns][j]) * dd;
    }
  }
  bf16_t* Y = (bf16_t*)(p.ws + OFF_HY);
#pragma unroll
  for (int j = 0; j < 4; ++j) {
    float ss = 0.f;
#pragma unroll
    for (int ns = 0; ns < 4; ++ns) ss += hs[ns][j] * hs[ns][j];
    ss = red16_sum(ss);
    const float rstd = rsqrtf(ss * (1.f / 64.f) + 1e-6f);
    const int row = row0 + 16 * w + 4 * g4 + j;
#pragma unroll
    for (int ns = 0; ns < 4; ++ns) {
      const int ch = h * 64 + 16 * ns + l15;
      const float o = bf2f(P[(size_t)row * PINP + C_MLO + ch]);
      Y[(size_t)row * 1024 + ch] = f2bf(hs[ns][j] * rstd * p.ml_norm[l * 256 + ch] * sigm_f(o));
    }
  }
  __syncthreads();
}

DI void conv_silu8(const Params& p, int l, const bf16_t* P, int row, bool hp, bool hn, int ch, float* out) {
  const bf16_t* src = P + (size_t)row * PINP + C_XBC + ch;
  const u32x4 z = {0u, 0u, 0u, 0u};
  const u32x4 c0 = *(const u32x4*)src, pm = hp ? *(const u32x4*)(src - PINP) : z, nx = hn ? *(const u32x4*)(src + PINP) : z;
  const float* cw = p.ssd_conv_w + (size_t)l * 3 * 768 + ch; const float* cb = p.ssd_conv_b + l * 768 + ch;
  const float a[8] = {bflo(pm.x), bfhi(pm.x), bflo(pm.y), bfhi(pm.y), bflo(pm.z), bfhi(pm.z), bflo(pm.w), bfhi(pm.w)};
  const float m[8] = {bflo(c0.x), bfhi(c0.x), bflo(c0.y), bfhi(c0.y), bflo(c0.z), bfhi(c0.z), bflo(c0.w), bfhi(c0.w)};
  const float n[8] = {bflo(nx.x), bfhi(nx.x), bflo(nx.y), bfhi(nx.y), bflo(nx.z), bfhi(nx.z), bflo(nx.w), bfhi(nx.w)};
#pragma unroll
  for (int j = 0; j < 8; ++j) out[j] = silu_f(cb[j] + cw[j] * a[j] + cw[768 + j] * m[j] + cw[1536 + j] * n[j]);
}
DI void ssd_gates(const Params& p, int l, int dir, int h, int row0, int tid, int lane, float& dt, float& cs, float& tot) {
  const float* DTR = (const float*)(p.ws + OFF_DTR);
  dt = softplus_f(DTR[(size_t)(row0 + tid) * 8 + dir * 4 + h] + p.ssd_dt_bias[l * 8 + dir * 4 + h]);
  const float la = -dt * __expf(p.ssd_a_log[l * 8 + dir * 4 + h]);
  const float pre = wave_incl_scan(la, lane); tot = __shfl(pre, 63);
  cs = dir ? tot - pre + la : pre;
}
DI void ssd_p1(const Params& p, int l, int item, char* smem) {
  const int tid = ltid(), lane = tid & 63, w = __builtin_amdgcn_readfirstlane(tid >> 6), l15 = lane & 15, g4 = lane >> 4;
  const int tcg = item % NCH; int r = item / NCH; const int dir = r & 1; r >>= 1; const int h = r & 3, b = r >> 2;
  int part, tc, row0; chunk_geom(tcg, b, part, tc, row0);
  const int c = chain_slot(dir, part, tc), chain = (b * 4 + h) * 2 + dir, lastc = part ? 3 : 127;
  bf16_t* Xt = (bf16_t*)smem;
  bf16_t* Bt = Xt + 64 * 72;
  float* fs = (float*)(Bt + 128 * 72);
  const bf16_t* P = (const bf16_t*)(p.ws + OFF_P);
  if (tid < 64) {
    float dt, cs, tot; ssd_gates(p, l, dir, h, row0, tid, lane, dt, cs, tot);
    fs[tid] = __expf(tot - cs) * dt;
    if (tid == 0) ((float*)(p.ws + OFF_SSA))[(chain * NCH + c) * 32] = tot;
  }
  __syncthreads();
  const int grp = h >> 1;
  for (int id = tid; id < 64 * 24; id += 256) {
    const int s = id / 24, cc = id % 24;
    const bool hp = !(tc == 0 && s == 0), hn = !(tc == lastc && s == 63);
    float v[8];
    if (cc < 8) { conv_silu8(p, l, P, row0 + s, hp, hn, h * 64 + cc * 8, v); const float wv = fs[s];
#pragma unroll
      for (int j = 0; j < 8; ++j) Xt[(cc * 8 + j) * 72 + s] = f2bf(v[j] * wv); }
    else { const int n0 = (cc - 8) * 8; conv_silu8(p, l, P, row0 + s, hp, hn, 256 + grp * 128 + n0, v);
#pragma unroll
      for (int j = 0; j < 8; ++j) Bt[(n0 + j) * 72 + s] = f2bf(v[j]); }
  }
  __syncthreads();
  float* SS = (float*)(p.ws + OFF_SSDS) + (size_t)(chain * NCH + c) * 8192;
#pragma unroll
  for (int ns = 0; ns < 8; ++ns) {
    f32x4 acc = {0.f, 0.f, 0.f, 0.f};
#pragma unroll
    for (int ks = 0; ks < 2; ++ks) acc = MFMA16(ld_frag(Xt + (16 * w + l15) * 72 + ks * 32 + g4 * 8), ld_frag(Bt + (16 * ns + l15) * 72 + ks * 32 + g4 * 8), acc);
#pragma unroll
    for (int j = 0; j < 4; ++j) SS[(16 * w + 4 * g4 + j) * 128 + 16 * ns + l15] = acc[j];
  }
  __syncthreads();
}
DI void ssd_p2(const Params& p, int item) {
  const int gi = item * 256 + ltid(), chain = gi >> 13, e = gi & 8191;
  float* SS = (float*)(p.ws + OFF_SSDS) + (size_t)chain * NCH * 8192 + e;
  const float* SA = (const float*)(p.ws + OFF_SSA) + (size_t)chain * NCH * 32;
  float S = 0.f;
  for (int c0 = 0; c0 < NCH; c0 += 12) {
    float d[12], a[12];
#pragma unroll
    for (int i = 0; i < 12; ++i) { d[i] = SS[(size_t)(c0 + i) * 8192]; a[i] = SA[(c0 + i) * 32]; }
#pragma unroll
    for (int i = 0; i < 12; ++i) { SS[(size_t)(c0 + i) * 8192] = S; S = __expf(a[i]) * S + d[i]; }
  }
}
DI void ssd_p3(const Params& p, int l, int item, char* smem) {
  const int tid = ltid(), lane = tid & 63, w = __builtin_amdgcn_readfirstlane(tid >> 6), l15 = lane & 15, g4 = lane >> 4;
  const int h = item & 3; const int r = item >> 2; const int tcg = r % NCH, b = r / NCH;
  int part, tc, row0; chunk_geom(tcg, b, part, tc, row0);
  const int lastc = part ? 3 : 127, grp = h >> 1;
  bf16_t* Cm = (bf16_t*)smem;
  bf16_t* Bm = Cm + 64 * 136;
  bf16_t* Xt = Bm + 64 * 136;
  bf16_t* Sb = Xt + 64 * 72;
  float* fcs = (float*)(Sb + 64 * 72);
  float* fdt = fcs + 64;
  const bf16_t* P = (const bf16_t*)(p.ws + OFF_P);
  for (int id = tid; id < 64 * 40; id += 256) {
    const int s = id / 40, cc = id % 40;
    const bool hp = !(tc == 0 && s == 0), hn = !(tc == lastc && s == 63);
    float v[8];
    if (cc < 8) { conv_silu8(p, l, P, row0 + s, hp, hn, h * 64 + cc * 8, v);
#pragma unroll
      for (int j = 0; j < 8; ++j) Xt[(cc * 8 + j) * 72 + s] = f2bf(v[j]); }
    else {
      const int q = cc - 8, isC = q >= 16, n0 = (q & 15) * 8;
      conv_silu8(p, l, P, row0 + s, hp, hn, 256 + isC * 256 + grp * 128 + n0, v);
      u32x4 o; o.x = pack2(v[0], v[1]); o.y = pack2(v[2], v[3]); o.z = pack2(v[4], v[5]); o.w = pack2(v[6], v[7]);
      *(u32x4*)((isC ? Cm : Bm) + s * 136 + n0) = o;
    }
  }
  f32x4 ys[4];
#pragma unroll
  for (int ns = 0; ns < 4; ++ns) ys[ns] = (f32x4){0.f, 0.f, 0.f, 0.f};
#pragma unroll 1
  for (int dir = 0; dir < 2; ++dir) {
    const int c = chain_slot(dir, part, tc), chain = (b * 4 + h) * 2 + dir;
    const float* St = (const float*)(p.ws + OFF_SSDS) + (size_t)(chain * NCH + c) * 8192;
    __syncthreads();
    if (tid < 64) { float dt, cs, tot; ssd_gates(p, l, dir, h, row0, tid, lane, dt, cs, tot); fcs[tid] = cs; fdt[tid] = dt; }
    __syncthreads();
    float ci[4];
#pragma unroll
    for (int j = 0; j < 4; ++j) ci[j] = fcs[16 * w + 4 * g4 + j];
#pragma unroll
    for (int ns = 0; ns < 4; ++ns) {
      f32x4 a = {0.f, 0.f, 0.f, 0.f};
#pragma unroll
      for (int ks = 0; ks < 4; ++ks) a = MFMA16(ld_frag(Cm + (16 * w + l15) * 136 + ks * 32 + g4 * 8), ld_frag(Bm + (16 * ns + l15) * 136 + ks * 32 + g4 * 8), a);
      const int s = 16 * ns + l15; const float css = fcs[s], dts = fdt[s];
#pragma unroll
      for (int j = 0; j < 4; ++j) {
        const int i = 16 * w + 4 * g4 + j; const bool ok = dir ? (s >= i) : (s <= i);
        Sb[i * 72 + s] = f2bf(ok ? a[j] * __expf(ci[j] - css) * dts : 0.f);
      }
    }
    __syncthreads();
#pragma unroll
    for (int ns = 0; ns < 4; ++ns) {
      f32x4 a = {0.f, 0.f, 0.f, 0.f}, bq = {0.f, 0.f, 0.f, 0.f};
#pragma unroll
      for (int ks = 0; ks < 2; ++ks) a = MFMA16(ld_frag(Sb + (16 * w + l15) * 72 + ks * 32 + g4 * 8), ld_frag(Xt + (16 * ns + l15) * 72 + ks * 32 + g4 * 8), a);
#pragma unroll
      for (int ks = 0; ks < 4; ++ks) bq = MFMA16(ld_frag(Cm + (16 * w + l15) * 136 + ks * 32 + g4 * 8), frag_from_f32(St + (16 * ns + l15) * 128 + ks * 32 + g4 * 8, 1.f), bq);
#pragma unroll
      for (int j = 0; j < 4; ++j) ys[ns][j] += a[j] + __expf(ci[j]) * bq[j];
    }
  }
  bf16_t* Y = (bf16_t*)(p.ws + OFF_HY); float* SSQ = (float*)(p.ws + OFF_SSQ);
  const float dsk = p.ssd_d[l * 4 + h];
#pragma unroll
  for (int j = 0; j < 4; ++j) {
    const int i = 16 * w + 4 * g4 + j, row = row0 + i; float ss = 0.f;
#pragma unroll
    for (int ns = 0; ns < 4; ++ns) {
      const int pp = 16 * ns + l15;
      const float xv = bf2f(Xt[pp * 72 + i]);
      const float z = bf2f(P[(size_t)row * PINP + C_Z + h * 64 + pp]);
      const float g = (ys[ns][j] + dsk * xv) * silu_f(z);
      ss += g * g; Y[(size_t)row * 1024 + 512 + h * 64 + pp] = f2bf(g);
    }
    ss = red16_sum(ss);
    if (l15 == 0) SSQ[(size_t)h * NROW + row] = ss;
  }
  __syncthreads();
}

struct S5Par { float are, aim, bre[16], bim[16]; };
DI void s5_params(const Params& p, int l, int dir, int g, int n, S5Par& q, float& dtv, float& lre, float& lim) {
  const int ai = ((l * 2 + dir) * 16 + g) * 64 + n;
  lre = fminf(p.s5_a_re[ai], -1e-4f); lim = p.s5_a_im[ai];
  dtv = __expf(p.s5_log_dt[(l * 2 + dir) * 16 + g]);
  const float mag = __expf(lre * dtv), ang = lim * dtv;
  q.are = mag * cosf(ang); q.aim = mag * sinf(ang);
  const float den = lre * lre + lim * lim;
  const float fre = ((q.are - 1.f) * lre + q.aim * lim) / den, fim = (q.aim * lre - (q.are - 1.f) * lim) / den;
  const float* br = p.s5_b_re + ((size_t)(l * 16 + g) * 64 + n) * 16; const float* bi = p.s5_b_im + ((size_t)(l * 16 + g) * 64 + n) * 16;
#pragma unroll
  for (int j = 0; j < 16; ++j) { q.bre[j] = fre * br[j] - fim * bi[j]; q.bim[j] = fre * bi[j] + fim * br[j]; }
}
DI void s5_step(const S5Par& q, const bf16_t* us, int s, float& xr, float& xi) {
  const u32x4 a0 = *(const u32x4*)(us + s * 16), a1 = *(const u32x4*)(us + s * 16 + 8);
  const unsigned uw[8] = {a0.x, a0.y, a0.z, a0.w, a1.x, a1.y, a1.z, a1.w};
  float br = 0.f, bi = 0.f;
#pragma unroll
  for (int j = 0; j < 8; ++j) { const float a = bflo(uw[j]), c = bfhi(uw[j]); br += q.bre[2 * j] * a + q.bre[2 * j + 1] * c; bi += q.bim[2 * j] * a + q.bim[2 * j + 1] * c; }
  const float nr = q.are * xr - q.aim * xi + br, ni = q.are * xi + q.aim * xr + bi;
  xr = nr; xi = ni;
}
DI void s5_p1(const Params& p, int l, int item, char* smem) {
  const int lane = ltid() & 63, wi = item * 4 + __builtin_amdgcn_readfirstlane(ltid() >> 6);
  const int tcg = wi % NCH; int r = wi / NCH; const int dir = r & 1; r >>= 1; const int g = r & 15, b = r >> 4;
  int part, tc, row0; chunk_geom(tcg, b, part, tc, row0);
  const int c = chain_slot(dir, part, tc);
  S5Par q; float dtv, lre, lim; s5_params(p, l, dir, g, lane, q, dtv, lre, lim);
  const bf16_t* up = (const bf16_t*)(p.ws + OFF_P) + (size_t)(row0 + lane) * PINP + C_S5 + g * 16;
  bf16_t* us = (bf16_t*)smem + __builtin_amdgcn_readfirstlane(ltid() >> 6) * 1024;
  *(u32x4*)(us + lane * 16) = *(const u32x4*)up; *(u32x4*)(us + lane * 16 + 8) = *(const u32x4*)(up + 8);
  float xr = 0.f, xi = 0.f;
  for (int st = 0; st < 64; ++st) { const int s = dir ? 63 - st : st; s5_step(q, us, s, xr, xi); }
  float* S = (float*)(p.ws + OFF_S5S) + ((size_t)((b * 16 + g) * 2 + dir) * NCH + c) * 128;
  S[lane] = xr; S[64 + lane] = xi;
}
DI void s5_p2(const Params& p, int l, int item) {
  const int gi = item * 256 + ltid(), n = gi & 63, dir = (gi >> 6) & 1, g = (gi >> 7) & 15, b = gi >> 11;
  const int ai = ((l * 2 + dir) * 16 + g) * 64 + n;
  const float lre = fminf(p.s5_a_re[ai], -1e-4f), lim = p.s5_a_im[ai], dtv = __expf(p.s5_log_dt[(l * 2 + dir) * 16 + g]);
  const float mag = __expf(64.f * lre * dtv), ang = 64.f * (lim * dtv);
  const float ar = mag * cosf(ang), aim = mag * sinf(ang);
  float* S = (float*)(p.ws + OFF_S5S) + (size_t)((b * 16 + g) * 2 + dir) * NCH * 128 + n;
  float xr = 0.f, xi = 0.f;
  for (int c0 = 0; c0 < NCH; c0 += 12) {
    float dr[12], di[12];
#pragma unroll
    for (int i = 0; i < 12; ++i) { dr[i] = S[(c0 + i) * 128]; di[i] = S[(c0 + i) * 128 + 64]; }
#pragma unroll
    for (int i = 0; i < 12; ++i) { S[(c0 + i) * 128] = xr; S[(c0 + i) * 128 + 64] = xi; const float nr = ar * xr - aim * xi + dr[i], ni = ar * xi + aim * xr + di[i]; xr = nr; xi = ni; }
  }
}
DI void s5_p3(const Params& p, int l, int item, char* smem) {
  const int tid = ltid(), lane = tid & 63, w = __builtin_amdgcn_readfirstlane(tid >> 6), l15 = lane & 15, g4 = lane >> 4;
  const int tcg = item % NCH, b = item / NCH;
  int part, tc, row0; chunk_geom(tcg, b, part, tc, row0);
  bf16_t* xs = (bf16_t*)smem + w * (16 * 136);
  bf16_t* yg = (bf16_t*)smem + 4 * 16 * 136;
  const bf16_t* P = (const bf16_t*)(p.ws + OFF_P);
#pragma unroll 1
  for (int gi = 0; gi < 4; ++gi) {
    const int g = w + 4 * gi;
    const bf16_t* up = P + (size_t)(row0 + lane) * PINP + C_S5 + g * 16;
    bf16_t* us = (bf16_t*)smem + 25600 + w * 1024;
    *(u32x4*)(us + lane * 16) = *(const u32x4*)up; *(u32x4*)(us + lane * 16 + 8) = *(const u32x4*)(up + 8);
    f32x4 yt[4];
#pragma unroll
    for (int ib = 0; ib < 4; ++ib) yt[ib] = (f32x4){0.f, 0.f, 0.f, 0.f};
#pragma unroll
    for (int dir = 0; dir < 2; ++dir) {
      S5Par q; float dtv, lre, lim; s5_params(p, l, dir, g, lane, q, dtv, lre, lim);
      const int c = chain_slot(dir, part, tc);
      const float* S = (const float*)(p.ws + OFF_S5S) + ((size_t)((b * 16 + g) * 2 + dir) * NCH + c) * 128;
      float xr = S[lane], xi = S[64 + lane];
      bf16x8 cf[4];
#pragma unroll
      for (int ks = 0; ks < 4; ++ks) {
        const int k = ks * 32 + g4 * 8;
        const float* src = (k < 64 ? p.s5_c_re : p.s5_c_im) + ((size_t)(l * 16 + g) * 16 + l15) * 64 + (k & 63);
        cf[ks] = frag_from_f32(src, k < 64 ? 1.f : -1.f);
      }
#pragma unroll
      for (int blk = 0; blk < 4; ++blk) {
        asm volatile("s_waitcnt lgkmcnt(0)" ::: "memory");
#pragma unroll 4
        for (int st = 0; st < 16; ++st) {
          const int step = blk * 16 + st, s = dir ? 63 - step : step;
          s5_step(q, us, s, xr, xi);
          xs[(s & 15) * 136 + lane] = f2bf(xr); xs[(s & 15) * 136 + 64 + lane] = f2bf(xi);
        }
        asm volatile("s_waitcnt lgkmcnt(0)" ::: "memory");
        f32x4 a = {0.f, 0.f, 0.f, 0.f};
#pragma unroll
        for (int ks = 0; ks < 4; ++ks) a = MFMA16(ld_frag(xs + l15 * 136 + ks * 32 + g4 * 8), cf[ks], a);
        const int ib = dir ? 3 - blk : blk;
        yt[ib] += a;
      }
    }
#pragma unroll
    for (int ib = 0; ib < 4; ++ib)
#pragma unroll
      for (int j = 0; j < 4; ++j) {
        const int tok = 16 * ib + 4 * g4 + j, ch = g * 16 + l15;
        const float u = bf2f(P[(size_t)(row0 + tok) * PINP + C_S5 + ch]);
        yg[tok * 264 + ch] = f2bf(gelu_tanh_f(yt[ib][j] + p.s5_d[l * 256 + ch] * u));
      }
  }
  __syncthreads();
  const bf16_t* Wg = (const bf16_t*)(p.ws + OFF_WGLU) + (size_t)l * 256 * 256;
  bf16_t* Y = (bf16_t*)(p.ws + OFF_HY);
#pragma unroll 1
  for (int ns = 0; ns < 4; ++ns) {
    f32x4 acc[4];
#pragma unroll
    for (int ms = 0; ms < 4; ++ms) acc[ms] = (f32x4){0.f, 0.f, 0.f, 0.f};
#pragma unroll
    for (int ks = 0; ks < 8; ++ks) {
      const bf16x8 wf = ld_frag(Wg + (size_t)(64 * w + 16 * ns + l15) * 256 + ks * 32 + g4 * 8);
#pragma unroll
      for (int ms = 0; ms < 4; ++ms) acc[ms] = MFMA16(wf, ld_frag(yg + (16 * ms + l15) * 264 + ks * 32 + g4 * 8), acc[ms]);
    }
#pragma unroll
    for (int ms = 0; ms < 4; ++ms) {
      const int tok = 16 * ms + l15, n0 = 64 * w + 16 * ns + 4 * g4;
      const u32x2 yv = *(const u32x2*)(yg + tok * 264 + n0);
      f32x4 o; o[0] = bflo(yv.x) * sigm_f(acc[ms][0]); o[1] = bfhi(yv.x) * sigm_f(acc[ms][1]); o[2] = bflo(yv.y) * sigm_f(acc[ms][2]); o[3] = bfhi(yv.y) * sigm_f(acc[ms][3]);
      store_bf4(Y + (size_t)(row0 + tok) * 1024 + 768 + n0, o);
    }
  }
  __syncthreads();
}

DI void outproj_item(const Params& p, int l, int item, char* smem) {
  const int mt = item >> 3, nt = item & 7;
  const float* MOD = (const float*)(p.ws + OFF_MOD);
  gemm_tile<1, 2>((const bf16_t*)(p.ws + OFF_HY), 1024, (const bf16_t*)(p.ws + OFF_WOUT) + (size_t)l * 1024 * 1024, 1024, 1024, mt * 128, nt * 128, smem, (const float*)(p.ws + OFF_SSQ),
               [&](int row, int col, f32x4 v) {
                 const int s = row < NLAT ? row / T : 2;
                 const f32x4 gt = *(const f32x4*)(MOD + (size_t)(l * 3 + s) * 6144 + 2048 + col);
                 float* xp = row < NLAT ? p.xb + (size_t)row * 1024 + col : (float*)(p.ws + OFF_CTX) + (size_t)(row - NLAT) * 1024 + col;
                 *(f32x4*)xp = *(f32x4*)xp + gt * v;
               });
}
DI void ffnup_item(const Params& p, int l, int item, char* smem) {
  const int mt = item / 44, nt = item % 44;
  bf16_t* UG = (bf16_t*)(p.ws + OFF_R);
  bf16_t* Ts = (bf16_t*)smem;
  const int m0 = mt * 128, n0 = nt * 128;
  gemm_tile<0, 0>((const bf16_t*)(p.ws + OFF_HY), 1024, (const bf16_t*)(p.ws + OFF_WUP) + (size_t)l * 5632 * 1024, 1024, 1024, mt * 128, nt * 128, smem, nullptr,
               [&](int row, int col, f32x4 v) { store_bf4(Ts + (row - m0) * 136 + (col - n0), v); });
  __syncthreads();
  { const int tid = ltid();
#pragma unroll
    for (int i = 0; i < 8; ++i) { const int id = tid + 256 * i, r = id >> 4, c = id & 15; *(u32x4*)(UG + (size_t)(m0 + r) * 5632 + n0 + c * 8) = *(const u32x4*)(Ts + r * 136 + c * 8); } }
  __syncthreads();
}
DI void act_item(const Params& p, int l, int item) {
  bf16_t* UG = (bf16_t*)(p.ws + OFF_R);
  const float* cw = p.ffn_conv_w + (size_t)l * 3 * DFF;
  for (int i = 0; i < 11; ++i) {
    const int id = ltid() + 256 * i, r = id / 352, cc = id % 352, row = item * 8 + r, k = cc * 8;
    int t, tl; if (row < NLAT) { t = row % T; tl = T; } else { t = (row - NLAT) % TC; tl = TC; }
    bf16_t* up = UG + (size_t)row * 5632 + k; const bf16_t* gp = up + DFF;
    const u32x4 z = {0u, 0u, 0u, 0u};
    const u32x4 u = *(const u32x4*)up, g0 = *(const u32x4*)gp, gm = t > 0 ? *(const u32x4*)(gp - 5632) : z, gn = t < tl - 1 ? *(const u32x4*)(gp + 5632) : z;
    const float uf[8] = {bflo(u.x), bfhi(u.x), bflo(u.y), bfhi(u.y), bflo(u.z), bfhi(u.z), bflo(u.w), bfhi(u.w)};
    const float a[8] = {bflo(gm.x), bfhi(gm.x), bflo(gm.y), bfhi(gm.y), bflo(gm.z), bfhi(gm.z), bflo(gm.w), bfhi(gm.w)};
    const float m[8] = {bflo(g0.x), bfhi(g0.x), bflo(g0.y), bfhi(g0.y), bflo(g0.z), bfhi(g0.z), bflo(g0.w), bfhi(g0.w)};
    const float n[8] = {bflo(gn.x), bfhi(gn.x), bflo(gn.y), bfhi(gn.y), bflo(gn.z), bfhi(gn.z), bflo(gn.w), bfhi(gn.w)};
    float o[8];
#pragma unroll
    for (int j = 0; j < 8; ++j) o[j] = silu_f(cw[k + j] * a[j] + cw[DFF + k + j] * m[j] + cw[2 * DFF + k + j] * n[j]) * uf[j];
    u32x4 ov; ov.x = pack2(o[0], o[1]); ov.y = pack2(o[2], o[3]); ov.z = pack2(o[4], o[5]); ov.w = pack2(o[6], o[7]);
    *(u32x4*)up = ov;
  }
}
DI void ffndown_item(const Params& p, int l, int item, char* smem) {
  const int mt = item >> 3, nt = item & 7;
  const float* MOD = (const float*)(p.ws + OFF_MOD);
  gemm_tile<0, 2>((const bf16_t*)(p.ws + OFF_R), 5632, (const bf16_t*)(p.ws + OFF_WDN) + (size_t)l * 1024 * 2816, 2816, 2816, mt * 128, nt * 128, smem, nullptr,
               [&](int row, int col, f32x4 v) {
                 const int s = row < NLAT ? row / T : 2;
                 const f32x4 gt = *(const f32x4*)(MOD + (size_t)(l * 3 + s) * 6144 + 5120 + col);
                 float* xp = row < NLAT ? p.xb + (size_t)row * 1024 + col : (float*)(p.ws + OFF_CTX) + (size_t)(row - NLAT) * 1024 + col;
                 *(f32x4*)xp = *(f32x4*)xp + gt * v;
               });
}
DI void final_item(const Params& p, int item) {
  const int lane = ltid() & 63, w = __builtin_amdgcn_readfirstlane(ltid() >> 6), row = item * 4 + w;
  float* x = p.xb + (size_t)row * 1024;
  float4 v[4]; float ss = 0.f;
#pragma unroll
  for (int i = 0; i < 4; ++i) { v[i] = *(const float4*)(x + (i * 64 + lane) * 4); ss += v[i].x * v[i].x + v[i].y * v[i].y + v[i].z * v[i].z + v[i].w * v[i].w; }
  ss = wave_sum(ss);
  const float rstd = rsqrtf(ss * (1.f / 1024.f) + 1e-6f);
#pragma unroll
  for (int i = 0; i < 4; ++i) {
    const int k = (i * 64 + lane) * 4; const float4 g = *(const float4*)(p.final_norm + k);
    float4 o; o.x = v[i].x * rstd * g.x; o.y = v[i].y * rstd * g.y; o.z = v[i].z * rstd * g.z; o.w = v[i].w * rstd * g.w;
    *(float4*)(x + k) = o;
  }
}

constexpr int PPL = 12;
constexpr int N_PHASES = 2 + NL * PPL;
#define FOR_ITEMS(n) for (int it = blockIdx.x; it < (n); it += gridDim.x)

DI void run_phase(const Params& p, int ph, char* smem) {
  if (ph == 0) { FOR_ITEMS(P0_ITEMS) p0_item(p, it, smem); return; }
  if (ph == N_PHASES - 1) { FOR_ITEMS(NLAT / 4) final_item(p, it); return; }
  const int l = (ph - 1) / PPL, k = (ph - 1) % PPL;
  const int mtiles = (l == NL - 1) ? 128 : 132;
  switch (k) {
    case 0: FOR_ITEMS(NROW / 4) norm_item(p, l, 0, it); break;
    case 1: FOR_ITEMS(132 * 22) gemm_in_item(p, l, it, smem); break;
    case 2: FOR_ITEMS(2112) s5_p1(p, l, it, smem); break;
    case 3: {
      constexpr int n0 = 2112, n1 = n0 + 2112, n2 = n1 + 528, n3 = n2 + 396, n5 = n3 + 66;
      FOR_ITEMS(n5) {
        if (it < n0) ssd_p1(p, l, it, smem);
        else if (it < n1) mlstm_p1(p, l, it - n0, smem);
        else if (it < n2) kvproj_item(p, l, it - n1, smem);
        else if (it < n3) qproj_item(p, l, it - n2, smem);
        else ropek_item(p, it - n3);
      }
    } break;
    case 4: {
      constexpr int n0 = 512, n1 = n0 + 260, n2 = n1 + 16;
      FOR_ITEMS(n2) { if (it < n0) ssd_p2(p, it); else if (it < n1) mlstm_p2(p, it - n0); else s5_p2(p, l, it - n1); }
    } break;
    case 5: FOR_ITEMS(264) s5_p3(p, l, it, smem); break;
    case 6: {
      constexpr int n0 = 528, n2 = n0 + 1056, n3 = n2 + 1056;
      const bool late = blockIdx.x >= (gridDim.x >> 1);
      if (!late) { FOR_ITEMS(n0) attn_item(p, it, smem); }
      FOR_ITEMS(n3) {
        if (it < n0) continue;
        if (it < n2) ssd_p3(p, l, it - n0, smem);
        else mlstm_p3(p, l, it - n2, smem);
      }
      if (late) { FOR_ITEMS(n0) attn_item(p, it, smem); }
    } break;
    case 7: FOR_ITEMS(mtiles * 8) outproj_item(p, l, it, smem); break;
    case 8: FOR_ITEMS(mtiles * 32) norm_item(p, l, 1, it); break;
    case 9: FOR_ITEMS(mtiles * 44) ffnup_item(p, l, it, smem); break;
    case 10: FOR_ITEMS(mtiles * 16) act_item(p, l, it); break;
    case 11: FOR_ITEMS(mtiles * 8) ffndown_item(p, l, it, smem); break;
  }
}

#ifndef HASH_LO
#define HASH_LO OFF_MOD
#define HASH_HI WS_NEED
#endif
#ifndef PROBE_N
#define PROBE_N 0
#endif
DI void hash_dump(const Params& p) {
  const size_t NOUT = (size_t)NLAT * 1024, nw = (HASH_HI - HASH_LO) / 4;
  const unsigned* wsw = (const unsigned*)(p.ws + HASH_LO);
  for (size_t i = (size_t)blockIdx.x * 256 + threadIdx.x; i < NOUT; i += (size_t)gridDim.x * 256) {
    unsigned h = 12345u;
    for (size_t j = i; j < nw; j += NOUT) h = h * 1664525u + wsw[j];
    p.xb[i] = (float)(h & 0xFFFFFFu);
  }
}

#define XB_TMO      128
#define XB_XCNT(j)  (256  + 64 * (j))
#define XB_XSUB(j)  (1280 + 64 * (j))
#define XB_XGEN(j)  (2304 + 64 * (j))
#define XB_TOP      3328
#define XB_TOPGEN   3392
#define XCD_BAR_WORDS 3456
#define XB_SPIN_CAP (1u << 22)
#define LAS __attribute__((address_space(3)))
DI unsigned xb_ld(unsigned* p) { return __hip_atomic_load(p, __ATOMIC_RELAXED, __HIP_MEMORY_SCOPE_AGENT); }
DI unsigned xb_add(unsigned* p, unsigned v) { return __hip_atomic_fetch_add(p, v, __ATOMIC_RELAXED, __HIP_MEMORY_SCOPE_AGENT); }
DI unsigned xb_xcc_id() { return (unsigned)__builtin_amdgcn_s_getreg((3 << 11) | 20) & 0xFu; }
#define XB_SPIN(cond, bar) do { unsigned _sp = 0; while (cond) { __builtin_amdgcn_s_sleep(1); \
    if ((++_sp & 255u) == 0u) { if (xb_ld(&(bar)[XB_TMO])) break; if (_sp > XB_SPIN_CAP) { atomicAdd(&(bar)[XB_TMO], 1u); break; } } } } while (0)
struct XcdBarrier { unsigned* bar; unsigned x; volatile LAS unsigned* st; };
DI XcdBarrier xcd_barrier_post(unsigned* bar, volatile LAS unsigned* st) {
  XcdBarrier b; b.bar = bar; b.x = xb_xcc_id(); b.st = st;
  if (threadIdx.x == 0) (void)xb_add(&bar[XB_XCNT(b.x)], 1u);
  return b;
}
DI void xcd_barrier_complete(unsigned* bar, unsigned x, unsigned& nloc, unsigned& nx) {
  const unsigned G = gridDim.x;
  unsigned sum, cnt, mine, sp = 0u;
  for (;;) {
    sum = 0u; cnt = 0u; mine = 0u;
#pragma unroll
    for (unsigned j = 0; j < 16; ++j) { const unsigned c = xb_ld(&bar[XB_XCNT(j)]); sum += c; cnt += (c > 0u) ? 1u : 0u; mine = (j == x) ? c : mine; }
    if (sum == G) break;
    __builtin_amdgcn_s_sleep(1);
    if ((++sp & 255u) == 0u) { if (xb_ld(&bar[XB_TMO])) break; if (sp > XB_SPIN_CAP) { atomicAdd(&bar[XB_TMO], 1u); break; } }
  }
  nloc = mine > 0u ? mine : 1u; nx = cnt > 0u ? cnt : 1u;
}
DI void xcd_barrier(const XcdBarrier& b) {
  asm volatile("s_waitcnt vmcnt(0)" ::: "memory");
  __syncthreads();
  if (threadIdx.x == 0) {
    unsigned* bar = b.bar;
    __builtin_amdgcn_s_waitcnt(0);
    unsigned nloc = b.st[0], nx = b.st[1];
    if (nloc == 0u) { xcd_barrier_complete(bar, b.x, nloc, nx); b.st[0] = nloc; b.st[1] = nx; }
    const unsigned old = xb_add(&bar[XB_XSUB(b.x)], 1u);
    const unsigned gen = old / nloc;
    if (old + 1u == (gen + 1u) * nloc) {
      __builtin_amdgcn_fence(__ATOMIC_RELEASE, "agent");
      asm volatile("s_waitcnt vmcnt(0)" ::: "memory");
      const unsigned og = xb_add(&bar[XB_TOP], 1u);
      const unsigned tg = og / nx;
      if (og + 1u == (tg + 1u) * nx) xb_add(&bar[XB_TOPGEN], 1u);
      else XB_SPIN(xb_ld(&bar[XB_TOPGEN]) == tg, bar);
      __builtin_amdgcn_fence(__ATOMIC_ACQUIRE, "agent");
      xb_add(&bar[XB_XGEN(b.x)], 1u);
      asm volatile("s_waitcnt vmcnt(0)" ::: "memory");
    } else {
      XB_SPIN(xb_ld(&bar[XB_XGEN(b.x)]) == gen, bar);
      __builtin_amdgcn_fence(__ATOMIC_ACQUIRE, "agent");
      asm volatile("s_waitcnt vmcnt(0)" ::: "memory");
    }
  }
  __syncthreads();
}
constexpr size_t OFF_BAR = ((WS_NEED + 255) / 256) * 256;
constexpr int SMEM_BYTES = 59392;
__global__ void __launch_bounds__(256, 2) trunk_fwd(Params p) {
  __shared__ __attribute__((aligned(16))) char smem[SMEM_BYTES];
  __shared__ uint4 xb_words;
  cg::grid_group grid = cg::this_grid();
  if (threadIdx.x == 0) xb_words = make_uint4(0u, 0u, 0u, 0u);
  __syncthreads();
  XcdBarrier xb = xcd_barrier_post((unsigned*)(p.ws + OFF_BAR), (volatile LAS unsigned*)&xb_words);
  for (int ph = p.ph_lo; ph < p.ph_hi; ++ph) {
    run_phase(p, ph, smem);
    if (ph + 1 < p.ph_hi) { if (ph == p.ph_lo) grid.sync(); else xcd_barrier(xb); }
  }
}

__global__ void __launch_bounds__(256) hash_kernel(Params p) { hash_dump(p); }

extern "C" void kernel_launch(void* const* d_in, const int* in_sizes, int n_in, void* d_out, int out_size, void* d_ws, size_t ws_size, hipStream_t stream) {
  static int grid_blocks = 0;
  if (!grid_blocks) {
    int dev = 0, cus = 0, per_cu = 0;
    hipGetDevice(&dev);
    hipDeviceGetAttribute(&cus, hipDeviceAttributeMultiprocessorCount, dev);
    hipOccupancyMaxActiveBlocksPerMultiprocessor(&per_cu, trunk_fwd, 256, 0);
    if (per_cu > 2) per_cu = 2;
    grid_blocks = cus * per_cu;
  }
  if (ws_size < OFF_BAR + XCD_BAR_WORDS * 4) { fprintf(stderr, "workspace too small: %zu < %zu\n", ws_size, (size_t)WS_NEED); return; }
  Params p{};
  const float** fp = (const float**)&p;
  for (int i = 0; i < 35; ++i) fp[i] = (const float*)d_in[i];
  p.xb = (float*)d_out; p.ws = (char*)d_ws;
#if MULTI_LAUNCH
#if PROBE_N
  for (int ph = 0; ph < PROBE_N; ++ph) { p.ph_lo = ph; p.ph_hi = ph + 1; hipLaunchKernelGGL(trunk_fwd, dim3(grid_blocks), dim3(256), 0, stream, p); }
  hipLaunchKernelGGL(hash_kernel, dim3(grid_blocks), dim3(256), 0, stream, p);
#else
  for (int ph = 0; ph < N_PHASES; ++ph) { p.ph_lo = ph; p.ph_hi = ph + 1; hipLaunchKernelGGL(trunk_fwd, dim3(grid_blocks), dim3(256), 0, stream, p); }
#endif
#else
  p.ph_lo = 0; p.ph_hi = N_PHASES;
  hipMemsetAsync((char*)d_ws + OFF_BAR, 0, XCD_BAR_WORDS * 4, stream);
  void* args[] = {&p};
  hipError_t e = hipLaunchCooperativeKernel((void*)trunk_fwd, dim3(grid_blocks), dim3(256), args, 0, stream);
  if (e != hipSuccess) fprintf(stderr, "cooperative launch failed: %s (grid %d)\n", hipGetErrorString(e), grid_blocks);
#endif
}
```

```cpp
#include <hip/hip_runtime.h>
#include <hip/hip_cooperative_groups.h>
#include <cstdio>
#include <cstdint>
namespace cg = cooperative_groups;

#ifndef PROBE_MASK
#define PROBE_MASK 63
#endif
#ifndef ZERO_FILL
#define ZERO_FILL 0
#endif
#ifndef MULTI_LAUNCH
#define MULTI_LAUNCH 0
#endif

typedef unsigned short bf16_t;
typedef short bf16x8 __attribute__((ext_vector_type(8)));
typedef float f32x4 __attribute__((ext_vector_type(4)));
typedef unsigned u32x4 __attribute__((ext_vector_type(4)));
typedef unsigned u32x2 __attribute__((ext_vector_type(2)));
#define DI __device__ __forceinline__
#define MFMA16(a, b, c) __builtin_amdgcn_mfma_f32_16x16x32_bf16((a), (b), (c), 0, 0, 0)

constexpr int NB = 2, T = 8192, TC = 256, NL = 4;
constexpr int NLAT = NB * T, NROW = NLAT + NB * TC;
constexpr int TALL = T + TC;
constexpr int PINP = 2816;
constexpr int C_MLQ = 0, C_MLK = 256, C_MLV = 512, C_MLO = 768, C_CQ = 1040, C_CKV = 1296, C_KR = 1424,
              C_Z = 1456, C_XBC = 1712, C_S5 = 2488;
constexpr int NCH = 132;
constexpr int DFF = 2816;

constexpr size_t SZ_WIN = (size_t)NL * 2816 * 1024 * 2, SZ_WUQ = (size_t)NL * 384 * 256 * 2, SZ_WUKV = (size_t)NL * 512 * 128 * 2,
                 SZ_WGLU = (size_t)NL * 256 * 256 * 2, SZ_WOUT = (size_t)NL * 1024 * 1024 * 2, SZ_WUP = (size_t)NL * 5632 * 1024 * 2,
                 SZ_WDN = (size_t)NL * 1024 * 2816 * 2, SZ_MOD = (size_t)NL * 3 * 6144 * 4, SZ_CTX = (size_t)512 * 1024 * 4,
                 SZ_HY = (size_t)NROW * 1024 * 2, SZ_GML = (size_t)NROW * 16 * 4, SZ_DTR = (size_t)NROW * 8 * 4, SZ_SSQ = (size_t)NROW * 4 * 4,
                 SZ_QRAW = (size_t)NROW * 384 * 2, SZ_KH = (size_t)NB * 4 * TALL * 64 * 2 + (size_t)NB * TALL * 32 * 2, SZ_VT = (size_t)NB * 4 * 64 * TALL * 2,
                 SZ_S5S = (size_t)NB * 16 * 2 * NCH * 128 * 4, SZ_MLM = (size_t)16 * NCH * 32 * 4, SZ_SSA = (size_t)16 * NCH * 32 * 4,
                 SZ_P = (size_t)NROW * PINP * 2, SZ_MLS = (size_t)16 * NCH * 4160 * 4, SZ_SSDS = (size_t)16 * NCH * 8192 * 4;
constexpr size_t OFF_WIN = 0, OFF_WUQ = OFF_WIN + SZ_WIN, OFF_WUKV = OFF_WUQ + SZ_WUQ, OFF_WGLU = OFF_WUKV + SZ_WUKV,
                 OFF_WOUT = OFF_WGLU + SZ_WGLU, OFF_WUP = OFF_WOUT + SZ_WOUT, OFF_WDN = OFF_WUP + SZ_WUP, OFF_MOD = OFF_WDN + SZ_WDN,
                 OFF_CTX = OFF_MOD + SZ_MOD, OFF_HY = OFF_CTX + SZ_CTX, OFF_GML = OFF_HY + SZ_HY, OFF_DTR = OFF_GML + SZ_GML,
                 OFF_SSQ = OFF_DTR + SZ_DTR, OFF_QRAW = OFF_SSQ + SZ_SSQ, OFF_KH = OFF_QRAW + SZ_QRAW, OFF_VT = OFF_KH + SZ_KH,
                 OFF_S5S = OFF_VT + SZ_VT, OFF_MLM = OFF_S5S + SZ_S5S, OFF_SSA = OFF_MLM + SZ_MLM,
                 OFF_R = ((OFF_SSA + SZ_SSA + 255) / 256) * 256, OFF_P = OFF_R, OFF_MLS = OFF_P + SZ_P, OFF_SSDS = OFF_MLS + SZ_MLS,
                 WS_NEED = OFF_SSDS + SZ_SSDS;
static_assert((size_t)NROW * 5632 * 2 <= SZ_P + SZ_MLS + SZ_SSDS, "UG overlay");

constexpr size_t OFF_KR = OFF_KH + (size_t)NB * 4 * TALL * 64 * 2;
constexpr size_t OFF_YG = ((WS_NEED + 255) / 256) * 256;
constexpr size_t OFF_BAR = OFF_YG + (size_t)NROW * 256 * 2;
struct Params {
  const float *x, *c, *ctx, *c_ctx, *w_mod, *b_mod, *norm1, *norm2, *w_in, *ml_gate_bias, *ml_norm, *mla_q_norm, *mla_kv_norm,
      *mla_w_uq, *mla_w_ukv, *ssd_conv_w, *ssd_conv_b, *ssd_a_log, *ssd_dt_bias, *ssd_d, *ssd_norm, *s5_a_re, *s5_a_im, *s5_log_dt,
      *s5_b_re, *s5_b_im, *s5_c_re, *s5_c_im, *s5_d, *s5_w_glu, *w_out, *ffn_w_up, *ffn_conv_w, *ffn_w_down, *final_norm;
  float* xb;
  char* ws;
  int ph_lo, ph_hi;
};

typedef __bf16 hbf16x2 __attribute__((ext_vector_type(2)));
typedef float f32x2 __attribute__((ext_vector_type(2)));
DI bf16_t f2bf(float x) { return __builtin_bit_cast(bf16_t, (__bf16)x); }
DI float bf2f(bf16_t v) { return __uint_as_float(((unsigned)v) << 16); }
DI unsigned pack2(float lo, float hi) { f32x2 v = {lo, hi}; return __builtin_bit_cast(unsigned, __builtin_convertvector(v, hbf16x2)); }
DI float bflo(unsigned w) { return __uint_as_float(w << 16); }
DI float bfhi(unsigned w) { return __uint_as_float(w & 0xffff0000u); }
DI float silu_f(float x) { return x / (1.f + __expf(-x)); }
DI float sigm_f(float x) { return 1.f / (1.f + __expf(-x)); }
DI float softplus_f(float x) { return fmaxf(x, 0.f) + log1pf(__expf(-fabsf(x))); }
DI float logsigm_f(float x) { return fminf(x, 0.f) - log1pf(__expf(-fabsf(x))); }
DI float gelu_tanh_f(float x) { float u = 0.7978845608f * (x + 0.044715f * x * x * x); return x * sigm_f(2.f * u); }
DI float wave_sum(float v) { for (int o = 32; o; o >>= 1) v += __shfl_xor(v, o); return v; }
DI float wave_max(float v) { for (int o = 32; o; o >>= 1) v = fmaxf(v, __shfl_xor(v, o)); return v; }
DI float wave_incl_scan(float v, int lane) { for (int o = 1; o < 64; o <<= 1) { float t = __shfl_up(v, o); if (lane >= o) v += t; } return v; }
DI float red16_max(float v) { v = fmaxf(v, __shfl_xor(v, 1)); v = fmaxf(v, __shfl_xor(v, 2)); v = fmaxf(v, __shfl_xor(v, 4)); v = fmaxf(v, __shfl_xor(v, 8)); return v; }
DI float red16_sum(float v) { v += __shfl_xor(v, 1); v += __shfl_xor(v, 2); v += __shfl_xor(v, 4); v += __shfl_xor(v, 8); return v; }
DI bf16x8 ld_frag(const bf16_t* p) { return *(const bf16x8*)p; }
DI bf16x8 mk_frag(unsigned a, unsigned b, unsigned c, unsigned d) { u32x4 u = {a, b, c, d}; return __builtin_bit_cast(bf16x8, u); }
DI bf16x8 frag_from_f32(const float* p, float sgn) {
  float4 a = *(const float4*)p, b = *(const float4*)(p + 4);
  return mk_frag(pack2(a.x * sgn, a.y * sgn), pack2(a.z * sgn, a.w * sgn), pack2(b.x * sgn, b.y * sgn), pack2(b.z * sgn, b.w * sgn));
}
DI int ltid() { int t = threadIdx.x; asm volatile("" : "+v"(t)); return t; }
DI int row_of(int b, int part, int t) { return part ? NLAT + b * TC + t : b * T + t; }

DI void tr_tile(const float* __restrict__ src, int K, int N, bf16_t* __restrict__ dst, const float* gain, int glo, int ghi, int tk, int tn, float* tile) {
  const int tid = ltid(), c4 = tid & 15, rq = tid >> 4;
  const bool vec = (N & 3) == 0;
#pragma unroll
  for (int rr = 0; rr < 4; ++rr) {
    const int r = rr * 16 + rq, k = tk * 64 + r, n = tn * 64 + c4 * 4;
    float4 v;
    if (vec && n + 3 < N) v = *(const float4*)(src + (size_t)k * N + n);
    else { v.x = n < N ? src[(size_t)k * N + n] : 0.f; v.y = n + 1 < N ? src[(size_t)k * N + n + 1] : 0.f; v.z = n + 2 < N ? src[(size_t)k * N + n + 2] : 0.f; v.w = n + 3 < N ? src[(size_t)k * N + n + 3] : 0.f; }
    if (gain && k >= glo && k < ghi) { const float g = gain[k - glo]; v.x *= g; v.y *= g; v.z *= g; v.w *= g; }
    *(float4*)(tile + r * 68 + c4 * 4) = v;
  }
  __syncthreads();
#pragma unroll
  for (int q = 0; q < 2; ++q) {
    const int id = tid + 256 * q, n = id >> 3, k0 = (id & 7) * 8;
    u32x4 o;
    o.x = pack2(tile[(k0 + 0) * 68 + n], tile[(k0 + 1) * 68 + n]); o.y = pack2(tile[(k0 + 2) * 68 + n], tile[(k0 + 3) * 68 + n]);
    o.z = pack2(tile[(k0 + 4) * 68 + n], tile[(k0 + 5) * 68 + n]); o.w = pack2(tile[(k0 + 6) * 68 + n], tile[(k0 + 7) * 68 + n]);
    *(u32x4*)(dst + (size_t)(tn * 64 + n) * K + tk * 64 + k0) = o;
  }
  __syncthreads();
}

constexpr int TR_PER_LAYER = 3128, P0_TR = NL * TR_PER_LAYER, P0_MOD = NL * 96, P0_CPX = NLAT * 1024 / 4096, P0_CPC = 512 * 1024 / 4096;
constexpr int P0_ZERO = (int)((WS_NEED - OFF_HY + 65535) / 65536);
constexpr int P0_ITEMS = P0_TR + P0_MOD + P0_CPX + P0_CPC + (ZERO_FILL ? P0_ZERO : 0);

DI void p0_item(const Params& p, int item, char* smem) {
  const int tid = ltid();
  if (item < P0_MOD) {
    const int l = item / 96, cb = item % 96, cl = tid & 63, kq = tid >> 6;
    float* sv = (float*)smem;
    float* red = sv + 3072;
    for (int i = tid; i < 1024; i += 256) { sv[i] = silu_f(p.c[i]); sv[1024 + i] = silu_f(p.c[1024 + i]); sv[2048 + i] = silu_f(p.c_ctx[i]); }
    __syncthreads();
    const int col = cb * 64 + cl; const float* W = p.w_mod + (size_t)l * 1024 * 6144 + col;
    float a0 = 0.f, a1 = 0.f, a2 = 0.f;
#pragma unroll 16
    for (int k = kq * 256; k < kq * 256 + 256; ++k) { const float w = W[(size_t)k * 6144]; a0 += sv[k] * w; a1 += sv[1024 + k] * w; a2 += sv[2048 + k] * w; }
    red[(kq * 3 + 0) * 64 + cl] = a0; red[(kq * 3 + 1) * 64 + cl] = a1; red[(kq * 3 + 2) * 64 + cl] = a2;
    __syncthreads();
    if (tid < 192) {
      const int s = tid >> 6; const float bm = p.b_mod[l * 6144 + col];
      const float v = red[(0 * 3 + s) * 64 + cl] + red[(1 * 3 + s) * 64 + cl] + red[(2 * 3 + s) * 64 + cl] + red[(3 * 3 + s) * 64 + cl] + bm;
      ((float*)(p.ws + OFF_MOD))[(size_t)(l * 3 + s) * 6144 + col] = v;
    }
    __syncthreads();
    return;
  }
  item -= P0_MOD;
  if (item < P0_TR) {
    const int l = item / TR_PER_LAYER; int t = item % TR_PER_LAYER; float* tile = (float*)smem;
    if (t < 704) { tr_tile(p.w_in + (size_t)l * 1024 * 2744, 1024, 2744, (bf16_t*)(p.ws + OFF_WIN) + (size_t)l * 2816 * 1024, nullptr, 0, 0, t / 44, t % 44, tile); return; }
    t -= 704;
    if (t < 24) { tr_tile(p.mla_w_uq + (size_t)l * 256 * 384, 256, 384, (bf16_t*)(p.ws + OFF_WUQ) + (size_t)l * 384 * 256, p.mla_q_norm + l * 256, 0, 256, t / 6, t % 6, tile); return; }
    t -= 24;
    if (t < 16) { tr_tile(p.mla_w_ukv + (size_t)l * 128 * 512, 128, 512, (bf16_t*)(p.ws + OFF_WUKV) + (size_t)l * 512 * 128, p.mla_kv_norm + l * 128, 0, 128, t / 8, t % 8, tile); return; }
    t -= 16;
    if (t < 16) { tr_tile(p.s5_w_glu + (size_t)l * 256 * 256, 256, 256, (bf16_t*)(p.ws + OFF_WGLU) + (size_t)l * 256 * 256, nullptr, 0, 0, t / 4, t % 4, tile); return; }
    t -= 16;
    if (t < 256) { tr_tile(p.w_out + (size_t)l * 1024 * 1024, 1024, 1024, (bf16_t*)(p.ws + OFF_WOUT) + (size_t)l * 1024 * 1024, p.ssd_norm + l * 256, 512, 768, t / 16, t % 16, tile); return; }
    t -= 256;
    if (t < 1408) { tr_tile(p.ffn_w_up + (size_t)l * 1024 * 5632, 1024, 5632, (bf16_t*)(p.ws + OFF_WUP) + (size_t)l * 5632 * 1024, nullptr, 0, 0, t / 88, t % 88, tile); return; }
    t -= 1408;
    tr_tile(p.ffn_w_down + (size_t)l * 2816 * 1024, 2816, 1024, (bf16_t*)(p.ws + OFF_WDN) + (size_t)l * 1024 * 2816, nullptr, 0, 0, t / 16, t % 16, tile);
    return;
  }
  item -= P0_TR;
  if (item >= P0_CPX + P0_CPC) {
    item -= P0_CPX + P0_CPC;
    char* z = p.ws + OFF_HY + (size_t)item * 65536;
    const size_t lim = WS_NEED - OFF_HY - (size_t)item * 65536;
    for (int i = 0; i < 16; ++i) { const size_t o = (size_t)(i * 256 + tid) * 16; if (o < lim) *(u32x4*)(z + o) = (u32x4){0u, 0u, 0u, 0u}; }
    return;
  }
  const float* src; float* dst;
  if (item < P0_CPX) { src = p.x + (size_t)item * 4096; dst = p.xb + (size_t)item * 4096; }
  else { item -= P0_CPX; src = p.ctx + (size_t)item * 4096; dst = (float*)(p.ws + OFF_CTX) + (size_t)item * 4096; }
  for (int i = 0; i < 4; ++i) { const int o = (i * 256 + tid) * 4; *(float4*)(dst + o) = *(const float4*)(src + o); }
}

DI void norm_item(const Params& p, int l, int which, int item) {
  const int lane = ltid() & 63, w = __builtin_amdgcn_readfirstlane(ltid() >> 6), row = item * 4 + w;
  const float* x = row < NLAT ? p.xb + (size_t)row * 1024 : (const float*)(p.ws + OFF_CTX) + (size_t)(row - NLAT) * 1024;
  float4 v[4]; float ss = 0.f;
#pragma unroll
  for (int i = 0; i < 4; ++i) { v[i] = *(const float4*)(x + (i * 64 + lane) * 4); ss += v[i].x * v[i].x + v[i].y * v[i].y + v[i].z * v[i].z + v[i].w * v[i].w; }
  ss = wave_sum(ss);
  const float rstd = rsqrtf(ss * (1.f / 1024.f) + 1e-6f);
  const int s = row < NLAT ? row / T : 2;
  const float* g = (which ? p.norm2 : p.norm1) + l * 1024;
  const float* md = (const float*)(p.ws + OFF_MOD) + (size_t)(l * 3 + s) * 6144 + (which ? 3072 : 0);
  bf16_t* H = (bf16_t*)(p.ws + OFF_HY) + (size_t)row * 1024;
#pragma unroll
  for (int i = 0; i < 4; ++i) {
    const int k = (i * 64 + lane) * 4;
    const float4 g4 = *(const float4*)(g + k), sh = *(const float4*)(md + k), sc = *(const float4*)(md + 1024 + k);
    u32x2 o; o.x = pack2(v[i].x * rstd * g4.x * (1.f + sc.x) + sh.x, v[i].y * rstd * g4.y * (1.f + sc.y) + sh.y);
    o.y = pack2(v[i].z * rstd * g4.z * (1.f + sc.z) + sh.z, v[i].w * rstd * g4.w * (1.f + sc.w) + sh.w);
    *(u32x2*)(H + k) = o;
  }
}

DI u32x4 scale_bf8(u32x4 q, float s) {
  q.x = pack2(bflo(q.x) * s, bfhi(q.x) * s); q.y = pack2(bflo(q.y) * s, bfhi(q.y) * s);
  q.z = pack2(bflo(q.z) * s, bfhi(q.z) * s); q.w = pack2(bflo(q.w) * s, bfhi(q.w) * s); return q;
}
#define GEMM_STEP(AR, BR, KT)                                                                                         \
  {                                                                                                                   \
    if (AMODE == 1 && (KT) >= 8 && (KT) < 12) {                                                                       \
      _Pragma("unroll") for (int i = 0; i < 4; ++i) AR[i] = scale_bf8(AR[i], rs[i]);                                  \
    }                                                                                                                 \
    _Pragma("unroll") for (int i = 0; i < 4; ++i) { *(u32x4*)(As + (r0 + 32 * i) * 72 + cc * 8) = AR[i]; *(u32x4*)(Bs + (r0 + 32 * i) * 72 + cc * 8) = BR[i]; } \
    __syncthreads();                                                                                                  \
    if ((KT) + 2 < nk) {                                                                                              \
      _Pragma("unroll") for (int i = 0; i < 4; ++i) { AR[i] = *(const u32x4*)(ap + i * astep + ((KT) + 2) * 64); BR[i] = *(const u32x4*)(bp + i * bstep + ((KT) + 2) * 64); } \
    }                                                                                                                 \
    __builtin_amdgcn_sched_barrier(0);                                                                                \
    _Pragma("unroll") for (int ks = 0; ks < 2; ++ks) {                                                                \
      bf16x8 af[4], bfr[4];                                                                                           \
      _Pragma("unroll") for (int i = 0; i < 4; ++i) { af[i] = ld_frag(As + (64 * wm + 16 * i + l15) * 72 + ks * 32 + g4 * 8); bfr[i] = ld_frag(Bs + (64 * wn + 16 * i + l15) * 72 + ks * 32 + g4 * 8); } \
      _Pragma("unroll") for (int i = 0; i < 4; ++i)                                                                   \
        _Pragma("unroll") for (int j = 0; j < 4; ++j) acc[i][j] = MFMA16(bfr[j], af[i], acc[i][j]);                   \
    }                                                                                                                 \
    __syncthreads();                                                                                                  \
  }
template <int AMODE, int STAGE, class Epi>
DI void gemm_tile(const bf16_t* __restrict__ A, int lda, const bf16_t* __restrict__ Bt, int ldb, int K, int m0, int n0, char* smem, const float* ssq, Epi epi) {
  bf16_t* As = (bf16_t*)smem; bf16_t* Bs = As + 128 * 72;
  const int tid = ltid(), lane = tid & 63, w = __builtin_amdgcn_readfirstlane(tid >> 6), wm = w >> 1, wn = w & 1, l15 = lane & 15, g4 = lane >> 4;
  u32x4 ar0[4], br0[4], ar1[4], br1[4]; float rs[4];
  const int r0 = tid >> 3, cc = tid & 7;
  const bf16_t* ap = A + (size_t)(m0 + r0) * lda + cc * 8;
  const bf16_t* bp = Bt + (size_t)(n0 + r0) * ldb + cc * 8;
  const size_t astep = (size_t)32 * lda, bstep = (size_t)32 * ldb;
  if (AMODE == 1) {
#pragma unroll
    for (int i = 0; i < 4; ++i) { const float* q = ssq + (m0 + r0 + 32 * i); rs[i] = rsqrtf((q[0] + q[NROW] + q[2 * NROW] + q[3 * NROW]) * (1.f / 256.f) + 1e-6f); }
  }
  f32x4 acc[4][4];
#pragma unroll
  for (int i = 0; i < 4; ++i)
#pragma unroll
    for (int j = 0; j < 4; ++j) acc[i][j] = (f32x4){0.f, 0.f, 0.f, 0.f};
  const int nk = K >> 6;
#pragma unroll
  for (int i = 0; i < 4; ++i) { ar0[i] = *(const u32x4*)(ap + i * astep); br0[i] = *(const u32x4*)(bp + i * bstep); }
#pragma unroll
  for (int i = 0; i < 4; ++i) { ar1[i] = *(const u32x4*)(ap + i * astep + 64); br1[i] = *(const u32x4*)(bp + i * bstep + 64); }
  for (int kt = 0; kt < nk; kt += 2) {
    GEMM_STEP(ar0, br0, kt)
    GEMM_STEP(ar1, br1, kt + 1)
  }
  if (STAGE == 2) {
    float* Tf = (float*)smem;
#pragma unroll
    for (int h = 0; h < 2; ++h) {
      if (wm == h) {
#pragma unroll
        for (int i = 0; i < 4; ++i)
#pragma unroll
          for (int j = 0; j < 4; ++j) *(f32x4*)(Tf + (16 * i + l15) * 132 + 64 * wn + 16 * j + 4 * g4) = acc[i][j];
      }
      __syncthreads();
#pragma unroll
      for (int q = 0; q < 8; ++q) { const int id = tid + 256 * q, r = id >> 5, c = id & 31; epi(m0 + 64 * h + r, n0 + c * 4, *(const f32x4*)(Tf + r * 132 + c * 4)); }
      __syncthreads();
    }
    return;
  }
#pragma unroll
  for (int i = 0; i < 4; ++i)
#pragma unroll
    for (int j = 0; j < 4; ++j) epi(m0 + 64 * wm + 16 * i + l15, n0 + 64 * wn + 16 * j + 4 * g4, acc[i][j]);
}

DI void store_bf4(bf16_t* dst, f32x4 v) { u32x2 o; o.x = pack2(v[0], v[1]); o.y = pack2(v[2], v[3]); *(u32x2*)dst = o; }

DI void gemm_in_item(const Params& p, int l, int item, char* smem) {
  const int mt = item / 22, nt = item % 22;
  bf16_t* P = (bf16_t*)(p.ws + OFF_P); float* GML = (float*)(p.ws + OFF_GML); float* DTR = (float*)(p.ws + OFF_DTR);
  bf16_t* Ts = (bf16_t*)smem;
  const int m0 = mt * 128, n0 = nt * 128;
  gemm_tile<0, 0>((const bf16_t*)(p.ws + OFF_HY), 1024, (const bf16_t*)(p.ws + OFF_WIN) + (size_t)l * 2816 * 1024, 1024, 1024, mt * 128, nt * 128, smem, nullptr,
               [&](int row, int col, f32x4 v) {
                 store_bf4(Ts + (row - m0) * 136 + (col - n0), v);
                 if (col >= 1024 && col < 1040) *(f32x4*)(GML + (size_t)row * 16 + (col - 1024)) = v;
                 if (col >= 2480 && col < 2488) *(f32x4*)(DTR + (size_t)row * 8 + (col - 2480)) = v;
               });
  __syncthreads();
  { const int tid = ltid();
#pragma unroll
    for (int i = 0; i < 8; ++i) { const int id = tid + 256 * i, r = id >> 4, c = id & 15; *(u32x4*)(P + (size_t)(m0 + r) * PINP + n0 + c * 8) = *(const u32x4*)(Ts + r * 136 + c * 8); } }
  __syncthreads();
}

DI void tile_rstd(const bf16_t* P, int m0, int col0, int ncols, float* rst) {
  const int tid = ltid(), r = tid >> 1, hf = tid & 1, n = ncols >> 1;
  const bf16_t* src = P + (size_t)(m0 + r) * PINP + col0 + hf * n;
  float ss = 0.f;
  for (int c = 0; c < n; c += 8) { const u32x4 q = *(const u32x4*)(src + c);
    ss += bflo(q.x) * bflo(q.x) + bfhi(q.x) * bfhi(q.x) + bflo(q.y) * bflo(q.y) + bfhi(q.y) * bfhi(q.y) + bflo(q.z) * bflo(q.z) + bfhi(q.z) * bfhi(q.z) + bflo(q.w) * bflo(q.w) + bfhi(q.w) * bfhi(q.w); }
  ss += __shfl_xor(ss, 1);
  if (hf == 0) rst[r] = rsqrtf(ss / (float)ncols + 1e-6f);
  __syncthreads();
}
DI void qproj_item(const Params& p, int l, int item, char* smem) {
  const int mt = item / 3, nt = item % 3; const bf16_t* P = (const bf16_t*)(p.ws + OFF_P);
  float* rst = (float*)(smem + 36864);
  tile_rstd(P, mt * 128, C_CQ, 256, rst);
  bf16_t* Q = (bf16_t*)(p.ws + OFF_QRAW);
  gemm_tile<0, 0>(P + C_CQ, PINP, (const bf16_t*)(p.ws + OFF_WUQ) + (size_t)l * 384 * 256, 256, 256, mt * 128, nt * 128, smem, nullptr,
               [&](int row, int col, f32x4 v) { const float r = rst[row - mt * 128]; store_bf4(Q + (size_t)row * 384 + col, v * r); });
  __syncthreads();
}
DI void kvproj_item(const Params& p, int l, int item, char* smem) {
  const int mt = item / 4, nt = item % 4; const bf16_t* P = (const bf16_t*)(p.ws + OFF_P);
  float* rst = (float*)(smem + 36864);
  tile_rstd(P, mt * 128, C_CKV, 128, rst);
  bf16_t* KH = (bf16_t*)(p.ws + OFF_KH); bf16_t* VT = (bf16_t*)(p.ws + OFF_VT);
  gemm_tile<0, 0>(P + C_CKV, PINP, (const bf16_t*)(p.ws + OFF_WUKV) + (size_t)l * 512 * 128, 128, 128, mt * 128, nt * 128, smem, nullptr,
               [&](int row, int col, f32x4 v) {
                 const float r = rst[row - mt * 128]; v = v * r;
                 const int hh = col >> 7, dd = col & 127;
                 int b, tpos; if (row < NLAT) { b = row / T; tpos = row % T; } else { b = (row - NLAT) / TC; tpos = T + (row - NLAT) % TC; }
                 if (dd < 64) store_bf4(KH + ((size_t)(b * 4 + hh) * TALL + tpos) * 64 + dd, v);
                 else {
                   bf16_t* vp = VT + ((size_t)(b * 4 + hh) * 64 + (dd - 64)) * TALL + tpos;
                   vp[0] = f2bf(v[0]); vp[TALL] = f2bf(v[1]); vp[2 * TALL] = f2bf(v[2]); vp[3 * TALL] = f2bf(v[3]);
                 }
               });
  __syncthreads();
}
DI void rope_cs(int t, int i, float& cs, float& sn) {
  const int pos = (i < 8) ? (t >> 6) : (t & 63); const int f = i & 7;
  const float inv = exp2f(-(float)f * (13.287712379549449f / 8.f));
  const float ang = (float)pos * inv;
  cs = cosf(ang); sn = sinf(ang);
}
DI void ropek_item(const Params& p, int item) {
  const int row = item * 256 + ltid();
  const bf16_t* src = (const bf16_t*)(p.ws + OFF_P) + (size_t)row * PINP + C_KR;
  u32x4 q[4];
#pragma unroll
  for (int i = 0; i < 4; ++i) q[i] = *(const u32x4*)(src + i * 8);
  float v[32];
#pragma unroll
  for (int i = 0; i < 4; ++i) { v[i * 8 + 0] = bflo(q[i].x); v[i * 8 + 1] = bfhi(q[i].x); v[i * 8 + 2] = bflo(q[i].y); v[i * 8 + 3] = bfhi(q[i].y);
    v[i * 8 + 4] = bflo(q[i].z); v[i * 8 + 5] = bfhi(q[i].z); v[i * 8 + 6] = bflo(q[i].w); v[i * 8 + 7] = bfhi(q[i].w); }
  int b, tpos;
  if (row < NLAT) {
    b = row / T; tpos = row % T;
#pragma unroll
    for (int i = 0; i < 16; ++i) { float cs, sn; rope_cs(tpos, i, cs, sn); const float x1 = v[i], x2 = v[i + 16]; v[i] = x1 * cs - x2 * sn; v[i + 16] = x1 * sn + x2 * cs; }
  } else { b = (row - NLAT) / TC; tpos = T + (row - NLAT) % TC; }
  u32x4 o[4];
#pragma unroll
  for (int i = 0; i < 4; ++i) { o[i].x = pack2(v[i * 8], v[i * 8 + 1]); o[i].y = pack2(v[i * 8 + 2], v[i * 8 + 3]); o[i].z = pack2(v[i * 8 + 4], v[i * 8 + 5]); o[i].w = pack2(v[i * 8 + 6], v[i * 8 + 7]); }
  bf16_t* dst = (bf16_t*)(p.ws + OFF_KR) + ((size_t)b * TALL + tpos) * 32;
#pragma unroll
  for (int i = 0; i < 4; ++i) *(u32x4*)(dst + i * 8) = o[i];
}

DI void attn_item(const Params& p, int item, char* smem) {
  const int tid = ltid(), lane = tid & 63, w = __builtin_amdgcn_readfirstlane(tid >> 6), l15 = lane & 15, g4 = lane >> 4;
  int b, h, qt, latent;
  if (item < 512) { latent = 1; qt = item & 63; h = (item >> 6) & 3; b = item >> 8; }
  else { latent = 0; const int i2 = item - 512; qt = i2 & 1; h = (i2 >> 1) & 3; b = i2 >> 3; }
  const int qrow0 = latent ? b * T + qt * 128 : NLAT + b * TC + qt * 128;
  bf16_t* Qs = (bf16_t*)smem;
  bf16_t* Ks = (bf16_t*)smem;
  bf16_t* Vs = Ks + 64 * 104;
  const bf16_t* Qraw = (const bf16_t*)(p.ws + OFF_QRAW);
  const float qscale = 0.10206207261596577f * 1.4426950408889634f;
  for (int id = tid; id < 1280; id += 256) {
    const int r = id / 10, cc = id % 10;
    const bf16_t* src = Qraw + (size_t)(qrow0 + r) * 384 + h * 96 + cc * 8;
    const u32x4 q = *(const u32x4*)src;
    float a[8] = {bflo(q.x), bfhi(q.x), bflo(q.y), bfhi(q.y), bflo(q.z), bfhi(q.z), bflo(q.w), bfhi(q.w)};
    if (cc < 8) {
      u32x4 o; o.x = pack2(a[0] * qscale, a[1] * qscale); o.y = pack2(a[2] * qscale, a[3] * qscale); o.z = pack2(a[4] * qscale, a[5] * qscale); o.w = pack2(a[6] * qscale, a[7] * qscale);
      *(u32x4*)(Qs + r * 104 + cc * 8) = o;
    } else {
      const u32x4 q2 = *(const u32x4*)(src + 16);
      float c2[8] = {bflo(q2.x), bfhi(q2.x), bflo(q2.y), bfhi(q2.y), bflo(q2.z), bfhi(q2.z), bflo(q2.w), bfhi(q2.w)};
      float o1[8], o2[8];
#pragma unroll
      for (int j = 0; j < 8; ++j) {
        float cs = 1.f, sn = 0.f;
        if (latent) rope_cs(qt * 128 + r, (cc - 8) * 8 + j, cs, sn);
        o1[j] = (a[j] * cs - c2[j] * sn) * qscale; o2[j] = (a[j] * sn + c2[j] * cs) * qscale;
      }
      u32x4 o; o.x = pack2(o1[0], o1[1]); o.y = pack2(o1[2], o1[3]); o.z = pack2(o1[4], o1[5]); o.w = pack2(o1[6], o1[7]);
      *(u32x4*)(Qs + r * 104 + cc * 8) = o;
      o.x = pack2(o2[0], o2[1]); o.y = pack2(o2[2], o2[3]); o.z = pack2(o2[4], o2[5]); o.w = pack2(o2[6], o2[7]);
      *(u32x4*)(Qs + r * 104 + cc * 8 + 16) = o;
    }
  }
  __syncthreads();
  bf16x8 qf[2][3];
#pragma unroll
  for (int qs = 0; qs < 2; ++qs)
#pragma unroll
    for (int ks = 0; ks < 3; ++ks) qf[qs][ks] = ld_frag(Qs + (32 * w + 16 * qs + l15) * 104 + ks * 32 + g4 * 8);
  __syncthreads();
  const int kt0 = latent ? 0 : 128, kt1 = 132;
  const bf16_t* Kg = (const bf16_t*)(p.ws + OFF_KH) + (size_t)(b * 4 + h) * TALL * 64;
  const bf16_t* Rg = (const bf16_t*)(p.ws + OFF_KR) + (size_t)b * TALL * 32;
  const bf16_t* Vg = (const bf16_t*)(p.ws + OFF_VT) + (size_t)(b * 4 + h) * 64 * TALL;
  u32x4 kr[3], vr[2];
  const int ve0 = tid >> 3, vc = tid & 7;
  {
    kr[0] = *(const u32x4*)(Kg + (size_t)kt0 * 4096 + tid * 8); kr[1] = *(const u32x4*)(Kg + (size_t)kt0 * 4096 + (tid + 256) * 8);
    kr[2] = *(const u32x4*)(Rg + (size_t)kt0 * 2048 + tid * 8);
#pragma unroll
    for (int i = 0; i < 2; ++i) vr[i] = *(const u32x4*)(Vg + (size_t)(ve0 + 32 * i) * TALL + kt0 * 64 + vc * 8);
  }
  float mrun[2] = {-1e30f, -1e30f}, lsum[2] = {0.f, 0.f};
  f32x4 O[4][2];
#pragma unroll
  for (int es = 0; es < 4; ++es)
#pragma unroll
    for (int qs = 0; qs < 2; ++qs) O[es][qs] = (f32x4){0.f, 0.f, 0.f, 0.f};
  constexpr int KVB = 64 * 104 + 64 * 72;
  {
#pragma unroll
    for (int i = 0; i < 2; ++i) { const int id = tid + 256 * i; *(u32x4*)(Ks + (id >> 3) * 104 + (id & 7) * 8) = kr[i]; }
    *(u32x4*)(Ks + (tid >> 2) * 104 + 64 + (tid & 3) * 8) = kr[2];
#pragma unroll
    for (int i = 0; i < 2; ++i) *(u32x4*)(Vs + (ve0 + 32 * i) * 72 + vc * 8) = vr[i];
    if (kt0 + 1 < kt1) {
      kr[0] = *(const u32x4*)(Kg + (size_t)(kt0 + 1) * 4096 + tid * 8); kr[1] = *(const u32x4*)(Kg + (size_t)(kt0 + 1) * 4096 + (tid + 256) * 8);
      kr[2] = *(const u32x4*)(Rg + (size_t)(kt0 + 1) * 2048 + tid * 8);
#pragma unroll
      for (int i = 0; i < 2; ++i) vr[i] = *(const u32x4*)(Vg + (size_t)(ve0 + 32 * i) * TALL + (kt0 + 1) * 64 + vc * 8);
    }
    __syncthreads();
  }
  for (int kt = kt0; kt < kt1; ++kt) {
    const int cur = (kt - kt0) & 1;
    const bf16_t* Kc = Ks + cur * KVB; const bf16_t* Vc = Vs + cur * KVB;
    bf16_t* Kn = Ks + (cur ^ 1) * KVB; bf16_t* Vn = Vs + (cur ^ 1) * KVB;
    if (kt + 1 < kt1) {
#pragma unroll
      for (int i = 0; i < 2; ++i) { const int id = tid + 256 * i; *(u32x4*)(Kn + (id >> 3) * 104 + (id & 7) * 8) = kr[i]; }
      *(u32x4*)(Kn + (tid >> 2) * 104 + 64 + (tid & 3) * 8) = kr[2];
#pragma unroll
      for (int i = 0; i < 2; ++i) *(u32x4*)(Vn + (ve0 + 32 * i) * 72 + vc * 8) = vr[i];
    }
    if (kt + 2 < kt1) {
      kr[0] = *(const u32x4*)(Kg + (size_t)(kt + 2) * 4096 + tid * 8); kr[1] = *(const u32x4*)(Kg + (size_t)(kt + 2) * 4096 + (tid + 256) * 8);
      kr[2] = *(const u32x4*)(Rg + (size_t)(kt + 2) * 2048 + tid * 8);
#pragma unroll
      for (int i = 0; i < 2; ++i) vr[i] = *(const u32x4*)(Vg + (size_t)(ve0 + 32 * i) * TALL + (kt + 2) * 64 + vc * 8);
    }
    __builtin_amdgcn_sched_barrier(0);
    f32x4 sa[4][2];
#pragma unroll
    for (int kb = 0; kb < 4; ++kb)
#pragma unroll
      for (int qs = 0; qs < 2; ++qs) sa[kb][qs] = (f32x4){0.f, 0.f, 0.f, 0.f};
#pragma unroll
    for (int ks = 0; ks < 3; ++ks)
#pragma unroll
      for (int kb = 0; kb < 4; ++kb) {
        const bf16x8 a = ld_frag(Kc + (16 * kb + l15) * 104 + ks * 32 + g4 * 8);
#pragma unroll
        for (int qs = 0; qs < 2; ++qs) sa[kb][qs] = MFMA16(a, qf[qs][ks], sa[kb][qs]);
      }
    bf16x8 pf[2][2];
#pragma unroll
    for (int qs = 0; qs < 2; ++qs) {
      float mx = -1e30f;
#pragma unroll
      for (int kb = 0; kb < 4; ++kb)
#pragma unroll
        for (int j = 0; j < 4; ++j) mx = fmaxf(mx, sa[kb][qs][j]);
      mx = fmaxf(mx, __shfl_xor(mx, 16)); mx = fmaxf(mx, __shfl_xor(mx, 32));
      const float mnew = fmaxf(mrun[qs], mx), alpha = __builtin_amdgcn_exp2f(mrun[qs] - mnew);
      mrun[qs] = mnew;
      float ps = 0.f;
#pragma unroll
      for (int kb = 0; kb < 4; ++kb)
#pragma unroll
        for (int j = 0; j < 4; ++j) { const float e = __builtin_amdgcn_exp2f(sa[kb][qs][j] - mnew); sa[kb][qs][j] = e; ps += e; }
      lsum[qs] = lsum[qs] * alpha + ps;
#pragma unroll
      for (int es = 0; es < 4; ++es) O[es][qs] = O[es][qs] * alpha;
#pragma unroll
      for (int k2 = 0; k2 < 2; ++k2)
        pf[qs][k2] = mk_frag(pack2(sa[2 * k2][qs][0], sa[2 * k2][qs][1]), pack2(sa[2 * k2][qs][2], sa[2 * k2][qs][3]),
                             pack2(sa[2 * k2 + 1][qs][0], sa[2 * k2 + 1][qs][1]), pack2(sa[2 * k2 + 1][qs][2], sa[2 * k2 + 1][qs][3]));
    }
#pragma unroll
    for (int k2 = 0; k2 < 2; ++k2)
#pragma unroll
      for (int es = 0; es < 4; ++es) {
        const bf16_t* vp = Vc + (16 * es + l15) * 72 + 32 * k2 + 4 * g4;
        const u32x2 lo = *(const u32x2*)vp, hi = *(const u32x2*)(vp + 16);
        const bf16x8 a = mk_frag(lo.x, lo.y, hi.x, hi.y);
#pragma unroll
        for (int qs = 0; qs < 2; ++qs) O[es][qs] = MFMA16(a, pf[qs][k2], O[es][qs]);
      }
    __syncthreads();
  }
  bf16_t* Y = (bf16_t*)(p.ws + OFF_HY);
#pragma unroll
  for (int qs = 0; qs < 2; ++qs) {
    float l = lsum[qs]; l += __shfl_xor(l, 16); l += __shfl_xor(l, 32);
    const float inv = 1.f / l;
    const int row = qrow0 + 32 * w + 16 * qs + l15;
#pragma unroll
    for (int es = 0; es < 4; ++es) store_bf4(Y + (size_t)row * 1024 + 256 + h * 64 + 16 * es + 4 * g4, O[es][qs] * inv);
  }
  __syncthreads();
}

DI void chunk_geom(int tcg, int b, int& part, int& tc, int& row0) { part = tcg >= 128; tc = part ? tcg - 128 : tcg; row0 = row_of(b, part, tc * 64); }
DI int chain_slot(int dir, int part, int tc) { return dir ? (part ? 3 - tc : 131 - tc) : (part ? tc : 4 + tc); }

DI void mlstm_p1(const Params& p, int l, int item, char* smem) {
  const int tid = ltid(), lane = tid & 63, w = __builtin_amdgcn_readfirstlane(tid >> 6), l15 = lane & 15, g4 = lane >> 4;
  const int tcg = item % NCH; int r = item / NCH; const int dir = r & 1; r >>= 1; const int h = r & 3, b = r >> 2;
  int part, tc, row0; chunk_geom(tcg, b, part, tc, row0);
  const int c = chain_slot(dir, part, tc), chain = (b * 4 + h) * 2 + dir;
  bf16_t* A = (bf16_t*)smem;
  bf16_t* Bk = A + 80 * 72;
  float* fs = (float*)(Bk + 64 * 72);
  const bf16_t* P = (const bf16_t*)(p.ws + OFF_P); const float* GML = (const float*)(p.ws + OFF_GML);
  float* MLM = (float*)(p.ws + OFF_MLM) + (size_t)(chain * NCH + c) * 32;
  if (tid < 64) {
    const int gi = 2 * dir;
    const float ig = GML[(size_t)(row0 + tid) * 16 + gi * 4 + h] + p.ml_gate_bias[l * 16 + gi * 4 + h];
    const float fg = GML[(size_t)(row0 + tid) * 16 + (gi + 1) * 4 + h] + p.ml_gate_bias[l * 16 + (gi + 1) * 4 + h];
    const float lf = logsigm_f(fg);
    const float pre = wave_incl_scan(lf, lane), tot = __shfl(pre, 63);
    const float bc = dir ? tot - pre + lf : pre;
    const float wlog = tot - bc + ig, mloc = wave_max(wlog), wv = __expf(wlog - mloc);
    fs[tid] = wv; A[64 * 72 + tid] = f2bf(wv);
    if (tid == 0) { MLM[0] = mloc; MLM[1] = tot; }
  }
  for (int i = tid; i < 15 * 72; i += 256) A[65 * 72 + i] = 0;
  __syncthreads();
  {
    const int s = tid >> 2, d0 = (tid & 3) * 16; const float wv = fs[s];
    const bf16_t* kp = P + (size_t)(row0 + s) * PINP + C_MLK + h * 64 + d0;
    const bf16_t* vp = P + (size_t)(row0 + s) * PINP + C_MLV + h * 64 + d0;
#pragma unroll
    for (int hf = 0; hf < 2; ++hf) {
      const u32x4 kq = *(const u32x4*)(kp + hf * 8), vq = *(const u32x4*)(vp + hf * 8);
      const float kk[8] = {bflo(kq.x), bfhi(kq.x), bflo(kq.y), bfhi(kq.y), bflo(kq.z), bfhi(kq.z), bflo(kq.w), bfhi(kq.w)};
      const float vv[8] = {bflo(vq.x), bfhi(vq.x), bflo(vq.y), bfhi(vq.y), bflo(vq.z), bfhi(vq.z), bflo(vq.w), bfhi(vq.w)};
#pragma unroll
      for (int j = 0; j < 8; ++j) { Bk[(d0 + hf * 8 + j) * 72 + s] = f2bf(kk[j] * 0.125f); A[(d0 + hf * 8 + j) * 72 + s] = f2bf(vv[j] * wv); }
    }
  }
  __syncthreads();
  float* MLS = (float*)(p.ws + OFF_MLS) + (size_t)(chain * NCH + c) * 4160;
  for (int t = w; t < 20; t += 4) {
    const int ms = t >> 2, ns = t & 3;
    f32x4 acc = {0.f, 0.f, 0.f, 0.f};
#pragma unroll
    for (int ks = 0; ks < 2; ++ks) acc = MFMA16(ld_frag(A + (16 * ms + l15) * 72 + ks * 32 + g4 * 8), ld_frag(Bk + (16 * ns + l15) * 72 + ks * 32 + g4 * 8), acc);
#pragma unroll
    for (int j = 0; j < 4; ++j) { const int e = 16 * ms + 4 * g4 + j; if (e <= 64) MLS[e * 64 + 16 * ns + l15] = acc[j]; }
  }
  __syncthreads();
}
DI void mlstm_p2(const Params& p, int item) {
  const int gi = item * 256 + ltid(), chain = gi / 4160, e = gi % 4160;
  float* MLS = (float*)(p.ws + OFF_MLS) + (size_t)chain * NCH * 4160 + e;
  float* MLM = (float*)(p.ws + OFF_MLM) + (size_t)chain * NCH * 32;
  float C = 0.f, m = 0.f;
  for (int c0 = 0; c0 < NCH; c0 += 12) {
    float d[12], ml[12], bl[12];
#pragma unroll
    for (int i = 0; i < 12; ++i) { d[i] = MLS[(size_t)(c0 + i) * 4160]; ml[i] = MLM[(c0 + i) * 32]; bl[i] = MLM[(c0 + i) * 32 + 1]; }
#pragma unroll
    for (int i = 0; i < 12; ++i) {
      MLS[(size_t)(c0 + i) * 4160] = C; if (e == 0) MLM[(c0 + i) * 32 + 16] = m;
      const float mn = fmaxf(bl[i] + m, ml[i]);
      C = __expf(bl[i] + m - mn) * C + __expf(ml[i] - mn) * d[i]; m = mn;
    }
  }
}
DI void mlstm_p3(const Params& p, int l, int item, char* smem) {
  const int tid = ltid(), lane = tid & 63, w = __builtin_amdgcn_readfirstlane(tid >> 6), l15 = lane & 15, g4 = lane >> 4;
  const int h = item & 3; const int r = item >> 2; const int tcg = r % NCH, b = r / NCH;
  int part, tc, row0; chunk_geom(tcg, b, part, tc, row0);
  bf16_t* Qs = (bf16_t*)smem;
  bf16_t* Ks = Qs + 64 * 72;
  bf16_t* Vt = Ks + 64 * 72;
  bf16_t* Sb = Vt + 64 * 72;
  float* fb = (float*)(Sb + 64 * 72);
  float* fi = fb + 64;
  const bf16_t* P = (const bf16_t*)(p.ws + OFF_P); const float* GML = (const float*)(p.ws + OFF_GML);
  {
    const int s = tid >> 2, d0 = (tid & 3) * 16;
    const bf16_t* base = P + (size_t)(row0 + s) * PINP + h * 64 + d0;
#pragma unroll
    for (int hf = 0; hf < 2; ++hf) {
      *(u32x4*)(Qs + s * 72 + d0 + hf * 8) = *(const u32x4*)(base + C_MLQ + hf * 8);
      const u32x4 kq = *(const u32x4*)(base + C_MLK + hf * 8), vq = *(const u32x4*)(base + C_MLV + hf * 8);
      u32x4 ko; ko.x = pack2(bflo(kq.x) * 0.125f, bfhi(kq.x) * 0.125f); ko.y = pack2(bflo(kq.y) * 0.125f, bfhi(kq.y) * 0.125f);
      ko.z = pack2(bflo(kq.z) * 0.125f, bfhi(kq.z) * 0.125f); ko.w = pack2(bflo(kq.w) * 0.125f, bfhi(kq.w) * 0.125f);
      *(u32x4*)(Ks + s * 72 + d0 + hf * 8) = ko;
      const unsigned vw[4] = {vq.x, vq.y, vq.z, vq.w};
#pragma unroll
      for (int j = 0; j < 4; ++j) { Vt[(d0 + hf * 8 + 2 * j) * 72 + s] = (bf16_t)(vw[j] & 0xffffu); Vt[(d0 + hf * 8 + 2 * j + 1) * 72 + s] = (bf16_t)(vw[j] >> 16); }
    }
  }
  f32x4 hs[4];
#pragma unroll
  for (int ns = 0; ns < 4; ++ns) hs[ns] = (f32x4){0.f, 0.f, 0.f, 0.f};
#pragma unroll 1
  for (int dir = 0; dir < 2; ++dir) {
    const int c = chain_slot(dir, part, tc), chain = (b * 4 + h) * 2 + dir;
    const float m_in = ((const float*)(p.ws + OFF_MLM))[(size_t)(chain * NCH + c) * 32 + 16];
    const float* Cst = (const float*)(p.ws + OFF_MLS) + (size_t)(chain * NCH + c) * 4160;
    __syncthreads();
    if (tid < 64) {
      const int gi = 2 * dir;
      const float ig = GML[(size_t)(row0 + tid) * 16 + gi * 4 + h] + p.ml_gate_bias[l * 16 + gi * 4 + h];
      const float fg = GML[(size_t)(row0 + tid) * 16 + (gi + 1) * 4 + h] + p.ml_gate_bias[l * 16 + (gi + 1) * 4 + h];
      const float lf = logsigm_f(fg);
      const float pre = wave_incl_scan(lf, lane), tot = __shfl(pre, 63);
      fb[tid] = dir ? tot - pre + lf : pre; fi[tid] = ig;
    }
    __syncthreads();
    f32x4 sc[4];
#pragma unroll
    for (int ns = 0; ns < 4; ++ns) {
      f32x4 a = {0.f, 0.f, 0.f, 0.f};
#pragma unroll
      for (int ks = 0; ks < 2; ++ks) a = MFMA16(ld_frag(Qs + (16 * w + l15) * 72 + ks * 32 + g4 * 8), ld_frag(Ks + (16 * ns + l15) * 72 + ks * 32 + g4 * 8), a);
      sc[ns] = a;
    }
    float bi[4], mt[4], rsum[4];
#pragma unroll
    for (int j = 0; j < 4; ++j) {
      const int i = 16 * w + 4 * g4 + j; bi[j] = fb[i];
      float mx = -1e30f;
#pragma unroll
      for (int ns = 0; ns < 4; ++ns) { const int s = 16 * ns + l15; const bool ok = dir ? (s >= i) : (s <= i); const float dm = bi[j] - fb[s] + fi[s]; if (ok) mx = fmaxf(mx, dm); }
      mx = red16_max(mx);
      mt[j] = fmaxf(bi[j] + m_in, mx);
      float rs = 0.f;
#pragma unroll
      for (int ns = 0; ns < 4; ++ns) {
        const int s = 16 * ns + l15; const bool ok = dir ? (s >= i) : (s <= i);
        const float v = ok ? sc[ns][j] * __expf(bi[j] - fb[s] + fi[s] - mt[j]) : 0.f;
        rs += v; Sb[i * 72 + s] = f2bf(v);
      }
      rsum[j] = red16_sum(rs);
    }
    __syncthreads();
    f32x4 qc[5];
#pragma unroll
    for (int ns = 0; ns < 5; ++ns) {
      f32x4 a = {0.f, 0.f, 0.f, 0.f};
      const int e = 16 * ns + l15;
#pragma unroll
      for (int ks = 0; ks < 2; ++ks) {
        bf16x8 bfm;
        if (e <= 64) bfm = frag_from_f32(Cst + e * 64 + ks * 32 + g4 * 8, 1.f); else bfm = mk_frag(0u, 0u, 0u, 0u);
        a = MFMA16(ld_frag(Qs + (16 * w + l15) * 72 + ks * 32 + g4 * 8), bfm, a);
      }
      qc[ns] = a;
    }
    f32x4 nm[4];
#pragma unroll
    for (int ns = 0; ns < 4; ++ns) {
      f32x4 a = {0.f, 0.f, 0.f, 0.f};
#pragma unroll
      for (int ks = 0; ks < 2; ++ks) a = MFMA16(ld_frag(Sb + (16 * w + l15) * 72 + ks * 32 + g4 * 8), ld_frag(Vt + (16 * ns + l15) * 72 + ks * 32 + g4 * 8), a);
      nm[ns] = a;
    }
#pragma unroll
    for (int j = 0; j < 4; ++j) {
      const float wi = __expf(bi[j] + m_in - mt[j]);
      const float qn = __shfl(qc[4][j], lane & 48);
      const float den = rsum[j] + wi * qn;
      const float dd = 1.f / fmaxf(fabsf(den), __expf(-mt[j]));
#pragma unroll
      for (int ns = 0; ns < 4; ++ns) hs[ns][j] += (nm[ns][j] + wi * qc[ns][j]) * dd;
    }
  }
  bf16_t* Y = (bf16_t*)(p.ws + OFF_HY);
#pragma unroll
  for (int j = 0; j < 4; ++j) {
    float ss = 0.f;
#pragma unroll
    for (int ns = 0; ns < 4; ++ns) ss += hs[ns][j] * hs[ns][j];
    ss = red16_sum(ss);
    const float rstd = rsqrtf(ss * (1.f / 64.f) + 1e-6f);
    const int row = row0 + 16 * w + 4 * g4 + j;
#pragma unroll
    for (int ns = 0; ns < 4; ++ns) {
      const int ch = h * 64 + 16 * ns + l15;
      const float o = bf2f(P[(size_t)row * PINP + C_MLO + ch]);
      Y[(size_t)row * 1024 + ch] = f2bf(hs[ns][j] * rstd * p.ml_norm[l * 256 + ch] * sigm_f(o));
    }
  }
  __syncthreads();
}

DI void conv_silu8(const Params& p, int l, const bf16_t* P, int row, bool hp, bool hn, int ch, float* out) {
  const bf16_t* src = P + (size_t)row * PINP + C_XBC + ch;
  const u32x4 z = {0u, 0u, 0u, 0u};
  const u32x4 c0 = *(const u32x4*)src, pm = hp ? *(const u32x4*)(src - PINP) : z, nx = hn ? *(const u32x4*)(src + PINP) : z;
  const float* cw = p.ssd_conv_w + (size_t)l * 3 * 768 + ch; const float* cb = p.ssd_conv_b + l * 768 + ch;
  const float a[8] = {bflo(pm.x), bfhi(pm.x), bflo(pm.y), bfhi(pm.y), bflo(pm.z), bfhi(pm.z), bflo(pm.w), bfhi(pm.w)};
  const float m[8] = {bflo(c0.x), bfhi(c0.x), bflo(c0.y), bfhi(c0.y), bflo(c0.z), bfhi(c0.z), bflo(c0.w), bfhi(c0.w)};
  const float n[8] = {bflo(nx.x), bfhi(nx.x), bflo(nx.y), bfhi(nx.y), bflo(nx.z), bfhi(nx.z), bflo(nx.w), bfhi(nx.w)};
#pragma unroll
  for (int j = 0; j < 8; ++j) out[j] = silu_f(cb[j] + cw[j] * a[j] + cw[768 + j] * m[j] + cw[1536 + j] * n[j]);
}
DI void ssd_gates(const Params& p, int l, int dir, int h, int row0, int tid, int lane, float& dt, float& cs, float& tot) {
  const float* DTR = (const float*)(p.ws + OFF_DTR);
  dt = softplus_f(DTR[(size_t)(row0 + tid) * 8 + dir * 4 + h] + p.ssd_dt_bias[l * 8 + dir * 4 + h]);
  const float la = -dt * __expf(p.ssd_a_log[l * 8 + dir * 4 + h]);
  const float pre = wave_incl_scan(la, lane); tot = __shfl(pre, 63);
  cs = dir ? tot - pre + la : pre;
}
DI void ssd_p1(const Params& p, int l, int item, char* smem) {
  const int tid = ltid(), lane = tid & 63, w = __builtin_amdgcn_readfirstlane(tid >> 6), l15 = lane & 15, g4 = lane >> 4;
  const int tcg = item % NCH; int r = item / NCH; const int dir = r & 1; r >>= 1; const int h = r & 3, b = r >> 2;
  int part, tc, row0; chunk_geom(tcg, b, part, tc, row0);
  const int c = chain_slot(dir, part, tc), chain = (b * 4 + h) * 2 + dir, lastc = part ? 3 : 127;
  bf16_t* Xt = (bf16_t*)smem;
  bf16_t* Bt = Xt + 64 * 72;
  float* fs = (float*)(Bt + 128 * 72);
  const bf16_t* P = (const bf16_t*)(p.ws + OFF_P);
  if (tid < 64) {
    float dt, cs, tot; ssd_gates(p, l, dir, h, row0, tid, lane, dt, cs, tot);
    fs[tid] = __expf(tot - cs) * dt;
    if (tid == 0) ((float*)(p.ws + OFF_SSA))[(chain * NCH + c) * 32] = tot;
  }
  __syncthreads();
  const int grp = h >> 1;
  for (int id = tid; id < 64 * 24; id += 256) {
    const int s = id / 24, cc = id % 24;
    const bool hp = !(tc == 0 && s == 0), hn = !(tc == lastc && s == 63);
    float v[8];
    if (cc < 8) { conv_silu8(p, l, P, row0 + s, hp, hn, h * 64 + cc * 8, v); const float wv = fs[s];
#pragma unroll
      for (int j = 0; j < 8; ++j) Xt[(cc * 8 + j) * 72 + s] = f2bf(v[j] * wv); }
    else { const int n0 = (cc - 8) * 8; conv_silu8(p, l, P, row0 + s, hp, hn, 256 + grp * 128 + n0, v);
#pragma unroll
      for (int j = 0; j < 8; ++j) Bt[(n0 + j) * 72 + s] = f2bf(v[j]); }
  }
  __syncthreads();
  float* SS = (float*)(p.ws + OFF_SSDS) + (size_t)(chain * NCH + c) * 8192;
#pragma unroll
  for (int ns = 0; ns < 8; ++ns) {
    f32x4 acc = {0.f, 0.f, 0.f, 0.f};
#pragma unroll
    for (int ks = 0; ks < 2; ++ks) acc = MFMA16(ld_frag(Xt + (16 * w + l15) * 72 + ks * 32 + g4 * 8), ld_frag(Bt + (16 * ns + l15) * 72 + ks * 32 + g4 * 8), acc);
#pragma unroll
    for (int j = 0; j < 4; ++j) SS[(16 * w + 4 * g4 + j) * 128 + 16 * ns + l15] = acc[j];
  }
  __syncthreads();
}
DI void ssd_p2(const Params& p, int item) {
  const int gi = item * 256 + ltid(), chain = gi >> 13, e = gi & 8191;
  float* SS = (float*)(p.ws + OFF_SSDS) + (size_t)chain * NCH * 8192 + e;
  const float* SA = (const float*)(p.ws + OFF_SSA) + (size_t)chain * NCH * 32;
  float S = 0.f;
  for (int c0 = 0; c0 < NCH; c0 += 12) {
    float d[12], a[12];
#pragma unroll
    for (int i = 0; i < 12; ++i) { d[i] = SS[(size_t)(c0 + i) * 8192]; a[i] = SA[(c0 + i) * 32]; }
#pragma unroll
    for (int i = 0; i < 12; ++i) { SS[(size_t)(c0 + i) * 8192] = S; S = __expf(a[i]) * S + d[i]; }
  }
}
DI void ssd_p3(const Params& p, int l, int item, char* smem) {
  const int tid = ltid(), lane = tid & 63, w = __builtin_amdgcn_readfirstlane(tid >> 6), l15 = lane & 15, g4 = lane >> 4;
  const int h = item & 3; const int r = item >> 2; const int tcg = r % NCH, b = r / NCH;
  int part, tc, row0; chunk_geom(tcg, b, part, tc, row0);
  const int lastc = part ? 3 : 127, grp = h >> 1;
  bf16_t* Cm = (bf16_t*)smem;
  bf16_t* Bm = Cm + 64 * 136;
  bf16_t* Xt = Bm + 64 * 136;
  bf16_t* Sb = Xt + 64 * 72;
  float* fcs = (float*)(Sb + 64 * 72);
  float* fdt = fcs + 64;
  const bf16_t* P = (const bf16_t*)(p.ws + OFF_P);
  for (int id = tid; id < 64 * 40; id += 256) {
    const int s = id / 40, cc = id % 40;
    const bool hp = !(tc == 0 && s == 0), hn = !(tc == lastc && s == 63);
    float v[8];
    if (cc < 8) { conv_silu8(p, l, P, row0 + s, hp, hn, h * 64 + cc * 8, v);
#pragma unroll
      for (int j = 0; j < 8; ++j) Xt[(cc * 8 + j) * 72 + s] = f2bf(v[j]); }
    else {
      const int q = cc - 8, isC = q >= 16, n0 = (q & 15) * 8;
      conv_silu8(p, l, P, row0 + s, hp, hn, 256 + isC * 256 + grp * 128 + n0, v);
      u32x4 o; o.x = pack2(v[0], v[1]); o.y = pack2(v[2], v[3]); o.z = pack2(v[4], v[5]); o.w = pack2(v[6], v[7]);
      *(u32x4*)((isC ? Cm : Bm) + s * 136 + n0) = o;
    }
  }
  f32x4 ys[4];
#pragma unroll
  for (int ns = 0; ns < 4; ++ns) ys[ns] = (f32x4){0.f, 0.f, 0.f, 0.f};
#pragma unroll 1
  for (int dir = 0; dir < 2; ++dir) {
    const int c = chain_slot(dir, part, tc), chain = (b * 4 + h) * 2 + dir;
    const float* St = (const float*)(p.ws + OFF_SSDS) + (size_t)(chain * NCH + c) * 8192;
    __syncthreads();
    if (tid < 64) { float dt, cs, tot; ssd_gates(p, l, dir, h, row0, tid, lane, dt, cs, tot); fcs[tid] = cs; fdt[tid] = dt; }
    __syncthreads();
    float ci[4];
#pragma unroll
    for (int j = 0; j < 4; ++j) ci[j] = fcs[16 * w + 4 * g4 + j];
#pragma unroll
    for (int ns = 0; ns < 4; ++ns) {
      f32x4 a = {0.f, 0.f, 0.f, 0.f};
#pragma unroll
      for (int ks = 0; ks < 4; ++ks) a = MFMA16(ld_frag(Cm + (16 * w + l15) * 136 + ks * 32 + g4 * 8), ld_frag(Bm + (16 * ns + l15) * 136 + ks * 32 + g4 * 8), a);
      const int s = 16 * ns + l15; const float css = fcs[s], dts = fdt[s];
#pragma unroll
      for (int j = 0; j < 4; ++j) {
        const int i = 16 * w + 4 * g4 + j; const bool ok = dir ? (s >= i) : (s <= i);
        Sb[i * 72 + s] = f2bf(ok ? a[j] * __expf(ci[j] - css) * dts : 0.f);
      }
    }
    __syncthreads();
#pragma unroll
    for (int ns = 0; ns < 4; ++ns) {
      f32x4 a = {0.f, 0.f, 0.f, 0.f}, bq = {0.f, 0.f, 0.f, 0.f};
#pragma unroll
      for (int ks = 0; ks < 2; ++ks) a = MFMA16(ld_frag(Sb + (16 * w + l15) * 72 + ks * 32 + g4 * 8), ld_frag(Xt + (16 * ns + l15) * 72 + ks * 32 + g4 * 8), a);
#pragma unroll
      for (int ks = 0; ks < 4; ++ks) bq = MFMA16(ld_frag(Cm + (16 * w + l15) * 136 + ks * 32 + g4 * 8), frag_from_f32(St + (16 * ns + l15) * 128 + ks * 32 + g4 * 8, 1.f), bq);
#pragma unroll
      for (int j = 0; j < 4; ++j) ys[ns][j] += a[j] + __expf(ci[j]) * bq[j];
    }
  }
  bf16_t* Y = (bf16_t*)(p.ws + OFF_HY); float* SSQ = (float*)(p.ws + OFF_SSQ);
  const float dsk = p.ssd_d[l * 4 + h];
#pragma unroll
  for (int j = 0; j < 4; ++j) {
    const int i = 16 * w + 4 * g4 + j, row = row0 + i; float ss = 0.f;
#pragma unroll
    for (int ns = 0; ns < 4; ++ns) {
      const int pp = 16 * ns + l15;
      const float xv = bf2f(Xt[pp * 72 + i]);
      const float z = bf2f(P[(size_t)row * PINP + C_Z + h * 64 + pp]);
      const float g = (ys[ns][j] + dsk * xv) * silu_f(z);
      ss += g * g; Y[(size_t)row * 1024 + 512 + h * 64 + pp] = f2bf(g);
    }
    ss = red16_sum(ss);
    if (l15 == 0) SSQ[(size_t)h * NROW + row] = ss;
  }
  __syncthreads();
}

struct S5Par { float are, aim, bre[16], bim[16]; };
DI void s5_params(const Params& p, int l, int dir, int g, int n, S5Par& q, float& dtv, float& lre, float& lim) {
  const int ai = ((l * 2 + dir) * 16 + g) * 64 + n;
  lre = fminf(p.s5_a_re[ai], -1e-4f); lim = p.s5_a_im[ai];
  dtv = __expf(p.s5_log_dt[(l * 2 + dir) * 16 + g]);
  const float mag = __expf(lre * dtv), ang = lim * dtv;
  q.are = mag * cosf(ang); q.aim = mag * sinf(ang);
  const float den = lre * lre + lim * lim;
  const float fre = ((q.are - 1.f) * lre + q.aim * lim) / den, fim = (q.aim * lre - (q.are - 1.f) * lim) / den;
  const float* br = p.s5_b_re + ((size_t)(l * 16 + g) * 64 + n) * 16; const float* bi = p.s5_b_im + ((size_t)(l * 16 + g) * 64 + n) * 16;
#pragma unroll
  for (int j = 0; j < 16; ++j) { q.bre[j] = fre * br[j] - fim * bi[j]; q.bim[j] = fre * bi[j] + fim * br[j]; }
}
DI void s5_step(const S5Par& q, const bf16_t* us, int s, float& xr, float& xi) {
  const u32x4 a0 = *(const u32x4*)(us + s * 16), a1 = *(const u32x4*)(us + s * 16 + 8);
  const unsigned uw[8] = {a0.x, a0.y, a0.z, a0.w, a1.x, a1.y, a1.z, a1.w};
  float br = 0.f, bi = 0.f;
#pragma unroll
  for (int j = 0; j < 8; ++j) { const float a = bflo(uw[j]), c = bfhi(uw[j]); br += q.bre[2 * j] * a + q.bre[2 * j + 1] * c; bi += q.bim[2 * j] * a + q.bim[2 * j + 1] * c; }
  const float nr = q.are * xr - q.aim * xi + br, ni = q.are * xi + q.aim * xr + bi;
  xr = nr; xi = ni;
}
DI void s5_p1(const Params& p, int l, int item, char* smem) {
  const int lane = ltid() & 63, wi = item * 4 + __builtin_amdgcn_readfirstlane(ltid() >> 6);
  const int tcg = wi % NCH; int r = wi / NCH; const int dir = r & 1; r >>= 1; const int g = r & 15, b = r >> 4;
  int part, tc, row0; chunk_geom(tcg, b, part, tc, row0);
  const int c = chain_slot(dir, part, tc);
  S5Par q; float dtv, lre, lim; s5_params(p, l, dir, g, lane, q, dtv, lre, lim);
  const bf16_t* up = (const bf16_t*)(p.ws + OFF_P) + (size_t)(row0 + lane) * PINP + C_S5 + g * 16;
  bf16_t* us = (bf16_t*)smem + __builtin_amdgcn_readfirstlane(ltid() >> 6) * 1024;
  *(u32x4*)(us + lane * 16) = *(const u32x4*)up; *(u32x4*)(us + lane * 16 + 8) = *(const u32x4*)(up + 8);
  float xr = 0.f, xi = 0.f;
  for (int st = 0; st < 64; ++st) { const int s = dir ? 63 - st : st; s5_step(q, us, s, xr, xi); }
  float* S = (float*)(p.ws + OFF_S5S) + ((size_t)((b * 16 + g) * 2 + dir) * NCH + c) * 128;
  S[lane] = xr; S[64 + lane] = xi;
}
DI void s5_p2(const Params& p, int l, int item) {
  const int gi = item * 256 + ltid(), n = gi & 63, dir = (gi >> 6) & 1, g = (gi >> 7) & 15, b = gi >> 11;
  const int ai = ((l * 2 + dir) * 16 + g) * 64 + n;
  const float lre = fminf(p.s5_a_re[ai], -1e-4f), lim = p.s5_a_im[ai], dtv = __expf(p.s5_log_dt[(l * 2 + dir) * 16 + g]);
  const float mag = __expf(64.f * lre * dtv), ang = 64.f * (lim * dtv);
  const float ar = mag * cosf(ang), aim = mag * sinf(ang);
  float* S = (float*)(p.ws + OFF_S5S) + (size_t)((b * 16 + g) * 2 + dir) * NCH * 128 + n;
  float xr = 0.f, xi = 0.f;
  for (int c0 = 0; c0 < NCH; c0 += 12) {
    float dr[12], di[12];
#pragma unroll
    for (int i = 0; i < 12; ++i) { dr[i] = S[(c0 + i) * 128]; di[i] = S[(c0 + i) * 128 + 64]; }
#pragma unroll
    for (int i = 0; i < 12; ++i) { S[(c0 + i) * 128] = xr; S[(c0 + i) * 128 + 64] = xi; const float nr = ar * xr - aim * xi + dr[i], ni = ar * xi + aim * xr + di[i]; xr = nr; xi = ni; }
  }
}
DI void s5_p3(const Params& p, int l, int item, char* smem) {
  const int tid = ltid(), lane = tid & 63, w = __builtin_amdgcn_readfirstlane(tid >> 6), l15 = lane & 15, g4 = lane >> 4;
  const int half = item & 1; const int r2 = item >> 1; const int tcg = r2 % NCH, b = r2 / NCH;
  int part, tc, row0; chunk_geom(tcg, b, part, tc, row0);
  bf16_t* xs = (bf16_t*)smem + w * (16 * 136);
  bf16_t* YG = (bf16_t*)(p.ws + OFF_YG);
  const bf16_t* P = (const bf16_t*)(p.ws + OFF_P);
#pragma unroll 1
  for (int gi = 0; gi < 2; ++gi) {
    const int g = half * 8 + w + 4 * gi;
    const bf16_t* up = P + (size_t)(row0 + lane) * PINP + C_S5 + g * 16;
    bf16_t* us = (bf16_t*)smem + 25600 + w * 1024;
    *(u32x4*)(us + lane * 16) = *(const u32x4*)up; *(u32x4*)(us + lane * 16 + 8) = *(const u32x4*)(up + 8);
    f32x4 yt[4];
#pragma unroll
    for (int ib = 0; ib < 4; ++ib) yt[ib] = (f32x4){0.f, 0.f, 0.f, 0.f};
#pragma unroll
    for (int dir = 0; dir < 2; ++dir) {
      S5Par q; float dtv, lre, lim; s5_params(p, l, dir, g, lane, q, dtv, lre, lim);
      const int c = chain_slot(dir, part, tc);
      const float* S = (const float*)(p.ws + OFF_S5S) + ((size_t)((b * 16 + g) * 2 + dir) * NCH + c) * 128;
      float xr = S[lane], xi = S[64 + lane];
      bf16x8 cf[4];
#pragma unroll
      for (int ks = 0; ks < 4; ++ks) {
        const int k = ks * 32 + g4 * 8;
        const float* src = (k < 64 ? p.s5_c_re : p.s5_c_im) + ((size_t)(l * 16 + g) * 16 + l15) * 64 + (k & 63);
        cf[ks] = frag_from_f32(src, k < 64 ? 1.f : -1.f);
      }
#pragma unroll
      for (int blk = 0; blk < 4; ++blk) {
        asm volatile("s_waitcnt lgkmcnt(0)" ::: "memory");
#pragma unroll 4
        for (int st = 0; st < 16; ++st) {
          const int step = blk * 16 + st, s = dir ? 63 - step : step;
          s5_step(q, us, s, xr, xi);
          xs[(s & 15) * 136 + lane] = f2bf(xr); xs[(s & 15) * 136 + 64 + lane] = f2bf(xi);
        }
        asm volatile("s_waitcnt lgkmcnt(0)" ::: "memory");
        f32x4 a = {0.f, 0.f, 0.f, 0.f};
#pragma unroll
        for (int ks = 0; ks < 4; ++ks) a = MFMA16(ld_frag(xs + l15 * 136 + ks * 32 + g4 * 8), cf[ks], a);
        const int ib = dir ? 3 - blk : blk;
        yt[ib] += a;
      }
    }
#pragma unroll
    for (int ib = 0; ib < 4; ++ib)
#pragma unroll
      for (int j = 0; j < 4; ++j) {
        const int tok = 16 * ib + 4 * g4 + j, ch = g * 16 + l15;
        const float u = bf2f(P[(size_t)(row0 + tok) * PINP + C_S5 + ch]);
        YG[(size_t)(row0 + tok) * 256 + ch] = f2bf(gelu_tanh_f(yt[ib][j] + p.s5_d[l * 256 + ch] * u));
      }
  }
  __syncthreads();
}
DI void glu_item(const Params& p, int l, int item, char* smem) {
  const int mt = item >> 1, nt = item & 1;
  const bf16_t* YG = (const bf16_t*)(p.ws + OFF_YG); bf16_t* Y = (bf16_t*)(p.ws + OFF_HY);
  gemm_tile<0, 0>(YG, 256, (const bf16_t*)(p.ws + OFF_WGLU) + (size_t)l * 256 * 256, 256, 256, mt * 128, nt * 128, smem, nullptr,
                  [&](int row, int col, f32x4 v) {
                    const u32x2 yv = *(const u32x2*)(YG + (size_t)row * 256 + col);
                    f32x4 o; o[0] = bflo(yv.x) * sigm_f(v[0]); o[1] = bfhi(yv.x) * sigm_f(v[1]); o[2] = bflo(yv.y) * sigm_f(v[2]); o[3] = bfhi(yv.y) * sigm_f(v[3]);
                    store_bf4(Y + (size_t)row * 1024 + 768 + col, o);
                  });
}

DI void outproj_item(const Params& p, int l, int item, char* smem) {
  const int mt = item >> 3, nt = item & 7;
  const float* MOD = (const float*)(p.ws + OFF_MOD);
  gemm_tile<1, 2>((const bf16_t*)(p.ws + OFF_HY), 1024, (const bf16_t*)(p.ws + OFF_WOUT) + (size_t)l * 1024 * 1024, 1024, 1024, mt * 128, nt * 128, smem, (const float*)(p.ws + OFF_SSQ),
               [&](int row, int col, f32x4 v) {
                 const int s = row < NLAT ? row / T : 2;
                 const f32x4 gt = *(const f32x4*)(MOD + (size_t)(l * 3 + s) * 6144 + 2048 + col);
                 float* xp = row < NLAT ? p.xb + (size_t)row * 1024 + col : (float*)(p.ws + OFF_CTX) + (size_t)(row - NLAT) * 1024 + col;
                 *(f32x4*)xp = *(f32x4*)xp + gt * v;
               });
}
DI void ffnup_item(const Params& p, int l, int item, char* smem) {
  const int mt = item / 44, nt = item % 44;
  bf16_t* UG = (bf16_t*)(p.ws + OFF_R);
  bf16_t* Ts = (bf16_t*)smem;
  const int m0 = mt * 128, n0 = nt * 128;
  gemm_tile<0, 0>((const bf16_t*)(p.ws + OFF_HY), 1024, (const bf16_t*)(p.ws + OFF_WUP) + (size_t)l * 5632 * 1024, 1024, 1024, mt * 128, nt * 128, smem, nullptr,
               [&](int row, int col, f32x4 v) { store_bf4(Ts + (row - m0) * 136 + (col - n0), v); });
  __syncthreads();
  { const int tid = ltid();
#pragma unroll
    for (int i = 0; i < 8; ++i) { const int id = tid + 256 * i, r = id >> 4, c = id & 15; *(u32x4*)(UG + (size_t)(m0 + r) * 5632 + n0 + c * 8) = *(const u32x4*)(Ts + r * 136 + c * 8); } }
  __syncthreads();
}
DI void act_item(const Params& p, int l, int item) {
  bf16_t* UG = (bf16_t*)(p.ws + OFF_R);
  const float* cw = p.ffn_conv_w + (size_t)l * 3 * DFF;
  for (int i = 0; i < 11; ++i) {
    const int id = ltid() + 256 * i, r = id / 352, cc = id % 352, row = item * 8 + r, k = cc * 8;
    int t, tl; if (row < NLAT) { t = row % T; tl = T; } else { t = (row - NLAT) % TC; tl = TC; }
    bf16_t* up = UG + (size_t)row * 5632 + k; const bf16_t* gp = up + DFF;
    const u32x4 z = {0u, 0u, 0u, 0u};
    const u32x4 u = *(const u32x4*)up, g0 = *(const u32x4*)gp, gm = t > 0 ? *(const u32x4*)(gp - 5632) : z, gn = t < tl - 1 ? *(const u32x4*)(gp + 5632) : z;
    const float uf[8] = {bflo(u.x), bfhi(u.x), bflo(u.y), bfhi(u.y), bflo(u.z), bfhi(u.z), bflo(u.w), bfhi(u.w)};
    const float a[8] = {bflo(gm.x), bfhi(gm.x), bflo(gm.y), bfhi(gm.y), bflo(gm.z), bfhi(gm.z), bflo(gm.w), bfhi(gm.w)};
    const float m[8] = {bflo(g0.x), bfhi(g0.x), bflo(g0.y), bfhi(g0.y), bflo(g0.z), bfhi(g0.z), bflo(g0.w), bfhi(g0.w)};
    const float n[8] = {bflo(gn.x), bfhi(gn.x), bflo(gn.y), bfhi(gn.y), bflo(gn.z), bfhi(gn.z), bflo(gn.w), bfhi(gn.w)};
    float o[8];
#pragma unroll
    for (int j = 0; j < 8; ++j) o[j] = silu_f(cw[k + j] * a[j] + cw[DFF + k + j] * m[j] + cw[2 * DFF + k + j] * n[j]) * uf[j];
    u32x4 ov; ov.x = pack2(o[0], o[1]); ov.y = pack2(o[2], o[3]); ov.z = pack2(o[4], o[5]); ov.w = pack2(o[6], o[7]);
    *(u32x4*)up = ov;
  }
}
DI void ffndown_item(const Params& p, int l, int item, char* smem) {
  const int mt = item >> 3, nt = item & 7;
  const float* MOD = (const float*)(p.ws + OFF_MOD);
  gemm_tile<0, 2>((const bf16_t*)(p.ws + OFF_R), 5632, (const bf16_t*)(p.ws + OFF_WDN) + (size_t)l * 1024 * 2816, 2816, 2816, mt * 128, nt * 128, smem, nullptr,
               [&](int row, int col, f32x4 v) {
                 const int s = row < NLAT ? row / T : 2;
                 const f32x4 gt = *(const f32x4*)(MOD + (size_t)(l * 3 + s) * 6144 + 5120 + col);
                 float* xp = row < NLAT ? p.xb + (size_t)row * 1024 + col : (float*)(p.ws + OFF_CTX) + (size_t)(row - NLAT) * 1024 + col;
                 *(f32x4*)xp = *(f32x4*)xp + gt * v;
               });
}
DI void final_item(const Params& p, int item) {
  const int lane = ltid() & 63, w = __builtin_amdgcn_readfirstlane(ltid() >> 6), row = item * 4 + w;
  float* x = p.xb + (size_t)row * 1024;
  float4 v[4]; float ss = 0.f;
#pragma unroll
  for (int i = 0; i < 4; ++i) { v[i] = *(const float4*)(x + (i * 64 + lane) * 4); ss += v[i].x * v[i].x + v[i].y * v[i].y + v[i].z * v[i].z + v[i].w * v[i].w; }
  ss = wave_sum(ss);
  const float rstd = rsqrtf(ss * (1.f / 1024.f) + 1e-6f);
#pragma unroll
  for (int i = 0; i < 4; ++i) {
    const int k = (i * 64 + lane) * 4; const float4 g = *(const float4*)(p.final_norm + k);
    float4 o; o.x = v[i].x * rstd * g.x; o.y = v[i].y * rstd * g.y; o.z = v[i].z * rstd * g.z; o.w = v[i].w * rstd * g.w;
    *(float4*)(x + k) = o;
  }
}

constexpr int PPL = 11;
constexpr int N_PHASES = 2 + NL * PPL;
#define FOR_ITEMS(n) for (int it = blockIdx.x; it < (n); it += gridDim.x)

DI void run_phase(const Params& p, int ph, char* smem) {
  if (ph == 0) { FOR_ITEMS(P0_ITEMS) p0_item(p, it, smem); return; }
  if (ph == N_PHASES - 1) { FOR_ITEMS(NLAT / 4) final_item(p, it); return; }
  const int l = (ph - 1) / PPL, k = (ph - 1) % PPL;
  const int mtiles = (l == NL - 1) ? 128 : 132;
  switch (k) {
    case 0: FOR_ITEMS(NROW / 4) norm_item(p, l, 0, it); break;
    case 1: FOR_ITEMS(132 * 22) gemm_in_item(p, l, it, smem); break;
    case 2: FOR_ITEMS(2112) s5_p1(p, l, it, smem); break;
    case 3: {
      constexpr int n0 = 2112, n1 = n0 + 2112, n2 = n1 + 528, n3 = n2 + 396, n5 = n3 + 66;
      FOR_ITEMS(n5 + 16) {
        if (it < n0) ssd_p1(p, l, it, smem);
        else if (it < n1) mlstm_p1(p, l, it - n0, smem);
        else if (it < n2) kvproj_item(p, l, it - n1, smem);
        else if (it < n3) qproj_item(p, l, it - n2, smem);
        else if (it < n5) ropek_item(p, it - n3);
        else s5_p2(p, l, it - n5);
      }
    } break;
    case 4: {
      constexpr int n0 = 528, n1 = n0 + 512, n2 = n1 + 260;
      FOR_ITEMS(n2) { if (it < n0) s5_p3(p, l, it, smem); else if (it < n1) ssd_p2(p, it - n0); else mlstm_p2(p, it - n1); }
    } break;
    case 5: {
      constexpr int n0 = 528, n2 = n0 + 1056, n3x = n2 + 1056, n3 = n3x + 264;
      const bool late = blockIdx.x >= (gridDim.x >> 1);
      if (!late) { FOR_ITEMS(n0) attn_item(p, it, smem); }
      FOR_ITEMS(n3) {
        if (it < n0) continue;
        if (it < n2) ssd_p3(p, l, it - n0, smem);
        else if (it < n3x) mlstm_p3(p, l, it - n2, smem);
        else glu_item(p, l, it - n3x, smem);
      }
      if (late) { FOR_ITEMS(n0) attn_item(p, it, smem); }
    } break;
    case 6: FOR_ITEMS(mtiles * 8) outproj_item(p, l, it, smem); break;
    case 7: FOR_ITEMS(mtiles * 32) norm_item(p, l, 1, it); break;
    case 8: FOR_ITEMS(mtiles * 44) ffnup_item(p, l, it, smem); break;
    case 9: FOR_ITEMS(mtiles * 16) act_item(p, l, it); break;
    case 10: FOR_ITEMS(mtiles * 8) ffndown_item(p, l, it, smem); break;
  }
}

#ifndef HASH_LO
#define HASH_LO OFF_MOD
#define HASH_HI WS_NEED
#endif
#ifndef PROBE_N
#define PROBE_N 0
#endif
DI void hash_dump(const Params& p) {
  const size_t NOUT = (size_t)NLAT * 1024, nw = (HASH_HI - HASH_LO) / 4;
  const unsigned* wsw = (const unsigned*)(p.ws + HASH_LO);
  for (size_t i = (size_t)blockIdx.x * 256 + threadIdx.x; i < NOUT; i += (size_t)gridDim.x * 256) {
    unsigned h = 12345u;
    for (size_t j = i; j < nw; j += NOUT) h = h * 1664525u + wsw[j];
    p.xb[i] = (float)(h & 0xFFFFFFu);
  }
}

#define XB_TMO      128
#define XB_XCNT(j)  (256  + 64 * (j))
#define XB_XSUB(j)  (1280 + 64 * (j))
#define XB_XGEN(j)  (2304 + 64 * (j))
#define XB_TOP      3328
#define XB_TOPGEN   3392
#define XCD_BAR_WORDS 3456
#define XB_SPIN_CAP (1u << 22)
#define LAS __attribute__((address_space(3)))
DI unsigned xb_ld(unsigned* p) { return __hip_atomic_load(p, __ATOMIC_RELAXED, __HIP_MEMORY_SCOPE_AGENT); }
DI unsigned xb_add(unsigned* p, unsigned v) { return __hip_atomic_fetch_add(p, v, __ATOMIC_RELAXED, __HIP_MEMORY_SCOPE_AGENT); }
DI unsigned xb_xcc_id() { return (unsigned)__builtin_amdgcn_s_getreg((3 << 11) | 20) & 0xFu; }
#define XB_SPIN(cond, bar) do { unsigned _sp = 0; while (cond) { __builtin_amdgcn_s_sleep(1); \
    if ((++_sp & 255u) == 0u) { if (xb_ld(&(bar)[XB_TMO])) break; if (_sp > XB_SPIN_CAP) { atomicAdd(&(bar)[XB_TMO], 1u); break; } } } } while (0)
struct XcdBarrier { unsigned* bar; unsigned x; volatile LAS unsigned* st; };
DI XcdBarrier xcd_barrier_post(unsigned* bar, volatile LAS unsigned* st) {
  XcdBarrier b; b.bar = bar; b.x = xb_xcc_id(); b.st = st;
  if (threadIdx.x == 0) (void)xb_add(&bar[XB_XCNT(b.x)], 1u);
  return b;
}
DI void xcd_barrier_complete(unsigned* bar, unsigned x, unsigned& nloc, unsigned& nx) {
  const unsigned G = gridDim.x;
  unsigned sum, cnt, mine, sp = 0u;
  for (;;) {
    sum = 0u; cnt = 0u; mine = 0u;
#pragma unroll
    for (unsigned j = 0; j < 16; ++j) { const unsigned c = xb_ld(&bar[XB_XCNT(j)]); sum += c; cnt += (c > 0u) ? 1u : 0u; mine = (j == x) ? c : mine; }
    if (sum == G) break;
    __builtin_amdgcn_s_sleep(1);
    if ((++sp & 255u) == 0u) { if (xb_ld(&bar[XB_TMO])) break; if (sp > XB_SPIN_CAP) { atomicAdd(&bar[XB_TMO], 1u); break; } }
  }
  nloc = mine > 0u ? mine : 1u; nx = cnt > 0u ? cnt : 1u;
}
DI void xcd_barrier(const XcdBarrier& b) {
  asm volatile("s_waitcnt vmcnt(0)" ::: "memory");
  __syncthreads();
  if (threadIdx.x == 0) {
    unsigned* bar = b.bar;
    __builtin_amdgcn_s_waitcnt(0);
    unsigned nloc = b.st[0], nx = b.st[1];
    if (nloc == 0u) { xcd_barrier_complete(bar, b.x, nloc, nx); b.st[0] = nloc; b.st[1] = nx; }
    const unsigned old = xb_add(&bar[XB_XSUB(b.x)], 1u);
    const unsigned gen = old / nloc;
    if (old + 1u == (gen + 1u) * nloc) {
      __builtin_amdgcn_fence(__ATOMIC_RELEASE, "agent");
      asm volatile("s_waitcnt vmcnt(0)" ::: "memory");
      const unsigned og = xb_add(&bar[XB_TOP], 1u);
      const unsigned tg = og / nx;
      if (og + 1u == (tg + 1u) * nx) xb_add(&bar[XB_TOPGEN], 1u);
      else XB_SPIN(xb_ld(&bar[XB_TOPGEN]) == tg, bar);
      __builtin_amdgcn_fence(__ATOMIC_ACQUIRE, "agent");
      xb_add(&bar[XB_XGEN(b.x)], 1u);
      asm volatile("s_waitcnt vmcnt(0)" ::: "memory");
    } else {
      XB_SPIN(xb_ld(&bar[XB_XGEN(b.x)]) == gen, bar);
      __builtin_amdgcn_fence(__ATOMIC_ACQUIRE, "agent");
      asm volatile("s_waitcnt vmcnt(0)" ::: "memory");
    }
  }
  __syncthreads();
}
constexpr int SMEM_BYTES = 59392;
__global__ void __launch_bounds__(256, 2) trunk_fwd(Params p) {
  __shared__ __attribute__((aligned(16))) char smem[SMEM_BYTES];
  __shared__ uint4 xb_words;
  cg::grid_group grid = cg::this_grid();
  if (threadIdx.x == 0) xb_words = make_uint4(0u, 0u, 0u, 0u);
  __syncthreads();
  XcdBarrier xb = xcd_barrier_post((unsigned*)(p.ws + OFF_BAR), (volatile LAS unsigned*)&xb_words);
  for (int ph = p.ph_lo; ph < p.ph_hi; ++ph) {
    run_phase(p, ph, smem);
    if (ph + 1 < p.ph_hi) { if (ph == p.ph_lo) grid.sync(); else xcd_barrier(xb); }
  }
}

__global__ void __launch_bounds__(256) hash_kernel(Params p) { hash_dump(p); }

extern "C" void kernel_launch(void* const* d_in, const int* in_sizes, int n_in, void* d_out, int out_size, void* d_ws, size_t ws_size, hipStream_t stream) {
  static int grid_blocks = 0;
  if (!grid_blocks) {
    int dev = 0, cus = 0, per_cu = 0;
    hipGetDevice(&dev);
    hipDeviceGetAttribute(&cus, hipDeviceAttributeMultiprocessorCount, dev);
    hipOccupancyMaxActiveBlocksPerMultiprocessor(&per_cu, trunk_fwd, 256, 0);
    if (per_cu > 2) per_cu = 2;
    grid_blocks = cus * per_cu;
  }
  if (ws_size < OFF_BAR + XCD_BAR_WORDS * 4) { fprintf(stderr, "workspace too small: %zu < %zu\n", ws_size, (size_t)WS_NEED); return; }
  Params p{};
  const float** fp = (const float**)&p;
  for (int i = 0; i < 35; ++i) fp[i] = (const float*)d_in[i];
  p.xb = (float*)d_out; p.ws = (char*)d_ws;
#if MULTI_LAUNCH
#if PROBE_N
  for (int ph = 0; ph < PROBE_N; ++ph) { p.ph_lo = ph; p.ph_hi = ph + 1; hipLaunchKernelGGL(trunk_fwd, dim3(grid_blocks), dim3(256), 0, stream, p); }
  hipLaunchKernelGGL(hash_kernel, dim3(grid_blocks), dim3(256), 0, stream, p);
#else
  for (int ph = 0; ph < N_PHASES; ++ph) { p.ph_lo = ph; p.ph_hi = ph + 1; hipLaunchKernelGGL(trunk_fwd, dim3(grid_blocks), dim3(256), 0, stream, p); }
#endif
#else
  p.ph_lo = 0; p.ph_hi = N_PHASES;
  hipMemsetAsync((char*)d_ws + OFF_BAR, 0, XCD_BAR_WORDS * 4, stream);
  void* args[] = {&p};
  hipError_t e = hipLaunchCooperativeKernel((void*)trunk_fwd, dim3(grid_blocks), dim3(256), args, 0, stream);
  if (e != hipSuccess) fprintf(stderr, "cooperative launch failed: %s (grid %d)\n", hipGetErrorString(e), grid_blocks);
#endif
}
```

```cpp
#include <hip/hip_runtime.h>
#include <hip/hip_cooperative_groups.h>
#include <cstdio>
#include <cstdint>
namespace cg = cooperative_groups;

#ifndef PROBE_MASK
#define PROBE_MASK 63
#endif
#ifndef ZERO_FILL
#define ZERO_FILL 0
#endif
#ifndef MULTI_LAUNCH
#define MULTI_LAUNCH 0
#endif

typedef unsigned short bf16_t;
typedef short bf16x8 __attribute__((ext_vector_type(8)));
typedef float f32x4 __attribute__((ext_vector_type(4)));
typedef unsigned u32x4 __attribute__((ext_vector_type(4)));
typedef unsigned u32x2 __attribute__((ext_vector_type(2)));
#define DI __device__ __forceinline__
#define MFMA16(a, b, c) __builtin_amdgcn_mfma_f32_16x16x32_bf16((a), (b), (c), 0, 0, 0)

constexpr int NB = 2, T = 8192, TC = 256, NL = 4;
constexpr int NLAT = NB * T, NROW = NLAT + NB * TC;
constexpr int TALL = T + TC;
constexpr int PINP = 2816;
constexpr int C_MLQ = 0, C_MLK = 256, C_MLV = 512, C_MLO = 768, C_CQ = 1040, C_CKV = 1296, C_KR = 1424,
              C_Z = 1456, C_XBC = 1712, C_S5 = 2488;
constexpr int NCH = 132;
constexpr int DFF = 2816;

constexpr size_t SZ_WIN = (size_t)NL * 2816 * 1024 * 2, SZ_WUQ = (size_t)NL * 384 * 256 * 2, SZ_WUKV = (size_t)NL * 512 * 128 * 2,
                 SZ_WGLU = (size_t)NL * 256 * 256 * 2, SZ_WOUT = (size_t)NL * 1024 * 1024 * 2, SZ_WUP = (size_t)NL * 5632 * 1024 * 2,
                 SZ_WDN = (size_t)NL * 1024 * 2816 * 2, SZ_MOD = (size_t)NL * 3 * 6144 * 4, SZ_CTX = (size_t)512 * 1024 * 4,
                 SZ_HY = (size_t)NROW * 1024 * 2, SZ_GML = (size_t)NROW * 16 * 4, SZ_DTR = (size_t)NROW * 8 * 4, SZ_SSQ = (size_t)NROW * 4 * 4,
                 SZ_QRAW = (size_t)NROW * 384 * 2, SZ_KH = (size_t)NB * 4 * TALL * 64 * 2 + (size_t)NB * TALL * 32 * 2, SZ_VT = (size_t)NB * 4 * 64 * TALL * 2,
                 SZ_S5S = (size_t)NB * 16 * 2 * NCH * 128 * 4, SZ_MLM = (size_t)16 * NCH * 32 * 4, SZ_SSA = (size_t)16 * NCH * 32 * 4,
                 SZ_P = (size_t)NROW * PINP * 2, SZ_MLS = (size_t)16 * NCH * 4160 * 4, SZ_SSDS = (size_t)16 * NCH * 8192 * 4;
constexpr size_t OFF_WIN = 0, OFF_WUQ = OFF_WIN + SZ_WIN, OFF_WUKV = OFF_WUQ + SZ_WUQ, OFF_WGLU = OFF_WUKV + SZ_WUKV,
                 OFF_WOUT = OFF_WGLU + SZ_WGLU, OFF_WUP = OFF_WOUT + SZ_WOUT, OFF_WDN = OFF_WUP + SZ_WUP, OFF_MOD = OFF_WDN + SZ_WDN,
                 OFF_CTX = OFF_MOD + SZ_MOD, OFF_HY = OFF_CTX + SZ_CTX, OFF_GML = OFF_HY + SZ_HY, OFF_DTR = OFF_GML + SZ_GML,
                 OFF_SSQ = OFF_DTR + SZ_DTR, OFF_QRAW = OFF_SSQ + SZ_SSQ, OFF_KH = OFF_QRAW + SZ_QRAW, OFF_VT = OFF_KH + SZ_KH,
                 OFF_S5S = OFF_VT + SZ_VT, OFF_MLM = OFF_S5S + SZ_S5S, OFF_SSA = OFF_MLM + SZ_MLM,
                 OFF_R = ((OFF_SSA + SZ_SSA + 255) / 256) * 256, OFF_P = OFF_R, OFF_MLS = OFF_P + SZ_P, OFF_SSDS = OFF_MLS + SZ_MLS,
                 WS_NEED = OFF_SSDS + SZ_SSDS;
static_assert((size_t)NROW * 5632 * 2 <= SZ_P + SZ_MLS + SZ_SSDS, "UG overlay");

constexpr size_t OFF_KR = OFF_KH + (size_t)NB * 4 * TALL * 64 * 2;
constexpr size_t OFF_YG = ((WS_NEED + 255) / 256) * 256;
constexpr size_t OFF_BAR = OFF_YG + (size_t)NROW * 256 * 2;
struct Params {
  const float *x, *c, *ctx, *c_ctx, *w_mod, *b_mod, *norm1, *norm2, *w_in, *ml_gate_bias, *ml_norm, *mla_q_norm, *mla_kv_norm,
      *mla_w_uq, *mla_w_ukv, *ssd_conv_w, *ssd_conv_b, *ssd_a_log, *ssd_dt_bias, *ssd_d, *ssd_norm, *s5_a_re, *s5_a_im, *s5_log_dt,
      *s5_b_re, *s5_b_im, *s5_c_re, *s5_c_im, *s5_d, *s5_w_glu, *w_out, *ffn_w_up, *ffn_conv_w, *ffn_w_down, *final_norm;
  float* xb;
  char* ws;
  int ph_lo, ph_hi;
};

typedef __bf16 hbf16x2 __attribute__((ext_vector_type(2)));
typedef float f32x2 __attribute__((ext_vector_type(2)));
DI bf16_t f2bf(float x) { return __builtin_bit_cast(bf16_t, (__bf16)x); }
DI float bf2f(bf16_t v) { return __uint_as_float(((unsigned)v) << 16); }
DI unsigned pack2(float lo, float hi) { f32x2 v = {lo, hi}; return __builtin_bit_cast(unsigned, __builtin_convertvector(v, hbf16x2)); }
DI float bflo(unsigned w) { return __uint_as_float(w << 16); }
DI float bfhi(unsigned w) { return __uint_as_float(w & 0xffff0000u); }
DI float silu_f(float x) { return x / (1.f + __expf(-x)); }
DI float sigm_f(float x) { return 1.f / (1.f + __expf(-x)); }
DI float softplus_f(float x) { return fmaxf(x, 0.f) + log1pf(__expf(-fabsf(x))); }
DI float logsigm_f(float x) { return fminf(x, 0.f) - log1pf(__expf(-fabsf(x))); }
DI float gelu_tanh_f(float x) { float u = 0.7978845608f * (x + 0.044715f * x * x * x); return x * sigm_f(2.f * u); }
DI float wave_sum(float v) { for (int o = 32; o; o >>= 1) v += __shfl_xor(v, o); return v; }
DI float wave_max(float v) { for (int o = 32; o; o >>= 1) v = fmaxf(v, __shfl_xor(v, o)); return v; }
DI float wave_incl_scan(float v, int lane) { for (int o = 1; o < 64; o <<= 1) { float t = __shfl_up(v, o); if (lane >= o) v += t; } return v; }
DI float red16_max(float v) { v = fmaxf(v, __shfl_xor(v, 1)); v = fmaxf(v, __shfl_xor(v, 2)); v = fmaxf(v, __shfl_xor(v, 4)); v = fmaxf(v, __shfl_xor(v, 8)); return v; }
DI float red16_sum(float v) { v += __shfl_xor(v, 1); v += __shfl_xor(v, 2); v += __shfl_xor(v, 4); v += __shfl_xor(v, 8); return v; }
DI bf16x8 ld_frag(const bf16_t* p) { return *(const bf16x8*)p; }
DI bf16x8 mk_frag(unsigned a, unsigned b, unsigned c, unsigned d) { u32x4 u = {a, b, c, d}; return __builtin_bit_cast(bf16x8, u); }
DI bf16x8 frag_from_f32(const float* p, float sgn) {
  float4 a = *(const float4*)p, b = *(const float4*)(p + 4);
  return mk_frag(pack2(a.x * sgn, a.y * sgn), pack2(a.z * sgn, a.w * sgn), pack2(b.x * sgn, b.y * sgn), pack2(b.z * sgn, b.w * sgn));
}
DI int ltid() { int t = threadIdx.x; asm volatile("" : "+v"(t)); return t; }
DI int row_of(int b, int part, int t) { return part ? NLAT + b * TC + t : b * T + t; }

DI void tr_tile(const float* __restrict__ src, int K, int N, bf16_t* __restrict__ dst, const float* gain, int glo, int ghi, int tk, int tn, float* tile, int drow0 = -1) {
  const int tid = ltid(), c4 = tid & 15, rq = tid >> 4;
  const bool vec = (N & 3) == 0;
#pragma unroll
  for (int rr = 0; rr < 4; ++rr) {
    const int r = rr * 16 + rq, k = tk * 64 + r, n = tn * 64 + c4 * 4;
    float4 v;
    if (vec && n + 3 < N) v = *(const float4*)(src + (size_t)k * N + n);
    else { v.x = n < N ? src[(size_t)k * N + n] : 0.f; v.y = n + 1 < N ? src[(size_t)k * N + n + 1] : 0.f; v.z = n + 2 < N ? src[(size_t)k * N + n + 2] : 0.f; v.w = n + 3 < N ? src[(size_t)k * N + n + 3] : 0.f; }
    if (gain && k >= glo && k < ghi) { const float g = gain[k - glo]; v.x *= g; v.y *= g; v.z *= g; v.w *= g; }
    *(float4*)(tile + r * 68 + c4 * 4) = v;
  }
  __syncthreads();
#pragma unroll
  for (int q = 0; q < 2; ++q) {
    const int id = tid + 256 * q, n = id >> 3, k0 = (id & 7) * 8;
    u32x4 o;
    o.x = pack2(tile[(k0 + 0) * 68 + n], tile[(k0 + 1) * 68 + n]); o.y = pack2(tile[(k0 + 2) * 68 + n], tile[(k0 + 3) * 68 + n]);
    o.z = pack2(tile[(k0 + 4) * 68 + n], tile[(k0 + 5) * 68 + n]); o.w = pack2(tile[(k0 + 6) * 68 + n], tile[(k0 + 7) * 68 + n]);
    *(u32x4*)(dst + (size_t)((drow0 >= 0 ? drow0 : tn * 64) + n) * K + tk * 64 + k0) = o;
  }
  __syncthreads();
}

constexpr int TR_PER_LAYER = 3128, P0_TR = NL * TR_PER_LAYER, P0_MOD = NL * 96, P0_CPX = NLAT * 1024 / 4096, P0_CPC = 512 * 1024 / 4096;
constexpr int P0_ZERO = (int)((WS_NEED - OFF_HY + 65535) / 65536);
constexpr int P0_ITEMS = P0_TR + P0_MOD + P0_CPX + P0_CPC + (ZERO_FILL ? P0_ZERO : 0);

DI void p0_item(const Params& p, int item, char* smem) {
  const int tid = ltid();
  if (item < P0_MOD) {
    const int l = item / 96, cb = item % 96, cl = tid & 63, kq = tid >> 6;
    float* sv = (float*)smem;
    float* red = sv + 3072;
    for (int i = tid; i < 1024; i += 256) { sv[i] = silu_f(p.c[i]); sv[1024 + i] = silu_f(p.c[1024 + i]); sv[2048 + i] = silu_f(p.c_ctx[i]); }
    __syncthreads();
    const int col = cb * 64 + cl; const float* W = p.w_mod + (size_t)l * 1024 * 6144 + col;
    float a0 = 0.f, a1 = 0.f, a2 = 0.f;
#pragma unroll 16
    for (int k = kq * 256; k < kq * 256 + 256; ++k) { const float w = W[(size_t)k * 6144]; a0 += sv[k] * w; a1 += sv[1024 + k] * w; a2 += sv[2048 + k] * w; }
    red[(kq * 3 + 0) * 64 + cl] = a0; red[(kq * 3 + 1) * 64 + cl] = a1; red[(kq * 3 + 2) * 64 + cl] = a2;
    __syncthreads();
    if (tid < 192) {
      const int s = tid >> 6; const float bm = p.b_mod[l * 6144 + col];
      const float v = red[(0 * 3 + s) * 64 + cl] + red[(1 * 3 + s) * 64 + cl] + red[(2 * 3 + s) * 64 + cl] + red[(3 * 3 + s) * 64 + cl] + bm;
      ((float*)(p.ws + OFF_MOD))[(size_t)(l * 3 + s) * 6144 + col] = v;
    }
    __syncthreads();
    return;
  }
  item -= P0_MOD;
  if (item < P0_TR) {
    const int l = item / TR_PER_LAYER; int t = item % TR_PER_LAYER; float* tile = (float*)smem;
    if (t < 704) { tr_tile(p.w_in + (size_t)l * 1024 * 2744, 1024, 2744, (bf16_t*)(p.ws + OFF_WIN) + (size_t)l * 2816 * 1024, nullptr, 0, 0, t / 44, t % 44, tile); return; }
    t -= 704;
    if (t < 24) { tr_tile(p.mla_w_uq + (size_t)l * 256 * 384, 256, 384, (bf16_t*)(p.ws + OFF_WUQ) + (size_t)l * 384 * 256, p.mla_q_norm + l * 256, 0, 256, t / 6, t % 6, tile); return; }
    t -= 24;
    if (t < 16) { tr_tile(p.mla_w_ukv + (size_t)l * 128 * 512, 128, 512, (bf16_t*)(p.ws + OFF_WUKV) + (size_t)l * 512 * 128, p.mla_kv_norm + l * 128, 0, 128, t / 8, t % 8, tile); return; }
    t -= 16;
    if (t < 16) { tr_tile(p.s5_w_glu + (size_t)l * 256 * 256, 256, 256, (bf16_t*)(p.ws + OFF_WGLU) + (size_t)l * 256 * 256, nullptr, 0, 0, t / 4, t % 4, tile); return; }
    t -= 16;
    if (t < 256) { tr_tile(p.w_out + (size_t)l * 1024 * 1024, 1024, 1024, (bf16_t*)(p.ws + OFF_WOUT) + (size_t)l * 1024 * 1024, p.ssd_norm + l * 256, 512, 768, t / 16, t % 16, tile); return; }
    t -= 256;
    if (t < 1408) { tr_tile(p.ffn_w_up + (size_t)l * 1024 * 5632, 1024, 5632, (bf16_t*)(p.ws + OFF_WUP) + (size_t)l * 5632 * 1024, nullptr, 0, 0, t / 88, t % 88, tile, (t % 88) < 44 ? (t % 88) * 128 : ((t % 88) - 44) * 128 + 64); return; }
    t -= 1408;
    tr_tile(p.ffn_w_down + (size_t)l * 2816 * 1024, 2816, 1024, (bf16_t*)(p.ws + OFF_WDN) + (size_t)l * 1024 * 2816, nullptr, 0, 0, t / 16, t % 16, tile);
    return;
  }
  item -= P0_TR;
  if (item >= P0_CPX + P0_CPC) {
    item -= P0_CPX + P0_CPC;
    char* z = p.ws + OFF_HY + (size_t)item * 65536;
    const size_t lim = WS_NEED - OFF_HY - (size_t)item * 65536;
    for (int i = 0; i < 16; ++i) { const size_t o = (size_t)(i * 256 + tid) * 16; if (o < lim) *(u32x4*)(z + o) = (u32x4){0u, 0u, 0u, 0u}; }
    return;
  }
  const float* src; float* dst;
  if (item < P0_CPX) { src = p.x + (size_t)item * 4096; dst = p.xb + (size_t)item * 4096; }
  else { item -= P0_CPX; src = p.ctx + (size_t)item * 4096; dst = (float*)(p.ws + OFF_CTX) + (size_t)item * 4096; }
  for (int i = 0; i < 4; ++i) { const int o = (i * 256 + tid) * 4; *(float4*)(dst + o) = *(const float4*)(src + o); }
}

DI void norm_item(const Params& p, int l, int which, int item) {
  const int lane = ltid() & 63, w = __builtin_amdgcn_readfirstlane(ltid() >> 6), row = item * 4 + w;
  const float* x = row < NLAT ? p.xb + (size_t)row * 1024 : (const float*)(p.ws + OFF_CTX) + (size_t)(row - NLAT) * 1024;
  float4 v[4]; float ss = 0.f;
#pragma unroll
  for (int i = 0; i < 4; ++i) { v[i] = *(const float4*)(x + (i * 64 + lane) * 4); ss += v[i].x * v[i].x + v[i].y * v[i].y + v[i].z * v[i].z + v[i].w * v[i].w; }
  ss = wave_sum(ss);
  const float rstd = rsqrtf(ss * (1.f / 1024.f) + 1e-6f);
  const int s = row < NLAT ? row / T : 2;
  const float* g = (which ? p.norm2 : p.norm1) + l * 1024;
  const float* md = (const float*)(p.ws + OFF_MOD) + (size_t)(l * 3 + s) * 6144 + (which ? 3072 : 0);
  bf16_t* H = (bf16_t*)(p.ws + OFF_HY) + (size_t)row * 1024;
#pragma unroll
  for (int i = 0; i < 4; ++i) {
    const int k = (i * 64 + lane) * 4;
    const float4 g4 = *(const float4*)(g + k), sh = *(const float4*)(md + k), sc = *(const float4*)(md + 1024 + k);
    u32x2 o; o.x = pack2(v[i].x * rstd * g4.x * (1.f + sc.x) + sh.x, v[i].y * rstd * g4.y * (1.f + sc.y) + sh.y);
    o.y = pack2(v[i].z * rstd * g4.z * (1.f + sc.z) + sh.z, v[i].w * rstd * g4.w * (1.f + sc.w) + sh.w);
    *(u32x2*)(H + k) = o;
  }
}

DI u32x4 scale_bf8(u32x4 q, float s) {
  q.x = pack2(bflo(q.x) * s, bfhi(q.x) * s); q.y = pack2(bflo(q.y) * s, bfhi(q.y) * s);
  q.z = pack2(bflo(q.z) * s, bfhi(q.z) * s); q.w = pack2(bflo(q.w) * s, bfhi(q.w) * s); return q;
}
#define GEMM_STEP(AR, BR, KT)                                                                                         \
  {                                                                                                                   \
    if (AMODE == 1 && (KT) >= 8 && (KT) < 12) {                                                                       \
      _Pragma("unroll") for (int i = 0; i < 4; ++i) AR[i] = scale_bf8(AR[i], rs[i]);                                  \
    }                                                                                                                 \
    _Pragma("unroll") for (int i = 0; i < 4; ++i) { *(u32x4*)(As + (r0 + 32 * i) * 72 + cc * 8) = AR[i]; *(u32x4*)(Bs + (r0 + 32 * i) * 72 + cc * 8) = BR[i]; } \
    __syncthreads();                                                                                                  \
    if ((KT) + 2 < nk) {                                                                                              \
      _Pragma("unroll") for (int i = 0; i < 4; ++i) { AR[i] = *(const u32x4*)((CLAMP ? apx[i] : ap + i * astep) + ((KT) + 2) * 64); BR[i] = *(const u32x4*)(bp + i * bstep + ((KT) + 2) * 64); } \
    }                                                                                                                 \
    __builtin_amdgcn_sched_barrier(0);                                                                                \
    _Pragma("unroll") for (int ks = 0; ks < 2; ++ks) {                                                                \
      bf16x8 af[4], bfr[4];                                                                                           \
      _Pragma("unroll") for (int i = 0; i < 4; ++i) { af[i] = ld_frag(As + (64 * wm + 16 * i + l15) * 72 + ks * 32 + g4 * 8); bfr[i] = ld_frag(Bs + (64 * wn + 16 * i + l15) * 72 + ks * 32 + g4 * 8); } \
      _Pragma("unroll") for (int i = 0; i < 4; ++i)                                                                   \
        _Pragma("unroll") for (int j = 0; j < 4; ++j) acc[i][j] = MFMA16(bfr[j], af[i], acc[i][j]);                   \
    }                                                                                                                 \
    __syncthreads();                                                                                                  \
  }
template <int AMODE, int STAGE, class Epi, int CLAMP = 0>
DI void gemm_tile(const bf16_t* __restrict__ A, int lda, const bf16_t* __restrict__ Bt, int ldb, int K, int m0, int n0, char* smem, const float* ssq, Epi epi, int rlo = 0, int rhi = 0) {
  bf16_t* As = (bf16_t*)smem; bf16_t* Bs = As + 128 * 72;
  const int tid = ltid(), lane = tid & 63, w = __builtin_amdgcn_readfirstlane(tid >> 6), wm = w >> 1, wn = w & 1, l15 = lane & 15, g4 = lane >> 4;
  u32x4 ar0[4], br0[4], ar1[4], br1[4]; float rs[4];
  const int r0 = tid >> 3, cc = tid & 7;
  const bf16_t* ap = A + (size_t)(m0 + r0) * lda + cc * 8;
  const bf16_t* bp = Bt + (size_t)(n0 + r0) * ldb + cc * 8;
  const size_t astep = (size_t)32 * lda, bstep = (size_t)32 * ldb;
  const bf16_t* apx[4];
  if (CLAMP) {
#pragma unroll
    for (int i = 0; i < 4; ++i) { int r = m0 + r0 + 32 * i; r = r < rlo ? rlo : (r > rhi ? rhi : r); apx[i] = A + (size_t)r * lda + cc * 8; }
  }
  if (AMODE == 1) {
#pragma unroll
    for (int i = 0; i < 4; ++i) { const float* q = ssq + (m0 + r0 + 32 * i); rs[i] = rsqrtf((q[0] + q[NROW] + q[2 * NROW] + q[3 * NROW]) * (1.f / 256.f) + 1e-6f); }
  }
  f32x4 acc[4][4];
#pragma unroll
  for (int i = 0; i < 4; ++i)
#pragma unroll
    for (int j = 0; j < 4; ++j) acc[i][j] = (f32x4){0.f, 0.f, 0.f, 0.f};
  const int nk = K >> 6;
#pragma unroll
  for (int i = 0; i < 4; ++i) { ar0[i] = *(const u32x4*)(CLAMP ? apx[i] : ap + i * astep); br0[i] = *(const u32x4*)(bp + i * bstep); }
#pragma unroll
  for (int i = 0; i < 4; ++i) { ar1[i] = *(const u32x4*)((CLAMP ? apx[i] : ap + i * astep) + 64); br1[i] = *(const u32x4*)(bp + i * bstep + 64); }
  for (int kt = 0; kt < nk; kt += 2) {
    GEMM_STEP(ar0, br0, kt)
    GEMM_STEP(ar1, br1, kt + 1)
  }
  if (STAGE == 2) {
    float* Tf = (float*)smem;
#pragma unroll
    for (int h = 0; h < 2; ++h) {
      if (wm == h) {
#pragma unroll
        for (int i = 0; i < 4; ++i)
#pragma unroll
          for (int j = 0; j < 4; ++j) *(f32x4*)(Tf + (16 * i + l15) * 132 + 64 * wn + 16 * j + 4 * g4) = acc[i][j];
      }
      __syncthreads();
#pragma unroll
      for (int q = 0; q < 8; ++q) { const int id = tid + 256 * q, r = id >> 5, c = id & 31; epi(m0 + 64 * h + r, n0 + c * 4, *(const f32x4*)(Tf + r * 132 + c * 4)); }
      __syncthreads();
    }
    return;
  }
#pragma unroll
  for (int i = 0; i < 4; ++i)
#pragma unroll
    for (int j = 0; j < 4; ++j) epi(m0 + 64 * wm + 16 * i + l15, n0 + 64 * wn + 16 * j + 4 * g4, acc[i][j]);
}

DI void store_bf4(bf16_t* dst, f32x4 v) { u32x2 o; o.x = pack2(v[0], v[1]); o.y = pack2(v[2], v[3]); *(u32x2*)dst = o; }

DI void gemm_in_item(const Params& p, int l, int item, char* smem) {
  const int mt = item / 22, nt = item % 22;
  bf16_t* P = (bf16_t*)(p.ws + OFF_P); float* GML = (float*)(p.ws + OFF_GML); float* DTR = (float*)(p.ws + OFF_DTR);
  bf16_t* Ts = (bf16_t*)smem;
  const int m0 = mt * 128, n0 = nt * 128;
  gemm_tile<0, 0>((const bf16_t*)(p.ws + OFF_HY), 1024, (const bf16_t*)(p.ws + OFF_WIN) + (size_t)l * 2816 * 1024, 1024, 1024, mt * 128, nt * 128, smem, nullptr,
               [&](int row, int col, f32x4 v) {
                 store_bf4(Ts + (row - m0) * 136 + (col - n0), v);
                 if (col >= 1024 && col < 1040) *(f32x4*)(GML + (size_t)row * 16 + (col - 1024)) = v;
                 if (col >= 2480 && col < 2488) *(f32x4*)(DTR + (size_t)row * 8 + (col - 2480)) = v;
               });
  __syncthreads();
  { const int tid = ltid();
#pragma unroll
    for (int i = 0; i < 8; ++i) { const int id = tid + 256 * i, r = id >> 4, c = id & 15; *(u32x4*)(P + (size_t)(m0 + r) * PINP + n0 + c * 8) = *(const u32x4*)(Ts + r * 136 + c * 8); } }
  __syncthreads();
}

DI void tile_rstd(const bf16_t* P, int m0, int col0, int ncols, float* rst) {
  const int tid = ltid(), r = tid >> 1, hf = tid & 1, n = ncols >> 1;
  const bf16_t* src = P + (size_t)(m0 + r) * PINP + col0 + hf * n;
  float ss = 0.f;
  for (int c = 0; c < n; c += 8) { const u32x4 q = *(const u32x4*)(src + c);
    ss += bflo(q.x) * bflo(q.x) + bfhi(q.x) * bfhi(q.x) + bflo(q.y) * bflo(q.y) + bfhi(q.y) * bfhi(q.y) + bflo(q.z) * bflo(q.z) + bfhi(q.z) * bfhi(q.z) + bflo(q.w) * bflo(q.w) + bfhi(q.w) * bfhi(q.w); }
  ss += __shfl_xor(ss, 1);
  if (hf == 0) rst[r] = rsqrtf(ss / (float)ncols + 1e-6f);
  __syncthreads();
}
DI void qproj_item(const Params& p, int l, int item, char* smem) {
  const int mt = item / 3, nt = item % 3; const bf16_t* P = (const bf16_t*)(p.ws + OFF_P);
  float* rst = (float*)(smem + 36864);
  tile_rstd(P, mt * 128, C_CQ, 256, rst);
  bf16_t* Q = (bf16_t*)(p.ws + OFF_QRAW);
  gemm_tile<0, 0>(P + C_CQ, PINP, (const bf16_t*)(p.ws + OFF_WUQ) + (size_t)l * 384 * 256, 256, 256, mt * 128, nt * 128, smem, nullptr,
               [&](int row, int col, f32x4 v) { const float r = rst[row - mt * 128]; store_bf4(Q + (size_t)row * 384 + col, v * r); });
  __syncthreads();
}
DI void kvproj_item(const Params& p, int l, int item, char* smem) {
  const int mt = item / 4, nt = item % 4; const bf16_t* P = (const bf16_t*)(p.ws + OFF_P);
  float* rst = (float*)(smem + 36864);
  tile_rstd(P, mt * 128, C_CKV, 128, rst);
  bf16_t* KH = (bf16_t*)(p.ws + OFF_KH); bf16_t* VT = (bf16_t*)(p.ws + OFF_VT);
  gemm_tile<0, 0>(P + C_CKV, PINP, (const bf16_t*)(p.ws + OFF_WUKV) + (size_t)l * 512 * 128, 128, 128, mt * 128, nt * 128, smem, nullptr,
               [&](int row, int col, f32x4 v) {
                 const float r = rst[row - mt * 128]; v = v * r;
                 const int hh = col >> 7, dd = col & 127;
                 int b, tpos; if (row < NLAT) { b = row / T; tpos = row % T; } else { b = (row - NLAT) / TC; tpos = T + (row - NLAT) % TC; }
                 if (dd < 64) store_bf4(KH + ((size_t)(b * 4 + hh) * TALL + tpos) * 64 + dd, v);
                 else {
                   bf16_t* vp = VT + ((size_t)(b * 4 + hh) * 64 + (dd - 64)) * TALL + tpos;
                   vp[0] = f2bf(v[0]); vp[TALL] = f2bf(v[1]); vp[2 * TALL] = f2bf(v[2]); vp[3 * TALL] = f2bf(v[3]);
                 }
               });
  __syncthreads();
}
DI void rope_cs(int t, int i, float& cs, float& sn) {
  const int pos = (i < 8) ? (t >> 6) : (t & 63); const int f = i & 7;
  const float inv = exp2f(-(float)f * (13.287712379549449f / 8.f));
  const float ang = (float)pos * inv;
  cs = cosf(ang); sn = sinf(ang);
}
DI void ropek_item(const Params& p, int item) {
  const int row = item * 256 + ltid();
  const bf16_t* src = (const bf16_t*)(p.ws + OFF_P) + (size_t)row * PINP + C_KR;
  u32x4 q[4];
#pragma unroll
  for (int i = 0; i < 4; ++i) q[i] = *(const u32x4*)(src + i * 8);
  float v[32];
#pragma unroll
  for (int i = 0; i < 4; ++i) { v[i * 8 + 0] = bflo(q[i].x); v[i * 8 + 1] = bfhi(q[i].x); v[i * 8 + 2] = bflo(q[i].y); v[i * 8 + 3] = bfhi(q[i].y);
    v[i * 8 + 4] = bflo(q[i].z); v[i * 8 + 5] = bfhi(q[i].z); v[i * 8 + 6] = bflo(q[i].w); v[i * 8 + 7] = bfhi(q[i].w); }
  int b, tpos;
  if (row < NLAT) {
    b = row / T; tpos = row % T;
#pragma unroll
    for (int i = 0; i < 16; ++i) { float cs, sn; rope_cs(tpos, i, cs, sn); const float x1 = v[i], x2 = v[i + 16]; v[i] = x1 * cs - x2 * sn; v[i + 16] = x1 * sn + x2 * cs; }
  } else { b = (row - NLAT) / TC; tpos = T + (row - NLAT) % TC; }
  u32x4 o[4];
#pragma unroll
  for (int i = 0; i < 4; ++i) { o[i].x = pack2(v[i * 8], v[i * 8 + 1]); o[i].y = pack2(v[i * 8 + 2], v[i * 8 + 3]); o[i].z = pack2(v[i * 8 + 4], v[i * 8 + 5]); o[i].w = pack2(v[i * 8 + 6], v[i * 8 + 7]); }
  bf16_t* dst = (bf16_t*)(p.ws + OFF_KR) + ((size_t)b * TALL + tpos) * 32;
#pragma unroll
  for (int i = 0; i < 4; ++i) *(u32x4*)(dst + i * 8) = o[i];
}

DI void attn_item(const Params& p, int item, char* smem) {
  const int tid = ltid(), lane = tid & 63, w = __builtin_amdgcn_readfirstlane(tid >> 6), l15 = lane & 15, g4 = lane >> 4;
  int b, h, qt, latent;
  if (item < 512) { latent = 1; qt = item & 63; h = (item >> 6) & 3; b = item >> 8; }
  else { latent = 0; const int i2 = item - 512; qt = i2 & 1; h = (i2 >> 1) & 3; b = i2 >> 3; }
  const int qrow0 = latent ? b * T + qt * 128 : NLAT + b * TC + qt * 128;
  bf16_t* Qs = (bf16_t*)smem;
  bf16_t* Ks = (bf16_t*)smem;
  bf16_t* Vs = Ks + 64 * 104;
  const bf16_t* Qraw = (const bf16_t*)(p.ws + OFF_QRAW);
  const float qscale = 0.10206207261596577f * 1.4426950408889634f;
  for (int id = tid; id < 1280; id += 256) {
    const int r = id / 10, cc = id % 10;
    const bf16_t* src = Qraw + (size_t)(qrow0 + r) * 384 + h * 96 + cc * 8;
    const u32x4 q = *(const u32x4*)src;
    float a[8] = {bflo(q.x), bfhi(q.x), bflo(q.y), bfhi(q.y), bflo(q.z), bfhi(q.z), bflo(q.w), bfhi(q.w)};
    if (cc < 8) {
      u32x4 o; o.x = pack2(a[0] * qscale, a[1] * qscale); o.y = pack2(a[2] * qscale, a[3] * qscale); o.z = pack2(a[4] * qscale, a[5] * qscale); o.w = pack2(a[6] * qscale, a[7] * qscale);
      *(u32x4*)(Qs + r * 104 + cc * 8) = o;
    } else {
      const u32x4 q2 = *(const u32x4*)(src + 16);
      float c2[8] = {bflo(q2.x), bfhi(q2.x), bflo(q2.y), bfhi(q2.y), bflo(q2.z), bfhi(q2.z), bflo(q2.w), bfhi(q2.w)};
      float o1[8], o2[8];
#pragma unroll
      for (int j = 0; j < 8; ++j) {
        float cs = 1.f, sn = 0.f;
        if (latent) rope_cs(qt * 128 + r, (cc - 8) * 8 + j, cs, sn);
        o1[j] = (a[j] * cs - c2[j] * sn) * qscale; o2[j] = (a[j] * sn + c2[j] * cs) * qscale;
      }
      u32x4 o; o.x = pack2(o1[0], o1[1]); o.y = pack2(o1[2], o1[3]); o.z = pack2(o1[4], o1[5]); o.w = pack2(o1[6], o1[7]);
      *(u32x4*)(Qs + r * 104 + cc * 8) = o;
      o.x = pack2(o2[0], o2[1]); o.y = pack2(o2[2], o2[3]); o.z = pack2(o2[4], o2[5]); o.w = pack2(o2[6], o2[7]);
      *(u32x4*)(Qs + r * 104 + cc * 8 + 16) = o;
    }
  }
  __syncthreads();
  bf16x8 qf[2][3];
#pragma unroll
  for (int qs = 0; qs < 2; ++qs)
#pragma unroll
    for (int ks = 0; ks < 3; ++ks) qf[qs][ks] = ld_frag(Qs + (32 * w + 16 * qs + l15) * 104 + ks * 32 + g4 * 8);
  __syncthreads();
  const int kt0 = latent ? 0 : 128, kt1 = 132;
  const bf16_t* Kg = (const bf16_t*)(p.ws + OFF_KH) + (size_t)(b * 4 + h) * TALL * 64;
  const bf16_t* Rg = (const bf16_t*)(p.ws + OFF_KR) + (size_t)b * TALL * 32;
  const bf16_t* Vg = (const bf16_t*)(p.ws + OFF_VT) + (size_t)(b * 4 + h) * 64 * TALL;
  u32x4 kr[3], vr[2];
  const int ve0 = tid >> 3, vc = tid & 7;
  {
    kr[0] = *(const u32x4*)(Kg + (size_t)kt0 * 4096 + tid * 8); kr[1] = *(const u32x4*)(Kg + (size_t)kt0 * 4096 + (tid + 256) * 8);
    kr[2] = *(const u32x4*)(Rg + (size_t)kt0 * 2048 + tid * 8);
#pragma unroll
    for (int i = 0; i < 2; ++i) vr[i] = *(const u32x4*)(Vg + (size_t)(ve0 + 32 * i) * TALL + kt0 * 64 + vc * 8);
  }
  float mrun[2] = {-1e30f, -1e30f}, lsum[2] = {0.f, 0.f};
  f32x4 O[4][2];
#pragma unroll
  for (int es = 0; es < 4; ++es)
#pragma unroll
    for (int qs = 0; qs < 2; ++qs) O[es][qs] = (f32x4){0.f, 0.f, 0.f, 0.f};
  constexpr int KVB = 64 * 104 + 64 * 72;
  {
#pragma unroll
    for (int i = 0; i < 2; ++i) { const int id = tid + 256 * i; *(u32x4*)(Ks + (id >> 3) * 104 + (id & 7) * 8) = kr[i]; }
    *(u32x4*)(Ks + (tid >> 2) * 104 + 64 + (tid & 3) * 8) = kr[2];
#pragma unroll
    for (int i = 0; i < 2; ++i) *(u32x4*)(Vs + (ve0 + 32 * i) * 72 + vc * 8) = vr[i];
    if (kt0 + 1 < kt1) {
      kr[0] = *(const u32x4*)(Kg + (size_t)(kt0 + 1) * 4096 + tid * 8); kr[1] = *(const u32x4*)(Kg + (size_t)(kt0 + 1) * 4096 + (tid + 256) * 8);
      kr[2] = *(const u32x4*)(Rg + (size_t)(kt0 + 1) * 2048 + tid * 8);
#pragma unroll
      for (int i = 0; i < 2; ++i) vr[i] = *(const u32x4*)(Vg + (size_t)(ve0 + 32 * i) * TALL + (kt0 + 1) * 64 + vc * 8);
    }
    __syncthreads();
  }
  for (int kt = kt0; kt < kt1; ++kt) {
    const int cur = (kt - kt0) & 1;
    const bf16_t* Kc = Ks + cur * KVB; const bf16_t* Vc = Vs + cur * KVB;
    bf16_t* Kn = Ks + (cur ^ 1) * KVB; bf16_t* Vn = Vs + (cur ^ 1) * KVB;
    if (kt + 1 < kt1) {
#pragma unroll
      for (int i = 0; i < 2; ++i) { const int id = tid + 256 * i; *(u32x4*)(Kn + (id >> 3) * 104 + (id & 7) * 8) = kr[i]; }
      *(u32x4*)(Kn + (tid >> 2) * 104 + 64 + (tid & 3) * 8) = kr[2];
#pragma unroll
      for (int i = 0; i < 2; ++i) *(u32x4*)(Vn + (ve0 + 32 * i) * 72 + vc * 8) = vr[i];
    }
    if (kt + 2 < kt1) {
      kr[0] = *(const u32x4*)(Kg + (size_t)(kt + 2) * 4096 + tid * 8); kr[1] = *(const u32x4*)(Kg + (size_t)(kt + 2) * 4096 + (tid + 256) * 8);
      kr[2] = *(const u32x4*)(Rg + (size_t)(kt + 2) * 2048 + tid * 8);
#pragma unroll
      for (int i = 0; i < 2; ++i) vr[i] = *(const u32x4*)(Vg + (size_t)(ve0 + 32 * i) * TALL + (kt + 2) * 64 + vc * 8);
    }
    __builtin_amdgcn_sched_barrier(0);
    f32x4 sa[4][2];
#pragma unroll
    for (int kb = 0; kb < 4; ++kb)
#pragma unroll
      for (int qs = 0; qs < 2; ++qs) sa[kb][qs] = (f32x4){0.f, 0.f, 0.f, 0.f};
#pragma unroll
    for (int ks = 0; ks < 3; ++ks)
#pragma unroll
      for (int kb = 0; kb < 4; ++kb) {
        const bf16x8 a = ld_frag(Kc + (16 * kb + l15) * 104 + ks * 32 + g4 * 8);
#pragma unroll
        for (int qs = 0; qs < 2; ++qs) sa[kb][qs] = MFMA16(a, qf[qs][ks], sa[kb][qs]);
      }
    bf16x8 pf[2][2];
#pragma unroll
    for (int qs = 0; qs < 2; ++qs) {
      float mx = -1e30f;
#pragma unroll
      for (int kb = 0; kb < 4; ++kb)
#pragma unroll
        for (int j = 0; j < 4; ++j) mx = fmaxf(mx, sa[kb][qs][j]);
      mx = fmaxf(mx, __shfl_xor(mx, 16)); mx = fmaxf(mx, __shfl_xor(mx, 32));
      const float mnew = fmaxf(mrun[qs], mx), alpha = __builtin_amdgcn_exp2f(mrun[qs] - mnew);
      mrun[qs] = mnew;
      float ps = 0.f;
#pragma unroll
      for (int kb = 0; kb < 4; ++kb)
#pragma unroll
        for (int j = 0; j < 4; ++j) { const float e = __builtin_amdgcn_exp2f(sa[kb][qs][j] - mnew); sa[kb][qs][j] = e; ps += e; }
      lsum[qs] = lsum[qs] * alpha + ps;
#pragma unroll
      for (int es = 0; es < 4; ++es) O[es][qs] = O[es][qs] * alpha;
#pragma unroll
      for (int k2 = 0; k2 < 2; ++k2)
        pf[qs][k2] = mk_frag(pack2(sa[2 * k2][qs][0], sa[2 * k2][qs][1]), pack2(sa[2 * k2][qs][2], sa[2 * k2][qs][3]),
                             pack2(sa[2 * k2 + 1][qs][0], sa[2 * k2 + 1][qs][1]), pack2(sa[2 * k2 + 1][qs][2], sa[2 * k2 + 1][qs][3]));
    }
#pragma unroll
    for (int k2 = 0; k2 < 2; ++k2)
#pragma unroll
      for (int es = 0; es < 4; ++es) {
        const bf16_t* vp = Vc + (16 * es + l15) * 72 + 32 * k2 + 4 * g4;
        const u32x2 lo = *(const u32x2*)vp, hi = *(const u32x2*)(vp + 16);
        const bf16x8 a = mk_frag(lo.x, lo.y, hi.x, hi.y);
#pragma unroll
        for (int qs = 0; qs < 2; ++qs) O[es][qs] = MFMA16(a, pf[qs][k2], O[es][qs]);
      }
    __syncthreads();
  }
  bf16_t* Y = (bf16_t*)(p.ws + OFF_HY);
#pragma unroll
  for (int qs = 0; qs < 2; ++qs) {
    float l = lsum[qs]; l += __shfl_xor(l, 16); l += __shfl_xor(l, 32);
    const float inv = 1.f / l;
    const int row = qrow0 + 32 * w + 16 * qs + l15;
#pragma unroll
    for (int es = 0; es < 4; ++es) store_bf4(Y + (size_t)row * 1024 + 256 + h * 64 + 16 * es + 4 * g4, O[es][qs] * inv);
  }
  __syncthreads();
}

DI void chunk_geom(int tcg, int b, int& part, int& tc, int& row0) { part = tcg >= 128; tc = part ? tcg - 128 : tcg; row0 = row_of(b, part, tc * 64); }
DI int chain_slot(int dir, int part, int tc) { return dir ? (part ? 3 - tc : 131 - tc) : (part ? tc : 4 + tc); }

DI void mlstm_p1(const Params& p, int l, int item, char* smem) {
  const int tid = ltid(), lane = tid & 63, w = __builtin_amdgcn_readfirstlane(tid >> 6), l15 = lane & 15, g4 = lane >> 4;
  const int tcg = item % NCH; int r = item / NCH; const int dir = r & 1; r >>= 1; const int h = r & 3, b = r >> 2;
  int part, tc, row0; chunk_geom(tcg, b, part, tc, row0);
  const int c = chain_slot(dir, part, tc), chain = (b * 4 + h) * 2 + dir;
  bf16_t* A = (bf16_t*)smem;
  bf16_t* Bk = A + 80 * 72;
  float* fs = (float*)(Bk + 64 * 72);
  const bf16_t* P = (const bf16_t*)(p.ws + OFF_P); const float* GML = (const float*)(p.ws + OFF_GML);
  float* MLM = (float*)(p.ws + OFF_MLM) + (size_t)(chain * NCH + c) * 32;
  if (tid < 64) {
    const int gi = 2 * dir;
    const float ig = GML[(size_t)(row0 + tid) * 16 + gi * 4 + h] + p.ml_gate_bias[l * 16 + gi * 4 + h];
    const float fg = GML[(size_t)(row0 + tid) * 16 + (gi + 1) * 4 + h] + p.ml_gate_bias[l * 16 + (gi + 1) * 4 + h];
    const float lf = logsigm_f(fg);
    const float pre = wave_incl_scan(lf, lane), tot = __shfl(pre, 63);
    const float bc = dir ? tot - pre + lf : pre;
    const float wlog = tot - bc + ig, mloc = wave_max(wlog), wv = __expf(wlog - mloc);
    fs[tid] = wv; A[64 * 72 + tid] = f2bf(wv);
    if (tid == 0) { MLM[0] = mloc; MLM[1] = tot; }
  }
  for (int i = tid; i < 15 * 72; i += 256) A[65 * 72 + i] = 0;
  __syncthreads();
  {
    const int s = tid >> 2, d0 = (tid & 3) * 16; const float wv = fs[s];
    const bf16_t* kp = P + (size_t)(row0 + s) * PINP + C_MLK + h * 64 + d0;
    const bf16_t* vp = P + (size_t)(row0 + s) * PINP + C_MLV + h * 64 + d0;
#pragma unroll
    for (int hf = 0; hf < 2; ++hf) {
      const u32x4 kq = *(const u32x4*)(kp + hf * 8), vq = *(const u32x4*)(vp + hf * 8);
      const float kk[8] = {bflo(kq.x), bfhi(kq.x), bflo(kq.y), bfhi(kq.y), bflo(kq.z), bfhi(kq.z), bflo(kq.w), bfhi(kq.w)};
      const float vv[8] = {bflo(vq.x), bfhi(vq.x), bflo(vq.y), bfhi(vq.y), bflo(vq.z), bfhi(vq.z), bflo(vq.w), bfhi(vq.w)};
#pragma unroll
      for (int j = 0; j < 8; ++j) { Bk[(d0 + hf * 8 + j) * 72 + s] = f2bf(kk[j] * 0.125f); A[(d0 + hf * 8 + j) * 72 + s] = f2bf(vv[j] * wv); }
    }
  }
  __syncthreads();
  float* MLS = (float*)(p.ws + OFF_MLS) + (size_t)(chain * NCH + c) * 4160;
  for (int t = w; t < 20; t += 4) {
    const int ms = t >> 2, ns = t & 3;
    f32x4 acc = {0.f, 0.f, 0.f, 0.f};
#pragma unroll
    for (int ks = 0; ks < 2; ++ks) acc = MFMA16(ld_frag(A + (16 * ms + l15) * 72 + ks * 32 + g4 * 8), ld_frag(Bk + (16 * ns + l15) * 72 + ks * 32 + g4 * 8), acc);
#pragma unroll
    for (int j = 0; j < 4; ++j) { const int e = 16 * ms + 4 * g4 + j; if (e <= 64) MLS[e * 64 + 16 * ns + l15] = acc[j]; }
  }
  __syncthreads();
}
DI void mlstm_p2(const Params& p, int item) {
  const int gi = item * 256 + ltid(), chain = gi / 4160, e = gi % 4160;
  float* MLS = (float*)(p.ws + OFF_MLS) + (size_t)chain * NCH * 4160 + e;
  float* MLM = (float*)(p.ws + OFF_MLM) + (size_t)chain * NCH * 32;
  float C = 0.f, m = 0.f;
  for (int c0 = 0; c0 < NCH; c0 += 12) {
    float d[12], ml[12], bl[12];
#pragma unroll
    for (int i = 0; i < 12; ++i) { d[i] = MLS[(size_t)(c0 + i) * 4160]; ml[i] = MLM[(c0 + i) * 32]; bl[i] = MLM[(c0 + i) * 32 + 1]; }
#pragma unroll
    for (int i = 0; i < 12; ++i) {
      MLS[(size_t)(c0 + i) * 4160] = C; if (e == 0) MLM[(c0 + i) * 32 + 16] = m;
      const float mn = fmaxf(bl[i] + m, ml[i]);
      C = __expf(bl[i] + m - mn) * C + __expf(ml[i] - mn) * d[i]; m = mn;
    }
  }
}
DI void mlstm_p3(const Params& p, int l, int item, char* smem) {
  const int tid = ltid(), lane = tid & 63, w = __builtin_amdgcn_readfirstlane(tid >> 6), l15 = lane & 15, g4 = lane >> 4;
  const int h = item & 3; const int r = item >> 2; const int tcg = r % NCH, b = r / NCH;
  int part, tc, row0; chunk_geom(tcg, b, part, tc, row0);
  bf16_t* Qs = (bf16_t*)smem;
  bf16_t* Ks = Qs + 64 * 72;
  bf16_t* Vt = Ks + 64 * 72;
  bf16_t* Sb = Vt + 64 * 72;
  float* fb = (float*)(Sb + 64 * 72);
  float* fi = fb + 64;
  const bf16_t* P = (const bf16_t*)(p.ws + OFF_P); const float* GML = (const float*)(p.ws + OFF_GML);
  {
    const int s = tid >> 2, d0 = (tid & 3) * 16;
    const bf16_t* base = P + (size_t)(row0 + s) * PINP + h * 64 + d0;
#pragma unroll
    for (int hf = 0; hf < 2; ++hf) {
      *(u32x4*)(Qs + s * 72 + d0 + hf * 8) = *(const u32x4*)(base + C_MLQ + hf * 8);
      const u32x4 kq = *(const u32x4*)(base + C_MLK + hf * 8), vq = *(const u32x4*)(base + C_MLV + hf * 8);
      u32x4 ko; ko.x = pack2(bflo(kq.x) * 0.125f, bfhi(kq.x) * 0.125f); ko.y = pack2(bflo(kq.y) * 0.125f, bfhi(kq.y) * 0.125f);
      ko.z = pack2(bflo(kq.z) * 0.125f, bfhi(kq.z) * 0.125f); ko.w = pack2(bflo(kq.w) * 0.125f, bfhi(kq.w) * 0.125f);
      *(u32x4*)(Ks + s * 72 + d0 + hf * 8) = ko;
      const unsigned vw[4] = {vq.x, vq.y, vq.z, vq.w};
#pragma unroll
      for (int j = 0; j < 4; ++j) { Vt[(d0 + hf * 8 + 2 * j) * 72 + s] = (bf16_t)(vw[j] & 0xffffu); Vt[(d0 + hf * 8 + 2 * j + 1) * 72 + s] = (bf16_t)(vw[j] >> 16); }
    }
  }
  f32x4 hs[4];
#pragma unroll
  for (int ns = 0; ns < 4; ++ns) hs[ns] = (f32x4){0.f, 0.f, 0.f, 0.f};
#pragma unroll 1
  for (int dir = 0; dir < 2; ++dir) {
    const int c = chain_slot(dir, part, tc), chain = (b * 4 + h) * 2 + dir;
    const float m_in = ((const float*)(p.ws + OFF_MLM))[(size_t)(chain * NCH + c) * 32 + 16];
    const float* Cst = (const float*)(p.ws + OFF_MLS) + (size_t)(chain * NCH + c) * 4160;
    __syncthreads();
    if (tid < 64) {
      const int gi = 2 * dir;
      const float ig = GML[(size_t)(row0 + tid) * 16 + gi * 4 + h] + p.ml_gate_bias[l * 16 + gi * 4 + h];
      const float fg = GML[(size_t)(row0 + tid) * 16 + (gi + 1) * 4 + h] + p.ml_gate_bias[l * 16 + (gi + 1) * 4 + h];
      const float lf = logsigm_f(fg);
      const float pre = wave_incl_scan(lf, lane), tot = __shfl(pre, 63);
      fb[tid] = dir ? tot - pre + lf : pre; fi[tid] = ig;
    }
    __syncthreads();
    f32x4 sc[4];
#pragma unroll
    for (int ns = 0; ns < 4; ++ns) {
      f32x4 a = {0.f, 0.f, 0.f, 0.f};
#pragma unroll
      for (int ks = 0; ks < 2; ++ks) a = MFMA16(ld_frag(Qs + (16 * w + l15) * 72 + ks * 32 + g4 * 8), ld_frag(Ks + (16 * ns + l15) * 72 + ks * 32 + g4 * 8), a);
      sc[ns] = a;
    }
    float bi[4], mt[4], rsum[4];
#pragma unroll
    for (int j = 0; j < 4; ++j) {
      const int i = 16 * w + 4 * g4 + j; bi[j] = fb[i];
      float mx = -1e30f;
#pragma unroll
      for (int ns = 0; ns < 4; ++ns) { const int s = 16 * ns + l15; const bool ok = dir ? (s >= i) : (s <= i); const float dm = bi[j] - fb[s] + fi[s]; if (ok) mx = fmaxf(mx, dm); }
      mx = red16_max(mx);
      mt[j] = fmaxf(bi[j] + m_in, mx);
      float rs = 0.f;
#pragma unroll
      for (int ns = 0; ns < 4; ++ns) {
        const int s = 16 * ns + l15; const bool ok = dir ? (s >= i) : (s <= i);
        const float v = ok ? sc[ns][j] * __expf(bi[j] - fb[s] + fi[s] - mt[j]) : 0.f;
        rs += v; Sb[i * 72 + s] = f2bf(v);
      }
      rsum[j] = red16_sum(rs);
    }
    __syncthreads();
    f32x4 qc[5];
#pragma unroll
    for (int ns = 0; ns < 5; ++ns) {
      f32x4 a = {0.f, 0.f, 0.f, 0.f};
      const int e = 16 * ns + l15;
#pragma unroll
      for (int ks = 0; ks < 2; ++ks) {
        bf16x8 bfm;
        if (e <= 64) bfm = frag_from_f32(Cst + e * 64 + ks * 32 + g4 * 8, 1.f); else bfm = mk_frag(0u, 0u, 0u, 0u);
        a = MFMA16(ld_frag(Qs + (16 * w + l15) * 72 + ks * 32 + g4 * 8), bfm, a);
      }
      qc[ns] = a;
    }
    f32x4 nm[4];
#pragma unroll
    for (int ns = 0; ns < 4; ++ns) {
      f32x4 a = {0.f, 0.f, 0.f, 0.f};
#pragma unroll
      for (int ks = 0; ks < 2; ++ks) a = MFMA16(ld_frag(Sb + (16 * w + l15) * 72 + ks * 32 + g4 * 8), ld_frag(Vt + (16 * ns + l15) * 72 + ks * 32 + g4 * 8), a);
      nm[ns] = a;
    }
#pragma unroll
    for (int j = 0; j < 4; ++j) {
      const float wi = __expf(bi[j] + m_in - mt[j]);
      const float qn = __shfl(qc[4][j], lane & 48);
      const float den = rsum[j] + wi * qn;
      const float dd = 1.f / fmaxf(fabsf(den), __expf(-mt[j]));
#pragma unroll
      for (int ns = 0; ns < 4; ++ns) hs[ns][j] += (nm[ns][j] + wi * qc[ns][j]) * dd;
    }
  }
  bf16_t* Y = (bf16_t*)(p.ws + OFF_HY);
#pragma unroll
  for (int j = 0; j < 4; ++j) {
    float ss = 0.f;
#pragma unroll
    for (int ns = 0; ns < 4; ++ns) ss += hs[ns][j] * hs[ns][j];
    ss = red16_sum(ss);
    const float rstd = rsqrtf(ss * (1.f / 64.f) + 1e-6f);
    const int row = row0 + 16 * w + 4 * g4 + j;
#pragma unroll
    for (int ns = 0; ns < 4; ++ns) {
      const int ch = h * 64 + 16 * ns + l15;
      const float o = bf2f(P[(size_t)row * PINP + C_MLO + ch]);
      Y[(size_t)row * 1024 + ch] = f2bf(hs[ns][j] * rstd * p.ml_norm[l * 256 + ch] * sigm_f(o));
    }
  }
  __syncthreads();
}

DI void conv_silu8(const Params& p, int l, const bf16_t* P, int row, bool hp, bool hn, int ch, float* out) {
  const bf16_t* src = P + (size_t)row * PINP + C_XBC + ch;
  const u32x4 z = {0u, 0u, 0u, 0u};
  const u32x4 c0 = *(const u32x4*)src, pm = hp ? *(const u32x4*)(src - PINP) : z, nx = hn ? *(const u32x4*)(src + PINP) : z;
  const float* cw = p.ssd_conv_w + (size_t)l * 3 * 768 + ch; const float* cb = p.ssd_conv_b + l * 768 + ch;
  const float a[8] = {bflo(pm.x), bfhi(pm.x), bflo(pm.y), bfhi(pm.y), bflo(pm.z), bfhi(pm.z), bflo(pm.w), bfhi(pm.w)};
  const float m[8] = {bflo(c0.x), bfhi(c0.x), bflo(c0.y), bfhi(c0.y), bflo(c0.z), bfhi(c0.z), bflo(c0.w), bfhi(c0.w)};
  const float n[8] = {bflo(nx.x), bfhi(nx.x), bflo(nx.y), bfhi(nx.y), bflo(nx.z), bfhi(nx.z), bflo(nx.w), bfhi(nx.w)};
#pragma unroll
  for (int j = 0; j < 8; ++j) out[j] = silu_f(cb[j] + cw[j] * a[j] + cw[768 + j] * m[j] + cw[1536 + j] * n[j]);
}
DI void ssd_gates(const Params& p, int l, int dir, int h, int row0, int tid, int lane, float& dt, float& cs, float& tot) {
  const float* DTR = (const float*)(p.ws + OFF_DTR);
  dt = softplus_f(DTR[(size_t)(row0 + tid) * 8 + dir * 4 + h] + p.ssd_dt_bias[l * 8 + dir * 4 + h]);
  const float la = -dt * __expf(p.ssd_a_log[l * 8 + dir * 4 + h]);
  const float pre = wave_incl_scan(la, lane); tot = __shfl(pre, 63);
  cs = dir ? tot - pre + la : pre;
}
DI void ssd_p1(const Params& p, int l, int item, char* smem) {
  const int tid = ltid(), lane = tid & 63, w = __builtin_amdgcn_readfirstlane(tid >> 6), l15 = lane & 15, g4 = lane >> 4;
  const int tcg = item % NCH; int r = item / NCH; const int dir = r & 1; r >>= 1; const int h = r & 3, b = r >> 2;
  int part, tc, row0; chunk_geom(tcg, b, part, tc, row0);
  const int c = chain_slot(dir, part, tc), chain = (b * 4 + h) * 2 + dir, lastc = part ? 3 : 127;
  bf16_t* Xt = (bf16_t*)smem;
  bf16_t* Bt = Xt + 64 * 72;
  float* fs = (float*)(Bt + 128 * 72);
  const bf16_t* P = (const bf16_t*)(p.ws + OFF_P);
  if (tid < 64) {
    float dt, cs, tot; ssd_gates(p, l, dir, h, row0, tid, lane, dt, cs, tot);
    fs[tid] = __expf(tot - cs) * dt;
    if (tid == 0) ((float*)(p.ws + OFF_SSA))[(chain * NCH + c) * 32] = tot;
  }
  __syncthreads();
  const int grp = h >> 1;
  for (int id = tid; id < 64 * 24; id += 256) {
    const int s = id / 24, cc = id % 24;
    const bool hp = !(tc == 0 && s == 0), hn = !(tc == lastc && s == 63);
    float v[8];
    if (cc < 8) { conv_silu8(p, l, P, row0 + s, hp, hn, h * 64 + cc * 8, v); const float wv = fs[s];
#pragma unroll
      for (int j = 0; j < 8; ++j) Xt[(cc * 8 + j) * 72 + s] = f2bf(v[j] * wv); }
    else { const int n0 = (cc - 8) * 8; conv_silu8(p, l, P, row0 + s, hp, hn, 256 + grp * 128 + n0, v);
#pragma unroll
      for (int j = 0; j < 8; ++j) Bt[(n0 + j) * 72 + s] = f2bf(v[j]); }
  }
  __syncthreads();
  float* SS = (float*)(p.ws + OFF_SSDS) + (size_t)(chain * NCH + c) * 8192;
#pragma unroll
  for (int ns = 0; ns < 8; ++ns) {
    f32x4 acc = {0.f, 0.f, 0.f, 0.f};
#pragma unroll
    for (int ks = 0; ks < 2; ++ks) acc = MFMA16(ld_frag(Xt + (16 * w + l15) * 72 + ks * 32 + g4 * 8), ld_frag(Bt + (16 * ns + l15) * 72 + ks * 32 + g4 * 8), acc);
#pragma unroll
    for (int j = 0; j < 4; ++j) SS[(16 * w + 4 * g4 + j) * 128 + 16 * ns + l15] = acc[j];
  }
  __syncthreads();
}
DI void ssd_p2(const Params& p, int item) {
  const int gi = item * 256 + ltid(), chain = gi >> 13, e = gi & 8191;
  float* SS = (float*)(p.ws + OFF_SSDS) + (size_t)chain * NCH * 8192 + e;
  const float* SA = (const float*)(p.ws + OFF_SSA) + (size_t)chain * NCH * 32;
  float S = 0.f;
  for (int c0 = 0; c0 < NCH; c0 += 12) {
    float d[12], a[12];
#pragma unroll
    for (int i = 0; i < 12; ++i) { d[i] = SS[(size_t)(c0 + i) * 8192]; a[i] = SA[(c0 + i) * 32]; }
#pragma unroll
    for (int i = 0; i < 12; ++i) { SS[(size_t)(c0 + i) * 8192] = S; S = __expf(a[i]) * S + d[i]; }
  }
}
DI void ssd_p3(const Params& p, int l, int item, char* smem) {
  const int tid = ltid(), lane = tid & 63, w = __builtin_amdgcn_readfirstlane(tid >> 6), l15 = lane & 15, g4 = lane >> 4;
  const int h = item & 3; const int r = item >> 2; const int tcg = r % NCH, b = r / NCH;
  int part, tc, row0; chunk_geom(tcg, b, part, tc, row0);
  const int lastc = part ? 3 : 127, grp = h >> 1;
  bf16_t* Cm = (bf16_t*)smem;
  bf16_t* Bm = Cm + 64 * 136;
  bf16_t* Xt = Bm + 64 * 136;
  bf16_t* Sb = Xt + 64 * 72;
  float* fcs = (float*)(Sb + 64 * 72);
  float* fdt = fcs + 64;
  const bf16_t* P = (const bf16_t*)(p.ws + OFF_P);
  for (int id = tid; id < 64 * 40; id += 256) {
    const int s = id / 40, cc = id % 40;
    const bool hp = !(tc == 0 && s == 0), hn = !(tc == lastc && s == 63);
    float v[8];
    if (cc < 8) { conv_silu8(p, l, P, row0 + s, hp, hn, h * 64 + cc * 8, v);
#pragma unroll
      for (int j = 0; j < 8; ++j) Xt[(cc * 8 + j) * 72 + s] = f2bf(v[j]); }
    else {
      const int q = cc - 8, isC = q >= 16, n0 = (q & 15) * 8;
      conv_silu8(p, l, P, row0 + s, hp, hn, 256 + isC * 256 + grp * 128 + n0, v);
      u32x4 o; o.x = pack2(v[0], v[1]); o.y = pack2(v[2], v[3]); o.z = pack2(v[4], v[5]); o.w = pack2(v[6], v[7]);
      *(u32x4*)((isC ? Cm : Bm) + s * 136 + n0) = o;
    }
  }
  f32x4 ys[4];
#pragma unroll
  for (int ns = 0; ns < 4; ++ns) ys[ns] = (f32x4){0.f, 0.f, 0.f, 0.f};
#pragma unroll 1
  for (int dir = 0; dir < 2; ++dir) {
    const int c = chain_slot(dir, part, tc), chain = (b * 4 + h) * 2 + dir;
    const float* St = (const float*)(p.ws + OFF_SSDS) + (size_t)(chain * NCH + c) * 8192;
    __syncthreads();
    if (tid < 64) { float dt, cs, tot; ssd_gates(p, l, dir, h, row0, tid, lane, dt, cs, tot); fcs[tid] = cs; fdt[tid] = dt; }
    __syncthreads();
    float ci[4];
#pragma unroll
    for (int j = 0; j < 4; ++j) ci[j] = fcs[16 * w + 4 * g4 + j];
#pragma unroll
    for (int ns = 0; ns < 4; ++ns) {
      f32x4 a = {0.f, 0.f, 0.f, 0.f};
#pragma unroll
      for (int ks = 0; ks < 4; ++ks) a = MFMA16(ld_frag(Cm + (16 * w + l15) * 136 + ks * 32 + g4 * 8), ld_frag(Bm + (16 * ns + l15) * 136 + ks * 32 + g4 * 8), a);
      const int s = 16 * ns + l15; const float css = fcs[s], dts = fdt[s];
#pragma unroll
      for (int j = 0; j < 4; ++j) {
        const int i = 16 * w + 4 * g4 + j; const bool ok = dir ? (s >= i) : (s <= i);
        Sb[i * 72 + s] = f2bf(ok ? a[j] * __expf(ci[j] - css) * dts : 0.f);
      }
    }
    __syncthreads();
#pragma unroll
    for (int ns = 0; ns < 4; ++ns) {
      f32x4 a = {0.f, 0.f, 0.f, 0.f}, bq = {0.f, 0.f, 0.f, 0.f};
#pragma unroll
      for (int ks = 0; ks < 2; ++ks) a = MFMA16(ld_frag(Sb + (16 * w + l15) * 72 + ks * 32 + g4 * 8), ld_frag(Xt + (16 * ns + l15) * 72 + ks * 32 + g4 * 8), a);
#pragma unroll
      for (int ks = 0; ks < 4; ++ks) bq = MFMA16(ld_frag(Cm + (16 * w + l15) * 136 + ks * 32 + g4 * 8), frag_from_f32(St + (16 * ns + l15) * 128 + ks * 32 + g4 * 8, 1.f), bq);
#pragma unroll
      for (int j = 0; j < 4; ++j) ys[ns][j] += a[j] + __expf(ci[j]) * bq[j];
    }
  }
  bf16_t* Y = (bf16_t*)(p.ws + OFF_HY); float* SSQ = (float*)(p.ws + OFF_SSQ);
  const float dsk = p.ssd_d[l * 4 + h];
#pragma unroll
  for (int j = 0; j < 4; ++j) {
    const int i = 16 * w + 4 * g4 + j, row = row0 + i; float ss = 0.f;
#pragma unroll
    for (int ns = 0; ns < 4; ++ns) {
      const int pp = 16 * ns + l15;
      const float xv = bf2f(Xt[pp * 72 + i]);
      const float z = bf2f(P[(size_t)row * PINP + C_Z + h * 64 + pp]);
      const float g = (ys[ns][j] + dsk * xv) * silu_f(z);
      ss += g * g; Y[(size_t)row * 1024 + 512 + h * 64 + pp] = f2bf(g);
    }
    ss = red16_sum(ss);
    if (l15 == 0) SSQ[(size_t)h * NROW + row] = ss;
  }
  __syncthreads();
}

struct S5Par { float are, aim, bre[16], bim[16]; };
DI void s5_params(const Params& p, int l, int dir, int g, int n, S5Par& q, float& dtv, float& lre, float& lim) {
  const int ai = ((l * 2 + dir) * 16 + g) * 64 + n;
  lre = fminf(p.s5_a_re[ai], -1e-4f); lim = p.s5_a_im[ai];
  dtv = __expf(p.s5_log_dt[(l * 2 + dir) * 16 + g]);
  const float mag = __expf(lre * dtv), ang = lim * dtv;
  q.are = mag * cosf(ang); q.aim = mag * sinf(ang);
  const float den = lre * lre + lim * lim;
  const float fre = ((q.are - 1.f) * lre + q.aim * lim) / den, fim = (q.aim * lre - (q.are - 1.f) * lim) / den;
  const float* br = p.s5_b_re + ((size_t)(l * 16 + g) * 64 + n) * 16; const float* bi = p.s5_b_im + ((size_t)(l * 16 + g) * 64 + n) * 16;
#pragma unroll
  for (int j = 0; j < 16; ++j) { q.bre[j] = fre * br[j] - fim * bi[j]; q.bim[j] = fre * bi[j] + fim * br[j]; }
}
DI void s5_step(const S5Par& q, const bf16_t* us, int s, float& xr, float& xi) {
  const u32x4 a0 = *(const u32x4*)(us + s * 16), a1 = *(const u32x4*)(us + s * 16 + 8);
  const unsigned uw[8] = {a0.x, a0.y, a0.z, a0.w, a1.x, a1.y, a1.z, a1.w};
  float br = 0.f, bi = 0.f;
#pragma unroll
  for (int j = 0; j < 8; ++j) { const float a = bflo(uw[j]), c = bfhi(uw[j]); br += q.bre[2 * j] * a + q.bre[2 * j + 1] * c; bi += q.bim[2 * j] * a + q.bim[2 * j + 1] * c; }
  const float nr = q.are * xr - q.aim * xi + br, ni = q.are * xi + q.aim * xr + bi;
  xr = nr; xi = ni;
}
DI void s5_p1(const Params& p, int l, int item, char* smem) {
  const int lane = ltid() & 63, wi = item * 4 + __builtin_amdgcn_readfirstlane(ltid() >> 6);
  const int tcg = wi % NCH; int r = wi / NCH; const int dir = r & 1; r >>= 1; const int g = r & 15, b = r >> 4;
  int part, tc, row0; chunk_geom(tcg, b, part, tc, row0);
  const int c = chain_slot(dir, part, tc);
  S5Par q; float dtv, lre, lim; s5_params(p, l, dir, g, lane, q, dtv, lre, lim);
  const bf16_t* up = (const bf16_t*)(p.ws + OFF_P) + (size_t)(row0 + lane) * PINP + C_S5 + g * 16;
  bf16_t* us = (bf16_t*)smem + __builtin_amdgcn_readfirstlane(ltid() >> 6) * 1024;
  *(u32x4*)(us + lane * 16) = *(const u32x4*)up; *(u32x4*)(us + lane * 16 + 8) = *(const u32x4*)(up + 8);
  float xr = 0.f, xi = 0.f;
  for (int st = 0; st < 64; ++st) { const int s = dir ? 63 - st : st; s5_step(q, us, s, xr, xi); }
  float* S = (float*)(p.ws + OFF_S5S) + ((size_t)((b * 16 + g) * 2 + dir) * NCH + c) * 128;
  S[lane] = xr; S[64 + lane] = xi;
}
DI void s5_p2(const Params& p, int l, int item) {
  const int gi = item * 256 + ltid(), n = gi & 63, dir = (gi >> 6) & 1, g = (gi >> 7) & 15, b = gi >> 11;
  const int ai = ((l * 2 + dir) * 16 + g) * 64 + n;
  const float lre = fminf(p.s5_a_re[ai], -1e-4f), lim = p.s5_a_im[ai], dtv = __expf(p.s5_log_dt[(l * 2 + dir) * 16 + g]);
  const float mag = __expf(64.f * lre * dtv), ang = 64.f * (lim * dtv);
  const float ar = mag * cosf(ang), aim = mag * sinf(ang);
  float* S = (float*)(p.ws + OFF_S5S) + (size_t)((b * 16 + g) * 2 + dir) * NCH * 128 + n;
  float xr = 0.f, xi = 0.f;
  for (int c0 = 0; c0 < NCH; c0 += 12) {
    float dr[12], di[12];
#pragma unroll
    for (int i = 0; i < 12; ++i) { dr[i] = S[(c0 + i) * 128]; di[i] = S[(c0 + i) * 128 + 64]; }
#pragma unroll
    for (int i = 0; i < 12; ++i) { S[(c0 + i) * 128] = xr; S[(c0 + i) * 128 + 64] = xi; const float nr = ar * xr - aim * xi + dr[i], ni = ar * xi + aim * xr + di[i]; xr = nr; xi = ni; }
  }
}
DI void s5_p3(const Params& p, int l, int item, char* smem) {
  const int tid = ltid(), lane = tid & 63, w = __builtin_amdgcn_readfirstlane(tid >> 6), l15 = lane & 15, g4 = lane >> 4;
  const int half = item & 1; const int r2 = item >> 1; const int tcg = r2 % NCH, b = r2 / NCH;
  int part, tc, row0; chunk_geom(tcg, b, part, tc, row0);
  bf16_t* xs = (bf16_t*)smem + w * (16 * 136);
  bf16_t* YG = (bf16_t*)(p.ws + OFF_YG);
  const bf16_t* P = (const bf16_t*)(p.ws + OFF_P);
#pragma unroll 1
  for (int gi = 0; gi < 2; ++gi) {
    const int g = half * 8 + w + 4 * gi;
    const bf16_t* up = P + (size_t)(row0 + lane) * PINP + C_S5 + g * 16;
    bf16_t* us = (bf16_t*)smem + 25600 + w * 1024;
    *(u32x4*)(us + lane * 16) = *(const u32x4*)up; *(u32x4*)(us + lane * 16 + 8) = *(const u32x4*)(up + 8);
    f32x4 yt[4];
#pragma unroll
    for (int ib = 0; ib < 4; ++ib) yt[ib] = (f32x4){0.f, 0.f, 0.f, 0.f};
#pragma unroll
    for (int dir = 0; dir < 2; ++dir) {
      S5Par q; float dtv, lre, lim; s5_params(p, l, dir, g, lane, q, dtv, lre, lim);
      const int c = chain_slot(dir, part, tc);
      const float* S = (const float*)(p.ws + OFF_S5S) + ((size_t)((b * 16 + g) * 2 + dir) * NCH + c) * 128;
      float xr = S[lane], xi = S[64 + lane];
      bf16x8 cf[4];
#pragma unroll
      for (int ks = 0; ks < 4; ++ks) {
        const int k = ks * 32 + g4 * 8;
        const float* src = (k < 64 ? p.s5_c_re : p.s5_c_im) + ((size_t)(l * 16 + g) * 16 + l15) * 64 + (k & 63);
        cf[ks] = frag_from_f32(src, k < 64 ? 1.f : -1.f);
      }
#pragma unroll
      for (int blk = 0; blk < 4; ++blk) {
        asm volatile("s_waitcnt lgkmcnt(0)" ::: "memory");
#pragma unroll 4
        for (int st = 0; st < 16; ++st) {
          const int step = blk * 16 + st, s = dir ? 63 - step : step;
          s5_step(q, us, s, xr, xi);
          xs[(s & 15) * 136 + lane] = f2bf(xr); xs[(s & 15) * 136 + 64 + lane] = f2bf(xi);
        }
        asm volatile("s_waitcnt lgkmcnt(0)" ::: "memory");
        f32x4 a = {0.f, 0.f, 0.f, 0.f};
#pragma unroll
        for (int ks = 0; ks < 4; ++ks) a = MFMA16(ld_frag(xs + l15 * 136 + ks * 32 + g4 * 8), cf[ks], a);
        const int ib = dir ? 3 - blk : blk;
        yt[ib] += a;
      }
    }
#pragma unroll
    for (int ib = 0; ib < 4; ++ib)
#pragma unroll
      for (int j = 0; j < 4; ++j) {
        const int tok = 16 * ib + 4 * g4 + j, ch = g * 16 + l15;
        const float u = bf2f(P[(size_t)(row0 + tok) * PINP + C_S5 + ch]);
        YG[(size_t)(row0 + tok) * 256 + ch] = f2bf(gelu_tanh_f(yt[ib][j] + p.s5_d[l * 256 + ch] * u));
      }
  }
  __syncthreads();
}
DI void glu_item(const Params& p, int l, int item, char* smem) {
  const int mt = item >> 1, nt = item & 1;
  const bf16_t* YG = (const bf16_t*)(p.ws + OFF_YG); bf16_t* Y = (bf16_t*)(p.ws + OFF_HY);
  gemm_tile<0, 0>(YG, 256, (const bf16_t*)(p.ws + OFF_WGLU) + (size_t)l * 256 * 256, 256, 256, mt * 128, nt * 128, smem, nullptr,
                  [&](int row, int col, f32x4 v) {
                    const u32x2 yv = *(const u32x2*)(YG + (size_t)row * 256 + col);
                    f32x4 o; o[0] = bflo(yv.x) * sigm_f(v[0]); o[1] = bfhi(yv.x) * sigm_f(v[1]); o[2] = bflo(yv.y) * sigm_f(v[2]); o[3] = bfhi(yv.y) * sigm_f(v[3]);
                    store_bf4(Y + (size_t)row * 1024 + 768 + col, o);
                  });
}

DI void outproj_item(const Params& p, int l, int item, char* smem) {
  const int mt = item >> 3, nt = item & 7;
  const float* MOD = (const float*)(p.ws + OFF_MOD);
  gemm_tile<1, 2>((const bf16_t*)(p.ws + OFF_HY), 1024, (const bf16_t*)(p.ws + OFF_WOUT) + (size_t)l * 1024 * 1024, 1024, 1024, mt * 128, nt * 128, smem, (const float*)(p.ws + OFF_SSQ),
               [&](int row, int col, f32x4 v) {
                 const int s = row < NLAT ? row / T : 2;
                 const f32x4 gt = *(const f32x4*)(MOD + (size_t)(l * 3 + s) * 6144 + 2048 + col);
                 float* xp = row < NLAT ? p.xb + (size_t)row * 1024 + col : (float*)(p.ws + OFF_CTX) + (size_t)(row - NLAT) * 1024 + col;
                 *(f32x4*)xp = *(f32x4*)xp + gt * v;
               });
}
DI void ffnup_item(const Params& p, int l, int item, char* smem) {
  const int mtile = item / 44, nt = item % 44;
  int seq0, slen, ti;
  if (mtile < 132) { seq0 = (mtile / 66) * T; slen = T; ti = mtile % 66; }
  else { const int j = mtile - 132; seq0 = NLAT + (j / 3) * TC; slen = TC; ti = j % 3; }
  const int m0 = seq0 + 126 * ti - 1, n0 = nt * 128;
  bf16_t* ACT = (bf16_t*)(p.ws + OFF_R);
  bf16_t* Ts = (bf16_t*)smem;
  auto epi = [&](int row, int col, f32x4 v) {
    const int lr = row - m0, c = col - n0, t = 126 * ti - 1 + lr;
    if (c >= 64 && (t < 0 || t >= slen)) v = (f32x4){0.f, 0.f, 0.f, 0.f};
    store_bf4(Ts + lr * 136 + c, v);
  };
  gemm_tile<0, 0, decltype(epi), 1>((const bf16_t*)(p.ws + OFF_HY), 1024, (const bf16_t*)(p.ws + OFF_WUP) + (size_t)l * 5632 * 1024, 1024, 1024, m0, n0, smem, nullptr, epi, seq0, seq0 + slen - 1);
  __syncthreads();
  {
    const int tid = ltid();
    const float* cw = p.ffn_conv_w + (size_t)l * 3 * DFF + nt * 64;
#pragma unroll
    for (int q = 0; q < 4; ++q) {
      const int id = tid + 256 * q, lr = 1 + (id >> 3), c8 = (id & 7) * 8, t = 126 * ti - 1 + lr;
      if (id < 1008 && t < slen) {
        const u32x4 uu = *(const u32x4*)(Ts + lr * 136 + c8), gm = *(const u32x4*)(Ts + (lr - 1) * 136 + 64 + c8), g0 = *(const u32x4*)(Ts + lr * 136 + 64 + c8), gn = *(const u32x4*)(Ts + (lr + 1) * 136 + 64 + c8);
        const float uf[8] = {bflo(uu.x), bfhi(uu.x), bflo(uu.y), bfhi(uu.y), bflo(uu.z), bfhi(uu.z), bflo(uu.w), bfhi(uu.w)};
        const float a[8] = {bflo(gm.x), bfhi(gm.x), bflo(gm.y), bfhi(gm.y), bflo(gm.z), bfhi(gm.z), bflo(gm.w), bfhi(gm.w)};
        const float m[8] = {bflo(g0.x), bfhi(g0.x), bflo(g0.y), bfhi(g0.y), bflo(g0.z), bfhi(g0.z), bflo(g0.w), bfhi(g0.w)};
        const float n[8] = {bflo(gn.x), bfhi(gn.x), bflo(gn.y), bfhi(gn.y), bflo(gn.z), bfhi(gn.z), bflo(gn.w), bfhi(gn.w)};
        float o[8];
#pragma unroll
        for (int j = 0; j < 8; ++j) o[j] = silu_f(cw[c8 + j] * a[j] + cw[DFF + c8 + j] * m[j] + cw[2 * DFF + c8 + j] * n[j]) * uf[j];
        u32x4 ov; ov.x = pack2(o[0], o[1]); ov.y = pack2(o[2], o[3]); ov.z = pack2(o[4], o[5]); ov.w = pack2(o[6], o[7]);
        *(u32x4*)(ACT + (size_t)(seq0 + t) * DFF + nt * 64 + c8) = ov;
      }
    }
  }
  __syncthreads();
}
DI void ffndown_item(const Params& p, int l, int item, char* smem) {
  const int mt = item >> 3, nt = item & 7;
  const float* MOD = (const float*)(p.ws + OFF_MOD);
  gemm_tile<0, 2>((const bf16_t*)(p.ws + OFF_R), DFF, (const bf16_t*)(p.ws + OFF_WDN) + (size_t)l * 1024 * 2816, 2816, 2816, mt * 128, nt * 128, smem, nullptr,
               [&](int row, int col, f32x4 v) {
                 const int s = row < NLAT ? row / T : 2;
                 const f32x4 gt = *(const f32x4*)(MOD + (size_t)(l * 3 + s) * 6144 + 5120 + col);
                 float* xp = row < NLAT ? p.xb + (size_t)row * 1024 + col : (float*)(p.ws + OFF_CTX) + (size_t)(row - NLAT) * 1024 + col;
                 *(f32x4*)xp = *(f32x4*)xp + gt * v;
               });
}
DI void final_item(const Params& p, int item) {
  const int lane = ltid() & 63, w = __builtin_amdgcn_readfirstlane(ltid() >> 6), row = item * 4 + w;
  float* x = p.xb + (size_t)row * 1024;
  float4 v[4]; float ss = 0.f;
#pragma unroll
  for (int i = 0; i < 4; ++i) { v[i] = *(const float4*)(x + (i * 64 + lane) * 4); ss += v[i].x * v[i].x + v[i].y * v[i].y + v[i].z * v[i].z + v[i].w * v[i].w; }
  ss = wave_sum(ss);
  const float rstd = rsqrtf(ss * (1.f / 1024.f) + 1e-6f);
#pragma unroll
  for (int i = 0; i < 4; ++i) {
    const int k = (i * 64 + lane) * 4; const float4 g = *(const float4*)(p.final_norm + k);
    float4 o; o.x = v[i].x * rstd * g.x; o.y = v[i].y * rstd * g.y; o.z = v[i].z * rstd * g.z; o.w = v[i].w * rstd * g.w;
    *(float4*)(x + k) = o;
  }
}

constexpr int PPL = 10;
constexpr int N_PHASES = 2 + NL * PPL;
#define FOR_ITEMS(n) for (int it = blockIdx.x; it < (n); it += gridDim.x)

DI void run_phase(const Params& p, int ph, char* smem) {
  if (ph == 0) { FOR_ITEMS(P0_ITEMS) p0_item(p, it, smem); return; }
  if (ph == N_PHASES - 1) { FOR_ITEMS(NLAT / 4) final_item(p, it); return; }
  const int l = (ph - 1) / PPL, k = (ph - 1) % PPL;
  const int mtiles = (l == NL - 1) ? 128 : 132;
  switch (k) {
    case 0: FOR_ITEMS(NROW / 4) norm_item(p, l, 0, it); break;
    case 1: FOR_ITEMS(132 * 22) gemm_in_item(p, l, it, smem); break;
    case 2: FOR_ITEMS(2112) s5_p1(p, l, it, smem); break;
    case 3: {
      constexpr int n0 = 2112, n1 = n0 + 2112, n2 = n1 + 528, n3 = n2 + 396, n5 = n3 + 66;
      FOR_ITEMS(n5 + 16) {
        if (it < n0) ssd_p1(p, l, it, smem);
        else if (it < n1) mlstm_p1(p, l, it - n0, smem);
        else if (it < n2) kvproj_item(p, l, it - n1, smem);
        else if (it < n3) qproj_item(p, l, it - n2, smem);
        else if (it < n5) ropek_item(p, it - n3);
        else s5_p2(p, l, it - n5);
      }
    } break;
    case 4: {
      constexpr int n0 = 528, n1 = n0 + 512, n2 = n1 + 260;
      FOR_ITEMS(n2) { if (it < n0) s5_p3(p, l, it, smem); else if (it < n1) ssd_p2(p, it - n0); else mlstm_p2(p, it - n1); }
    } break;
    case 5: {
      constexpr int n0 = 528, n2 = n0 + 1056, n3x = n2 + 1056, n3 = n3x + 264;
      const bool late = blockIdx.x >= (gridDim.x >> 1);
      if (!late) { FOR_ITEMS(n0) attn_item(p, it, smem); }
      FOR_ITEMS(n3) {
        if (it < n0) continue;
        if (it < n2) ssd_p3(p, l, it - n0, smem);
        else if (it < n3x) mlstm_p3(p, l, it - n2, smem);
        else glu_item(p, l, it - n3x, smem);
      }
      if (late) { FOR_ITEMS(n0) attn_item(p, it, smem); }
    } break;
    case 6: FOR_ITEMS(mtiles * 8) outproj_item(p, l, it, smem); break;
    case 7: FOR_ITEMS(mtiles * 32) norm_item(p, l, 1, it); break;
    case 8: FOR_ITEMS(((l == NL - 1) ? 132 : 138) * 44) ffnup_item(p, l, it, smem); break;
    case 9: FOR_ITEMS(mtiles * 8) ffndown_item(p, l, it, smem); break;
  }
}

#ifndef HASH_LO
#define HASH_LO OFF_MOD
#define HASH_HI WS_NEED
#endif
#ifndef PROBE_N
#define PROBE_N 0
#endif
DI void hash_dump(const Params& p) {
  const size_t NOUT = (size_t)NLAT * 1024, nw = (HASH_HI - HASH_LO) / 4;
  const unsigned* wsw = (const unsigned*)(p.ws + HASH_LO);
  for (size_t i = (size_t)blockIdx.x * 256 + threadIdx.x; i < NOUT; i += (size_t)gridDim.x * 256) {
    unsigned h = 12345u;
    for (size_t j = i; j < nw; j += NOUT) h = h * 1664525u + wsw[j];
    p.xb[i] = (float)(h & 0xFFFFFFu);
  }
}

#define XB_TMO      128
#define XB_XCNT(j)  (256  + 64 * (j))
#define XB_XSUB(j)  (1280 + 64 * (j))
#define XB_XGEN(j)  (2304 + 64 * (j))
#define XB_TOP      3328
#define XB_TOPGEN   3392
#define XCD_BAR_WORDS 3456
#define XB_SPIN_CAP (1u << 22)
#define LAS __attribute__((address_space(3)))
DI unsigned xb_ld(unsigned* p) { return __hip_atomic_load(p, __ATOMIC_RELAXED, __HIP_MEMORY_SCOPE_AGENT); }
DI unsigned xb_add(unsigned* p, unsigned v) { return __hip_atomic_fetch_add(p, v, __ATOMIC_RELAXED, __HIP_MEMORY_SCOPE_AGENT); }
DI unsigned xb_xcc_id() { return (unsigned)__builtin_amdgcn_s_getreg((3 << 11) | 20) & 0xFu; }
#define XB_SPIN(cond, bar) do { unsigned _sp = 0; while (cond) { __builtin_amdgcn_s_sleep(1); \
    if ((++_sp & 255u) == 0u) { if (xb_ld(&(bar)[XB_TMO])) break; if (_sp > XB_SPIN_CAP) { atomicAdd(&(bar)[XB_TMO], 1u); break; } } } } while (0)
struct XcdBarrier { unsigned* bar; unsigned x; volatile LAS unsigned* st; };
DI XcdBarrier xcd_barrier_post(unsigned* bar, volatile LAS unsigned* st) {
  XcdBarrier b; b.bar = bar; b.x = xb_xcc_id(); b.st = st;
  if (threadIdx.x == 0) (void)xb_add(&bar[XB_XCNT(b.x)], 1u);
  return b;
}
DI void xcd_barrier_complete(unsigned* bar, unsigned x, unsigned& nloc, unsigned& nx) {
  const unsigned G = gridDim.x;
  unsigned sum, cnt, mine, sp = 0u;
  for (;;) {
    sum = 0u; cnt = 0u; mine = 0u;
#pragma unroll
    for (unsigned j = 0; j < 16; ++j) { const unsigned c = xb_ld(&bar[XB_XCNT(j)]); sum += c; cnt += (c > 0u) ? 1u : 0u; mine = (j == x) ? c : mine; }
    if (sum == G) break;
    __builtin_amdgcn_s_sleep(1);
    if ((++sp & 255u) == 0u) { if (xb_ld(&bar[XB_TMO])) break; if (sp > XB_SPIN_CAP) { atomicAdd(&bar[XB_TMO], 1u); break; } }
  }
  nloc = mine > 0u ? mine : 1u; nx = cnt > 0u ? cnt : 1u;
}
DI void xcd_barrier(const XcdBarrier& b) {
  asm volatile("s_waitcnt vmcnt(0)" ::: "memory");
  __syncthreads();
  if (threadIdx.x == 0) {
    unsigned* bar = b.bar;
    __builtin_amdgcn_s_waitcnt(0);
    unsigned nloc = b.st[0], nx = b.st[1];
    if (nloc == 0u) { xcd_barrier_complete(bar, b.x, nloc, nx); b.st[0] = nloc; b.st[1] = nx; }
    const unsigned old = xb_add(&bar[XB_XSUB(b.x)], 1u);
    const unsigned gen = old / nloc;
    if (old + 1u == (gen + 1u) * nloc) {
      __builtin_amdgcn_fence(__ATOMIC_RELEASE, "agent");
      asm volatile("s_waitcnt vmcnt(0)" ::: "memory");
      const unsigned og = xb_add(&bar[XB_TOP], 1u);
      const unsigned tg = og / nx;
      if (og + 1u == (tg + 1u) * nx) xb_add(&bar[XB_TOPGEN], 1u);
      else XB_SPIN(xb_ld(&bar[XB_TOPGEN]) == tg, bar);
      __builtin_amdgcn_fence(__ATOMIC_ACQUIRE, "agent");
      xb_add(&bar[XB_XGEN(b.x)], 1u);
      asm volatile("s_waitcnt vmcnt(0)" ::: "memory");
    } else {
      XB_SPIN(xb_ld(&bar[XB_XGEN(b.x)]) == gen, bar);
      __builtin_amdgcn_fence(__ATOMIC_ACQUIRE, "agent");
      asm volatile("s_waitcnt vmcnt(0)" ::: "memory");
    }
  }
  __syncthreads();
}
constexpr int SMEM_BYTES = 59392;
__global__ void __launch_bounds__(256, 2) trunk_fwd(Params p) {
  __shared__ __attribute__((aligned(16))) char smem[SMEM_BYTES];
  __shared__ uint4 xb_words;
  cg::grid_group grid = cg::this_grid();
  if (threadIdx.x == 0) xb_words = make_uint4(0u, 0u, 0u, 0u);
  __syncthreads();
  XcdBarrier xb = xcd_barrier_post((unsigned*)(p.ws + OFF_BAR), (volatile LAS unsigned*)&xb_words);
  for (int ph = p.ph_lo; ph < p.ph_hi; ++ph) {
    run_phase(p, ph, smem);
    if (ph + 1 < p.ph_hi) { if (ph == p.ph_lo) grid.sync(); else xcd_barrier(xb); }
  }
}

__global__ void __launch_bounds__(256) hash_kernel(Params p) { hash_dump(p); }

extern "C" void kernel_launch(void* const* d_in, const int* in_sizes, int n_in, void* d_out, int out_size, void* d_ws, size_t ws_size, hipStream_t stream) {
  static int grid_blocks = 0;
  if (!grid_blocks) {
    int dev = 0, cus = 0, per_cu = 0;
    hipGetDevice(&dev);
    hipDeviceGetAttribute(&cus, hipDeviceAttributeMultiprocessorCount, dev);
    hipOccupancyMaxActiveBlocksPerMultiprocessor(&per_cu, trunk_fwd, 256, 0);
    if (per_cu > 2) per_cu = 2;
    grid_blocks = cus * per_cu;
  }
  if (ws_size < OFF_BAR + XCD_BAR_WORDS * 4) { fprintf(stderr, "workspace too small: %zu < %zu\n", ws_size, (size_t)WS_NEED); return; }
  Params p{};
  const float** fp = (const float**)&p;
  for (int i = 0; i < 35; ++i) fp[i] = (const float*)d_in[i];
  p.xb = (float*)d_out; p.ws = (char*)d_ws;
#if MULTI_LAUNCH
#if PROBE_N
  for (int ph = 0; ph < PROBE_N; ++ph) { p.ph_lo = ph; p.ph_hi = ph + 1; hipLaunchKernelGGL(trunk_fwd, dim3(grid_blocks), dim3(256), 0, stream, p); }
  hipLaunchKernelGGL(hash_kernel, dim3(grid_blocks), dim3(256), 0, stream, p);
#else
  for (int ph = 0; ph < N_PHASES; ++ph) { p.ph_lo = ph; p.ph_hi = ph + 1; hipLaunchKernelGGL(trunk_fwd, dim3(grid_blocks), dim3(256), 0, stream, p); }
#endif
#else
  p.ph_lo = 0; p.ph_hi = N_PHASES;
  hipMemsetAsync((char*)d_ws + OFF_BAR, 0, XCD_BAR_WORDS * 4, stream);
  void* args[] = {&p};
  hipError_t e = hipLaunchCooperativeKernel((void*)trunk_fwd, dim3(grid_blocks), dim3(256), args, 0, stream);
  if (e != hipSuccess) fprintf(stderr, "cooperative launch failed: %s (grid %d)\n", hipGetErrorString(e), grid_blocks);
#endif
}
```

```cpp
#include <hip/hip_runtime.h>
#include <hip/hip_cooperative_groups.h>
#include <cstdio>
#include <cstdint>
namespace cg = cooperative_groups;

#ifndef PROBE_MASK
#define PROBE_MASK 63
#endif
#ifndef ZERO_FILL
#define ZERO_FILL 0
#endif
#ifndef MULTI_LAUNCH
#define MULTI_LAUNCH 0
#endif

typedef unsigned short bf16_t;
typedef short bf16x8 __attribute__((ext_vector_type(8)));
typedef float f32x4 __attribute__((ext_vector_type(4)));
typedef unsigned u32x4 __attribute__((ext_vector_type(4)));
typedef unsigned u32x2 __attribute__((ext_vector_type(2)));
#define DI __device__ __forceinline__
#define MFMA16(a, b, c) __builtin_amdgcn_mfma_f32_16x16x32_bf16((a), (b), (c), 0, 0, 0)

constexpr int NB = 2, T = 8192, TC = 256, NL = 4;
constexpr int NLAT = NB * T, NROW = NLAT + NB * TC;
constexpr int TALL = T + TC;
constexpr int PINP = 2816;
constexpr int C_MLQ = 0, C_MLK = 256, C_MLV = 512, C_MLO = 768, C_CQ = 1040, C_CKV = 1296, C_KR = 1424,
              C_Z = 1456, C_XBC = 1712, C_S5 = 2488;
constexpr int NCH = 132;
constexpr int DFF = 2816;

constexpr size_t SZ_WIN = (size_t)NL * 2816 * 1024 * 2, SZ_WUQ = (size_t)NL * 384 * 256 * 2, SZ_WUKV = (size_t)NL * 512 * 128 * 2,
                 SZ_WGLU = (size_t)NL * 256 * 256 * 2, SZ_WOUT = (size_t)NL * 1024 * 1024 * 2, SZ_WUP = (size_t)NL * 5632 * 1024 * 2,
                 SZ_WDN = (size_t)NL * 1024 * 2816 * 2, SZ_MOD = (size_t)NL * 3 * 6144 * 4, SZ_CTX = (size_t)512 * 1024 * 4,
                 SZ_HY = (size_t)NROW * 1024 * 2, SZ_GML = (size_t)NROW * 16 * 4, SZ_DTR = (size_t)NROW * 8 * 4, SZ_SSQ = (size_t)NROW * 4 * 4,
                 SZ_QRAW = (size_t)NROW * 384 * 2, SZ_KH = (size_t)NB * 4 * TALL * 64 * 2 + (size_t)NB * TALL * 32 * 2, SZ_VT = (size_t)NB * 4 * 64 * TALL * 2,
                 SZ_S5S = (size_t)NB * 16 * 2 * NCH * 128 * 4, SZ_MLM = (size_t)16 * NCH * 32 * 4, SZ_SSA = (size_t)16 * NCH * 32 * 4,
                 SZ_P = (size_t)NROW * PINP * 2, SZ_MLS = (size_t)16 * NCH * 4160 * 4, SZ_SSDS = (size_t)16 * NCH * 8192 * 4;
constexpr size_t OFF_WIN = 0, OFF_WUQ = OFF_WIN + SZ_WIN, OFF_WUKV = OFF_WUQ + SZ_WUQ, OFF_WGLU = OFF_WUKV + SZ_WUKV,
                 OFF_WOUT = OFF_WGLU + SZ_WGLU, OFF_WUP = OFF_WOUT + SZ_WOUT, OFF_WDN = OFF_WUP + SZ_WUP, OFF_MOD = OFF_WDN + SZ_WDN,
                 OFF_CTX = OFF_MOD + SZ_MOD, OFF_HY = OFF_CTX + SZ_CTX, OFF_GML = OFF_HY + SZ_HY, OFF_DTR = OFF_GML + SZ_GML,
                 OFF_SSQ = OFF_DTR + SZ_DTR, OFF_QRAW = OFF_SSQ + SZ_SSQ, OFF_KH = OFF_QRAW + SZ_QRAW, OFF_VT = OFF_KH + SZ_KH,
                 OFF_S5S = OFF_VT + SZ_VT, OFF_MLM = OFF_S5S + SZ_S5S, OFF_SSA = OFF_MLM + SZ_MLM,
                 OFF_R = ((OFF_SSA + SZ_SSA + 255) / 256) * 256, OFF_P = OFF_R, OFF_MLS = OFF_P + SZ_P, OFF_SSDS = OFF_MLS + SZ_MLS,
                 WS_NEED = OFF_SSDS + SZ_SSDS;
static_assert((size_t)NROW * 5632 * 2 <= SZ_P + SZ_MLS + SZ_SSDS, "UG overlay");

constexpr size_t OFF_KR = OFF_KH + (size_t)NB * 4 * TALL * 64 * 2;
constexpr size_t OFF_YG = ((WS_NEED + 255) / 256) * 256;
constexpr size_t OFF_BAR = OFF_YG + (size_t)NROW * 256 * 2;
struct Params {
  const float *x, *c, *ctx, *c_ctx, *w_mod, *b_mod, *norm1, *norm2, *w_in, *ml_gate_bias, *ml_norm, *mla_q_norm, *mla_kv_norm,
      *mla_w_uq, *mla_w_ukv, *ssd_conv_w, *ssd_conv_b, *ssd_a_log, *ssd_dt_bias, *ssd_d, *ssd_norm, *s5_a_re, *s5_a_im, *s5_log_dt,
      *s5_b_re, *s5_b_im, *s5_c_re, *s5_c_im, *s5_d, *s5_w_glu, *w_out, *ffn_w_up, *ffn_conv_w, *ffn_w_down, *final_norm;
  float* xb;
  char* ws;
  int ph_lo, ph_hi;
};

typedef __bf16 hbf16x2 __attribute__((ext_vector_type(2)));
typedef float f32x2 __attribute__((ext_vector_type(2)));
DI bf16_t f2bf(float x) { return __builtin_bit_cast(bf16_t, (__bf16)x); }
DI float bf2f(bf16_t v) { return __uint_as_float(((unsigned)v) << 16); }
DI unsigned pack2(float lo, float hi) { f32x2 v = {lo, hi}; return __builtin_bit_cast(unsigned, __builtin_convertvector(v, hbf16x2)); }
DI float bflo(unsigned w) { return __uint_as_float(w << 16); }
DI float bfhi(unsigned w) { return __uint_as_float(w & 0xffff0000u); }
DI float silu_f(float x) { return x / (1.f + __expf(-x)); }
DI float sigm_f(float x) { return 1.f / (1.f + __expf(-x)); }
DI float softplus_f(float x) { return fmaxf(x, 0.f) + log1pf(__expf(-fabsf(x))); }
DI float logsigm_f(float x) { return fminf(x, 0.f) - log1pf(__expf(-fabsf(x))); }
DI float gelu_tanh_f(float x) { float u = 0.7978845608f * (x + 0.044715f * x * x * x); return x * sigm_f(2.f * u); }
DI float wave_sum(float v) { for (int o = 32; o; o >>= 1) v += __shfl_xor(v, o); return v; }
DI float wave_max(float v) { for (int o = 32; o; o >>= 1) v = fmaxf(v, __shfl_xor(v, o)); return v; }
DI float wave_incl_scan(float v, int lane) { for (int o = 1; o < 64; o <<= 1) { float t = __shfl_up(v, o); if (lane >= o) v += t; } return v; }
DI float red16_max(float v) { v = fmaxf(v, __shfl_xor(v, 1)); v = fmaxf(v, __shfl_xor(v, 2)); v = fmaxf(v, __shfl_xor(v, 4)); v = fmaxf(v, __shfl_xor(v, 8)); return v; }
DI float red16_sum(float v) { v += __shfl_xor(v, 1); v += __shfl_xor(v, 2); v += __shfl_xor(v, 4); v += __shfl_xor(v, 8); return v; }
DI bf16x8 ld_frag(const bf16_t* p) { return *(const bf16x8*)p; }
DI bf16x8 mk_frag(unsigned a, unsigned b, unsigned c, unsigned d) { u32x4 u = {a, b, c, d}; return __builtin_bit_cast(bf16x8, u); }
DI bf16x8 frag_from_f32(const float* p, float sgn) {
  float4 a = *(const float4*)p, b = *(const float4*)(p + 4);
  return mk_frag(pack2(a.x * sgn, a.y * sgn), pack2(a.z * sgn, a.w * sgn), pack2(b.x * sgn, b.y * sgn), pack2(b.z * sgn, b.w * sgn));
}
DI int ltid() { int t = threadIdx.x; asm volatile("" : "+v"(t)); return t; }
DI int row_of(int b, int part, int t) { return part ? NLAT + b * TC + t : b * T + t; }

DI void tr_tile(const float* __restrict__ src, int K, int N, bf16_t* __restrict__ dst, const float* gain, int glo, int ghi, int tk, int tn, float* tile, int drow0 = -1) {
  const int tid = ltid(), c4 = tid & 15, rq = tid >> 4;
  const bool vec = (N & 3) == 0;
#pragma unroll
  for (int rr = 0; rr < 4; ++rr) {
    const int r = rr * 16 + rq, k = tk * 64 + r, n = tn * 64 + c4 * 4;
    float4 v;
    if (vec && n + 3 < N) v = *(const float4*)(src + (size_t)k * N + n);
    else { v.x = n < N ? src[(size_t)k * N + n] : 0.f; v.y = n + 1 < N ? src[(size_t)k * N + n + 1] : 0.f; v.z = n + 2 < N ? src[(size_t)k * N + n + 2] : 0.f; v.w = n + 3 < N ? src[(size_t)k * N + n + 3] : 0.f; }
    if (gain && k >= glo && k < ghi) { const float g = gain[k - glo]; v.x *= g; v.y *= g; v.z *= g; v.w *= g; }
    *(float4*)(tile + r * 68 + c4 * 4) = v;
  }
  __syncthreads();
#pragma unroll
  for (int q = 0; q < 2; ++q) {
    const int id = tid + 256 * q, n = id >> 3, k0 = (id & 7) * 8;
    u32x4 o;
    o.x = pack2(tile[(k0 + 0) * 68 + n], tile[(k0 + 1) * 68 + n]); o.y = pack2(tile[(k0 + 2) * 68 + n], tile[(k0 + 3) * 68 + n]);
    o.z = pack2(tile[(k0 + 4) * 68 + n], tile[(k0 + 5) * 68 + n]); o.w = pack2(tile[(k0 + 6) * 68 + n], tile[(k0 + 7) * 68 + n]);
    *(u32x4*)(dst + (size_t)((drow0 >= 0 ? drow0 : tn * 64) + n) * K + tk * 64 + k0) = o;
  }
  __syncthreads();
}

constexpr int TR_PER_LAYER = 3128, P0_TR = NL * TR_PER_LAYER, P0_MOD = NL * 96, P0_CPX = NLAT * 1024 / 4096, P0_CPC = 512 * 1024 / 4096;
constexpr int P0_ZERO = (int)((WS_NEED - OFF_HY + 65535) / 65536);
constexpr int P0_ITEMS = P0_TR + P0_MOD + P0_CPX + P0_CPC + (ZERO_FILL ? P0_ZERO : 0);

DI void p0_item(const Params& p, int item, char* smem) {
  const int tid = ltid();
  if (item < P0_MOD) {
    const int l = item / 96, cb = item % 96, cl = tid & 63, kq = tid >> 6;
    float* sv = (float*)smem;
    float* red = sv + 3072;
    for (int i = tid; i < 1024; i += 256) { sv[i] = silu_f(p.c[i]); sv[1024 + i] = silu_f(p.c[1024 + i]); sv[2048 + i] = silu_f(p.c_ctx[i]); }
    __syncthreads();
    const int col = cb * 64 + cl; const float* W = p.w_mod + (size_t)l * 1024 * 6144 + col;
    float a0 = 0.f, a1 = 0.f, a2 = 0.f;
#pragma unroll 16
    for (int k = kq * 256; k < kq * 256 + 256; ++k) { const float w = W[(size_t)k * 6144]; a0 += sv[k] * w; a1 += sv[1024 + k] * w; a2 += sv[2048 + k] * w; }
    red[(kq * 3 + 0) * 64 + cl] = a0; red[(kq * 3 + 1) * 64 + cl] = a1; red[(kq * 3 + 2) * 64 + cl] = a2;
    __syncthreads();
    if (tid < 192) {
      const int s = tid >> 6; const float bm = p.b_mod[l * 6144 + col];
      const float v = red[(0 * 3 + s) * 64 + cl] + red[(1 * 3 + s) * 64 + cl] + red[(2 * 3 + s) * 64 + cl] + red[(3 * 3 + s) * 64 + cl] + bm;
      ((float*)(p.ws + OFF_MOD))[(size_t)(l * 3 + s) * 6144 + col] = v;
    }
    __syncthreads();
    return;
  }
  item -= P0_MOD;
  if (item < P0_TR) {
    const int l = item / TR_PER_LAYER; int t = item % TR_PER_LAYER; float* tile = (float*)smem;
    if (t < 704) { tr_tile(p.w_in + (size_t)l * 1024 * 2744, 1024, 2744, (bf16_t*)(p.ws + OFF_WIN) + (size_t)l * 2816 * 1024, nullptr, 0, 0, t / 44, t % 44, tile); return; }
    t -= 704;
    if (t < 24) { tr_tile(p.mla_w_uq + (size_t)l * 256 * 384, 256, 384, (bf16_t*)(p.ws + OFF_WUQ) + (size_t)l * 384 * 256, p.mla_q_norm + l * 256, 0, 256, t / 6, t % 6, tile); return; }
    t -= 24;
    if (t < 16) { tr_tile(p.mla_w_ukv + (size_t)l * 128 * 512, 128, 512, (bf16_t*)(p.ws + OFF_WUKV) + (size_t)l * 512 * 128, p.mla_kv_norm + l * 128, 0, 128, t / 8, t % 8, tile); return; }
    t -= 16;
    if (t < 16) { tr_tile(p.s5_w_glu + (size_t)l * 256 * 256, 256, 256, (bf16_t*)(p.ws + OFF_WGLU) + (size_t)l * 256 * 256, nullptr, 0, 0, t / 4, t % 4, tile); return; }
    t -= 16;
    if (t < 256) { tr_tile(p.w_out + (size_t)l * 1024 * 1024, 1024, 1024, (bf16_t*)(p.ws + OFF_WOUT) + (size_t)l * 1024 * 1024, p.ssd_norm + l * 256, 512, 768, t / 16, t % 16, tile); return; }
    t -= 256;
    if (t < 1408) { tr_tile(p.ffn_w_up + (size_t)l * 1024 * 5632, 1024, 5632, (bf16_t*)(p.ws + OFF_WUP) + (size_t)l * 5632 * 1024, nullptr, 0, 0, t / 88, t % 88, tile, (t % 88) < 44 ? (t % 88) * 128 : ((t % 88) - 44) * 128 + 64); return; }
    t -= 1408;
    tr_tile(p.ffn_w_down + (size_t)l * 2816 * 1024, 2816, 1024, (bf16_t*)(p.ws + OFF_WDN) + (size_t)l * 1024 * 2816, nullptr, 0, 0, t / 16, t % 16, tile);
    return;
  }
  item -= P0_TR;
  if (item >= P0_CPX + P0_CPC) {
    item -= P0_CPX + P0_CPC;
    char* z = p.ws + OFF_HY + (size_t)item * 65536;
    const size_t lim = WS_NEED - OFF_HY - (size_t)item * 65536;
    for (int i = 0; i < 16; ++i) { const size_t o = (size_t)(i * 256 + tid) * 16; if (o < lim) *(u32x4*)(z + o) = (u32x4){0u, 0u, 0u, 0u}; }
    return;
  }
  const float* src; float* dst;
  if (item < P0_CPX) { src = p.x + (size_t)item * 4096; dst = p.xb + (size_t)item * 4096; }
  else { item -= P0_CPX; src = p.ctx + (size_t)item * 4096; dst = (float*)(p.ws + OFF_CTX) + (size_t)item * 4096; }
  for (int i = 0; i < 4; ++i) { const int o = (i * 256 + tid) * 4; *(float4*)(dst + o) = *(const float4*)(src + o); }
}

DI void norm_item(const Params& p, int l, int which, int item) {
  const int lane = ltid() & 63, w = __builtin_amdgcn_readfirstlane(ltid() >> 6), row = item * 4 + w;
  const float* x = row < NLAT ? p.xb + (size_t)row * 1024 : (const float*)(p.ws + OFF_CTX) + (size_t)(row - NLAT) * 1024;
  float4 v[4]; float ss = 0.f;
#pragma unroll
  for (int i = 0; i < 4; ++i) { v[i] = *(const float4*)(x + (i * 64 + lane) * 4); ss += v[i].x * v[i].x + v[i].y * v[i].y + v[i].z * v[i].z + v[i].w * v[i].w; }
  ss = wave_sum(ss);
  const float rstd = rsqrtf(ss * (1.f / 1024.f) + 1e-6f);
  const int s = row < NLAT ? row / T : 2;
  const float* g = (which ? p.norm2 : p.norm1) + l * 1024;
  const float* md = (const float*)(p.ws + OFF_MOD) + (size_t)(l * 3 + s) * 6144 + (which ? 3072 : 0);
  bf16_t* H = (bf16_t*)(p.ws + OFF_HY) + (size_t)row * 1024;
#pragma unroll
  for (int i = 0; i < 4; ++i) {
    const int k = (i * 64 + lane) * 4;
    const float4 g4 = *(const float4*)(g + k), sh = *(const float4*)(md + k), sc = *(const float4*)(md + 1024 + k);
    u32x2 o; o.x = pack2(v[i].x * rstd * g4.x * (1.f + sc.x) + sh.x, v[i].y * rstd * g4.y * (1.f + sc.y) + sh.y);
    o.y = pack2(v[i].z * rstd * g4.z * (1.f + sc.z) + sh.z, v[i].w * rstd * g4.w * (1.f + sc.w) + sh.w);
    *(u32x2*)(H + k) = o;
  }
}

DI u32x4 scale_bf8(u32x4 q, float s) {
  q.x = pack2(bflo(q.x) * s, bfhi(q.x) * s); q.y = pack2(bflo(q.y) * s, bfhi(q.y) * s);
  q.z = pack2(bflo(q.z) * s, bfhi(q.z) * s); q.w = pack2(bflo(q.w) * s, bfhi(q.w) * s); return q;
}
#define GEMM_STEP(AR, BR, KT)                                                                                         \
  {                                                                                                                   \
    if (AMODE == 1 && (KT) >= 8 && (KT) < 12) {                                                                       \
      _Pragma("unroll") for (int i = 0; i < 4; ++i) AR[i] = scale_bf8(AR[i], rs[i]);                                  \
    }                                                                                                                 \
    _Pragma("unroll") for (int i = 0; i < 4; ++i) { *(u32x4*)(As + (r0 + 32 * i) * 72 + cc * 8) = AR[i]; *(u32x4*)(Bs + (r0 + 32 * i) * 72 + cc * 8) = BR[i]; } \
    __syncthreads();                                                                                                  \
    if ((KT) + 2 < nk) {                                                                                              \
      _Pragma("unroll") for (int i = 0; i < 4; ++i) { AR[i] = *(const u32x4*)((CLAMP ? apx[i] : ap + i * astep) + ((KT) + 2) * 64); BR[i] = *(const u32x4*)(bp + i * bstep + ((KT) + 2) * 64); } \
    }                                                                                                                 \
    __builtin_amdgcn_sched_barrier(0);                                                                                \
    _Pragma("unroll") for (int ks = 0; ks < 2; ++ks) {                                                                \
      bf16x8 af[4], bfr[4];                                                                                           \
      _Pragma("unroll") for (int i = 0; i < 4; ++i) { af[i] = ld_frag(As + (64 * wm + 16 * i + l15) * 72 + ks * 32 + g4 * 8); bfr[i] = ld_frag(Bs + (64 * wn + 16 * i + l15) * 72 + ks * 32 + g4 * 8); } \
      _Pragma("unroll") for (int i = 0; i < 4; ++i)                                                                   \
        _Pragma("unroll") for (int j = 0; j < 4; ++j) acc[i][j] = MFMA16(bfr[j], af[i], acc[i][j]);                   \
    }                                                                                                                 \
    __syncthreads();                                                                                                  \
  }
template <int AMODE, int STAGE, class Epi, int CLAMP = 0>
DI void gemm_tile(const bf16_t* __restrict__ A, int lda, const bf16_t* __restrict__ Bt, int ldb, int K, int m0, int n0, char* smem, const float* ssq, Epi epi, int rlo = 0, int rhi = 0) {
  bf16_t* As = (bf16_t*)smem; bf16_t* Bs = As + 128 * 72;
  const int tid = ltid(), lane = tid & 63, w = __builtin_amdgcn_readfirstlane(tid >> 6), wm = w >> 1, wn = w & 1, l15 = lane & 15, g4 = lane >> 4;
  u32x4 ar0[4], br0[4], ar1[4], br1[4]; float rs[4];
  const int r0 = tid >> 3, cc = tid & 7;
  const bf16_t* ap = A + (size_t)(m0 + r0) * lda + cc * 8;
  const bf16_t* bp = Bt + (size_t)(n0 + r0) * ldb + cc * 8;
  const size_t astep = (size_t)32 * lda, bstep = (size_t)32 * ldb;
  const bf16_t* apx[4];
  if (CLAMP) {
#pragma unroll
    for (int i = 0; i < 4; ++i) { int r = m0 + r0 + 32 * i; r = r < rlo ? rlo : (r > rhi ? rhi : r); apx[i] = A + (size_t)r * lda + cc * 8; }
  }
  if (AMODE == 1) {
#pragma unroll
    for (int i = 0; i < 4; ++i) { const float* q = ssq + (m0 + r0 + 32 * i); rs[i] = rsqrtf((q[0] + q[NROW] + q[2 * NROW] + q[3 * NROW]) * (1.f / 256.f) + 1e-6f); }
  }
  f32x4 acc[4][4];
#pragma unroll
  for (int i = 0; i < 4; ++i)
#pragma unroll
    for (int j = 0; j < 4; ++j) acc[i][j] = (f32x4){0.f, 0.f, 0.f, 0.f};
  const int nk = K >> 6;
#pragma unroll
  for (int i = 0; i < 4; ++i) { ar0[i] = *(const u32x4*)(CLAMP ? apx[i] : ap + i * astep); br0[i] = *(const u32x4*)(bp + i * bstep); }
#pragma unroll
  for (int i = 0; i < 4; ++i) { ar1[i] = *(const u32x4*)((CLAMP ? apx[i] : ap + i * astep) + 64); br1[i] = *(const u32x4*)(bp + i * bstep + 64); }
  for (int kt = 0; kt < nk; kt += 2) {
    GEMM_STEP(ar0, br0, kt)
    GEMM_STEP(ar1, br1, kt + 1)
  }
  if (STAGE == 2) {
    float* Tf = (float*)smem;
#pragma unroll
    for (int h = 0; h < 2; ++h) {
      if (wm == h) {
#pragma unroll
        for (int i = 0; i < 4; ++i)
#pragma unroll
          for (int j = 0; j < 4; ++j) *(f32x4*)(Tf + (16 * i + l15) * 132 + 64 * wn + 16 * j + 4 * g4) = acc[i][j];
      }
      __syncthreads();
#pragma unroll
      for (int q = 0; q < 8; ++q) { const int id = tid + 256 * q, r = id >> 5, c = id & 31; epi(m0 + 64 * h + r, n0 + c * 4, *(const f32x4*)(Tf + r * 132 + c * 4)); }
      __syncthreads();
    }
    return;
  }
#pragma unroll
  for (int i = 0; i < 4; ++i)
#pragma unroll
    for (int j = 0; j < 4; ++j) epi(m0 + 64 * wm + 16 * i + l15, n0 + 64 * wn + 16 * j + 4 * g4, acc[i][j]);
}

DI void store_bf4(bf16_t* dst, f32x4 v) { u32x2 o; o.x = pack2(v[0], v[1]); o.y = pack2(v[2], v[3]); *(u32x2*)dst = o; }

DI void gemm_in_item(const Params& p, int l, int item, char* smem) {
  const int mtile = item / 22, nt = item % 22;
  int seq0, slen, ti;
  if (mtile < 132) { seq0 = (mtile / 66) * T; slen = T; ti = mtile % 66; }
  else { const int j = mtile - 132; seq0 = NLAT + (j / 3) * TC; slen = TC; ti = j % 3; }
  const int m0 = seq0 + 126 * ti - 1, n0 = nt * 128;
  bf16_t* P = (bf16_t*)(p.ws + OFF_P); float* GML = (float*)(p.ws + OFF_GML); float* DTR = (float*)(p.ws + OFF_DTR);
  bf16_t* Ts = (bf16_t*)smem;
  auto epi = [&](int row, int col, f32x4 v) {
    const int lr = row - m0, t = 126 * ti - 1 + lr;
    store_bf4(Ts + lr * 136 + (col - n0), v);
    if (lr >= 1 && lr <= 126 && t < slen) {
      if (col >= 1024 && col < 1040) *(f32x4*)(GML + (size_t)row * 16 + (col - 1024)) = v;
      if (col >= 2480 && col < 2488) *(f32x4*)(DTR + (size_t)row * 8 + (col - 2480)) = v;
    }
  };
  gemm_tile<0, 0, decltype(epi), 1>((const bf16_t*)(p.ws + OFF_HY), 1024, (const bf16_t*)(p.ws + OFF_WIN) + (size_t)l * 2816 * 1024, 1024, 1024, m0, n0, smem, nullptr, epi, seq0, seq0 + slen - 1);
  __syncthreads();
  {
    const int tid = ltid();
    const float* cw = p.ssd_conv_w + (size_t)l * 3 * 768; const float* cb = p.ssd_conv_b + l * 768;
#pragma unroll
    for (int q = 0; q < 8; ++q) {
      const int id = tid + 256 * q, lr = 1 + (id >> 4), c8 = (id & 15) * 8, t = 126 * ti - 1 + lr, col = n0 + c8;
      if (id < 2016 && t < slen) {
        u32x4 o = *(const u32x4*)(Ts + lr * 136 + c8);
        if (col >= C_XBC && col < C_XBC + 768) {
          const int ch = col - C_XBC;
          const u32x4 z = {0u, 0u, 0u, 0u};
          const u32x4 pm = t > 0 ? *(const u32x4*)(Ts + (lr - 1) * 136 + c8) : z, nx = t + 1 < slen ? *(const u32x4*)(Ts + (lr + 1) * 136 + c8) : z;
          const float a[8] = {bflo(pm.x), bfhi(pm.x), bflo(pm.y), bfhi(pm.y), bflo(pm.z), bfhi(pm.z), bflo(pm.w), bfhi(pm.w)};
          const float m[8] = {bflo(o.x), bfhi(o.x), bflo(o.y), bfhi(o.y), bflo(o.z), bfhi(o.z), bflo(o.w), bfhi(o.w)};
          const float n[8] = {bflo(nx.x), bfhi(nx.x), bflo(nx.y), bfhi(nx.y), bflo(nx.z), bfhi(nx.z), bflo(nx.w), bfhi(nx.w)};
          float r[8];
#pragma unroll
          for (int j = 0; j < 8; ++j) r[j] = silu_f(cb[ch + j] + cw[ch + j] * a[j] + cw[768 + ch + j] * m[j] + cw[1536 + ch + j] * n[j]);
          o.x = pack2(r[0], r[1]); o.y = pack2(r[2], r[3]); o.z = pack2(r[4], r[5]); o.w = pack2(r[6], r[7]);
        }
        *(u32x4*)(P + (size_t)(seq0 + t) * PINP + col) = o;
      }
    }
  }
  __syncthreads();
}

DI void tile_rstd(const bf16_t* P, int m0, int col0, int ncols, float* rst) {
  const int tid = ltid(), r = tid >> 1, hf = tid & 1, n = ncols >> 1;
  const bf16_t* src = P + (size_t)(m0 + r) * PINP + col0 + hf * n;
  float ss = 0.f;
  for (int c = 0; c < n; c += 8) { const u32x4 q = *(const u32x4*)(src + c);
    ss += bflo(q.x) * bflo(q.x) + bfhi(q.x) * bfhi(q.x) + bflo(q.y) * bflo(q.y) + bfhi(q.y) * bfhi(q.y) + bflo(q.z) * bflo(q.z) + bfhi(q.z) * bfhi(q.z) + bflo(q.w) * bflo(q.w) + bfhi(q.w) * bfhi(q.w); }
  ss += __shfl_xor(ss, 1);
  if (hf == 0) rst[r] = rsqrtf(ss / (float)ncols + 1e-6f);
  __syncthreads();
}
DI void qproj_item(const Params& p, int l, int item, char* smem) {
  const int mt = item / 3, nt = item % 3; const bf16_t* P = (const bf16_t*)(p.ws + OFF_P);
  float* rst = (float*)(smem + 36864);
  tile_rstd(P, mt * 128, C_CQ, 256, rst);
  bf16_t* Q = (bf16_t*)(p.ws + OFF_QRAW);
  gemm_tile<0, 0>(P + C_CQ, PINP, (const bf16_t*)(p.ws + OFF_WUQ) + (size_t)l * 384 * 256, 256, 256, mt * 128, nt * 128, smem, nullptr,
               [&](int row, int col, f32x4 v) { const float r = rst[row - mt * 128]; store_bf4(Q + (size_t)row * 384 + col, v * r); });
  __syncthreads();
}
DI void kvproj_item(const Params& p, int l, int item, char* smem) {
  const int mt = item / 4, nt = item % 4; const bf16_t* P = (const bf16_t*)(p.ws + OFF_P);
  float* rst = (float*)(smem + 36864);
  tile_rstd(P, mt * 128, C_CKV, 128, rst);
  bf16_t* KH = (bf16_t*)(p.ws + OFF_KH); bf16_t* VT = (bf16_t*)(p.ws + OFF_VT);
  gemm_tile<0, 0>(P + C_CKV, PINP, (const bf16_t*)(p.ws + OFF_WUKV) + (size_t)l * 512 * 128, 128, 128, mt * 128, nt * 128, smem, nullptr,
               [&](int row, int col, f32x4 v) {
                 const float r = rst[row - mt * 128]; v = v * r;
                 const int hh = col >> 7, dd = col & 127;
                 int b, tpos; if (row < NLAT) { b = row / T; tpos = row % T; } else { b = (row - NLAT) / TC; tpos = T + (row - NLAT) % TC; }
                 if (dd < 64) store_bf4(KH + ((size_t)(b * 4 + hh) * TALL + tpos) * 64 + dd, v);
                 else {
                   bf16_t* vp = VT + ((size_t)(b * 4 + hh) * 64 + (dd - 64)) * TALL + tpos;
                   vp[0] = f2bf(v[0]); vp[TALL] = f2bf(v[1]); vp[2 * TALL] = f2bf(v[2]); vp[3 * TALL] = f2bf(v[3]);
                 }
               });
  __syncthreads();
}
DI void rope_cs(int t, int i, float& cs, float& sn) {
  const int pos = (i < 8) ? (t >> 6) : (t & 63); const int f = i & 7;
  const float inv = exp2f(-(float)f * (13.287712379549449f / 8.f));
  const float ang = (float)pos * inv;
  cs = cosf(ang); sn = sinf(ang);
}
DI void ropek_item(const Params& p, int item) {
  const int row = item * 256 + ltid();
  const bf16_t* src = (const bf16_t*)(p.ws + OFF_P) + (size_t)row * PINP + C_KR;
  u32x4 q[4];
#pragma unroll
  for (int i = 0; i < 4; ++i) q[i] = *(const u32x4*)(src + i * 8);
  float v[32];
#pragma unroll
  for (int i = 0; i < 4; ++i) { v[i * 8 + 0] = bflo(q[i].x); v[i * 8 + 1] = bfhi(q[i].x); v[i * 8 + 2] = bflo(q[i].y); v[i * 8 + 3] = bfhi(q[i].y);
    v[i * 8 + 4] = bflo(q[i].z); v[i * 8 + 5] = bfhi(q[i].z); v[i * 8 + 6] = bflo(q[i].w); v[i * 8 + 7] = bfhi(q[i].w); }
  int b, tpos;
  if (row < NLAT) {
    b = row / T; tpos = row % T;
#pragma unroll
    for (int i = 0; i < 16; ++i) { float cs, sn; rope_cs(tpos, i, cs, sn); const float x1 = v[i], x2 = v[i + 16]; v[i] = x1 * cs - x2 * sn; v[i + 16] = x1 * sn + x2 * cs; }
  } else { b = (row - NLAT) / TC; tpos = T + (row - NLAT) % TC; }
  u32x4 o[4];
#pragma unroll
  for (int i = 0; i < 4; ++i) { o[i].x = pack2(v[i * 8], v[i * 8 + 1]); o[i].y = pack2(v[i * 8 + 2], v[i * 8 + 3]); o[i].z = pack2(v[i * 8 + 4], v[i * 8 + 5]); o[i].w = pack2(v[i * 8 + 6], v[i * 8 + 7]); }
  bf16_t* dst = (bf16_t*)(p.ws + OFF_KR) + ((size_t)b * TALL + tpos) * 32;
#pragma unroll
  for (int i = 0; i < 4; ++i) *(u32x4*)(dst + i * 8) = o[i];
}

DI void attn_item(const Params& p, int item, char* smem) {
  const int tid = ltid(), lane = tid & 63, w = __builtin_amdgcn_readfirstlane(tid >> 6), l15 = lane & 15, g4 = lane >> 4;
  int b, h, qt, latent;
  if (item < 512) { latent = 1; qt = item & 63; h = (item >> 6) & 3; b = item >> 8; }
  else { latent = 0; const int i2 = item - 512; qt = i2 & 1; h = (i2 >> 1) & 3; b = i2 >> 3; }
  const int qrow0 = latent ? b * T + qt * 128 : NLAT + b * TC + qt * 128;
  bf16_t* Qs = (bf16_t*)smem;
  bf16_t* Ks = (bf16_t*)smem;
  bf16_t* Vs = Ks + 64 * 104;
  const bf16_t* Qraw = (const bf16_t*)(p.ws + OFF_QRAW);
  const float qscale = 0.10206207261596577f * 1.4426950408889634f;
  for (int id = tid; id < 1280; id += 256) {
    const int r = id / 10, cc = id % 10;
    const bf16_t* src = Qraw + (size_t)(qrow0 + r) * 384 + h * 96 + cc * 8;
    const u32x4 q = *(const u32x4*)src;
    float a[8] = {bflo(q.x), bfhi(q.x), bflo(q.y), bfhi(q.y), bflo(q.z), bfhi(q.z), bflo(q.w), bfhi(q.w)};
    if (cc < 8) {
      u32x4 o; o.x = pack2(a[0] * qscale, a[1] * qscale); o.y = pack2(a[2] * qscale, a[3] * qscale); o.z = pack2(a[4] * qscale, a[5] * qscale); o.w = pack2(a[6] * qscale, a[7] * qscale);
      *(u32x4*)(Qs + r * 104 + cc * 8) = o;
    } else {
      const u32x4 q2 = *(const u32x4*)(src + 16);
      float c2[8] = {bflo(q2.x), bfhi(q2.x), bflo(q2.y), bfhi(q2.y), bflo(q2.z), bfhi(q2.z), bflo(q2.w), bfhi(q2.w)};
      float o1[8], o2[8];
#pragma unroll
      for (int j = 0; j < 8; ++j) {
        float cs = 1.f, sn = 0.f;
        if (latent) rope_cs(qt * 128 + r, (cc - 8) * 8 + j, cs, sn);
        o1[j] = (a[j] * cs - c2[j] * sn) * qscale; o2[j] = (a[j] * sn + c2[j] * cs) * qscale;
      }
      u32x4 o; o.x = pack2(o1[0], o1[1]); o.y = pack2(o1[2], o1[3]); o.z = pack2(o1[4], o1[5]); o.w = pack2(o1[6], o1[7]);
      *(u32x4*)(Qs + r * 104 + cc * 8) = o;
      o.x = pack2(o2[0], o2[1]); o.y = pack2(o2[2], o2[3]); o.z = pack2(o2[4], o2[5]); o.w = pack2(o2[6], o2[7]);
      *(u32x4*)(Qs + r * 104 + cc * 8 + 16) = o;
    }
  }
  __syncthreads();
  bf16x8 qf[2][3];
#pragma unroll
  for (int qs = 0; qs < 2; ++qs)
#pragma unroll
    for (int ks = 0; ks < 3; ++ks) qf[qs][ks] = ld_frag(Qs + (32 * w + 16 * qs + l15) * 104 + ks * 32 + g4 * 8);
  __syncthreads();
  const int kt0 = latent ? 0 : 128, kt1 = 132;
  const bf16_t* Kg = (const bf16_t*)(p.ws + OFF_KH) + (size_t)(b * 4 + h) * TALL * 64;
  const bf16_t* Rg = (const bf16_t*)(p.ws + OFF_KR) + (size_t)b * TALL * 32;
  const bf16_t* Vg = (const bf16_t*)(p.ws + OFF_VT) + (size_t)(b * 4 + h) * 64 * TALL;
  u32x4 kr[3], vr[2];
  const int ve0 = tid >> 3, vc = tid & 7;
  {
    kr[0] = *(const u32x4*)(Kg + (size_t)kt0 * 4096 + tid * 8); kr[1] = *(const u32x4*)(Kg + (size_t)kt0 * 4096 + (tid + 256) * 8);
    kr[2] = *(const u32x4*)(Rg + (size_t)kt0 * 2048 + tid * 8);
#pragma unroll
    for (int i = 0; i < 2; ++i) vr[i] = *(const u32x4*)(Vg + (size_t)(ve0 + 32 * i) * TALL + kt0 * 64 + vc * 8);
  }
  float mrun[2] = {0.f, 0.f}, lsum[2] = {0.f, 0.f};
  f32x4 O[4][2];
#pragma unroll
  for (int es = 0; es < 4; ++es)
#pragma unroll
    for (int qs = 0; qs < 2; ++qs) O[es][qs] = (f32x4){0.f, 0.f, 0.f, 0.f};
  constexpr int KVB = 64 * 104 + 64 * 72;
  {
#pragma unroll
    for (int i = 0; i < 2; ++i) { const int id = tid + 256 * i; *(u32x4*)(Ks + (id >> 3) * 104 + (id & 7) * 8) = kr[i]; }
    *(u32x4*)(Ks + (tid >> 2) * 104 + 64 + (tid & 3) * 8) = kr[2];
#pragma unroll
    for (int i = 0; i < 2; ++i) *(u32x4*)(Vs + (ve0 + 32 * i) * 72 + vc * 8) = vr[i];
    if (kt0 + 1 < kt1) {
      kr[0] = *(const u32x4*)(Kg + (size_t)(kt0 + 1) * 4096 + tid * 8); kr[1] = *(const u32x4*)(Kg + (size_t)(kt0 + 1) * 4096 + (tid + 256) * 8);
      kr[2] = *(const u32x4*)(Rg + (size_t)(kt0 + 1) * 2048 + tid * 8);
#pragma unroll
      for (int i = 0; i < 2; ++i) vr[i] = *(const u32x4*)(Vg + (size_t)(ve0 + 32 * i) * TALL + (kt0 + 1) * 64 + vc * 8);
    }
    __syncthreads();
  }
  for (int kt = kt0; kt < kt1; ++kt) {
    const int cur = (kt - kt0) & 1;
    const bf16_t* Kc = Ks + cur * KVB; const bf16_t* Vc = Vs + cur * KVB;
    bf16_t* Kn = Ks + (cur ^ 1) * KVB; bf16_t* Vn = Vs + (cur ^ 1) * KVB;
    if (kt + 1 < kt1) {
#pragma unroll
      for (int i = 0; i < 2; ++i) { const int id = tid + 256 * i; *(u32x4*)(Kn + (id >> 3) * 104 + (id & 7) * 8) = kr[i]; }
      *(u32x4*)(Kn + (tid >> 2) * 104 + 64 + (tid & 3) * 8) = kr[2];
#pragma unroll
      for (int i = 0; i < 2; ++i) *(u32x4*)(Vn + (ve0 + 32 * i) * 72 + vc * 8) = vr[i];
    }
    if (kt + 2 < kt1) {
      kr[0] = *(const u32x4*)(Kg + (size_t)(kt + 2) * 4096 + tid * 8); kr[1] = *(const u32x4*)(Kg + (size_t)(kt + 2) * 4096 + (tid + 256) * 8);
      kr[2] = *(const u32x4*)(Rg + (size_t)(kt + 2) * 2048 + tid * 8);
#pragma unroll
      for (int i = 0; i < 2; ++i) vr[i] = *(const u32x4*)(Vg + (size_t)(ve0 + 32 * i) * TALL + (kt + 2) * 64 + vc * 8);
    }
    __builtin_amdgcn_sched_barrier(0);
    f32x4 sa[4][2];
#pragma unroll
    for (int kb = 0; kb < 4; ++kb)
#pragma unroll
      for (int qs = 0; qs < 2; ++qs) { const float nm = -mrun[qs]; sa[kb][qs] = (f32x4){nm, nm, nm, nm}; }
#pragma unroll
    for (int ks = 0; ks < 3; ++ks)
#pragma unroll
      for (int kb = 0; kb < 4; ++kb) {
        const bf16x8 a = ld_frag(Kc + (16 * kb + l15) * 104 + ks * 32 + g4 * 8);
#pragma unroll
        for (int qs = 0; qs < 2; ++qs) sa[kb][qs] = MFMA16(a, qf[qs][ks], sa[kb][qs]);
      }
    bf16x8 pf[2][2];
    float dl[2];
#pragma unroll
    for (int qs = 0; qs < 2; ++qs) {
      float mx = -1e30f;
#pragma unroll
      for (int kb = 0; kb < 4; ++kb)
#pragma unroll
        for (int j = 0; j < 4; ++j) mx = fmaxf(mx, sa[kb][qs][j]);
      mx = fmaxf(mx, __shfl_xor(mx, 16)); mx = fmaxf(mx, __shfl_xor(mx, 32));
      dl[qs] = (kt == kt0) ? mx : fmaxf(mx, 0.f);
    }
    const bool grew = (kt == kt0) || __builtin_amdgcn_ballot_w64(dl[0] > 0.f || dl[1] > 0.f) != 0ull;
#pragma unroll
    for (int qs = 0; qs < 2; ++qs) {
      float ps = 0.f;
      if (grew) {
        const float d = dl[qs], alpha = (kt == kt0) ? 0.f : __builtin_amdgcn_exp2f(-d);
        mrun[qs] += d;
#pragma unroll
        for (int kb = 0; kb < 4; ++kb)
#pragma unroll
          for (int j = 0; j < 4; ++j) { const float e = __builtin_amdgcn_exp2f(sa[kb][qs][j] - d); sa[kb][qs][j] = e; ps += e; }
        lsum[qs] = lsum[qs] * alpha + ps;
#pragma unroll
        for (int es = 0; es < 4; ++es) O[es][qs] = O[es][qs] * alpha;
      } else {
#pragma unroll
        for (int kb = 0; kb < 4; ++kb)
#pragma unroll
          for (int j = 0; j < 4; ++j) { const float e = __builtin_amdgcn_exp2f(sa[kb][qs][j]); sa[kb][qs][j] = e; ps += e; }
        lsum[qs] += ps;
      }
#pragma unroll
      for (int k2 = 0; k2 < 2; ++k2)
        pf[qs][k2] = mk_frag(pack2(sa[2 * k2][qs][0], sa[2 * k2][qs][1]), pack2(sa[2 * k2][qs][2], sa[2 * k2][qs][3]),
                             pack2(sa[2 * k2 + 1][qs][0], sa[2 * k2 + 1][qs][1]), pack2(sa[2 * k2 + 1][qs][2], sa[2 * k2 + 1][qs][3]));
    }
#pragma unroll
    for (int k2 = 0; k2 < 2; ++k2)
#pragma unroll
      for (int es = 0; es < 4; ++es) {
        const bf16_t* vp = Vc + (16 * es + l15) * 72 + 32 * k2 + 4 * g4;
        const u32x2 lo = *(const u32x2*)vp, hi = *(const u32x2*)(vp + 16);
        const bf16x8 a = mk_frag(lo.x, lo.y, hi.x, hi.y);
#pragma unroll
        for (int qs = 0; qs < 2; ++qs) O[es][qs] = MFMA16(a, pf[qs][k2], O[es][qs]);
      }
    __syncthreads();
  }
  bf16_t* Y = (bf16_t*)(p.ws + OFF_HY);
#pragma unroll
  for (int qs = 0; qs < 2; ++qs) {
    float l = lsum[qs]; l += __shfl_xor(l, 16); l += __shfl_xor(l, 32);
    const float inv = 1.f / l;
    const int row = qrow0 + 32 * w + 16 * qs + l15;
#pragma unroll
    for (int es = 0; es < 4; ++es) store_bf4(Y + (size_t)row * 1024 + 256 + h * 64 + 16 * es + 4 * g4, O[es][qs] * inv);
  }
  __syncthreads();
}

DI void chunk_geom(int tcg, int b, int& part, int& tc, int& row0) { part = tcg >= 128; tc = part ? tcg - 128 : tcg; row0 = row_of(b, part, tc * 64); }
DI int chain_slot(int dir, int part, int tc) { return dir ? (part ? 3 - tc : 131 - tc) : (part ? tc : 4 + tc); }

DI void mlstm_p1(const Params& p, int l, int item, char* smem) {
  const int tid = ltid(), lane = tid & 63, w = __builtin_amdgcn_readfirstlane(tid >> 6), l15 = lane & 15, g4 = lane >> 4;
  const int tcg = item % NCH; int r = item / NCH; const int dir = r & 1; r >>= 1; const int h = r & 3, b = r >> 2;
  int part, tc, row0; chunk_geom(tcg, b, part, tc, row0);
  const int c = chain_slot(dir, part, tc), chain = (b * 4 + h) * 2 + dir;
  bf16_t* A = (bf16_t*)smem;
  bf16_t* Bk = A + 80 * 72;
  float* fs = (float*)(Bk + 64 * 72);
  const bf16_t* P = (const bf16_t*)(p.ws + OFF_P); const float* GML = (const float*)(p.ws + OFF_GML);
  float* MLM = (float*)(p.ws + OFF_MLM) + (size_t)(chain * NCH + c) * 32;
  if (tid < 64) {
    const int gi = 2 * dir;
    const float ig = GML[(size_t)(row0 + tid) * 16 + gi * 4 + h] + p.ml_gate_bias[l * 16 + gi * 4 + h];
    const float fg = GML[(size_t)(row0 + tid) * 16 + (gi + 1) * 4 + h] + p.ml_gate_bias[l * 16 + (gi + 1) * 4 + h];
    const float lf = logsigm_f(fg);
    const float pre = wave_incl_scan(lf, lane), tot = __shfl(pre, 63);
    const float bc = dir ? tot - pre + lf : pre;
    const float wlog = tot - bc + ig, mloc = wave_max(wlog), wv = __expf(wlog - mloc);
    fs[tid] = wv; A[64 * 72 + tid] = f2bf(wv);
    if (tid == 0) { MLM[0] = mloc; MLM[1] = tot; }
  }
  for (int i = tid; i < 15 * 72; i += 256) A[65 * 72 + i] = 0;
  __syncthreads();
  {
    const int s = tid >> 2, d0 = (tid & 3) * 16; const float wv = fs[s];
    const bf16_t* kp = P + (size_t)(row0 + s) * PINP + C_MLK + h * 64 + d0;
    const bf16_t* vp = P + (size_t)(row0 + s) * PINP + C_MLV + h * 64 + d0;
#pragma unroll
    for (int hf = 0; hf < 2; ++hf) {
      const u32x4 kq = *(const u32x4*)(kp + hf * 8), vq = *(const u32x4*)(vp + hf * 8);
      const float kk[8] = {bflo(kq.x), bfhi(kq.x), bflo(kq.y), bfhi(kq.y), bflo(kq.z), bfhi(kq.z), bflo(kq.w), bfhi(kq.w)};
      const float vv[8] = {bflo(vq.x), bfhi(vq.x), bflo(vq.y), bfhi(vq.y), bflo(vq.z), bfhi(vq.z), bflo(vq.w), bfhi(vq.w)};
#pragma unroll
      for (int j = 0; j < 8; ++j) { Bk[(d0 + hf * 8 + j) * 72 + s] = f2bf(kk[j] * 0.125f); A[(d0 + hf * 8 + j) * 72 + s] = f2bf(vv[j] * wv); }
    }
  }
  __syncthreads();
  float* MLS = (float*)(p.ws + OFF_MLS) + (size_t)(chain * NCH + c) * 4160;
  for (int t = w; t < 20; t += 4) {
    const int ms = t >> 2, ns = t & 3;
    f32x4 acc = {0.f, 0.f, 0.f, 0.f};
#pragma unroll
    for (int ks = 0; ks < 2; ++ks) acc = MFMA16(ld_frag(A + (16 * ms + l15) * 72 + ks * 32 + g4 * 8), ld_frag(Bk + (16 * ns + l15) * 72 + ks * 32 + g4 * 8), acc);
#pragma unroll
    for (int j = 0; j < 4; ++j) { const int e = 16 * ms + 4 * g4 + j; if (e <= 64) MLS[e * 64 + 16 * ns + l15] = acc[j]; }
  }
  __syncthreads();
}
DI void mlstm_p2(const Params& p, int item) {
  const int gi = item * 256 + ltid(), chain = gi / 4160, e = gi % 4160;
  float* MLS = (float*)(p.ws + OFF_MLS) + (size_t)chain * NCH * 4160 + e;
  float* MLM = (float*)(p.ws + OFF_MLM) + (size_t)chain * NCH * 32;
  float C = 0.f, m = 0.f;
  for (int c0 = 0; c0 < NCH; c0 += 12) {
    float d[12], ml[12], bl[12];
#pragma unroll
    for (int i = 0; i < 12; ++i) { d[i] = MLS[(size_t)(c0 + i) * 4160]; ml[i] = MLM[(c0 + i) * 32]; bl[i] = MLM[(c0 + i) * 32 + 1]; }
#pragma unroll
    for (int i = 0; i < 12; ++i) {
      MLS[(size_t)(c0 + i) * 4160] = C; if (e == 0) MLM[(c0 + i) * 32 + 16] = m;
      const float mn = fmaxf(bl[i] + m, ml[i]);
      C = __expf(bl[i] + m - mn) * C + __expf(ml[i] - mn) * d[i]; m = mn;
    }
  }
}
DI void mlstm_p3(const Params& p, int l, int item, char* smem) {
  const int tid = ltid(), lane = tid & 63, w = __builtin_amdgcn_readfirstlane(tid >> 6), l15 = lane & 15, g4 = lane >> 4;
  const int h = item & 3; const int r = item >> 2; const int tcg = r % NCH, b = r / NCH;
  int part, tc, row0; chunk_geom(tcg, b, part, tc, row0);
  bf16_t* Qs = (bf16_t*)smem;
  bf16_t* Ks = Qs + 64 * 72;
  bf16_t* Vt = Ks + 64 * 72;
  bf16_t* Sb = Vt + 64 * 72;
  float* fb = (float*)(Sb + 64 * 72);
  float* fi = fb + 64;
  const bf16_t* P = (const bf16_t*)(p.ws + OFF_P); const float* GML = (const float*)(p.ws + OFF_GML);
  {
    const int s = tid >> 2, d0 = (tid & 3) * 16;
    const bf16_t* base = P + (size_t)(row0 + s) * PINP + h * 64 + d0;
#pragma unroll
    for (int hf = 0; hf < 2; ++hf) {
      *(u32x4*)(Qs + s * 72 + d0 + hf * 8) = *(const u32x4*)(base + C_MLQ + hf * 8);
      const u32x4 kq = *(const u32x4*)(base + C_MLK + hf * 8), vq = *(const u32x4*)(base + C_MLV + hf * 8);
      u32x4 ko; ko.x = pack2(bflo(kq.x) * 0.125f, bfhi(kq.x) * 0.125f); ko.y = pack2(bflo(kq.y) * 0.125f, bfhi(kq.y) * 0.125f);
      ko.z = pack2(bflo(kq.z) * 0.125f, bfhi(kq.z) * 0.125f); ko.w = pack2(bflo(kq.w) * 0.125f, bfhi(kq.w) * 0.125f);
      *(u32x4*)(Ks + s * 72 + d0 + hf * 8) = ko;
      const unsigned vw[4] = {vq.x, vq.y, vq.z, vq.w};
#pragma unroll
      for (int j = 0; j < 4; ++j) { Vt[(d0 + hf * 8 + 2 * j) * 72 + s] = (bf16_t)(vw[j] & 0xffffu); Vt[(d0 + hf * 8 + 2 * j + 1) * 72 + s] = (bf16_t)(vw[j] >> 16); }
    }
  }
  f32x4 hs[4];
#pragma unroll
  for (int ns = 0; ns < 4; ++ns) hs[ns] = (f32x4){0.f, 0.f, 0.f, 0.f};
#pragma unroll 1
  for (int dir = 0; dir < 2; ++dir) {
    const int c = chain_slot(dir, part, tc), chain = (b * 4 + h) * 2 + dir;
    const float m_in = ((const float*)(p.ws + OFF_MLM))[(size_t)(chain * NCH + c) * 32 + 16];
    const float* Cst = (const float*)(p.ws + OFF_MLS) + (size_t)(chain * NCH + c) * 4160;
    __syncthreads();
    if (tid < 64) {
      const int gi = 2 * dir;
      const float ig = GML[(size_t)(row0 + tid) * 16 + gi * 4 + h] + p.ml_gate_bias[l * 16 + gi * 4 + h];
      const float fg = GML[(size_t)(row0 + tid) * 16 + (gi + 1) * 4 + h] + p.ml_gate_bias[l * 16 + (gi + 1) * 4 + h];
      const float lf = logsigm_f(fg);
      const float pre = wave_incl_scan(lf, lane), tot = __shfl(pre, 63);
      fb[tid] = dir ? tot - pre + lf : pre; fi[tid] = ig;
    }
    __syncthreads();
    f32x4 sc[4];
#pragma unroll
    for (int ns = 0; ns < 4; ++ns) {
      f32x4 a = {0.f, 0.f, 0.f, 0.f};
#pragma unroll
      for (int ks = 0; ks < 2; ++ks) a = MFMA16(ld_frag(Qs + (16 * w + l15) * 72 + ks * 32 + g4 * 8), ld_frag(Ks + (16 * ns + l15) * 72 + ks * 32 + g4 * 8), a);
      sc[ns] = a;
    }
    float bi[4], mt[4], rsum[4];
#pragma unroll
    for (int j = 0; j < 4; ++j) {
      const int i = 16 * w + 4 * g4 + j; bi[j] = fb[i];
      float mx = -1e30f;
#pragma unroll
      for (int ns = 0; ns < 4; ++ns) { const int s = 16 * ns + l15; const bool ok = dir ? (s >= i) : (s <= i); const float dm = bi[j] - fb[s] + fi[s]; if (ok) mx = fmaxf(mx, dm); }
      mx = red16_max(mx);
      mt[j] = fmaxf(bi[j] + m_in, mx);
      float rs = 0.f;
#pragma unroll
      for (int ns = 0; ns < 4; ++ns) {
        const int s = 16 * ns + l15; const bool ok = dir ? (s >= i) : (s <= i);
        const float v = ok ? sc[ns][j] * __expf(bi[j] - fb[s] + fi[s] - mt[j]) : 0.f;
        rs += v; Sb[i * 72 + s] = f2bf(v);
      }
      rsum[j] = red16_sum(rs);
    }
    __syncthreads();
    f32x4 qc[5];
#pragma unroll
    for (int ns = 0; ns < 5; ++ns) {
      f32x4 a = {0.f, 0.f, 0.f, 0.f};
      const int e = 16 * ns + l15;
#pragma unroll
      for (int ks = 0; ks < 2; ++ks) {
        bf16x8 bfm;
        if (e <= 64) bfm = frag_from_f32(Cst + e * 64 + ks * 32 + g4 * 8, 1.f); else bfm = mk_frag(0u, 0u, 0u, 0u);
        a = MFMA16(ld_frag(Qs + (16 * w + l15) * 72 + ks * 32 + g4 * 8), bfm, a);
      }
      qc[ns] = a;
    }
    f32x4 nm[4];
#pragma unroll
    for (int ns = 0; ns < 4; ++ns) {
      f32x4 a = {0.f, 0.f, 0.f, 0.f};
#pragma unroll
      for (int ks = 0; ks < 2; ++ks) a = MFMA16(ld_frag(Sb + (16 * w + l15) * 72 + ks * 32 + g4 * 8), ld_frag(Vt + (16 * ns + l15) * 72 + ks * 32 + g4 * 8), a);
      nm[ns] = a;
    }
#pragma unroll
    for (int j = 0; j < 4; ++j) {
      const float wi = __expf(bi[j] + m_in - mt[j]);
      const float qn = __shfl(qc[4][j], lane & 48);
      const float den = rsum[j] + wi * qn;
      const float dd = 1.f / fmaxf(fabsf(den), __expf(-mt[j]));
#pragma unroll
      for (int ns = 0; ns < 4; ++ns) hs[ns][j] += (nm[ns][j] + wi * qc[ns][j]) * dd;
    }
  }
  bf16_t* Y = (bf16_t*)(p.ws + OFF_HY);
#pragma unroll
  for (int j = 0; j < 4; ++j) {
    float ss = 0.f;
#pragma unroll
    for (int ns = 0; ns < 4; ++ns) ss += hs[ns][j] * hs[ns][j];
    ss = red16_sum(ss);
    const float rstd = rsqrtf(ss * (1.f / 64.f) + 1e-6f);
    const int row = row0 + 16 * w + 4 * g4 + j;
#pragma unroll
    for (int ns = 0; ns < 4; ++ns) {
      const int ch = h * 64 + 16 * ns + l15;
      const float o = bf2f(P[(size_t)row * PINP + C_MLO + ch]);
      Y[(size_t)row * 1024 + ch] = f2bf(hs[ns][j] * rstd * p.ml_norm[l * 256 + ch] * sigm_f(o));
    }
  }
  __syncthreads();
}

DI void conv_silu8(const Params& p, int l, const bf16_t* P, int row, bool hp, bool hn, int ch, float* out) {
  const u32x4 c0 = *(const u32x4*)(P + (size_t)row * PINP + C_XBC + ch);
  out[0] = bflo(c0.x); out[1] = bfhi(c0.x); out[2] = bflo(c0.y); out[3] = bfhi(c0.y); out[4] = bflo(c0.z); out[5] = bfhi(c0.z); out[6] = bflo(c0.w); out[7] = bfhi(c0.w);
}
DI void ssd_gates(const Params& p, int l, int dir, int h, int row0, int tid, int lane, float& dt, float& cs, float& tot) {
  const float* DTR = (const float*)(p.ws + OFF_DTR);
  dt = softplus_f(DTR[(size_t)(row0 + tid) * 8 + dir * 4 + h] + p.ssd_dt_bias[l * 8 + dir * 4 + h]);
  const float la = -dt * __expf(p.ssd_a_log[l * 8 + dir * 4 + h]);
  const float pre = wave_incl_scan(la, lane); tot = __shfl(pre, 63);
  cs = dir ? tot - pre + la : pre;
}
DI void ssd_p1(const Params& p, int l, int item, char* smem) {
  const int tid = ltid(), lane = tid & 63, w = __builtin_amdgcn_readfirstlane(tid >> 6), l15 = lane & 15, g4 = lane >> 4;
  const int tcg = item % NCH; int r = item / NCH; const int dir = r & 1; r >>= 1; const int h = r & 3, b = r >> 2;
  int part, tc, row0; chunk_geom(tcg, b, part, tc, row0);
  const int c = chain_slot(dir, part, tc), chain = (b * 4 + h) * 2 + dir, lastc = part ? 3 : 127;
  bf16_t* Xt = (bf16_t*)smem;
  bf16_t* Bt = Xt + 64 * 72;
  float* fs = (float*)(Bt + 128 * 72);
  const bf16_t* P = (const bf16_t*)(p.ws + OFF_P);
  if (tid < 64) {
    float dt, cs, tot; ssd_gates(p, l, dir, h, row0, tid, lane, dt, cs, tot);
    fs[tid] = __expf(tot - cs) * dt;
    if (tid == 0) ((float*)(p.ws + OFF_SSA))[(chain * NCH + c) * 32] = tot;
  }
  __syncthreads();
  const int grp = h >> 1;
  for (int id = tid; id < 64 * 24; id += 256) {
    const int s = id / 24, cc = id % 24;
    const bool hp = !(tc == 0 && s == 0), hn = !(tc == lastc && s == 63);
    float v[8];
    if (cc < 8) { conv_silu8(p, l, P, row0 + s, hp, hn, h * 64 + cc * 8, v); const float wv = fs[s];
#pragma unroll
      for (int j = 0; j < 8; ++j) Xt[(cc * 8 + j) * 72 + s] = f2bf(v[j] * wv); }
    else { const int n0 = (cc - 8) * 8; conv_silu8(p, l, P, row0 + s, hp, hn, 256 + grp * 128 + n0, v);
#pragma unroll
      for (int j = 0; j < 8; ++j) Bt[(n0 + j) * 72 + s] = f2bf(v[j]); }
  }
  __syncthreads();
  float* SS = (float*)(p.ws + OFF_SSDS) + (size_t)(chain * NCH + c) * 8192;
#pragma unroll
  for (int ns = 0; ns < 8; ++ns) {
    f32x4 acc = {0.f, 0.f, 0.f, 0.f};
#pragma unroll
    for (int ks = 0; ks < 2; ++ks) acc = MFMA16(ld_frag(Xt + (16 * w + l15) * 72 + ks * 32 + g4 * 8), ld_frag(Bt + (16 * ns + l15) * 72 + ks * 32 + g4 * 8), acc);
#pragma unroll
    for (int j = 0; j < 4; ++j) SS[(16 * w + 4 * g4 + j) * 128 + 16 * ns + l15] = acc[j];
  }
  __syncthreads();
}
DI void ssd_p2(const Params& p, int item) {
  const int gi = item * 256 + ltid(), chain = gi >> 13, e = gi & 8191;
  float* SS = (float*)(p.ws + OFF_SSDS) + (size_t)chain * NCH * 8192 + e;
  const float* SA = (const float*)(p.ws + OFF_SSA) + (size_t)chain * NCH * 32;
  float S = 0.f;
  for (int c0 = 0; c0 < NCH; c0 += 12) {
    float d[12], a[12];
#pragma unroll
    for (int i = 0; i < 12; ++i) { d[i] = SS[(size_t)(c0 + i) * 8192]; a[i] = SA[(c0 + i) * 32]; }
#pragma unroll
    for (int i = 0; i < 12; ++i) { SS[(size_t)(c0 + i) * 8192] = S; S = __expf(a[i]) * S + d[i]; }
  }
}
DI void ssd_p3(const Params& p, int l, int item, char* smem) {
  const int tid = ltid(), lane = tid & 63, w = __builtin_amdgcn_readfirstlane(tid >> 6), l15 = lane & 15, g4 = lane >> 4;
  const int h = item & 3; const int r = item >> 2; const int tcg = r % NCH, b = r / NCH;
  int part, tc, row0; chunk_geom(tcg, b, part, tc, row0);
  const int lastc = part ? 3 : 127, grp = h >> 1;
  bf16_t* Cm = (bf16_t*)smem;
  bf16_t* Bm = Cm + 64 * 136;
  bf16_t* Xt = Bm + 64 * 136;
  bf16_t* Sb = Xt + 64 * 72;
  float* fcs = (float*)(Sb + 64 * 72);
  float* fdt = fcs + 64;
  const bf16_t* P = (const bf16_t*)(p.ws + OFF_P);
  for (int id = tid; id < 64 * 40; id += 256) {
    const int s = id / 40, cc = id % 40;
    const bool hp = !(tc == 0 && s == 0), hn = !(tc == lastc && s == 63);
    float v[8];
    if (cc < 8) { conv_silu8(p, l, P, row0 + s, hp, hn, h * 64 + cc * 8, v);
#pragma unroll
      for (int j = 0; j < 8; ++j) Xt[(cc * 8 + j) * 72 + s] = f2bf(v[j]); }
    else {
      const int q = cc - 8, isC = q >= 16, n0 = (q & 15) * 8;
      conv_silu8(p, l, P, row0 + s, hp, hn, 256 + isC * 256 + grp * 128 + n0, v);
      u32x4 o; o.x = pack2(v[0], v[1]); o.y = pack2(v[2], v[3]); o.z = pack2(v[4], v[5]); o.w = pack2(v[6], v[7]);
      *(u32x4*)((isC ? Cm : Bm) + s * 136 + n0) = o;
    }
  }
  f32x4 ys[4];
#pragma unroll
  for (int ns = 0; ns < 4; ++ns) ys[ns] = (f32x4){0.f, 0.f, 0.f, 0.f};
#pragma unroll 1
  for (int dir = 0; dir < 2; ++dir) {
    const int c = chain_slot(dir, part, tc), chain = (b * 4 + h) * 2 + dir;
    const float* St = (const float*)(p.ws + OFF_SSDS) + (size_t)(chain * NCH + c) * 8192;
    __syncthreads();
    if (tid < 64) { float dt, cs, tot; ssd_gates(p, l, dir, h, row0, tid, lane, dt, cs, tot); fcs[tid] = cs; fdt[tid] = dt; }
    __syncthreads();
    float ci[4];
#pragma unroll
    for (int j = 0; j < 4; ++j) ci[j] = fcs[16 * w + 4 * g4 + j];
#pragma unroll
    for (int ns = 0; ns < 4; ++ns) {
      f32x4 a = {0.f, 0.f, 0.f, 0.f};
#pragma unroll
      for (int ks = 0; ks < 4; ++ks) a = MFMA16(ld_frag(Cm + (16 * w + l15) * 136 + ks * 32 + g4 * 8), ld_frag(Bm + (16 * ns + l15) * 136 + ks * 32 + g4 * 8), a);
      const int s = 16 * ns + l15; const float css = fcs[s], dts = fdt[s];
#pragma unroll
      for (int j = 0; j < 4; ++j) {
        const int i = 16 * w + 4 * g4 + j; const bool ok = dir ? (s >= i) : (s <= i);
        Sb[i * 72 + s] = f2bf(ok ? a[j] * __expf(ci[j] - css) * dts : 0.f);
      }
    }
    __syncthreads();
#pragma unroll
    for (int ns = 0; ns < 4; ++ns) {
      f32x4 a = {0.f, 0.f, 0.f, 0.f}, bq = {0.f, 0.f, 0.f, 0.f};
#pragma unroll
      for (int ks = 0; ks < 2; ++ks) a = MFMA16(ld_frag(Sb + (16 * w + l15) * 72 + ks * 32 + g4 * 8), ld_frag(Xt + (16 * ns + l15) * 72 + ks * 32 + g4 * 8), a);
#pragma unroll
      for (int ks = 0; ks < 4; ++ks) bq = MFMA16(ld_frag(Cm + (16 * w + l15) * 136 + ks * 32 + g4 * 8), frag_from_f32(St + (16 * ns + l15) * 128 + ks * 32 + g4 * 8, 1.f), bq);
#pragma unroll
      for (int j = 0; j < 4; ++j) ys[ns][j] += a[j] + __expf(ci[j]) * bq[j];
    }
  }
  bf16_t* Y = (bf16_t*)(p.ws + OFF_HY); float* SSQ = (float*)(p.ws + OFF_SSQ);
  const float dsk = p.ssd_d[l * 4 + h];
#pragma unroll
  for (int j = 0; j < 4; ++j) {
    const int i = 16 * w + 4 * g4 + j, row = row0 + i; float ss = 0.f;
#pragma unroll
    for (int ns = 0; ns < 4; ++ns) {
      const int pp = 16 * ns + l15;
      const float xv = bf2f(Xt[pp * 72 + i]);
      const float z = bf2f(P[(size_t)row * PINP + C_Z + h * 64 + pp]);
      const float g = (ys[ns][j] + dsk * xv) * silu_f(z);
      ss += g * g; Y[(size_t)row * 1024 + 512 + h * 64 + pp] = f2bf(g);
    }
    ss = red16_sum(ss);
    if (l15 == 0) SSQ[(size_t)h * NROW + row] = ss;
  }
  __syncthreads();
}

struct S5Par { float are, aim, bre[16], bim[16]; };
DI void s5_params(const Params& p, int l, int dir, int g, int n, S5Par& q, float& dtv, float& lre, float& lim) {
  const int ai = ((l * 2 + dir) * 16 + g) * 64 + n;
  lre = fminf(p.s5_a_re[ai], -1e-4f); lim = p.s5_a_im[ai];
  dtv = __expf(p.s5_log_dt[(l * 2 + dir) * 16 + g]);
  const float mag = __expf(lre * dtv), ang = lim * dtv;
  q.are = mag * cosf(ang); q.aim = mag * sinf(ang);
  const float den = lre * lre + lim * lim;
  const float fre = ((q.are - 1.f) * lre + q.aim * lim) / den, fim = (q.aim * lre - (q.are - 1.f) * lim) / den;
  const float* br = p.s5_b_re + ((size_t)(l * 16 + g) * 64 + n) * 16; const float* bi = p.s5_b_im + ((size_t)(l * 16 + g) * 64 + n) * 16;
#pragma unroll
  for (int j = 0; j < 16; ++j) { q.bre[j] = fre * br[j] - fim * bi[j]; q.bim[j] = fre * bi[j] + fim * br[j]; }
}
DI void s5_step(const S5Par& q, const bf16_t* us, int s, float& xr, float& xi) {
  const u32x4 a0 = *(const u32x4*)(us + s * 16), a1 = *(const u32x4*)(us + s * 16 + 8);
  const unsigned uw[8] = {a0.x, a0.y, a0.z, a0.w, a1.x, a1.y, a1.z, a1.w};
  float br = 0.f, bi = 0.f;
#pragma unroll
  for (int j = 0; j < 8; ++j) { const float a = bflo(uw[j]), c = bfhi(uw[j]); br += q.bre[2 * j] * a + q.bre[2 * j + 1] * c; bi += q.bim[2 * j] * a + q.bim[2 * j + 1] * c; }
  const float nr = q.are * xr - q.aim * xi + br, ni = q.are * xi + q.aim * xr + bi;
  xr = nr; xi = ni;
}
DI void s5_p1(const Params& p, int l, int item, char* smem) {
  const int lane = ltid() & 63, wi = item * 4 + __builtin_amdgcn_readfirstlane(ltid() >> 6);
  const int tcg = wi % NCH; int r = wi / NCH; const int dir = r & 1; r >>= 1; const int g = r & 15, b = r >> 4;
  int part, tc, row0; chunk_geom(tcg, b, part, tc, row0);
  const int c = chain_slot(dir, part, tc);
  S5Par q; float dtv, lre, lim; s5_params(p, l, dir, g, lane, q, dtv, lre, lim);
  const bf16_t* up = (const bf16_t*)(p.ws + OFF_P) + (size_t)(row0 + lane) * PINP + C_S5 + g * 16;
  bf16_t* us = (bf16_t*)smem + __builtin_amdgcn_readfirstlane(ltid() >> 6) * 1024;
  *(u32x4*)(us + lane * 16) = *(const u32x4*)up; *(u32x4*)(us + lane * 16 + 8) = *(const u32x4*)(up + 8);
  float xr = 0.f, xi = 0.f;
  for (int st = 0; st < 64; ++st) { const int s = dir ? 63 - st : st; s5_step(q, us, s, xr, xi); }
  float* S = (float*)(p.ws + OFF_S5S) + ((size_t)((b * 16 + g) * 2 + dir) * NCH + c) * 128;
  S[lane] = xr; S[64 + lane] = xi;
}
DI void s5_p2(const Params& p, int l, int item) {
  const int gi = item * 256 + ltid(), n = gi & 63, dir = (gi >> 6) & 1, g = (gi >> 7) & 15, b = gi >> 11;
  const int ai = ((l * 2 + dir) * 16 + g) * 64 + n;
  const float lre = fminf(p.s5_a_re[ai], -1e-4f), lim = p.s5_a_im[ai], dtv = __expf(p.s5_log_dt[(l * 2 + dir) * 16 + g]);
  const float mag = __expf(64.f * lre * dtv), ang = 64.f * (lim * dtv);
  const float ar = mag * cosf(ang), aim = mag * sinf(ang);
  float* S = (float*)(p.ws + OFF_S5S) + (size_t)((b * 16 + g) * 2 + dir) * NCH * 128 + n;
  float xr = 0.f, xi = 0.f;
  for (int c0 = 0; c0 < NCH; c0 += 12) {
    float dr[12], di[12];
#pragma unroll
    for (int i = 0; i < 12; ++i) { dr[i] = S[(c0 + i) * 128]; di[i] = S[(c0 + i) * 128 + 64]; }
#pragma unroll
    for (int i = 0; i < 12; ++i) { S[(c0 + i) * 128] = xr; S[(c0 + i) * 128 + 64] = xi; const float nr = ar * xr - aim * xi + dr[i], ni = ar * xi + aim * xr + di[i]; xr = nr; xi = ni; }
  }
}
DI void s5_p3(const Params& p, int l, int item, char* smem) {
  const int tid = ltid(), lane = tid & 63, w = __builtin_amdgcn_readfirstlane(tid >> 6), l15 = lane & 15, g4 = lane >> 4;
  const int half = item & 1; const int r2 = item >> 1; const int tcg = r2 % NCH, b = r2 / NCH;
  int part, tc, row0; chunk_geom(tcg, b, part, tc, row0);
  bf16_t* xs = (bf16_t*)smem + w * (16 * 136);
  bf16_t* YG = (bf16_t*)(p.ws + OFF_YG);
  const bf16_t* P = (const bf16_t*)(p.ws + OFF_P);
#pragma unroll 1
  for (int gi = 0; gi < 2; ++gi) {
    const int g = half * 8 + w + 4 * gi;
    const bf16_t* up = P + (size_t)(row0 + lane) * PINP + C_S5 + g * 16;
    bf16_t* us = (bf16_t*)smem + 25600 + w * 1024;
    *(u32x4*)(us + lane * 16) = *(const u32x4*)up; *(u32x4*)(us + lane * 16 + 8) = *(const u32x4*)(up + 8);
    f32x4 yt[4];
#pragma unroll
    for (int ib = 0; ib < 4; ++ib) yt[ib] = (f32x4){0.f, 0.f, 0.f, 0.f};
#pragma unroll
    for (int dir = 0; dir < 2; ++dir) {
      S5Par q; float dtv, lre, lim; s5_params(p, l, dir, g, lane, q, dtv, lre, lim);
      const int c = chain_slot(dir, part, tc);
      const float* S = (const float*)(p.ws + OFF_S5S) + ((size_t)((b * 16 + g) * 2 + dir) * NCH + c) * 128;
      float xr = S[lane], xi = S[64 + lane];
      bf16x8 cf[4];
#pragma unroll
      for (int ks = 0; ks < 4; ++ks) {
        const int k = ks * 32 + g4 * 8;
        const float* src = (k < 64 ? p.s5_c_re : p.s5_c_im) + ((size_t)(l * 16 + g) * 16 + l15) * 64 + (k & 63);
        cf[ks] = frag_from_f32(src, k < 64 ? 1.f : -1.f);
      }
#pragma unroll
      for (int blk = 0; blk < 4; ++blk) {
        asm volatile("s_waitcnt lgkmcnt(0)" ::: "memory");
#pragma unroll 4
        for (int st = 0; st < 16; ++st) {
          const int step = blk * 16 + st, s = dir ? 63 - step : step;
          s5_step(q, us, s, xr, xi);
          xs[(s & 15) * 136 + lane] = f2bf(xr); xs[(s & 15) * 136 + 64 + lane] = f2bf(xi);
        }
        asm volatile("s_waitcnt lgkmcnt(0)" ::: "memory");
        f32x4 a = {0.f, 0.f, 0.f, 0.f};
#pragma unroll
        for (int ks = 0; ks < 4; ++ks) a = MFMA16(ld_frag(xs + l15 * 136 + ks * 32 + g4 * 8), cf[ks], a);
        const int ib = dir ? 3 - blk : blk;
        yt[ib] += a;
      }
    }
#pragma unroll
    for (int ib = 0; ib < 4; ++ib)
#pragma unroll
      for (int j = 0; j < 4; ++j) {
        const int tok = 16 * ib + 4 * g4 + j, ch = g * 16 + l15;
        const float u = bf2f(P[(size_t)(row0 + tok) * PINP + C_S5 + ch]);
        YG[(size_t)(row0 + tok) * 256 + ch] = f2bf(gelu_tanh_f(yt[ib][j] + p.s5_d[l * 256 + ch] * u));
      }
  }
  __syncthreads();
}
DI void glu_item(const Params& p, int l, int item, char* smem) {
  const int mt = item >> 1, nt = item & 1;
  const bf16_t* YG = (const bf16_t*)(p.ws + OFF_YG); bf16_t* Y = (bf16_t*)(p.ws + OFF_HY);
  gemm_tile<0, 0>(YG, 256, (const bf16_t*)(p.ws + OFF_WGLU) + (size_t)l * 256 * 256, 256, 256, mt * 128, nt * 128, smem, nullptr,
                  [&](int row, int col, f32x4 v) {
                    const u32x2 yv = *(const u32x2*)(YG + (size_t)row * 256 + col);
                    f32x4 o; o[0] = bflo(yv.x) * sigm_f(v[0]); o[1] = bfhi(yv.x) * sigm_f(v[1]); o[2] = bflo(yv.y) * sigm_f(v[2]); o[3] = bfhi(yv.y) * sigm_f(v[3]);
                    store_bf4(Y + (size_t)row * 1024 + 768 + col, o);
                  });
}

DI void outproj_item(const Params& p, int l, int item, char* smem) {
  const int mt = item >> 3, nt = item & 7;
  const float* MOD = (const float*)(p.ws + OFF_MOD);
  gemm_tile<1, 2>((const bf16_t*)(p.ws + OFF_HY), 1024, (const bf16_t*)(p.ws + OFF_WOUT) + (size_t)l * 1024 * 1024, 1024, 1024, mt * 128, nt * 128, smem, (const float*)(p.ws + OFF_SSQ),
               [&](int row, int col, f32x4 v) {
                 const int s = row < NLAT ? row / T : 2;
                 const f32x4 gt = *(const f32x4*)(MOD + (size_t)(l * 3 + s) * 6144 + 2048 + col);
                 float* xp = row < NLAT ? p.xb + (size_t)row * 1024 + col : (float*)(p.ws + OFF_CTX) + (size_t)(row - NLAT) * 1024 + col;
                 *(f32x4*)xp = *(f32x4*)xp + gt * v;
               });
}
DI void ffnup_item(const Params& p, int l, int item, char* smem) {
  const int mtile = item / 44, nt = item % 44;
  int seq0, slen, ti;
  if (mtile < 132) { seq0 = (mtile / 66) * T; slen = T; ti = mtile % 66; }
  else { const int j = mtile - 132; seq0 = NLAT + (j / 3) * TC; slen = TC; ti = j % 3; }
  const int m0 = seq0 + 126 * ti - 1, n0 = nt * 128;
  bf16_t* ACT = (bf16_t*)(p.ws + OFF_R);
  bf16_t* Ts = (bf16_t*)smem;
  auto epi = [&](int row, int col, f32x4 v) {
    const int lr = row - m0, c = col - n0, t = 126 * ti - 1 + lr;
    if (c >= 64 && (t < 0 || t >= slen)) v = (f32x4){0.f, 0.f, 0.f, 0.f};
    store_bf4(Ts + lr * 136 + c, v);
  };
  gemm_tile<0, 0, decltype(epi), 1>((const bf16_t*)(p.ws + OFF_HY), 1024, (const bf16_t*)(p.ws + OFF_WUP) + (size_t)l * 5632 * 1024, 1024, 1024, m0, n0, smem, nullptr, epi, seq0, seq0 + slen - 1);
  __syncthreads();
  {
    const int tid = ltid();
    const float* cw = p.ffn_conv_w + (size_t)l * 3 * DFF + nt * 64;
#pragma unroll
    for (int q = 0; q < 4; ++q) {
      const int id = tid + 256 * q, lr = 1 + (id >> 3), c8 = (id & 7) * 8, t = 126 * ti - 1 + lr;
      if (id < 1008 && t < slen) {
        const u32x4 uu = *(const u32x4*)(Ts + lr * 136 + c8), gm = *(const u32x4*)(Ts + (lr - 1) * 136 + 64 + c8), g0 = *(const u32x4*)(Ts + lr * 136 + 64 + c8), gn = *(const u32x4*)(Ts + (lr + 1) * 136 + 64 + c8);
        const float uf[8] = {bflo(uu.x), bfhi(uu.x), bflo(uu.y), bfhi(uu.y), bflo(uu.z), bfhi(uu.z), bflo(uu.w), bfhi(uu.w)};
        const float a[8] = {bflo(gm.x), bfhi(gm.x), bflo(gm.y), bfhi(gm.y), bflo(gm.z), bfhi(gm.z), bflo(gm.w), bfhi(gm.w)};
        const float m[8] = {bflo(g0.x), bfhi(g0.x), bflo(g0.y), bfhi(g0.y), bflo(g0.z), bfhi(g0.z), bflo(g0.w), bfhi(g0.w)};
        const float n[8] = {bflo(gn.x), bfhi(gn.x), bflo(gn.y), bfhi(gn.y), bflo(gn.z), bfhi(gn.z), bflo(gn.w), bfhi(gn.w)};
        float o[8];
#pragma unroll
        for (int j = 0; j < 8; ++j) o[j] = silu_f(cw[c8 + j] * a[j] + cw[DFF + c8 + j] * m[j] + cw[2 * DFF + c8 + j] * n[j]) * uf[j];
        u32x4 ov; ov.x = pack2(o[0], o[1]); ov.y = pack2(o[2], o[3]); ov.z = pack2(o[4], o[5]); ov.w = pack2(o[6], o[7]);
        *(u32x4*)(ACT + (size_t)(seq0 + t) * DFF + nt * 64 + c8) = ov;
      }
    }
  }
  __syncthreads();
}
DI void ffndown_item(const Params& p, int l, int item, char* smem) {
  const int mt = item >> 3, nt = item & 7;
  const float* MOD = (const float*)(p.ws + OFF_MOD);
  gemm_tile<0, 2>((const bf16_t*)(p.ws + OFF_R), DFF, (const bf16_t*)(p.ws + OFF_WDN) + (size_t)l * 1024 * 2816, 2816, 2816, mt * 128, nt * 128, smem, nullptr,
               [&](int row, int col, f32x4 v) {
                 const int s = row < NLAT ? row / T : 2;
                 const f32x4 gt = *(const f32x4*)(MOD + (size_t)(l * 3 + s) * 6144 + 5120 + col);
                 float* xp = row < NLAT ? p.xb + (size_t)row * 1024 + col : (float*)(p.ws + OFF_CTX) + (size_t)(row - NLAT) * 1024 + col;
                 *(f32x4*)xp = *(f32x4*)xp + gt * v;
               });
}
DI void final_item(const Params& p, int item) {
  const int lane = ltid() & 63, w = __builtin_amdgcn_readfirstlane(ltid() >> 6), row = item * 4 + w;
  float* x = p.xb + (size_t)row * 1024;
  float4 v[4]; float ss = 0.f;
#pragma unroll
  for (int i = 0; i < 4; ++i) { v[i] = *(const float4*)(x + (i * 64 + lane) * 4); ss += v[i].x * v[i].x + v[i].y * v[i].y + v[i].z * v[i].z + v[i].w * v[i].w; }
  ss = wave_sum(ss);
  const float rstd = rsqrtf(ss * (1.f / 1024.f) + 1e-6f);
#pragma unroll
  for (int i = 0; i < 4; ++i) {
    const int k = (i * 64 + lane) * 4; const float4 g = *(const float4*)(p.final_norm + k);
    float4 o; o.x = v[i].x * rstd * g.x; o.y = v[i].y * rstd * g.y; o.z = v[i].z * rstd * g.z; o.w = v[i].w * rstd * g.w;
    *(float4*)(x + k) = o;
  }
}

constexpr int PPL = 10;
constexpr int N_PHASES = 2 + NL * PPL;
#define FOR_ITEMS(n) for (int it = blockIdx.x; it < (n); it += gridDim.x)

DI void run_phase(const Params& p, int ph, char* smem) {
  if (ph == 0) { FOR_ITEMS(P0_ITEMS) p0_item(p, it, smem); return; }
  if (ph == N_PHASES - 1) { FOR_ITEMS(NLAT / 4) final_item(p, it); return; }
  const int l = (ph - 1) / PPL, k = (ph - 1) % PPL;
  const int mtiles = (l == NL - 1) ? 128 : 132;
  switch (k) {
    case 0: FOR_ITEMS(NROW / 4) norm_item(p, l, 0, it); break;
    case 1: FOR_ITEMS(138 * 22) gemm_in_item(p, l, it, smem); break;
    case 2: FOR_ITEMS(2112) s5_p1(p, l, it, smem); break;
    case 3: {
      constexpr int n0 = 2112, n1 = n0 + 2112, n2 = n1 + 528, n3 = n2 + 396, n5 = n3 + 66;
      FOR_ITEMS(n5 + 16) {
        if (it < n0) ssd_p1(p, l, it, smem);
        else if (it < n1) mlstm_p1(p, l, it - n0, smem);
        else if (it < n2) kvproj_item(p, l, it - n1, smem);
        else if (it < n3) qproj_item(p, l, it - n2, smem);
        else if (it < n5) ropek_item(p, it - n3);
        else s5_p2(p, l, it - n5);
      }
    } break;
    case 4: {
      constexpr int n0 = 528, n1 = n0 + 512, n2 = n1 + 260;
      FOR_ITEMS(n2) { if (it < n0) s5_p3(p, l, it, smem); else if (it < n1) ssd_p2(p, it - n0); else mlstm_p2(p, it - n1); }
    } break;
    case 5: {
      constexpr int n0 = 528, n2 = n0 + 1056, n3x = n2 + 1056, n3 = n3x + 264;
      const bool late = blockIdx.x >= (gridDim.x >> 1);
      if (!late) { FOR_ITEMS(n0) attn_item(p, it, smem); }
      FOR_ITEMS(n3) {
        if (it < n0) continue;
        if (it < n2) ssd_p3(p, l, it - n0, smem);
        else if (it < n3x) mlstm_p3(p, l, it - n2, smem);
        else glu_item(p, l, it - n3x, smem);
      }
      if (late) { FOR_ITEMS(n0) attn_item(p, it, smem); }
    } break;
    case 6: FOR_ITEMS(mtiles * 8) outproj_item(p, l, it, smem); break;
    case 7: FOR_ITEMS(mtiles * 32) norm_item(p, l, 1, it); break;
    case 8: FOR_ITEMS(((l == NL - 1) ? 132 : 138) * 44) ffnup_item(p, l, it, smem); break;
    case 9: FOR_ITEMS(mtiles * 8) ffndown_item(p, l, it, smem); break;
  }
}

#ifndef HASH_LO
#define HASH_LO OFF_MOD
#define HASH_HI WS_NEED
#endif
#ifndef PROBE_N
#define PROBE_N 0
#endif
DI void hash_dump(const Params& p) {
  const size_t NOUT = (size_t)NLAT * 1024, nw = (HASH_HI - HASH_LO) / 4;
  const unsigned* wsw = (const unsigned*)(p.ws + HASH_LO);
  for (size_t i = (size_t)blockIdx.x * 256 + threadIdx.x; i < NOUT; i += (size_t)gridDim.x * 256) {
    unsigned h = 12345u;
    for (size_t j = i; j < nw; j += NOUT) h = h * 1664525u + wsw[j];
    p.xb[i] = (float)(h & 0xFFFFFFu);
  }
}

#define XB_TMO      128
#define XB_XCNT(j)  (256  + 64 * (j))
#define XB_XSUB(j)  (1280 + 64 * (j))
#define XB_XGEN(j)  (2304 + 64 * (j))
#define XB_TOP      3328
#define XB_TOPGEN   3392
#define XCD_BAR_WORDS 3456
#define XB_SPIN_CAP (1u << 22)
#define LAS __attribute__((address_space(3)))
DI unsigned xb_ld(unsigned* p) { return __hip_atomic_load(p, __ATOMIC_RELAXED, __HIP_MEMORY_SCOPE_AGENT); }
DI unsigned xb_add(unsigned* p, unsigned v) { return __hip_atomic_fetch_add(p, v, __ATOMIC_RELAXED, __HIP_MEMORY_SCOPE_AGENT); }
DI unsigned xb_xcc_id() { return (unsigned)__builtin_amdgcn_s_getreg((3 << 11) | 20) & 0xFu; }
#define XB_SPIN(cond, bar) do { unsigned _sp = 0; while (cond) { __builtin_amdgcn_s_sleep(1); \
    if ((++_sp & 255u) == 0u) { if (xb_ld(&(bar)[XB_TMO])) break; if (_sp > XB_SPIN_CAP) { atomicAdd(&(bar)[XB_TMO], 1u); break; } } } } while (0)
struct XcdBarrier { unsigned* bar; unsigned x; volatile LAS unsigned* st; };
DI XcdBarrier xcd_barrier_post(unsigned* bar, volatile LAS unsigned* st) {
  XcdBarrier b; b.bar = bar; b.x = xb_xcc_id(); b.st = st;
  if (threadIdx.x == 0) (void)xb_add(&bar[XB_XCNT(b.x)], 1u);
  return b;
}
DI void xcd_barrier_complete(unsigned* bar, unsigned x, unsigned& nloc, unsigned& nx) {
  const unsigned G = gridDim.x;
  unsigned sum, cnt, mine, sp = 0u;
  for (;;) {
    sum = 0u; cnt = 0u; mine = 0u;
#pragma unroll
    for (unsigned j = 0; j < 16; ++j) { const unsigned c = xb_ld(&bar[XB_XCNT(j)]); sum += c; cnt += (c > 0u) ? 1u : 0u; mine = (j == x) ? c : mine; }
    if (sum == G) break;
    __builtin_amdgcn_s_sleep(1);
    if ((++sp & 255u) == 0u) { if (xb_ld(&bar[XB_TMO])) break; if (sp > XB_SPIN_CAP) { atomicAdd(&bar[XB_TMO], 1u); break; } }
  }
  nloc = mine > 0u ? mine : 1u; nx = cnt > 0u ? cnt : 1u;
}
DI void xcd_barrier(const XcdBarrier& b) {
  asm volatile("s_waitcnt vmcnt(0)" ::: "memory");
  __syncthreads();
  if (threadIdx.x == 0) {
    unsigned* bar = b.bar;
    __builtin_amdgcn_s_waitcnt(0);
    unsigned nloc = b.st[0], nx = b.st[1];
    if (nloc == 0u) { xcd_barrier_complete(bar, b.x, nloc, nx); b.st[0] = nloc; b.st[1] = nx; }
    const unsigned old = xb_add(&bar[XB_XSUB(b.x)], 1u);
    const unsigned gen = old / nloc;
    if (old + 1u == (gen + 1u) * nloc) {
      __builtin_amdgcn_fence(__ATOMIC_RELEASE, "agent");
      asm volatile("s_waitcnt vmcnt(0)" ::: "memory");
      const unsigned og = xb_add(&bar[XB_TOP], 1u);
      const unsigned tg = og / nx;
      if (og + 1u == (tg + 1u) * nx) xb_add(&bar[XB_TOPGEN], 1u);
      else XB_SPIN(xb_ld(&bar[XB_TOPGEN]) == tg, bar);
      __builtin_amdgcn_fence(__ATOMIC_ACQUIRE, "agent");
      xb_add(&bar[XB_XGEN(b.x)], 1u);
      asm volatile("s_waitcnt vmcnt(0)" ::: "memory");
    } else {
      XB_SPIN(xb_ld(&bar[XB_XGEN(b.x)]) == gen, bar);
      __builtin_amdgcn_fence(__ATOMIC_ACQUIRE, "agent");
      asm volatile("s_waitcnt vmcnt(0)" ::: "memory");
    }
  }
  __syncthreads();
}
constexpr int SMEM_BYTES = 59392;
__global__ void __launch_bounds__(256, 2) trunk_fwd(Params p) {
  __shared__ __attribute__((aligned(16))) char smem[SMEM_BYTES];
  __shared__ uint4 xb_words;
  cg::grid_group grid = cg::this_grid();
  if (threadIdx.x == 0) xb_words = make_uint4(0u, 0u, 0u, 0u);
  __syncthreads();
  XcdBarrier xb = xcd_barrier_post((unsigned*)(p.ws + OFF_BAR), (volatile LAS unsigned*)&xb_words);
  for (int ph = p.ph_lo; ph < p.ph_hi; ++ph) {
    run_phase(p, ph, smem);
    if (ph + 1 < p.ph_hi) { if (ph == p.ph_lo) grid.sync(); else xcd_barrier(xb); }
  }
}

__global__ void __launch_bounds__(256) hash_kernel(Params p) { hash_dump(p); }

extern "C" void kernel_launch(void* const* d_in, const int* in_sizes, int n_in, void* d_out, int out_size, void* d_ws, size_t ws_size, hipStream_t stream) {
  static int grid_blocks = 0;
  if (!grid_blocks) {
    int dev = 0, cus = 0, per_cu = 0;
    hipGetDevice(&dev);
    hipDeviceGetAttribute(&cus, hipDeviceAttributeMultiprocessorCount, dev);
    hipOccupancyMaxActiveBlocksPerMultiprocessor(&per_cu, trunk_fwd, 256, 0);
    if (per_cu > 2) per_cu = 2;
    grid_blocks = cus * per_cu;
  }
  if (ws_size < OFF_BAR + XCD_BAR_WORDS * 4) { fprintf(stderr, "workspace too small: %zu < %zu\n", ws_size, (size_t)WS_NEED); return; }
  Params p{};
  const float** fp = (const float**)&p;
  for (int i = 0; i < 35; ++i) fp[i] = (const float*)d_in[i];
  p.xb = (float*)d_out; p.ws = (char*)d_ws;
#if MULTI_LAUNCH
#if PROBE_N
  for (int ph = 0; ph < PROBE_N; ++ph) { p.ph_lo = ph; p.ph_hi = ph + 1; hipLaunchKernelGGL(trunk_fwd, dim3(grid_blocks), dim3(256), 0, stream, p); }
  hipLaunchKernelGGL(hash_kernel, dim3(grid_blocks), dim3(256), 0, stream, p);
#else
  for (int ph = 0; ph < N_PHASES; ++ph) { p.ph_lo = ph; p.ph_hi = ph + 1; hipLaunchKernelGGL(trunk_fwd, dim3(grid_blocks), dim3(256), 0, stream, p); }
#endif
#else
  p.ph_lo = 0; p.ph_hi = N_PHASES;
  hipMemsetAsync((char*)d_ws + OFF_BAR, 0, XCD_BAR_WORDS * 4, stream);
  void* args[] = {&p};
  hipError_t e = hipLaunchCooperativeKernel((void*)trunk_fwd, dim3(grid_blocks), dim3(256), args, 0, stream);
  if (e != hipSuccess) fprintf(stderr, "cooperative launch failed: %s (grid %d)\n", hipGetErrorString(e), grid_blocks);
#endif
}
```

```cpp
#include <hip/hip_runtime.h>
#include <hip/hip_cooperative_groups.h>
#include <cstdio>
#include <cstdint>
namespace cg = cooperative_groups;

#ifndef PROBE_MASK
#define PROBE_MASK 63
#endif
#ifndef ZERO_FILL
#define ZERO_FILL 0
#endif
#ifndef MULTI_LAUNCH
#define MULTI_LAUNCH 0
#endif

typedef unsigned short bf16_t;
typedef short bf16x8 __attribute__((ext_vector_type(8)));
typedef float f32x4 __attribute__((ext_vector_type(4)));
typedef unsigned u32x4 __attribute__((ext_vector_type(4)));
typedef unsigned u32x2 __attribute__((ext_vector_type(2)));
#define DI __device__ __forceinline__
#define MFMA16(a, b, c) __builtin_amdgcn_mfma_f32_16x16x32_bf16((a), (b), (c), 0, 0, 0)

constexpr int NB = 2, T = 8192, TC = 256, NL = 4;
constexpr int NLAT = NB * T, NROW = NLAT + NB * TC;
constexpr int TALL = T + TC;
constexpr int PINP = 2816;
constexpr int C_MLQ = 0, C_MLK = 256, C_MLV = 512, C_MLO = 768, C_CQ = 1040, C_CKV = 1296, C_KR = 1424,
              C_Z = 1456, C_XBC = 1712, C_S5 = 2488;
constexpr int NCH = 132;
constexpr int DFF = 2816;

constexpr size_t SZ_WIN = (size_t)NL * 2816 * 1024 * 2, SZ_WUQ = (size_t)NL * 384 * 256 * 2, SZ_WUKV = (size_t)NL * 512 * 128 * 2,
                 SZ_WGLU = (size_t)NL * 256 * 256 * 2, SZ_WOUT = (size_t)NL * 1024 * 1024 * 2, SZ_WUP = (size_t)NL * 5632 * 1024 * 2,
                 SZ_WDN = (size_t)NL * 1024 * 2816 * 2, SZ_MOD = (size_t)NL * 3 * 6144 * 4, SZ_CTX = (size_t)512 * 1024 * 4,
                 SZ_HY = (size_t)NROW * 1024 * 2, SZ_GML = (size_t)NROW * 16 * 4, SZ_DTR = (size_t)NROW * 8 * 4, SZ_SSQ = (size_t)NROW * 4 * 4,
                 SZ_QRAW = (size_t)NROW * 384 * 2, SZ_KH = (size_t)NB * 4 * TALL * 64 * 2 + (size_t)NB * TALL * 32 * 2, SZ_VT = (size_t)NB * 4 * 64 * TALL * 2,
                 SZ_S5S = (size_t)NB * 16 * 2 * NCH * 128 * 4, SZ_MLM = (size_t)16 * NCH * 32 * 4, SZ_SSA = (size_t)16 * NCH * 32 * 4,
                 SZ_P = (size_t)NROW * PINP * 2, SZ_MLS = (size_t)16 * NCH * 4160 * 4, SZ_SSDS = (size_t)16 * NCH * 8192 * 4;
constexpr size_t OFF_WIN = 0, OFF_WUQ = OFF_WIN + SZ_WIN, OFF_WUKV = OFF_WUQ + SZ_WUQ, OFF_WGLU = OFF_WUKV + SZ_WUKV,
                 OFF_WOUT = OFF_WGLU + SZ_WGLU, OFF_WUP = OFF_WOUT + SZ_WOUT, OFF_WDN = OFF_WUP + SZ_WUP, OFF_MOD = OFF_WDN + SZ_WDN,
                 OFF_CTX = OFF_MOD + SZ_MOD, OFF_HY = OFF_CTX + SZ_CTX, OFF_GML = OFF_HY + SZ_HY, OFF_DTR = OFF_GML + SZ_GML,
                 OFF_SSQ = OFF_DTR + SZ_DTR, OFF_QRAW = OFF_SSQ + SZ_SSQ, OFF_KH = OFF_QRAW + SZ_QRAW, OFF_VT = OFF_KH + SZ_KH,
                 OFF_S5S = OFF_VT + SZ_VT, OFF_MLM = OFF_S5S + SZ_S5S, OFF_SSA = OFF_MLM + SZ_MLM,
                 OFF_R = ((OFF_SSA + SZ_SSA + 255) / 256) * 256, OFF_P = OFF_R, OFF_MLS = OFF_P + SZ_P, OFF_SSDS = OFF_MLS + SZ_MLS,
                 WS_NEED = OFF_SSDS + SZ_SSDS;
static_assert((size_t)NROW * 5632 * 2 <= SZ_P + SZ_MLS + SZ_SSDS, "UG overlay");

constexpr size_t OFF_KR = OFF_KH + (size_t)NB * 4 * TALL * 64 * 2;
constexpr size_t OFF_YG = ((WS_NEED + 255) / 256) * 256;
constexpr size_t OFF_BAR = OFF_YG + (size_t)NROW * 256 * 2;
struct Params {
  const float *x, *c, *ctx, *c_ctx, *w_mod, *b_mod, *norm1, *norm2, *w_in, *ml_gate_bias, *ml_norm, *mla_q_norm, *mla_kv_norm,
      *mla_w_uq, *mla_w_ukv, *ssd_conv_w, *ssd_conv_b, *ssd_a_log, *ssd_dt_bias, *ssd_d, *ssd_norm, *s5_a_re, *s5_a_im, *s5_log_dt,
      *s5_b_re, *s5_b_im, *s5_c_re, *s5_c_im, *s5_d, *s5_w_glu, *w_out, *ffn_w_up, *ffn_conv_w, *ffn_w_down, *final_norm;
  float* xb;
  char* ws;
  int ph_lo, ph_hi;
};

typedef __bf16 hbf16x2 __attribute__((ext_vector_type(2)));
typedef float f32x2 __attribute__((ext_vector_type(2)));
DI bf16_t f2bf(float x) { return __builtin_bit_cast(bf16_t, (__bf16)x); }
DI float bf2f(bf16_t v) { return __uint_as_float(((unsigned)v) << 16); }
DI unsigned pack2(float lo, float hi) { f32x2 v = {lo, hi}; return __builtin_bit_cast(unsigned, __builtin_convertvector(v, hbf16x2)); }
DI float bflo(unsigned w) { return __uint_as_float(w << 16); }
DI float bfhi(unsigned w) { return __uint_as_float(w & 0xffff0000u); }
DI float silu_f(float x) { return x / (1.f + __expf(-x)); }
DI float sigm_f(float x) { return 1.f / (1.f + __expf(-x)); }
DI float softplus_f(float x) { return fmaxf(x, 0.f) + log1pf(__expf(-fabsf(x))); }
DI float logsigm_f(float x) { return fminf(x, 0.f) - log1pf(__expf(-fabsf(x))); }
DI float gelu_tanh_f(float x) { float u = 0.7978845608f * (x + 0.044715f * x * x * x); return x * sigm_f(2.f * u); }
DI float wave_sum(float v) { for (int o = 32; o; o >>= 1) v += __shfl_xor(v, o); return v; }
DI float wave_max(float v) { for (int o = 32; o; o >>= 1) v = fmaxf(v, __shfl_xor(v, o)); return v; }
DI float wave_incl_scan(float v, int lane) { for (int o = 1; o < 64; o <<= 1) { float t = __shfl_up(v, o); if (lane >= o) v += t; } return v; }
DI float red16_max(float v) { v = fmaxf(v, __shfl_xor(v, 1)); v = fmaxf(v, __shfl_xor(v, 2)); v = fmaxf(v, __shfl_xor(v, 4)); v = fmaxf(v, __shfl_xor(v, 8)); return v; }
DI float red16_sum(float v) { v += __shfl_xor(v, 1); v += __shfl_xor(v, 2); v += __shfl_xor(v, 4); v += __shfl_xor(v, 8); return v; }
DI bf16x8 ld_frag(const bf16_t* p) { return *(const bf16x8*)p; }
DI bf16x8 mk_frag(unsigned a, unsigned b, unsigned c, unsigned d) { u32x4 u = {a, b, c, d}; return __builtin_bit_cast(bf16x8, u); }
DI bf16x8 frag_from_f32(const float* p, float sgn) {
  float4 a = *(const float4*)p, b = *(const float4*)(p + 4);
  return mk_frag(pack2(a.x * sgn, a.y * sgn), pack2(a.z * sgn, a.w * sgn), pack2(b.x * sgn, b.y * sgn), pack2(b.z * sgn, b.w * sgn));
}
DI int ltid() { int t = threadIdx.x; asm volatile("" : "+v"(t)); return t; }
DI int row_of(int b, int part, int t) { return part ? NLAT + b * TC + t : b * T + t; }

DI void tr_tile(const float* __restrict__ src, int K, int N, bf16_t* __restrict__ dst, const float* gain, int glo, int ghi, int tk, int tn, float* tile, int drow0 = -1) {
  const int tid = ltid(), c4 = tid & 15, rq = tid >> 4;
  const bool vec = (N & 3) == 0;
#pragma unroll
  for (int rr = 0; rr < 4; ++rr) {
    const int r = rr * 16 + rq, k = tk * 64 + r, n = tn * 64 + c4 * 4;
    float4 v;
    if (vec && n + 3 < N) v = *(const float4*)(src + (size_t)k * N + n);
    else { v.x = n < N ? src[(size_t)k * N + n] : 0.f; v.y = n + 1 < N ? src[(size_t)k * N + n + 1] : 0.f; v.z = n + 2 < N ? src[(size_t)k * N + n + 2] : 0.f; v.w = n + 3 < N ? src[(size_t)k * N + n + 3] : 0.f; }
    if (gain && k >= glo && k < ghi) { const float g = gain[k - glo]; v.x *= g; v.y *= g; v.z *= g; v.w *= g; }
    *(float4*)(tile + r * 68 + c4 * 4) = v;
  }
  __syncthreads();
#pragma unroll
  for (int q = 0; q < 2; ++q) {
    const int id = tid + 256 * q, n = id >> 3, k0 = (id & 7) * 8;
    u32x4 o;
    o.x = pack2(tile[(k0 + 0) * 68 + n], tile[(k0 + 1) * 68 + n]); o.y = pack2(tile[(k0 + 2) * 68 + n], tile[(k0 + 3) * 68 + n]);
    o.z = pack2(tile[(k0 + 4) * 68 + n], tile[(k0 + 5) * 68 + n]); o.w = pack2(tile[(k0 + 6) * 68 + n], tile[(k0 + 7) * 68 + n]);
    *(u32x4*)(dst + (size_t)((drow0 >= 0 ? drow0 : tn * 64) + n) * K + tk * 64 + k0) = o;
  }
  __syncthreads();
}

constexpr int TR_PER_LAYER = 3128, P0_TR = NL * TR_PER_LAYER, P0_MOD = NL * 96, P0_CPX = NLAT * 1024 / 4096, P0_CPC = 512 * 1024 / 4096;
constexpr int P0_ZERO = (int)((WS_NEED - OFF_HY + 65535) / 65536);
constexpr int P0_ITEMS = P0_TR + P0_MOD + P0_CPX + P0_CPC + (ZERO_FILL ? P0_ZERO : 0);

DI void p0_item(const Params& p, int item, char* smem) {
  const int tid = ltid();
  if (item < P0_MOD) {
    const int l = item / 96, cb = item % 96, cl = tid & 63, kq = tid >> 6;
    float* sv = (float*)smem;
    float* red = sv + 3072;
    for (int i = tid; i < 1024; i += 256) { sv[i] = silu_f(p.c[i]); sv[1024 + i] = silu_f(p.c[1024 + i]); sv[2048 + i] = silu_f(p.c_ctx[i]); }
    __syncthreads();
    const int col = cb * 64 + cl; const float* W = p.w_mod + (size_t)l * 1024 * 6144 + col;
    float a0 = 0.f, a1 = 0.f, a2 = 0.f;
#pragma unroll 16
    for (int k = kq * 256; k < kq * 256 + 256; ++k) { const float w = W[(size_t)k * 6144]; a0 += sv[k] * w; a1 += sv[1024 + k] * w; a2 += sv[2048 + k] * w; }
    red[(kq * 3 + 0) * 64 + cl] = a0; red[(kq * 3 + 1) * 64 + cl] = a1; red[(kq * 3 + 2) * 64 + cl] = a2;
    __syncthreads();
    if (tid < 192) {
      const int s = tid >> 6; const float bm = p.b_mod[l * 6144 + col];
      const float v = red[(0 * 3 + s) * 64 + cl] + red[(1 * 3 + s) * 64 + cl] + red[(2 * 3 + s) * 64 + cl] + red[(3 * 3 + s) * 64 + cl] + bm;
      ((float*)(p.ws + OFF_MOD))[(size_t)(l * 3 + s) * 6144 + col] = v;
    }
    __syncthreads();
    return;
  }
  item -= P0_MOD;
  if (item < P0_TR) {
    const int l = item / TR_PER_LAYER; int t = item % TR_PER_LAYER; float* tile = (float*)smem;
    if (t < 704) { tr_tile(p.w_in + (size_t)l * 1024 * 2744, 1024, 2744, (bf16_t*)(p.ws + OFF_WIN) + (size_t)l * 2816 * 1024, nullptr, 0, 0, t / 44, t % 44, tile); return; }
    t -= 704;
    if (t < 24) { tr_tile(p.mla_w_uq + (size_t)l * 256 * 384, 256, 384, (bf16_t*)(p.ws + OFF_WUQ) + (size_t)l * 384 * 256, p.mla_q_norm + l * 256, 0, 256, t / 6, t % 6, tile); return; }
    t -= 24;
    if (t < 16) { tr_tile(p.mla_w_ukv + (size_t)l * 128 * 512, 128, 512, (bf16_t*)(p.ws + OFF_WUKV) + (size_t)l * 512 * 128, p.mla_kv_norm + l * 128, 0, 128, t / 8, t % 8, tile); return; }
    t -= 16;
    if (t < 16) { tr_tile(p.s5_w_glu + (size_t)l * 256 * 256, 256, 256, (bf16_t*)(p.ws + OFF_WGLU) + (size_t)l * 256 * 256, nullptr, 0, 0, t / 4, t % 4, tile); return; }
    t -= 16;
    if (t < 256) { tr_tile(p.w_out + (size_t)l * 1024 * 1024, 1024, 1024, (bf16_t*)(p.ws + OFF_WOUT) + (size_t)l * 1024 * 1024, p.ssd_norm + l * 256, 512, 768, t / 16, t % 16, tile); return; }
    t -= 256;
    if (t < 1408) { tr_tile(p.ffn_w_up + (size_t)l * 1024 * 5632, 1024, 5632, (bf16_t*)(p.ws + OFF_WUP) + (size_t)l * 5632 * 1024, nullptr, 0, 0, t / 88, t % 88, tile, (t % 88) < 44 ? (t % 88) * 128 : ((t % 88) - 44) * 128 + 64); return; }
    t -= 1408;
    tr_tile(p.ffn_w_down + (size_t)l * 2816 * 1024, 2816, 1024, (bf16_t*)(p.ws + OFF_WDN) + (size_t)l * 1024 * 2816, nullptr, 0, 0, t / 16, t % 16, tile);
    return;
  }
  item -= P0_TR;
  if (item >= P0_CPX + P0_CPC) {
    item -= P0_CPX + P0_CPC;
    char* z = p.ws + OFF_HY + (size_t)item * 65536;
    const size_t lim = WS_NEED - OFF_HY - (size_t)item * 65536;
    for (int i = 0; i < 16; ++i) { const size_t o = (size_t)(i * 256 + tid) * 16; if (o < lim) *(u32x4*)(z + o) = (u32x4){0u, 0u, 0u, 0u}; }
    return;
  }
  const float* src; float* dst;
  if (item < P0_CPX) { src = p.x + (size_t)item * 4096; dst = p.xb + (size_t)item * 4096; }
  else { item -= P0_CPX; src = p.ctx + (size_t)item * 4096; dst = (float*)(p.ws + OFF_CTX) + (size_t)item * 4096; }
  for (int i = 0; i < 4; ++i) { const int o = (i * 256 + tid) * 4; *(float4*)(dst + o) = *(const float4*)(src + o); }
}


struct TrD { const float* src; bf16_t* dst; const float* gain; int K, N, glo, ghi, tk, tn, drow0; };
DI TrD tr_desc(const Params& p, int item) {
  const int l = item / TR_PER_LAYER; int t = item % TR_PER_LAYER; TrD d; d.gain = nullptr; d.glo = 0; d.ghi = 0; d.drow0 = -1;
  if (t < 704) { d.src = p.w_in + (size_t)l * 1024 * 2744; d.K = 1024; d.N = 2744; d.dst = (bf16_t*)(p.ws + OFF_WIN) + (size_t)l * 2816 * 1024; d.tk = t / 44; d.tn = t % 44; return d; }
  t -= 704;
  if (t < 24) { d.src = p.mla_w_uq + (size_t)l * 256 * 384; d.K = 256; d.N = 384; d.dst = (bf16_t*)(p.ws + OFF_WUQ) + (size_t)l * 384 * 256; d.gain = p.mla_q_norm + l * 256; d.ghi = 256; d.tk = t / 6; d.tn = t % 6; return d; }
  t -= 24;
  if (t < 16) { d.src = p.mla_w_ukv + (size_t)l * 128 * 512; d.K = 128; d.N = 512; d.dst = (bf16_t*)(p.ws + OFF_WUKV) + (size_t)l * 512 * 128; d.gain = p.mla_kv_norm + l * 128; d.ghi = 128; d.tk = t / 8; d.tn = t % 8; return d; }
  t -= 16;
  if (t < 16) { d.src = p.s5_w_glu + (size_t)l * 256 * 256; d.K = 256; d.N = 256; d.dst = (bf16_t*)(p.ws + OFF_WGLU) + (size_t)l * 256 * 256; d.tk = t / 4; d.tn = t % 4; return d; }
  t -= 16;
  if (t < 256) { d.src = p.w_out + (size_t)l * 1024 * 1024; d.K = 1024; d.N = 1024; d.dst = (bf16_t*)(p.ws + OFF_WOUT) + (size_t)l * 1024 * 1024; d.gain = p.ssd_norm + l * 256; d.glo = 512; d.ghi = 768; d.tk = t / 16; d.tn = t % 16; return d; }
  t -= 256;
  if (t < 1408) { d.src = p.ffn_w_up + (size_t)l * 1024 * 5632; d.K = 1024; d.N = 5632; d.dst = (bf16_t*)(p.ws + OFF_WUP) + (size_t)l * 5632 * 1024; d.tk = t / 88; d.tn = t % 88;
    d.drow0 = d.tn < 44 ? d.tn * 128 : (d.tn - 44) * 128 + 64; return d; }
  t -= 1408;
  d.src = p.ffn_w_down + (size_t)l * 2816 * 1024; d.K = 2816; d.N = 1024; d.dst = (bf16_t*)(p.ws + OFF_WDN) + (size_t)l * 1024 * 2816; d.tk = t / 16; d.tn = t % 16; return d;
}
DI void tr_load(const TrD& d, float4 (&v)[4]) {
  const int tid = ltid(), c4 = tid & 15, rq = tid >> 4;
  const bool vec = (d.N & 3) == 0;
#pragma unroll
  for (int rr = 0; rr < 4; ++rr) {
    const int r = rr * 16 + rq, k = d.tk * 64 + r, n = d.tn * 64 + c4 * 4;
    const float* s = d.src + (size_t)k * d.N + n;
    if (vec && n + 3 < d.N) v[rr] = *(const float4*)s;
    else { v[rr].x = n < d.N ? s[0] : 0.f; v[rr].y = n + 1 < d.N ? s[1] : 0.f; v[rr].z = n + 2 < d.N ? s[2] : 0.f; v[rr].w = n + 3 < d.N ? s[3] : 0.f; }
  }
}
DI void tr_finish(const TrD& d, const float4 (&v)[4], float* tile) {
  const int tid = ltid(), c4 = tid & 15, rq = tid >> 4;
#pragma unroll
  for (int rr = 0; rr < 4; ++rr) {
    const int r = rr * 16 + rq, k = d.tk * 64 + r;
    float4 x = v[rr];
    if (d.gain && k >= d.glo && k < d.ghi) { const float g = d.gain[k - d.glo]; x.x *= g; x.y *= g; x.z *= g; x.w *= g; }
    *(float4*)(tile + r * 68 + c4 * 4) = x;
  }
  __syncthreads();
#pragma unroll
  for (int q = 0; q < 2; ++q) {
    const int id = tid + 256 * q, n = id >> 3, k0 = (id & 7) * 8;
    u32x4 o;
    o.x = pack2(tile[(k0 + 0) * 68 + n], tile[(k0 + 1) * 68 + n]); o.y = pack2(tile[(k0 + 2) * 68 + n], tile[(k0 + 3) * 68 + n]);
    o.z = pack2(tile[(k0 + 4) * 68 + n], tile[(k0 + 5) * 68 + n]); o.w = pack2(tile[(k0 + 6) * 68 + n], tile[(k0 + 7) * 68 + n]);
    *(u32x4*)(d.dst + (size_t)((d.drow0 >= 0 ? d.drow0 : d.tn * 64) + n) * d.K + d.tk * 64 + k0) = o;
  }
  __syncthreads();
}
DI void p0_transposes(const Params& p, char* smem) {
  float* tile = (float*)smem;
  int t = blockIdx.x;
  if (t >= P0_TR) return;
  TrD d = tr_desc(p, t); float4 v[4]; tr_load(d, v);
  for (;;) {
    const int t1 = t + gridDim.x; const bool has = t1 < P0_TR;
    TrD d1 = d; float4 v1[4];
    if (has) { d1 = tr_desc(p, t1); tr_load(d1, v1); }
    tr_finish(d, v, tile);
    if (!has) break;
    d = d1; t = t1;
#pragma unroll
    for (int i = 0; i < 4; ++i) v[i] = v1[i];
  }
}

DI void norm_item(const Params& p, int l, int which, int item) {
  const int lane = ltid() & 63, w = __builtin_amdgcn_readfirstlane(ltid() >> 6), row = item * 4 + w;
  const float* x = row < NLAT ? p.xb + (size_t)row * 1024 : (const float*)(p.ws + OFF_CTX) + (size_t)(row - NLAT) * 1024;
  float4 v[4]; float ss = 0.f;
#pragma unroll
  for (int i = 0; i < 4; ++i) { v[i] = *(const float4*)(x + (i * 64 + lane) * 4); ss += v[i].x * v[i].x + v[i].y * v[i].y + v[i].z * v[i].z + v[i].w * v[i].w; }
  ss = wave_sum(ss);
  const float rstd = rsqrtf(ss * (1.f / 1024.f) + 1e-6f);
  const int s = row < NLAT ? row / T : 2;
  const float* g = (which ? p.norm2 : p.norm1) + l * 1024;
  const float* md = (const float*)(p.ws + OFF_MOD) + (size_t)(l * 3 + s) * 6144 + (which ? 3072 : 0);
  bf16_t* H = (bf16_t*)(p.ws + OFF_HY) + (size_t)row * 1024;
#pragma unroll
  for (int i = 0; i < 4; ++i) {
    const int k = (i * 64 + lane) * 4;
    const float4 g4 = *(const float4*)(g + k), sh = *(const float4*)(md + k), sc = *(const float4*)(md + 1024 + k);
    u32x2 o; o.x = pack2(v[i].x * rstd * g4.x * (1.f + sc.x) + sh.x, v[i].y * rstd * g4.y * (1.f + sc.y) + sh.y);
    o.y = pack2(v[i].z * rstd * g4.z * (1.f + sc.z) + sh.z, v[i].w * rstd * g4.w * (1.f + sc.w) + sh.w);
    *(u32x2*)(H + k) = o;
  }
}

DI u32x4 scale_bf8(u32x4 q, float s) {
  q.x = pack2(bflo(q.x) * s, bfhi(q.x) * s); q.y = pack2(bflo(q.y) * s, bfhi(q.y) * s);
  q.z = pack2(bflo(q.z) * s, bfhi(q.z) * s); q.w = pack2(bflo(q.w) * s, bfhi(q.w) * s); return q;
}
#define GEMM_STEP(AR, BR, KT)                                                                                         \
  {                                                                                                                   \
    if (AMODE == 1 && (KT) >= 8 && (KT) < 12) {                                                                       \
      _Pragma("unroll") for (int i = 0; i < 4; ++i) AR[i] = scale_bf8(AR[i], rs[i]);                                  \
    }                                                                                                                 \
    _Pragma("unroll") for (int i = 0; i < 4; ++i) { *(u32x4*)(As + (r0 + 32 * i) * 72 + cc * 8) = AR[i]; *(u32x4*)(Bs + (r0 + 32 * i) * 72 + cc * 8) = BR[i]; } \
    __syncthreads();                                                                                                  \
    if ((KT) + 2 < nk) {                                                                                              \
      _Pragma("unroll") for (int i = 0; i < 4; ++i) { AR[i] = *(const u32x4*)((CLAMP ? apx[i] : ap + i * astep) + ((KT) + 2) * 64); BR[i] = *(const u32x4*)(bp + i * bstep + ((KT) + 2) * 64); } \
    }                                                                                                                 \
    __builtin_amdgcn_sched_barrier(0);                                                                                \
    _Pragma("unroll") for (int ks = 0; ks < 2; ++ks) {                                                                \
      bf16x8 af[4], bfr[4];                                                                                           \
      _Pragma("unroll") for (int i = 0; i < 4; ++i) { af[i] = ld_frag(As + (64 * wm + 16 * i + l15) * 72 + ks * 32 + g4 * 8); bfr[i] = ld_frag(Bs + (64 * wn + 16 * i + l15) * 72 + ks * 32 + g4 * 8); } \
      _Pragma("unroll") for (int i = 0; i < 4; ++i)                                                                   \
        _Pragma("unroll") for (int j = 0; j < 4; ++j) acc[i][j] = MFMA16(bfr[j], af[i], acc[i][j]);                   \
    }                                                                                                                 \
    __syncthreads();                                                                                                  \
  }
template <int AMODE, int STAGE, class Epi, int CLAMP = 0>
DI void gemm_tile(const bf16_t* __restrict__ A, int lda, const bf16_t* __restrict__ Bt, int ldb, int K, int m0, int n0, char* smem, const float* ssq, Epi epi, int rlo = 0, int rhi = 0) {
  bf16_t* As = (bf16_t*)smem; bf16_t* Bs = As + 128 * 72;
  const int tid = ltid(), lane = tid & 63, w = __builtin_amdgcn_readfirstlane(tid >> 6), wm = w >> 1, wn = w & 1, l15 = lane & 15, g4 = lane >> 4;
  u32x4 ar0[4], br0[4], ar1[4], br1[4]; float rs[4];
  const int r0 = tid >> 3, cc = tid & 7;
  const bf16_t* ap = A + (size_t)(m0 + r0) * lda + cc * 8;
  const bf16_t* bp = Bt + (size_t)(n0 + r0) * ldb + cc * 8;
  const size_t astep = (size_t)32 * lda, bstep = (size_t)32 * ldb;
  const bf16_t* apx[4];
  if (CLAMP) {
#pragma unroll
    for (int i = 0; i < 4; ++i) { int r = m0 + r0 + 32 * i; r = r < rlo ? rlo : (r > rhi ? rhi : r); apx[i] = A + (size_t)r * lda + cc * 8; }
  }
  if (AMODE == 1) {
#pragma unroll
    for (int i = 0; i < 4; ++i) { const float* q = ssq + (m0 + r0 + 32 * i); rs[i] = rsqrtf((q[0] + q[NROW] + q[2 * NROW] + q[3 * NROW]) * (1.f / 256.f) + 1e-6f); }
  }
  f32x4 acc[4][4];
#pragma unroll
  for (int i = 0; i < 4; ++i)
#pragma unroll
    for (int j = 0; j < 4; ++j) acc[i][j] = (f32x4){0.f, 0.f, 0.f, 0.f};
  const int nk = K >> 6;
#pragma unroll
  for (int i = 0; i < 4; ++i) { ar0[i] = *(const u32x4*)(CLAMP ? apx[i] : ap + i * astep); br0[i] = *(const u32x4*)(bp + i * bstep); }
#pragma unroll
  for (int i = 0; i < 4; ++i) { ar1[i] = *(const u32x4*)((CLAMP ? apx[i] : ap + i * astep) + 64); br1[i] = *(const u32x4*)(bp + i * bstep + 64); }
  for (int kt = 0; kt < nk; kt += 2) {
    GEMM_STEP(ar0, br0, kt)
    GEMM_STEP(ar1, br1, kt + 1)
  }
  if (STAGE == 2) {
    float* Tf = (float*)smem;
#pragma unroll
    for (int h = 0; h < 2; ++h) {
      if (wm == h) {
#pragma unroll
        for (int i = 0; i < 4; ++i)
#pragma unroll
          for (int j = 0; j < 4; ++j) *(f32x4*)(Tf + (16 * i + l15) * 132 + 64 * wn + 16 * j + 4 * g4) = acc[i][j];
      }
      __syncthreads();
#pragma unroll
      for (int q = 0; q < 8; ++q) { const int id = tid + 256 * q, r = id >> 5, c = id & 31; epi(m0 + 64 * h + r, n0 + c * 4, *(const f32x4*)(Tf + r * 132 + c * 4)); }
      __syncthreads();
    }
    return;
  }
#pragma unroll
  for (int i = 0; i < 4; ++i)
#pragma unroll
    for (int j = 0; j < 4; ++j) epi(m0 + 64 * wm + 16 * i + l15, n0 + 64 * wn + 16 * j + 4 * g4, acc[i][j]);
}

DI void store_bf4(bf16_t* dst, f32x4 v) { u32x2 o; o.x = pack2(v[0], v[1]); o.y = pack2(v[2], v[3]); *(u32x2*)dst = o; }

DI void gemm_in_item(const Params& p, int l, int item, char* smem) {
  const int mtile = item / 22, nt = item % 22;
  int seq0, slen, ti;
  if (mtile < 132) { seq0 = (mtile / 66) * T; slen = T; ti = mtile % 66; }
  else { const int j = mtile - 132; seq0 = NLAT + (j / 3) * TC; slen = TC; ti = j % 3; }
  const int m0 = seq0 + 126 * ti - 1, n0 = nt * 128;
  bf16_t* P = (bf16_t*)(p.ws + OFF_P); float* GML = (float*)(p.ws + OFF_GML); float* DTR = (float*)(p.ws + OFF_DTR);
  bf16_t* Ts = (bf16_t*)smem;
  auto epi = [&](int row, int col, f32x4 v) {
    const int lr = row - m0, t = 126 * ti - 1 + lr;
    store_bf4(Ts + lr * 136 + (col - n0), v);
    if (lr >= 1 && lr <= 126 && t < slen) {
      if (col >= 1024 && col < 1040) *(f32x4*)(GML + (size_t)row * 16 + (col - 1024)) = v;
      if (col >= 2480 && col < 2488) *(f32x4*)(DTR + (size_t)row * 8 + (col - 2480)) = v;
    }
  };
  gemm_tile<0, 0, decltype(epi), 1>((const bf16_t*)(p.ws + OFF_HY), 1024, (const bf16_t*)(p.ws + OFF_WIN) + (size_t)l * 2816 * 1024, 1024, 1024, m0, n0, smem, nullptr, epi, seq0, seq0 + slen - 1);
  __syncthreads();
  {
    const int tid = ltid();
    const float* cw = p.ssd_conv_w + (size_t)l * 3 * 768; const float* cb = p.ssd_conv_b + l * 768;
#pragma unroll
    for (int q = 0; q < 8; ++q) {
      const int id = tid + 256 * q, lr = 1 + (id >> 4), c8 = (id & 15) * 8, t = 126 * ti - 1 + lr, col = n0 + c8;
      if (id < 2016 && t < slen) {
        u32x4 o = *(const u32x4*)(Ts + lr * 136 + c8);
        if (col >= C_XBC && col < C_XBC + 768) {
          const int ch = col - C_XBC;
          const u32x4 z = {0u, 0u, 0u, 0u};
          const u32x4 pm = t > 0 ? *(const u32x4*)(Ts + (lr - 1) * 136 + c8) : z, nx = t + 1 < slen ? *(const u32x4*)(Ts + (lr + 1) * 136 + c8) : z;
          const float a[8] = {bflo(pm.x), bfhi(pm.x), bflo(pm.y), bfhi(pm.y), bflo(pm.z), bfhi(pm.z), bflo(pm.w), bfhi(pm.w)};
          const float m[8] = {bflo(o.x), bfhi(o.x), bflo(o.y), bfhi(o.y), bflo(o.z), bfhi(o.z), bflo(o.w), bfhi(o.w)};
          const float n[8] = {bflo(nx.x), bfhi(nx.x), bflo(nx.y), bfhi(nx.y), bflo(nx.z), bfhi(nx.z), bflo(nx.w), bfhi(nx.w)};
          float r[8];
#pragma unroll
          for (int j = 0; j < 8; ++j) r[j] = silu_f(cb[ch + j] + cw[ch + j] * a[j] + cw[768 + ch + j] * m[j] + cw[1536 + ch + j] * n[j]);
          o.x = pack2(r[0], r[1]); o.y = pack2(r[2], r[3]); o.z = pack2(r[4], r[5]); o.w = pack2(r[6], r[7]);
        }
        *(u32x4*)(P + (size_t)(seq0 + t) * PINP + col) = o;
      }
    }
  }
  __syncthreads();
}

DI void tile_rstd(const bf16_t* P, int m0, int col0, int ncols, float* rst) {
  const int tid = ltid(), r = tid >> 1, hf = tid & 1, n = ncols >> 1;
  const bf16_t* src = P + (size_t)(m0 + r) * PINP + col0 + hf * n;
  float ss = 0.f;
  for (int c = 0; c < n; c += 8) { const u32x4 q = *(const u32x4*)(src + c);
    ss += bflo(q.x) * bflo(q.x) + bfhi(q.x) * bfhi(q.x) + bflo(q.y) * bflo(q.y) + bfhi(q.y) * bfhi(q.y) + bflo(q.z) * bflo(q.z) + bfhi(q.z) * bfhi(q.z) + bflo(q.w) * bflo(q.w) + bfhi(q.w) * bfhi(q.w); }
  ss += __shfl_xor(ss, 1);
  if (hf == 0) rst[r] = rsqrtf(ss / (float)ncols + 1e-6f);
  __syncthreads();
}
DI void qproj_item(const Params& p, int l, int item, char* smem) {
  const int mt = item / 3, nt = item % 3; const bf16_t* P = (const bf16_t*)(p.ws + OFF_P);
  float* rst = (float*)(smem + 36864);
  tile_rstd(P, mt * 128, C_CQ, 256, rst);
  bf16_t* Q = (bf16_t*)(p.ws + OFF_QRAW);
  gemm_tile<0, 0>(P + C_CQ, PINP, (const bf16_t*)(p.ws + OFF_WUQ) + (size_t)l * 384 * 256, 256, 256, mt * 128, nt * 128, smem, nullptr,
               [&](int row, int col, f32x4 v) { const float r = rst[row - mt * 128]; store_bf4(Q + (size_t)row * 384 + col, v * r); });
  __syncthreads();
}
DI void kvproj_item(const Params& p, int l, int item, char* smem) {
  const int mt = item / 4, nt = item % 4; const bf16_t* P = (const bf16_t*)(p.ws + OFF_P);
  float* rst = (float*)(smem + 36864);
  tile_rstd(P, mt * 128, C_CKV, 128, rst);
  bf16_t* KH = (bf16_t*)(p.ws + OFF_KH); bf16_t* VT = (bf16_t*)(p.ws + OFF_VT);
  gemm_tile<0, 0>(P + C_CKV, PINP, (const bf16_t*)(p.ws + OFF_WUKV) + (size_t)l * 512 * 128, 128, 128, mt * 128, nt * 128, smem, nullptr,
               [&](int row, int col, f32x4 v) {
                 const float r = rst[row - mt * 128]; v = v * r;
                 const int hh = col >> 7, dd = col & 127;
                 int b, tpos; if (row < NLAT) { b = row / T; tpos = row % T; } else { b = (row - NLAT) / TC; tpos = T + (row - NLAT) % TC; }
                 if (dd < 64) store_bf4(KH + ((size_t)(b * 4 + hh) * TALL + tpos) * 64 + dd, v);
                 else {
                   bf16_t* vp = VT + ((size_t)(b * 4 + hh) * 64 + (dd - 64)) * TALL + tpos;
                   vp[0] = f2bf(v[0]); vp[TALL] = f2bf(v[1]); vp[2 * TALL] = f2bf(v[2]); vp[3 * TALL] = f2bf(v[3]);
                 }
               });
  __syncthreads();
}
DI void rope_cs(int t, int i, float& cs, float& sn) {
  const int pos = (i < 8) ? (t >> 6) : (t & 63); const int f = i & 7;
  const float inv = exp2f(-(float)f * (13.287712379549449f / 8.f));
  const float ang = (float)pos * inv;
  cs = cosf(ang); sn = sinf(ang);
}
DI void ropek_item(const Params& p, int item) {
  const int row = item * 256 + ltid();
  const bf16_t* src = (const bf16_t*)(p.ws + OFF_P) + (size_t)row * PINP + C_KR;
  u32x4 q[4];
#pragma unroll
  for (int i = 0; i < 4; ++i) q[i] = *(const u32x4*)(src + i * 8);
  float v[32];
#pragma unroll
  for (int i = 0; i < 4; ++i) { v[i * 8 + 0] = bflo(q[i].x); v[i * 8 + 1] = bfhi(q[i].x); v[i * 8 + 2] = bflo(q[i].y); v[i * 8 + 3] = bfhi(q[i].y);
    v[i * 8 + 4] = bflo(q[i].z); v[i * 8 + 5] = bfhi(q[i].z); v[i * 8 + 6] = bflo(q[i].w); v[i * 8 + 7] = bfhi(q[i].w); }
  int b, tpos;
  if (row < NLAT) {
    b = row / T; tpos = row % T;
#pragma unroll
    for (int i = 0; i < 16; ++i) { float cs, sn; rope_cs(tpos, i, cs, sn); const float x1 = v[i], x2 = v[i + 16]; v[i] = x1 * cs - x2 * sn; v[i + 16] = x1 * sn + x2 * cs; }
  } else { b = (row - NLAT) / TC; tpos = T + (row - NLAT) % TC; }
  u32x4 o[4];
#pragma unroll
  for (int i = 0; i < 4; ++i) { o[i].x = pack2(v[i * 8], v[i * 8 + 1]); o[i].y = pack2(v[i * 8 + 2], v[i * 8 + 3]); o[i].z = pack2(v[i * 8 + 4], v[i * 8 + 5]); o[i].w = pack2(v[i * 8 + 6], v[i * 8 + 7]); }
  bf16_t* dst = (bf16_t*)(p.ws + OFF_KR) + ((size_t)b * TALL + tpos) * 32;
#pragma unroll
  for (int i = 0; i < 4; ++i) *(u32x4*)(dst + i * 8) = o[i];
}

DI void attn_item(const Params& p, int item, char* smem) {
  const int tid = ltid(), lane = tid & 63, w = __builtin_amdgcn_readfirstlane(tid >> 6), l15 = lane & 15, g4 = lane >> 4;
  int b, h, qt, latent;
  if (item < 512) { latent = 1; qt = item & 63; h = (item >> 6) & 3; b = item >> 8; }
  else { latent = 0; const int i2 = item - 512; qt = i2 & 1; h = (i2 >> 1) & 3; b = i2 >> 3; }
  const int qrow0 = latent ? b * T + qt * 128 : NLAT + b * TC + qt * 128;
  bf16_t* Qs = (bf16_t*)smem;
  bf16_t* Ks = (bf16_t*)smem;
  bf16_t* Vs = Ks + 64 * 104;
  const bf16_t* Qraw = (const bf16_t*)(p.ws + OFF_QRAW);
  const float qscale = 0.10206207261596577f * 1.4426950408889634f;
  for (int id = tid; id < 1280; id += 256) {
    const int r = id / 10, cc = id % 10;
    const bf16_t* src = Qraw + (size_t)(qrow0 + r) * 384 + h * 96 + cc * 8;
    const u32x4 q = *(const u32x4*)src;
    float a[8] = {bflo(q.x), bfhi(q.x), bflo(q.y), bfhi(q.y), bflo(q.z), bfhi(q.z), bflo(q.w), bfhi(q.w)};
    if (cc < 8) {
      u32x4 o; o.x = pack2(a[0] * qscale, a[1] * qscale); o.y = pack2(a[2] * qscale, a[3] * qscale); o.z = pack2(a[4] * qscale, a[5] * qscale); o.w = pack2(a[6] * qscale, a[7] * qscale);
      *(u32x4*)(Qs + r * 104 + cc * 8) = o;
    } else {
      const u32x4 q2 = *(const u32x4*)(src + 16);
      float c2[8] = {bflo(q2.x), bfhi(q2.x), bflo(q2.y), bfhi(q2.y), bflo(q2.z), bfhi(q2.z), bflo(q2.w), bfhi(q2.w)};
      float o1[8], o2[8];
#pragma unroll
      for (int j = 0; j < 8; ++j) {
        float cs = 1.f, sn = 0.f;
        if (latent) rope_cs(qt * 128 + r, (cc - 8) * 8 + j, cs, sn);
        o1[j] = (a[j] * cs - c2[j] * sn) * qscale; o2[j] = (a[j] * sn + c2[j] * cs) * qscale;
      }
      u32x4 o; o.x = pack2(o1[0], o1[1]); o.y = pack2(o1[2], o1[3]); o.z = pack2(o1[4], o1[5]); o.w = pack2(o1[6], o1[7]);
      *(u32x4*)(Qs + r * 104 + cc * 8) = o;
      o.x = pack2(o2[0], o2[1]); o.y = pack2(o2[2], o2[3]); o.z = pack2(o2[4], o2[5]); o.w = pack2(o2[6], o2[7]);
      *(u32x4*)(Qs + r * 104 + cc * 8 + 16) = o;
    }
  }
  __syncthreads();
  bf16x8 qf[2][3];
#pragma unroll
  for (int qs = 0; qs < 2; ++qs)
#pragma unroll
    for (int ks = 0; ks < 3; ++ks) qf[qs][ks] = ld_frag(Qs + (32 * w + 16 * qs + l15) * 104 + ks * 32 + g4 * 8);
  __syncthreads();
  const int kt0 = latent ? 0 : 128, kt1 = 132;
  const bf16_t* Kg = (const bf16_t*)(p.ws + OFF_KH) + (size_t)(b * 4 + h) * TALL * 64;
  const bf16_t* Rg = (const bf16_t*)(p.ws + OFF_KR) + (size_t)b * TALL * 32;
  const bf16_t* Vg = (const bf16_t*)(p.ws + OFF_VT) + (size_t)(b * 4 + h) * 64 * TALL;
  u32x4 kr[3], vr[2];
  const int ve0 = tid >> 3, vc = tid & 7;
  {
    kr[0] = *(const u32x4*)(Kg + (size_t)kt0 * 4096 + tid * 8); kr[1] = *(const u32x4*)(Kg + (size_t)kt0 * 4096 + (tid + 256) * 8);
    kr[2] = *(const u32x4*)(Rg + (size_t)kt0 * 2048 + tid * 8);
#pragma unroll
    for (int i = 0; i < 2; ++i) vr[i] = *(const u32x4*)(Vg + (size_t)(ve0 + 32 * i) * TALL + kt0 * 64 + vc * 8);
  }
  float mrun[2] = {0.f, 0.f}, lsum[2] = {0.f, 0.f};
  f32x4 O[4][2];
#pragma unroll
  for (int es = 0; es < 4; ++es)
#pragma unroll
    for (int qs = 0; qs < 2; ++qs) O[es][qs] = (f32x4){0.f, 0.f, 0.f, 0.f};
  constexpr int KVB = 64 * 104 + 64 * 72;
  {
#pragma unroll
    for (int i = 0; i < 2; ++i) { const int id = tid + 256 * i; *(u32x4*)(Ks + (id >> 3) * 104 + (id & 7) * 8) = kr[i]; }
    *(u32x4*)(Ks + (tid >> 2) * 104 + 64 + (tid & 3) * 8) = kr[2];
#pragma unroll
    for (int i = 0; i < 2; ++i) *(u32x4*)(Vs + (ve0 + 32 * i) * 72 + vc * 8) = vr[i];
    if (kt0 + 1 < kt1) {
      kr[0] = *(const u32x4*)(Kg + (size_t)(kt0 + 1) * 4096 + tid * 8); kr[1] = *(const u32x4*)(Kg + (size_t)(kt0 + 1) * 4096 + (tid + 256) * 8);
      kr[2] = *(const u32x4*)(Rg + (size_t)(kt0 + 1) * 2048 + tid * 8);
#pragma unroll
      for (int i = 0; i < 2; ++i) vr[i] = *(const u32x4*)(Vg + (size_t)(ve0 + 32 * i) * TALL + (kt0 + 1) * 64 + vc * 8);
    }
    __syncthreads();
  }
  for (int kt = kt0; kt < kt1; ++kt) {
    const int cur = (kt - kt0) & 1;
    const bf16_t* Kc = Ks + cur * KVB; const bf16_t* Vc = Vs + cur * KVB;
    bf16_t* Kn = Ks + (cur ^ 1) * KVB; bf16_t* Vn = Vs + (cur ^ 1) * KVB;
    if (kt + 1 < kt1) {
#pragma unroll
      for (int i = 0; i < 2; ++i) { const int id = tid + 256 * i; *(u32x4*)(Kn + (id >> 3) * 104 + (id & 7) * 8) = kr[i]; }
      *(u32x4*)(Kn + (tid >> 2) * 104 + 64 + (tid & 3) * 8) = kr[2];
#pragma unroll
      for (int i = 0; i < 2; ++i) *(u32x4*)(Vn + (ve0 + 32 * i) * 72 + vc * 8) = vr[i];
    }
    if (kt + 2 < kt1) {
      kr[0] = *(const u32x4*)(Kg + (size_t)(kt + 2) * 4096 + tid * 8); kr[1] = *(const u32x4*)(Kg + (size_t)(kt + 2) * 4096 + (tid + 256) * 8);
      kr[2] = *(const u32x4*)(Rg + (size_t)(kt + 2) * 2048 + tid * 8);
#pragma unroll
      for (int i = 0; i < 2; ++i) vr[i] = *(const u32x4*)(Vg + (size_t)(ve0 + 32 * i) * TALL + (kt + 2) * 64 + vc * 8);
    }
    __builtin_amdgcn_sched_barrier(0);
    f32x4 sa[4][2];
#pragma unroll
    for (int kb = 0; kb < 4; ++kb)
#pragma unroll
      for (int qs = 0; qs < 2; ++qs) { const float nm = -mrun[qs]; sa[kb][qs] = (f32x4){nm, nm, nm, nm}; }
#pragma unroll
    for (int ks = 0; ks < 3; ++ks)
#pragma unroll
      for (int kb = 0; kb < 4; ++kb) {
        const bf16x8 a = ld_frag(Kc + (16 * kb + l15) * 104 + ks * 32 + g4 * 8);
#pragma unroll
        for (int qs = 0; qs < 2; ++qs) sa[kb][qs] = MFMA16(a, qf[qs][ks], sa[kb][qs]);
      }
    bf16x8 pf[2][2];
    float dl[2];
#pragma unroll
    for (int qs = 0; qs < 2; ++qs) {
      float mx = -1e30f;
#pragma unroll
      for (int kb = 0; kb < 4; ++kb)
#pragma unroll
        for (int j = 0; j < 4; ++j) mx = fmaxf(mx, sa[kb][qs][j]);
      mx = fmaxf(mx, __shfl_xor(mx, 16)); mx = fmaxf(mx, __shfl_xor(mx, 32));
      dl[qs] = (kt == kt0) ? mx : fmaxf(mx, 0.f);
    }
    const bool grew = (kt == kt0) || __builtin_amdgcn_ballot_w64(dl[0] > 0.f || dl[1] > 0.f) != 0ull;
#pragma unroll
    for (int qs = 0; qs < 2; ++qs) {
      float ps = 0.f;
      if (grew) {
        const float d = dl[qs], alpha = (kt == kt0) ? 0.f : __builtin_amdgcn_exp2f(-d);
        mrun[qs] += d;
#pragma unroll
        for (int kb = 0; kb < 4; ++kb)
#pragma unroll
          for (int j = 0; j < 4; ++j) { const float e = __builtin_amdgcn_exp2f(sa[kb][qs][j] - d); sa[kb][qs][j] = e; ps += e; }
        lsum[qs] = lsum[qs] * alpha + ps;
#pragma unroll
        for (int es = 0; es < 4; ++es) O[es][qs] = O[es][qs] * alpha;
      } else {
#pragma unroll
        for (int kb = 0; kb < 4; ++kb)
#pragma unroll
          for (int j = 0; j < 4; ++j) { const float e = __builtin_amdgcn_exp2f(sa[kb][qs][j]); sa[kb][qs][j] = e; ps += e; }
        lsum[qs] += ps;
      }
#pragma unroll
      for (int k2 = 0; k2 < 2; ++k2)
        pf[qs][k2] = mk_frag(pack2(sa[2 * k2][qs][0], sa[2 * k2][qs][1]), pack2(sa[2 * k2][qs][2], sa[2 * k2][qs][3]),
                             pack2(sa[2 * k2 + 1][qs][0], sa[2 * k2 + 1][qs][1]), pack2(sa[2 * k2 + 1][qs][2], sa[2 * k2 + 1][qs][3]));
    }
#pragma unroll
    for (int k2 = 0; k2 < 2; ++k2)
#pragma unroll
      for (int es = 0; es < 4; ++es) {
        const bf16_t* vp = Vc + (16 * es + l15) * 72 + 32 * k2 + 4 * g4;
        const u32x2 lo = *(const u32x2*)vp, hi = *(const u32x2*)(vp + 16);
        const bf16x8 a = mk_frag(lo.x, lo.y, hi.x, hi.y);
#pragma unroll
        for (int qs = 0; qs < 2; ++qs) O[es][qs] = MFMA16(a, pf[qs][k2], O[es][qs]);
      }
    __syncthreads();
  }
  bf16_t* Y = (bf16_t*)(p.ws + OFF_HY);
#pragma unroll
  for (int qs = 0; qs < 2; ++qs) {
    float l = lsum[qs]; l += __shfl_xor(l, 16); l += __shfl_xor(l, 32);
    const float inv = 1.f / l;
    const int row = qrow0 + 32 * w + 16 * qs + l15;
#pragma unroll
    for (int es = 0; es < 4; ++es) store_bf4(Y + (size_t)row * 1024 + 256 + h * 64 + 16 * es + 4 * g4, O[es][qs] * inv);
  }
  __syncthreads();
}

DI void chunk_geom(int tcg, int b, int& part, int& tc, int& row0) { part = tcg >= 128; tc = part ? tcg - 128 : tcg; row0 = row_of(b, part, tc * 64); }
DI int chain_slot(int dir, int part, int tc) { return dir ? (part ? 3 - tc : 131 - tc) : (part ? tc : 4 + tc); }

DI void mlstm_p1(const Params& p, int l, int item, char* smem) {
  const int tid = ltid(), lane = tid & 63, w = __builtin_amdgcn_readfirstlane(tid >> 6), l15 = lane & 15, g4 = lane >> 4;
  const int tcg = item % NCH; int r = item / NCH; const int dir = r & 1; r >>= 1; const int h = r & 3, b = r >> 2;
  int part, tc, row0; chunk_geom(tcg, b, part, tc, row0);
  const int c = chain_slot(dir, part, tc), chain = (b * 4 + h) * 2 + dir;
  bf16_t* A = (bf16_t*)smem;
  bf16_t* Bk = A + 80 * 72;
  float* fs = (float*)(Bk + 64 * 72);
  const bf16_t* P = (const bf16_t*)(p.ws + OFF_P); const float* GML = (const float*)(p.ws + OFF_GML);
  float* MLM = (float*)(p.ws + OFF_MLM) + (size_t)(chain * NCH + c) * 32;
  if (tid < 64) {
    const int gi = 2 * dir;
    const float ig = GML[(size_t)(row0 + tid) * 16 + gi * 4 + h] + p.ml_gate_bias[l * 16 + gi * 4 + h];
    const float fg = GML[(size_t)(row0 + tid) * 16 + (gi + 1) * 4 + h] + p.ml_gate_bias[l * 16 + (gi + 1) * 4 + h];
    const float lf = logsigm_f(fg);
    const float pre = wave_incl_scan(lf, lane), tot = __shfl(pre, 63);
    const float bc = dir ? tot - pre + lf : pre;
    const float wlog = tot - bc + ig, mloc = wave_max(wlog), wv = __expf(wlog - mloc);
    fs[tid] = wv; A[64 * 72 + tid] = f2bf(wv);
    if (tid == 0) { MLM[0] = mloc; MLM[1] = tot; }
  }
  for (int i = tid; i < 15 * 72; i += 256) A[65 * 72 + i] = 0;
  __syncthreads();
  {
    const int s = tid >> 2, d0 = (tid & 3) * 16; const float wv = fs[s];
    const bf16_t* kp = P + (size_t)(row0 + s) * PINP + C_MLK + h * 64 + d0;
    const bf16_t* vp = P + (size_t)(row0 + s) * PINP + C_MLV + h * 64 + d0;
#pragma unroll
    for (int hf = 0; hf < 2; ++hf) {
      const u32x4 kq = *(const u32x4*)(kp + hf * 8), vq = *(const u32x4*)(vp + hf * 8);
      const float kk[8] = {bflo(kq.x), bfhi(kq.x), bflo(kq.y), bfhi(kq.y), bflo(kq.z), bfhi(kq.z), bflo(kq.w), bfhi(kq.w)};
      const float vv[8] = {bflo(vq.x), bfhi(vq.x), bflo(vq.y), bfhi(vq.y), bflo(vq.z), bfhi(vq.z), bflo(vq.w), bfhi(vq.w)};
#pragma unroll
      for (int j = 0; j < 8; ++j) { Bk[(d0 + hf * 8 + j) * 72 + s] = f2bf(kk[j] * 0.125f); A[(d0 + hf * 8 + j) * 72 + s] = f2bf(vv[j] * wv); }
    }
  }
  __syncthreads();
  float* MLS = (float*)(p.ws + OFF_MLS) + (size_t)(chain * NCH + c) * 4160;
  for (int t = w; t < 20; t += 4) {
    const int ms = t >> 2, ns = t & 3;
    f32x4 acc = {0.f, 0.f, 0.f, 0.f};
#pragma unroll
    for (int ks = 0; ks < 2; ++ks) acc = MFMA16(ld_frag(A + (16 * ms + l15) * 72 + ks * 32 + g4 * 8), ld_frag(Bk + (16 * ns + l15) * 72 + ks * 32 + g4 * 8), acc);
#pragma unroll
    for (int j = 0; j < 4; ++j) { const int e = 16 * ms + 4 * g4 + j; if (e <= 64) MLS[e * 64 + 16 * ns + l15] = acc[j]; }
  }
  __syncthreads();
}
DI void mlstm_p2(const Params& p, int item) {
  const int gi = item * 256 + ltid(), chain = gi / 4160, e = gi % 4160;
  float* MLS = (float*)(p.ws + OFF_MLS) + (size_t)chain * NCH * 4160 + e;
  float* MLM = (float*)(p.ws + OFF_MLM) + (size_t)chain * NCH * 32;
  float C = 0.f, m = 0.f;
  for (int c0 = 0; c0 < NCH; c0 += 12) {
    float d[12], ml[12], bl[12];
#pragma unroll
    for (int i = 0; i < 12; ++i) { d[i] = MLS[(size_t)(c0 + i) * 4160]; ml[i] = MLM[(c0 + i) * 32]; bl[i] = MLM[(c0 + i) * 32 + 1]; }
#pragma unroll
    for (int i = 0; i < 12; ++i) {
      MLS[(size_t)(c0 + i) * 4160] = C; if (e == 0) MLM[(c0 + i) * 32 + 16] = m;
      const float mn = fmaxf(bl[i] + m, ml[i]);
      C = __expf(bl[i] + m - mn) * C + __expf(ml[i] - mn) * d[i]; m = mn;
    }
  }
}
DI void mlstm_p3(const Params& p, int l, int item, char* smem) {
  const int tid = ltid(), lane = tid & 63, w = __builtin_amdgcn_readfirstlane(tid >> 6), l15 = lane & 15, g4 = lane >> 4;
  const int h = item & 3; const int r = item >> 2; const int tcg = r % NCH, b = r / NCH;
  int part, tc, row0; chunk_geom(tcg, b, part, tc, row0);
  bf16_t* Qs = (bf16_t*)smem;
  bf16_t* Ks = Qs + 64 * 72;
  bf16_t* Vt = Ks + 64 * 72;
  bf16_t* Sb = Vt + 64 * 72;
  float* fb = (float*)(Sb + 64 * 72);
  float* fi = fb + 64;
  const bf16_t* P = (const bf16_t*)(p.ws + OFF_P); const float* GML = (const float*)(p.ws + OFF_GML);
  {
    const int s = tid >> 2, d0 = (tid & 3) * 16;
    const bf16_t* base = P + (size_t)(row0 + s) * PINP + h * 64 + d0;
#pragma unroll
    for (int hf = 0; hf < 2; ++hf) {
      *(u32x4*)(Qs + s * 72 + d0 + hf * 8) = *(const u32x4*)(base + C_MLQ + hf * 8);
      const u32x4 kq = *(const u32x4*)(base + C_MLK + hf * 8), vq = *(const u32x4*)(base + C_MLV + hf * 8);
      u32x4 ko; ko.x = pack2(bflo(kq.x) * 0.125f, bfhi(kq.x) * 0.125f); ko.y = pack2(bflo(kq.y) * 0.125f, bfhi(kq.y) * 0.125f);
      ko.z = pack2(bflo(kq.z) * 0.125f, bfhi(kq.z) * 0.125f); ko.w = pack2(bflo(kq.w) * 0.125f, bfhi(kq.w) * 0.125f);
      *(u32x4*)(Ks + s * 72 + d0 + hf * 8) = ko;
      const unsigned vw[4] = {vq.x, vq.y, vq.z, vq.w};
#pragma unroll
      for (int j = 0; j < 4; ++j) { Vt[(d0 + hf * 8 + 2 * j) * 72 + s] = (bf16_t)(vw[j] & 0xffffu); Vt[(d0 + hf * 8 + 2 * j + 1) * 72 + s] = (bf16_t)(vw[j] >> 16); }
    }
  }
  f32x4 hs[4];
#pragma unroll
  for (int ns = 0; ns < 4; ++ns) hs[ns] = (f32x4){0.f, 0.f, 0.f, 0.f};
#pragma unroll 1
  for (int dir = 0; dir < 2; ++dir) {
    const int c = chain_slot(dir, part, tc), chain = (b * 4 + h) * 2 + dir;
    const float m_in = ((const float*)(p.ws + OFF_MLM))[(size_t)(chain * NCH + c) * 32 + 16];
    const float* Cst = (const float*)(p.ws + OFF_MLS) + (size_t)(chain * NCH + c) * 4160;
    __syncthreads();
    if (tid < 64) {
      const int gi = 2 * dir;
      const float ig = GML[(size_t)(row0 + tid) * 16 + gi * 4 + h] + p.ml_gate_bias[l * 16 + gi * 4 + h];
      const float fg = GML[(size_t)(row0 + tid) * 16 + (gi + 1) * 4 + h] + p.ml_gate_bias[l * 16 + (gi + 1) * 4 + h];
      const float lf = logsigm_f(fg);
      const float pre = wave_incl_scan(lf, lane), tot = __shfl(pre, 63);
      fb[tid] = dir ? tot - pre + lf : pre; fi[tid] = ig;
    }
    __syncthreads();
    f32x4 sc[4];
#pragma unroll
    for (int ns = 0; ns < 4; ++ns) {
      f32x4 a = {0.f, 0.f, 0.f, 0.f};
#pragma unroll
      for (int ks = 0; ks < 2; ++ks) a = MFMA16(ld_frag(Qs + (16 * w + l15) * 72 + ks * 32 + g4 * 8), ld_frag(Ks + (16 * ns + l15) * 72 + ks * 32 + g4 * 8), a);
      sc[ns] = a;
    }
    float bi[4], mt[4], rsum[4];
#pragma unroll
    for (int j = 0; j < 4; ++j) {
      const int i = 16 * w + 4 * g4 + j; bi[j] = fb[i];
      float mx = -1e30f;
#pragma unroll
      for (int ns = 0; ns < 4; ++ns) { const int s = 16 * ns + l15; const bool ok = dir ? (s >= i) : (s <= i); const float dm = bi[j] - fb[s] + fi[s]; if (ok) mx = fmaxf(mx, dm); }
      mx = red16_max(mx);
      mt[j] = fmaxf(bi[j] + m_in, mx);
      float rs = 0.f;
#pragma unroll
      for (int ns = 0; ns < 4; ++ns) {
        const int s = 16 * ns + l15; const bool ok = dir ? (s >= i) : (s <= i);
        const float v = ok ? sc[ns][j] * __expf(bi[j] - fb[s] + fi[s] - mt[j]) : 0.f;
        rs += v; Sb[i * 72 + s] = f2bf(v);
      }
      rsum[j] = red16_sum(rs);
    }
    __syncthreads();
    f32x4 qc[5];
#pragma unroll
    for (int ns = 0; ns < 5; ++ns) {
      f32x4 a = {0.f, 0.f, 0.f, 0.f};
      const int e = 16 * ns + l15;
#pragma unroll
      for (int ks = 0; ks < 2; ++ks) {
        bf16x8 bfm;
        if (e <= 64) bfm = frag_from_f32(Cst + e * 64 + ks * 32 + g4 * 8, 1.f); else bfm = mk_frag(0u, 0u, 0u, 0u);
        a = MFMA16(ld_frag(Qs + (16 * w + l15) * 72 + ks * 32 + g4 * 8), bfm, a);
      }
      qc[ns] = a;
    }
    f32x4 nm[4];
#pragma unroll
    for (int ns = 0; ns < 4; ++ns) {
      f32x4 a = {0.f, 0.f, 0.f, 0.f};
#pragma unroll
      for (int ks = 0; ks < 2; ++ks) a = MFMA16(ld_frag(Sb + (16 * w + l15) * 72 + ks * 32 + g4 * 8), ld_frag(Vt + (16 * ns + l15) * 72 + ks * 32 + g4 * 8), a);
      nm[ns] = a;
    }
#pragma unroll
    for (int j = 0; j < 4; ++j) {
      const float wi = __expf(bi[j] + m_in - mt[j]);
      const float qn = __shfl(qc[4][j], lane & 48);
      const float den = rsum[j] + wi * qn;
      const float dd = 1.f / fmaxf(fabsf(den), __expf(-mt[j]));
#pragma unroll
      for (int ns = 0; ns < 4; ++ns) hs[ns][j] += (nm[ns][j] + wi * qc[ns][j]) * dd;
    }
  }
  bf16_t* Y = (bf16_t*)(p.ws + OFF_HY);
#pragma unroll
  for (int j = 0; j < 4; ++j) {
    float ss = 0.f;
#pragma unroll
    for (int ns = 0; ns < 4; ++ns) ss += hs[ns][j] * hs[ns][j];
    ss = red16_sum(ss);
    const float rstd = rsqrtf(ss * (1.f / 64.f) + 1e-6f);
    const int row = row0 + 16 * w + 4 * g4 + j;
#pragma unroll
    for (int ns = 0; ns < 4; ++ns) {
      const int ch = h * 64 + 16 * ns + l15;
      const float o = bf2f(P[(size_t)row * PINP + C_MLO + ch]);
      Y[(size_t)row * 1024 + ch] = f2bf(hs[ns][j] * rstd * p.ml_norm[l * 256 + ch] * sigm_f(o));
    }
  }
  __syncthreads();
}

DI void conv_silu8(const Params& p, int l, const bf16_t* P, int row, bool hp, bool hn, int ch, float* out) {
  const u32x4 c0 = *(const u32x4*)(P + (size_t)row * PINP + C_XBC + ch);
  out[0] = bflo(c0.x); out[1] = bfhi(c0.x); out[2] = bflo(c0.y); out[3] = bfhi(c0.y); out[4] = bflo(c0.z); out[5] = bfhi(c0.z); out[6] = bflo(c0.w); out[7] = bfhi(c0.w);
}
DI void ssd_gates(const Params& p, int l, int dir, int h, int row0, int tid, int lane, float& dt, float& cs, float& tot) {
  const float* DTR = (const float*)(p.ws + OFF_DTR);
  dt = softplus_f(DTR[(size_t)(row0 + tid) * 8 + dir * 4 + h] + p.ssd_dt_bias[l * 8 + dir * 4 + h]);
  const float la = -dt * __expf(p.ssd_a_log[l * 8 + dir * 4 + h]);
  const float pre = wave_incl_scan(la, lane); tot = __shfl(pre, 63);
  cs = dir ? tot - pre + la : pre;
}
DI void ssd_p1(const Params& p, int l, int item, char* smem) {
  const int tid = ltid(), lane = tid & 63, w = __builtin_amdgcn_readfirstlane(tid >> 6), l15 = lane & 15, g4 = lane >> 4;
  const int tcg = item % NCH; int r = item / NCH; const int dir = r & 1; r >>= 1; const int h = r & 3, b = r >> 2;
  int part, tc, row0; chunk_geom(tcg, b, part, tc, row0);
  const int c = chain_slot(dir, part, tc), chain = (b * 4 + h) * 2 + dir, lastc = part ? 3 : 127;
  bf16_t* Xt = (bf16_t*)smem;
  bf16_t* Bt = Xt + 64 * 72;
  float* fs = (float*)(Bt + 128 * 72);
  const bf16_t* P = (const bf16_t*)(p.ws + OFF_P);
  if (tid < 64) {
    float dt, cs, tot; ssd_gates(p, l, dir, h, row0, tid, lane, dt, cs, tot);
    fs[tid] = __expf(tot - cs) * dt;
    if (tid == 0) ((float*)(p.ws + OFF_SSA))[(chain * NCH + c) * 32] = tot;
  }
  __syncthreads();
  const int grp = h >> 1;
  for (int id = tid; id < 64 * 24; id += 256) {
    const int s = id / 24, cc = id % 24;
    const bool hp = !(tc == 0 && s == 0), hn = !(tc == lastc && s == 63);
    float v[8];
    if (cc < 8) { conv_silu8(p, l, P, row0 + s, hp, hn, h * 64 + cc * 8, v); const float wv = fs[s];
#pragma unroll
      for (int j = 0; j < 8; ++j) Xt[(cc * 8 + j) * 72 + s] = f2bf(v[j] * wv); }
    else { const int n0 = (cc - 8) * 8; conv_silu8(p, l, P, row0 + s, hp, hn, 256 + grp * 128 + n0, v);
#pragma unroll
      for (int j = 0; j < 8; ++j) Bt[(n0 + j) * 72 + s] = f2bf(v[j]); }
  }
  __syncthreads();
  float* SS = (float*)(p.ws + OFF_SSDS) + (size_t)(chain * NCH + c) * 8192;
#pragma unroll
  for (int ns = 0; ns < 8; ++ns) {
    f32x4 acc = {0.f, 0.f, 0.f, 0.f};
#pragma unroll
    for (int ks = 0; ks < 2; ++ks) acc = MFMA16(ld_frag(Xt + (16 * w + l15) * 72 + ks * 32 + g4 * 8), ld_frag(Bt + (16 * ns + l15) * 72 + ks * 32 + g4 * 8), acc);
#pragma unroll
    for (int j = 0; j < 4; ++j) SS[(16 * w + 4 * g4 + j) * 128 + 16 * ns + l15] = acc[j];
  }
  __syncthreads();
}
DI void ssd_p2(const Params& p, int item) {
  const int gi = item * 256 + ltid(), chain = gi >> 13, e = gi & 8191;
  float* SS = (float*)(p.ws + OFF_SSDS) + (size_t)chain * NCH * 8192 + e;
  const float* SA = (const float*)(p.ws + OFF_SSA) + (size_t)chain * NCH * 32;
  float S = 0.f;
  for (int c0 = 0; c0 < NCH; c0 += 12) {
    float d[12], a[12];
#pragma unroll
    for (int i = 0; i < 12; ++i) { d[i] = SS[(size_t)(c0 + i) * 8192]; a[i] = SA[(c0 + i) * 32]; }
#pragma unroll
    for (int i = 0; i < 12; ++i) { SS[(size_t)(c0 + i) * 8192] = S; S = __expf(a[i]) * S + d[i]; }
  }
}
DI void ssd_p3(const Params& p, int l, int item, char* smem) {
  const int tid = ltid(), lane = tid & 63, w = __builtin_amdgcn_readfirstlane(tid >> 6), l15 = lane & 15, g4 = lane >> 4;
  const int h = item & 3; const int r = item >> 2; const int tcg = r % NCH, b = r / NCH;
  int part, tc, row0; chunk_geom(tcg, b, part, tc, row0);
  const int lastc = part ? 3 : 127, grp = h >> 1;
  bf16_t* Cm = (bf16_t*)smem;
  bf16_t* Bm = Cm + 64 * 136;
  bf16_t* Xt = Bm + 64 * 136;
  bf16_t* Sb = Xt + 64 * 72;
  float* fcs = (float*)(Sb + 64 * 72);
  float* fdt = fcs + 64;
  const bf16_t* P = (const bf16_t*)(p.ws + OFF_P);
  for (int id = tid; id < 64 * 40; id += 256) {
    const int s = id / 40, cc = id % 40;
    const bool hp = !(tc == 0 && s == 0), hn = !(tc == lastc && s == 63);
    float v[8];
    if (cc < 8) { conv_silu8(p, l, P, row0 + s, hp, hn, h * 64 + cc * 8, v);
#pragma unroll
      for (int j = 0; j < 8; ++j) Xt[(cc * 8 + j) * 72 + s] = f2bf(v[j]); }
    else {
      const int q = cc - 8, isC = q >= 16, n0 = (q & 15) * 8;
      conv_silu8(p, l, P, row0 + s, hp, hn, 256 + isC * 256 + grp * 128 + n0, v);
      u32x4 o; o.x = pack2(v[0], v[1]); o.y = pack2(v[2], v[3]); o.z = pack2(v[4], v[5]); o.w = pack2(v[6], v[7]);
      *(u32x4*)((isC ? Cm : Bm) + s * 136 + n0) = o;
    }
  }
  f32x4 ys[4];
#pragma unroll
  for (int ns = 0; ns < 4; ++ns) ys[ns] = (f32x4){0.f, 0.f, 0.f, 0.f};
#pragma unroll 1
  for (int dir = 0; dir < 2; ++dir) {
    const int c = chain_slot(dir, part, tc), chain = (b * 4 + h) * 2 + dir;
    const float* St = (const float*)(p.ws + OFF_SSDS) + (size_t)(chain * NCH + c) * 8192;
    __syncthreads();
    if (tid < 64) { float dt, cs, tot; ssd_gates(p, l, dir, h, row0, tid, lane, dt, cs, tot); fcs[tid] = cs; fdt[tid] = dt; }
    __syncthreads();
    float ci[4];
#pragma unroll
    for (int j = 0; j < 4; ++j) ci[j] = fcs[16 * w + 4 * g4 + j];
#pragma unroll
    for (int ns = 0; ns < 4; ++ns) {
      f32x4 a = {0.f, 0.f, 0.f, 0.f};
#pragma unroll
      for (int ks = 0; ks < 4; ++ks) a = MFMA16(ld_frag(Cm + (16 * w + l15) * 136 + ks * 32 + g4 * 8), ld_frag(Bm + (16 * ns + l15) * 136 + ks * 32 + g4 * 8), a);
      const int s = 16 * ns + l15; const float css = fcs[s], dts = fdt[s];
#pragma unroll
      for (int j = 0; j < 4; ++j) {
        const int i = 16 * w + 4 * g4 + j; const bool ok = dir ? (s >= i) : (s <= i);
        Sb[i * 72 + s] = f2bf(ok ? a[j] * __expf(ci[j] - css) * dts : 0.f);
      }
    }
    __syncthreads();
#pragma unroll
    for (int ns = 0; ns < 4; ++ns) {
      f32x4 a = {0.f, 0.f, 0.f, 0.f}, bq = {0.f, 0.f, 0.f, 0.f};
#pragma unroll
      for (int ks = 0; ks < 2; ++ks) a = MFMA16(ld_frag(Sb + (16 * w + l15) * 72 + ks * 32 + g4 * 8), ld_frag(Xt + (16 * ns + l15) * 72 + ks * 32 + g4 * 8), a);
#pragma unroll
      for (int ks = 0; ks < 4; ++ks) bq = MFMA16(ld_frag(Cm + (16 * w + l15) * 136 + ks * 32 + g4 * 8), frag_from_f32(St + (16 * ns + l15) * 128 + ks * 32 + g4 * 8, 1.f), bq);
#pragma unroll
      for (int j = 0; j < 4; ++j) ys[ns][j] += a[j] + __expf(ci[j]) * bq[j];
    }
  }
  bf16_t* Y = (bf16_t*)(p.ws + OFF_HY); float* SSQ = (float*)(p.ws + OFF_SSQ);
  const float dsk = p.ssd_d[l * 4 + h];
#pragma unroll
  for (int j = 0; j < 4; ++j) {
    const int i = 16 * w + 4 * g4 + j, row = row0 + i; float ss = 0.f;
#pragma unroll
    for (int ns = 0; ns < 4; ++ns) {
      const int pp = 16 * ns + l15;
      const float xv = bf2f(Xt[pp * 72 + i]);
      const float z = bf2f(P[(size_t)row * PINP + C_Z + h * 64 + pp]);
      const float g = (ys[ns][j] + dsk * xv) * silu_f(z);
      ss += g * g; Y[(size_t)row * 1024 + 512 + h * 64 + pp] = f2bf(g);
    }
    ss = red16_sum(ss);
    if (l15 == 0) SSQ[(size_t)h * NROW + row] = ss;
  }
  __syncthreads();
}

struct S5Par { float are, aim, bre[16], bim[16]; };
DI void s5_params(const Params& p, int l, int dir, int g, int n, S5Par& q, float& dtv, float& lre, float& lim) {
  const int ai = ((l * 2 + dir) * 16 + g) * 64 + n;
  lre = fminf(p.s5_a_re[ai], -1e-4f); lim = p.s5_a_im[ai];
  dtv = __expf(p.s5_log_dt[(l * 2 + dir) * 16 + g]);
  const float mag = __expf(lre * dtv), ang = lim * dtv;
  q.are = mag * cosf(ang); q.aim = mag * sinf(ang);
  const float den = lre * lre + lim * lim;
  const float fre = ((q.are - 1.f) * lre + q.aim * lim) / den, fim = (q.aim * lre - (q.are - 1.f) * lim) / den;
  const float* br = p.s5_b_re + ((size_t)(l * 16 + g) * 64 + n) * 16; const float* bi = p.s5_b_im + ((size_t)(l * 16 + g) * 64 + n) * 16;
#pragma unroll
  for (int j = 0; j < 16; ++j) { q.bre[j] = fre * br[j] - fim * bi[j]; q.bim[j] = fre * bi[j] + fim * br[j]; }
}
DI void s5_step(const S5Par& q, const bf16_t* us, int s, float& xr, float& xi) {
  const u32x4 a0 = *(const u32x4*)(us + s * 16), a1 = *(const u32x4*)(us + s * 16 + 8);
  const unsigned uw[8] = {a0.x, a0.y, a0.z, a0.w, a1.x, a1.y, a1.z, a1.w};
  float br = 0.f, bi = 0.f;
#pragma unroll
  for (int j = 0; j < 8; ++j) { const float a = bflo(uw[j]), c = bfhi(uw[j]); br += q.bre[2 * j] * a + q.bre[2 * j + 1] * c; bi += q.bim[2 * j] * a + q.bim[2 * j + 1] * c; }
  const float nr = q.are * xr - q.aim * xi + br, ni = q.are * xi + q.aim * xr + bi;
  xr = nr; xi = ni;
}
DI void s5_p1(const Params& p, int l, int item, char* smem) {
  const int lane = ltid() & 63, wi = item * 4 + __builtin_amdgcn_readfirstlane(ltid() >> 6);
  const int tcg = wi % NCH; int r = wi / NCH; const int dir = r & 1; r >>= 1; const int g = r & 15, b = r >> 4;
  int part, tc, row0; chunk_geom(tcg, b, part, tc, row0);
  const int c = chain_slot(dir, part, tc);
  S5Par q; float dtv, lre, lim; s5_params(p, l, dir, g, lane, q, dtv, lre, lim);
  const bf16_t* up = (const bf16_t*)(p.ws + OFF_P) + (size_t)(row0 + lane) * PINP + C_S5 + g * 16;
  bf16_t* us = (bf16_t*)smem + __builtin_amdgcn_readfirstlane(ltid() >> 6) * 1024;
  *(u32x4*)(us + lane * 16) = *(const u32x4*)up; *(u32x4*)(us + lane * 16 + 8) = *(const u32x4*)(up + 8);
  float xr = 0.f, xi = 0.f;
  for (int st = 0; st < 64; ++st) { const int s = dir ? 63 - st : st; s5_step(q, us, s, xr, xi); }
  float* S = (float*)(p.ws + OFF_S5S) + ((size_t)((b * 16 + g) * 2 + dir) * NCH + c) * 128;
  S[lane] = xr; S[64 + lane] = xi;
}
DI void s5_p2(const Params& p, int l, int item) {
  const int gi = item * 256 + ltid(), n = gi & 63, dir = (gi >> 6) & 1, g = (gi >> 7) & 15, b = gi >> 11;
  const int ai = ((l * 2 + dir) * 16 + g) * 64 + n;
  const float lre = fminf(p.s5_a_re[ai], -1e-4f), lim = p.s5_a_im[ai], dtv = __expf(p.s5_log_dt[(l * 2 + dir) * 16 + g]);
  const float mag = __expf(64.f * lre * dtv), ang = 64.f * (lim * dtv);
  const float ar = mag * cosf(ang), aim = mag * sinf(ang);
  float* S = (float*)(p.ws + OFF_S5S) + (size_t)((b * 16 + g) * 2 + dir) * NCH * 128 + n;
  float xr = 0.f, xi = 0.f;
  for (int c0 = 0; c0 < NCH; c0 += 12) {
    float dr[12], di[12];
#pragma unroll
    for (int i = 0; i < 12; ++i) { dr[i] = S[(c0 + i) * 128]; di[i] = S[(c0 + i) * 128 + 64]; }
#pragma unroll
    for (int i = 0; i < 12; ++i) { S[(c0 + i) * 128] = xr; S[(c0 + i) * 128 + 64] = xi; const float nr = ar * xr - aim * xi + dr[i], ni = ar * xi + aim * xr + di[i]; xr = nr; xi = ni; }
  }
}
DI void s5_p3(const Params& p, int l, int item, char* smem) {
  const int tid = ltid(), lane = tid & 63, w = __builtin_amdgcn_readfirstlane(tid >> 6), l15 = lane & 15, g4 = lane >> 4;
  const int half = item & 1; const int r2 = item >> 1; const int tcg = r2 % NCH, b = r2 / NCH;
  int part, tc, row0; chunk_geom(tcg, b, part, tc, row0);
  bf16_t* xs = (bf16_t*)smem + w * (16 * 136);
  bf16_t* YG = (bf16_t*)(p.ws + OFF_YG);
  const bf16_t* P = (const bf16_t*)(p.ws + OFF_P);
#pragma unroll 1
  for (int gi = 0; gi < 2; ++gi) {
    const int g = half * 8 + w + 4 * gi;
    const bf16_t* up = P + (size_t)(row0 + lane) * PINP + C_S5 + g * 16;
    bf16_t* us = (bf16_t*)smem + 25600 + w * 1024;
    *(u32x4*)(us + lane * 16) = *(const u32x4*)up; *(u32x4*)(us + lane * 16 + 8) = *(const u32x4*)(up + 8);
    f32x4 yt[4];
#pragma unroll
    for (int ib = 0; ib < 4; ++ib) yt[ib] = (f32x4){0.f, 0.f, 0.f, 0.f};
#pragma unroll
    for (int dir = 0; dir < 2; ++dir) {
      S5Par q; float dtv, lre, lim; s5_params(p, l, dir, g, lane, q, dtv, lre, lim);
      const int c = chain_slot(dir, part, tc);
      const float* S = (const float*)(p.ws + OFF_S5S) + ((size_t)((b * 16 + g) * 2 + dir) * NCH + c) * 128;
      float xr = S[lane], xi = S[64 + lane];
      bf16x8 cf[4];
#pragma unroll
      for (int ks = 0; ks < 4; ++ks) {
        const int k = ks * 32 + g4 * 8;
        const float* src = (k < 64 ? p.s5_c_re : p.s5_c_im) + ((size_t)(l * 16 + g) * 16 + l15) * 64 + (k & 63);
        cf[ks] = frag_from_f32(src, k < 64 ? 1.f : -1.f);
      }
#pragma unroll
      for (int blk = 0; blk < 4; ++blk) {
        asm volatile("s_waitcnt lgkmcnt(0)" ::: "memory");
#pragma unroll 4
        for (int st = 0; st < 16; ++st) {
          const int step = blk * 16 + st, s = dir ? 63 - step : step;
          s5_step(q, us, s, xr, xi);
          xs[(s & 15) * 136 + lane] = f2bf(xr); xs[(s & 15) * 136 + 64 + lane] = f2bf(xi);
        }
        asm volatile("s_waitcnt lgkmcnt(0)" ::: "memory");
        f32x4 a = {0.f, 0.f, 0.f, 0.f};
#pragma unroll
        for (int ks = 0; ks < 4; ++ks) a = MFMA16(ld_frag(xs + l15 * 136 + ks * 32 + g4 * 8), cf[ks], a);
        const int ib = dir ? 3 - blk : blk;
        yt[ib] += a;
      }
    }
#pragma unroll
    for (int ib = 0; ib < 4; ++ib)
#pragma unroll
      for (int j = 0; j < 4; ++j) {
        const int tok = 16 * ib + 4 * g4 + j, ch = g * 16 + l15;
        const float u = bf2f(P[(size_t)(row0 + tok) * PINP + C_S5 + ch]);
        YG[(size_t)(row0 + tok) * 256 + ch] = f2bf(gelu_tanh_f(yt[ib][j] + p.s5_d[l * 256 + ch] * u));
      }
  }
  __syncthreads();
}
DI void glu_item(const Params& p, int l, int item, char* smem) {
  const int mt = item >> 1, nt = item & 1;
  const bf16_t* YG = (const bf16_t*)(p.ws + OFF_YG); bf16_t* Y = (bf16_t*)(p.ws + OFF_HY);
  gemm_tile<0, 0>(YG, 256, (const bf16_t*)(p.ws + OFF_WGLU) + (size_t)l * 256 * 256, 256, 256, mt * 128, nt * 128, smem, nullptr,
                  [&](int row, int col, f32x4 v) {
                    const u32x2 yv = *(const u32x2*)(YG + (size_t)row * 256 + col);
                    f32x4 o; o[0] = bflo(yv.x) * sigm_f(v[0]); o[1] = bfhi(yv.x) * sigm_f(v[1]); o[2] = bflo(yv.y) * sigm_f(v[2]); o[3] = bfhi(yv.y) * sigm_f(v[3]);
                    store_bf4(Y + (size_t)row * 1024 + 768 + col, o);
                  });
}

DI void outproj_item(const Params& p, int l, int item, char* smem) {
  const int mt = item >> 3, nt = item & 7;
  const float* MOD = (const float*)(p.ws + OFF_MOD);
  gemm_tile<1, 2>((const bf16_t*)(p.ws + OFF_HY), 1024, (const bf16_t*)(p.ws + OFF_WOUT) + (size_t)l * 1024 * 1024, 1024, 1024, mt * 128, nt * 128, smem, (const float*)(p.ws + OFF_SSQ),
               [&](int row, int col, f32x4 v) {
                 const int s = row < NLAT ? row / T : 2;
                 const f32x4 gt = *(const f32x4*)(MOD + (size_t)(l * 3 + s) * 6144 + 2048 + col);
                 float* xp = row < NLAT ? p.xb + (size_t)row * 1024 + col : (float*)(p.ws + OFF_CTX) + (size_t)(row - NLAT) * 1024 + col;
                 *(f32x4*)xp = *(f32x4*)xp + gt * v;
               });
}
DI void ffnup_item(const Params& p, int l, int item, char* smem) {
  const int mtile = item / 44, nt = item % 44;
  int seq0, slen, ti;
  if (mtile < 132) { seq0 = (mtile / 66) * T; slen = T; ti = mtile % 66; }
  else { const int j = mtile - 132; seq0 = NLAT + (j / 3) * TC; slen = TC; ti = j % 3; }
  const int m0 = seq0 + 126 * ti - 1, n0 = nt * 128;
  bf16_t* ACT = (bf16_t*)(p.ws + OFF_R);
  bf16_t* Ts = (bf16_t*)smem;
  auto epi = [&](int row, int col, f32x4 v) {
    const int lr = row - m0, c = col - n0, t = 126 * ti - 1 + lr;
    if (c >= 64 && (t < 0 || t >= slen)) v = (f32x4){0.f, 0.f, 0.f, 0.f};
    store_bf4(Ts + lr * 136 + c, v);
  };
  gemm_tile<0, 0, decltype(epi), 1>((const bf16_t*)(p.ws + OFF_HY), 1024, (const bf16_t*)(p.ws + OFF_WUP) + (size_t)l * 5632 * 1024, 1024, 1024, m0, n0, smem, nullptr, epi, seq0, seq0 + slen - 1);
  __syncthreads();
  {
    const int tid = ltid();
    const float* cw = p.ffn_conv_w + (size_t)l * 3 * DFF + nt * 64;
#pragma unroll
    for (int q = 0; q < 4; ++q) {
      const int id = tid + 256 * q, lr = 1 + (id >> 3), c8 = (id & 7) * 8, t = 126 * ti - 1 + lr;
      if (id < 1008 && t < slen) {
        const u32x4 uu = *(const u32x4*)(Ts + lr * 136 + c8), gm = *(const u32x4*)(Ts + (lr - 1) * 136 + 64 + c8), g0 = *(const u32x4*)(Ts + lr * 136 + 64 + c8), gn = *(const u32x4*)(Ts + (lr + 1) * 136 + 64 + c8);
        const float uf[8] = {bflo(uu.x), bfhi(uu.x), bflo(uu.y), bfhi(uu.y), bflo(uu.z), bfhi(uu.z), bflo(uu.w), bfhi(uu.w)};
        const float a[8] = {bflo(gm.x), bfhi(gm.x), bflo(gm.y), bfhi(gm.y), bflo(gm.z), bfhi(gm.z), bflo(gm.w), bfhi(gm.w)};
        const float m[8] = {bflo(g0.x), bfhi(g0.x), bflo(g0.y), bfhi(g0.y), bflo(g0.z), bfhi(g0.z), bflo(g0.w), bfhi(g0.w)};
        const float n[8] = {bflo(gn.x), bfhi(gn.x), bflo(gn.y), bfhi(gn.y), bflo(gn.z), bfhi(gn.z), bflo(gn.w), bfhi(gn.w)};
        float o[8];
#pragma unroll
        for (int j = 0; j < 8; ++j) o[j] = silu_f(cw[c8 + j] * a[j] + cw[DFF + c8 + j] * m[j] + cw[2 * DFF + c8 + j] * n[j]) * uf[j];
        u32x4 ov; ov.x = pack2(o[0], o[1]); ov.y = pack2(o[2], o[3]); ov.z = pack2(o[4], o[5]); ov.w = pack2(o[6], o[7]);
        *(u32x4*)(ACT + (size_t)(seq0 + t) * DFF + nt * 64 + c8) = ov;
      }
    }
  }
  __syncthreads();
}
DI void ffndown_item(const Params& p, int l, int item, char* smem) {
  const int mt = item >> 3, nt = item & 7;
  const float* MOD = (const float*)(p.ws + OFF_MOD);
  gemm_tile<0, 2>((const bf16_t*)(p.ws + OFF_R), DFF, (const bf16_t*)(p.ws + OFF_WDN) + (size_t)l * 1024 * 2816, 2816, 2816, mt * 128, nt * 128, smem, nullptr,
               [&](int row, int col, f32x4 v) {
                 const int s = row < NLAT ? row / T : 2;
                 const f32x4 gt = *(const f32x4*)(MOD + (size_t)(l * 3 + s) * 6144 + 5120 + col);
                 float* xp = row < NLAT ? p.xb + (size_t)row * 1024 + col : (float*)(p.ws + OFF_CTX) + (size_t)(row - NLAT) * 1024 + col;
                 *(f32x4*)xp = *(f32x4*)xp + gt * v;
               });
}
DI void final_item(const Params& p, int item) {
  const int lane = ltid() & 63, w = __builtin_amdgcn_readfirstlane(ltid() >> 6), row = item * 4 + w;
  float* x = p.xb + (size_t)row * 1024;
  float4 v[4]; float ss = 0.f;
#pragma unroll
  for (int i = 0; i < 4; ++i) { v[i] = *(const float4*)(x + (i * 64 + lane) * 4); ss += v[i].x * v[i].x + v[i].y * v[i].y + v[i].z * v[i].z + v[i].w * v[i].w; }
  ss = wave_sum(ss);
  const float rstd = rsqrtf(ss * (1.f / 1024.f) + 1e-6f);
#pragma unroll
  for (int i = 0; i < 4; ++i) {
    const int k = (i * 64 + lane) * 4; const float4 g = *(const float4*)(p.final_norm + k);
    float4 o; o.x = v[i].x * rstd * g.x; o.y = v[i].y * rstd * g.y; o.z = v[i].z * rstd * g.z; o.w = v[i].w * rstd * g.w;
    *(float4*)(x + k) = o;
  }
}

constexpr int PPL = 10;
constexpr int N_PHASES = 2 + NL * PPL;
#define FOR_ITEMS(n) for (int it = blockIdx.x; it < (n); it += gridDim.x)

DI void run_phase(const Params& p, int ph, char* smem) {
  if (ph == 0) {
    FOR_ITEMS(P0_MOD) p0_item(p, it, smem);
    p0_transposes(p, smem);
    for (int it = P0_MOD + P0_TR + blockIdx.x; it < P0_ITEMS; it += gridDim.x) p0_item(p, it, smem);
    return;
  }
  if (ph == N_PHASES - 1) { FOR_ITEMS(NLAT / 4) final_item(p, it); return; }
  const int l = (ph - 1) / PPL, k = (ph - 1) % PPL;
  const int mtiles = (l == NL - 1) ? 128 : 132;
  switch (k) {
    case 0: FOR_ITEMS(NROW / 4) norm_item(p, l, 0, it); break;
    case 1: FOR_ITEMS(138 * 22) gemm_in_item(p, l, it, smem); break;
    case 2: FOR_ITEMS(2112) s5_p1(p, l, it, smem); break;
    case 3: {
      constexpr int n0 = 2112, n1 = n0 + 2112, n2 = n1 + 528, n3 = n2 + 396, n5 = n3 + 66;
      FOR_ITEMS(n5 + 16) {
        if (it < n0) ssd_p1(p, l, it, smem);
        else if (it < n1) mlstm_p1(p, l, it - n0, smem);
        else if (it < n2) kvproj_item(p, l, it - n1, smem);
        else if (it < n3) qproj_item(p, l, it - n2, smem);
        else if (it < n5) ropek_item(p, it - n3);
        else s5_p2(p, l, it - n5);
      }
    } break;
    case 4: {
      constexpr int n0 = 528, n1 = n0 + 512, n2 = n1 + 260;
      FOR_ITEMS(n2) { if (it < n0) s5_p3(p, l, it, smem); else if (it < n1) ssd_p2(p, it - n0); else mlstm_p2(p, it - n1); }
    } break;
    case 5: {
      constexpr int n0 = 528, n2 = n0 + 1056, n3x = n2 + 1056, n3 = n3x + 264;
      const bool late = blockIdx.x >= (gridDim.x >> 1);
      if (!late) { FOR_ITEMS(n0) attn_item(p, it, smem); }
      FOR_ITEMS(n3) {
        if (it < n0) continue;
        if (it < n2) ssd_p3(p, l, it - n0, smem);
        else if (it < n3x) mlstm_p3(p, l, it - n2, smem);
        else glu_item(p, l, it - n3x, smem);
      }
      if (late) { FOR_ITEMS(n0) attn_item(p, it, smem); }
    } break;
    case 6: FOR_ITEMS(mtiles * 8) outproj_item(p, l, it, smem); break;
    case 7: FOR_ITEMS(mtiles * 32) norm_item(p, l, 1, it); break;
    case 8: FOR_ITEMS(((l == NL - 1) ? 132 : 138) * 44) ffnup_item(p, l, it, smem); break;
    case 9: FOR_ITEMS(mtiles * 8) ffndown_item(p, l, it, smem); break;
  }
}

#ifndef HASH_LO
#define HASH_LO OFF_MOD
#define HASH_HI WS_NEED
#endif
#ifndef PROBE_N
#define PROBE_N 0
#endif
DI void hash_dump(const Params& p) {
  const size_t NOUT = (size_t)NLAT * 1024, nw = (HASH_HI - HASH_LO) / 4;
  const unsigned* wsw = (const unsigned*)(p.ws + HASH_LO);
  for (size_t i = (size_t)blockIdx.x * 256 + threadIdx.x; i < NOUT; i += (size_t)gridDim.x * 256) {
    unsigned h = 12345u;
    for (size_t j = i; j < nw; j += NOUT) h = h * 1664525u + wsw[j];
    p.xb[i] = (float)(h & 0xFFFFFFu);
  }
}

#define XB_TMO      128
#define XB_XCNT(j)  (256  + 64 * (j))
#define XB_XSUB(j)  (1280 + 64 * (j))
#define XB_XGEN(j)  (2304 + 64 * (j))
#define XB_TOP      3328
#define XB_TOPGEN   3392
#define XCD_BAR_WORDS 3456
#define XB_SPIN_CAP (1u << 22)
#define LAS __attribute__((address_space(3)))
DI unsigned xb_ld(unsigned* p) { return __hip_atomic_load(p, __ATOMIC_RELAXED, __HIP_MEMORY_SCOPE_AGENT); }
DI unsigned xb_add(unsigned* p, unsigned v) { return __hip_atomic_fetch_add(p, v, __ATOMIC_RELAXED, __HIP_MEMORY_SCOPE_AGENT); }
DI unsigned xb_xcc_id() { return (unsigned)__builtin_amdgcn_s_getreg((3 << 11) | 20) & 0xFu; }
#define XB_SPIN(cond, bar) do { unsigned _sp = 0; while (cond) { __builtin_amdgcn_s_sleep(1); \
    if ((++_sp & 255u) == 0u) { if (xb_ld(&(bar)[XB_TMO])) break; if (_sp > XB_SPIN_CAP) { atomicAdd(&(bar)[XB_TMO], 1u); break; } } } } while (0)
struct XcdBarrier { unsigned* bar; unsigned x; volatile LAS unsigned* st; };
DI XcdBarrier xcd_barrier_post(unsigned* bar, volatile LAS unsigned* st) {
  XcdBarrier b; b.bar = bar; b.x = xb_xcc_id(); b.st = st;
  if (threadIdx.x == 0) (void)xb_add(&bar[XB_XCNT(b.x)], 1u);
  return b;
}
DI void xcd_barrier_complete(unsigned* bar, unsigned x, unsigned& nloc, unsigned& nx) {
  const unsigned G = gridDim.x;
  unsigned sum, cnt, mine, sp = 0u;
  for (;;) {
    sum = 0u; cnt = 0u; mine = 0u;
#pragma unroll
    for (unsigned j = 0; j < 16; ++j) { const unsigned c = xb_ld(&bar[XB_XCNT(j)]); sum += c; cnt += (c > 0u) ? 1u : 0u; mine = (j == x) ? c : mine; }
    if (sum == G) break;
    __builtin_amdgcn_s_sleep(1);
    if ((++sp & 255u) == 0u) { if (xb_ld(&bar[XB_TMO])) break; if (sp > XB_SPIN_CAP) { atomicAdd(&bar[XB_TMO], 1u); break; } }
  }
  nloc = mine > 0u ? mine : 1u; nx = cnt > 0u ? cnt : 1u;
}
DI void xcd_barrier(const XcdBarrier& b) {
  asm volatile("s_waitcnt vmcnt(0)" ::: "memory");
  __syncthreads();
  if (threadIdx.x == 0) {
    unsigned* bar = b.bar;
    __builtin_amdgcn_s_waitcnt(0);
    unsigned nloc = b.st[0], nx = b.st[1];
    if (nloc == 0u) { xcd_barrier_complete(bar, b.x, nloc, nx); b.st[0] = nloc; b.st[1] = nx; }
    const unsigned old = xb_add(&bar[XB_XSUB(b.x)], 1u);
    const unsigned gen = old / nloc;
    if (old + 1u == (gen + 1u) * nloc) {
      __builtin_amdgcn_fence(__ATOMIC_RELEASE, "agent");
      asm volatile("s_waitcnt vmcnt(0)" ::: "memory");
      const unsigned og = xb_add(&bar[XB_TOP], 1u);
      const unsigned tg = og / nx;
      if (og + 1u == (tg + 1u) * nx) xb_add(&bar[XB_TOPGEN], 1u);
      else XB_SPIN(xb_ld(&bar[XB_TOPGEN]) == tg, bar);
      __builtin_amdgcn_fence(__ATOMIC_ACQUIRE, "agent");
      xb_add(&bar[XB_XGEN(b.x)], 1u);
      asm volatile("s_waitcnt vmcnt(0)" ::: "memory");
    } else {
      XB_SPIN(xb_ld(&bar[XB_XGEN(b.x)]) == gen, bar);
      __builtin_amdgcn_fence(__ATOMIC_ACQUIRE, "agent");
      asm volatile("s_waitcnt vmcnt(0)" ::: "memory");
    }
  }
  __syncthreads();
}
constexpr int SMEM_BYTES = 59392;
__global__ void __launch_bounds__(256, 2) trunk_fwd(Params p) {
  __shared__ __attribute__((aligned(16))) char smem[SMEM_BYTES];
  __shared__ uint4 xb_words;
  cg::grid_group grid = cg::this_grid();
  if (threadIdx.x == 0) xb_words = make_uint4(0u, 0u, 0u, 0u);
  __syncthreads();
  XcdBarrier xb = xcd_barrier_post((unsigned*)(p.ws + OFF_BAR), (volatile LAS unsigned*)&xb_words);
  for (int ph = p.ph_lo; ph < p.ph_hi; ++ph) {
    run_phase(p, ph, smem);
    if (ph + 1 < p.ph_hi) { if (ph == p.ph_lo) grid.sync(); else xcd_barrier(xb); }
  }
}

__global__ void __launch_bounds__(256) hash_kernel(Params p) { hash_dump(p); }

extern "C" void kernel_launch(void* const* d_in, const int* in_sizes, int n_in, void* d_out, int out_size, void* d_ws, size_t ws_size, hipStream_t stream) {
  static int grid_blocks = 0;
  if (!grid_blocks) {
    int dev = 0, cus = 0, per_cu = 0;
    hipGetDevice(&dev);
    hipDeviceGetAttribute(&cus, hipDeviceAttributeMultiprocessorCount, dev);
    hipOccupancyMaxActiveBlocksPerMultiprocessor(&per_cu, trunk_fwd, 256, 0);
    if (per_cu > 2) per_cu = 2;
    grid_blocks = cus * per_cu;
  }
  if (ws_size < OFF_BAR + XCD_BAR_WORDS * 4) { fprintf(stderr, "workspace too small: %zu < %zu\n", ws_size, (size_t)WS_NEED); return; }
  Params p{};
  const float** fp = (const float**)&p;
  for (int i = 0; i < 35; ++i) fp[i] = (const float*)d_in[i];
  p.xb = (float*)d_out; p.ws = (char*)d_ws;
#if MULTI_LAUNCH
#if PROBE_N
  for (int ph = 0; ph < PROBE_N; ++ph) { p.ph_lo = ph; p.ph_hi = ph + 1; hipLaunchKernelGGL(trunk_fwd, dim3(grid_blocks), dim3(256), 0, stream, p); }
  hipLaunchKernelGGL(hash_kernel, dim3(grid_blocks), dim3(256), 0, stream, p);
#else
  for (int ph = 0; ph < N_PHASES; ++ph) { p.ph_lo = ph; p.ph_hi = ph + 1; hipLaunchKernelGGL(trunk_fwd, dim3(grid_blocks), dim3(256), 0, stream, p); }
#endif
#else
  p.ph_lo = 0; p.ph_hi = N_PHASES;
  hipMemsetAsync((char*)d_ws + OFF_BAR, 0, XCD_BAR_WORDS * 4, stream);
  void* args[] = {&p};
  hipError_t e = hipLaunchCooperativeKernel((void*)trunk_fwd, dim3(grid_blocks), dim3(256), args, 0, stream);
  if (e != hipSuccess) fprintf(stderr, "cooperative launch failed: %s (grid %d)\n", hipGetErrorString(e), grid_blocks);
#endif
}
```

```cpp
#include <hip/hip_runtime.h>
#include <hip/hip_cooperative_groups.h>
#include <cstdio>
#include <cstdint>
namespace cg = cooperative_groups;

#ifndef PROBE_MASK
#define PROBE_MASK 63
#endif
#ifndef ZERO_FILL
#define ZERO_FILL 0
#endif
#ifndef MULTI_LAUNCH
#define MULTI_LAUNCH 0
#endif

typedef unsigned short bf16_t;
typedef short bf16x8 __attribute__((ext_vector_type(8)));
typedef float f32x4 __attribute__((ext_vector_type(4)));
typedef unsigned u32x4 __attribute__((ext_vector_type(4)));
typedef unsigned u32x2 __attribute__((ext_vector_type(2)));
#define DI __device__ __forceinline__
#define MFMA16(a, b, c) __builtin_amdgcn_mfma_f32_16x16x32_bf16((a), (b), (c), 0, 0, 0)

constexpr int NB = 2, T = 8192, TC = 256, NL = 4;
constexpr int NLAT = NB * T, NROW = NLAT + NB * TC;
constexpr int TALL = T + TC;
constexpr int PINP = 2816;
constexpr int C_MLQ = 0, C_MLK = 256, C_MLV = 512, C_MLO = 768, C_CQ = 1040, C_CKV = 1296, C_KR = 1424,
              C_Z = 1456, C_XBC = 1712, C_S5 = 2488;
constexpr int NCH = 132;
constexpr int DFF = 2816;

constexpr size_t SZ_WIN = (size_t)NL * 2816 * 1024 * 2, SZ_WUQ = (size_t)NL * 384 * 256 * 2, SZ_WUKV = (size_t)NL * 512 * 128 * 2,
                 SZ_WGLU = (size_t)NL * 256 * 256 * 2, SZ_WOUT = (size_t)NL * 1024 * 1024 * 2, SZ_WUP = (size_t)NL * 5632 * 1024 * 2,
                 SZ_WDN = (size_t)NL * 1024 * 2816 * 2, SZ_MOD = (size_t)NL * 3 * 6144 * 4, SZ_CTX = (size_t)512 * 1024 * 4,
                 SZ_HY = (size_t)NROW * 1024 * 2, SZ_GML = (size_t)NROW * 16 * 4, SZ_DTR = (size_t)NROW * 8 * 4, SZ_SSQ = (size_t)NROW * 4 * 4,
                 SZ_QRAW = (size_t)NROW * 384 * 2, SZ_KH = (size_t)NB * 4 * TALL * 64 * 2 + (size_t)NB * TALL * 32 * 2, SZ_VT = (size_t)NB * 4 * 64 * TALL * 2,
                 SZ_S5S = (size_t)NB * 16 * 2 * NCH * 128 * 4, SZ_MLM = (size_t)16 * NCH * 32 * 4, SZ_SSA = (size_t)16 * NCH * 32 * 4,
                 SZ_P = (size_t)NROW * PINP * 2, SZ_MLS = (size_t)16 * NCH * 4160 * 4, SZ_SSDS = (size_t)16 * NCH * 8192 * 4;
constexpr size_t OFF_WIN = 0, OFF_WUQ = OFF_WIN + SZ_WIN, OFF_WUKV = OFF_WUQ + SZ_WUQ, OFF_WGLU = OFF_WUKV + SZ_WUKV,
                 OFF_WOUT = OFF_WGLU + SZ_WGLU, OFF_WUP = OFF_WOUT + SZ_WOUT, OFF_WDN = OFF_WUP + SZ_WUP, OFF_MOD = OFF_WDN + SZ_WDN,
                 OFF_CTX = OFF_MOD + SZ_MOD, OFF_HY = OFF_CTX + SZ_CTX, OFF_GML = OFF_HY + SZ_HY, OFF_DTR = OFF_GML + SZ_GML,
                 OFF_SSQ = OFF_DTR + SZ_DTR, OFF_QRAW = OFF_SSQ + SZ_SSQ, OFF_KH = OFF_QRAW + SZ_QRAW, OFF_VT = OFF_KH + SZ_KH,
                 OFF_S5S = OFF_VT + SZ_VT, OFF_MLM = OFF_S5S + SZ_S5S, OFF_SSA = OFF_MLM + SZ_MLM,
                 OFF_R = ((OFF_SSA + SZ_SSA + 255) / 256) * 256, OFF_P = OFF_R, OFF_MLS = OFF_P + SZ_P, OFF_SSDS = OFF_MLS + SZ_MLS,
                 WS_NEED = OFF_SSDS + SZ_SSDS;
static_assert((size_t)NROW * 5632 * 2 <= SZ_P + SZ_MLS + SZ_SSDS, "UG overlay");

constexpr size_t OFF_KR = OFF_KH + (size_t)NB * 4 * TALL * 64 * 2;
constexpr size_t OFF_YG = ((WS_NEED + 255) / 256) * 256;
constexpr size_t OFF_BAR = OFF_YG + (size_t)NROW * 256 * 2;
struct Params {
  const float *x, *c, *ctx, *c_ctx, *w_mod, *b_mod, *norm1, *norm2, *w_in, *ml_gate_bias, *ml_norm, *mla_q_norm, *mla_kv_norm,
      *mla_w_uq, *mla_w_ukv, *ssd_conv_w, *ssd_conv_b, *ssd_a_log, *ssd_dt_bias, *ssd_d, *ssd_norm, *s5_a_re, *s5_a_im, *s5_log_dt,
      *s5_b_re, *s5_b_im, *s5_c_re, *s5_c_im, *s5_d, *s5_w_glu, *w_out, *ffn_w_up, *ffn_conv_w, *ffn_w_down, *final_norm;
  float* xb;
  char* ws;
  int ph_lo, ph_hi;
};

typedef __bf16 hbf16x2 __attribute__((ext_vector_type(2)));
typedef float f32x2 __attribute__((ext_vector_type(2)));
DI bf16_t f2bf(float x) { return __builtin_bit_cast(bf16_t, (__bf16)x); }
DI float bf2f(bf16_t v) { return __uint_as_float(((unsigned)v) << 16); }
DI unsigned pack2(float lo, float hi) { f32x2 v = {lo, hi}; return __builtin_bit_cast(unsigned, __builtin_convertvector(v, hbf16x2)); }
DI float bflo(unsigned w) { return __uint_as_float(w << 16); }
DI float bfhi(unsigned w) { return __uint_as_float(w & 0xffff0000u); }
DI float silu_f(float x) { return x / (1.f + __expf(-x)); }
DI float sigm_f(float x) { return 1.f / (1.f + __expf(-x)); }
DI float softplus_f(float x) { return fmaxf(x, 0.f) + log1pf(__expf(-fabsf(x))); }
DI float logsigm_f(float x) { return fminf(x, 0.f) - log1pf(__expf(-fabsf(x))); }
DI float gelu_tanh_f(float x) { float u = 0.7978845608f * (x + 0.044715f * x * x * x); return x * sigm_f(2.f * u); }
DI float wave_sum(float v) { for (int o = 32; o; o >>= 1) v += __shfl_xor(v, o); return v; }
DI float wave_max(float v) { for (int o = 32; o; o >>= 1) v = fmaxf(v, __shfl_xor(v, o)); return v; }
DI float wave_incl_scan(float v, int lane) { for (int o = 1; o < 64; o <<= 1) { float t = __shfl_up(v, o); if (lane >= o) v += t; } return v; }
DI float red16_max(float v) { v = fmaxf(v, __shfl_xor(v, 1)); v = fmaxf(v, __shfl_xor(v, 2)); v = fmaxf(v, __shfl_xor(v, 4)); v = fmaxf(v, __shfl_xor(v, 8)); return v; }
DI float red16_sum(float v) { v += __shfl_xor(v, 1); v += __shfl_xor(v, 2); v += __shfl_xor(v, 4); v += __shfl_xor(v, 8); return v; }
DI bf16x8 ld_frag(const bf16_t* p) { return *(const bf16x8*)p; }
DI bf16x8 mk_frag(unsigned a, unsigned b, unsigned c, unsigned d) { u32x4 u = {a, b, c, d}; return __builtin_bit_cast(bf16x8, u); }
DI bf16x8 frag_from_f32(const float* p, float sgn) {
  float4 a = *(const float4*)p, b = *(const float4*)(p + 4);
  return mk_frag(pack2(a.x * sgn, a.y * sgn), pack2(a.z * sgn, a.w * sgn), pack2(b.x * sgn, b.y * sgn), pack2(b.z * sgn, b.w * sgn));
}
DI int ltid() { int t = threadIdx.x; asm volatile("" : "+v"(t)); return t; }
DI int row_of(int b, int part, int t) { return part ? NLAT + b * TC + t : b * T + t; }

DI void tr_tile(const float* __restrict__ src, int K, int N, bf16_t* __restrict__ dst, const float* gain, int glo, int ghi, int tk, int tn, float* tile, int drow0 = -1) {
  const int tid = ltid(), c4 = tid & 15, rq = tid >> 4;
  const bool vec = (N & 3) == 0;
#pragma unroll
  for (int rr = 0; rr < 4; ++rr) {
    const int r = rr * 16 + rq, k = tk * 64 + r, n = tn * 64 + c4 * 4;
    float4 v;
    if (vec && n + 3 < N) v = *(const float4*)(src + (size_t)k * N + n);
    else { v.x = n < N ? src[(size_t)k * N + n] : 0.f; v.y = n + 1 < N ? src[(size_t)k * N + n + 1] : 0.f; v.z = n + 2 < N ? src[(size_t)k * N + n + 2] : 0.f; v.w = n + 3 < N ? src[(size_t)k * N + n + 3] : 0.f; }
    if (gain && k >= glo && k < ghi) { const float g = gain[k - glo]; v.x *= g; v.y *= g; v.z *= g; v.w *= g; }
    *(float4*)(tile + r * 68 + c4 * 4) = v;
  }
  __syncthreads();
#pragma unroll
  for (int q = 0; q < 2; ++q) {
    const int id = tid + 256 * q, n = id >> 3, k0 = (id & 7) * 8;
    u32x4 o;
    o.x = pack2(tile[(k0 + 0) * 68 + n], tile[(k0 + 1) * 68 + n]); o.y = pack2(tile[(k0 + 2) * 68 + n], tile[(k0 + 3) * 68 + n]);
    o.z = pack2(tile[(k0 + 4) * 68 + n], tile[(k0 + 5) * 68 + n]); o.w = pack2(tile[(k0 + 6) * 68 + n], tile[(k0 + 7) * 68 + n]);
    *(u32x4*)(dst + (size_t)((drow0 >= 0 ? drow0 : tn * 64) + n) * K + tk * 64 + k0) = o;
  }
  __syncthreads();
}

constexpr int TR_PER_LAYER = 3128, P0_TR = NL * TR_PER_LAYER, P0_MOD = NL * 96, P0_CPX = NLAT * 1024 / 4096, P0_CPC = 512 * 1024 / 4096;
constexpr int P0_ZERO = (int)((WS_NEED - OFF_HY + 65535) / 65536);
constexpr int P0_ITEMS = P0_TR + P0_MOD + P0_CPX + P0_CPC + (ZERO_FILL ? P0_ZERO : 0);

DI void p0_item(const Params& p, int item, char* smem) {
  const int tid = ltid();
  if (item < P0_MOD) {
    const int l = item / 96, cb = item % 96, cl = tid & 63, kq = tid >> 6;
    float* sv = (float*)smem;
    float* red = sv + 3072;
    for (int i = tid; i < 1024; i += 256) { sv[i] = silu_f(p.c[i]); sv[1024 + i] = silu_f(p.c[1024 + i]); sv[2048 + i] = silu_f(p.c_ctx[i]); }
    __syncthreads();
    const int col = cb * 64 + cl; const float* W = p.w_mod + (size_t)l * 1024 * 6144 + col;
    float a0 = 0.f, a1 = 0.f, a2 = 0.f;
#pragma unroll 16
    for (int k = kq * 256; k < kq * 256 + 256; ++k) { const float w = W[(size_t)k * 6144]; a0 += sv[k] * w; a1 += sv[1024 + k] * w; a2 += sv[2048 + k] * w; }
    red[(kq * 3 + 0) * 64 + cl] = a0; red[(kq * 3 + 1) * 64 + cl] = a1; red[(kq * 3 + 2) * 64 + cl] = a2;
    __syncthreads();
    if (tid < 192) {
      const int s = tid >> 6; const float bm = p.b_mod[l * 6144 + col];
      const float v = red[(0 * 3 + s) * 64 + cl] + red[(1 * 3 + s) * 64 + cl] + red[(2 * 3 + s) * 64 + cl] + red[(3 * 3 + s) * 64 + cl] + bm;
      ((float*)(p.ws + OFF_MOD))[(size_t)(l * 3 + s) * 6144 + col] = v;
    }
    __syncthreads();
    return;
  }
  item -= P0_MOD;
  if (item < P0_TR) {
    const int l = item / TR_PER_LAYER; int t = item % TR_PER_LAYER; float* tile = (float*)smem;
    if (t < 704) { tr_tile(p.w_in + (size_t)l * 1024 * 2744, 1024, 2744, (bf16_t*)(p.ws + OFF_WIN) + (size_t)l * 2816 * 1024, nullptr, 0, 0, t / 44, t % 44, tile); return; }
    t -= 704;
    if (t < 24) { tr_tile(p.mla_w_uq + (size_t)l * 256 * 384, 256, 384, (bf16_t*)(p.ws + OFF_WUQ) + (size_t)l * 384 * 256, p.mla_q_norm + l * 256, 0, 256, t / 6, t % 6, tile); return; }
    t -= 24;
    if (t < 16) { tr_tile(p.mla_w_ukv + (size_t)l * 128 * 512, 128, 512, (bf16_t*)(p.ws + OFF_WUKV) + (size_t)l * 512 * 128, p.mla_kv_norm + l * 128, 0, 128, t / 8, t % 8, tile); return; }
    t -= 16;
    if (t < 16) { tr_tile(p.s5_w_glu + (size_t)l * 256 * 256, 256, 256, (bf16_t*)(p.ws + OFF_WGLU) + (size_t)l * 256 * 256, nullptr, 0, 0, t / 4, t % 4, tile); return; }
    t -= 16;
    if (t < 256) { tr_tile(p.w_out + (size_t)l * 1024 * 1024, 1024, 1024, (bf16_t*)(p.ws + OFF_WOUT) + (size_t)l * 1024 * 1024, p.ssd_norm + l * 256, 512, 768, t / 16, t % 16, tile); return; }
    t -= 256;
    if (t < 1408) { tr_tile(p.ffn_w_up + (size_t)l * 1024 * 5632, 1024, 5632, (bf16_t*)(p.ws + OFF_WUP) + (size_t)l * 5632 * 1024, nullptr, 0, 0, t / 88, t % 88, tile, (t % 88) < 44 ? (t % 88) * 128 : ((t % 88) - 44) * 128 + 64); return; }
    t -= 1408;
    tr_tile(p.ffn_w_down + (size_t)l * 2816 * 1024, 2816, 1024, (bf16_t*)(p.ws + OFF_WDN) + (size_t)l * 1024 * 2816, nullptr, 0, 0, t / 16, t % 16, tile);
    return;
  }
  item -= P0_TR;
  if (item >= P0_CPX + P0_CPC) {
    item -= P0_CPX + P0_CPC;
    char* z = p.ws + OFF_HY + (size_t)item * 65536;
    const size_t lim = WS_NEED - OFF_HY - (size_t)item * 65536;
    for (int i = 0; i < 16; ++i) { const size_t o = (size_t)(i * 256 + tid) * 16; if (o < lim) *(u32x4*)(z + o) = (u32x4){0u, 0u, 0u, 0u}; }
    return;
  }
  const float* src; float* dst;
  if (item < P0_CPX) { src = p.x + (size_t)item * 4096; dst = p.xb + (size_t)item * 4096; }
  else { item -= P0_CPX; src = p.ctx + (size_t)item * 4096; dst = (float*)(p.ws + OFF_CTX) + (size_t)item * 4096; }
  for (int i = 0; i < 4; ++i) { const int o = (i * 256 + tid) * 4; *(float4*)(dst + o) = *(const float4*)(src + o); }
}


struct TrD { const float* src; bf16_t* dst; const float* gain; int K, N, glo, ghi, tk, tn, drow0; };
DI TrD tr_desc(const Params& p, int item) {
  const int l = item / TR_PER_LAYER; int t = item % TR_PER_LAYER; TrD d; d.gain = nullptr; d.glo = 0; d.ghi = 0; d.drow0 = -1;
  if (t < 704) { d.src = p.w_in + (size_t)l * 1024 * 2744; d.K = 1024; d.N = 2744; d.dst = (bf16_t*)(p.ws + OFF_WIN) + (size_t)l * 2816 * 1024; d.tk = t / 44; d.tn = t % 44; return d; }
  t -= 704;
  if (t < 24) { d.src = p.mla_w_uq + (size_t)l * 256 * 384; d.K = 256; d.N = 384; d.dst = (bf16_t*)(p.ws + OFF_WUQ) + (size_t)l * 384 * 256; d.gain = p.mla_q_norm + l * 256; d.ghi = 256; d.tk = t / 6; d.tn = t % 6; return d; }
  t -= 24;
  if (t < 16) { d.src = p.mla_w_ukv + (size_t)l * 128 * 512; d.K = 128; d.N = 512; d.dst = (bf16_t*)(p.ws + OFF_WUKV) + (size_t)l * 512 * 128; d.gain = p.mla_kv_norm + l * 128; d.ghi = 128; d.tk = t / 8; d.tn = t % 8; return d; }
  t -= 16;
  if (t < 16) { d.src = p.s5_w_glu + (size_t)l * 256 * 256; d.K = 256; d.N = 256; d.dst = (bf16_t*)(p.ws + OFF_WGLU) + (size_t)l * 256 * 256; d.tk = t / 4; d.tn = t % 4; return d; }
  t -= 16;
  if (t < 256) { d.src = p.w_out + (size_t)l * 1024 * 1024; d.K = 1024; d.N = 1024; d.dst = (bf16_t*)(p.ws + OFF_WOUT) + (size_t)l * 1024 * 1024; d.gain = p.ssd_norm + l * 256; d.glo = 512; d.ghi = 768; d.tk = t / 16; d.tn = t % 16; return d; }
  t -= 256;
  if (t < 1408) { d.src = p.ffn_w_up + (size_t)l * 1024 * 5632; d.K = 1024; d.N = 5632; d.dst = (bf16_t*)(p.ws + OFF_WUP) + (size_t)l * 5632 * 1024; d.tk = t / 88; d.tn = t % 88;
    d.drow0 = d.tn < 44 ? d.tn * 128 : (d.tn - 44) * 128 + 64; return d; }
  t -= 1408;
  d.src = p.ffn_w_down + (size_t)l * 2816 * 1024; d.K = 2816; d.N = 1024; d.dst = (bf16_t*)(p.ws + OFF_WDN) + (size_t)l * 1024 * 2816; d.tk = t / 16; d.tn = t % 16; return d;
}
DI void tr_load(const TrD& d, float4 (&v)[4]) {
  const int tid = ltid(), c4 = tid & 15, rq = tid >> 4;
  const bool vec = (d.N & 3) == 0;
#pragma unroll
  for (int rr = 0; rr < 4; ++rr) {
    const int r = rr * 16 + rq, k = d.tk * 64 + r, n = d.tn * 64 + c4 * 4;
    const float* s = d.src + (size_t)k * d.N + n;
    if (vec && n + 3 < d.N) v[rr] = *(const float4*)s;
    else { v[rr].x = n < d.N ? s[0] : 0.f; v[rr].y = n + 1 < d.N ? s[1] : 0.f; v[rr].z = n + 2 < d.N ? s[2] : 0.f; v[rr].w = n + 3 < d.N ? s[3] : 0.f; }
  }
}
DI void tr_finish(const TrD& d, const float4 (&v)[4], float* tile) {
  const int tid = ltid(), c4 = tid & 15, rq = tid >> 4;
#pragma unroll
  for (int rr = 0; rr < 4; ++rr) {
    const int r = rr * 16 + rq, k = d.tk * 64 + r;
    float4 x = v[rr];
    if (d.gain && k >= d.glo && k < d.ghi) { const float g = d.gain[k - d.glo]; x.x *= g; x.y *= g; x.z *= g; x.w *= g; }
    *(float4*)(tile + r * 68 + c4 * 4) = x;
  }
  __syncthreads();
#pragma unroll
  for (int q = 0; q < 2; ++q) {
    const int id = tid + 256 * q, n = id >> 3, k0 = (id & 7) * 8;
    u32x4 o;
    o.x = pack2(tile[(k0 + 0) * 68 + n], tile[(k0 + 1) * 68 + n]); o.y = pack2(tile[(k0 + 2) * 68 + n], tile[(k0 + 3) * 68 + n]);
    o.z = pack2(tile[(k0 + 4) * 68 + n], tile[(k0 + 5) * 68 + n]); o.w = pack2(tile[(k0 + 6) * 68 + n], tile[(k0 + 7) * 68 + n]);
    *(u32x4*)(d.dst + (size_t)((d.drow0 >= 0 ? d.drow0 : d.tn * 64) + n) * d.K + d.tk * 64 + k0) = o;
  }
  __syncthreads();
}
DI void p0_transposes(const Params& p, char* smem) {
  float* tile = (float*)smem;
  int t = blockIdx.x;
  if (t >= P0_TR) return;
  TrD d = tr_desc(p, t); float4 v[4]; tr_load(d, v);
  for (;;) {
    const int t1 = t + gridDim.x; const bool has = t1 < P0_TR;
    TrD d1 = d; float4 v1[4];
    if (has) { d1 = tr_desc(p, t1); tr_load(d1, v1); }
    tr_finish(d, v, tile);
    if (!has) break;
    d = d1; t = t1;
#pragma unroll
    for (int i = 0; i < 4; ++i) v[i] = v1[i];
  }
}

DI void norm_item(const Params& p, int l, int which, int item) {
  const int lane = ltid() & 63, w = __builtin_amdgcn_readfirstlane(ltid() >> 6), row = item * 4 + w;
  const float* x = row < NLAT ? p.xb + (size_t)row * 1024 : (const float*)(p.ws + OFF_CTX) + (size_t)(row - NLAT) * 1024;
  float4 v[4]; float ss = 0.f;
#pragma unroll
  for (int i = 0; i < 4; ++i) { v[i] = *(const float4*)(x + (i * 64 + lane) * 4); ss += v[i].x * v[i].x + v[i].y * v[i].y + v[i].z * v[i].z + v[i].w * v[i].w; }
  ss = wave_sum(ss);
  const float rstd = rsqrtf(ss * (1.f / 1024.f) + 1e-6f);
  const int s = row < NLAT ? row / T : 2;
  const float* g = (which ? p.norm2 : p.norm1) + l * 1024;
  const float* md = (const float*)(p.ws + OFF_MOD) + (size_t)(l * 3 + s) * 6144 + (which ? 3072 : 0);
  bf16_t* H = (bf16_t*)(p.ws + OFF_HY) + (size_t)row * 1024;
#pragma unroll
  for (int i = 0; i < 4; ++i) {
    const int k = (i * 64 + lane) * 4;
    const float4 g4 = *(const float4*)(g + k), sh = *(const float4*)(md + k), sc = *(const float4*)(md + 1024 + k);
    u32x2 o; o.x = pack2(v[i].x * rstd * g4.x * (1.f + sc.x) + sh.x, v[i].y * rstd * g4.y * (1.f + sc.y) + sh.y);
    o.y = pack2(v[i].z * rstd * g4.z * (1.f + sc.z) + sh.z, v[i].w * rstd * g4.w * (1.f + sc.w) + sh.w);
    *(u32x2*)(H + k) = o;
  }
}

DI u32x4 scale_bf8(u32x4 q, float s) {
  q.x = pack2(bflo(q.x) * s, bfhi(q.x) * s); q.y = pack2(bflo(q.y) * s, bfhi(q.y) * s);
  q.z = pack2(bflo(q.z) * s, bfhi(q.z) * s); q.w = pack2(bflo(q.w) * s, bfhi(q.w) * s); return q;
}
#define GEMM_STEP(AR, BR, KT, CUR)                                                                                    \
  {                                                                                                                   \
    bf16_t* Aw = As + (1 - (CUR)) * GBUF; bf16_t* Bw = Aw + 128 * 72;                                                 \
    const bf16_t* Ac = As + (CUR) * GBUF; const bf16_t* Bc = Ac + 128 * 72;                                           \
    if ((KT) + 1 < nk) {                                                                                              \
      if (AMODE == 1 && (KT) + 1 >= 8 && (KT) + 1 < 12) {                                                             \
        _Pragma("unroll") for (int i = 0; i < 4; ++i) AR[i] = scale_bf8(AR[i], rs[i]);                                \
      }                                                                                                               \
      _Pragma("unroll") for (int i = 0; i < 4; ++i) { *(u32x4*)(Aw + (r0 + 32 * i) * 72 + cc * 8) = AR[i]; *(u32x4*)(Bw + (r0 + 32 * i) * 72 + cc * 8) = BR[i]; } \
    }                                                                                                                 \
    if ((KT) + 3 < nk) {                                                                                              \
      _Pragma("unroll") for (int i = 0; i < 4; ++i) { AR[i] = *(const u32x4*)((CLAMP ? apx[i] : ap + i * astep) + ((KT) + 3) * 64); BR[i] = *(const u32x4*)(bp + i * bstep + ((KT) + 3) * 64); } \
    }                                                                                                                 \
    __builtin_amdgcn_sched_barrier(0);                                                                                \
    _Pragma("unroll") for (int ks = 0; ks < 2; ++ks) {                                                                \
      bf16x8 af[4], bfr[4];                                                                                           \
      _Pragma("unroll") for (int i = 0; i < 4; ++i) { af[i] = ld_frag(Ac + (64 * wm + 16 * i + l15) * 72 + ks * 32 + g4 * 8); bfr[i] = ld_frag(Bc + (64 * wn + 16 * i + l15) * 72 + ks * 32 + g4 * 8); } \
      _Pragma("unroll") for (int i = 0; i < 4; ++i)                                                                   \
        _Pragma("unroll") for (int j = 0; j < 4; ++j) acc[i][j] = MFMA16(bfr[j], af[i], acc[i][j]);                   \
    }                                                                                                                 \
    __syncthreads();                                                                                                  \
  }
template <int AMODE, int STAGE, class Epi, int CLAMP = 0>
DI void gemm_tile(const bf16_t* __restrict__ A, int lda, const bf16_t* __restrict__ Bt, int ldb, int K, int m0, int n0, char* smem, const float* ssq, Epi epi, int rlo = 0, int rhi = 0) {
  bf16_t* As = (bf16_t*)smem; bf16_t* Bs = As + 128 * 72;
  const int tid = ltid(), lane = tid & 63, w = __builtin_amdgcn_readfirstlane(tid >> 6), wm = w >> 1, wn = w & 1, l15 = lane & 15, g4 = lane >> 4;
  u32x4 ar0[4], br0[4], ar1[4], br1[4]; float rs[4];
  const int r0 = tid >> 3, cc = tid & 7;
  const bf16_t* ap = A + (size_t)(m0 + r0) * lda + cc * 8;
  const bf16_t* bp = Bt + (size_t)(n0 + r0) * ldb + cc * 8;
  const size_t astep = (size_t)32 * lda, bstep = (size_t)32 * ldb;
  const bf16_t* apx[4];
  if (CLAMP) {
#pragma unroll
    for (int i = 0; i < 4; ++i) { int r = m0 + r0 + 32 * i; r = r < rlo ? rlo : (r > rhi ? rhi : r); apx[i] = A + (size_t)r * lda + cc * 8; }
  }
  if (AMODE == 1) {
#pragma unroll
    for (int i = 0; i < 4; ++i) { const float* q = ssq + (m0 + r0 + 32 * i); rs[i] = rsqrtf((q[0] + q[NROW] + q[2 * NROW] + q[3 * NROW]) * (1.f / 256.f) + 1e-6f); }
  }
  f32x4 acc[4][4];
#pragma unroll
  for (int i = 0; i < 4; ++i)
#pragma unroll
    for (int j = 0; j < 4; ++j) acc[i][j] = (f32x4){0.f, 0.f, 0.f, 0.f};
  const int nk = K >> 6;
#pragma unroll
  for (int i = 0; i < 4; ++i) { ar0[i] = *(const u32x4*)(CLAMP ? apx[i] : ap + i * astep); br0[i] = *(const u32x4*)(bp + i * bstep); }
  constexpr int GBUF = 2 * 128 * 72;
#pragma unroll
  for (int i = 0; i < 4; ++i) { ar1[i] = *(const u32x4*)((CLAMP ? apx[i] : ap + i * astep) + 64); br1[i] = *(const u32x4*)(bp + i * bstep + 64); }
#pragma unroll
  for (int i = 0; i < 4; ++i) { *(u32x4*)(As + (r0 + 32 * i) * 72 + cc * 8) = ar0[i]; *(u32x4*)(Bs + (r0 + 32 * i) * 72 + cc * 8) = br0[i]; }
  if (2 < nk) {
#pragma unroll
    for (int i = 0; i < 4; ++i) { ar0[i] = *(const u32x4*)((CLAMP ? apx[i] : ap + i * astep) + 128); br0[i] = *(const u32x4*)(bp + i * bstep + 128); }
  }
  __syncthreads();
  for (int kt = 0; kt < nk; kt += 2) {
    GEMM_STEP(ar1, br1, kt, 0)
    GEMM_STEP(ar0, br0, kt + 1, 1)
  }
  if (STAGE == 2) {
    float* Tf = (float*)smem;
#pragma unroll
    for (int h = 0; h < 2; ++h) {
      if (wm == h) {
#pragma unroll
        for (int i = 0; i < 4; ++i)
#pragma unroll
          for (int j = 0; j < 4; ++j) *(f32x4*)(Tf + (16 * i + l15) * 132 + 64 * wn + 16 * j + 4 * g4) = acc[i][j];
      }
      __syncthreads();
#pragma unroll
      for (int q = 0; q < 8; ++q) { const int id = tid + 256 * q, r = id >> 5, c = id & 31; epi(m0 + 64 * h + r, n0 + c * 4, *(const f32x4*)(Tf + r * 132 + c * 4)); }
      __syncthreads();
    }
    return;
  }
#pragma unroll
  for (int i = 0; i < 4; ++i)
#pragma unroll
    for (int j = 0; j < 4; ++j) epi(m0 + 64 * wm + 16 * i + l15, n0 + 64 * wn + 16 * j + 4 * g4, acc[i][j]);
}

DI void store_bf4(bf16_t* dst, f32x4 v) { u32x2 o; o.x = pack2(v[0], v[1]); o.y = pack2(v[2], v[3]); *(u32x2*)dst = o; }

DI void gemm_in_item(const Params& p, int l, int item, char* smem) {
  const int mtile = item / 22, nt = item % 22;
  int seq0, slen, ti;
  if (mtile < 132) { seq0 = (mtile / 66) * T; slen = T; ti = mtile % 66; }
  else { const int j = mtile - 132; seq0 = NLAT + (j / 3) * TC; slen = TC; ti = j % 3; }
  const int m0 = seq0 + 126 * ti - 1, n0 = nt * 128;
  bf16_t* P = (bf16_t*)(p.ws + OFF_P); float* GML = (float*)(p.ws + OFF_GML); float* DTR = (float*)(p.ws + OFF_DTR);
  bf16_t* Ts = (bf16_t*)smem;
  auto epi = [&](int row, int col, f32x4 v) {
    const int lr = row - m0, t = 126 * ti - 1 + lr;
    store_bf4(Ts + lr * 136 + (col - n0), v);
    if (lr >= 1 && lr <= 126 && t < slen) {
      if (col >= 1024 && col < 1040) *(f32x4*)(GML + (size_t)row * 16 + (col - 1024)) = v;
      if (col >= 2480 && col < 2488) *(f32x4*)(DTR + (size_t)row * 8 + (col - 2480)) = v;
    }
  };
  gemm_tile<0, 0, decltype(epi), 1>((const bf16_t*)(p.ws + OFF_HY), 1024, (const bf16_t*)(p.ws + OFF_WIN) + (size_t)l * 2816 * 1024, 1024, 1024, m0, n0, smem, nullptr, epi, seq0, seq0 + slen - 1);
  __syncthreads();
  {
    const int tid = ltid();
    const float* cw = p.ssd_conv_w + (size_t)l * 3 * 768; const float* cb = p.ssd_conv_b + l * 768;
#pragma unroll
    for (int q = 0; q < 8; ++q) {
      const int id = tid + 256 * q, lr = 1 + (id >> 4), c8 = (id & 15) * 8, t = 126 * ti - 1 + lr, col = n0 + c8;
      if (id < 2016 && t < slen) {
        u32x4 o = *(const u32x4*)(Ts + lr * 136 + c8);
        if (col >= C_XBC && col < C_XBC + 768) {
          const int ch = col - C_XBC;
          const u32x4 z = {0u, 0u, 0u, 0u};
          const u32x4 pm = t > 0 ? *(const u32x4*)(Ts + (lr - 1) * 136 + c8) : z, nx = t + 1 < slen ? *(const u32x4*)(Ts + (lr + 1) * 136 + c8) : z;
          const float a[8] = {bflo(pm.x), bfhi(pm.x), bflo(pm.y), bfhi(pm.y), bflo(pm.z), bfhi(pm.z), bflo(pm.w), bfhi(pm.w)};
          const float m[8] = {bflo(o.x), bfhi(o.x), bflo(o.y), bfhi(o.y), bflo(o.z), bfhi(o.z), bflo(o.w), bfhi(o.w)};
          const float n[8] = {bflo(nx.x), bfhi(nx.x), bflo(nx.y), bfhi(nx.y), bflo(nx.z), bfhi(nx.z), bflo(nx.w), bfhi(nx.w)};
          float r[8];
#pragma unroll
          for (int j = 0; j < 8; ++j) r[j] = silu_f(cb[ch + j] + cw[ch + j] * a[j] + cw[768 + ch + j] * m[j] + cw[1536 + ch + j] * n[j]);
          o.x = pack2(r[0], r[1]); o.y = pack2(r[2], r[3]); o.z = pack2(r[4], r[5]); o.w = pack2(r[6], r[7]);
        }
        *(u32x4*)(P + (size_t)(seq0 + t) * PINP + col) = o;
      }
    }
  }
  __syncthreads();
}

DI void tile_rstd(const bf16_t* P, int m0, int col0, int ncols, float* rst) {
  const int tid = ltid(), r = tid >> 1, hf = tid & 1, n = ncols >> 1;
  const bf16_t* src = P + (size_t)(m0 + r) * PINP + col0 + hf * n;
  float ss = 0.f;
  for (int c = 0; c < n; c += 8) { const u32x4 q = *(const u32x4*)(src + c);
    ss += bflo(q.x) * bflo(q.x) + bfhi(q.x) * bfhi(q.x) + bflo(q.y) * bflo(q.y) + bfhi(q.y) * bfhi(q.y) + bflo(q.z) * bflo(q.z) + bfhi(q.z) * bfhi(q.z) + bflo(q.w) * bflo(q.w) + bfhi(q.w) * bfhi(q.w); }
  ss += __shfl_xor(ss, 1);
  if (hf == 0) rst[r] = rsqrtf(ss / (float)ncols + 1e-6f);
  __syncthreads();
}
DI void qproj_item(const Params& p, int l, int item, char* smem) {
  const int mt = item / 3, nt = item % 3; const bf16_t* P = (const bf16_t*)(p.ws + OFF_P);
  float* rst = (float*)(smem + 73728);
  tile_rstd(P, mt * 128, C_CQ, 256, rst);
  bf16_t* Q = (bf16_t*)(p.ws + OFF_QRAW);
  gemm_tile<0, 0>(P + C_CQ, PINP, (const bf16_t*)(p.ws + OFF_WUQ) + (size_t)l * 384 * 256, 256, 256, mt * 128, nt * 128, smem, nullptr,
               [&](int row, int col, f32x4 v) { const float r = rst[row - mt * 128]; store_bf4(Q + (size_t)row * 384 + col, v * r); });
  __syncthreads();
}
DI void kvproj_item(const Params& p, int l, int item, char* smem) {
  const int mt = item / 4, nt = item % 4; const bf16_t* P = (const bf16_t*)(p.ws + OFF_P);
  float* rst = (float*)(smem + 73728);
  tile_rstd(P, mt * 128, C_CKV, 128, rst);
  bf16_t* KH = (bf16_t*)(p.ws + OFF_KH); bf16_t* VT = (bf16_t*)(p.ws + OFF_VT);
  gemm_tile<0, 0>(P + C_CKV, PINP, (const bf16_t*)(p.ws + OFF_WUKV) + (size_t)l * 512 * 128, 128, 128, mt * 128, nt * 128, smem, nullptr,
               [&](int row, int col, f32x4 v) {
                 const float r = rst[row - mt * 128]; v = v * r;
                 const int hh = col >> 7, dd = col & 127;
                 int b, tpos; if (row < NLAT) { b = row / T; tpos = row % T; } else { b = (row - NLAT) / TC; tpos = T + (row - NLAT) % TC; }
                 if (dd < 64) store_bf4(KH + ((size_t)(b * 4 + hh) * TALL + tpos) * 64 + dd, v);
                 else {
                   bf16_t* vp = VT + ((size_t)(b * 4 + hh) * 64 + (dd - 64)) * TALL + tpos;
                   vp[0] = f2bf(v[0]); vp[TALL] = f2bf(v[1]); vp[2 * TALL] = f2bf(v[2]); vp[3 * TALL] = f2bf(v[3]);
                 }
               });
  __syncthreads();
}
DI void rope_cs(int t, int i, float& cs, float& sn) {
  const int pos = (i < 8) ? (t >> 6) : (t & 63); const int f = i & 7;
  const float inv = exp2f(-(float)f * (13.287712379549449f / 8.f));
  const float ang = (float)pos * inv;
  cs = cosf(ang); sn = sinf(ang);
}
DI void ropek_item(const Params& p, int item) {
  const int row = item * 256 + ltid();
  const bf16_t* src = (const bf16_t*)(p.ws + OFF_P) + (size_t)row * PINP + C_KR;
  u32x4 q[4];
#pragma unroll
  for (int i = 0; i < 4; ++i) q[i] = *(const u32x4*)(src + i * 8);
  float v[32];
#pragma unroll
  for (int i = 0; i < 4; ++i) { v[i * 8 + 0] = bflo(q[i].x); v[i * 8 + 1] = bfhi(q[i].x); v[i * 8 + 2] = bflo(q[i].y); v[i * 8 + 3] = bfhi(q[i].y);
    v[i * 8 + 4] = bflo(q[i].z); v[i * 8 + 5] = bfhi(q[i].z); v[i * 8 + 6] = bflo(q[i].w); v[i * 8 + 7] = bfhi(q[i].w); }
  int b, tpos;
  if (row < NLAT) {
    b = row / T; tpos = row % T;
#pragma unroll
    for (int i = 0; i < 16; ++i) { float cs, sn; rope_cs(tpos, i, cs, sn); const float x1 = v[i], x2 = v[i + 16]; v[i] = x1 * cs - x2 * sn; v[i + 16] = x1 * sn + x2 * cs; }
  } else { b = (row - NLAT) / TC; tpos = T + (row - NLAT) % TC; }
  u32x4 o[4];
#pragma unroll
  for (int i = 0; i < 4; ++i) { o[i].x = pack2(v[i * 8], v[i * 8 + 1]); o[i].y = pack2(v[i * 8 + 2], v[i * 8 + 3]); o[i].z = pack2(v[i * 8 + 4], v[i * 8 + 5]); o[i].w = pack2(v[i * 8 + 6], v[i * 8 + 7]); }
  bf16_t* dst = (bf16_t*)(p.ws + OFF_KR) + ((size_t)b * TALL + tpos) * 32;
#pragma unroll
  for (int i = 0; i < 4; ++i) *(u32x4*)(dst + i * 8) = o[i];
}

DI void attn_item(const Params& p, int item, char* smem) {
  const int tid = ltid(), lane = tid & 63, w = __builtin_amdgcn_readfirstlane(tid >> 6), l15 = lane & 15, g4 = lane >> 4;
  int b, h, qt, latent;
  if (item < 512) { latent = 1; qt = item & 63; h = (item >> 6) & 3; b = item >> 8; }
  else { latent = 0; const int i2 = item - 512; qt = i2 & 1; h = (i2 >> 1) & 3; b = i2 >> 3; }
  const int qrow0 = latent ? b * T + qt * 128 : NLAT + b * TC + qt * 128;
  bf16_t* Qs = (bf16_t*)smem;
  bf16_t* Ks = (bf16_t*)smem;
  bf16_t* Vs = Ks + 64 * 104;
  const bf16_t* Qraw = (const bf16_t*)(p.ws + OFF_QRAW);
  const float qscale = 0.10206207261596577f * 1.4426950408889634f;
  for (int id = tid; id < 1280; id += 256) {
    const int r = id / 10, cc = id % 10;
    const bf16_t* src = Qraw + (size_t)(qrow0 + r) * 384 + h * 96 + cc * 8;
    const u32x4 q = *(const u32x4*)src;
    float a[8] = {bflo(q.x), bfhi(q.x), bflo(q.y), bfhi(q.y), bflo(q.z), bfhi(q.z), bflo(q.w), bfhi(q.w)};
    if (cc < 8) {
      u32x4 o; o.x = pack2(a[0] * qscale, a[1] * qscale); o.y = pack2(a[2] * qscale, a[3] * qscale); o.z = pack2(a[4] * qscale, a[5] * qscale); o.w = pack2(a[6] * qscale, a[7] * qscale);
      *(u32x4*)(Qs + r * 104 + cc * 8) = o;
    } else {
      const u32x4 q2 = *(const u32x4*)(src + 16);
      float c2[8] = {bflo(q2.x), bfhi(q2.x), bflo(q2.y), bfhi(q2.y), bflo(q2.z), bfhi(q2.z), bflo(q2.w), bfhi(q2.w)};
      float o1[8], o2[8];
#pragma unroll
      for (int j = 0; j < 8; ++j) {
        float cs = 1.f, sn = 0.f;
        if (latent) rope_cs(qt * 128 + r, (cc - 8) * 8 + j, cs, sn);
        o1[j] = (a[j] * cs - c2[j] * sn) * qscale; o2[j] = (a[j] * sn + c2[j] * cs) * qscale;
      }
      u32x4 o; o.x = pack2(o1[0], o1[1]); o.y = pack2(o1[2], o1[3]); o.z = pack2(o1[4], o1[5]); o.w = pack2(o1[6], o1[7]);
      *(u32x4*)(Qs + r * 104 + cc * 8) = o;
      o.x = pack2(o2[0], o2[1]); o.y = pack2(o2[2], o2[3]); o.z = pack2(o2[4], o2[5]); o.w = pack2(o2[6], o2[7]);
      *(u32x4*)(Qs + r * 104 + cc * 8 + 16) = o;
    }
  }
  __syncthreads();
  bf16x8 qf[2][3];
#pragma unroll
  for (int qs = 0; qs < 2; ++qs)
#pragma unroll
    for (int ks = 0; ks < 3; ++ks) qf[qs][ks] = ld_frag(Qs + (32 * w + 16 * qs + l15) * 104 + ks * 32 + g4 * 8);
  __syncthreads();
  const int kt0 = latent ? 0 : 128, kt1 = 132;
  const bf16_t* Kg = (const bf16_t*)(p.ws + OFF_KH) + (size_t)(b * 4 + h) * TALL * 64;
  const bf16_t* Rg = (const bf16_t*)(p.ws + OFF_KR) + (size_t)b * TALL * 32;
  const bf16_t* Vg = (const bf16_t*)(p.ws + OFF_VT) + (size_t)(b * 4 + h) * 64 * TALL;
  u32x4 kr[3], vr[2];
  const int ve0 = tid >> 3, vc = tid & 7;
  {
    kr[0] = *(const u32x4*)(Kg + (size_t)kt0 * 4096 + tid * 8); kr[1] = *(const u32x4*)(Kg + (size_t)kt0 * 4096 + (tid + 256) * 8);
    kr[2] = *(const u32x4*)(Rg + (size_t)kt0 * 2048 + tid * 8);
#pragma unroll
    for (int i = 0; i < 2; ++i) vr[i] = *(const u32x4*)(Vg + (size_t)(ve0 + 32 * i) * TALL + kt0 * 64 + vc * 8);
  }
  float mrun[2] = {0.f, 0.f}, lsum[2] = {0.f, 0.f};
  f32x4 O[4][2];
#pragma unroll
  for (int es = 0; es < 4; ++es)
#pragma unroll
    for (int qs = 0; qs < 2; ++qs) O[es][qs] = (f32x4){0.f, 0.f, 0.f, 0.f};
  constexpr int KVB = 64 * 104 + 64 * 72;
  {
#pragma unroll
    for (int i = 0; i < 2; ++i) { const int id = tid + 256 * i; *(u32x4*)(Ks + (id >> 3) * 104 + (id & 7) * 8) = kr[i]; }
    *(u32x4*)(Ks + (tid >> 2) * 104 + 64 + (tid & 3) * 8) = kr[2];
#pragma unroll
    for (int i = 0; i < 2; ++i) *(u32x4*)(Vs + (ve0 + 32 * i) * 72 + vc * 8) = vr[i];
    if (kt0 + 1 < kt1) {
      kr[0] = *(const u32x4*)(Kg + (size_t)(kt0 + 1) * 4096 + tid * 8); kr[1] = *(const u32x4*)(Kg + (size_t)(kt0 + 1) * 4096 + (tid + 256) * 8);
      kr[2] = *(const u32x4*)(Rg + (size_t)(kt0 + 1) * 2048 + tid * 8);
#pragma unroll
      for (int i = 0; i < 2; ++i) vr[i] = *(const u32x4*)(Vg + (size_t)(ve0 + 32 * i) * TALL + (kt0 + 1) * 64 + vc * 8);
    }
    __syncthreads();
  }
  for (int kt = kt0; kt < kt1; ++kt) {
    const int cur = (kt - kt0) & 1;
    const bf16_t* Kc = Ks + cur * KVB; const bf16_t* Vc = Vs + cur * KVB;
    bf16_t* Kn = Ks + (cur ^ 1) * KVB; bf16_t* Vn = Vs + (cur ^ 1) * KVB;
    if (kt + 1 < kt1) {
#pragma unroll
      for (int i = 0; i < 2; ++i) { const int id = tid + 256 * i; *(u32x4*)(Kn + (id >> 3) * 104 + (id & 7) * 8) = kr[i]; }
      *(u32x4*)(Kn + (tid >> 2) * 104 + 64 + (tid & 3) * 8) = kr[2];
#pragma unroll
      for (int i = 0; i < 2; ++i) *(u32x4*)(Vn + (ve0 + 32 * i) * 72 + vc * 8) = vr[i];
    }
    if (kt + 2 < kt1) {
      kr[0] = *(const u32x4*)(Kg + (size_t)(kt + 2) * 4096 + tid * 8); kr[1] = *(const u32x4*)(Kg + (size_t)(kt + 2) * 4096 + (tid + 256) * 8);
      kr[2] = *(const u32x4*)(Rg + (size_t)(kt + 2) * 2048 + tid * 8);
#pragma unroll
      for (int i = 0; i < 2; ++i) vr[i] = *(const u32x4*)(Vg + (size_t)(ve0 + 32 * i) * TALL + (kt + 2) * 64 + vc * 8);
    }
    __builtin_amdgcn_sched_barrier(0);
    f32x4 sa[4][2];
#pragma unroll
    for (int kb = 0; kb < 4; ++kb)
#pragma unroll
      for (int qs = 0; qs < 2; ++qs) { const float nm = -mrun[qs]; sa[kb][qs] = (f32x4){nm, nm, nm, nm}; }
#pragma unroll
    for (int ks = 0; ks < 3; ++ks)
#pragma unroll
      for (int kb = 0; kb < 4; ++kb) {
        const bf16x8 a = ld_frag(Kc + (16 * kb + l15) * 104 + ks * 32 + g4 * 8);
#pragma unroll
        for (int qs = 0; qs < 2; ++qs) sa[kb][qs] = MFMA16(a, qf[qs][ks], sa[kb][qs]);
      }
    bf16x8 pf[2][2];
    float dl[2];
#pragma unroll
    for (int qs = 0; qs < 2; ++qs) {
      float mx = -1e30f;
#pragma unroll
      for (int kb = 0; kb < 4; ++kb)
#pragma unroll
        for (int j = 0; j < 4; ++j) mx = fmaxf(mx, sa[kb][qs][j]);
      mx = fmaxf(mx, __shfl_xor(mx, 16)); mx = fmaxf(mx, __shfl_xor(mx, 32));
      dl[qs] = (kt == kt0) ? mx : fmaxf(mx, 0.f);
    }
    const bool grew = (kt == kt0) || __builtin_amdgcn_ballot_w64(dl[0] > 0.f || dl[1] > 0.f) != 0ull;
#pragma unroll
    for (int qs = 0; qs < 2; ++qs) {
      float ps = 0.f;
      if (grew) {
        const float d = dl[qs], alpha = (kt == kt0) ? 0.f : __builtin_amdgcn_exp2f(-d);
        mrun[qs] += d;
#pragma unroll
        for (int kb = 0; kb < 4; ++kb)
#pragma unroll
          for (int j = 0; j < 4; ++j) { const float e = __builtin_amdgcn_exp2f(sa[kb][qs][j] - d); sa[kb][qs][j] = e; ps += e; }
        lsum[qs] = lsum[qs] * alpha + ps;
#pragma unroll
        for (int es = 0; es < 4; ++es) O[es][qs] = O[es][qs] * alpha;
      } else {
#pragma unroll
        for (int kb = 0; kb < 4; ++kb)
#pragma unroll
          for (int j = 0; j < 4; ++j) { const float e = __builtin_amdgcn_exp2f(sa[kb][qs][j]); sa[kb][qs][j] = e; ps += e; }
        lsum[qs] += ps;
      }
#pragma unroll
      for (int k2 = 0; k2 < 2; ++k2)
        pf[qs][k2] = mk_frag(pack2(sa[2 * k2][qs][0], sa[2 * k2][qs][1]), pack2(sa[2 * k2][qs][2], sa[2 * k2][qs][3]),
                             pack2(sa[2 * k2 + 1][qs][0], sa[2 * k2 + 1][qs][1]), pack2(sa[2 * k2 + 1][qs][2], sa[2 * k2 + 1][qs][3]));
    }
#pragma unroll
    for (int k2 = 0; k2 < 2; ++k2)
#pragma unroll
      for (int es = 0; es < 4; ++es) {
        const bf16_t* vp = Vc + (16 * es + l15) * 72 + 32 * k2 + 4 * g4;
        const u32x2 lo = *(const u32x2*)vp, hi = *(const u32x2*)(vp + 16);
        const bf16x8 a = mk_frag(lo.x, lo.y, hi.x, hi.y);
#pragma unroll
        for (int qs = 0; qs < 2; ++qs) O[es][qs] = MFMA16(a, pf[qs][k2], O[es][qs]);
      }
    __syncthreads();
  }
  bf16_t* Y = (bf16_t*)(p.ws + OFF_HY);
#pragma unroll
  for (int qs = 0; qs < 2; ++qs) {
    float l = lsum[qs]; l += __shfl_xor(l, 16); l += __shfl_xor(l, 32);
    const float inv = 1.f / l;
    const int row = qrow0 + 32 * w + 16 * qs + l15;
#pragma unroll
    for (int es = 0; es < 4; ++es) store_bf4(Y + (size_t)row * 1024 + 256 + h * 64 + 16 * es + 4 * g4, O[es][qs] * inv);
  }
  __syncthreads();
}

DI void chunk_geom(int tcg, int b, int& part, int& tc, int& row0) { part = tcg >= 128; tc = part ? tcg - 128 : tcg; row0 = row_of(b, part, tc * 64); }
DI int chain_slot(int dir, int part, int tc) { return dir ? (part ? 3 - tc : 131 - tc) : (part ? tc : 4 + tc); }

DI void mlstm_p1(const Params& p, int l, int item, char* smem) {
  const int tid = ltid(), lane = tid & 63, w = __builtin_amdgcn_readfirstlane(tid >> 6), l15 = lane & 15, g4 = lane >> 4;
  const int tcg = item % NCH; int r = item / NCH; const int dir = r & 1; r >>= 1; const int h = r & 3, b = r >> 2;
  int part, tc, row0; chunk_geom(tcg, b, part, tc, row0);
  const int c = chain_slot(dir, part, tc), chain = (b * 4 + h) * 2 + dir;
  bf16_t* A = (bf16_t*)smem;
  bf16_t* Bk = A + 80 * 72;
  float* fs = (float*)(Bk + 64 * 72);
  const bf16_t* P = (const bf16_t*)(p.ws + OFF_P); const float* GML = (const float*)(p.ws + OFF_GML);
  float* MLM = (float*)(p.ws + OFF_MLM) + (size_t)(chain * NCH + c) * 32;
  if (tid < 64) {
    const int gi = 2 * dir;
    const float ig = GML[(size_t)(row0 + tid) * 16 + gi * 4 + h] + p.ml_gate_bias[l * 16 + gi * 4 + h];
    const float fg = GML[(size_t)(row0 + tid) * 16 + (gi + 1) * 4 + h] + p.ml_gate_bias[l * 16 + (gi + 1) * 4 + h];
    const float lf = logsigm_f(fg);
    const float pre = wave_incl_scan(lf, lane), tot = __shfl(pre, 63);
    const float bc = dir ? tot - pre + lf : pre;
    const float wlog = tot - bc + ig, mloc = wave_max(wlog), wv = __expf(wlog - mloc);
    fs[tid] = wv; A[64 * 72 + tid] = f2bf(wv);
    if (tid == 0) { MLM[0] = mloc; MLM[1] = tot; }
  }
  for (int i = tid; i < 15 * 72; i += 256) A[65 * 72 + i] = 0;
  __syncthreads();
  {
    const int s = tid >> 2, d0 = (tid & 3) * 16; const float wv = fs[s];
    const bf16_t* kp = P + (size_t)(row0 + s) * PINP + C_MLK + h * 64 + d0;
    const bf16_t* vp = P + (size_t)(row0 + s) * PINP + C_MLV + h * 64 + d0;
#pragma unroll
    for (int hf = 0; hf < 2; ++hf) {
      const u32x4 kq = *(const u32x4*)(kp + hf * 8), vq = *(const u32x4*)(vp + hf * 8);
      const float kk[8] = {bflo(kq.x), bfhi(kq.x), bflo(kq.y), bfhi(kq.y), bflo(kq.z), bfhi(kq.z), bflo(kq.w), bfhi(kq.w)};
      const float vv[8] = {bflo(vq.x), bfhi(vq.x), bflo(vq.y), bfhi(vq.y), bflo(vq.z), bfhi(vq.z), bflo(vq.w), bfhi(vq.w)};
#pragma unroll
      for (int j = 0; j < 8; ++j) { Bk[(d0 + hf * 8 + j) * 72 + s] = f2bf(kk[j] * 0.125f); A[(d0 + hf * 8 + j) * 72 + s] = f2bf(vv[j] * wv); }
    }
  }
  __syncthreads();
  float* MLS = (float*)(p.ws + OFF_MLS) + (size_t)(chain * NCH + c) * 4160;
  for (int t = w; t < 20; t += 4) {
    const int ms = t >> 2, ns = t & 3;
    f32x4 acc = {0.f, 0.f, 0.f, 0.f};
#pragma unroll
    for (int ks = 0; ks < 2; ++ks) acc = MFMA16(ld_frag(A + (16 * ms + l15) * 72 + ks * 32 + g4 * 8), ld_frag(Bk + (16 * ns + l15) * 72 + ks * 32 + g4 * 8), acc);
#pragma unroll
    for (int j = 0; j < 4; ++j) { const int e = 16 * ms + 4 * g4 + j; if (e <= 64) MLS[e * 64 + 16 * ns + l15] = acc[j]; }
  }
  __syncthreads();
}
DI void mlstm_p2(const Params& p, int item) {
  const int gi = item * 256 + ltid(), chain = gi / 4160, e = gi % 4160;
  float* MLS = (float*)(p.ws + OFF_MLS) + (size_t)chain * NCH * 4160 + e;
  float* MLM = (float*)(p.ws + OFF_MLM) + (size_t)chain * NCH * 32;
  float C = 0.f, m = 0.f;
  for (int c0 = 0; c0 < NCH; c0 += 12) {
    float d[12], ml[12], bl[12];
#pragma unroll
    for (int i = 0; i < 12; ++i) { d[i] = MLS[(size_t)(c0 + i) * 4160]; ml[i] = MLM[(c0 + i) * 32]; bl[i] = MLM[(c0 + i) * 32 + 1]; }
#pragma unroll
    for (int i = 0; i < 12; ++i) {
      MLS[(size_t)(c0 + i) * 4160] = C; if (e == 0) MLM[(c0 + i) * 32 + 16] = m;
      const float mn = fmaxf(bl[i] + m, ml[i]);
      C = __expf(bl[i] + m - mn) * C + __expf(ml[i] - mn) * d[i]; m = mn;
    }
  }
}
DI void mlstm_p3(const Params& p, int l, int item, char* smem) {
  const int tid = ltid(), lane = tid & 63, w = __builtin_amdgcn_readfirstlane(tid >> 6), l15 = lane & 15, g4 = lane >> 4;
  const int h = item & 3; const int r = item >> 2; const int tcg = r % NCH, b = r / NCH;
  int part, tc, row0; chunk_geom(tcg, b, part, tc, row0);
  bf16_t* Qs = (bf16_t*)smem;
  bf16_t* Ks = Qs + 64 * 72;
  bf16_t* Vt = Ks + 64 * 72;
  bf16_t* Sb = Vt + 64 * 72;
  float* fb = (float*)(Sb + 64 * 72);
  float* fi = fb + 64;
  const bf16_t* P = (const bf16_t*)(p.ws + OFF_P); const float* GML = (const float*)(p.ws + OFF_GML);
  {
    const int s = tid >> 2, d0 = (tid & 3) * 16;
    const bf16_t* base = P + (size_t)(row0 + s) * PINP + h * 64 + d0;
#pragma unroll
    for (int hf = 0; hf < 2; ++hf) {
      *(u32x4*)(Qs + s * 72 + d0 + hf * 8) = *(const u32x4*)(base + C_MLQ + hf * 8);
      const u32x4 kq = *(const u32x4*)(base + C_MLK + hf * 8), vq = *(const u32x4*)(base + C_MLV + hf * 8);
      u32x4 ko; ko.x = pack2(bflo(kq.x) * 0.125f, bfhi(kq.x) * 0.125f); ko.y = pack2(bflo(kq.y) * 0.125f, bfhi(kq.y) * 0.125f);
      ko.z = pack2(bflo(kq.z) * 0.125f, bfhi(kq.z) * 0.125f); ko.w = pack2(bflo(kq.w) * 0.125f, bfhi(kq.w) * 0.125f);
      *(u32x4*)(Ks + s * 72 + d0 + hf * 8) = ko;
      const unsigned vw[4] = {vq.x, vq.y, vq.z, vq.w};
#pragma unroll
      for (int j = 0; j < 4; ++j) { Vt[(d0 + hf * 8 + 2 * j) * 72 + s] = (bf16_t)(vw[j] & 0xffffu); Vt[(d0 + hf * 8 + 2 * j + 1) * 72 + s] = (bf16_t)(vw[j] >> 16); }
    }
  }
  f32x4 hs[4];
#pragma unroll
  for (int ns = 0; ns < 4; ++ns) hs[ns] = (f32x4){0.f, 0.f, 0.f, 0.f};
#pragma unroll 1
  for (int dir = 0; dir < 2; ++dir) {
    const int c = chain_slot(dir, part, tc), chain = (b * 4 + h) * 2 + dir;
    const float m_in = ((const float*)(p.ws + OFF_MLM))[(size_t)(chain * NCH + c) * 32 + 16];
    const float* Cst = (const float*)(p.ws + OFF_MLS) + (size_t)(chain * NCH + c) * 4160;
    __syncthreads();
    if (tid < 64) {
      const int gi = 2 * dir;
      const float ig = GML[(size_t)(row0 + tid) * 16 + gi * 4 + h] + p.ml_gate_bias[l * 16 + gi * 4 + h];
      const float fg = GML[(size_t)(row0 + tid) * 16 + (gi + 1) * 4 + h] + p.ml_gate_bias[l * 16 + (gi + 1) * 4 + h];
      const float lf = logsigm_f(fg);
      const float pre = wave_incl_scan(lf, lane), tot = __shfl(pre, 63);
      fb[tid] = dir ? tot - pre + lf : pre; fi[tid] = ig;
    }
    __syncthreads();
    f32x4 sc[4];
#pragma unroll
    for (int ns = 0; ns < 4; ++ns) {
      f32x4 a = {0.f, 0.f, 0.f, 0.f};
#pragma unroll
      for (int ks = 0; ks < 2; ++ks) a = MFMA16(ld_frag(Qs + (16 * w + l15) * 72 + ks * 32 + g4 * 8), ld_frag(Ks + (16 * ns + l15) * 72 + ks * 32 + g4 * 8), a);
      sc[ns] = a;
    }
    float bi[4], mt[4], rsum[4];
#pragma unroll
    for (int j = 0; j < 4; ++j) {
      const int i = 16 * w + 4 * g4 + j; bi[j] = fb[i];
      float mx = -1e30f;
#pragma unroll
      for (int ns = 0; ns < 4; ++ns) { const int s = 16 * ns + l15; const bool ok = dir ? (s >= i) : (s <= i); const float dm = bi[j] - fb[s] + fi[s]; if (ok) mx = fmaxf(mx, dm); }
      mx = red16_max(mx);
      mt[j] = fmaxf(bi[j] + m_in, mx);
      float rs = 0.f;
#pragma unroll
      for (int ns = 0; ns < 4; ++ns) {
        const int s = 16 * ns + l15; const bool ok = dir ? (s >= i) : (s <= i);
        const float v = ok ? sc[ns][j] * __expf(bi[j] - fb[s] + fi[s] - mt[j]) : 0.f;
        rs += v; Sb[i * 72 + s] = f2bf(v);
      }
      rsum[j] = red16_sum(rs);
    }
    __syncthreads();
    f32x4 qc[5];
#pragma unroll
    for (int ns = 0; ns < 5; ++ns) {
      f32x4 a = {0.f, 0.f, 0.f, 0.f};
      const int e = 16 * ns + l15;
#pragma unroll
      for (int ks = 0; ks < 2; ++ks) {
        bf16x8 bfm;
        if (e <= 64) bfm = frag_from_f32(Cst + e * 64 + ks * 32 + g4 * 8, 1.f); else bfm = mk_frag(0u, 0u, 0u, 0u);
        a = MFMA16(ld_frag(Qs + (16 * w + l15) * 72 + ks * 32 + g4 * 8), bfm, a);
      }
      qc[ns] = a;
    }
    f32x4 nm[4];
#pragma unroll
    for (int ns = 0; ns < 4; ++ns) {
      f32x4 a = {0.f, 0.f, 0.f, 0.f};
#pragma unroll
      for (int ks = 0; ks < 2; ++ks) a = MFMA16(ld_frag(Sb + (16 * w + l15) * 72 + ks * 32 + g4 * 8), ld_frag(Vt + (16 * ns + l15) * 72 + ks * 32 + g4 * 8), a);
      nm[ns] = a;
    }
#pragma unroll
    for (int j = 0; j < 4; ++j) {
      const float wi = __expf(bi[j] + m_in - mt[j]);
      const float qn = __shfl(qc[4][j], lane & 48);
      const float den = rsum[j] + wi * qn;
      const float dd = 1.f / fmaxf(fabsf(den), __expf(-mt[j]));
#pragma unroll
      for (int ns = 0; ns < 4; ++ns) hs[ns][j] += (nm[ns][j] + wi * qc[ns][j]) * dd;
    }
  }
  bf16_t* Y = (bf16_t*)(p.ws + OFF_HY);
#pragma unroll
  for (int j = 0; j < 4; ++j) {
    float ss = 0.f;
#pragma unroll
    for (int ns = 0; ns < 4; ++ns) ss += hs[ns][j] * hs[ns][j];
    ss = red16_sum(ss);
    const float rstd = rsqrtf(ss * (1.f / 64.f) + 1e-6f);
    const int row = row0 + 16 * w + 4 * g4 + j;
#pragma unroll
    for (int ns = 0; ns < 4; ++ns) {
      const int ch = h * 64 + 16 * ns + l15;
      const float o = bf2f(P[(size_t)row * PINP + C_MLO + ch]);
      Y[(size_t)row * 1024 + ch] = f2bf(hs[ns][j] * rstd * p.ml_norm[l * 256 + ch] * sigm_f(o));
    }
  }
  __syncthreads();
}

DI void conv_silu8(const Params& p, int l, const bf16_t* P, int row, bool hp, bool hn, int ch, float* out) {
  const u32x4 c0 = *(const u32x4*)(P + (size_t)row * PINP + C_XBC + ch);
  out[0] = bflo(c0.x); out[1] = bfhi(c0.x); out[2] = bflo(c0.y); out[3] = bfhi(c0.y); out[4] = bflo(c0.z); out[5] = bfhi(c0.z); out[6] = bflo(c0.w); out[7] = bfhi(c0.w);
}
DI void ssd_gates(const Params& p, int l, int dir, int h, int row0, int tid, int lane, float& dt, float& cs, float& tot) {
  const float* DTR = (const float*)(p.ws + OFF_DTR);
  dt = softplus_f(DTR[(size_t)(row0 + tid) * 8 + dir * 4 + h] + p.ssd_dt_bias[l * 8 + dir * 4 + h]);
  const float la = -dt * __expf(p.ssd_a_log[l * 8 + dir * 4 + h]);
  const float pre = wave_incl_scan(la, lane); tot = __shfl(pre, 63);
  cs = dir ? tot - pre + la : pre;
}
DI void ssd_p1(const Params& p, int l, int item, char* smem) {
  const int tid = ltid(), lane = tid & 63, w = __builtin_amdgcn_readfirstlane(tid >> 6), l15 = lane & 15, g4 = lane >> 4;
  const int tcg = item % NCH; int r = item / NCH; const int dir = r & 1; r >>= 1; const int h = r & 3, b = r >> 2;
  int part, tc, row0; chunk_geom(tcg, b, part, tc, row0);
  const int c = chain_slot(dir, part, tc), chain = (b * 4 + h) * 2 + dir, lastc = part ? 3 : 127;
  bf16_t* Xt = (bf16_t*)smem;
  bf16_t* Bt = Xt + 64 * 72;
  float* fs = (float*)(Bt + 128 * 72);
  const bf16_t* P = (const bf16_t*)(p.ws + OFF_P);
  if (tid < 64) {
    float dt, cs, tot; ssd_gates(p, l, dir, h, row0, tid, lane, dt, cs, tot);
    fs[tid] = __expf(tot - cs) * dt;
    if (tid == 0) ((float*)(p.ws + OFF_SSA))[(chain * NCH + c) * 32] = tot;
  }
  __syncthreads();
  const int grp = h >> 1;
  for (int id = tid; id < 64 * 24; id += 256) {
    const int s = id / 24, cc = id % 24;
    const bool hp = !(tc == 0 && s == 0), hn = !(tc == lastc && s == 63);
    float v[8];
    if (cc < 8) { conv_silu8(p, l, P, row0 + s, hp, hn, h * 64 + cc * 8, v); const float wv = fs[s];
#pragma unroll
      for (int j = 0; j < 8; ++j) Xt[(cc * 8 + j) * 72 + s] = f2bf(v[j] * wv); }
    else { const int n0 = (cc - 8) * 8; conv_silu8(p, l, P, row0 + s, hp, hn, 256 + grp * 128 + n0, v);
#pragma unroll
      for (int j = 0; j < 8; ++j) Bt[(n0 + j) * 72 + s] = f2bf(v[j]); }
  }
  __syncthreads();
  float* SS = (float*)(p.ws + OFF_SSDS) + (size_t)(chain * NCH + c) * 8192;
#pragma unroll
  for (int ns = 0; ns < 8; ++ns) {
    f32x4 acc = {0.f, 0.f, 0.f, 0.f};
#pragma unroll
    for (int ks = 0; ks < 2; ++ks) acc = MFMA16(ld_frag(Xt + (16 * w + l15) * 72 + ks * 32 + g4 * 8), ld_frag(Bt + (16 * ns + l15) * 72 + ks * 32 + g4 * 8), acc);
#pragma unroll
    for (int j = 0; j < 4; ++j) SS[(16 * w + 4 * g4 + j) * 128 + 16 * ns + l15] = acc[j];
  }
  __syncthreads();
}
DI void ssd_p2(const Params& p, int item) {
  const int gi = item * 256 + ltid(), chain = gi >> 13, e = gi & 8191;
  float* SS = (float*)(p.ws + OFF_SSDS) + (size_t)chain * NCH * 8192 + e;
  const float* SA = (const float*)(p.ws + OFF_SSA) + (size_t)chain * NCH * 32;
  float S = 0.f;
  for (int c0 = 0; c0 < NCH; c0 += 12) {
    float d[12], a[12];
#pragma unroll
    for (int i = 0; i < 12; ++i) { d[i] = SS[(size_t)(c0 + i) * 8192]; a[i] = SA[(c0 + i) * 32]; }
#pragma unroll
    for (int i = 0; i < 12; ++i) { SS[(size_t)(c0 + i) * 8192] = S; S = __expf(a[i]) * S + d[i]; }
  }
}
DI void ssd_p3(const Params& p, int l, int item, char* smem) {
  const int tid = ltid(), lane = tid & 63, w = __builtin_amdgcn_readfirstlane(tid >> 6), l15 = lane & 15, g4 = lane >> 4;
  const int h = item & 3; const int r = item >> 2; const int tcg = r % NCH, b = r / NCH;
  int part, tc, row0; chunk_geom(tcg, b, part, tc, row0);
  const int lastc = part ? 3 : 127, grp = h >> 1;
  bf16_t* Cm = (bf16_t*)smem;
  bf16_t* Bm = Cm + 64 * 136;
  bf16_t* Xt = Bm + 64 * 136;
  bf16_t* Sb = Xt + 64 * 72;
  float* fcs = (float*)(Sb + 64 * 72);
  float* fdt = fcs + 64;
  const bf16_t* P = (const bf16_t*)(p.ws + OFF_P);
  for (int id = tid; id < 64 * 40; id += 256) {
    const int s = id / 40, cc = id % 40;
    const bool hp = !(tc == 0 && s == 0), hn = !(tc == lastc && s == 63);
    float v[8];
    if (cc < 8) { conv_silu8(p, l, P, row0 + s, hp, hn, h * 64 + cc * 8, v);
#pragma unroll
      for (int j = 0; j < 8; ++j) Xt[(cc * 8 + j) * 72 + s] = f2bf(v[j]); }
    else {
      const int q = cc - 8, isC = q >= 16, n0 = (q & 15) * 8;
      conv_silu8(p, l, P, row0 + s, hp, hn, 256 + isC * 256 + grp * 128 + n0, v);
      u32x4 o; o.x = pack2(v[0], v[1]); o.y = pack2(v[2], v[3]); o.z = pack2(v[4], v[5]); o.w = pack2(v[6], v[7]);
      *(u32x4*)((isC ? Cm : Bm) + s * 136 + n0) = o;
    }
  }
  f32x4 ys[4];
#pragma unroll
  for (int ns = 0; ns < 4; ++ns) ys[ns] = (f32x4){0.f, 0.f, 0.f, 0.f};
#pragma unroll 1
  for (int dir = 0; dir < 2; ++dir) {
    const int c = chain_slot(dir, part, tc), chain = (b * 4 + h) * 2 + dir;
    const float* St = (const float*)(p.ws + OFF_SSDS) + (size_t)(chain * NCH + c) * 8192;
    __syncthreads();
    if (tid < 64) { float dt, cs, tot; ssd_gates(p, l, dir, h, row0, tid, lane, dt, cs, tot); fcs[tid] = cs; fdt[tid] = dt; }
    __syncthreads();
    float ci[4];
#pragma unroll
    for (int j = 0; j < 4; ++j) ci[j] = fcs[16 * w + 4 * g4 + j];
#pragma unroll
    for (int ns = 0; ns < 4; ++ns) {
      f32x4 a = {0.f, 0.f, 0.f, 0.f};
#pragma unroll
      for (int ks = 0; ks < 4; ++ks) a = MFMA16(ld_frag(Cm + (16 * w + l15) * 136 + ks * 32 + g4 * 8), ld_frag(Bm + (16 * ns + l15) * 136 + ks * 32 + g4 * 8), a);
      const int s = 16 * ns + l15; const float css = fcs[s], dts = fdt[s];
#pragma unroll
      for (int j = 0; j < 4; ++j) {
        const int i = 16 * w + 4 * g4 + j; const bool ok = dir ? (s >= i) : (s <= i);
        Sb[i * 72 + s] = f2bf(ok ? a[j] * __expf(ci[j] - css) * dts : 0.f);
      }
    }
    __syncthreads();
#pragma unroll
    for (int ns = 0; ns < 4; ++ns) {
      f32x4 a = {0.f, 0.f, 0.f, 0.f}, bq = {0.f, 0.f, 0.f, 0.f};
#pragma unroll
      for (int ks = 0; ks < 2; ++ks) a = MFMA16(ld_frag(Sb + (16 * w + l15) * 72 + ks * 32 + g4 * 8), ld_frag(Xt + (16 * ns + l15) * 72 + ks * 32 + g4 * 8), a);
#pragma unroll
      for (int ks = 0; ks < 4; ++ks) bq = MFMA16(ld_frag(Cm + (16 * w + l15) * 136 + ks * 32 + g4 * 8), frag_from_f32(St + (16 * ns + l15) * 128 + ks * 32 + g4 * 8, 1.f), bq);
#pragma unroll
      for (int j = 0; j < 4; ++j) ys[ns][j] += a[j] + __expf(ci[j]) * bq[j];
    }
  }
  bf16_t* Y = (bf16_t*)(p.ws + OFF_HY); float* SSQ = (float*)(p.ws + OFF_SSQ);
  const float dsk = p.ssd_d[l * 4 + h];
#pragma unroll
  for (int j = 0; j < 4; ++j) {
    const int i = 16 * w + 4 * g4 + j, row = row0 + i; float ss = 0.f;
#pragma unroll
    for (int ns = 0; ns < 4; ++ns) {
      const int pp = 16 * ns + l15;
      const float xv = bf2f(Xt[pp * 72 + i]);
      const float z = bf2f(P[(size_t)row * PINP + C_Z + h * 64 + pp]);
      const float g = (ys[ns][j] + dsk * xv) * silu_f(z);
      ss += g * g; Y[(size_t)row * 1024 + 512 + h * 64 + pp] = f2bf(g);
    }
    ss = red16_sum(ss);
    if (l15 == 0) SSQ[(size_t)h * NROW + row] = ss;
  }
  __syncthreads();
}

struct S5Par { float are, aim, bre[16], bim[16]; };
DI void s5_params(const Params& p, int l, int dir, int g, int n, S5Par& q, float& dtv, float& lre, float& lim) {
  const int ai = ((l * 2 + dir) * 16 + g) * 64 + n;
  lre = fminf(p.s5_a_re[ai], -1e-4f); lim = p.s5_a_im[ai];
  dtv = __expf(p.s5_log_dt[(l * 2 + dir) * 16 + g]);
  const float mag = __expf(lre * dtv), ang = lim * dtv;
  q.are = mag * cosf(ang); q.aim = mag * sinf(ang);
  const float den = lre * lre + lim * lim;
  const float fre = ((q.are - 1.f) * lre + q.aim * lim) / den, fim = (q.aim * lre - (q.are - 1.f) * lim) / den;
  const float* br = p.s5_b_re + ((size_t)(l * 16 + g) * 64 + n) * 16; const float* bi = p.s5_b_im + ((size_t)(l * 16 + g) * 64 + n) * 16;
#pragma unroll
  for (int j = 0; j < 16; ++j) { q.bre[j] = fre * br[j] - fim * bi[j]; q.bim[j] = fre * bi[j] + fim * br[j]; }
}
DI void s5_step(const S5Par& q, const bf16_t* us, int s, float& xr, float& xi) {
  const u32x4 a0 = *(const u32x4*)(us + s * 16), a1 = *(const u32x4*)(us + s * 16 + 8);
  const unsigned uw[8] = {a0.x, a0.y, a0.z, a0.w, a1.x, a1.y, a1.z, a1.w};
  float br = 0.f, bi = 0.f;
#pragma unroll
  for (int j = 0; j < 8; ++j) { const float a = bflo(uw[j]), c = bfhi(uw[j]); br += q.bre[2 * j] * a + q.bre[2 * j + 1] * c; bi += q.bim[2 * j] * a + q.bim[2 * j + 1] * c; }
  const float nr = q.are * xr - q.aim * xi + br, ni = q.are * xi + q.aim * xr + bi;
  xr = nr; xi = ni;
}
DI void s5_p1(const Params& p, int l, int item, char* smem) {
  const int lane = ltid() & 63, wi = item * 4 + __builtin_amdgcn_readfirstlane(ltid() >> 6);
  const int tcg = wi % NCH; int r = wi / NCH; const int dir = r & 1; r >>= 1; const int g = r & 15, b = r >> 4;
  int part, tc, row0; chunk_geom(tcg, b, part, tc, row0);
  const int c = chain_slot(dir, part, tc);
  S5Par q; float dtv, lre, lim; s5_params(p, l, dir, g, lane, q, dtv, lre, lim);
  const bf16_t* up = (const bf16_t*)(p.ws + OFF_P) + (size_t)(row0 + lane) * PINP + C_S5 + g * 16;
  bf16_t* us = (bf16_t*)smem + __builtin_amdgcn_readfirstlane(ltid() >> 6) * 1024;
  *(u32x4*)(us + lane * 16) = *(const u32x4*)up; *(u32x4*)(us + lane * 16 + 8) = *(const u32x4*)(up + 8);
  float xr = 0.f, xi = 0.f;
  for (int st = 0; st < 64; ++st) { const int s = dir ? 63 - st : st; s5_step(q, us, s, xr, xi); }
  float* S = (float*)(p.ws + OFF_S5S) + ((size_t)((b * 16 + g) * 2 + dir) * NCH + c) * 128;
  S[lane] = xr; S[64 + lane] = xi;
}
DI void s5_p2(const Params& p, int l, int item) {
  const int gi = item * 256 + ltid(), n = gi & 63, dir = (gi >> 6) & 1, g = (gi >> 7) & 15, b = gi >> 11;
  const int ai = ((l * 2 + dir) * 16 + g) * 64 + n;
  const float lre = fminf(p.s5_a_re[ai], -1e-4f), lim = p.s5_a_im[ai], dtv = __expf(p.s5_log_dt[(l * 2 + dir) * 16 + g]);
  const float mag = __expf(64.f * lre * dtv), ang = 64.f * (lim * dtv);
  const float ar = mag * cosf(ang), aim = mag * sinf(ang);
  float* S = (float*)(p.ws + OFF_S5S) + (size_t)((b * 16 + g) * 2 + dir) * NCH * 128 + n;
  float xr = 0.f, xi = 0.f;
  for (int c0 = 0; c0 < NCH; c0 += 12) {
    float dr[12], di[12];
#pragma unroll
    for (int i = 0; i < 12; ++i) { dr[i] = S[(c0 + i) * 128]; di[i] = S[(c0 + i) * 128 + 64]; }
#pragma unroll
    for (int i = 0; i < 12; ++i) { S[(c0 + i) * 128] = xr; S[(c0 + i) * 128 + 64] = xi; const float nr = ar * xr - aim * xi + dr[i], ni = ar * xi + aim * xr + di[i]; xr = nr; xi = ni; }
  }
}
DI void s5_p3(const Params& p, int l, int item, char* smem) {
  const int tid = ltid(), lane = tid & 63, w = __builtin_amdgcn_readfirstlane(tid >> 6), l15 = lane & 15, g4 = lane >> 4;
  const int half = item & 1; const int r2 = item >> 1; const int tcg = r2 % NCH, b = r2 / NCH;
  int part, tc, row0; chunk_geom(tcg, b, part, tc, row0);
  bf16_t* xs = (bf16_t*)smem + w * (16 * 136);
  bf16_t* YG = (bf16_t*)(p.ws + OFF_YG);
  const bf16_t* P = (const bf16_t*)(p.ws + OFF_P);
#pragma unroll 1
  for (int gi = 0; gi < 2; ++gi) {
    const int g = half * 8 + w + 4 * gi;
    const bf16_t* up = P + (size_t)(row0 + lane) * PINP + C_S5 + g * 16;
    bf16_t* us = (bf16_t*)smem + 25600 + w * 1024;
    *(u32x4*)(us + lane * 16) = *(const u32x4*)up; *(u32x4*)(us + lane * 16 + 8) = *(const u32x4*)(up + 8);
    f32x4 yt[4];
#pragma unroll
    for (int ib = 0; ib < 4; ++ib) yt[ib] = (f32x4){0.f, 0.f, 0.f, 0.f};
#pragma unroll
    for (int dir = 0; dir < 2; ++dir) {
      S5Par q; float dtv, lre, lim; s5_params(p, l, dir, g, lane, q, dtv, lre, lim);
      const int c = chain_slot(dir, part, tc);
      const float* S = (const float*)(p.ws + OFF_S5S) + ((size_t)((b * 16 + g) * 2 + dir) * NCH + c) * 128;
      float xr = S[lane], xi = S[64 + lane];
      bf16x8 cf[4];
#pragma unroll
      for (int ks = 0; ks < 4; ++ks) {
        const int k = ks * 32 + g4 * 8;
        const float* src = (k < 64 ? p.s5_c_re : p.s5_c_im) + ((size_t)(l * 16 + g) * 16 + l15) * 64 + (k & 63);
        cf[ks] = frag_from_f32(src, k < 64 ? 1.f : -1.f);
      }
#pragma unroll
      for (int blk = 0; blk < 4; ++blk) {
        asm volatile("s_waitcnt lgkmcnt(0)" ::: "memory");
#pragma unroll 4
        for (int st = 0; st < 16; ++st) {
          const int step = blk * 16 + st, s = dir ? 63 - step : step;
          s5_step(q, us, s, xr, xi);
          xs[(s & 15) * 136 + lane] = f2bf(xr); xs[(s & 15) * 136 + 64 + lane] = f2bf(xi);
        }
        asm volatile("s_waitcnt lgkmcnt(0)" ::: "memory");
        f32x4 a = {0.f, 0.f, 0.f, 0.f};
#pragma unroll
        for (int ks = 0; ks < 4; ++ks) a = MFMA16(ld_frag(xs + l15 * 136 + ks * 32 + g4 * 8), cf[ks], a);
        const int ib = dir ? 3 - blk : blk;
        yt[ib] += a;
      }
    }
#pragma unroll
    for (int ib = 0; ib < 4; ++ib)
#pragma unroll
      for (int j = 0; j < 4; ++j) {
        const int tok = 16 * ib + 4 * g4 + j, ch = g * 16 + l15;
        const float u = bf2f(P[(size_t)(row0 + tok) * PINP + C_S5 + ch]);
        YG[(size_t)(row0 + tok) * 256 + ch] = f2bf(gelu_tanh_f(yt[ib][j] + p.s5_d[l * 256 + ch] * u));
      }
  }
  __syncthreads();
}
DI void glu_item(const Params& p, int l, int item, char* smem) {
  const int mt = item >> 1, nt = item & 1;
  const bf16_t* YG = (const bf16_t*)(p.ws + OFF_YG); bf16_t* Y = (bf16_t*)(p.ws + OFF_HY);
  gemm_tile<0, 0>(YG, 256, (const bf16_t*)(p.ws + OFF_WGLU) + (size_t)l * 256 * 256, 256, 256, mt * 128, nt * 128, smem, nullptr,
                  [&](int row, int col, f32x4 v) {
                    const u32x2 yv = *(const u32x2*)(YG + (size_t)row * 256 + col);
                    f32x4 o; o[0] = bflo(yv.x) * sigm_f(v[0]); o[1] = bfhi(yv.x) * sigm_f(v[1]); o[2] = bflo(yv.y) * sigm_f(v[2]); o[3] = bfhi(yv.y) * sigm_f(v[3]);
                    store_bf4(Y + (size_t)row * 1024 + 768 + col, o);
                  });
}

DI void outproj_item(const Params& p, int l, int item, char* smem) {
  const int mt = item >> 3, nt = item & 7;
  const float* MOD = (const float*)(p.ws + OFF_MOD);
  gemm_tile<1, 2>((const bf16_t*)(p.ws + OFF_HY), 1024, (const bf16_t*)(p.ws + OFF_WOUT) + (size_t)l * 1024 * 1024, 1024, 1024, mt * 128, nt * 128, smem, (const float*)(p.ws + OFF_SSQ),
               [&](int row, int col, f32x4 v) {
                 const int s = row < NLAT ? row / T : 2;
                 const f32x4 gt = *(const f32x4*)(MOD + (size_t)(l * 3 + s) * 6144 + 2048 + col);
                 float* xp = row < NLAT ? p.xb + (size_t)row * 1024 + col : (float*)(p.ws + OFF_CTX) + (size_t)(row - NLAT) * 1024 + col;
                 *(f32x4*)xp = *(f32x4*)xp + gt * v;
               });
}
DI void ffnup_item(const Params& p, int l, int item, char* smem) {
  const int mtile = item / 44, nt = item % 44;
  int seq0, slen, ti;
  if (mtile < 132) { seq0 = (mtile / 66) * T; slen = T; ti = mtile % 66; }
  else { const int j = mtile - 132; seq0 = NLAT + (j / 3) * TC; slen = TC; ti = j % 3; }
  const int m0 = seq0 + 126 * ti - 1, n0 = nt * 128;
  bf16_t* ACT = (bf16_t*)(p.ws + OFF_R);
  bf16_t* Ts = (bf16_t*)smem;
  auto epi = [&](int row, int col, f32x4 v) {
    const int lr = row - m0, c = col - n0, t = 126 * ti - 1 + lr;
    if (c >= 64 && (t < 0 || t >= slen)) v = (f32x4){0.f, 0.f, 0.f, 0.f};
    store_bf4(Ts + lr * 136 + c, v);
  };
  gemm_tile<0, 0, decltype(epi), 1>((const bf16_t*)(p.ws + OFF_HY), 1024, (const bf16_t*)(p.ws + OFF_WUP) + (size_t)l * 5632 * 1024, 1024, 1024, m0, n0, smem, nullptr, epi, seq0, seq0 + slen - 1);
  __syncthreads();
  {
    const int tid = ltid();
    const float* cw = p.ffn_conv_w + (size_t)l * 3 * DFF + nt * 64;
#pragma unroll
    for (int q = 0; q < 4; ++q) {
      const int id = tid + 256 * q, lr = 1 + (id >> 3), c8 = (id & 7) * 8, t = 126 * ti - 1 + lr;
      if (id < 1008 && t < slen) {
        const u32x4 uu = *(const u32x4*)(Ts + lr * 136 + c8), gm = *(const u32x4*)(Ts + (lr - 1) * 136 + 64 + c8), g0 = *(const u32x4*)(Ts + lr * 136 + 64 + c8), gn = *(const u32x4*)(Ts + (lr + 1) * 136 + 64 + c8);
        const float uf[8] = {bflo(uu.x), bfhi(uu.x), bflo(uu.y), bfhi(uu.y), bflo(uu.z), bfhi(uu.z), bflo(uu.w), bfhi(uu.w)};
        const float a[8] = {bflo(gm.x), bfhi(gm.x), bflo(gm.y), bfhi(gm.y), bflo(gm.z), bfhi(gm.z), bflo(gm.w), bfhi(gm.w)};
        const float m[8] = {bflo(g0.x), bfhi(g0.x), bflo(g0.y), bfhi(g0.y), bflo(g0.z), bfhi(g0.z), bflo(g0.w), bfhi(g0.w)};
        const float n[8] = {bflo(gn.x), bfhi(gn.x), bflo(gn.y), bfhi(gn.y), bflo(gn.z), bfhi(gn.z), bflo(gn.w), bfhi(gn.w)};
        float o[8];
#pragma unroll
        for (int j = 0; j < 8; ++j) o[j] = silu_f(cw[c8 + j] * a[j] + cw[DFF + c8 + j] * m[j] + cw[2 * DFF + c8 + j] * n[j]) * uf[j];
        u32x4 ov; ov.x = pack2(o[0], o[1]); ov.y = pack2(o[2], o[3]); ov.z = pack2(o[4], o[5]); ov.w = pack2(o[6], o[7]);
        *(u32x4*)(ACT + (size_t)(seq0 + t) * DFF + nt * 64 + c8) = ov;
      }
    }
  }
  __syncthreads();
}
DI void ffndown_item(const Params& p, int l, int item, char* smem) {
  const int mt = item >> 3, nt = item & 7;
  const float* MOD = (const float*)(p.ws + OFF_MOD);
  gemm_tile<0, 2>((const bf16_t*)(p.ws + OFF_R), DFF, (const bf16_t*)(p.ws + OFF_WDN) + (size_t)l * 1024 * 2816, 2816, 2816, mt * 128, nt * 128, smem, nullptr,
               [&](int row, int col, f32x4 v) {
                 const int s = row < NLAT ? row / T : 2;
                 const f32x4 gt = *(const f32x4*)(MOD + (size_t)(l * 3 + s) * 6144 + 5120 + col);
                 float* xp = row < NLAT ? p.xb + (size_t)row * 1024 + col : (float*)(p.ws + OFF_CTX) + (size_t)(row - NLAT) * 1024 + col;
                 *(f32x4*)xp = *(f32x4*)xp + gt * v;
               });
}
DI void final_item(const Params& p, int item) {
  const int lane = ltid() & 63, w = __builtin_amdgcn_readfirstlane(ltid() >> 6), row = item * 4 + w;
  float* x = p.xb + (size_t)row * 1024;
  float4 v[4]; float ss = 0.f;
#pragma unroll
  for (int i = 0; i < 4; ++i) { v[i] = *(const float4*)(x + (i * 64 + lane) * 4); ss += v[i].x * v[i].x + v[i].y * v[i].y + v[i].z * v[i].z + v[i].w * v[i].w; }
  ss = wave_sum(ss);
  const float rstd = rsqrtf(ss * (1.f / 1024.f) + 1e-6f);
#pragma unroll
  for (int i = 0; i < 4; ++i) {
    const int k = (i * 64 + lane) * 4; const float4 g = *(const float4*)(p.final_norm + k);
    float4 o; o.x = v[i].x * rstd * g.x; o.y = v[i].y * rstd * g.y; o.z = v[i].z * rstd * g.z; o.w = v[i].w * rstd * g.w;
    *(float4*)(x + k) = o;
  }
}

constexpr int PPL = 10;
constexpr int N_PHASES = 2 + NL * PPL;
#define FOR_ITEMS(n) for (int it = blockIdx.x; it < (n); it += gridDim.x)

DI void run_phase(const Params& p, int ph, char* smem) {
  if (ph == 0) {
    FOR_ITEMS(P0_MOD) p0_item(p, it, smem);
    p0_transposes(p, smem);
    for (int it = P0_MOD + P0_TR + blockIdx.x; it < P0_ITEMS; it += gridDim.x) p0_item(p, it, smem);
    return;
  }
  if (ph == N_PHASES - 1) { FOR_ITEMS(NLAT / 4) final_item(p, it); return; }
  const int l = (ph - 1) / PPL, k = (ph - 1) % PPL;
  const int mtiles = (l == NL - 1) ? 128 : 132;
  switch (k) {
    case 0: FOR_ITEMS(NROW / 4) norm_item(p, l, 0, it); break;
    case 1: FOR_ITEMS(138 * 22) gemm_in_item(p, l, it, smem); break;
    case 2: FOR_ITEMS(2112) s5_p1(p, l, it, smem); break;
    case 3: {
      constexpr int n0 = 2112, n1 = n0 + 2112, n2 = n1 + 528, n3 = n2 + 396, n5 = n3 + 66;
      FOR_ITEMS(n5 + 16) {
        if (it < n0) ssd_p1(p, l, it, smem);
        else if (it < n1) mlstm_p1(p, l, it - n0, smem);
        else if (it < n2) kvproj_item(p, l, it - n1, smem);
        else if (it < n3) qproj_item(p, l, it - n2, smem);
        else if (it < n5) ropek_item(p, it - n3);
        else s5_p2(p, l, it - n5);
      }
    } break;
    case 4: {
      constexpr int n0 = 528, n1 = n0 + 512, n2 = n1 + 260;
      FOR_ITEMS(n2) { if (it < n0) s5_p3(p, l, it, smem); else if (it < n1) ssd_p2(p, it - n0); else mlstm_p2(p, it - n1); }
    } break;
    case 5: {
      constexpr int n0 = 528, n2 = n0 + 1056, n3x = n2 + 1056, n3 = n3x + 264;
      const bool late = blockIdx.x >= (gridDim.x >> 1);
      if (!late) { FOR_ITEMS(n0) attn_item(p, it, smem); }
      FOR_ITEMS(n3) {
        if (it < n0) continue;
        if (it < n2) ssd_p3(p, l, it - n0, smem);
        else if (it < n3x) mlstm_p3(p, l, it - n2, smem);
        else glu_item(p, l, it - n3x, smem);
      }
      if (late) { FOR_ITEMS(n0) attn_item(p, it, smem); }
    } break;
    case 6: FOR_ITEMS(mtiles * 8) outproj_item(p, l, it, smem); break;
    case 7: FOR_ITEMS(mtiles * 32) norm_item(p, l, 1, it); break;
    case 8: FOR_ITEMS(((l == NL - 1) ? 132 : 138) * 44) ffnup_item(p, l, it, smem); break;
    case 9: FOR_ITEMS(mtiles * 8) ffndown_item(p, l, it, smem); break;
  }
}

#ifndef HASH_LO
#define HASH_LO OFF_MOD
#define HASH_HI WS_NEED
#endif
#ifndef PROBE_N
#define PROBE_N 0
#endif
DI void hash_dump(const Params& p) {
  const size_t NOUT = (size_t)NLAT * 1024, nw = (HASH_HI - HASH_LO) / 4;
  const unsigned* wsw = (const unsigned*)(p.ws + HASH_LO);
  for (size_t i = (size_t)blockIdx.x * 256 + threadIdx.x; i < NOUT; i += (size_t)gridDim.x * 256) {
    unsigned h = 12345u;
    for (size_t j = i; j < nw; j += NOUT) h = h * 1664525u + wsw[j];
    p.xb[i] = (float)(h & 0xFFFFFFu);
  }
}

#define XB_TMO      128
#define XB_XCNT(j)  (256  + 64 * (j))
#define XB_XSUB(j)  (1280 + 64 * (j))
#define XB_XGEN(j)  (2304 + 64 * (j))
#define XB_TOP      3328
#define XB_TOPGEN   3392
#define XCD_BAR_WORDS 3456
#define XB_SPIN_CAP (1u << 22)
#define LAS __attribute__((address_space(3)))
DI unsigned xb_ld(unsigned* p) { return __hip_atomic_load(p, __ATOMIC_RELAXED, __HIP_MEMORY_SCOPE_AGENT); }
DI unsigned xb_add(unsigned* p, unsigned v) { return __hip_atomic_fetch_add(p, v, __ATOMIC_RELAXED, __HIP_MEMORY_SCOPE_AGENT); }
DI unsigned xb_xcc_id() { return (unsigned)__builtin_amdgcn_s_getreg((3 << 11) | 20) & 0xFu; }
#define XB_SPIN(cond, bar) do { unsigned _sp = 0; while (cond) { __builtin_amdgcn_s_sleep(1); \
    if ((++_sp & 255u) == 0u) { if (xb_ld(&(bar)[XB_TMO])) break; if (_sp > XB_SPIN_CAP) { atomicAdd(&(bar)[XB_TMO], 1u); break; } } } } while (0)
struct XcdBarrier { unsigned* bar; unsigned x; volatile LAS unsigned* st; };
DI XcdBarrier xcd_barrier_post(unsigned* bar, volatile LAS unsigned* st) {
  XcdBarrier b; b.bar = bar; b.x = xb_xcc_id(); b.st = st;
  if (threadIdx.x == 0) (void)xb_add(&bar[XB_XCNT(b.x)], 1u);
  return b;
}
DI void xcd_barrier_complete(unsigned* bar, unsigned x, unsigned& nloc, unsigned& nx) {
  const unsigned G = gridDim.x;
  unsigned sum, cnt, mine, sp = 0u;
  for (;;) {
    sum = 0u; cnt = 0u; mine = 0u;
#pragma unroll
    for (unsigned j = 0; j < 16; ++j) { const unsigned c = xb_ld(&bar[XB_XCNT(j)]); sum += c; cnt += (c > 0u) ? 1u : 0u; mine = (j == x) ? c : mine; }
    if (sum == G) break;
    __builtin_amdgcn_s_sleep(1);
    if ((++sp & 255u) == 0u) { if (xb_ld(&bar[XB_TMO])) break; if (sp > XB_SPIN_CAP) { atomicAdd(&bar[XB_TMO], 1u); break; } }
  }
  nloc = mine > 0u ? mine : 1u; nx = cnt > 0u ? cnt : 1u;
}
DI void xcd_barrier(const XcdBarrier& b) {
  asm volatile("s_waitcnt vmcnt(0)" ::: "memory");
  __syncthreads();
  if (threadIdx.x == 0) {
    unsigned* bar = b.bar;
    __builtin_amdgcn_s_waitcnt(0);
    unsigned nloc = b.st[0], nx = b.st[1];
    if (nloc == 0u) { xcd_barrier_complete(bar, b.x, nloc, nx); b.st[0] = nloc; b.st[1] = nx; }
    const unsigned old = xb_add(&bar[XB_XSUB(b.x)], 1u);
    const unsigned gen = old / nloc;
    if (old + 1u == (gen + 1u) * nloc) {
      __builtin_amdgcn_fence(__ATOMIC_RELEASE, "agent");
      asm volatile("s_waitcnt vmcnt(0)" ::: "memory");
      const unsigned og = xb_add(&bar[XB_TOP], 1u);
      const unsigned tg = og / nx;
      if (og + 1u == (tg + 1u) * nx) xb_add(&bar[XB_TOPGEN], 1u);
      else XB_SPIN(xb_ld(&bar[XB_TOPGEN]) == tg, bar);
      __builtin_amdgcn_fence(__ATOMIC_ACQUIRE, "agent");
      xb_add(&bar[XB_XGEN(b.x)], 1u);
      asm volatile("s_waitcnt vmcnt(0)" ::: "memory");
    } else {
      XB_SPIN(xb_ld(&bar[XB_XGEN(b.x)]) == gen, bar);
      __builtin_amdgcn_fence(__ATOMIC_ACQUIRE, "agent");
      asm volatile("s_waitcnt vmcnt(0)" ::: "memory");
    }
  }
  __syncthreads();
}
constexpr int SMEM_BYTES = 73728 + 512;
__global__ void __launch_bounds__(256, 2) trunk_fwd(Params p) {
  extern __shared__ __attribute__((aligned(16))) char smem[];
  __shared__ uint4 xb_words;
  cg::grid_group grid = cg::this_grid();
  if (threadIdx.x == 0) xb_words = make_uint4(0u, 0u, 0u, 0u);
  __syncthreads();
  XcdBarrier xb = xcd_barrier_post((unsigned*)(p.ws + OFF_BAR), (volatile LAS unsigned*)&xb_words);
  for (int ph = p.ph_lo; ph < p.ph_hi; ++ph) {
    run_phase(p, ph, smem);
    if (ph + 1 < p.ph_hi) { if (ph == p.ph_lo) grid.sync(); else xcd_barrier(xb); }
  }
}

__global__ void __launch_bounds__(256) hash_kernel(Params p) { hash_dump(p); }

extern "C" void kernel_launch(void* const* d_in, const int* in_sizes, int n_in, void* d_out, int out_size, void* d_ws, size_t ws_size, hipStream_t stream) {
  static int grid_blocks = 0;
  if (!grid_blocks) {
    int dev = 0, cus = 0, per_cu = 0;
    hipGetDevice(&dev);
    hipDeviceGetAttribute(&cus, hipDeviceAttributeMultiprocessorCount, dev);
    if (hipFuncSetAttribute((const void*)trunk_fwd, hipFuncAttributeMaxDynamicSharedMemorySize, SMEM_BYTES) != hipSuccess) fprintf(stderr, "hipFuncSetAttribute(%d B LDS) failed\n", SMEM_BYTES);
    hipOccupancyMaxActiveBlocksPerMultiprocessor(&per_cu, trunk_fwd, 256, SMEM_BYTES);
    if (per_cu > 2) per_cu = 2;
    grid_blocks = cus * per_cu;
  }
  if (ws_size < OFF_BAR + XCD_BAR_WORDS * 4) { fprintf(stderr, "workspace too small: %zu < %zu\n", ws_size, (size_t)WS_NEED); return; }
  Params p{};
  const float** fp = (const float**)&p;
  for (int i = 0; i < 35; ++i) fp[i] = (const float*)d_in[i];
  p.xb = (float*)d_out; p.ws = (char*)d_ws;
#if MULTI_LAUNCH
#if PROBE_N
  for (int ph = 0; ph < PROBE_N; ++ph) { p.ph_lo = ph; p.ph_hi = ph + 1; hipLaunchKernelGGL(trunk_fwd, dim3(grid_blocks), dim3(256), 0, stream, p); }
  hipLaunchKernelGGL(hash_kernel, dim3(grid_blocks), dim3(256), 0, stream, p);
#else
  for (int ph = 0; ph < N_PHASES; ++ph) { p.ph_lo = ph; p.ph_hi = ph + 1; hipLaunchKernelGGL(trunk_fwd, dim3(grid_blocks), dim3(256), 0, stream, p); }
#endif
#else
  p.ph_lo = 0; p.ph_hi = N_PHASES;
  hipMemsetAsync((char*)d_ws + OFF_BAR, 0, XCD_BAR_WORDS * 4, stream);
  void* args[] = {&p};
  hipError_t e = hipLaunchCooperativeKernel((void*)trunk_fwd, dim3(grid_blocks), dim3(256), args, SMEM_BYTES, stream);
  if (e != hipSuccess) fprintf(stderr, "cooperative launch failed: %s (grid %d)\n", hipGetErrorString(e), grid_blocks);
#endif
}
```

```cpp
#include <hip/hip_runtime.h>
#include <hip/hip_cooperative_groups.h>
#include <cstdio>
#include <cstdint>
namespace cg = cooperative_groups;

#ifndef PROBE_MASK
#define PROBE_MASK 63
#endif
#ifndef ZERO_FILL
#define ZERO_FILL 0
#endif
#ifndef MULTI_LAUNCH
#define MULTI_LAUNCH 0
#endif

typedef unsigned short bf16_t;
typedef short bf16x8 __attribute__((ext_vector_type(8)));
typedef float f32x4 __attribute__((ext_vector_type(4)));
typedef unsigned u32x4 __attribute__((ext_vector_type(4)));
typedef unsigned u32x2 __attribute__((ext_vector_type(2)));
#define DI __device__ __forceinline__
#define MFMA16(a, b, c) __builtin_amdgcn_mfma_f32_16x16x32_bf16((a), (b), (c), 0, 0, 0)

constexpr int NB = 2, T = 8192, TC = 256, NL = 4;
constexpr int NLAT = NB * T, NROW = NLAT + NB * TC;
constexpr int TALL = T + TC;
constexpr int PINP = 2816;
constexpr int C_MLQ = 0, C_MLK = 256, C_MLV = 512, C_MLO = 768, C_CQ = 1040, C_CKV = 1296, C_KR = 1424,
              C_Z = 1456, C_XBC = 1712, C_S5 = 2488;
constexpr int NCH = 132;
constexpr int DFF = 2816;

constexpr size_t SZ_WIN = (size_t)NL * 2816 * 1024 * 2, SZ_WUQ = (size_t)NL * 384 * 256 * 2, SZ_WUKV = (size_t)NL * 512 * 128 * 2,
                 SZ_WGLU = (size_t)NL * 256 * 256 * 2, SZ_WOUT = (size_t)NL * 1024 * 1024 * 2, SZ_WUP = (size_t)NL * 5632 * 1024 * 2,
                 SZ_WDN = (size_t)NL * 1024 * 2816 * 2, SZ_MOD = (size_t)NL * 3 * 6144 * 4, SZ_CTX = (size_t)512 * 1024 * 4,
                 SZ_HY = (size_t)NROW * 1024 * 2, SZ_GML = (size_t)NROW * 16 * 4, SZ_DTR = (size_t)NROW * 8 * 4, SZ_SSQ = (size_t)NROW * 4 * 4,
                 SZ_QRAW = (size_t)NROW * 384 * 2, SZ_KH = (size_t)NB * 4 * TALL * 64 * 2 + (size_t)NB * TALL * 32 * 2, SZ_VT = (size_t)NB * 4 * 64 * TALL * 2,
                 SZ_S5S = (size_t)NB * 16 * 2 * NCH * 128 * 4, SZ_MLM = (size_t)16 * NCH * 32 * 4, SZ_SSA = (size_t)16 * NCH * 32 * 4,
                 SZ_P = (size_t)NROW * PINP * 2, SZ_MLS = (size_t)16 * NCH * 4160 * 4, SZ_SSDS = (size_t)16 * NCH * 8192 * 4;
constexpr size_t OFF_WIN = 0, OFF_WUQ = OFF_WIN + SZ_WIN, OFF_WUKV = OFF_WUQ + SZ_WUQ, OFF_WGLU = OFF_WUKV + SZ_WUKV,
                 OFF_WOUT = OFF_WGLU + SZ_WGLU, OFF_WUP = OFF_WOUT + SZ_WOUT, OFF_WDN = OFF_WUP + SZ_WUP, OFF_MOD = OFF_WDN + SZ_WDN,
                 OFF_CTX = OFF_MOD + SZ_MOD, OFF_HY = OFF_CTX + SZ_CTX, OFF_GML = OFF_HY + SZ_HY, OFF_DTR = OFF_GML + SZ_GML,
                 OFF_SSQ = OFF_DTR + SZ_DTR, OFF_QRAW = OFF_SSQ + SZ_SSQ, OFF_KH = OFF_QRAW + SZ_QRAW, OFF_VT = OFF_KH + SZ_KH,
                 OFF_S5S = OFF_VT + SZ_VT, OFF_MLM = OFF_S5S + SZ_S5S, OFF_SSA = OFF_MLM + SZ_MLM,
                 OFF_R = ((OFF_SSA + SZ_SSA + 255) / 256) * 256, OFF_P = OFF_R, OFF_MLS = OFF_P + SZ_P, OFF_SSDS = OFF_MLS + SZ_MLS,
                 WS_NEED = OFF_SSDS + SZ_SSDS;
static_assert((size_t)NROW * 5632 * 2 <= SZ_P + SZ_MLS + SZ_SSDS, "UG overlay");

constexpr size_t OFF_KR = OFF_KH + (size_t)NB * 4 * TALL * 64 * 2;
constexpr size_t OFF_YG = ((WS_NEED + 255) / 256) * 256;
constexpr size_t OFF_BAR = OFF_YG + (size_t)NROW * 256 * 2;
struct Params {
  const float *x, *c, *ctx, *c_ctx, *w_mod, *b_mod, *norm1, *norm2, *w_in, *ml_gate_bias, *ml_norm, *mla_q_norm, *mla_kv_norm,
      *mla_w_uq, *mla_w_ukv, *ssd_conv_w, *ssd_conv_b, *ssd_a_log, *ssd_dt_bias, *ssd_d, *ssd_norm, *s5_a_re, *s5_a_im, *s5_log_dt,
      *s5_b_re, *s5_b_im, *s5_c_re, *s5_c_im, *s5_d, *s5_w_glu, *w_out, *ffn_w_up, *ffn_conv_w, *ffn_w_down, *final_norm;
  float* xb;
  char* ws;
  int ph_lo, ph_hi;
};

typedef __bf16 hbf16x2 __attribute__((ext_vector_type(2)));
typedef float f32x2 __attribute__((ext_vector_type(2)));
DI bf16_t f2bf(float x) { return __builtin_bit_cast(bf16_t, (__bf16)x); }
DI float bf2f(bf16_t v) { return __uint_as_float(((unsigned)v) << 16); }
DI unsigned pack2(float lo, float hi) { f32x2 v = {lo, hi}; return __builtin_bit_cast(unsigned, __builtin_convertvector(v, hbf16x2)); }
DI float bflo(unsigned w) { return __uint_as_float(w << 16); }
DI float bfhi(unsigned w) { return __uint_as_float(w & 0xffff0000u); }
DI float silu_f(float x) { return x / (1.f + __expf(-x)); }
DI float sigm_f(float x) { return 1.f / (1.f + __expf(-x)); }
DI float softplus_f(float x) { return fmaxf(x, 0.f) + log1pf(__expf(-fabsf(x))); }
DI float logsigm_f(float x) { return fminf(x, 0.f) - log1pf(__expf(-fabsf(x))); }
DI float gelu_tanh_f(float x) { float u = 0.7978845608f * (x + 0.044715f * x * x * x); return x * sigm_f(2.f * u); }
DI float wave_sum(float v) { for (int o = 32; o; o >>= 1) v += __shfl_xor(v, o); return v; }
DI float wave_max(float v) { for (int o = 32; o; o >>= 1) v = fmaxf(v, __shfl_xor(v, o)); return v; }
DI float wave_incl_scan(float v, int lane) { for (int o = 1; o < 64; o <<= 1) { float t = __shfl_up(v, o); if (lane >= o) v += t; } return v; }
DI float red16_max(float v) { v = fmaxf(v, __shfl_xor(v, 1)); v = fmaxf(v, __shfl_xor(v, 2)); v = fmaxf(v, __shfl_xor(v, 4)); v = fmaxf(v, __shfl_xor(v, 8)); return v; }
DI float red16_sum(float v) { v += __shfl_xor(v, 1); v += __shfl_xor(v, 2); v += __shfl_xor(v, 4); v += __shfl_xor(v, 8); return v; }
DI bf16x8 ld_frag(const bf16_t* p) { return *(const bf16x8*)p; }
DI bf16x8 mk_frag(unsigned a, unsigned b, unsigned c, unsigned d) { u32x4 u = {a, b, c, d}; return __builtin_bit_cast(bf16x8, u); }
DI bf16x8 frag_from_f32(const float* p, float sgn) {
  float4 a = *(const float4*)p, b = *(const float4*)(p + 4);
  return mk_frag(pack2(a.x * sgn, a.y * sgn), pack2(a.z * sgn, a.w * sgn), pack2(b.x * sgn, b.y * sgn), pack2(b.z * sgn, b.w * sgn));
}
DI int ltid() { int t = threadIdx.x; asm volatile("" : "+v"(t)); return t; }
DI int row_of(int b, int part, int t) { return part ? NLAT + b * TC + t : b * T + t; }

DI void tr_tile(const float* __restrict__ src, int K, int N, bf16_t* __restrict__ dst, const float* gain, int glo, int ghi, int tk, int tn, float* tile, int drow0 = -1) {
  const int tid = ltid(), c4 = tid & 15, rq = tid >> 4;
  const bool vec = (N & 3) == 0;
#pragma unroll
  for (int rr = 0; rr < 4; ++rr) {
    const int r = rr * 16 + rq, k = tk * 64 + r, n = tn * 64 + c4 * 4;
    float4 v;
    if (vec && n + 3 < N) v = *(const float4*)(src + (size_t)k * N + n);
    else { v.x = n < N ? src[(size_t)k * N + n] : 0.f; v.y = n + 1 < N ? src[(size_t)k * N + n + 1] : 0.f; v.z = n + 2 < N ? src[(size_t)k * N + n + 2] : 0.f; v.w = n + 3 < N ? src[(size_t)k * N + n + 3] : 0.f; }
    if (gain && k >= glo && k < ghi) { const float g = gain[k - glo]; v.x *= g; v.y *= g; v.z *= g; v.w *= g; }
    *(float4*)(tile + r * 68 + c4 * 4) = v;
  }
  __syncthreads();
#pragma unroll
  for (int q = 0; q < 2; ++q) {
    const int id = tid + 256 * q, n = id >> 3, k0 = (id & 7) * 8;
    u32x4 o;
    o.x = pack2(tile[(k0 + 0) * 68 + n], tile[(k0 + 1) * 68 + n]); o.y = pack2(tile[(k0 + 2) * 68 + n], tile[(k0 + 3) * 68 + n]);
    o.z = pack2(tile[(k0 + 4) * 68 + n], tile[(k0 + 5) * 68 + n]); o.w = pack2(tile[(k0 + 6) * 68 + n], tile[(k0 + 7) * 68 + n]);
    *(u32x4*)(dst + (size_t)((drow0 >= 0 ? drow0 : tn * 64) + n) * K + tk * 64 + k0) = o;
  }
  __syncthreads();
}

constexpr int TR_PER_LAYER = 3128, P0_TR = NL * TR_PER_LAYER, P0_MOD = NL * 96, P0_CPX = NLAT * 1024 / 4096, P0_CPC = 512 * 1024 / 4096;
constexpr int P0_ZERO = (int)((WS_NEED - OFF_HY + 65535) / 65536);
constexpr int P0_ITEMS = P0_TR + P0_MOD + P0_CPX + P0_CPC + (ZERO_FILL ? P0_ZERO : 0);

DI void p0_item(const Params& p, int item, char* smem) {
  const int tid = ltid();
  if (item < P0_MOD) {
    const int l = item / 96, cb = item % 96, cl = tid & 63, kq = tid >> 6;
    float* sv = (float*)smem;
    float* red = sv + 3072;
    for (int i = tid; i < 1024; i += 256) { sv[i] = silu_f(p.c[i]); sv[1024 + i] = silu_f(p.c[1024 + i]); sv[2048 + i] = silu_f(p.c_ctx[i]); }
    __syncthreads();
    const int col = cb * 64 + cl; const float* W = p.w_mod + (size_t)l * 1024 * 6144 + col;
    float a0 = 0.f, a1 = 0.f, a2 = 0.f;
#pragma unroll 16
    for (int k = kq * 256; k < kq * 256 + 256; ++k) { const float w = W[(size_t)k * 6144]; a0 += sv[k] * w; a1 += sv[1024 + k] * w; a2 += sv[2048 + k] * w; }
    red[(kq * 3 + 0) * 64 + cl] = a0; red[(kq * 3 + 1) * 64 + cl] = a1; red[(kq * 3 + 2) * 64 + cl] = a2;
    __syncthreads();
    if (tid < 192) {
      const int s = tid >> 6; const float bm = p.b_mod[l * 6144 + col];
      const float v = red[(0 * 3 + s) * 64 + cl] + red[(1 * 3 + s) * 64 + cl] + red[(2 * 3 + s) * 64 + cl] + red[(3 * 3 + s) * 64 + cl] + bm;
      ((float*)(p.ws + OFF_MOD))[(size_t)(l * 3 + s) * 6144 + col] = v;
    }
    __syncthreads();
    return;
  }
  item -= P0_MOD;
  if (item < P0_TR) {
    const int l = item / TR_PER_LAYER; int t = item % TR_PER_LAYER; float* tile = (float*)smem;
    if (t < 704) { tr_tile(p.w_in + (size_t)l * 1024 * 2744, 1024, 2744, (bf16_t*)(p.ws + OFF_WIN) + (size_t)l * 2816 * 1024, nullptr, 0, 0, t / 44, t % 44, tile); return; }
    t -= 704;
    if (t < 24) { tr_tile(p.mla_w_uq + (size_t)l * 256 * 384, 256, 384, (bf16_t*)(p.ws + OFF_WUQ) + (size_t)l * 384 * 256, p.mla_q_norm + l * 256, 0, 256, t / 6, t % 6, tile); return; }
    t -= 24;
    if (t < 16) { tr_tile(p.mla_w_ukv + (size_t)l * 128 * 512, 128, 512, (bf16_t*)(p.ws + OFF_WUKV) + (size_t)l * 512 * 128, p.mla_kv_norm + l * 128, 0, 128, t / 8, t % 8, tile); return; }
    t -= 16;
    if (t < 16) { tr_tile(p.s5_w_glu + (size_t)l * 256 * 256, 256, 256, (bf16_t*)(p.ws + OFF_WGLU) + (size_t)l * 256 * 256, nullptr, 0, 0, t / 4, t % 4, tile); return; }
    t -= 16;
    if (t < 256) { tr_tile(p.w_out + (size_t)l * 1024 * 1024, 1024, 1024, (bf16_t*)(p.ws + OFF_WOUT) + (size_t)l * 1024 * 1024, p.ssd_norm + l * 256, 512, 768, t / 16, t % 16, tile); return; }
    t -= 256;
    if (t < 1408) { tr_tile(p.ffn_w_up + (size_t)l * 1024 * 5632, 1024, 5632, (bf16_t*)(p.ws + OFF_WUP) + (size_t)l * 5632 * 1024, nullptr, 0, 0, t / 88, t % 88, tile, (t % 88) < 44 ? (t % 88) * 128 : ((t % 88) - 44) * 128 + 64); return; }
    t -= 1408;
    tr_tile(p.ffn_w_down + (size_t)l * 2816 * 1024, 2816, 1024, (bf16_t*)(p.ws + OFF_WDN) + (size_t)l * 1024 * 2816, nullptr, 0, 0, t / 16, t % 16, tile);
    return;
  }
  item -= P0_TR;
  if (item >= P0_CPX + P0_CPC) {
    item -= P0_CPX + P0_CPC;
    char* z = p.ws + OFF_HY + (size_t)item * 65536;
    const size_t lim = WS_NEED - OFF_HY - (size_t)item * 65536;
    for (int i = 0; i < 16; ++i) { const size_t o = (size_t)(i * 256 + tid) * 16; if (o < lim) *(u32x4*)(z + o) = (u32x4){0u, 0u, 0u, 0u}; }
    return;
  }
  const float* src; float* dst;
  if (item < P0_CPX) { src = p.x + (size_t)item * 4096; dst = p.xb + (size_t)item * 4096; }
  else { item -= P0_CPX; src = p.ctx + (size_t)item * 4096; dst = (float*)(p.ws + OFF_CTX) + (size_t)item * 4096; }
  for (int i = 0; i < 4; ++i) { const int o = (i * 256 + tid) * 4; *(float4*)(dst + o) = *(const float4*)(src + o); }
}


struct TrD { const float* src; bf16_t* dst; const float* gain; int K, N, glo, ghi, tk, tn, drow0; };
DI TrD tr_desc(const Params& p, int item) {
  const int l = item / TR_PER_LAYER; int t = item % TR_PER_LAYER; TrD d; d.gain = nullptr; d.glo = 0; d.ghi = 0; d.drow0 = -1;
  if (t < 704) { d.src = p.w_in + (size_t)l * 1024 * 2744; d.K = 1024; d.N = 2744; d.dst = (bf16_t*)(p.ws + OFF_WIN) + (size_t)l * 2816 * 1024; d.tk = t / 44; d.tn = t % 44; return d; }
  t -= 704;
  if (t < 24) { d.src = p.mla_w_uq + (size_t)l * 256 * 384; d.K = 256; d.N = 384; d.dst = (bf16_t*)(p.ws + OFF_WUQ) + (size_t)l * 384 * 256; d.gain = p.mla_q_norm + l * 256; d.ghi = 256; d.tk = t / 6; d.tn = t % 6; return d; }
  t -= 24;
  if (t < 16) { d.src = p.mla_w_ukv + (size_t)l * 128 * 512; d.K = 128; d.N = 512; d.dst = (bf16_t*)(p.ws + OFF_WUKV) + (size_t)l * 512 * 128; d.gain = p.mla_kv_norm + l * 128; d.ghi = 128; d.tk = t / 8; d.tn = t % 8; return d; }
  t -= 16;
  if (t < 16) { d.src = p.s5_w_glu + (size_t)l * 256 * 256; d.K = 256; d.N = 256; d.dst = (bf16_t*)(p.ws + OFF_WGLU) + (size_t)l * 256 * 256; d.tk = t / 4; d.tn = t % 4; return d; }
  t -= 16;
  if (t < 256) { d.src = p.w_out + (size_t)l * 1024 * 1024; d.K = 1024; d.N = 1024; d.dst = (bf16_t*)(p.ws + OFF_WOUT) + (size_t)l * 1024 * 1024; d.gain = p.ssd_norm + l * 256; d.glo = 512; d.ghi = 768; d.tk = t / 16; d.tn = t % 16; return d; }
  t -= 256;
  if (t < 1408) { d.src = p.ffn_w_up + (size_t)l * 1024 * 5632; d.K = 1024; d.N = 5632; d.dst = (bf16_t*)(p.ws + OFF_WUP) + (size_t)l * 5632 * 1024; d.tk = t / 88; d.tn = t % 88;
    d.drow0 = d.tn < 44 ? d.tn * 128 : (d.tn - 44) * 128 + 64; return d; }
  t -= 1408;
  d.src = p.ffn_w_down + (size_t)l * 2816 * 1024; d.K = 2816; d.N = 1024; d.dst = (bf16_t*)(p.ws + OFF_WDN) + (size_t)l * 1024 * 2816; d.tk = t / 16; d.tn = t % 16; return d;
}
DI void tr_load(const TrD& d, float4 (&v)[4]) {
  const int tid = ltid(), c4 = tid & 15, rq = tid >> 4;
  const bool vec = (d.N & 3) == 0;
#pragma unroll
  for (int rr = 0; rr < 4; ++rr) {
    const int r = rr * 16 + rq, k = d.tk * 64 + r, n = d.tn * 64 + c4 * 4;
    const float* s = d.src + (size_t)k * d.N + n;
    if (vec && n + 3 < d.N) v[rr] = *(const float4*)s;
    else { v[rr].x = n < d.N ? s[0] : 0.f; v[rr].y = n + 1 < d.N ? s[1] : 0.f; v[rr].z = n + 2 < d.N ? s[2] : 0.f; v[rr].w = n + 3 < d.N ? s[3] : 0.f; }
  }
}
DI void tr_finish(const TrD& d, const float4 (&v)[4], float* tile) {
  const int tid = ltid(), c4 = tid & 15, rq = tid >> 4;
#pragma unroll
  for (int rr = 0; rr < 4; ++rr) {
    const int r = rr * 16 + rq, k = d.tk * 64 + r;
    float4 x = v[rr];
    if (d.gain && k >= d.glo && k < d.ghi) { const float g = d.gain[k - d.glo]; x.x *= g; x.y *= g; x.z *= g; x.w *= g; }
    *(float4*)(tile + r * 68 + c4 * 4) = x;
  }
  __syncthreads();
#pragma unroll
  for (int q = 0; q < 2; ++q) {
    const int id = tid + 256 * q, n = id >> 3, k0 = (id & 7) * 8;
    u32x4 o;
    o.x = pack2(tile[(k0 + 0) * 68 + n], tile[(k0 + 1) * 68 + n]); o.y = pack2(tile[(k0 + 2) * 68 + n], tile[(k0 + 3) * 68 + n]);
    o.z = pack2(tile[(k0 + 4) * 68 + n], tile[(k0 + 5) * 68 + n]); o.w = pack2(tile[(k0 + 6) * 68 + n], tile[(k0 + 7) * 68 + n]);
    *(u32x4*)(d.dst + (size_t)((d.drow0 >= 0 ? d.drow0 : d.tn * 64) + n) * d.K + d.tk * 64 + k0) = o;
  }
  __syncthreads();
}
DI void p0_transposes(const Params& p, char* smem) {
  float* tile = (float*)smem;
  int t = blockIdx.x;
  if (t >= P0_TR) return;
  TrD d = tr_desc(p, t); float4 v[4]; tr_load(d, v);
  for (;;) {
    const int t1 = t + gridDim.x; const bool has = t1 < P0_TR;
    TrD d1 = d; float4 v1[4];
    if (has) { d1 = tr_desc(p, t1); tr_load(d1, v1); }
    tr_finish(d, v, tile);
    if (!has) break;
    d = d1; t = t1;
#pragma unroll
    for (int i = 0; i < 4; ++i) v[i] = v1[i];
  }
}

DI void norm_item(const Params& p, int l, int which, int item) {
  const int lane = ltid() & 63, w = __builtin_amdgcn_readfirstlane(ltid() >> 6), row = item * 4 + w;
  const float* x = row < NLAT ? p.xb + (size_t)row * 1024 : (const float*)(p.ws + OFF_CTX) + (size_t)(row - NLAT) * 1024;
  float4 v[4]; float ss = 0.f;
#pragma unroll
  for (int i = 0; i < 4; ++i) { v[i] = *(const float4*)(x + (i * 64 + lane) * 4); ss += v[i].x * v[i].x + v[i].y * v[i].y + v[i].z * v[i].z + v[i].w * v[i].w; }
  ss = wave_sum(ss);
  const float rstd = rsqrtf(ss * (1.f / 1024.f) + 1e-6f);
  const int s = row < NLAT ? row / T : 2;
  const float* g = (which ? p.norm2 : p.norm1) + l * 1024;
  const float* md = (const float*)(p.ws + OFF_MOD) + (size_t)(l * 3 + s) * 6144 + (which ? 3072 : 0);
  bf16_t* H = (bf16_t*)(p.ws + OFF_HY) + (size_t)row * 1024;
#pragma unroll
  for (int i = 0; i < 4; ++i) {
    const int k = (i * 64 + lane) * 4;
    const float4 g4 = *(const float4*)(g + k), sh = *(const float4*)(md + k), sc = *(const float4*)(md + 1024 + k);
    u32x2 o; o.x = pack2(v[i].x * rstd * g4.x * (1.f + sc.x) + sh.x, v[i].y * rstd * g4.y * (1.f + sc.y) + sh.y);
    o.y = pack2(v[i].z * rstd * g4.z * (1.f + sc.z) + sh.z, v[i].w * rstd * g4.w * (1.f + sc.w) + sh.w);
    *(u32x2*)(H + k) = o;
  }
}

DI u32x4 scale_bf8(u32x4 q, float s) {
  q.x = pack2(bflo(q.x) * s, bfhi(q.x) * s); q.y = pack2(bflo(q.y) * s, bfhi(q.y) * s);
  q.z = pack2(bflo(q.z) * s, bfhi(q.z) * s); q.w = pack2(bflo(q.w) * s, bfhi(q.w) * s); return q;
}
#define GEMM_STEP(AR, BR, KT, CUR)                                                                                    \
  {                                                                                                                   \
    bf16_t* Aw = As + (1 - (CUR)) * GBUF; bf16_t* Bw = Aw + 128 * 72;                                                 \
    const bf16_t* Ac = As + (CUR) * GBUF; const bf16_t* Bc = Ac + 128 * 72;                                           \
    if ((KT) + 1 < nk) {                                                                                              \
      if (AMODE == 1 && (KT) + 1 >= 8 && (KT) + 1 < 12) {                                                             \
        _Pragma("unroll") for (int i = 0; i < 4; ++i) AR[i] = scale_bf8(AR[i], rs[i]);                                \
      }                                                                                                               \
      _Pragma("unroll") for (int i = 0; i < 4; ++i) { *(u32x4*)(Aw + (r0 + 32 * i) * 72 + cc * 8) = AR[i]; *(u32x4*)(Bw + (r0 + 32 * i) * 72 + cc * 8) = BR[i]; } \
    }                                                                                                                 \
    if ((KT) + 3 < nk) {                                                                                              \
      _Pragma("unroll") for (int i = 0; i < 4; ++i) { AR[i] = *(const u32x4*)((CLAMP ? apx[i] : ap + i * astep) + ((KT) + 3) * 64); BR[i] = *(const u32x4*)(bp + i * bstep + ((KT) + 3) * 64); } \
    }                                                                                                                 \
    __builtin_amdgcn_sched_barrier(0);                                                                                \
    __builtin_amdgcn_s_setprio(1);                                                                                    \
    _Pragma("unroll") for (int ks = 0; ks < 2; ++ks) {                                                                \
      bf16x8 af[4], bfr[4];                                                                                           \
      _Pragma("unroll") for (int i = 0; i < 4; ++i) { af[i] = ld_frag(Ac + (64 * wm + 16 * i + l15) * 72 + ks * 32 + g4 * 8); bfr[i] = ld_frag(Bc + (64 * wn + 16 * i + l15) * 72 + ks * 32 + g4 * 8); } \
      _Pragma("unroll") for (int i = 0; i < 4; ++i)                                                                   \
        _Pragma("unroll") for (int j = 0; j < 4; ++j) acc[i][j] = MFMA16(bfr[j], af[i], acc[i][j]);                   \
    }                                                                                                                 \
    __builtin_amdgcn_s_setprio(0);                                                                                    \
    __syncthreads();                                                                                                  \
  }
template <int AMODE, int STAGE, class Epi, int CLAMP = 0>
DI void gemm_tile(const bf16_t* __restrict__ A, int lda, const bf16_t* __restrict__ Bt, int ldb, int K, int m0, int n0, char* smem, const float* ssq, Epi epi, int rlo = 0, int rhi = 0) {
  bf16_t* As = (bf16_t*)smem; bf16_t* Bs = As + 128 * 72;
  const int tid = ltid(), lane = tid & 63, w = __builtin_amdgcn_readfirstlane(tid >> 6), wm = w >> 1, wn = w & 1, l15 = lane & 15, g4 = lane >> 4;
  u32x4 ar0[4], br0[4], ar1[4], br1[4]; float rs[4];
  const int r0 = tid >> 3, cc = tid & 7;
  const bf16_t* ap = A + (size_t)(m0 + r0) * lda + cc * 8;
  const bf16_t* bp = Bt + (size_t)(n0 + r0) * ldb + cc * 8;
  const size_t astep = (size_t)32 * lda, bstep = (size_t)32 * ldb;
  const bf16_t* apx[4];
  if (CLAMP) {
#pragma unroll
    for (int i = 0; i < 4; ++i) { int r = m0 + r0 + 32 * i; r = r < rlo ? rlo : (r > rhi ? rhi : r); apx[i] = A + (size_t)r * lda + cc * 8; }
  }
  if (AMODE == 1) {
#pragma unroll
    for (int i = 0; i < 4; ++i) { const float* q = ssq + (m0 + r0 + 32 * i); rs[i] = rsqrtf((q[0] + q[NROW] + q[2 * NROW] + q[3 * NROW]) * (1.f / 256.f) + 1e-6f); }
  }
  f32x4 acc[4][4];
#pragma unroll
  for (int i = 0; i < 4; ++i)
#pragma unroll
    for (int j = 0; j < 4; ++j) acc[i][j] = (f32x4){0.f, 0.f, 0.f, 0.f};
  const int nk = K >> 6;
#pragma unroll
  for (int i = 0; i < 4; ++i) { ar0[i] = *(const u32x4*)(CLAMP ? apx[i] : ap + i * astep); br0[i] = *(const u32x4*)(bp + i * bstep); }
  constexpr int GBUF = 2 * 128 * 72;
#pragma unroll
  for (int i = 0; i < 4; ++i) { ar1[i] = *(const u32x4*)((CLAMP ? apx[i] : ap + i * astep) + 64); br1[i] = *(const u32x4*)(bp + i * bstep + 64); }
#pragma unroll
  for (int i = 0; i < 4; ++i) { *(u32x4*)(As + (r0 + 32 * i) * 72 + cc * 8) = ar0[i]; *(u32x4*)(Bs + (r0 + 32 * i) * 72 + cc * 8) = br0[i]; }
  if (2 < nk) {
#pragma unroll
    for (int i = 0; i < 4; ++i) { ar0[i] = *(const u32x4*)((CLAMP ? apx[i] : ap + i * astep) + 128); br0[i] = *(const u32x4*)(bp + i * bstep + 128); }
  }
  __syncthreads();
  for (int kt = 0; kt < nk; kt += 2) {
    GEMM_STEP(ar1, br1, kt, 0)
    GEMM_STEP(ar0, br0, kt + 1, 1)
  }
  if (STAGE == 2) {
    float* Tf = (float*)smem;
#pragma unroll
    for (int h = 0; h < 2; ++h) {
      if (wm == h) {
#pragma unroll
        for (int i = 0; i < 4; ++i)
#pragma unroll
          for (int j = 0; j < 4; ++j) *(f32x4*)(Tf + (16 * i + l15) * 132 + 64 * wn + 16 * j + 4 * g4) = acc[i][j];
      }
      __syncthreads();
#pragma unroll
      for (int q = 0; q < 8; ++q) { const int id = tid + 256 * q, r = id >> 5, c = id & 31; epi(m0 + 64 * h + r, n0 + c * 4, *(const f32x4*)(Tf + r * 132 + c * 4)); }
      __syncthreads();
    }
    return;
  }
#pragma unroll
  for (int i = 0; i < 4; ++i)
#pragma unroll
    for (int j = 0; j < 4; ++j) epi(m0 + 64 * wm + 16 * i + l15, n0 + 64 * wn + 16 * j + 4 * g4, acc[i][j]);
}

DI void store_bf4(bf16_t* dst, f32x4 v) { u32x2 o; o.x = pack2(v[0], v[1]); o.y = pack2(v[2], v[3]); *(u32x2*)dst = o; }

DI void gemm_in_item(const Params& p, int l, int item, char* smem) {
  const int mtile = item / 22, nt = item % 22;
  int seq0, slen, ti;
  if (mtile < 132) { seq0 = (mtile / 66) * T; slen = T; ti = mtile % 66; }
  else { const int j = mtile - 132; seq0 = NLAT + (j / 3) * TC; slen = TC; ti = j % 3; }
  const int m0 = seq0 + 126 * ti - 1, n0 = nt * 128;
  bf16_t* P = (bf16_t*)(p.ws + OFF_P); float* GML = (float*)(p.ws + OFF_GML); float* DTR = (float*)(p.ws + OFF_DTR);
  bf16_t* Ts = (bf16_t*)smem;
  auto epi = [&](int row, int col, f32x4 v) {
    const int lr = row - m0, t = 126 * ti - 1 + lr;
    store_bf4(Ts + lr * 136 + (col - n0), v);
    if (lr >= 1 && lr <= 126 && t < slen) {
      if (col >= 1024 && col < 1040) *(f32x4*)(GML + (size_t)row * 16 + (col - 1024)) = v;
      if (col >= 2480 && col < 2488) *(f32x4*)(DTR + (size_t)row * 8 + (col - 2480)) = v;
    }
  };
  gemm_tile<0, 0, decltype(epi), 1>((const bf16_t*)(p.ws + OFF_HY), 1024, (const bf16_t*)(p.ws + OFF_WIN) + (size_t)l * 2816 * 1024, 1024, 1024, m0, n0, smem, nullptr, epi, seq0, seq0 + slen - 1);
  __syncthreads();
  {
    const int tid = ltid();
    const float* cw = p.ssd_conv_w + (size_t)l * 3 * 768; const float* cb = p.ssd_conv_b + l * 768;
#pragma unroll
    for (int q = 0; q < 8; ++q) {
      const int id = tid + 256 * q, lr = 1 + (id >> 4), c8 = (id & 15) * 8, t = 126 * ti - 1 + lr, col = n0 + c8;
      if (id < 2016 && t < slen) {
        u32x4 o = *(const u32x4*)(Ts + lr * 136 + c8);
        if (col >= C_XBC && col < C_XBC + 768) {
          const int ch = col - C_XBC;
          const u32x4 z = {0u, 0u, 0u, 0u};
          const u32x4 pm = t > 0 ? *(const u32x4*)(Ts + (lr - 1) * 136 + c8) : z, nx = t + 1 < slen ? *(const u32x4*)(Ts + (lr + 1) * 136 + c8) : z;
          const float a[8] = {bflo(pm.x), bfhi(pm.x), bflo(pm.y), bfhi(pm.y), bflo(pm.z), bfhi(pm.z), bflo(pm.w), bfhi(pm.w)};
          const float m[8] = {bflo(o.x), bfhi(o.x), bflo(o.y), bfhi(o.y), bflo(o.z), bfhi(o.z), bflo(o.w), bfhi(o.w)};
          const float n[8] = {bflo(nx.x), bfhi(nx.x), bflo(nx.y), bfhi(nx.y), bflo(nx.z), bfhi(nx.z), bflo(nx.w), bfhi(nx.w)};
          float r[8];
#pragma unroll
          for (int j = 0; j < 8; ++j) r[j] = silu_f(cb[ch + j] + cw[ch + j] * a[j] + cw[768 + ch + j] * m[j] + cw[1536 + ch + j] * n[j]);
          o.x = pack2(r[0], r[1]); o.y = pack2(r[2], r[3]); o.z = pack2(r[4], r[5]); o.w = pack2(r[6], r[7]);
        }
        *(u32x4*)(P + (size_t)(seq0 + t) * PINP + col) = o;
      }
    }
  }
  __syncthreads();
}

DI void tile_rstd(const bf16_t* P, int m0, int col0, int ncols, float* rst) {
  const int tid = ltid(), r = tid >> 1, hf = tid & 1, n = ncols >> 1;
  const bf16_t* src = P + (size_t)(m0 + r) * PINP + col0 + hf * n;
  float ss = 0.f;
  for (int c = 0; c < n; c += 8) { const u32x4 q = *(const u32x4*)(src + c);
    ss += bflo(q.x) * bflo(q.x) + bfhi(q.x) * bfhi(q.x) + bflo(q.y) * bflo(q.y) + bfhi(q.y) * bfhi(q.y) + bflo(q.z) * bflo(q.z) + bfhi(q.z) * bfhi(q.z) + bflo(q.w) * bflo(q.w) + bfhi(q.w) * bfhi(q.w); }
  ss += __shfl_xor(ss, 1);
  if (hf == 0) rst[r] = rsqrtf(ss / (float)ncols + 1e-6f);
  __syncthreads();
}
DI void qproj_item(const Params& p, int l, int item, char* smem) {
  const int mt = item / 3, nt = item % 3; const bf16_t* P = (const bf16_t*)(p.ws + OFF_P);
  float* rst = (float*)(smem + 73728);
  tile_rstd(P, mt * 128, C_CQ, 256, rst);
  bf16_t* Q = (bf16_t*)(p.ws + OFF_QRAW);
  gemm_tile<0, 0>(P + C_CQ, PINP, (const bf16_t*)(p.ws + OFF_WUQ) + (size_t)l * 384 * 256, 256, 256, mt * 128, nt * 128, smem, nullptr,
               [&](int row, int col, f32x4 v) { const float r = rst[row - mt * 128]; store_bf4(Q + (size_t)row * 384 + col, v * r); });
  __syncthreads();
}
DI void kvproj_item(const Params& p, int l, int item, char* smem) {
  const int mt = item / 4, nt = item % 4; const bf16_t* P = (const bf16_t*)(p.ws + OFF_P);
  float* rst = (float*)(smem + 73728);
  tile_rstd(P, mt * 128, C_CKV, 128, rst);
  bf16_t* KH = (bf16_t*)(p.ws + OFF_KH); bf16_t* VT = (bf16_t*)(p.ws + OFF_VT);
  gemm_tile<0, 0>(P + C_CKV, PINP, (const bf16_t*)(p.ws + OFF_WUKV) + (size_t)l * 512 * 128, 128, 128, mt * 128, nt * 128, smem, nullptr,
               [&](int row, int col, f32x4 v) {
                 const float r = rst[row - mt * 128]; v = v * r;
                 const int hh = col >> 7, dd = col & 127;
                 int b, tpos; if (row < NLAT) { b = row / T; tpos = row % T; } else { b = (row - NLAT) / TC; tpos = T + (row - NLAT) % TC; }
                 if (dd < 64) store_bf4(KH + ((size_t)(b * 4 + hh) * TALL + tpos) * 64 + dd, v);
                 else {
                   bf16_t* vp = VT + ((size_t)(b * 4 + hh) * 64 + (dd - 64)) * TALL + tpos;
                   vp[0] = f2bf(v[0]); vp[TALL] = f2bf(v[1]); vp[2 * TALL] = f2bf(v[2]); vp[3 * TALL] = f2bf(v[3]);
                 }
               });
  __syncthreads();
}
DI void rope_cs(int t, int i, float& cs, float& sn) {
  const int pos = (i < 8) ? (t >> 6) : (t & 63); const int f = i & 7;
  const float inv = exp2f(-(float)f * (13.287712379549449f / 8.f));
  const float ang = (float)pos * inv;
  cs = cosf(ang); sn = sinf(ang);
}
DI void ropek_item(const Params& p, int item) {
  const int row = item * 256 + ltid();
  const bf16_t* src = (const bf16_t*)(p.ws + OFF_P) + (size_t)row * PINP + C_KR;
  u32x4 q[4];
#pragma unroll
  for (int i = 0; i < 4; ++i) q[i] = *(const u32x4*)(src + i * 8);
  float v[32];
#pragma unroll
  for (int i = 0; i < 4; ++i) { v[i * 8 + 0] = bflo(q[i].x); v[i * 8 + 1] = bfhi(q[i].x); v[i * 8 + 2] = bflo(q[i].y); v[i * 8 + 3] = bfhi(q[i].y);
    v[i * 8 + 4] = bflo(q[i].z); v[i * 8 + 5] = bfhi(q[i].z); v[i * 8 + 6] = bflo(q[i].w); v[i * 8 + 7] = bfhi(q[i].w); }
  int b, tpos;
  if (row < NLAT) {
    b = row / T; tpos = row % T;
#pragma unroll
    for (int i = 0; i < 16; ++i) { float cs, sn; rope_cs(tpos, i, cs, sn); const float x1 = v[i], x2 = v[i + 16]; v[i] = x1 * cs - x2 * sn; v[i + 16] = x1 * sn + x2 * cs; }
  } else { b = (row - NLAT) / TC; tpos = T + (row - NLAT) % TC; }
  u32x4 o[4];
#pragma unroll
  for (int i = 0; i < 4; ++i) { o[i].x = pack2(v[i * 8], v[i * 8 + 1]); o[i].y = pack2(v[i * 8 + 2], v[i * 8 + 3]); o[i].z = pack2(v[i * 8 + 4], v[i * 8 + 5]); o[i].w = pack2(v[i * 8 + 6], v[i * 8 + 7]); }
  bf16_t* dst = (bf16_t*)(p.ws + OFF_KR) + ((size_t)b * TALL + tpos) * 32;
#pragma unroll
  for (int i = 0; i < 4; ++i) *(u32x4*)(dst + i * 8) = o[i];
}

DI void attn_item(const Params& p, int item, char* smem) {
  const int tid = ltid(), lane = tid & 63, w = __builtin_amdgcn_readfirstlane(tid >> 6), l15 = lane & 15, g4 = lane >> 4;
  int b, h, qt, latent;
  if (item < 512) { latent = 1; qt = item & 63; h = (item >> 6) & 3; b = item >> 8; }
  else { latent = 0; const int i2 = item - 512; qt = i2 & 1; h = (i2 >> 1) & 3; b = i2 >> 3; }
  const int qrow0 = latent ? b * T + qt * 128 : NLAT + b * TC + qt * 128;
  bf16_t* Qs = (bf16_t*)smem;
  bf16_t* Ks = (bf16_t*)smem;
  bf16_t* Vs = Ks + 64 * 104;
  const bf16_t* Qraw = (const bf16_t*)(p.ws + OFF_QRAW);
  const float qscale = 0.10206207261596577f * 1.4426950408889634f;
  for (int id = tid; id < 1280; id += 256) {
    const int r = id / 10, cc = id % 10;
    const bf16_t* src = Qraw + (size_t)(qrow0 + r) * 384 + h * 96 + cc * 8;
    const u32x4 q = *(const u32x4*)src;
    float a[8] = {bflo(q.x), bfhi(q.x), bflo(q.y), bfhi(q.y), bflo(q.z), bfhi(q.z), bflo(q.w), bfhi(q.w)};
    if (cc < 8) {
      u32x4 o; o.x = pack2(a[0] * qscale, a[1] * qscale); o.y = pack2(a[2] * qscale, a[3] * qscale); o.z = pack2(a[4] * qscale, a[5] * qscale); o.w = pack2(a[6] * qscale, a[7] * qscale);
      *(u32x4*)(Qs + r * 104 + cc * 8) = o;
    } else {
      const u32x4 q2 = *(const u32x4*)(src + 16);
      float c2[8] = {bflo(q2.x), bfhi(q2.x), bflo(q2.y), bfhi(q2.y), bflo(q2.z), bfhi(q2.z), bflo(q2.w), bfhi(q2.w)};
      float o1[8], o2[8];
#pragma unroll
      for (int j = 0; j < 8; ++j) {
        float cs = 1.f, sn = 0.f;
        if (latent) rope_cs(qt * 128 + r, (cc - 8) * 8 + j, cs, sn);
        o1[j] = (a[j] * cs - c2[j] * sn) * qscale; o2[j] = (a[j] * sn + c2[j] * cs) * qscale;
      }
      u32x4 o; o.x = pack2(o1[0], o1[1]); o.y = pack2(o1[2], o1[3]); o.z = pack2(o1[4], o1[5]); o.w = pack2(o1[6], o1[7]);
      *(u32x4*)(Qs + r * 104 + cc * 8) = o;
      o.x = pack2(o2[0], o2[1]); o.y = pack2(o2[2], o2[3]); o.z = pack2(o2[4], o2[5]); o.w = pack2(o2[6], o2[7]);
      *(u32x4*)(Qs + r * 104 + cc * 8 + 16) = o;
    }
  }
  __syncthreads();
  bf16x8 qf[2][3];
#pragma unroll
  for (int qs = 0; qs < 2; ++qs)
#pragma unroll
    for (int ks = 0; ks < 3; ++ks) qf[qs][ks] = ld_frag(Qs + (32 * w + 16 * qs + l15) * 104 + ks * 32 + g4 * 8);
  __syncthreads();
  const int kt0 = latent ? 0 : 128, kt1 = 132;
  const bf16_t* Kg = (const bf16_t*)(p.ws + OFF_KH) + (size_t)(b * 4 + h) * TALL * 64;
  const bf16_t* Rg = (const bf16_t*)(p.ws + OFF_KR) + (size_t)b * TALL * 32;
  const bf16_t* Vg = (const bf16_t*)(p.ws + OFF_VT) + (size_t)(b * 4 + h) * 64 * TALL;
  u32x4 kr[3], vr[2];
  const int ve0 = tid >> 3, vc = tid & 7;
  {
    kr[0] = *(const u32x4*)(Kg + (size_t)kt0 * 4096 + tid * 8); kr[1] = *(const u32x4*)(Kg + (size_t)kt0 * 4096 + (tid + 256) * 8);
    kr[2] = *(const u32x4*)(Rg + (size_t)kt0 * 2048 + tid * 8);
#pragma unroll
    for (int i = 0; i < 2; ++i) vr[i] = *(const u32x4*)(Vg + (size_t)(ve0 + 32 * i) * TALL + kt0 * 64 + vc * 8);
  }
  float mrun[2] = {0.f, 0.f}, lsum[2] = {0.f, 0.f};
  f32x4 O[4][2];
#pragma unroll
  for (int es = 0; es < 4; ++es)
#pragma unroll
    for (int qs = 0; qs < 2; ++qs) O[es][qs] = (f32x4){0.f, 0.f, 0.f, 0.f};
  constexpr int KVB = 64 * 104 + 64 * 72;
  {
#pragma unroll
    for (int i = 0; i < 2; ++i) { const int id = tid + 256 * i; *(u32x4*)(Ks + (id >> 3) * 104 + (id & 7) * 8) = kr[i]; }
    *(u32x4*)(Ks + (tid >> 2) * 104 + 64 + (tid & 3) * 8) = kr[2];
#pragma unroll
    for (int i = 0; i < 2; ++i) *(u32x4*)(Vs + (ve0 + 32 * i) * 72 + vc * 8) = vr[i];
    if (kt0 + 1 < kt1) {
      kr[0] = *(const u32x4*)(Kg + (size_t)(kt0 + 1) * 4096 + tid * 8); kr[1] = *(const u32x4*)(Kg + (size_t)(kt0 + 1) * 4096 + (tid + 256) * 8);
      kr[2] = *(const u32x4*)(Rg + (size_t)(kt0 + 1) * 2048 + tid * 8);
#pragma unroll
      for (int i = 0; i < 2; ++i) vr[i] = *(const u32x4*)(Vg + (size_t)(ve0 + 32 * i) * TALL + (kt0 + 1) * 64 + vc * 8);
    }
    __syncthreads();
  }
  for (int kt = kt0; kt < kt1; ++kt) {
    const int cur = (kt - kt0) & 1;
    const bf16_t* Kc = Ks + cur * KVB; const bf16_t* Vc = Vs + cur * KVB;
    bf16_t* Kn = Ks + (cur ^ 1) * KVB; bf16_t* Vn = Vs + (cur ^ 1) * KVB;
    if (kt + 1 < kt1) {
#pragma unroll
      for (int i = 0; i < 2; ++i) { const int id = tid + 256 * i; *(u32x4*)(Kn + (id >> 3) * 104 + (id & 7) * 8) = kr[i]; }
      *(u32x4*)(Kn + (tid >> 2) * 104 + 64 + (tid & 3) * 8) = kr[2];
#pragma unroll
      for (int i = 0; i < 2; ++i) *(u32x4*)(Vn + (ve0 + 32 * i) * 72 + vc * 8) = vr[i];
    }
    if (kt + 2 < kt1) {
      kr[0] = *(const u32x4*)(Kg + (size_t)(kt + 2) * 4096 + tid * 8); kr[1] = *(const u32x4*)(Kg + (size_t)(kt + 2) * 4096 + (tid + 256) * 8);
      kr[2] = *(const u32x4*)(Rg + (size_t)(kt + 2) * 2048 + tid * 8);
#pragma unroll
      for (int i = 0; i < 2; ++i) vr[i] = *(const u32x4*)(Vg + (size_t)(ve0 + 32 * i) * TALL + (kt + 2) * 64 + vc * 8);
    }
    __builtin_amdgcn_sched_barrier(0);
    f32x4 sa[4][2];
#pragma unroll
    for (int kb = 0; kb < 4; ++kb)
#pragma unroll
      for (int qs = 0; qs < 2; ++qs) { const float nm = -mrun[qs]; sa[kb][qs] = (f32x4){nm, nm, nm, nm}; }
#pragma unroll
    for (int ks = 0; ks < 3; ++ks)
#pragma unroll
      for (int kb = 0; kb < 4; ++kb) {
        const bf16x8 a = ld_frag(Kc + (16 * kb + l15) * 104 + ks * 32 + g4 * 8);
#pragma unroll
        for (int qs = 0; qs < 2; ++qs) sa[kb][qs] = MFMA16(a, qf[qs][ks], sa[kb][qs]);
      }
    bf16x8 pf[2][2];
    float dl[2];
#pragma unroll
    for (int qs = 0; qs < 2; ++qs) {
      float mx = -1e30f;
#pragma unroll
      for (int kb = 0; kb < 4; ++kb)
#pragma unroll
        for (int j = 0; j < 4; ++j) mx = fmaxf(mx, sa[kb][qs][j]);
      mx = fmaxf(mx, __shfl_xor(mx, 16)); mx = fmaxf(mx, __shfl_xor(mx, 32));
      dl[qs] = (kt == kt0) ? mx : fmaxf(mx, 0.f);
    }
    const bool grew = (kt == kt0) || __builtin_amdgcn_ballot_w64(dl[0] > 0.f || dl[1] > 0.f) != 0ull;
#pragma unroll
    for (int qs = 0; qs < 2; ++qs) {
      float ps = 0.f;
      if (grew) {
        const float d = dl[qs], alpha = (kt == kt0) ? 0.f : __builtin_amdgcn_exp2f(-d);
        mrun[qs] += d;
#pragma unroll
        for (int kb = 0; kb < 4; ++kb)
#pragma unroll
          for (int j = 0; j < 4; ++j) { const float e = __builtin_amdgcn_exp2f(sa[kb][qs][j] - d); sa[kb][qs][j] = e; ps += e; }
        lsum[qs] = lsum[qs] * alpha + ps;
#pragma unroll
        for (int es = 0; es < 4; ++es) O[es][qs] = O[es][qs] * alpha;
      } else {
#pragma unroll
        for (int kb = 0; kb < 4; ++kb)
#pragma unroll
          for (int j = 0; j < 4; ++j) { const float e = __builtin_amdgcn_exp2f(sa[kb][qs][j]); sa[kb][qs][j] = e; ps += e; }
        lsum[qs] += ps;
      }
#pragma unroll
      for (int k2 = 0; k2 < 2; ++k2)
        pf[qs][k2] = mk_frag(pack2(sa[2 * k2][qs][0], sa[2 * k2][qs][1]), pack2(sa[2 * k2][qs][2], sa[2 * k2][qs][3]),
                             pack2(sa[2 * k2 + 1][qs][0], sa[2 * k2 + 1][qs][1]), pack2(sa[2 * k2 + 1][qs][2], sa[2 * k2 + 1][qs][3]));
    }
#pragma unroll
    for (int k2 = 0; k2 < 2; ++k2)
#pragma unroll
      for (int es = 0; es < 4; ++es) {
        const bf16_t* vp = Vc + (16 * es + l15) * 72 + 32 * k2 + 4 * g4;
        const u32x2 lo = *(const u32x2*)vp, hi = *(const u32x2*)(vp + 16);
        const bf16x8 a = mk_frag(lo.x, lo.y, hi.x, hi.y);
#pragma unroll
        for (int qs = 0; qs < 2; ++qs) O[es][qs] = MFMA16(a, pf[qs][k2], O[es][qs]);
      }
    __syncthreads();
  }
  bf16_t* Y = (bf16_t*)(p.ws + OFF_HY);
#pragma unroll
  for (int qs = 0; qs < 2; ++qs) {
    float l = lsum[qs]; l += __shfl_xor(l, 16); l += __shfl_xor(l, 32);
    const float inv = 1.f / l;
    const int row = qrow0 + 32 * w + 16 * qs + l15;
#pragma unroll
    for (int es = 0; es < 4; ++es) store_bf4(Y + (size_t)row * 1024 + 256 + h * 64 + 16 * es + 4 * g4, O[es][qs] * inv);
  }
  __syncthreads();
}

DI void chunk_geom(int tcg, int b, int& part, int& tc, int& row0) { part = tcg >= 128; tc = part ? tcg - 128 : tcg; row0 = row_of(b, part, tc * 64); }
DI int chain_slot(int dir, int part, int tc) { return dir ? (part ? 3 - tc : 131 - tc) : (part ? tc : 4 + tc); }

DI void mlstm_p1(const Params& p, int l, int item, char* smem) {
  const int tid = ltid(), lane = tid & 63, w = __builtin_amdgcn_readfirstlane(tid >> 6), l15 = lane & 15, g4 = lane >> 4;
  const int tcg = item % NCH; int r = item / NCH; const int dir = r & 1; r >>= 1; const int h = r & 3, b = r >> 2;
  int part, tc, row0; chunk_geom(tcg, b, part, tc, row0);
  const int c = chain_slot(dir, part, tc), chain = (b * 4 + h) * 2 + dir;
  bf16_t* A = (bf16_t*)smem;
  bf16_t* Bk = A + 80 * 72;
  float* fs = (float*)(Bk + 64 * 72);
  const bf16_t* P = (const bf16_t*)(p.ws + OFF_P); const float* GML = (const float*)(p.ws + OFF_GML);
  float* MLM = (float*)(p.ws + OFF_MLM) + (size_t)(chain * NCH + c) * 32;
  if (tid < 64) {
    const int gi = 2 * dir;
    const float ig = GML[(size_t)(row0 + tid) * 16 + gi * 4 + h] + p.ml_gate_bias[l * 16 + gi * 4 + h];
    const float fg = GML[(size_t)(row0 + tid) * 16 + (gi + 1) * 4 + h] + p.ml_gate_bias[l * 16 + (gi + 1) * 4 + h];
    const float lf = logsigm_f(fg);
    const float pre = wave_incl_scan(lf, lane), tot = __shfl(pre, 63);
    const float bc = dir ? tot - pre + lf : pre;
    const float wlog = tot - bc + ig, mloc = wave_max(wlog), wv = __expf(wlog - mloc);
    fs[tid] = wv; A[64 * 72 + tid] = f2bf(wv);
    if (tid == 0) { MLM[0] = mloc; MLM[1] = tot; }
  }
  for (int i = tid; i < 15 * 72; i += 256) A[65 * 72 + i] = 0;
  __syncthreads();
  {
    const int s = tid >> 2, d0 = (tid & 3) * 16; const float wv = fs[s];
    const bf16_t* kp = P + (size_t)(row0 + s) * PINP + C_MLK + h * 64 + d0;
    const bf16_t* vp = P + (size_t)(row0 + s) * PINP + C_MLV + h * 64 + d0;
#pragma unroll
    for (int hf = 0; hf < 2; ++hf) {
      const u32x4 kq = *(const u32x4*)(kp + hf * 8), vq = *(const u32x4*)(vp + hf * 8);
      const float kk[8] = {bflo(kq.x), bfhi(kq.x), bflo(kq.y), bfhi(kq.y), bflo(kq.z), bfhi(kq.z), bflo(kq.w), bfhi(kq.w)};
      const float vv[8] = {bflo(vq.x), bfhi(vq.x), bflo(vq.y), bfhi(vq.y), bflo(vq.z), bfhi(vq.z), bflo(vq.w), bfhi(vq.w)};
#pragma unroll
      for (int j = 0; j < 8; ++j) { Bk[(d0 + hf * 8 + j) * 72 + s] = f2bf(kk[j] * 0.125f); A[(d0 + hf * 8 + j) * 72 + s] = f2bf(vv[j] * wv); }
    }
  }
  __syncthreads();
  float* MLS = (float*)(p.ws + OFF_MLS) + (size_t)(chain * NCH + c) * 4160;
  for (int t = w; t < 20; t += 4) {
    const int ms = t >> 2, ns = t & 3;
    f32x4 acc = {0.f, 0.f, 0.f, 0.f};
#pragma unroll
    for (int ks = 0; ks < 2; ++ks) acc = MFMA16(ld_frag(A + (16 * ms + l15) * 72 + ks * 32 + g4 * 8), ld_frag(Bk + (16 * ns + l15) * 72 + ks * 32 + g4 * 8), acc);
#pragma unroll
    for (int j = 0; j < 4; ++j) { const int e = 16 * ms + 4 * g4 + j; if (e <= 64) MLS[e * 64 + 16 * ns + l15] = acc[j]; }
  }
  __syncthreads();
}
DI void mlstm_p2(const Params& p, int item) {
  const int gi = item * 256 + ltid(), chain = gi / 4160, e = gi % 4160;
  float* MLS = (float*)(p.ws + OFF_MLS) + (size_t)chain * NCH * 4160 + e;
  float* MLM = (float*)(p.ws + OFF_MLM) + (size_t)chain * NCH * 32;
  float C = 0.f, m = 0.f;
  for (int c0 = 0; c0 < NCH; c0 += 12) {
    float d[12], ml[12], bl[12];
#pragma unroll
    for (int i = 0; i < 12; ++i) { d[i] = MLS[(size_t)(c0 + i) * 4160]; ml[i] = MLM[(c0 + i) * 32]; bl[i] = MLM[(c0 + i) * 32 + 1]; }
#pragma unroll
    for (int i = 0; i < 12; ++i) {
      MLS[(size_t)(c0 + i) * 4160] = C; if (e == 0) MLM[(c0 + i) * 32 + 16] = m;
      const float mn = fmaxf(bl[i] + m, ml[i]);
      C = __expf(bl[i] + m - mn) * C + __expf(ml[i] - mn) * d[i]; m = mn;
    }
  }
}
DI void mlstm_p3(const Params& p, int l, int item, char* smem) {
  const int tid = ltid(), lane = tid & 63, w = __builtin_amdgcn_readfirstlane(tid >> 6), l15 = lane & 15, g4 = lane >> 4;
  const int h = item & 3; const int r = item >> 2; const int tcg = r % NCH, b = r / NCH;
  int part, tc, row0; chunk_geom(tcg, b, part, tc, row0);
  bf16_t* Qs = (bf16_t*)smem;
  bf16_t* Ks = Qs + 64 * 72;
  bf16_t* Vt = Ks + 64 * 72;
  bf16_t* Sb = Vt + 64 * 72;
  float* fb = (float*)(Sb + 64 * 72);
  float* fi = fb + 64;
  const bf16_t* P = (const bf16_t*)(p.ws + OFF_P); const float* GML = (const float*)(p.ws + OFF_GML);
  {
    const int s = tid >> 2, d0 = (tid & 3) * 16;
    const bf16_t* base = P + (size_t)(row0 + s) * PINP + h * 64 + d0;
#pragma unroll
    for (int hf = 0; hf < 2; ++hf) {
      *(u32x4*)(Qs + s * 72 + d0 + hf * 8) = *(const u32x4*)(base + C_MLQ + hf * 8);
      const u32x4 kq = *(const u32x4*)(base + C_MLK + hf * 8), vq = *(const u32x4*)(base + C_MLV + hf * 8);
      u32x4 ko; ko.x = pack2(bflo(kq.x) * 0.125f, bfhi(kq.x) * 0.125f); ko.y = pack2(bflo(kq.y) * 0.125f, bfhi(kq.y) * 0.125f);
      ko.z = pack2(bflo(kq.z) * 0.125f, bfhi(kq.z) * 0.125f); ko.w = pack2(bflo(kq.w) * 0.125f, bfhi(kq.w) * 0.125f);
      *(u32x4*)(Ks + s * 72 + d0 + hf * 8) = ko;
      const unsigned vw[4] = {vq.x, vq.y, vq.z, vq.w};
#pragma unroll
      for (int j = 0; j < 4; ++j) { Vt[(d0 + hf * 8 + 2 * j) * 72 + s] = (bf16_t)(vw[j] & 0xffffu); Vt[(d0 + hf * 8 + 2 * j + 1) * 72 + s] = (bf16_t)(vw[j] >> 16); }
    }
  }
  f32x4 hs[4];
#pragma unroll
  for (int ns = 0; ns < 4; ++ns) hs[ns] = (f32x4){0.f, 0.f, 0.f, 0.f};
#pragma unroll 1
  for (int dir = 0; dir < 2; ++dir) {
    const int c = chain_slot(dir, part, tc), chain = (b * 4 + h) * 2 + dir;
    const float m_in = ((const float*)(p.ws + OFF_MLM))[(size_t)(chain * NCH + c) * 32 + 16];
    const float* Cst = (const float*)(p.ws + OFF_MLS) + (size_t)(chain * NCH + c) * 4160;
    __syncthreads();
    if (tid < 64) {
      const int gi = 2 * dir;
      const float ig = GML[(size_t)(row0 + tid) * 16 + gi * 4 + h] + p.ml_gate_bias[l * 16 + gi * 4 + h];
      const float fg = GML[(size_t)(row0 + tid) * 16 + (gi + 1) * 4 + h] + p.ml_gate_bias[l * 16 + (gi + 1) * 4 + h];
      const float lf = logsigm_f(fg);
      const float pre = wave_incl_scan(lf, lane), tot = __shfl(pre, 63);
      fb[tid] = dir ? tot - pre + lf : pre; fi[tid] = ig;
    }
    __syncthreads();
    f32x4 sc[4];
#pragma unroll
    for (int ns = 0; ns < 4; ++ns) {
      f32x4 a = {0.f, 0.f, 0.f, 0.f};
#pragma unroll
      for (int ks = 0; ks < 2; ++ks) a = MFMA16(ld_frag(Qs + (16 * w + l15) * 72 + ks * 32 + g4 * 8), ld_frag(Ks + (16 * ns + l15) * 72 + ks * 32 + g4 * 8), a);
      sc[ns] = a;
    }
    float bi[4], mt[4], rsum[4];
#pragma unroll
    for (int j = 0; j < 4; ++j) {
      const int i = 16 * w + 4 * g4 + j; bi[j] = fb[i];
      float mx = -1e30f;
#pragma unroll
      for (int ns = 0; ns < 4; ++ns) { const int s = 16 * ns + l15; const bool ok = dir ? (s >= i) : (s <= i); const float dm = bi[j] - fb[s] + fi[s]; if (ok) mx = fmaxf(mx, dm); }
      mx = red16_max(mx);
      mt[j] = fmaxf(bi[j] + m_in, mx);
      float rs = 0.f;
#pragma unroll
      for (int ns = 0; ns < 4; ++ns) {
        const int s = 16 * ns + l15; const bool ok = dir ? (s >= i) : (s <= i);
        const float v = ok ? sc[ns][j] * __expf(bi[j] - fb[s] + fi[s] - mt[j]) : 0.f;
        rs += v; Sb[i * 72 + s] = f2bf(v);
      }
      rsum[j] = red16_sum(rs);
    }
    __syncthreads();
    f32x4 qc[5];
#pragma unroll
    for (int ns = 0; ns < 5; ++ns) {
      f32x4 a = {0.f, 0.f, 0.f, 0.f};
      const int e = 16 * ns + l15;
#pragma unroll
      for (int ks = 0; ks < 2; ++ks) {
        bf16x8 bfm;
        if (e <= 64) bfm = frag_from_f32(Cst + e * 64 + ks * 32 + g4 * 8, 1.f); else bfm = mk_frag(0u, 0u, 0u, 0u);
        a = MFMA16(ld_frag(Qs + (16 * w + l15) * 72 + ks * 32 + g4 * 8), bfm, a);
      }
      qc[ns] = a;
    }
    f32x4 nm[4];
#pragma unroll
    for (int ns = 0; ns < 4; ++ns) {
      f32x4 a = {0.f, 0.f, 0.f, 0.f};
#pragma unroll
      for (int ks = 0; ks < 2; ++ks) a = MFMA16(ld_frag(Sb + (16 * w + l15) * 72 + ks * 32 + g4 * 8), ld_frag(Vt + (16 * ns + l15) * 72 + ks * 32 + g4 * 8), a);
      nm[ns] = a;
    }
#pragma unroll
    for (int j = 0; j < 4; ++j) {
      const float wi = __expf(bi[j] + m_in - mt[j]);
      const float qn = __shfl(qc[4][j], lane & 48);
      const float den = rsum[j] + wi * qn;
      const float dd = 1.f / fmaxf(fabsf(den), __expf(-mt[j]));
#pragma unroll
      for (int ns = 0; ns < 4; ++ns) hs[ns][j] += (nm[ns][j] + wi * qc[ns][j]) * dd;
    }
  }
  bf16_t* Y = (bf16_t*)(p.ws + OFF_HY);
#pragma unroll
  for (int j = 0; j < 4; ++j) {
    float ss = 0.f;
#pragma unroll
    for (int ns = 0; ns < 4; ++ns) ss += hs[ns][j] * hs[ns][j];
    ss = red16_sum(ss);
    const float rstd = rsqrtf(ss * (1.f / 64.f) + 1e-6f);
    const int row = row0 + 16 * w + 4 * g4 + j;
#pragma unroll
    for (int ns = 0; ns < 4; ++ns) {
      const int ch = h * 64 + 16 * ns + l15;
      const float o = bf2f(P[(size_t)row * PINP + C_MLO + ch]);
      Y[(size_t)row * 1024 + ch] = f2bf(hs[ns][j] * rstd * p.ml_norm[l * 256 + ch] * sigm_f(o));
    }
  }
  __syncthreads();
}

DI void conv_silu8(const Params& p, int l, const bf16_t* P, int row, bool hp, bool hn, int ch, float* out) {
  const u32x4 c0 = *(const u32x4*)(P + (size_t)row * PINP + C_XBC + ch);
  out[0] = bflo(c0.x); out[1] = bfhi(c0.x); out[2] = bflo(c0.y); out[3] = bfhi(c0.y); out[4] = bflo(c0.z); out[5] = bfhi(c0.z); out[6] = bflo(c0.w); out[7] = bfhi(c0.w);
}
DI void ssd_gates(const Params& p, int l, int dir, int h, int row0, int tid, int lane, float& dt, float& cs, float& tot) {
  const float* DTR = (const float*)(p.ws + OFF_DTR);
  dt = softplus_f(DTR[(size_t)(row0 + tid) * 8 + dir * 4 + h] + p.ssd_dt_bias[l * 8 + dir * 4 + h]);
  const float la = -dt * __expf(p.ssd_a_log[l * 8 + dir * 4 + h]);
  const float pre = wave_incl_scan(la, lane); tot = __shfl(pre, 63);
  cs = dir ? tot - pre + la : pre;
}
DI void ssd_p1(const Params& p, int l, int item, char* smem) {
  const int tid = ltid(), lane = tid & 63, w = __builtin_amdgcn_readfirstlane(tid >> 6), l15 = lane & 15, g4 = lane >> 4;
  const int tcg = item % NCH; int r = item / NCH; const int dir = r & 1; r >>= 1; const int h = r & 3, b = r >> 2;
  int part, tc, row0; chunk_geom(tcg, b, part, tc, row0);
  const int c = chain_slot(dir, part, tc), chain = (b * 4 + h) * 2 + dir, lastc = part ? 3 : 127;
  bf16_t* Xt = (bf16_t*)smem;
  bf16_t* Bt = Xt + 64 * 72;
  float* fs = (float*)(Bt + 128 * 72);
  const bf16_t* P = (const bf16_t*)(p.ws + OFF_P);
  if (tid < 64) {
    float dt, cs, tot; ssd_gates(p, l, dir, h, row0, tid, lane, dt, cs, tot);
    fs[tid] = __expf(tot - cs) * dt;
    if (tid == 0) ((float*)(p.ws + OFF_SSA))[(chain * NCH + c) * 32] = tot;
  }
  __syncthreads();
  const int grp = h >> 1;
  for (int id = tid; id < 64 * 24; id += 256) {
    const int s = id / 24, cc = id % 24;
    const bool hp = !(tc == 0 && s == 0), hn = !(tc == lastc && s == 63);
    float v[8];
    if (cc < 8) { conv_silu8(p, l, P, row0 + s, hp, hn, h * 64 + cc * 8, v); const float wv = fs[s];
#pragma unroll
      for (int j = 0; j < 8; ++j) Xt[(cc * 8 + j) * 72 + s] = f2bf(v[j] * wv); }
    else { const int n0 = (cc - 8) * 8; conv_silu8(p, l, P, row0 + s, hp, hn, 256 + grp * 128 + n0, v);
#pragma unroll
      for (int j = 0; j < 8; ++j) Bt[(n0 + j) * 72 + s] = f2bf(v[j]); }
  }
  __syncthreads();
  float* SS = (float*)(p.ws + OFF_SSDS) + (size_t)(chain * NCH + c) * 8192;
#pragma unroll
  for (int ns = 0; ns < 8; ++ns) {
    f32x4 acc = {0.f, 0.f, 0.f, 0.f};
#pragma unroll
    for (int ks = 0; ks < 2; ++ks) acc = MFMA16(ld_frag(Xt + (16 * w + l15) * 72 + ks * 32 + g4 * 8), ld_frag(Bt + (16 * ns + l15) * 72 + ks * 32 + g4 * 8), acc);
#pragma unroll
    for (int j = 0; j < 4; ++j) SS[(16 * w + 4 * g4 + j) * 128 + 16 * ns + l15] = acc[j];
  }
  __syncthreads();
}
DI void ssd_p2(const Params& p, int item) {
  const int gi = item * 256 + ltid(), chain = gi >> 13, e = gi & 8191;
  float* SS = (float*)(p.ws + OFF_SSDS) + (size_t)chain * NCH * 8192 + e;
  const float* SA = (const float*)(p.ws + OFF_SSA) + (size_t)chain * NCH * 32;
  float S = 0.f;
  for (int c0 = 0; c0 < NCH; c0 += 12) {
    float d[12], a[12];
#pragma unroll
    for (int i = 0; i < 12; ++i) { d[i] = SS[(size_t)(c0 + i) * 8192]; a[i] = SA[(c0 + i) * 32]; }
#pragma unroll
    for (int i = 0; i < 12; ++i) { SS[(size_t)(c0 + i) * 8192] = S; S = __expf(a[i]) * S + d[i]; }
  }
}
DI void ssd_p3(const Params& p, int l, int item, char* smem) {
  const int tid = ltid(), lane = tid & 63, w = __builtin_amdgcn_readfirstlane(tid >> 6), l15 = lane & 15, g4 = lane >> 4;
  const int h = item & 3; const int r = item >> 2; const int tcg = r % NCH, b = r / NCH;
  int part, tc, row0; chunk_geom(tcg, b, part, tc, row0);
  const int lastc = part ? 3 : 127, grp = h >> 1;
  bf16_t* Cm = (bf16_t*)smem;
  bf16_t* Bm = Cm + 64 * 136;
  bf16_t* Xt = Bm + 64 * 136;
  bf16_t* Sb = Xt + 64 * 72;
  float* fcs = (float*)(Sb + 64 * 72);
  float* fdt = fcs + 64;
  const bf16_t* P = (const bf16_t*)(p.ws + OFF_P);
  for (int id = tid; id < 64 * 40; id += 256) {
    const int s = id / 40, cc = id % 40;
    const bool hp = !(tc == 0 && s == 0), hn = !(tc == lastc && s == 63);
    float v[8];
    if (cc < 8) { conv_silu8(p, l, P, row0 + s, hp, hn, h * 64 + cc * 8, v);
#pragma unroll
      for (int j = 0; j < 8; ++j) Xt[(cc * 8 + j) * 72 + s] = f2bf(v[j]); }
    else {
      const int q = cc - 8, isC = q >= 16, n0 = (q & 15) * 8;
      conv_silu8(p, l, P, row0 + s, hp, hn, 256 + isC * 256 + grp * 128 + n0, v);
      u32x4 o; o.x = pack2(v[0], v[1]); o.y = pack2(v[2], v[3]); o.z = pack2(v[4], v[5]); o.w = pack2(v[6], v[7]);
      *(u32x4*)((isC ? Cm : Bm) + s * 136 + n0) = o;
    }
  }
  f32x4 ys[4];
#pragma unroll
  for (int ns = 0; ns < 4; ++ns) ys[ns] = (f32x4){0.f, 0.f, 0.f, 0.f};
#pragma unroll 1
  for (int dir = 0; dir < 2; ++dir) {
    const int c = chain_slot(dir, part, tc), chain = (b * 4 + h) * 2 + dir;
    const float* St = (const float*)(p.ws + OFF_SSDS) + (size_t)(chain * NCH + c) * 8192;
    __syncthreads();
    if (tid < 64) { float dt, cs, tot; ssd_gates(p, l, dir, h, row0, tid, lane, dt, cs, tot); fcs[tid] = cs; fdt[tid] = dt; }
    __syncthreads();
    float ci[4];
#pragma unroll
    for (int j = 0; j < 4; ++j) ci[j] = fcs[16 * w + 4 * g4 + j];
#pragma unroll
    for (int ns = 0; ns < 4; ++ns) {
      f32x4 a = {0.f, 0.f, 0.f, 0.f};
#pragma unroll
      for (int ks = 0; ks < 4; ++ks) a = MFMA16(ld_frag(Cm + (16 * w + l15) * 136 + ks * 32 + g4 * 8), ld_frag(Bm + (16 * ns + l15) * 136 + ks * 32 + g4 * 8), a);
      const int s = 16 * ns + l15; const float css = fcs[s], dts = fdt[s];
#pragma unroll
      for (int j = 0; j < 4; ++j) {
        const int i = 16 * w + 4 * g4 + j; const bool ok = dir ? (s >= i) : (s <= i);
        Sb[i * 72 + s] = f2bf(ok ? a[j] * __expf(ci[j] - css) * dts : 0.f);
      }
    }
    __syncthreads();
#pragma unroll
    for (int ns = 0; ns < 4; ++ns) {
      f32x4 a = {0.f, 0.f, 0.f, 0.f}, bq = {0.f, 0.f, 0.f, 0.f};
#pragma unroll
      for (int ks = 0; ks < 2; ++ks) a = MFMA16(ld_frag(Sb + (16 * w + l15) * 72 + ks * 32 + g4 * 8), ld_frag(Xt + (16 * ns + l15) * 72 + ks * 32 + g4 * 8), a);
#pragma unroll
      for (int ks = 0; ks < 4; ++ks) bq = MFMA16(ld_frag(Cm + (16 * w + l15) * 136 + ks * 32 + g4 * 8), frag_from_f32(St + (16 * ns + l15) * 128 + ks * 32 + g4 * 8, 1.f), bq);
#pragma unroll
      for (int j = 0; j < 4; ++j) ys[ns][j] += a[j] + __expf(ci[j]) * bq[j];
    }
  }
  bf16_t* Y = (bf16_t*)(p.ws + OFF_HY); float* SSQ = (float*)(p.ws + OFF_SSQ);
  const float dsk = p.ssd_d[l * 4 + h];
#pragma unroll
  for (int j = 0; j < 4; ++j) {
    const int i = 16 * w + 4 * g4 + j, row = row0 + i; float ss = 0.f;
#pragma unroll
    for (int ns = 0; ns < 4; ++ns) {
      const int pp = 16 * ns + l15;
      const float xv = bf2f(Xt[pp * 72 + i]);
      const float z = bf2f(P[(size_t)row * PINP + C_Z + h * 64 + pp]);
      const float g = (ys[ns][j] + dsk * xv) * silu_f(z);
      ss += g * g; Y[(size_t)row * 1024 + 512 + h * 64 + pp] = f2bf(g);
    }
    ss = red16_sum(ss);
    if (l15 == 0) SSQ[(size_t)h * NROW + row] = ss;
  }
  __syncthreads();
}

struct S5Par { float are, aim, bre[16], bim[16]; };
DI void s5_params(const Params& p, int l, int dir, int g, int n, S5Par& q, float& dtv, float& lre, float& lim) {
  const int ai = ((l * 2 + dir) * 16 + g) * 64 + n;
  lre = fminf(p.s5_a_re[ai], -1e-4f); lim = p.s5_a_im[ai];
  dtv = __expf(p.s5_log_dt[(l * 2 + dir) * 16 + g]);
  const float mag = __expf(lre * dtv), ang = lim * dtv;
  q.are = mag * cosf(ang); q.aim = mag * sinf(ang);
  const float den = lre * lre + lim * lim;
  const float fre = ((q.are - 1.f) * lre + q.aim * lim) / den, fim = (q.aim * lre - (q.are - 1.f) * lim) / den;
  const float* br = p.s5_b_re + ((size_t)(l * 16 + g) * 64 + n) * 16; const float* bi = p.s5_b_im + ((size_t)(l * 16 + g) * 64 + n) * 16;
#pragma unroll
  for (int j = 0; j < 16; ++j) { q.bre[j] = fre * br[j] - fim * bi[j]; q.bim[j] = fre * bi[j] + fim * br[j]; }
}
DI void s5_step(const S5Par& q, const bf16_t* us, int s, float& xr, float& xi) {
  const u32x4 a0 = *(const u32x4*)(us + s * 16), a1 = *(const u32x4*)(us + s * 16 + 8);
  const unsigned uw[8] = {a0.x, a0.y, a0.z, a0.w, a1.x, a1.y, a1.z, a1.w};
  float br = 0.f, bi = 0.f;
#pragma unroll
  for (int j = 0; j < 8; ++j) { const float a = bflo(uw[j]), c = bfhi(uw[j]); br += q.bre[2 * j] * a + q.bre[2 * j + 1] * c; bi += q.bim[2 * j] * a + q.bim[2 * j + 1] * c; }
  const float nr = q.are * xr - q.aim * xi + br, ni = q.are * xi + q.aim * xr + bi;
  xr = nr; xi = ni;
}
DI void s5_p1(const Params& p, int l, int item, char* smem) {
  const int lane = ltid() & 63, wi = item * 4 + __builtin_amdgcn_readfirstlane(ltid() >> 6);
  const int tcg = wi % NCH; int r = wi / NCH; const int dir = r & 1; r >>= 1; const int g = r & 15, b = r >> 4;
  int part, tc, row0; chunk_geom(tcg, b, part, tc, row0);
  const int c = chain_slot(dir, part, tc);
  S5Par q; float dtv, lre, lim; s5_params(p, l, dir, g, lane, q, dtv, lre, lim);
  const bf16_t* up = (const bf16_t*)(p.ws + OFF_P) + (size_t)(row0 + lane) * PINP + C_S5 + g * 16;
  bf16_t* us = (bf16_t*)smem + __builtin_amdgcn_readfirstlane(ltid() >> 6) * 1024;
  *(u32x4*)(us + lane * 16) = *(const u32x4*)up; *(u32x4*)(us + lane * 16 + 8) = *(const u32x4*)(up + 8);
  float xr = 0.f, xi = 0.f;
  for (int st = 0; st < 64; ++st) { const int s = dir ? 63 - st : st; s5_step(q, us, s, xr, xi); }
  float* S = (float*)(p.ws + OFF_S5S) + ((size_t)((b * 16 + g) * 2 + dir) * NCH + c) * 128;
  S[lane] = xr; S[64 + lane] = xi;
}
DI void s5_p2(const Params& p, int l, int item) {
  const int gi = item * 256 + ltid(), n = gi & 63, dir = (gi >> 6) & 1, g = (gi >> 7) & 15, b = gi >> 11;
  const int ai = ((l * 2 + dir) * 16 + g) * 64 + n;
  const float lre = fminf(p.s5_a_re[ai], -1e-4f), lim = p.s5_a_im[ai], dtv = __expf(p.s5_log_dt[(l * 2 + dir) * 16 + g]);
  const float mag = __expf(64.f * lre * dtv), ang = 64.f * (lim * dtv);
  const float ar = mag * cosf(ang), aim = mag * sinf(ang);
  float* S = (float*)(p.ws + OFF_S5S) + (size_t)((b * 16 + g) * 2 + dir) * NCH * 128 + n;
  float xr = 0.f, xi = 0.f;
  for (int c0 = 0; c0 < NCH; c0 += 12) {
    float dr[12], di[12];
#pragma unroll
    for (int i = 0; i < 12; ++i) { dr[i] = S[(c0 + i) * 128]; di[i] = S[(c0 + i) * 128 + 64]; }
#pragma unroll
    for (int i = 0; i < 12; ++i) { S[(c0 + i) * 128] = xr; S[(c0 + i) * 128 + 64] = xi; const float nr = ar * xr - aim * xi + dr[i], ni = ar * xi + aim * xr + di[i]; xr = nr; xi = ni; }
  }
}
DI void s5_p3(const Params& p, int l, int item, char* smem) {
  const int tid = ltid(), lane = tid & 63, w = __builtin_amdgcn_readfirstlane(tid >> 6), l15 = lane & 15, g4 = lane >> 4;
  const int half = item & 1; const int r2 = item >> 1; const int tcg = r2 % NCH, b = r2 / NCH;
  int part, tc, row0; chunk_geom(tcg, b, part, tc, row0);
  bf16_t* xs = (bf16_t*)smem + w * (16 * 136);
  bf16_t* YG = (bf16_t*)(p.ws + OFF_YG);
  const bf16_t* P = (const bf16_t*)(p.ws + OFF_P);
#pragma unroll 1
  for (int gi = 0; gi < 2; ++gi) {
    const int g = half * 8 + w + 4 * gi;
    const bf16_t* up = P + (size_t)(row0 + lane) * PINP + C_S5 + g * 16;
    bf16_t* us = (bf16_t*)smem + 25600 + w * 1024;
    *(u32x4*)(us + lane * 16) = *(const u32x4*)up; *(u32x4*)(us + lane * 16 + 8) = *(const u32x4*)(up + 8);
    f32x4 yt[4];
#pragma unroll
    for (int ib = 0; ib < 4; ++ib) yt[ib] = (f32x4){0.f, 0.f, 0.f, 0.f};
#pragma unroll
    for (int dir = 0; dir < 2; ++dir) {
      S5Par q; float dtv, lre, lim; s5_params(p, l, dir, g, lane, q, dtv, lre, lim);
      const int c = chain_slot(dir, part, tc);
      const float* S = (const float*)(p.ws + OFF_S5S) + ((size_t)((b * 16 + g) * 2 + dir) * NCH + c) * 128;
      float xr = S[lane], xi = S[64 + lane];
      bf16x8 cf[4];
#pragma unroll
      for (int ks = 0; ks < 4; ++ks) {
        const int k = ks * 32 + g4 * 8;
        const float* src = (k < 64 ? p.s5_c_re : p.s5_c_im) + ((size_t)(l * 16 + g) * 16 + l15) * 64 + (k & 63);
        cf[ks] = frag_from_f32(src, k < 64 ? 1.f : -1.f);
      }
#pragma unroll
      for (int blk = 0; blk < 4; ++blk) {
        asm volatile("s_waitcnt lgkmcnt(0)" ::: "memory");
#pragma unroll 4
        for (int st = 0; st < 16; ++st) {
          const int step = blk * 16 + st, s = dir ? 63 - step : step;
          s5_step(q, us, s, xr, xi);
          xs[(s & 15) * 136 + lane] = f2bf(xr); xs[(s & 15) * 136 + 64 + lane] = f2bf(xi);
        }
        asm volatile("s_waitcnt lgkmcnt(0)" ::: "memory");
        f32x4 a = {0.f, 0.f, 0.f, 0.f};
#pragma unroll
        for (int ks = 0; ks < 4; ++ks) a = MFMA16(ld_frag(xs + l15 * 136 + ks * 32 + g4 * 8), cf[ks], a);
        const int ib = dir ? 3 - blk : blk;
        yt[ib] += a;
      }
    }
#pragma unroll
    for (int ib = 0; ib < 4; ++ib)
#pragma unroll
      for (int j = 0; j < 4; ++j) {
        const int tok = 16 * ib + 4 * g4 + j, ch = g * 16 + l15;
        const float u = bf2f(P[(size_t)(row0 + tok) * PINP + C_S5 + ch]);
        YG[(size_t)(row0 + tok) * 256 + ch] = f2bf(gelu_tanh_f(yt[ib][j] + p.s5_d[l * 256 + ch] * u));
      }
  }
  __syncthreads();
}
DI void glu_item(const Params& p, int l, int item, char* smem) {
  const int mt = item >> 1, nt = item & 1;
  const bf16_t* YG = (const bf16_t*)(p.ws + OFF_YG); bf16_t* Y = (bf16_t*)(p.ws + OFF_HY);
  gemm_tile<0, 0>(YG, 256, (const bf16_t*)(p.ws + OFF_WGLU) + (size_t)l * 256 * 256, 256, 256, mt * 128, nt * 128, smem, nullptr,
                  [&](int row, int col, f32x4 v) {
                    const u32x2 yv = *(const u32x2*)(YG + (size_t)row * 256 + col);
                    f32x4 o; o[0] = bflo(yv.x) * sigm_f(v[0]); o[1] = bfhi(yv.x) * sigm_f(v[1]); o[2] = bflo(yv.y) * sigm_f(v[2]); o[3] = bfhi(yv.y) * sigm_f(v[3]);
                    store_bf4(Y + (size_t)row * 1024 + 768 + col, o);
                  });
}

DI void outproj_item(const Params& p, int l, int item, char* smem) {
  const int mt = item >> 3, nt = item & 7;
  const float* MOD = (const float*)(p.ws + OFF_MOD);
  gemm_tile<1, 2>((const bf16_t*)(p.ws + OFF_HY), 1024, (const bf16_t*)(p.ws + OFF_WOUT) + (size_t)l * 1024 * 1024, 1024, 1024, mt * 128, nt * 128, smem, (const float*)(p.ws + OFF_SSQ),
               [&](int row, int col, f32x4 v) {
                 const int s = row < NLAT ? row / T : 2;
                 const f32x4 gt = *(const f32x4*)(MOD + (size_t)(l * 3 + s) * 6144 + 2048 + col);
                 float* xp = row < NLAT ? p.xb + (size_t)row * 1024 + col : (float*)(p.ws + OFF_CTX) + (size_t)(row - NLAT) * 1024 + col;
                 *(f32x4*)xp = *(f32x4*)xp + gt * v;
               });
}
DI void ffnup_item(const Params& p, int l, int item, char* smem) {
  const int mtile = item / 44, nt = item % 44;
  int seq0, slen, ti;
  if (mtile < 132) { seq0 = (mtile / 66) * T; slen = T; ti = mtile % 66; }
  else { const int j = mtile - 132; seq0 = NLAT + (j / 3) * TC; slen = TC; ti = j % 3; }
  const int m0 = seq0 + 126 * ti - 1, n0 = nt * 128;
  bf16_t* ACT = (bf16_t*)(p.ws + OFF_R);
  bf16_t* Ts = (bf16_t*)smem;
  auto epi = [&](int row, int col, f32x4 v) {
    const int lr = row - m0, c = col - n0, t = 126 * ti - 1 + lr;
    if (c >= 64 && (t < 0 || t >= slen)) v = (f32x4){0.f, 0.f, 0.f, 0.f};
    store_bf4(Ts + lr * 136 + c, v);
  };
  gemm_tile<0, 0, decltype(epi), 1>((const bf16_t*)(p.ws + OFF_HY), 1024, (const bf16_t*)(p.ws + OFF_WUP) + (size_t)l * 5632 * 1024, 1024, 1024, m0, n0, smem, nullptr, epi, seq0, seq0 + slen - 1);
  __syncthreads();
  {
    const int tid = ltid();
    const float* cw = p.ffn_conv_w + (size_t)l * 3 * DFF + nt * 64;
#pragma unroll
    for (int q = 0; q < 4; ++q) {
      const int id = tid + 256 * q, lr = 1 + (id >> 3), c8 = (id & 7) * 8, t = 126 * ti - 1 + lr;
      if (id < 1008 && t < slen) {
        const u32x4 uu = *(const u32x4*)(Ts + lr * 136 + c8), gm = *(const u32x4*)(Ts + (lr - 1) * 136 + 64 + c8), g0 = *(const u32x4*)(Ts + lr * 136 + 64 + c8), gn = *(const u32x4*)(Ts + (lr + 1) * 136 + 64 + c8);
        const float uf[8] = {bflo(uu.x), bfhi(uu.x), bflo(uu.y), bfhi(uu.y), bflo(uu.z), bfhi(uu.z), bflo(uu.w), bfhi(uu.w)};
        const float a[8] = {bflo(gm.x), bfhi(gm.x), bflo(gm.y), bfhi(gm.y), bflo(gm.z), bfhi(gm.z), bflo(gm.w), bfhi(gm.w)};
        const float m[8] = {bflo(g0.x), bfhi(g0.x), bflo(g0.y), bfhi(g0.y), bflo(g0.z), bfhi(g0.z), bflo(g0.w), bfhi(g0.w)};
        const float n[8] = {bflo(gn.x), bfhi(gn.x), bflo(gn.y), bfhi(gn.y), bflo(gn.z), bfhi(gn.z), bflo(gn.w), bfhi(gn.w)};
        float o[8];
#pragma unroll
        for (int j = 0; j < 8; ++j) o[j] = silu_f(cw[c8 + j] * a[j] + cw[DFF + c8 + j] * m[j] + cw[2 * DFF + c8 + j] * n[j]) * uf[j];
        u32x4 ov; ov.x = pack2(o[0], o[1]); ov.y = pack2(o[2], o[3]); ov.z = pack2(o[4], o[5]); ov.w = pack2(o[6], o[7]);
        *(u32x4*)(ACT + (size_t)(seq0 + t) * DFF + nt * 64 + c8) = ov;
      }
    }
  }
  __syncthreads();
}
DI void ffndown_item(const Params& p, int l, int item, char* smem) {
  const int mt = item >> 3, nt = item & 7;
  const float* MOD = (const float*)(p.ws + OFF_MOD);
  gemm_tile<0, 2>((const bf16_t*)(p.ws + OFF_R), DFF, (const bf16_t*)(p.ws + OFF_WDN) + (size_t)l * 1024 * 2816, 2816, 2816, mt * 128, nt * 128, smem, nullptr,
               [&](int row, int col, f32x4 v) {
                 const int s = row < NLAT ? row / T : 2;
                 const f32x4 gt = *(const f32x4*)(MOD + (size_t)(l * 3 + s) * 6144 + 5120 + col);
                 float* xp = row < NLAT ? p.xb + (size_t)row * 1024 + col : (float*)(p.ws + OFF_CTX) + (size_t)(row - NLAT) * 1024 + col;
                 *(f32x4*)xp = *(f32x4*)xp + gt * v;
               });
}
DI void final_item(const Params& p, int item) {
  const int lane = ltid() & 63, w = __builtin_amdgcn_readfirstlane(ltid() >> 6), row = item * 4 + w;
  float* x = p.xb + (size_t)row * 1024;
  float4 v[4]; float ss = 0.f;
#pragma unroll
  for (int i = 0; i < 4; ++i) { v[i] = *(const float4*)(x + (i * 64 + lane) * 4); ss += v[i].x * v[i].x + v[i].y * v[i].y + v[i].z * v[i].z + v[i].w * v[i].w; }
  ss = wave_sum(ss);
  const float rstd = rsqrtf(ss * (1.f / 1024.f) + 1e-6f);
#pragma unroll
  for (int i = 0; i < 4; ++i) {
    const int k = (i * 64 + lane) * 4; const float4 g = *(const float4*)(p.final_norm + k);
    float4 o; o.x = v[i].x * rstd * g.x; o.y = v[i].y * rstd * g.y; o.z = v[i].z * rstd * g.z; o.w = v[i].w * rstd * g.w;
    *(float4*)(x + k) = o;
  }
}

constexpr int PPL = 10;
constexpr int N_PHASES = 2 + NL * PPL;
#define FOR_ITEMS(n) for (int it = blockIdx.x; it < (n); it += gridDim.x)

DI void run_phase(const Params& p, int ph, char* smem) {
  if (ph == 0) {
    FOR_ITEMS(P0_MOD) p0_item(p, it, smem);
    p0_transposes(p, smem);
    for (int it = P0_MOD + P0_TR + blockIdx.x; it < P0_ITEMS; it += gridDim.x) p0_item(p, it, smem);
    return;
  }
  if (ph == N_PHASES - 1) { FOR_ITEMS(NLAT / 4) final_item(p, it); return; }
  const int l = (ph - 1) / PPL, k = (ph - 1) % PPL;
  const int mtiles = (l == NL - 1) ? 128 : 132;
  switch (k) {
    case 0: FOR_ITEMS(NROW / 4) norm_item(p, l, 0, it); break;
    case 1: FOR_ITEMS(138 * 22) gemm_in_item(p, l, it, smem); break;
    case 2: FOR_ITEMS(2112) s5_p1(p, l, it, smem); break;
    case 3: {
      constexpr int n0 = 2112, n1 = n0 + 2112, n2 = n1 + 528, n3 = n2 + 396, n5 = n3 + 66;
      FOR_ITEMS(n5 + 16) {
        if (it < n0) ssd_p1(p, l, it, smem);
        else if (it < n1) mlstm_p1(p, l, it - n0, smem);
        else if (it < n2) kvproj_item(p, l, it - n1, smem);
        else if (it < n3) qproj_item(p, l, it - n2, smem);
        else if (it < n5) ropek_item(p, it - n3);
        else s5_p2(p, l, it - n5);
      }
    } break;
    case 4: {
      constexpr int n0 = 528, n1 = n0 + 512, n2 = n1 + 260;
      FOR_ITEMS(n2) { if (it < n0) s5_p3(p, l, it, smem); else if (it < n1) ssd_p2(p, it - n0); else mlstm_p2(p, it - n1); }
    } break;
    case 5: {
      constexpr int n0 = 528, n2 = n0 + 1056, n3x = n2 + 1056, n3 = n3x + 264;
      const bool late = blockIdx.x >= (gridDim.x >> 1);
      if (!late) { FOR_ITEMS(n0) attn_item(p, it, smem); }
      FOR_ITEMS(n3) {
        if (it < n0) continue;
        if (it < n2) ssd_p3(p, l, it - n0, smem);
        else if (it < n3x) mlstm_p3(p, l, it - n2, smem);
        else glu_item(p, l, it - n3x, smem);
      }
      if (late) { FOR_ITEMS(n0) attn_item(p, it, smem); }
    } break;
    case 6: FOR_ITEMS(mtiles * 8) outproj_item(p, l, it, smem); break;
    case 7: FOR_ITEMS(mtiles * 32) norm_item(p, l, 1, it); break;
    case 8: FOR_ITEMS(((l == NL - 1) ? 132 : 138) * 44) ffnup_item(p, l, it, smem); break;
    case 9: FOR_ITEMS(mtiles * 8) ffndown_item(p, l, it, smem); break;
  }
}

#ifndef HASH_LO
#define HASH_LO OFF_MOD
#define HASH_HI WS_NEED
#endif
#ifndef PROBE_N
#define PROBE_N 0
#endif
DI void hash_dump(const Params& p) {
  const size_t NOUT = (size_t)NLAT * 1024, nw = (HASH_HI - HASH_LO) / 4;
  const unsigned* wsw = (const unsigned*)(p.ws + HASH_LO);
  for (size_t i = (size_t)blockIdx.x * 256 + threadIdx.x; i < NOUT; i += (size_t)gridDim.x * 256) {
    unsigned h = 12345u;
    for (size_t j = i; j < nw; j += NOUT) h = h * 1664525u + wsw[j];
    p.xb[i] = (float)(h & 0xFFFFFFu);
  }
}

#define XB_TMO      128
#define XB_XCNT(j)  (256  + 64 * (j))
#define XB_XSUB(j)  (1280 + 64 * (j))
#define XB_XGEN(j)  (2304 + 64 * (j))
#define XB_TOP      3328
#define XB_TOPGEN   3392
#define XCD_BAR_WORDS 3456
#define XB_SPIN_CAP (1u << 22)
#define LAS __attribute__((address_space(3)))
DI unsigned xb_ld(unsigned* p) { return __hip_atomic_load(p, __ATOMIC_RELAXED, __HIP_MEMORY_SCOPE_AGENT); }
DI unsigned xb_add(unsigned* p, unsigned v) { return __hip_atomic_fetch_add(p, v, __ATOMIC_RELAXED, __HIP_MEMORY_SCOPE_AGENT); }
DI unsigned xb_xcc_id() { return (unsigned)__builtin_amdgcn_s_getreg((3 << 11) | 20) & 0xFu; }
#define XB_SPIN(cond, bar) do { unsigned _sp = 0; while (cond) { __builtin_amdgcn_s_sleep(1); \
    if ((++_sp & 255u) == 0u) { if (xb_ld(&(bar)[XB_TMO])) break; if (_sp > XB_SPIN_CAP) { atomicAdd(&(bar)[XB_TMO], 1u); break; } } } } while (0)
struct XcdBarrier { unsigned* bar; unsigned x; volatile LAS unsigned* st; };
DI XcdBarrier xcd_barrier_post(unsigned* bar, volatile LAS unsigned* st) {
  XcdBarrier b; b.bar = bar; b.x = xb_xcc_id(); b.st = st;
  if (threadIdx.x == 0) (void)xb_add(&bar[XB_XCNT(b.x)], 1u);
  return b;
}
DI void xcd_barrier_complete(unsigned* bar, unsigned x, unsigned& nloc, unsigned& nx) {
  const unsigned G = gridDim.x;
  unsigned sum, cnt, mine, sp = 0u;
  for (;;) {
    sum = 0u; cnt = 0u; mine = 0u;
#pragma unroll
    for (unsigned j = 0; j < 16; ++j) { const unsigned c = xb_ld(&bar[XB_XCNT(j)]); sum += c; cnt += (c > 0u) ? 1u : 0u; mine = (j == x) ? c : mine; }
    if (sum == G) break;
    __builtin_amdgcn_s_sleep(1);
    if ((++sp & 255u) == 0u) { if (xb_ld(&bar[XB_TMO])) break; if (sp > XB_SPIN_CAP) { atomicAdd(&bar[XB_TMO], 1u); break; } }
  }
  nloc = mine > 0u ? mine : 1u; nx = cnt > 0u ? cnt : 1u;
}
DI void xcd_barrier(const XcdBarrier& b) {
  asm volatile("s_waitcnt vmcnt(0)" ::: "memory");
  __syncthreads();
  if (threadIdx.x == 0) {
    unsigned* bar = b.bar;
    __builtin_amdgcn_s_waitcnt(0);
    unsigned nloc = b.st[0], nx = b.st[1];
    if (nloc == 0u) { xcd_barrier_complete(bar, b.x, nloc, nx); b.st[0] = nloc; b.st[1] = nx; }
    const unsigned old = xb_add(&bar[XB_XSUB(b.x)], 1u);
    const unsigned gen = old / nloc;
    if (old + 1u == (gen + 1u) * nloc) {
      __builtin_amdgcn_fence(__ATOMIC_RELEASE, "agent");
      asm volatile("s_waitcnt vmcnt(0)" ::: "memory");
      const unsigned og = xb_add(&bar[XB_TOP], 1u);
      const unsigned tg = og / nx;
      if (og + 1u == (tg + 1u) * nx) xb_add(&bar[XB_TOPGEN], 1u);
      else XB_SPIN(xb_ld(&bar[XB_TOPGEN]) == tg, bar);
      __builtin_amdgcn_fence(__ATOMIC_ACQUIRE, "agent");
      xb_add(&bar[XB_XGEN(b.x)], 1u);
      asm volatile("s_waitcnt vmcnt(0)" ::: "memory");
    } else {
      XB_SPIN(xb_ld(&bar[XB_XGEN(b.x)]) == gen, bar);
      __builtin_amdgcn_fence(__ATOMIC_ACQUIRE, "agent");
      asm volatile("s_waitcnt vmcnt(0)" ::: "memory");
    }
  }
  __syncthreads();
}
constexpr int SMEM_BYTES = 73728 + 512;
__global__ void __launch_bounds__(256, 2) trunk_fwd(Params p) {
  extern __shared__ __attribute__((aligned(16))) char smem[];
  __shared__ uint4 xb_words;
  cg::grid_group grid = cg::this_grid();
  if (threadIdx.x == 0) xb_words = make_uint4(0u, 0u, 0u, 0u);
  __syncthreads();
  XcdBarrier xb = xcd_barrier_post((unsigned*)(p.ws + OFF_BAR), (volatile LAS unsigned*)&xb_words);
  for (int ph = p.ph_lo; ph < p.ph_hi; ++ph) {
    run_phase(p, ph, smem);
    if (ph + 1 < p.ph_hi) { if (ph == p.ph_lo) grid.sync(); else xcd_barrier(xb); }
  }
}

__global__ void __launch_bounds__(256) hash_kernel(Params p) { hash_dump(p); }

extern "C" void kernel_launch(void* const* d_in, const int* in_sizes, int n_in, void* d_out, int out_size, void* d_ws, size_t ws_size, hipStream_t stream) {
  static int grid_blocks = 0;
  if (!grid_blocks) {
    int dev = 0, cus = 0, per_cu = 0;
    hipGetDevice(&dev);
    hipDeviceGetAttribute(&cus, hipDeviceAttributeMultiprocessorCount, dev);
    if (hipFuncSetAttribute((const void*)trunk_fwd, hipFuncAttributeMaxDynamicSharedMemorySize, SMEM_BYTES) != hipSuccess) fprintf(stderr, "hipFuncSetAttribute(%d B LDS) failed\n", SMEM_BYTES);
    hipOccupancyMaxActiveBlocksPerMultiprocessor(&per_cu, trunk_fwd, 256, SMEM_BYTES);
    if (per_cu > 2) per_cu = 2;
    grid_blocks = cus * per_cu;
  }
  if (ws_size < OFF_BAR + XCD_BAR_WORDS * 4) { fprintf(stderr, "workspace too small: %zu < %zu\n", ws_size, (size_t)WS_NEED); return; }
  Params p{};
  const float** fp = (const float**)&p;
  for (int i = 0; i < 35; ++i) fp[i] = (const float*)d_in[i];
  p.xb = (float*)d_out; p.ws = (char*)d_ws;
#if MULTI_LAUNCH
#if PROBE_N
  for (int ph = 0; ph < PROBE_N; ++ph) { p.ph_lo = ph; p.ph_hi = ph + 1; hipLaunchKernelGGL(trunk_fwd, dim3(grid_blocks), dim3(256), 0, stream, p); }
  hipLaunchKernelGGL(hash_kernel, dim3(grid_blocks), dim3(256), 0, stream, p);
#else
  for (int ph = 0; ph < N_PHASES; ++ph) { p.ph_lo = ph; p.ph_hi = ph + 1; hipLaunchKernelGGL(trunk_fwd, dim3(grid_blocks), dim3(256), 0, stream, p); }
#endif
#else
  p.ph_lo = 0; p.ph_hi = N_PHASES;
  hipMemsetAsync((char*)d_ws + OFF_BAR, 0, XCD_BAR_WORDS * 4, stream);
  void* args[] = {&p};
  hipError_t e = hipLaunchCooperativeKernel((void*)trunk_fwd, dim3(grid_blocks), dim3(256), args, SMEM_BYTES, stream);
  if (e != hipSuccess) fprintf(stderr, "cooperative launch failed: %s (grid %d)\n", hipGetErrorString(e), grid_blocks);
#endif
}
```

```cpp
#include <hip/hip_runtime.h>
#include <hip/hip_cooperative_groups.h>
#include <cstdio>
#include <cstdint>
namespace cg = cooperative_groups;

#ifndef PROBE_MASK
#define PROBE_MASK 63
#endif
#ifndef ZERO_FILL
#define ZERO_FILL 0
#endif
#ifndef MULTI_LAUNCH
#define MULTI_LAUNCH 0
#endif

typedef unsigned short bf16_t;
typedef short bf16x8 __attribute__((ext_vector_type(8)));
typedef float f32x4 __attribute__((ext_vector_type(4)));
typedef unsigned u32x4 __attribute__((ext_vector_type(4)));
typedef unsigned u32x2 __attribute__((ext_vector_type(2)));
#define DI __device__ __forceinline__
#define MFMA16(a, b, c) __builtin_amdgcn_mfma_f32_16x16x32_bf16((a), (b), (c), 0, 0, 0)

constexpr int NB = 2, T = 8192, TC = 256, NL = 4;
constexpr int NLAT = NB * T, NROW = NLAT + NB * TC;
constexpr int TALL = T + TC;
constexpr int PINP = 2816;
constexpr int C_MLQ = 0, C_MLK = 256, C_MLV = 512, C_MLO = 768, C_CQ = 1040, C_CKV = 1296, C_KR = 1424,
              C_Z = 1456, C_XBC = 1712, C_S5 = 2488;
constexpr int NCH = 132;
constexpr int DFF = 2816;

constexpr size_t SZ_WIN = (size_t)NL * 2816 * 1024 * 2, SZ_WUQ = (size_t)NL * 384 * 256 * 2, SZ_WUKV = (size_t)NL * 512 * 128 * 2,
                 SZ_WGLU = (size_t)NL * 256 * 256 * 2, SZ_WOUT = (size_t)NL * 1024 * 1024 * 2, SZ_WUP = (size_t)NL * 5632 * 1024 * 2,
                 SZ_WDN = (size_t)NL * 1024 * 2816 * 2, SZ_MOD = (size_t)NL * 3 * 6144 * 4, SZ_CTX = (size_t)512 * 1024 * 4,
                 SZ_HY = (size_t)NROW * 1024 * 2, SZ_GML = (size_t)NROW * 16 * 4, SZ_DTR = (size_t)NROW * 8 * 4, SZ_SSQ = (size_t)NROW * 4 * 4,
                 SZ_QRAW = (size_t)NROW * 384 * 2, SZ_KH = (size_t)NB * 4 * TALL * 64 * 2 + (size_t)NB * TALL * 32 * 2, SZ_VT = (size_t)NB * 4 * 64 * TALL * 2,
                 SZ_S5S = (size_t)NB * 16 * 2 * NCH * 128 * 4, SZ_MLM = (size_t)16 * NCH * 32 * 4, SZ_SSA = (size_t)16 * NCH * 32 * 4,
                 SZ_P = (size_t)NROW * PINP * 2, SZ_MLS = (size_t)16 * NCH * 4160 * 4, SZ_SSDS = (size_t)16 * NCH * 8192 * 4;
constexpr size_t OFF_WIN = 0, OFF_WUQ = OFF_WIN + SZ_WIN, OFF_WUKV = OFF_WUQ + SZ_WUQ, OFF_WGLU = OFF_WUKV + SZ_WUKV,
                 OFF_WOUT = OFF_WGLU + SZ_WGLU, OFF_WUP = OFF_WOUT + SZ_WOUT, OFF_WDN = OFF_WUP + SZ_WUP, OFF_MOD = OFF_WDN + SZ_WDN,
                 OFF_CTX = OFF_MOD + SZ_MOD, OFF_HY = OFF_CTX + SZ_CTX, OFF_GML = OFF_HY + SZ_HY, OFF_DTR = OFF_GML + SZ_GML,
                 OFF_SSQ = OFF_DTR + SZ_DTR, OFF_QRAW = OFF_SSQ + SZ_SSQ, OFF_KH = OFF_QRAW + SZ_QRAW, OFF_VT = OFF_KH + SZ_KH,
                 OFF_S5S = OFF_VT + SZ_VT, OFF_MLM = OFF_S5S + SZ_S5S, OFF_SSA = OFF_MLM + SZ_MLM,
                 OFF_R = ((OFF_SSA + SZ_SSA + 255) / 256) * 256, OFF_P = OFF_R, OFF_MLS = OFF_P + SZ_P, OFF_SSDS = OFF_MLS + SZ_MLS,
                 WS_NEED = OFF_SSDS + SZ_SSDS;
static_assert((size_t)NROW * 5632 * 2 <= SZ_P + SZ_MLS + SZ_SSDS, "UG overlay");

constexpr size_t OFF_KR = OFF_KH + (size_t)NB * 4 * TALL * 64 * 2;
constexpr size_t OFF_YG = ((WS_NEED + 255) / 256) * 256;
constexpr size_t OFF_BAR = OFF_YG + (size_t)NROW * 256 * 2;
struct Params {
  const float *x, *c, *ctx, *c_ctx, *w_mod, *b_mod, *norm1, *norm2, *w_in, *ml_gate_bias, *ml_norm, *mla_q_norm, *mla_kv_norm,
      *mla_w_uq, *mla_w_ukv, *ssd_conv_w, *ssd_conv_b, *ssd_a_log, *ssd_dt_bias, *ssd_d, *ssd_norm, *s5_a_re, *s5_a_im, *s5_log_dt,
      *s5_b_re, *s5_b_im, *s5_c_re, *s5_c_im, *s5_d, *s5_w_glu, *w_out, *ffn_w_up, *ffn_conv_w, *ffn_w_down, *final_norm;
  float* xb;
  char* ws;
  int ph_lo, ph_hi;
};

typedef __bf16 hbf16x2 __attribute__((ext_vector_type(2)));
typedef float f32x2 __attribute__((ext_vector_type(2)));
DI bf16_t f2bf(float x) { return __builtin_bit_cast(bf16_t, (__bf16)x); }
DI float bf2f(bf16_t v) { return __uint_as_float(((unsigned)v) << 16); }
DI unsigned pack2(float lo, float hi) { f32x2 v = {lo, hi}; return __builtin_bit_cast(unsigned, __builtin_convertvector(v, hbf16x2)); }
DI float bflo(unsigned w) { return __uint_as_float(w << 16); }
DI float bfhi(unsigned w) { return __uint_as_float(w & 0xffff0000u); }
DI float silu_f(float x) { return x / (1.f + __expf(-x)); }
DI float sigm_f(float x) { return 1.f / (1.f + __expf(-x)); }
DI float softplus_f(float x) { return fmaxf(x, 0.f) + log1pf(__expf(-fabsf(x))); }
DI float logsigm_f(float x) { return fminf(x, 0.f) - log1pf(__expf(-fabsf(x))); }
DI float gelu_tanh_f(float x) { float u = 0.7978845608f * (x + 0.044715f * x * x * x); return x * sigm_f(2.f * u); }
DI float wave_sum(float v) { for (int o = 32; o; o >>= 1) v += __shfl_xor(v, o); return v; }
DI float wave_max(float v) { for (int o = 32; o; o >>= 1) v = fmaxf(v, __shfl_xor(v, o)); return v; }
DI float wave_incl_scan(float v, int lane) { for (int o = 1; o < 64; o <<= 1) { float t = __shfl_up(v, o); if (lane >= o) v += t; } return v; }
DI float red16_max(float v) { v = fmaxf(v, __shfl_xor(v, 1)); v = fmaxf(v, __shfl_xor(v, 2)); v = fmaxf(v, __shfl_xor(v, 4)); v = fmaxf(v, __shfl_xor(v, 8)); return v; }
DI float red16_sum(float v) { v += __shfl_xor(v, 1); v += __shfl_xor(v, 2); v += __shfl_xor(v, 4); v += __shfl_xor(v, 8); return v; }
DI bf16x8 ld_frag(const bf16_t* p) { return *(const bf16x8*)p; }
DI bf16x8 mk_frag(unsigned a, unsigned b, unsigned c, unsigned d) { u32x4 u = {a, b, c, d}; return __builtin_bit_cast(bf16x8, u); }
DI bf16x8 frag_from_f32(const float* p, float sgn) {
  float4 a = *(const float4*)p, b = *(const float4*)(p + 4);
  return mk_frag(pack2(a.x * sgn, a.y * sgn), pack2(a.z * sgn, a.w * sgn), pack2(b.x * sgn, b.y * sgn), pack2(b.z * sgn, b.w * sgn));
}
DI int ltid() { int t = threadIdx.x; asm volatile("" : "+v"(t)); return t; }
DI int row_of(int b, int part, int t) { return part ? NLAT + b * TC + t : b * T + t; }

DI void tr_tile(const float* __restrict__ src, int K, int N, bf16_t* __restrict__ dst, const float* gain, int glo, int ghi, int tk, int tn, float* tile, int drow0 = -1) {
  const int tid = ltid(), c4 = tid & 15, rq = tid >> 4;
  const bool vec = (N & 3) == 0;
#pragma unroll
  for (int rr = 0; rr < 4; ++rr) {
    const int r = rr * 16 + rq, k = tk * 64 + r, n = tn * 64 + c4 * 4;
    float4 v;
    if (vec && n + 3 < N) v = *(const float4*)(src + (size_t)k * N + n);
    else { v.x = n < N ? src[(size_t)k * N + n] : 0.f; v.y = n + 1 < N ? src[(size_t)k * N + n + 1] : 0.f; v.z = n + 2 < N ? src[(size_t)k * N + n + 2] : 0.f; v.w = n + 3 < N ? src[(size_t)k * N + n + 3] : 0.f; }
    if (gain && k >= glo && k < ghi) { const float g = gain[k - glo]; v.x *= g; v.y *= g; v.z *= g; v.w *= g; }
    *(float4*)(tile + r * 68 + c4 * 4) = v;
  }
  __syncthreads();
#pragma unroll
  for (int q = 0; q < 2; ++q) {
    const int id = tid + 256 * q, n = id >> 3, k0 = (id & 7) * 8;
    u32x4 o;
    o.x = pack2(tile[(k0 + 0) * 68 + n], tile[(k0 + 1) * 68 + n]); o.y = pack2(tile[(k0 + 2) * 68 + n], tile[(k0 + 3) * 68 + n]);
    o.z = pack2(tile[(k0 + 4) * 68 + n], tile[(k0 + 5) * 68 + n]); o.w = pack2(tile[(k0 + 6) * 68 + n], tile[(k0 + 7) * 68 + n]);
    *(u32x4*)(dst + (size_t)((drow0 >= 0 ? drow0 : tn * 64) + n) * K + tk * 64 + k0) = o;
  }
  __syncthreads();
}

constexpr int TR_PER_LAYER = 3128, P0_TR = NL * TR_PER_LAYER, P0_MOD = NL * 96, P0_CPX = NLAT * 1024 / 4096, P0_CPC = 512 * 1024 / 4096;
constexpr int P0_ZERO = (int)((WS_NEED - OFF_HY + 65535) / 65536);
constexpr int P0_ITEMS = P0_TR + P0_MOD + P0_CPX + P0_CPC + (ZERO_FILL ? P0_ZERO : 0);

DI void p0_item(const Params& p, int item, char* smem) {
  const int tid = ltid();
  if (item < P0_MOD) {
    const int l = item / 96, cb = item % 96, cl = tid & 63, kq = tid >> 6;
    float* sv = (float*)smem;
    float* red = sv + 3072;
    for (int i = tid; i < 1024; i += 256) { sv[i] = silu_f(p.c[i]); sv[1024 + i] = silu_f(p.c[1024 + i]); sv[2048 + i] = silu_f(p.c_ctx[i]); }
    __syncthreads();
    const int col = cb * 64 + cl; const float* W = p.w_mod + (size_t)l * 1024 * 6144 + col;
    float a0 = 0.f, a1 = 0.f, a2 = 0.f;
#pragma unroll 16
    for (int k = kq * 256; k < kq * 256 + 256; ++k) { const float w = W[(size_t)k * 6144]; a0 += sv[k] * w; a1 += sv[1024 + k] * w; a2 += sv[2048 + k] * w; }
    red[(kq * 3 + 0) * 64 + cl] = a0; red[(kq * 3 + 1) * 64 + cl] = a1; red[(kq * 3 + 2) * 64 + cl] = a2;
    __syncthreads();
    if (tid < 192) {
      const int s = tid >> 6; const float bm = p.b_mod[l * 6144 + col];
      const float v = red[(0 * 3 + s) * 64 + cl] + red[(1 * 3 + s) * 64 + cl] + red[(2 * 3 + s) * 64 + cl] + red[(3 * 3 + s) * 64 + cl] + bm;
      ((float*)(p.ws + OFF_MOD))[(size_t)(l * 3 + s) * 6144 + col] = v;
    }
    __syncthreads();
    return;
  }
  item -= P0_MOD;
  if (item < P0_TR) {
    const int l = item / TR_PER_LAYER; int t = item % TR_PER_LAYER; float* tile = (float*)smem;
    if (t < 704) { tr_tile(p.w_in + (size_t)l * 1024 * 2744, 1024, 2744, (bf16_t*)(p.ws + OFF_WIN) + (size_t)l * 2816 * 1024, nullptr, 0, 0, t / 44, t % 44, tile); return; }
    t -= 704;
    if (t < 24) { tr_tile(p.mla_w_uq + (size_t)l * 256 * 384, 256, 384, (bf16_t*)(p.ws + OFF_WUQ) + (size_t)l * 384 * 256, p.mla_q_norm + l * 256, 0, 256, t / 6, t % 6, tile); return; }
    t -= 24;
    if (t < 16) { tr_tile(p.mla_w_ukv + (size_t)l * 128 * 512, 128, 512, (bf16_t*)(p.ws + OFF_WUKV) + (size_t)l * 512 * 128, p.mla_kv_norm + l * 128, 0, 128, t / 8, t % 8, tile); return; }
    t -= 16;
    if (t < 16) { tr_tile(p.s5_w_glu + (size_t)l * 256 * 256, 256, 256, (bf16_t*)(p.ws + OFF_WGLU) + (size_t)l * 256 * 256, nullptr, 0, 0, t / 4, t % 4, tile); return; }
    t -= 16;
    if (t < 256) { tr_tile(p.w_out + (size_t)l * 1024 * 1024, 1024, 1024, (bf16_t*)(p.ws + OFF_WOUT) + (size_t)l * 1024 * 1024, p.ssd_norm + l * 256, 512, 768, t / 16, t % 16, tile); return; }
    t -= 256;
    if (t < 1408) { tr_tile(p.ffn_w_up + (size_t)l * 1024 * 5632, 1024, 5632, (bf16_t*)(p.ws + OFF_WUP) + (size_t)l * 5632 * 1024, nullptr, 0, 0, t / 88, t % 88, tile, (t % 88) < 44 ? (t % 88) * 128 : ((t % 88) - 44) * 128 + 64); return; }
    t -= 1408;
    tr_tile(p.ffn_w_down + (size_t)l * 2816 * 1024, 2816, 1024, (bf16_t*)(p.ws + OFF_WDN) + (size_t)l * 1024 * 2816, nullptr, 0, 0, t / 16, t % 16, tile);
    return;
  }
  item -= P0_TR;
  if (item >= P0_CPX + P0_CPC) {
    item -= P0_CPX + P0_CPC;
    char* z = p.ws + OFF_HY + (size_t)item * 65536;
    const size_t lim = WS_NEED - OFF_HY - (size_t)item * 65536;
    for (int i = 0; i < 16; ++i) { const size_t o = (size_t)(i * 256 + tid) * 16; if (o < lim) *(u32x4*)(z + o) = (u32x4){0u, 0u, 0u, 0u}; }
    return;
  }
  const float* src; float* dst;
  if (item < P0_CPX) { src = p.x + (size_t)item * 4096; dst = p.xb + (size_t)item * 4096; }
  else { item -= P0_CPX; src = p.ctx + (size_t)item * 4096; dst = (float*)(p.ws + OFF_CTX) + (size_t)item * 4096; }
  for (int i = 0; i < 4; ++i) { const int o = (i * 256 + tid) * 4; *(float4*)(dst + o) = *(const float4*)(src + o); }
}


struct TrD { const float* src; bf16_t* dst; const float* gain; int K, N, glo, ghi, tk, tn, drow0; };
DI TrD tr_desc(const Params& p, int item) {
  const int l = item / TR_PER_LAYER; int t = item % TR_PER_LAYER; TrD d; d.gain = nullptr; d.glo = 0; d.ghi = 0; d.drow0 = -1;
  if (t < 704) { d.src = p.w_in + (size_t)l * 1024 * 2744; d.K = 1024; d.N = 2744; d.dst = (bf16_t*)(p.ws + OFF_WIN) + (size_t)l * 2816 * 1024; d.tk = t / 44; d.tn = t % 44; return d; }
  t -= 704;
  if (t < 24) { d.src = p.mla_w_uq + (size_t)l * 256 * 384; d.K = 256; d.N = 384; d.dst = (bf16_t*)(p.ws + OFF_WUQ) + (size_t)l * 384 * 256; d.gain = p.mla_q_norm + l * 256; d.ghi = 256; d.tk = t / 6; d.tn = t % 6; return d; }
  t -= 24;
  if (t < 16) { d.src = p.mla_w_ukv + (size_t)l * 128 * 512; d.K = 128; d.N = 512; d.dst = (bf16_t*)(p.ws + OFF_WUKV) + (size_t)l * 512 * 128; d.gain = p.mla_kv_norm + l * 128; d.ghi = 128; d.tk = t / 8; d.tn = t % 8; return d; }
  t -= 16;
  if (t < 16) { d.src = p.s5_w_glu + (size_t)l * 256 * 256; d.K = 256; d.N = 256; d.dst = (bf16_t*)(p.ws + OFF_WGLU) + (size_t)l * 256 * 256; d.tk = t / 4; d.tn = t % 4; return d; }
  t -= 16;
  if (t < 256) { d.src = p.w_out + (size_t)l * 1024 * 1024; d.K = 1024; d.N = 1024; d.dst = (bf16_t*)(p.ws + OFF_WOUT) + (size_t)l * 1024 * 1024; d.gain = p.ssd_norm + l * 256; d.glo = 512; d.ghi = 768; d.tk = t / 16; d.tn = t % 16; return d; }
  t -= 256;
  if (t < 1408) { d.src = p.ffn_w_up + (size_t)l * 1024 * 5632; d.K = 1024; d.N = 5632; d.dst = (bf16_t*)(p.ws + OFF_WUP) + (size_t)l * 5632 * 1024; d.tk = t / 88; d.tn = t % 88;
    d.drow0 = d.tn < 44 ? d.tn * 128 : (d.tn - 44) * 128 + 64; return d; }
  t -= 1408;
  d.src = p.ffn_w_down + (size_t)l * 2816 * 1024; d.K = 2816; d.N = 1024; d.dst = (bf16_t*)(p.ws + OFF_WDN) + (size_t)l * 1024 * 2816; d.tk = t / 16; d.tn = t % 16; return d;
}
DI void tr_load(const TrD& d, float4 (&v)[4]) {
  const int tid = ltid(), c4 = tid & 15, rq = tid >> 4;
  const bool vec = (d.N & 3) == 0;
#pragma unroll
  for (int rr = 0; rr < 4; ++rr) {
    const int r = rr * 16 + rq, k = d.tk * 64 + r, n = d.tn * 64 + c4 * 4;
    const float* s = d.src + (size_t)k * d.N + n;
    if (vec && n + 3 < d.N) v[rr] = *(const float4*)s;
    else { v[rr].x = n < d.N ? s[0] : 0.f; v[rr].y = n + 1 < d.N ? s[1] : 0.f; v[rr].z = n + 2 < d.N ? s[2] : 0.f; v[rr].w = n + 3 < d.N ? s[3] : 0.f; }
  }
}
DI void tr_finish(const TrD& d, const float4 (&v)[4], float* tile) {
  const int tid = ltid(), c4 = tid & 15, rq = tid >> 4;
#pragma unroll
  for (int rr = 0; rr < 4; ++rr) {
    const int r = rr * 16 + rq, k = d.tk * 64 + r;
    float4 x = v[rr];
    if (d.gain && k >= d.glo && k < d.ghi) { const float g = d.gain[k - d.glo]; x.x *= g; x.y *= g; x.z *= g; x.w *= g; }
    *(float4*)(tile + r * 68 + c4 * 4) = x;
  }
  __syncthreads();
#pragma unroll
  for (int q = 0; q < 2; ++q) {
    const int id = tid + 256 * q, n = id >> 3, k0 = (id & 7) * 8;
    u32x4 o;
    o.x = pack2(tile[(k0 + 0) * 68 + n], tile[(k0 + 1) * 68 + n]); o.y = pack2(tile[(k0 + 2) * 68 + n], tile[(k0 + 3) * 68 + n]);
    o.z = pack2(tile[(k0 + 4) * 68 + n], tile[(k0 + 5) * 68 + n]); o.w = pack2(tile[(k0 + 6) * 68 + n], tile[(k0 + 7) * 68 + n]);
    *(u32x4*)(d.dst + (size_t)((d.drow0 >= 0 ? d.drow0 : d.tn * 64) + n) * d.K + d.tk * 64 + k0) = o;
  }
  __syncthreads();
}
DI void p0_transposes(const Params& p, char* smem) {
  float* tile = (float*)smem;
  int t = blockIdx.x;
  if (t >= P0_TR) return;
  TrD d = tr_desc(p, t); float4 v[4]; tr_load(d, v);
  for (;;) {
    const int t1 = t + gridDim.x; const bool has = t1 < P0_TR;
    TrD d1 = d; float4 v1[4];
    if (has) { d1 = tr_desc(p, t1); tr_load(d1, v1); }
    tr_finish(d, v, tile);
    if (!has) break;
    d = d1; t = t1;
#pragma unroll
    for (int i = 0; i < 4; ++i) v[i] = v1[i];
  }
}

DI void norm_item(const Params& p, int l, int which, int item) {
  const int lane = ltid() & 63, w = __builtin_amdgcn_readfirstlane(ltid() >> 6), row = item * 4 + w;
  const float* x = row < NLAT ? p.xb + (size_t)row * 1024 : (const float*)(p.ws + OFF_CTX) + (size_t)(row - NLAT) * 1024;
  float4 v[4]; float ss = 0.f;
#pragma unroll
  for (int i = 0; i < 4; ++i) { v[i] = *(const float4*)(x + (i * 64 + lane) * 4); ss += v[i].x * v[i].x + v[i].y * v[i].y + v[i].z * v[i].z + v[i].w * v[i].w; }
  ss = wave_sum(ss);
  const float rstd = rsqrtf(ss * (1.f / 1024.f) + 1e-6f);
  const int s = row < NLAT ? row / T : 2;
  const float* g = (which ? p.norm2 : p.norm1) + l * 1024;
  const float* md = (const float*)(p.ws + OFF_MOD) + (size_t)(l * 3 + s) * 6144 + (which ? 3072 : 0);
  bf16_t* H = (bf16_t*)(p.ws + OFF_HY) + (size_t)row * 1024;
#pragma unroll
  for (int i = 0; i < 4; ++i) {
    const int k = (i * 64 + lane) * 4;
    const float4 g4 = *(const float4*)(g + k), sh = *(const float4*)(md + k), sc = *(const float4*)(md + 1024 + k);
    u32x2 o; o.x = pack2(v[i].x * rstd * g4.x * (1.f + sc.x) + sh.x, v[i].y * rstd * g4.y * (1.f + sc.y) + sh.y);
    o.y = pack2(v[i].z * rstd * g4.z * (1.f + sc.z) + sh.z, v[i].w * rstd * g4.w * (1.f + sc.w) + sh.w);
    *(u32x2*)(H + k) = o;
  }
}

DI u32x4 scale_bf8(u32x4 q, float s) {
  q.x = pack2(bflo(q.x) * s, bfhi(q.x) * s); q.y = pack2(bflo(q.y) * s, bfhi(q.y) * s);
  q.z = pack2(bflo(q.z) * s, bfhi(q.z) * s); q.w = pack2(bflo(q.w) * s, bfhi(q.w) * s); return q;
}
#define GEMM_STEP(AR, BR, KT, CUR)                                                                                    \
  {                                                                                                                   \
    bf16_t* Aw = As + (1 - (CUR)) * GBUF; bf16_t* Bw = Aw + 128 * 72;                                                 \
    const bf16_t* Ac = As + (CUR) * GBUF; const bf16_t* Bc = Ac + 128 * 72;                                           \
    if ((KT) + 1 < nk) {                                                                                              \
      if (AMODE == 1 && (KT) + 1 >= 8 && (KT) + 1 < 12) {                                                             \
        _Pragma("unroll") for (int i = 0; i < 4; ++i) AR[i] = scale_bf8(AR[i], rs[i]);                                \
      }                                                                                                               \
      _Pragma("unroll") for (int i = 0; i < 4; ++i) { *(u32x4*)(Aw + (r0 + 32 * i) * 72 + cc * 8) = AR[i]; *(u32x4*)(Bw + (r0 + 32 * i) * 72 + cc * 8) = BR[i]; } \
    }                                                                                                                 \
    if ((KT) + 3 < nk) {                                                                                              \
      _Pragma("unroll") for (int i = 0; i < 4; ++i) { AR[i] = *(const u32x4*)((CLAMP ? apx[i] : ap + i * astep) + ((KT) + 3) * 64); BR[i] = *(const u32x4*)(bp + i * bstep + ((KT) + 3) * 64); } \
    }                                                                                                                 \
    __builtin_amdgcn_sched_barrier(0);                                                                                \
    __builtin_amdgcn_s_setprio(1);                                                                                    \
    _Pragma("unroll") for (int ks = 0; ks < 2; ++ks) {                                                                \
      bf16x8 af[4], bfr[4];                                                                                           \
      _Pragma("unroll") for (int i = 0; i < 4; ++i) { af[i] = ld_frag(Ac + (64 * wm + 16 * i + l15) * 72 + ks * 32 + g4 * 8); bfr[i] = ld_frag(Bc + (64 * wn + 16 * i + l15) * 72 + ks * 32 + g4 * 8); } \
      _Pragma("unroll") for (int i = 0; i < 4; ++i)                                                                   \
        _Pragma("unroll") for (int j = 0; j < 4; ++j) acc[i][j] = MFMA16(bfr[j], af[i], acc[i][j]);                   \
    }                                                                                                                 \
    __builtin_amdgcn_s_setprio(0);                                                                                    \
    __syncthreads();                                                                                                  \
  }
template <int AMODE, int STAGE, class Epi, int CLAMP = 0>
DI void gemm_tile(const bf16_t* __restrict__ A, int lda, const bf16_t* __restrict__ Bt, int ldb, int K, int m0, int n0, char* smem, const float* ssq, Epi epi, int rlo = 0, int rhi = 0) {
  bf16_t* As = (bf16_t*)smem; bf16_t* Bs = As + 128 * 72;
  const int tid = ltid(), lane = tid & 63, w = __builtin_amdgcn_readfirstlane(tid >> 6), wm = w >> 1, wn = w & 1, l15 = lane & 15, g4 = lane >> 4;
  u32x4 ar0[4], br0[4], ar1[4], br1[4]; float rs[4];
  const int r0 = tid >> 3, cc = tid & 7;
  const bf16_t* ap = A + (size_t)(m0 + r0) * lda + cc * 8;
  const bf16_t* bp = Bt + (size_t)(n0 + r0) * ldb + cc * 8;
  const size_t astep = (size_t)32 * lda, bstep = (size_t)32 * ldb;
  const bf16_t* apx[4];
  if (CLAMP) {
#pragma unroll
    for (int i = 0; i < 4; ++i) { int r = m0 + r0 + 32 * i; r = r < rlo ? rlo : (r > rhi ? rhi : r); apx[i] = A + (size_t)r * lda + cc * 8; }
  }
  if (AMODE == 1) {
#pragma unroll
    for (int i = 0; i < 4; ++i) { const float* q = ssq + (m0 + r0 + 32 * i); rs[i] = rsqrtf((q[0] + q[NROW] + q[2 * NROW] + q[3 * NROW]) * (1.f / 256.f) + 1e-6f); }
  }
  f32x4 acc[4][4];
#pragma unroll
  for (int i = 0; i < 4; ++i)
#pragma unroll
    for (int j = 0; j < 4; ++j) acc[i][j] = (f32x4){0.f, 0.f, 0.f, 0.f};
  const int nk = K >> 6;
#pragma unroll
  for (int i = 0; i < 4; ++i) { ar0[i] = *(const u32x4*)(CLAMP ? apx[i] : ap + i * astep); br0[i] = *(const u32x4*)(bp + i * bstep); }
  constexpr int GBUF = 2 * 128 * 72;
#pragma unroll
  for (int i = 0; i < 4; ++i) { ar1[i] = *(const u32x4*)((CLAMP ? apx[i] : ap + i * astep) + 64); br1[i] = *(const u32x4*)(bp + i * bstep + 64); }
#pragma unroll
  for (int i = 0; i < 4; ++i) { *(u32x4*)(As + (r0 + 32 * i) * 72 + cc * 8) = ar0[i]; *(u32x4*)(Bs + (r0 + 32 * i) * 72 + cc * 8) = br0[i]; }
  if (2 < nk) {
#pragma unroll
    for (int i = 0; i < 4; ++i) { ar0[i] = *(const u32x4*)((CLAMP ? apx[i] : ap + i * astep) + 128); br0[i] = *(const u32x4*)(bp + i * bstep + 128); }
  }
  __syncthreads();
  for (int kt = 0; kt < nk; kt += 2) {
    GEMM_STEP(ar1, br1, kt, 0)
    GEMM_STEP(ar0, br0, kt + 1, 1)
  }
  if (STAGE == 2) {
    float* Tf = (float*)smem;
#pragma unroll
    for (int h = 0; h < 2; ++h) {
      if (wm == h) {
#pragma unroll
        for (int i = 0; i < 4; ++i)
#pragma unroll
          for (int j = 0; j < 4; ++j) *(f32x4*)(Tf + (16 * i + l15) * 132 + 64 * wn + 16 * j + 4 * g4) = acc[i][j];
      }
      __syncthreads();
#pragma unroll
      for (int q = 0; q < 8; ++q) { const int id = tid + 256 * q, r = id >> 5, c = id & 31; epi(m0 + 64 * h + r, n0 + c * 4, *(const f32x4*)(Tf + r * 132 + c * 4)); }
      __syncthreads();
    }
    return;
  }
#pragma unroll
  for (int i = 0; i < 4; ++i)
#pragma unroll
    for (int j = 0; j < 4; ++j) epi(m0 + 64 * wm + 16 * i + l15, n0 + 64 * wn + 16 * j + 4 * g4, acc[i][j]);
}

DI void store_bf4(bf16_t* dst, f32x4 v) { u32x2 o; o.x = pack2(v[0], v[1]); o.y = pack2(v[2], v[3]); *(u32x2*)dst = o; }

DI void gemm_in_item(const Params& p, int l, int item, char* smem) {
  const int mtile = item / 22, nt = item % 22;
  int seq0, slen, ti;
  if (mtile < 132) { seq0 = (mtile / 66) * T; slen = T; ti = mtile % 66; }
  else { const int j = mtile - 132; seq0 = NLAT + (j / 3) * TC; slen = TC; ti = j % 3; }
  const int m0 = seq0 + 126 * ti - 1, n0 = nt * 128;
  bf16_t* P = (bf16_t*)(p.ws + OFF_P); float* GML = (float*)(p.ws + OFF_GML); float* DTR = (float*)(p.ws + OFF_DTR);
  bf16_t* Ts = (bf16_t*)smem;
  auto epi = [&](int row, int col, f32x4 v) {
    const int lr = row - m0, t = 126 * ti - 1 + lr;
    store_bf4(Ts + lr * 136 + (col - n0), v);
    if (lr >= 1 && lr <= 126 && t < slen) {
      if (col >= 1024 && col < 1040) *(f32x4*)(GML + (size_t)row * 16 + (col - 1024)) = v;
      if (col >= 2480 && col < 2488) *(f32x4*)(DTR + (size_t)row * 8 + (col - 2480)) = v;
    }
  };
  gemm_tile<0, 0, decltype(epi), 1>((const bf16_t*)(p.ws + OFF_HY), 1024, (const bf16_t*)(p.ws + OFF_WIN) + (size_t)l * 2816 * 1024, 1024, 1024, m0, n0, smem, nullptr, epi, seq0, seq0 + slen - 1);
  __syncthreads();
  {
    const int tid = ltid();
    const float* cw = p.ssd_conv_w + (size_t)l * 3 * 768; const float* cb = p.ssd_conv_b + l * 768;
#pragma unroll
    for (int q = 0; q < 8; ++q) {
      const int id = tid + 256 * q, lr = 1 + (id >> 4), c8 = (id & 15) * 8, t = 126 * ti - 1 + lr, col = n0 + c8;
      if (id < 2016 && t < slen) {
        u32x4 o = *(const u32x4*)(Ts + lr * 136 + c8);
        if (col >= C_XBC && col < C_XBC + 768) {
          const int ch = col - C_XBC;
          const u32x4 z = {0u, 0u, 0u, 0u};
          const u32x4 pm = t > 0 ? *(const u32x4*)(Ts + (lr - 1) * 136 + c8) : z, nx = t + 1 < slen ? *(const u32x4*)(Ts + (lr + 1) * 136 + c8) : z;
          const float a[8] = {bflo(pm.x), bfhi(pm.x), bflo(pm.y), bfhi(pm.y), bflo(pm.z), bfhi(pm.z), bflo(pm.w), bfhi(pm.w)};
          const float m[8] = {bflo(o.x), bfhi(o.x), bflo(o.y), bfhi(o.y), bflo(o.z), bfhi(o.z), bflo(o.w), bfhi(o.w)};
          const float n[8] = {bflo(nx.x), bfhi(nx.x), bflo(nx.y), bfhi(nx.y), bflo(nx.z), bfhi(nx.z), bflo(nx.w), bfhi(nx.w)};
          float r[8];
#pragma unroll
          for (int j = 0; j < 8; ++j) r[j] = silu_f(cb[ch + j] + cw[ch + j] * a[j] + cw[768 + ch + j] * m[j] + cw[1536 + ch + j] * n[j]);
          o.x = pack2(r[0], r[1]); o.y = pack2(r[2], r[3]); o.z = pack2(r[4], r[5]); o.w = pack2(r[6], r[7]);
        }
        *(u32x4*)(P + (size_t)(seq0 + t) * PINP + col) = o;
      }
    }
  }
  __syncthreads();
}

DI void tile_rstd(const bf16_t* P, int m0, int col0, int ncols, float* rst) {
  const int tid = ltid(), r = tid >> 1, hf = tid & 1, n = ncols >> 1;
  const bf16_t* src = P + (size_t)(m0 + r) * PINP + col0 + hf * n;
  float ss = 0.f;
  for (int c = 0; c < n; c += 8) { const u32x4 q = *(const u32x4*)(src + c);
    ss += bflo(q.x) * bflo(q.x) + bfhi(q.x) * bfhi(q.x) + bflo(q.y) * bflo(q.y) + bfhi(q.y) * bfhi(q.y) + bflo(q.z) * bflo(q.z) + bfhi(q.z) * bfhi(q.z) + bflo(q.w) * bflo(q.w) + bfhi(q.w) * bfhi(q.w); }
  ss += __shfl_xor(ss, 1);
  if (hf == 0) rst[r] = rsqrtf(ss / (float)ncols + 1e-6f);
  __syncthreads();
}
DI void qproj_item(const Params& p, int l, int item, char* smem) {
  const int mt = item / 3, nt = item % 3; const bf16_t* P = (const bf16_t*)(p.ws + OFF_P);
  float* rst = (float*)(smem + 73728);
  tile_rstd(P, mt * 128, C_CQ, 256, rst);
  bf16_t* Q = (bf16_t*)(p.ws + OFF_QRAW);
  gemm_tile<0, 0>(P + C_CQ, PINP, (const bf16_t*)(p.ws + OFF_WUQ) + (size_t)l * 384 * 256, 256, 256, mt * 128, nt * 128, smem, nullptr,
               [&](int row, int col, f32x4 v) { const float r = rst[row - mt * 128]; store_bf4(Q + (size_t)row * 384 + col, v * r); });
  __syncthreads();
}
DI void kvproj_item(const Params& p, int l, int item, char* smem) {
  const int mt = item / 4, nt = item % 4; const bf16_t* P = (const bf16_t*)(p.ws + OFF_P);
  float* rst = (float*)(smem + 73728);
  tile_rstd(P, mt * 128, C_CKV, 128, rst);
  bf16_t* KH = (bf16_t*)(p.ws + OFF_KH); bf16_t* VT = (bf16_t*)(p.ws + OFF_VT);
  gemm_tile<0, 0>(P + C_CKV, PINP, (const bf16_t*)(p.ws + OFF_WUKV) + (size_t)l * 512 * 128, 128, 128, mt * 128, nt * 128, smem, nullptr,
               [&](int row, int col, f32x4 v) {
                 const float r = rst[row - mt * 128]; v = v * r;
                 const int hh = col >> 7, dd = col & 127;
                 int b, tpos; if (row < NLAT) { b = row / T; tpos = row % T; } else { b = (row - NLAT) / TC; tpos = T + (row - NLAT) % TC; }
                 if (dd < 64) store_bf4(KH + ((size_t)(b * 4 + hh) * TALL + tpos) * 64 + dd, v);
                 else {
                   bf16_t* vp = VT + ((size_t)(b * 4 + hh) * 64 + (dd - 64)) * TALL + tpos;
                   vp[0] = f2bf(v[0]); vp[TALL] = f2bf(v[1]); vp[2 * TALL] = f2bf(v[2]); vp[3 * TALL] = f2bf(v[3]);
                 }
               });
  __syncthreads();
}
DI void rope_cs(int t, int i, float& cs, float& sn) {
  const int pos = (i < 8) ? (t >> 6) : (t & 63); const int f = i & 7;
  const float inv = exp2f(-(float)f * (13.287712379549449f / 8.f));
  const float ang = (float)pos * inv;
  cs = cosf(ang); sn = sinf(ang);
}
DI void ropek_item(const Params& p, int item) {
  const int row = item * 256 + ltid();
  const bf16_t* src = (const bf16_t*)(p.ws + OFF_P) + (size_t)row * PINP + C_KR;
  u32x4 q[4];
#pragma unroll
  for (int i = 0; i < 4; ++i) q[i] = *(const u32x4*)(src + i * 8);
  float v[32];
#pragma unroll
  for (int i = 0; i < 4; ++i) { v[i * 8 + 0] = bflo(q[i].x); v[i * 8 + 1] = bfhi(q[i].x); v[i * 8 + 2] = bflo(q[i].y); v[i * 8 + 3] = bfhi(q[i].y);
    v[i * 8 + 4] = bflo(q[i].z); v[i * 8 + 5] = bfhi(q[i].z); v[i * 8 + 6] = bflo(q[i].w); v[i * 8 + 7] = bfhi(q[i].w); }
  int b, tpos;
  if (row < NLAT) {
    b = row / T; tpos = row % T;
#pragma unroll
    for (int i = 0; i < 16; ++i) { float cs, sn; rope_cs(tpos, i, cs, sn); const float x1 = v[i], x2 = v[i + 16]; v[i] = x1 * cs - x2 * sn; v[i + 16] = x1 * sn + x2 * cs; }
  } else { b = (row - NLAT) / TC; tpos = T + (row - NLAT) % TC; }
  u32x4 o[4];
#pragma unroll
  for (int i = 0; i < 4; ++i) { o[i].x = pack2(v[i * 8], v[i * 8 + 1]); o[i].y = pack2(v[i * 8 + 2], v[i * 8 + 3]); o[i].z = pack2(v[i * 8 + 4], v[i * 8 + 5]); o[i].w = pack2(v[i * 8 + 6], v[i * 8 + 7]); }
  bf16_t* dst = (bf16_t*)(p.ws + OFF_KR) + ((size_t)b * TALL + tpos) * 32;
#pragma unroll
  for (int i = 0; i < 4; ++i) *(u32x4*)(dst + i * 8) = o[i];
}

DI void attn_item(const Params& p, int item, char* smem) {
  const int tid = ltid(), lane = tid & 63, w = __builtin_amdgcn_readfirstlane(tid >> 6), l15 = lane & 15, g4 = lane >> 4;
  int b, h, qt, latent;
  if (item < 512) { latent = 1; qt = item & 63; h = (item >> 6) & 3; b = item >> 8; }
  else { latent = 0; const int i2 = item - 512; qt = i2 & 1; h = (i2 >> 1) & 3; b = i2 >> 3; }
  const int qrow0 = latent ? b * T + qt * 128 : NLAT + b * TC + qt * 128;
  bf16_t* Qs = (bf16_t*)smem;
  bf16_t* Ks = (bf16_t*)smem;
  bf16_t* Vs = Ks + 64 * 104;
  const bf16_t* Qraw = (const bf16_t*)(p.ws + OFF_QRAW);
  const float qscale = 0.10206207261596577f * 1.4426950408889634f;
  for (int id = tid; id < 1280; id += 256) {
    const int r = id / 10, cc = id % 10;
    const bf16_t* src = Qraw + (size_t)(qrow0 + r) * 384 + h * 96 + cc * 8;
    const u32x4 q = *(const u32x4*)src;
    float a[8] = {bflo(q.x), bfhi(q.x), bflo(q.y), bfhi(q.y), bflo(q.z), bfhi(q.z), bflo(q.w), bfhi(q.w)};
    if (cc < 8) {
      u32x4 o; o.x = pack2(a[0] * qscale, a[1] * qscale); o.y = pack2(a[2] * qscale, a[3] * qscale); o.z = pack2(a[4] * qscale, a[5] * qscale); o.w = pack2(a[6] * qscale, a[7] * qscale);
      *(u32x4*)(Qs + r * 104 + cc * 8) = o;
    } else {
      const u32x4 q2 = *(const u32x4*)(src + 16);
      float c2[8] = {bflo(q2.x), bfhi(q2.x), bflo(q2.y), bfhi(q2.y), bflo(q2.z), bfhi(q2.z), bflo(q2.w), bfhi(q2.w)};
      float o1[8], o2[8];
#pragma unroll
      for (int j = 0; j < 8; ++j) {
        float cs = 1.f, sn = 0.f;
        if (latent) rope_cs(qt * 128 + r, (cc - 8) * 8 + j, cs, sn);
        o1[j] = (a[j] * cs - c2[j] * sn) * qscale; o2[j] = (a[j] * sn + c2[j] * cs) * qscale;
      }
      u32x4 o; o.x = pack2(o1[0], o1[1]); o.y = pack2(o1[2], o1[3]); o.z = pack2(o1[4], o1[5]); o.w = pack2(o1[6], o1[7]);
      *(u32x4*)(Qs + r * 104 + cc * 8) = o;
      o.x = pack2(o2[0], o2[1]); o.y = pack2(o2[2], o2[3]); o.z = pack2(o2[4], o2[5]); o.w = pack2(o2[6], o2[7]);
      *(u32x4*)(Qs + r * 104 + cc * 8 + 16) = o;
    }
  }
  __syncthreads();
  bf16x8 qf[2][3];
#pragma unroll
  for (int qs = 0; qs < 2; ++qs)
#pragma unroll
    for (int ks = 0; ks < 3; ++ks) qf[qs][ks] = ld_frag(Qs + (32 * w + 16 * qs + l15) * 104 + ks * 32 + g4 * 8);
  __syncthreads();
  const int kt0 = latent ? 0 : 128, kt1 = 132;
  const bf16_t* Kg = (const bf16_t*)(p.ws + OFF_KH) + (size_t)(b * 4 + h) * TALL * 64;
  const bf16_t* Rg = (const bf16_t*)(p.ws + OFF_KR) + (size_t)b * TALL * 32;
  const bf16_t* Vg = (const bf16_t*)(p.ws + OFF_VT) + (size_t)(b * 4 + h) * 64 * TALL;
  u32x4 kr[3], vr[2];
  const int ve0 = tid >> 3, vc = tid & 7;
  {
    kr[0] = *(const u32x4*)(Kg + (size_t)kt0 * 4096 + tid * 8); kr[1] = *(const u32x4*)(Kg + (size_t)kt0 * 4096 + (tid + 256) * 8);
    kr[2] = *(const u32x4*)(Rg + (size_t)kt0 * 2048 + tid * 8);
#pragma unroll
    for (int i = 0; i < 2; ++i) vr[i] = *(const u32x4*)(Vg + (size_t)(ve0 + 32 * i) * TALL + kt0 * 64 + vc * 8);
  }
  float mrun[2] = {0.f, 0.f}, lsum[2] = {0.f, 0.f};
  f32x4 O[4][2];
#pragma unroll
  for (int es = 0; es < 4; ++es)
#pragma unroll
    for (int qs = 0; qs < 2; ++qs) O[es][qs] = (f32x4){0.f, 0.f, 0.f, 0.f};
  constexpr int KVB = 64 * 104 + 64 * 72;
  {
#pragma unroll
    for (int i = 0; i < 2; ++i) { const int id = tid + 256 * i; *(u32x4*)(Ks + (id >> 3) * 104 + (id & 7) * 8) = kr[i]; }
    *(u32x4*)(Ks + (tid >> 2) * 104 + 64 + (tid & 3) * 8) = kr[2];
#pragma unroll
    for (int i = 0; i < 2; ++i) *(u32x4*)(Vs + (ve0 + 32 * i) * 72 + vc * 8) = vr[i];
    if (kt0 + 1 < kt1) {
      kr[0] = *(const u32x4*)(Kg + (size_t)(kt0 + 1) * 4096 + tid * 8); kr[1] = *(const u32x4*)(Kg + (size_t)(kt0 + 1) * 4096 + (tid + 256) * 8);
      kr[2] = *(const u32x4*)(Rg + (size_t)(kt0 + 1) * 2048 + tid * 8);
#pragma unroll
      for (int i = 0; i < 2; ++i) vr[i] = *(const u32x4*)(Vg + (size_t)(ve0 + 32 * i) * TALL + (kt0 + 1) * 64 + vc * 8);
    }
    __syncthreads();
  }
  for (int kt = kt0; kt < kt1; ++kt) {
    const int cur = (kt - kt0) & 1;
    const bf16_t* Kc = Ks + cur * KVB; const bf16_t* Vc = Vs + cur * KVB;
    bf16_t* Kn = Ks + (cur ^ 1) * KVB; bf16_t* Vn = Vs + (cur ^ 1) * KVB;
    if (kt + 1 < kt1) {
#pragma unroll
      for (int i = 0; i < 2; ++i) { const int id = tid + 256 * i; *(u32x4*)(Kn + (id >> 3) * 104 + (id & 7) * 8) = kr[i]; }
      *(u32x4*)(Kn + (tid >> 2) * 104 + 64 + (tid & 3) * 8) = kr[2];
#pragma unroll
      for (int i = 0; i < 2; ++i) *(u32x4*)(Vn + (ve0 + 32 * i) * 72 + vc * 8) = vr[i];
    }
    if (kt + 2 < kt1) {
      kr[0] = *(const u32x4*)(Kg + (size_t)(kt + 2) * 4096 + tid * 8); kr[1] = *(const u32x4*)(Kg + (size_t)(kt + 2) * 4096 + (tid + 256) * 8);
      kr[2] = *(const u32x4*)(Rg + (size_t)(kt + 2) * 2048 + tid * 8);
#pragma unroll
      for (int i = 0; i < 2; ++i) vr[i] = *(const u32x4*)(Vg + (size_t)(ve0 + 32 * i) * TALL + (kt + 2) * 64 + vc * 8);
    }
    __builtin_amdgcn_sched_barrier(0);
    f32x4 sa[4][2];
#pragma unroll
    for (int kb = 0; kb < 4; ++kb)
#pragma unroll
      for (int qs = 0; qs < 2; ++qs) { const float nm = -mrun[qs]; sa[kb][qs] = (f32x4){nm, nm, nm, nm}; }
    __builtin_amdgcn_s_setprio(1);
#pragma unroll
    for (int ks = 0; ks < 3; ++ks)
#pragma unroll
      for (int kb = 0; kb < 4; ++kb) {
        const bf16x8 a = ld_frag(Kc + (16 * kb + l15) * 104 + ks * 32 + g4 * 8);
#pragma unroll
        for (int qs = 0; qs < 2; ++qs) sa[kb][qs] = MFMA16(a, qf[qs][ks], sa[kb][qs]);
      }
    __builtin_amdgcn_s_setprio(0);
    bf16x8 pf[2][2];
    float dl[2];
#pragma unroll
    for (int qs = 0; qs < 2; ++qs) {
      float mx = -1e30f;
#pragma unroll
      for (int kb = 0; kb < 4; ++kb)
#pragma unroll
        for (int j = 0; j < 4; ++j) mx = fmaxf(mx, sa[kb][qs][j]);
      mx = fmaxf(mx, __shfl_xor(mx, 16)); mx = fmaxf(mx, __shfl_xor(mx, 32));
      dl[qs] = (kt == kt0) ? mx : fmaxf(mx, 0.f);
    }
    const bool grew = (kt == kt0) || __builtin_amdgcn_ballot_w64(dl[0] > 0.f || dl[1] > 0.f) != 0ull;
#pragma unroll
    for (int qs = 0; qs < 2; ++qs) {
      float ps = 0.f;
      if (grew) {
        const float d = dl[qs], alpha = (kt == kt0) ? 0.f : __builtin_amdgcn_exp2f(-d);
        mrun[qs] += d;
#pragma unroll
        for (int kb = 0; kb < 4; ++kb)
#pragma unroll
          for (int j = 0; j < 4; ++j) { const float e = __builtin_amdgcn_exp2f(sa[kb][qs][j] - d); sa[kb][qs][j] = e; ps += e; }
        lsum[qs] = lsum[qs] * alpha + ps;
#pragma unroll
        for (int es = 0; es < 4; ++es) O[es][qs] = O[es][qs] * alpha;
      } else {
#pragma unroll
        for (int kb = 0; kb < 4; ++kb)
#pragma unroll
          for (int j = 0; j < 4; ++j) { const float e = __builtin_amdgcn_exp2f(sa[kb][qs][j]); sa[kb][qs][j] = e; ps += e; }
        lsum[qs] += ps;
      }
#pragma unroll
      for (int k2 = 0; k2 < 2; ++k2)
        pf[qs][k2] = mk_frag(pack2(sa[2 * k2][qs][0], sa[2 * k2][qs][1]), pack2(sa[2 * k2][qs][2], sa[2 * k2][qs][3]),
                             pack2(sa[2 * k2 + 1][qs][0], sa[2 * k2 + 1][qs][1]), pack2(sa[2 * k2 + 1][qs][2], sa[2 * k2 + 1][qs][3]));
    }
    __builtin_amdgcn_s_setprio(1);
#pragma unroll
    for (int k2 = 0; k2 < 2; ++k2)
#pragma unroll
      for (int es = 0; es < 4; ++es) {
        const bf16_t* vp = Vc + (16 * es + l15) * 72 + 32 * k2 + 4 * g4;
        const u32x2 lo = *(const u32x2*)vp, hi = *(const u32x2*)(vp + 16);
        const bf16x8 a = mk_frag(lo.x, lo.y, hi.x, hi.y);
#pragma unroll
        for (int qs = 0; qs < 2; ++qs) O[es][qs] = MFMA16(a, pf[qs][k2], O[es][qs]);
      }
    __builtin_amdgcn_s_setprio(0);
    __syncthreads();
  }
  bf16_t* Y = (bf16_t*)(p.ws + OFF_HY);
#pragma unroll
  for (int qs = 0; qs < 2; ++qs) {
    float l = lsum[qs]; l += __shfl_xor(l, 16); l += __shfl_xor(l, 32);
    const float inv = 1.f / l;
    const int row = qrow0 + 32 * w + 16 * qs + l15;
#pragma unroll
    for (int es = 0; es < 4; ++es) store_bf4(Y + (size_t)row * 1024 + 256 + h * 64 + 16 * es + 4 * g4, O[es][qs] * inv);
  }
  __syncthreads();
}

DI void chunk_geom(int tcg, int b, int& part, int& tc, int& row0) { part = tcg >= 128; tc = part ? tcg - 128 : tcg; row0 = row_of(b, part, tc * 64); }
DI int chain_slot(int dir, int part, int tc) { return dir ? (part ? 3 - tc : 131 - tc) : (part ? tc : 4 + tc); }

DI void mlstm_p1(const Params& p, int l, int item, char* smem) {
  const int tid = ltid(), lane = tid & 63, w = __builtin_amdgcn_readfirstlane(tid >> 6), l15 = lane & 15, g4 = lane >> 4;
  const int tcg = item % NCH; int r = item / NCH; const int dir = r & 1; r >>= 1; const int h = r & 3, b = r >> 2;
  int part, tc, row0; chunk_geom(tcg, b, part, tc, row0);
  const int c = chain_slot(dir, part, tc), chain = (b * 4 + h) * 2 + dir;
  bf16_t* A = (bf16_t*)smem;
  bf16_t* Bk = A + 80 * 72;
  float* fs = (float*)(Bk + 64 * 72);
  const bf16_t* P = (const bf16_t*)(p.ws + OFF_P); const float* GML = (const float*)(p.ws + OFF_GML);
  float* MLM = (float*)(p.ws + OFF_MLM) + (size_t)(chain * NCH + c) * 32;
  if (tid < 64) {
    const int gi = 2 * dir;
    const float ig = GML[(size_t)(row0 + tid) * 16 + gi * 4 + h] + p.ml_gate_bias[l * 16 + gi * 4 + h];
    const float fg = GML[(size_t)(row0 + tid) * 16 + (gi + 1) * 4 + h] + p.ml_gate_bias[l * 16 + (gi + 1) * 4 + h];
    const float lf = logsigm_f(fg);
    const float pre = wave_incl_scan(lf, lane), tot = __shfl(pre, 63);
    const float bc = dir ? tot - pre + lf : pre;
    const float wlog = tot - bc + ig, mloc = wave_max(wlog), wv = __expf(wlog - mloc);
    fs[tid] = wv; A[64 * 72 + tid] = f2bf(wv);
    if (tid == 0) { MLM[0] = mloc; MLM[1] = tot; }
  }
  for (int i = tid; i < 15 * 72; i += 256) A[65 * 72 + i] = 0;
  __syncthreads();
  {
    const int s = tid >> 2, d0 = (tid & 3) * 16; const float wv = fs[s];
    const bf16_t* kp = P + (size_t)(row0 + s) * PINP + C_MLK + h * 64 + d0;
    const bf16_t* vp = P + (size_t)(row0 + s) * PINP + C_MLV + h * 64 + d0;
#pragma unroll
    for (int hf = 0; hf < 2; ++hf) {
      const u32x4 kq = *(const u32x4*)(kp + hf * 8), vq = *(const u32x4*)(vp + hf * 8);
      const float kk[8] = {bflo(kq.x), bfhi(kq.x), bflo(kq.y), bfhi(kq.y), bflo(kq.z), bfhi(kq.z), bflo(kq.w), bfhi(kq.w)};
      const float vv[8] = {bflo(vq.x), bfhi(vq.x), bflo(vq.y), bfhi(vq.y), bflo(vq.z), bfhi(vq.z), bflo(vq.w), bfhi(vq.w)};
#pragma unroll
      for (int j = 0; j < 8; ++j) { Bk[(d0 + hf * 8 + j) * 72 + s] = f2bf(kk[j] * 0.125f); A[(d0 + hf * 8 + j) * 72 + s] = f2bf(vv[j] * wv); }
    }
  }
  __syncthreads();
  float* MLS = (float*)(p.ws + OFF_MLS) + (size_t)(chain * NCH + c) * 4160;
  for (int t = w; t < 20; t += 4) {
    const int ms = t >> 2, ns = t & 3;
    f32x4 acc = {0.f, 0.f, 0.f, 0.f};
#pragma unroll
    for (int ks = 0; ks < 2; ++ks) acc = MFMA16(ld_frag(A + (16 * ms + l15) * 72 + ks * 32 + g4 * 8), ld_frag(Bk + (16 * ns + l15) * 72 + ks * 32 + g4 * 8), acc);
#pragma unroll
    for (int j = 0; j < 4; ++j) { const int e = 16 * ms + 4 * g4 + j; if (e <= 64) MLS[e * 64 + 16 * ns + l15] = acc[j]; }
  }
  __syncthreads();
}
DI void mlstm_p2(const Params& p, int item) {
  const int gi = item * 256 + ltid(), chain = gi / 4160, e = gi % 4160;
  float* MLS = (float*)(p.ws + OFF_MLS) + (size_t)chain * NCH * 4160 + e;
  float* MLM = (float*)(p.ws + OFF_MLM) + (size_t)chain * NCH * 32;
  float C = 0.f, m = 0.f;
  for (int c0 = 0; c0 < NCH; c0 += 12) {
    float d[12], ml[12], bl[12];
#pragma unroll
    for (int i = 0; i < 12; ++i) { d[i] = MLS[(size_t)(c0 + i) * 4160]; ml[i] = MLM[(c0 + i) * 32]; bl[i] = MLM[(c0 + i) * 32 + 1]; }
#pragma unroll
    for (int i = 0; i < 12; ++i) {
      MLS[(size_t)(c0 + i) * 4160] = C; if (e == 0) MLM[(c0 + i) * 32 + 16] = m;
      const float mn = fmaxf(bl[i] + m, ml[i]);
      C = __expf(bl[i] + m - mn) * C + __expf(ml[i] - mn) * d[i]; m = mn;
    }
  }
}
DI void mlstm_p3(const Params& p, int l, int item, char* smem) {
  const int tid = ltid(), lane = tid & 63, w = __builtin_amdgcn_readfirstlane(tid >> 6), l15 = lane & 15, g4 = lane >> 4;
  const int h = item & 3; const int r = item >> 2; const int tcg = r % NCH, b = r / NCH;
  int part, tc, row0; chunk_geom(tcg, b, part, tc, row0);
  bf16_t* Qs = (bf16_t*)smem;
  bf16_t* Ks = Qs + 64 * 72;
  bf16_t* Vt = Ks + 64 * 72;
  bf16_t* Sb = Vt + 64 * 72;
  float* fb = (float*)(Sb + 64 * 72);
  float* fi = fb + 64;
  const bf16_t* P = (const bf16_t*)(p.ws + OFF_P); const float* GML = (const float*)(p.ws + OFF_GML);
  {
    const int s = tid >> 2, d0 = (tid & 3) * 16;
    const bf16_t* base = P + (size_t)(row0 + s) * PINP + h * 64 + d0;
#pragma unroll
    for (int hf = 0; hf < 2; ++hf) {
      *(u32x4*)(Qs + s * 72 + d0 + hf * 8) = *(const u32x4*)(base + C_MLQ + hf * 8);
      const u32x4 kq = *(const u32x4*)(base + C_MLK + hf * 8), vq = *(const u32x4*)(base + C_MLV + hf * 8);
      u32x4 ko; ko.x = pack2(bflo(kq.x) * 0.125f, bfhi(kq.x) * 0.125f); ko.y = pack2(bflo(kq.y) * 0.125f, bfhi(kq.y) * 0.125f);
      ko.z = pack2(bflo(kq.z) * 0.125f, bfhi(kq.z) * 0.125f); ko.w = pack2(bflo(kq.w) * 0.125f, bfhi(kq.w) * 0.125f);
      *(u32x4*)(Ks + s * 72 + d0 + hf * 8) = ko;
      const unsigned vw[4] = {vq.x, vq.y, vq.z, vq.w};
#pragma unroll
      for (int j = 0; j < 4; ++j) { Vt[(d0 + hf * 8 + 2 * j) * 72 + s] = (bf16_t)(vw[j] & 0xffffu); Vt[(d0 + hf * 8 + 2 * j + 1) * 72 + s] = (bf16_t)(vw[j] >> 16); }
    }
  }
  f32x4 hs[4];
#pragma unroll
  for (int ns = 0; ns < 4; ++ns) hs[ns] = (f32x4){0.f, 0.f, 0.f, 0.f};
#pragma unroll 1
  for (int dir = 0; dir < 2; ++dir) {
    const int c = chain_slot(dir, part, tc), chain = (b * 4 + h) * 2 + dir;
    const float m_in = ((const float*)(p.ws + OFF_MLM))[(size_t)(chain * NCH + c) * 32 + 16];
    const float* Cst = (const float*)(p.ws + OFF_MLS) + (size_t)(chain * NCH + c) * 4160;
    __syncthreads();
    if (tid < 64) {
      const int gi = 2 * dir;
      const float ig = GML[(size_t)(row0 + tid) * 16 + gi * 4 + h] + p.ml_gate_bias[l * 16 + gi * 4 + h];
      const float fg = GML[(size_t)(row0 + tid) * 16 + (gi + 1) * 4 + h] + p.ml_gate_bias[l * 16 + (gi + 1) * 4 + h];
      const float lf = logsigm_f(fg);
      const float pre = wave_incl_scan(lf, lane), tot = __shfl(pre, 63);
      fb[tid] = dir ? tot - pre + lf : pre; fi[tid] = ig;
    }
    __syncthreads();
    f32x4 sc[4];
#pragma unroll
    for (int ns = 0; ns < 4; ++ns) {
      f32x4 a = {0.f, 0.f, 0.f, 0.f};
#pragma unroll
      for (int ks = 0; ks < 2; ++ks) a = MFMA16(ld_frag(Qs + (16 * w + l15) * 72 + ks * 32 + g4 * 8), ld_frag(Ks + (16 * ns + l15) * 72 + ks * 32 + g4 * 8), a);
      sc[ns] = a;
    }
    float bi[4], mt[4], rsum[4];
#pragma unroll
    for (int j = 0; j < 4; ++j) {
      const int i = 16 * w + 4 * g4 + j; bi[j] = fb[i];
      float mx = -1e30f;
#pragma unroll
      for (int ns = 0; ns < 4; ++ns) { const int s = 16 * ns + l15; const bool ok = dir ? (s >= i) : (s <= i); const float dm = bi[j] - fb[s] + fi[s]; if (ok) mx = fmaxf(mx, dm); }
      mx = red16_max(mx);
      mt[j] = fmaxf(bi[j] + m_in, mx);
      float rs = 0.f;
#pragma unroll
      for (int ns = 0; ns < 4; ++ns) {
        const int s = 16 * ns + l15; const bool ok = dir ? (s >= i) : (s <= i);
        const float v = ok ? sc[ns][j] * __expf(bi[j] - fb[s] + fi[s] - mt[j]) : 0.f;
        rs += v; Sb[i * 72 + s] = f2bf(v);
      }
      rsum[j] = red16_sum(rs);
    }
    __syncthreads();
    f32x4 qc[5];
#pragma unroll
    for (int ns = 0; ns < 5; ++ns) {
      f32x4 a = {0.f, 0.f, 0.f, 0.f};
      const int e = 16 * ns + l15;
#pragma unroll
      for (int ks = 0; ks < 2; ++ks) {
        bf16x8 bfm;
        if (e <= 64) bfm = frag_from_f32(Cst + e * 64 + ks * 32 + g4 * 8, 1.f); else bfm = mk_frag(0u, 0u, 0u, 0u);
        a = MFMA16(ld_frag(Qs + (16 * w + l15) * 72 + ks * 32 + g4 * 8), bfm, a);
      }
      qc[ns] = a;
    }
    f32x4 nm[4];
#pragma unroll
    for (int ns = 0; ns < 4; ++ns) {
      f32x4 a = {0.f, 0.f, 0.f, 0.f};
#pragma unroll
      for (int ks = 0; ks < 2; ++ks) a = MFMA16(ld_frag(Sb + (16 * w + l15) * 72 + ks * 32 + g4 * 8), ld_frag(Vt + (16 * ns + l15) * 72 + ks * 32 + g4 * 8), a);
      nm[ns] = a;
    }
#pragma unroll
    for (int j = 0; j < 4; ++j) {
      const float wi = __expf(bi[j] + m_in - mt[j]);
      const float qn = __shfl(qc[4][j], lane & 48);
      const float den = rsum[j] + wi * qn;
      const float dd = 1.f / fmaxf(fabsf(den), __expf(-mt[j]));
#pragma unroll
      for (int ns = 0; ns < 4; ++ns) hs[ns][j] += (nm[ns][j] + wi * qc[ns][j]) * dd;
    }
  }
  bf16_t* Y = (bf16_t*)(p.ws + OFF_HY);
#pragma unroll
  for (int j = 0; j < 4; ++j) {
    float ss = 0.f;
#pragma unroll
    for (int ns = 0; ns < 4; ++ns) ss += hs[ns][j] * hs[ns][j];
    ss = red16_sum(ss);
    const float rstd = rsqrtf(ss * (1.f / 64.f) + 1e-6f);
    const int row = row0 + 16 * w + 4 * g4 + j;
#pragma unroll
    for (int ns = 0; ns < 4; ++ns) {
      const int ch = h * 64 + 16 * ns + l15;
      const float o = bf2f(P[(size_t)row * PINP + C_MLO + ch]);
      Y[(size_t)row * 1024 + ch] = f2bf(hs[ns][j] * rstd * p.ml_norm[l * 256 + ch] * sigm_f(o));
    }
  }
  __syncthreads();
}

DI void conv_silu8(const Params& p, int l, const bf16_t* P, int row, bool hp, bool hn, int ch, float* out) {
  const u32x4 c0 = *(const u32x4*)(P + (size_t)row * PINP + C_XBC + ch);
  out[0] = bflo(c0.x); out[1] = bfhi(c0.x); out[2] = bflo(c0.y); out[3] = bfhi(c0.y); out[4] = bflo(c0.z); out[5] = bfhi(c0.z); out[6] = bflo(c0.w); out[7] = bfhi(c0.w);
}
DI void ssd_gates(const Params& p, int l, int dir, int h, int row0, int tid, int lane, float& dt, float& cs, float& tot) {
  const float* DTR = (const float*)(p.ws + OFF_DTR);
  dt = softplus_f(DTR[(size_t)(row0 + tid) * 8 + dir * 4 + h] + p.ssd_dt_bias[l * 8 + dir * 4 + h]);
  const float la = -dt * __expf(p.ssd_a_log[l * 8 + dir * 4 + h]);
  const float pre = wave_incl_scan(la, lane); tot = __shfl(pre, 63);
  cs = dir ? tot - pre + la : pre;
}
DI void ssd_p1(const Params& p, int l, int item, char* smem) {
  const int tid = ltid(), lane = tid & 63, w = __builtin_amdgcn_readfirstlane(tid >> 6), l15 = lane & 15, g4 = lane >> 4;
  const int tcg = item % NCH; int r = item / NCH; const int dir = r & 1; r >>= 1; const int h = r & 3, b = r >> 2;
  int part, tc, row0; chunk_geom(tcg, b, part, tc, row0);
  const int c = chain_slot(dir, part, tc), chain = (b * 4 + h) * 2 + dir, lastc = part ? 3 : 127;
  bf16_t* Xt = (bf16_t*)smem;
  bf16_t* Bt = Xt + 64 * 72;
  float* fs = (float*)(Bt + 128 * 72);
  const bf16_t* P = (const bf16_t*)(p.ws + OFF_P);
  if (tid < 64) {
    float dt, cs, tot; ssd_gates(p, l, dir, h, row0, tid, lane, dt, cs, tot);
    fs[tid] = __expf(tot - cs) * dt;
    if (tid == 0) ((float*)(p.ws + OFF_SSA))[(chain * NCH + c) * 32] = tot;
  }
  __syncthreads();
  const int grp = h >> 1;
  for (int id = tid; id < 64 * 24; id += 256) {
    const int s = id / 24, cc = id % 24;
    const bool hp = !(tc == 0 && s == 0), hn = !(tc == lastc && s == 63);
    float v[8];
    if (cc < 8) { conv_silu8(p, l, P, row0 + s, hp, hn, h * 64 + cc * 8, v); const float wv = fs[s];
#pragma unroll
      for (int j = 0; j < 8; ++j) Xt[(cc * 8 + j) * 72 + s] = f2bf(v[j] * wv); }
    else { const int n0 = (cc - 8) * 8; conv_silu8(p, l, P, row0 + s, hp, hn, 256 + grp * 128 + n0, v);
#pragma unroll
      for (int j = 0; j < 8; ++j) Bt[(n0 + j) * 72 + s] = f2bf(v[j]); }
  }
  __syncthreads();
  float* SS = (float*)(p.ws + OFF_SSDS) + (size_t)(chain * NCH + c) * 8192;
#pragma unroll
  for (int ns = 0; ns < 8; ++ns) {
    f32x4 acc = {0.f, 0.f, 0.f, 0.f};
#pragma unroll
    for (int ks = 0; ks < 2; ++ks) acc = MFMA16(ld_frag(Xt + (16 * w + l15) * 72 + ks * 32 + g4 * 8), ld_frag(Bt + (16 * ns + l15) * 72 + ks * 32 + g4 * 8), acc);
#pragma unroll
    for (int j = 0; j < 4; ++j) SS[(16 * w + 4 * g4 + j) * 128 + 16 * ns + l15] = acc[j];
  }
  __syncthreads();
}
DI void ssd_p2(const Params& p, int item) {
  const int gi = item * 256 + ltid(), chain = gi >> 13, e = gi & 8191;
  float* SS = (float*)(p.ws + OFF_SSDS) + (size_t)chain * NCH * 8192 + e;
  const float* SA = (const float*)(p.ws + OFF_SSA) + (size_t)chain * NCH * 32;
  float S = 0.f;
  for (int c0 = 0; c0 < NCH; c0 += 12) {
    float d[12], a[12];
#pragma unroll
    for (int i = 0; i < 12; ++i) { d[i] = SS[(size_t)(c0 + i) * 8192]; a[i] = SA[(c0 + i) * 32]; }
#pragma unroll
    for (int i = 0; i < 12; ++i) { SS[(size_t)(c0 + i) * 8192] = S; S = __expf(a[i]) * S + d[i]; }
  }
}
DI void ssd_p3(const Params& p, int l, int item, char* smem) {
  const int tid = ltid(), lane = tid & 63, w = __builtin_amdgcn_readfirstlane(tid >> 6), l15 = lane & 15, g4 = lane >> 4;
  const int h = item & 3; const int r = item >> 2; const int tcg = r % NCH, b = r / NCH;
  int part, tc, row0; chunk_geom(tcg, b, part, tc, row0);
  const int lastc = part ? 3 : 127, grp = h >> 1;
  bf16_t* Cm = (bf16_t*)smem;
  bf16_t* Bm = Cm + 64 * 136;
  bf16_t* Xt = Bm + 64 * 136;
  bf16_t* Sb = Xt + 64 * 72;
  float* fcs = (float*)(Sb + 64 * 72);
  float* fdt = fcs + 64;
  const bf16_t* P = (const bf16_t*)(p.ws + OFF_P);
  for (int id = tid; id < 64 * 40; id += 256) {
    const int s = id / 40, cc = id % 40;
    const bool hp = !(tc == 0 && s == 0), hn = !(tc == lastc && s == 63);
    float v[8];
    if (cc < 8) { conv_silu8(p, l, P, row0 + s, hp, hn, h * 64 + cc * 8, v);
#pragma unroll
      for (int j = 0; j < 8; ++j) Xt[(cc * 8 + j) * 72 + s] = f2bf(v[j]); }
    else {
      const int q = cc - 8, isC = q >= 16, n0 = (q & 15) * 8;
      conv_silu8(p, l, P, row0 + s, hp, hn, 256 + isC * 256 + grp * 128 + n0, v);
      u32x4 o; o.x = pack2(v[0], v[1]); o.y = pack2(v[2], v[3]); o.z = pack2(v[4], v[5]); o.w = pack2(v[6], v[7]);
      *(u32x4*)((isC ? Cm : Bm) + s * 136 + n0) = o;
    }
  }
  f32x4 ys[4];
#pragma unroll
  for (int ns = 0; ns < 4; ++ns) ys[ns] = (f32x4){0.f, 0.f, 0.f, 0.f};
#pragma unroll 1
  for (int dir = 0; dir < 2; ++dir) {
    const int c = chain_slot(dir, part, tc), chain = (b * 4 + h) * 2 + dir;
    const float* St = (const float*)(p.ws + OFF_SSDS) + (size_t)(chain * NCH + c) * 8192;
    __syncthreads();
    if (tid < 64) { float dt, cs, tot; ssd_gates(p, l, dir, h, row0, tid, lane, dt, cs, tot); fcs[tid] = cs; fdt[tid] = dt; }
    __syncthreads();
    float ci[4];
#pragma unroll
    for (int j = 0; j < 4; ++j) ci[j] = fcs[16 * w + 4 * g4 + j];
#pragma unroll
    for (int ns = 0; ns < 4; ++ns) {
      f32x4 a = {0.f, 0.f, 0.f, 0.f};
#pragma unroll
      for (int ks = 0; ks < 4; ++ks) a = MFMA16(ld_frag(Cm + (16 * w + l15) * 136 + ks * 32 + g4 * 8), ld_frag(Bm + (16 * ns + l15) * 136 + ks * 32 + g4 * 8), a);
      const int s = 16 * ns + l15; const float css = fcs[s], dts = fdt[s];
#pragma unroll
      for (int j = 0; j < 4; ++j) {
        const int i = 16 * w + 4 * g4 + j; const bool ok = dir ? (s >= i) : (s <= i);
        Sb[i * 72 + s] = f2bf(ok ? a[j] * __expf(ci[j] - css) * dts : 0.f);
      }
    }
    __syncthreads();
#pragma unroll
    for (int ns = 0; ns < 4; ++ns) {
      f32x4 a = {0.f, 0.f, 0.f, 0.f}, bq = {0.f, 0.f, 0.f, 0.f};
#pragma unroll
      for (int ks = 0; ks < 2; ++ks) a = MFMA16(ld_frag(Sb + (16 * w + l15) * 72 + ks * 32 + g4 * 8), ld_frag(Xt + (16 * ns + l15) * 72 + ks * 32 + g4 * 8), a);
#pragma unroll
      for (int ks = 0; ks < 4; ++ks) bq = MFMA16(ld_frag(Cm + (16 * w + l15) * 136 + ks * 32 + g4 * 8), frag_from_f32(St + (16 * ns + l15) * 128 + ks * 32 + g4 * 8, 1.f), bq);
#pragma unroll
      for (int j = 0; j < 4; ++j) ys[ns][j] += a[j] + __expf(ci[j]) * bq[j];
    }
  }
  bf16_t* Y = (bf16_t*)(p.ws + OFF_HY); float* SSQ = (float*)(p.ws + OFF_SSQ);
  const float dsk = p.ssd_d[l * 4 + h];
#pragma unroll
  for (int j = 0; j < 4; ++j) {
    const int i = 16 * w + 4 * g4 + j, row = row0 + i; float ss = 0.f;
#pragma unroll
    for (int ns = 0; ns < 4; ++ns) {
      const int pp = 16 * ns + l15;
      const float xv = bf2f(Xt[pp * 72 + i]);
      const float z = bf2f(P[(size_t)row * PINP + C_Z + h * 64 + pp]);
      const float g = (ys[ns][j] + dsk * xv) * silu_f(z);
      ss += g * g; Y[(size_t)row * 1024 + 512 + h * 64 + pp] = f2bf(g);
    }
    ss = red16_sum(ss);
    if (l15 == 0) SSQ[(size_t)h * NROW + row] = ss;
  }
  __syncthreads();
}

struct S5Par { float are, aim, bre[16], bim[16]; };
DI void s5_params(const Params& p, int l, int dir, int g, int n, S5Par& q, float& dtv, float& lre, float& lim) {
  const int ai = ((l * 2 + dir) * 16 + g) * 64 + n;
  lre = fminf(p.s5_a_re[ai], -1e-4f); lim = p.s5_a_im[ai];
  dtv = __expf(p.s5_log_dt[(l * 2 + dir) * 16 + g]);
  const float mag = __expf(lre * dtv), ang = lim * dtv;
  q.are = mag * cosf(ang); q.aim = mag * sinf(ang);
  const float den = lre * lre + lim * lim;
  const float fre = ((q.are - 1.f) * lre + q.aim * lim) / den, fim = (q.aim * lre - (q.are - 1.f) * lim) / den;
  const float* br = p.s5_b_re + ((size_t)(l * 16 + g) * 64 + n) * 16; const float* bi = p.s5_b_im + ((size_t)(l * 16 + g) * 64 + n) * 16;
#pragma unroll
  for (int j = 0; j < 16; ++j) { q.bre[j] = fre * br[j] - fim * bi[j]; q.bim[j] = fre * bi[j] + fim * br[j]; }
}
DI void s5_step(const S5Par& q, const bf16_t* us, int s, float& xr, float& xi) {
  const u32x4 a0 = *(const u32x4*)(us + s * 16), a1 = *(const u32x4*)(us + s * 16 + 8);
  const unsigned uw[8] = {a0.x, a0.y, a0.z, a0.w, a1.x, a1.y, a1.z, a1.w};
  float br = 0.f, bi = 0.f;
#pragma unroll
  for (int j = 0; j < 8; ++j) { const float a = bflo(uw[j]), c = bfhi(uw[j]); br += q.bre[2 * j] * a + q.bre[2 * j + 1] * c; bi += q.bim[2 * j] * a + q.bim[2 * j + 1] * c; }
  const float nr = q.are * xr - q.aim * xi + br, ni = q.are * xi + q.aim * xr + bi;
  xr = nr; xi = ni;
}
DI void s5_p1(const Params& p, int l, int item, char* smem) {
  const int lane = ltid() & 63, wi = item * 4 + __builtin_amdgcn_readfirstlane(ltid() >> 6);
  const int tcg = wi % NCH; int r = wi / NCH; const int dir = r & 1; r >>= 1; const int g = r & 15, b = r >> 4;
  int part, tc, row0; chunk_geom(tcg, b, part, tc, row0);
  const int c = chain_slot(dir, part, tc);
  S5Par q; float dtv, lre, lim; s5_params(p, l, dir, g, lane, q, dtv, lre, lim);
  const bf16_t* up = (const bf16_t*)(p.ws + OFF_P) + (size_t)(row0 + lane) * PINP + C_S5 + g * 16;
  bf16_t* us = (bf16_t*)smem + __builtin_amdgcn_readfirstlane(ltid() >> 6) * 1024;
  *(u32x4*)(us + lane * 16) = *(const u32x4*)up; *(u32x4*)(us + lane * 16 + 8) = *(const u32x4*)(up + 8);
  float xr = 0.f, xi = 0.f;
  for (int st = 0; st < 64; ++st) { const int s = dir ? 63 - st : st; s5_step(q, us, s, xr, xi); }
  float* S = (float*)(p.ws + OFF_S5S) + ((size_t)((b * 16 + g) * 2 + dir) * NCH + c) * 128;
  S[lane] = xr; S[64 + lane] = xi;
}
DI void s5_p2(const Params& p, int l, int item) {
  const int gi = item * 256 + ltid(), n = gi & 63, dir = (gi >> 6) & 1, g = (gi >> 7) & 15, b = gi >> 11;
  const int ai = ((l * 2 + dir) * 16 + g) * 64 + n;
  const float lre = fminf(p.s5_a_re[ai], -1e-4f), lim = p.s5_a_im[ai], dtv = __expf(p.s5_log_dt[(l * 2 + dir) * 16 + g]);
  const float mag = __expf(64.f * lre * dtv), ang = 64.f * (lim * dtv);
  const float ar = mag * cosf(ang), aim = mag * sinf(ang);
  float* S = (float*)(p.ws + OFF_S5S) + (size_t)((b * 16 + g) * 2 + dir) * NCH * 128 + n;
  float xr = 0.f, xi = 0.f;
  for (int c0 = 0; c0 < NCH; c0 += 12) {
    float dr[12], di[12];
#pragma unroll
    for (int i = 0; i < 12; ++i) { dr[i] = S[(c0 + i) * 128]; di[i] = S[(c0 + i) * 128 + 64]; }
#pragma unroll
    for (int i = 0; i < 12; ++i) { S[(c0 + i) * 128] = xr; S[(c0 + i) * 128 + 64] = xi; const float nr = ar * xr - aim * xi + dr[i], ni = ar * xi + aim * xr + di[i]; xr = nr; xi = ni; }
  }
}
DI void s5_p3(const Params& p, int l, int item, char* smem) {
  const int tid = ltid(), lane = tid & 63, w = __builtin_amdgcn_readfirstlane(tid >> 6), l15 = lane & 15, g4 = lane >> 4;
  const int half = item & 1; const int r2 = item >> 1; const int tcg = r2 % NCH, b = r2 / NCH;
  int part, tc, row0; chunk_geom(tcg, b, part, tc, row0);
  bf16_t* xs = (bf16_t*)smem + w * (16 * 136);
  bf16_t* YG = (bf16_t*)(p.ws + OFF_YG);
  const bf16_t* P = (const bf16_t*)(p.ws + OFF_P);
#pragma unroll 1
  for (int gi = 0; gi < 2; ++gi) {
    const int g = half * 8 + w + 4 * gi;
    const bf16_t* up = P + (size_t)(row0 + lane) * PINP + C_S5 + g * 16;
    bf16_t* us = (bf16_t*)smem + 25600 + w * 1024;
    *(u32x4*)(us + lane * 16) = *(const u32x4*)up; *(u32x4*)(us + lane * 16 + 8) = *(const u32x4*)(up + 8);
    f32x4 yt[4];
#pragma unroll
    for (int ib = 0; ib < 4; ++ib) yt[ib] = (f32x4){0.f, 0.f, 0.f, 0.f};
#pragma unroll
    for (int dir = 0; dir < 2; ++dir) {
      S5Par q; float dtv, lre, lim; s5_params(p, l, dir, g, lane, q, dtv, lre, lim);
      const int c = chain_slot(dir, part, tc);
      const float* S = (const float*)(p.ws + OFF_S5S) + ((size_t)((b * 16 + g) * 2 + dir) * NCH + c) * 128;
      float xr = S[lane], xi = S[64 + lane];
      bf16x8 cf[4];
#pragma unroll
      for (int ks = 0; ks < 4; ++ks) {
        const int k = ks * 32 + g4 * 8;
        const float* src = (k < 64 ? p.s5_c_re : p.s5_c_im) + ((size_t)(l * 16 + g) * 16 + l15) * 64 + (k & 63);
        cf[ks] = frag_from_f32(src, k < 64 ? 1.f : -1.f);
      }
#pragma unroll
      for (int blk = 0; blk < 4; ++blk) {
        asm volatile("s_waitcnt lgkmcnt(0)" ::: "memory");
#pragma unroll 4
        for (int st = 0; st < 16; ++st) {
          const int step = blk * 16 + st, s = dir ? 63 - step : step;
          s5_step(q, us, s, xr, xi);
          xs[(s & 15) * 136 + lane] = f2bf(xr); xs[(s & 15) * 136 + 64 + lane] = f2bf(xi);
        }
        asm volatile("s_waitcnt lgkmcnt(0)" ::: "memory");
        f32x4 a = {0.f, 0.f, 0.f, 0.f};
#pragma unroll
        for (int ks = 0; ks < 4; ++ks) a = MFMA16(ld_frag(xs + l15 * 136 + ks * 32 + g4 * 8), cf[ks], a);
        const int ib = dir ? 3 - blk : blk;
        yt[ib] += a;
      }
    }
#pragma unroll
    for (int ib = 0; ib < 4; ++ib)
#pragma unroll
      for (int j = 0; j < 4; ++j) {
        const int tok = 16 * ib + 4 * g4 + j, ch = g * 16 + l15;
        const float u = bf2f(P[(size_t)(row0 + tok) * PINP + C_S5 + ch]);
        YG[(size_t)(row0 + tok) * 256 + ch] = f2bf(gelu_tanh_f(yt[ib][j] + p.s5_d[l * 256 + ch] * u));
      }
  }
  __syncthreads();
}
DI void glu_item(const Params& p, int l, int item, char* smem) {
  const int mt = item >> 1, nt = item & 1;
  const bf16_t* YG = (const bf16_t*)(p.ws + OFF_YG); bf16_t* Y = (bf16_t*)(p.ws + OFF_HY);
  gemm_tile<0, 0>(YG, 256, (const bf16_t*)(p.ws + OFF_WGLU) + (size_t)l * 256 * 256, 256, 256, mt * 128, nt * 128, smem, nullptr,
                  [&](int row, int col, f32x4 v) {
                    const u32x2 yv = *(const u32x2*)(YG + (size_t)row * 256 + col);
                    f32x4 o; o[0] = bflo(yv.x) * sigm_f(v[0]); o[1] = bfhi(yv.x) * sigm_f(v[1]); o[2] = bflo(yv.y) * sigm_f(v[2]); o[3] = bfhi(yv.y) * sigm_f(v[3]);
                    store_bf4(Y + (size_t)row * 1024 + 768 + col, o);
                  });
}

DI void outproj_item(const Params& p, int l, int item, char* smem) {
  const int mt = item >> 3, nt = item & 7;
  const float* MOD = (const float*)(p.ws + OFF_MOD);
  gemm_tile<1, 2>((const bf16_t*)(p.ws + OFF_HY), 1024, (const bf16_t*)(p.ws + OFF_WOUT) + (size_t)l * 1024 * 1024, 1024, 1024, mt * 128, nt * 128, smem, (const float*)(p.ws + OFF_SSQ),
               [&](int row, int col, f32x4 v) {
                 const int s = row < NLAT ? row / T : 2;
                 const f32x4 gt = *(const f32x4*)(MOD + (size_t)(l * 3 + s) * 6144 + 2048 + col);
                 float* xp = row < NLAT ? p.xb + (size_t)row * 1024 + col : (float*)(p.ws + OFF_CTX) + (size_t)(row - NLAT) * 1024 + col;
                 *(f32x4*)xp = *(f32x4*)xp + gt * v;
               });
}
DI void ffnup_item(const Params& p, int l, int item, char* smem) {
  const int mtile = item / 44, nt = item % 44;
  int seq0, slen, ti;
  if (mtile < 132) { seq0 = (mtile / 66) * T; slen = T; ti = mtile % 66; }
  else { const int j = mtile - 132; seq0 = NLAT + (j / 3) * TC; slen = TC; ti = j % 3; }
  const int m0 = seq0 + 126 * ti - 1, n0 = nt * 128;
  bf16_t* ACT = (bf16_t*)(p.ws + OFF_R);
  bf16_t* Ts = (bf16_t*)smem;
  auto epi = [&](int row, int col, f32x4 v) {
    const int lr = row - m0, c = col - n0, t = 126 * ti - 1 + lr;
    if (c >= 64 && (t < 0 || t >= slen)) v = (f32x4){0.f, 0.f, 0.f, 0.f};
    store_bf4(Ts + lr * 136 + c, v);
  };
  gemm_tile<0, 0, decltype(epi), 1>((const bf16_t*)(p.ws + OFF_HY), 1024, (const bf16_t*)(p.ws + OFF_WUP) + (size_t)l * 5632 * 1024, 1024, 1024, m0, n0, smem, nullptr, epi, seq0, seq0 + slen - 1);
  __syncthreads();
  {
    const int tid = ltid();
    const float* cw = p.ffn_conv_w + (size_t)l * 3 * DFF + nt * 64;
#pragma unroll
    for (int q = 0; q < 4; ++q) {
      const int id = tid + 256 * q, lr = 1 + (id >> 3), c8 = (id & 7) * 8, t = 126 * ti - 1 + lr;
      if (id < 1008 && t < slen) {
        const u32x4 uu = *(const u32x4*)(Ts + lr * 136 + c8), gm = *(const u32x4*)(Ts + (lr - 1) * 136 + 64 + c8), g0 = *(const u32x4*)(Ts + lr * 136 + 64 + c8), gn = *(const u32x4*)(Ts + (lr + 1) * 136 + 64 + c8);
        const float uf[8] = {bflo(uu.x), bfhi(uu.x), bflo(uu.y), bfhi(uu.y), bflo(uu.z), bfhi(uu.z), bflo(uu.w), bfhi(uu.w)};
        const float a[8] = {bflo(gm.x), bfhi(gm.x), bflo(gm.y), bfhi(gm.y), bflo(gm.z), bfhi(gm.z), bflo(gm.w), bfhi(gm.w)};
        const float m[8] = {bflo(g0.x), bfhi(g0.x), bflo(g0.y), bfhi(g0.y), bflo(g0.z), bfhi(g0.z), bflo(g0.w), bfhi(g0.w)};
        const float n[8] = {bflo(gn.x), bfhi(gn.x), bflo(gn.y), bfhi(gn.y), bflo(gn.z), bfhi(gn.z), bflo(gn.w), bfhi(gn.w)};
        float o[8];
#pragma unroll
        for (int j = 0; j < 8; ++j) o[j] = silu_f(cw[c8 + j] * a[j] + cw[DFF + c8 + j] * m[j] + cw[2 * DFF + c8 + j] * n[j]) * uf[j];
        u32x4 ov; ov.x = pack2(o[0], o[1]); ov.y = pack2(o[2], o[3]); ov.z = pack2(o[4], o[5]); ov.w = pack2(o[6], o[7]);
        *(u32x4*)(ACT + (size_t)(seq0 + t) * DFF + nt * 64 + c8) = ov;
      }
    }
  }
  __syncthreads();
}
DI void ffndown_item(const Params& p, int l, int item, char* smem) {
  const int mt = item >> 3, nt = item & 7;
  const float* MOD = (const float*)(p.ws + OFF_MOD);
  gemm_tile<0, 2>((const bf16_t*)(p.ws + OFF_R), DFF, (const bf16_t*)(p.ws + OFF_WDN) + (size_t)l * 1024 * 2816, 2816, 2816, mt * 128, nt * 128, smem, nullptr,
               [&](int row, int col, f32x4 v) {
                 const int s = row < NLAT ? row / T : 2;
                 const f32x4 gt = *(const f32x4*)(MOD + (size_t)(l * 3 + s) * 6144 + 5120 + col);
                 float* xp = row < NLAT ? p.xb + (size_t)row * 1024 + col : (float*)(p.ws + OFF_CTX) + (size_t)(row - NLAT) * 1024 + col;
                 *(f32x4*)xp = *(f32x4*)xp + gt * v;
               });
}
DI void final_item(const Params& p, int item) {
  const int lane = ltid() & 63, w = __builtin_amdgcn_readfirstlane(ltid() >> 6), row = item * 4 + w;
  float* x = p.xb + (size_t)row * 1024;
  float4 v[4]; float ss = 0.f;
#pragma unroll
  for (int i = 0; i < 4; ++i) { v[i] = *(const float4*)(x + (i * 64 + lane) * 4); ss += v[i].x * v[i].x + v[i].y * v[i].y + v[i].z * v[i].z + v[i].w * v[i].w; }
  ss = wave_sum(ss);
  const float rstd = rsqrtf(ss * (1.f / 1024.f) + 1e-6f);
#pragma unroll
  for (int i = 0; i < 4; ++i) {
    const int k = (i * 64 + lane) * 4; const float4 g = *(const float4*)(p.final_norm + k);
    float4 o; o.x = v[i].x * rstd * g.x; o.y = v[i].y * rstd * g.y; o.z = v[i].z * rstd * g.z; o.w = v[i].w * rstd * g.w;
    *(float4*)(x + k) = o;
  }
}

constexpr int PPL = 10;
constexpr int N_PHASES = 2 + NL * PPL;
#define FOR_ITEMS(n) for (int it = blockIdx.x; it < (n); it += gridDim.x)

DI void run_phase(const Params& p, int ph, char* smem) {
  if (ph == 0) {
    FOR_ITEMS(P0_MOD) p0_item(p, it, smem);
    p0_transposes(p, smem);
    for (int it = P0_MOD + P0_TR + blockIdx.x; it < P0_ITEMS; it += gridDim.x) p0_item(p, it, smem);
    return;
  }
  if (ph == N_PHASES - 1) { FOR_ITEMS(NLAT / 4) final_item(p, it); return; }
  const int l = (ph - 1) / PPL, k = (ph - 1) % PPL;
  const int mtiles = (l == NL - 1) ? 128 : 132;
  switch (k) {
    case 0: FOR_ITEMS(NROW / 4) norm_item(p, l, 0, it); break;
    case 1: FOR_ITEMS(138 * 22) gemm_in_item(p, l, it, smem); break;
    case 2: FOR_ITEMS(2112) s5_p1(p, l, it, smem); break;
    case 3: {
      constexpr int n0 = 2112, n1 = n0 + 2112, n2 = n1 + 528, n3 = n2 + 396, n5 = n3 + 66;
      FOR_ITEMS(n5 + 16) {
        if (it < n0) ssd_p1(p, l, it, smem);
        else if (it < n1) mlstm_p1(p, l, it - n0, smem);
        else if (it < n2) kvproj_item(p, l, it - n1, smem);
        else if (it < n3) qproj_item(p, l, it - n2, smem);
        else if (it < n5) ropek_item(p, it - n3);
        else s5_p2(p, l, it - n5);
      }
    } break;
    case 4: {
      constexpr int n0 = 528, n1 = n0 + 512, n2 = n1 + 260;
      FOR_ITEMS(n2) { if (it < n0) s5_p3(p, l, it, smem); else if (it < n1) ssd_p2(p, it - n0); else mlstm_p2(p, it - n1); }
    } break;
    case 5: {
      constexpr int n0 = 528, n2 = n0 + 1056, n3x = n2 + 1056, n3 = n3x + 264;
      const bool late = blockIdx.x >= (gridDim.x >> 1);
      if (!late) { FOR_ITEMS(n0) attn_item(p, it, smem); }
      FOR_ITEMS(n3) {
        if (it < n0) continue;
        if (it < n2) ssd_p3(p, l, it - n0, smem);
        else if (it < n3x) mlstm_p3(p, l, it - n2, smem);
        else glu_item(p, l, it - n3x, smem);
      }
      if (late) { FOR_ITEMS(n0) attn_item(p, it, smem); }
    } break;
    case 6: FOR_ITEMS(mtiles * 8) outproj_item(p, l, it, smem); break;
    case 7: FOR_ITEMS(mtiles * 32) norm_item(p, l, 1, it); break;
    case 8: FOR_ITEMS(((l == NL - 1) ? 132 : 138) * 44) ffnup_item(p, l, it, smem); break;
    case 9: FOR_ITEMS(mtiles * 8) ffndown_item(p, l, it, smem); break;
  }
}

#ifndef HASH_LO
#define HASH_LO OFF_MOD
#define HASH_HI WS_NEED
#endif
#ifndef PROBE_N
#define PROBE_N 0
#endif
DI void hash_dump(const Params& p) {
  const size_t NOUT = (size_t)NLAT * 1024, nw = (HASH_HI - HASH_LO) / 4;
  const unsigned* wsw = (const unsigned*)(p.ws + HASH_LO);
  for (size_t i = (size_t)blockIdx.x * 256 + threadIdx.x; i < NOUT; i += (size_t)gridDim.x * 256) {
    unsigned h = 12345u;
    for (size_t j = i; j < nw; j += NOUT) h = h * 1664525u + wsw[j];
    p.xb[i] = (float)(h & 0xFFFFFFu);
  }
}

#define XB_TMO      128
#define XB_XCNT(j)  (256  + 64 * (j))
#define XB_XSUB(j)  (1280 + 64 * (j))
#define XB_XGEN(j)  (2304 + 64 * (j))
#define XB_TOP      3328
#define XB_TOPGEN   3392
#define XCD_BAR_WORDS 3456
#define XB_SPIN_CAP (1u << 22)
#define LAS __attribute__((address_space(3)))
DI unsigned xb_ld(unsigned* p) { return __hip_atomic_load(p, __ATOMIC_RELAXED, __HIP_MEMORY_SCOPE_AGENT); }
DI unsigned xb_add(unsigned* p, unsigned v) { return __hip_atomic_fetch_add(p, v, __ATOMIC_RELAXED, __HIP_MEMORY_SCOPE_AGENT); }
DI unsigned xb_xcc_id() { return (unsigned)__builtin_amdgcn_s_getreg((3 << 11) | 20) & 0xFu; }
#define XB_SPIN(cond, bar) do { unsigned _sp = 0; while (cond) { __builtin_amdgcn_s_sleep(1); \
    if ((++_sp & 255u) == 0u) { if (xb_ld(&(bar)[XB_TMO])) break; if (_sp > XB_SPIN_CAP) { atomicAdd(&(bar)[XB_TMO], 1u); break; } } } } while (0)
struct XcdBarrier { unsigned* bar; unsigned x; volatile LAS unsigned* st; };
DI XcdBarrier xcd_barrier_post(unsigned* bar, volatile LAS unsigned* st) {
  XcdBarrier b; b.bar = bar; b.x = xb_xcc_id(); b.st = st;
  if (threadIdx.x == 0) (void)xb_add(&bar[XB_XCNT(b.x)], 1u);
  return b;
}
DI void xcd_barrier_complete(unsigned* bar, unsigned x, unsigned& nloc, unsigned& nx) {
  const unsigned G = gridDim.x;
  unsigned sum, cnt, mine, sp = 0u;
  for (;;) {
    sum = 0u; cnt = 0u; mine = 0u;
#pragma unroll
    for (unsigned j = 0; j < 16; ++j) { const unsigned c = xb_ld(&bar[XB_XCNT(j)]); sum += c; cnt += (c > 0u) ? 1u : 0u; mine = (j == x) ? c : mine; }
    if (sum == G) break;
    __builtin_amdgcn_s_sleep(1);
    if ((++sp & 255u) == 0u) { if (xb_ld(&bar[XB_TMO])) break; if (sp > XB_SPIN_CAP) { atomicAdd(&bar[XB_TMO], 1u); break; } }
  }
  nloc = mine > 0u ? mine : 1u; nx = cnt > 0u ? cnt : 1u;
}
DI void xcd_barrier(const XcdBarrier& b) {
  asm volatile("s_waitcnt vmcnt(0)" ::: "memory");
  __syncthreads();
  if (threadIdx.x == 0) {
    unsigned* bar = b.bar;
    __builtin_amdgcn_s_waitcnt(0);
    unsigned nloc = b.st[0], nx = b.st[1];
    if (nloc == 0u) { xcd_barrier_complete(bar, b.x, nloc, nx); b.st[0] = nloc; b.st[1] = nx; }
    const unsigned old = xb_add(&bar[XB_XSUB(b.x)], 1u);
    const unsigned gen = old / nloc;
    if (old + 1u == (gen + 1u) * nloc) {
      __builtin_amdgcn_fence(__ATOMIC_RELEASE, "agent");
      asm volatile("s_waitcnt vmcnt(0)" ::: "memory");
      const unsigned og = xb_add(&bar[XB_TOP], 1u);
      const unsigned tg = og / nx;
      if (og + 1u == (tg + 1u) * nx) xb_add(&bar[XB_TOPGEN], 1u);
      else XB_SPIN(xb_ld(&bar[XB_TOPGEN]) == tg, bar);
      __builtin_amdgcn_fence(__ATOMIC_ACQUIRE, "agent");
      xb_add(&bar[XB_XGEN(b.x)], 1u);
      asm volatile("s_waitcnt vmcnt(0)" ::: "memory");
    } else {
      XB_SPIN(xb_ld(&bar[XB_XGEN(b.x)]) == gen, bar);
      __builtin_amdgcn_fence(__ATOMIC_ACQUIRE, "agent");
      asm volatile("s_waitcnt vmcnt(0)" ::: "memory");
    }
  }
  __syncthreads();
}
constexpr int SMEM_BYTES = 73728 + 512;
__global__ void __launch_bounds__(256, 2) trunk_fwd(Params p) {
  extern __shared__ __attribute__((aligned(16))) char smem[];
  __shared__ uint4 xb_words;
  cg::grid_group grid = cg::this_grid();
  if (threadIdx.x == 0) xb_words = make_uint4(0u, 0u, 0u, 0u);
  __syncthreads();
  XcdBarrier xb = xcd_barrier_post((unsigned*)(p.ws + OFF_BAR), (volatile LAS unsigned*)&xb_words);
  for (int ph = p.ph_lo; ph < p.ph_hi; ++ph) {
    run_phase(p, ph, smem);
    if (ph + 1 < p.ph_hi) { if (ph == p.ph_lo) grid.sync(); else xcd_barrier(xb); }
  }
}

__global__ void __launch_bounds__(256) hash_kernel(Params p) { hash_dump(p); }

extern "C" void kernel_launch(void* const* d_in, const int* in_sizes, int n_in, void* d_out, int out_size, void* d_ws, size_t ws_size, hipStream_t stream) {
  static int grid_blocks = 0;
  if (!grid_blocks) {
    int dev = 0, cus = 0, per_cu = 0;
    hipGetDevice(&dev);
    hipDeviceGetAttribute(&cus, hipDeviceAttributeMultiprocessorCount, dev);
    if (hipFuncSetAttribute((const void*)trunk_fwd, hipFuncAttributeMaxDynamicSharedMemorySize, SMEM_BYTES) != hipSuccess) fprintf(stderr, "hipFuncSetAttribute(%d B LDS) failed\n", SMEM_BYTES);
    hipOccupancyMaxActiveBlocksPerMultiprocessor(&per_cu, trunk_fwd, 256, SMEM_BYTES);
    if (per_cu > 2) per_cu = 2;
    grid_blocks = cus * per_cu;
  }
  if (ws_size < OFF_BAR + XCD_BAR_WORDS * 4) { fprintf(stderr, "workspace too small: %zu < %zu\n", ws_size, (size_t)WS_NEED); return; }
  Params p{};
  const float** fp = (const float**)&p;
  for (int i = 0; i < 35; ++i) fp[i] = (const float*)d_in[i];
  p.xb = (float*)d_out; p.ws = (char*)d_ws;
#if MULTI_LAUNCH
#if PROBE_N
  for (int ph = 0; ph < PROBE_N; ++ph) { p.ph_lo = ph; p.ph_hi = ph + 1; hipLaunchKernelGGL(trunk_fwd, dim3(grid_blocks), dim3(256), 0, stream, p); }
  hipLaunchKernelGGL(hash_kernel, dim3(grid_blocks), dim3(256), 0, stream, p);
#else
  for (int ph = 0; ph < N_PHASES; ++ph) { p.ph_lo = ph; p.ph_hi = ph + 1; hipLaunchKernelGGL(trunk_fwd, dim3(grid_blocks), dim3(256), 0, stream, p); }
#endif
#else
  p.ph_lo = 0; p.ph_hi = N_PHASES;
  hipMemsetAsync((char*)d_ws + OFF_BAR, 0, XCD_BAR_WORDS * 4, stream);
  void* args[] = {&p};
  hipError_t e = hipLaunchCooperativeKernel((void*)trunk_fwd, dim3(grid_blocks), dim3(256), args, SMEM_BYTES, stream);
  if (e != hipSuccess) fprintf(stderr, "cooperative launch failed: %s (grid %d)\n", hipGetErrorString(e), grid_blocks);
#endif
}
```
